# Optimizing an MI355X kernel written in HIP

```python
import jax
import jax.numpy as jnp
from jax import lax
import numpy as np

D_MODEL = 1024
BATCH = 32
SEQ = 2048
DEPTH = 2

GRID_W = 64
CTX_LEN = 256
EPS = 1e-6
ROPE_BASE = 10000.0
NEG_INF = -1e30
N_ADA = 6
MIX_WIDTH = D_MODEL
RET_HEADS = 4
RET_V_DIM = MIX_WIDTH // (2 * RET_HEADS)
RET_QK_DIM = RET_V_DIM // 2
RET_CHUNK = 128
CONV_CH = MIX_WIDTH // 2
CONV_K = 3
ATT_HEADS = 16
ATT_HEAD_DIM = MIX_WIDTH // ATT_HEADS
ATT_KV_HEADS = 4
ATT_GROUP = ATT_HEADS // ATT_KV_HEADS
WINDOW = 128
ATT_BLOCK = 128
PEER_HEADS = 8
PEER_N_KEYS = 128
PEER_N_EXPERTS = PEER_N_KEYS * PEER_N_KEYS
PEER_D_KEY = 128
PEER_TOPK = 16
PEER_TOKEN_BLOCK = 128
N_EVEN = (DEPTH + 1) // 2
N_ODD = DEPTH // 2
RET_Q_W = RET_HEADS * RET_QK_DIM
RET_V_W = RET_HEADS * RET_V_DIM
EV_SPLITS = (RET_Q_W, 2 * RET_Q_W, 2 * RET_Q_W + RET_V_W, 2 * RET_Q_W + 2 * RET_V_W,
             2 * RET_Q_W + 2 * RET_V_W + CONV_CH, 2 * RET_Q_W + 2 * RET_V_W + 2 * CONV_CH)
EV_IN_COLS = 2 * RET_Q_W + 2 * RET_V_W + 3 * CONV_CH
ATT_Q_W = ATT_HEADS * ATT_HEAD_DIM
ATT_KV_W = ATT_KV_HEADS * ATT_HEAD_DIM
OD_IN_COLS = ATT_Q_W + 2 * ATT_KV_W

kernel_name = 'hybrid_retention_shortconv_swa_peer_dit'


def rmsnorm(x, gain):
    x32 = x.astype(jnp.float32)
    y = x32 * lax.rsqrt(jnp.mean(x32 * x32, axis=-1, keepdims=True) + EPS)
    return (y * gain.astype(jnp.float32)).astype(x.dtype)


def head_rmsnorm(y):
    y32 = y.astype(jnp.float32)
    return y32 * lax.rsqrt(jnp.mean(y32 * y32, axis=-1, keepdims=True) + EPS)


def modulate(x, shift, scale):
    return x * (1.0 + scale) + shift


def axial_rope_tables(n_tok, head_dim):
    n_rows = n_tok // GRID_W
    rows = jnp.broadcast_to(jnp.arange(n_rows, dtype=jnp.float32)[:, None], (n_rows, GRID_W)).reshape(-1)
    cols = jnp.broadcast_to(jnp.arange(GRID_W, dtype=jnp.float32)[None, :], (n_rows, GRID_W)).reshape(-1)
    n_freq = head_dim // 4
    inv_freq = ROPE_BASE ** (-jnp.arange(n_freq, dtype=jnp.float32) / n_freq)
    ang = jnp.concatenate([rows[:, None] * inv_freq, cols[:, None] * inv_freq], axis=-1)
    return jnp.cos(ang), jnp.sin(ang)


def _rotate_half(u, cos, sin):
    n = u.shape[-1] // 2
    u1, u2 = u[..., :n], u[..., n:]
    return jnp.concatenate([u1 * cos - u2 * sin, u2 * cos + u1 * sin], axis=-1)


def apply_axial_rope(x, cos, sin):
    n = x.shape[-1] // 4
    c = cos[None, :, None, :]
    s = sin[None, :, None, :]
    xr = _rotate_half(x[..., :2 * n], c[..., :n], s[..., :n])
    xc = _rotate_half(x[..., 2 * n:], c[..., n:], s[..., n:])
    return jnp.concatenate([xr, xc], axis=-1).astype(x.dtype)


def short_conv(u, w):
    t = u.shape[1]
    pad = CONV_K // 2
    up = jnp.pad(u, ((0, 0), (pad, pad), (0, 0)))
    return sum(w[i] * up[:, i:i + t] for i in range(CONV_K))


def retention_chunked(q, k, v, log_gamma, state0):
    b, t, h, dk = q.shape
    dv = v.shape[-1]
    n = t // RET_CHUNK
    qc = q.reshape(b, n, RET_CHUNK, h, dk)
    kc = k.reshape(b, n, RET_CHUNK, h, dk)
    vc = v.reshape(b, n, RET_CHUNK, h, dv)
    pos = jnp.arange(RET_CHUNK, dtype=jnp.float32)
    diff = pos[:, None] - pos[None, :]
    decay_in = jnp.where(diff[None] >= 0,
                         jnp.exp(log_gamma[:, None, None] * jnp.maximum(diff, 0.0)[None]), 0.0)
    scores = jnp.einsum('bnihd,bnjhd->bnhij', qc, kc) * decay_in
    inner = jnp.einsum('bnhij,bnjhe->bnihe', scores, vc)
    zeta = jnp.exp(log_gamma[:, None] * (RET_CHUNK - 1 - pos)[None])
    kv = jnp.einsum('bnjhd,bnjhe,hj->nbhde', kc, vc, zeta)
    chunk_decay = jnp.exp(log_gamma * RET_CHUNK)[None, :, None, None]

    def step(state, kv_i):
        return chunk_decay * state + kv_i, state

    state_final, state_prev = lax.scan(step, state0, kv)
    xi = jnp.exp(log_gamma[None, :] * (pos[:, None] + 1.0))
    cross = jnp.einsum('bnihd,nbhde->bnihe', qc, state_prev) * xi[None, None, :, :, None]
    return (inner + cross).reshape(b, t, h, dv), state_final


def retention_final_state(k, v, log_gamma):
    t = k.shape[1]
    pos = jnp.arange(t, dtype=jnp.float32)
    w = jnp.exp(log_gamma[:, None] * (t - 1 - pos)[None])
    return jnp.einsum('bthd,bthe,ht->bhde', k, v, w)


def bidirectional_retention(q_l, k_l, v_l, q_c, k_c, v_c, log_f, log_b):
    b, _, h, dk = k_c.shape
    dv = v_c.shape[-1]
    flip = lambda a: a[:, ::-1]
    zeros = jnp.zeros((b, h, dk, dv), jnp.float32)
    if q_c is not None:
        ctx_f, s_f = retention_chunked(q_c, k_c, v_c, log_f, zeros)
        ctx_b, s_b = retention_chunked(flip(q_c), flip(k_c), flip(v_c), log_b, zeros)
        out_ctx = ctx_f + flip(ctx_b)
    else:
        s_f = retention_final_state(k_c, v_c, log_f)
        s_b = retention_final_state(flip(k_c), flip(v_c), log_b)
        out_ctx = None
    lat_f, _ = retention_chunked(q_l, k_l, v_l, log_f, s_f)
    lat_b, _ = retention_chunked(flip(q_l), flip(k_l), flip(v_l), log_b, s_b)
    return lat_f + flip(lat_b), out_ctx


def even_output(ret, g, gb, gc, xt, conv_w, w_out):
    b, t = ret.shape[:2]
    y_ret = (head_rmsnorm(ret).reshape(b, t, RET_V_W) * jax.nn.silu(g.astype(jnp.float32))).astype(g.dtype)
    y_conv = gb * short_conv(gc * xt, conv_w)
    return jnp.concatenate([y_ret, y_conv], axis=-1) @ w_out


def even_mixer(a_lat, a_ctx, w_in, w_out, logit_f, logit_b, conv_w, need_ctx):
    b, n_lat, _ = a_lat.shape
    n_ctx = a_ctx.shape[1]
    k_scale = RET_QK_DIM ** -0.5
    log_f = jax.nn.log_sigmoid(logit_f.astype(jnp.float32))
    log_b = jax.nn.log_sigmoid(logit_b.astype(jnp.float32))
    cos, sin = axial_rope_tables(n_lat, RET_QK_DIM)
    q_l, k_l, v_l, g_l, gb_l, gc_l, x_l = jnp.split(a_lat @ w_in, EV_SPLITS, axis=-1)
    q_l = apply_axial_rope(q_l.reshape(b, n_lat, RET_HEADS, RET_QK_DIM), cos, sin)
    k_l = apply_axial_rope(k_l.reshape(b, n_lat, RET_HEADS, RET_QK_DIM), cos, sin) * k_scale
    v_l = v_l.reshape(b, n_lat, RET_HEADS, RET_V_DIM)
    if need_ctx:
        q_c, k_c, v_c, g_c, gb_c, gc_c, x_c = jnp.split(a_ctx @ w_in, EV_SPLITS, axis=-1)
        q_c = q_c.reshape(b, n_ctx, RET_HEADS, RET_QK_DIM)
    else:
        k_c, v_c = jnp.split(a_ctx @ w_in[:, RET_Q_W:2 * RET_Q_W + RET_V_W], (RET_Q_W,), axis=-1)
        q_c = None
    k_c = k_c.reshape(b, n_ctx, RET_HEADS, RET_QK_DIM) * k_scale
    v_c = v_c.reshape(b, n_ctx, RET_HEADS, RET_V_DIM)
    ret_l, ret_c = bidirectional_retention(q_l, k_l, v_l, q_c, k_c, v_c, log_f, log_b)
    out_lat = even_output(ret_l, g_l, gb_l, gc_l, x_l, conv_w, w_out)
    out_ctx = even_output(ret_c, g_c, gb_c, gc_c, x_c, conv_w, w_out) if need_ctx else None
    return out_lat, out_ctx


def odd_mixer(a_lat, a_ctx, w_in, w_out, sinks, need_ctx):
    b, n_lat, _ = a_lat.shape
    n_ctx = a_ctx.shape[1]
    scale = ATT_HEAD_DIM ** -0.5
    cos, sin = axial_rope_tables(n_lat, ATT_HEAD_DIM)
    q, k, v = jnp.split(a_lat @ w_in, (ATT_Q_W, ATT_Q_W + ATT_KV_W), axis=-1)
    q = apply_axial_rope(q.reshape(b, n_lat, ATT_HEADS, ATT_HEAD_DIM), cos, sin) * scale
    k = apply_axial_rope(k.reshape(b, n_lat, ATT_KV_HEADS, ATT_HEAD_DIM), cos, sin)
    v = v.reshape(b, n_lat, ATT_KV_HEADS, ATT_HEAD_DIM)
    if need_ctx:
        q_c, k_c, v_c = jnp.split(a_ctx @ w_in, (ATT_Q_W, ATT_Q_W + ATT_KV_W), axis=-1)
    else:
        k_c, v_c = jnp.split(a_ctx @ w_in[:, ATT_Q_W:], (ATT_KV_W,), axis=-1)
    k_c = k_c.reshape(b, n_ctx, ATT_KV_HEADS, ATT_HEAD_DIM)
    v_c = v_c.reshape(b, n_ctx, ATT_KV_HEADS, ATT_HEAD_DIM)
    sink = sinks.astype(jnp.float32).reshape(ATT_KV_HEADS, ATT_GROUP)

    span = ATT_BLOCK + 2 * WINDOW
    k_pad = jnp.pad(k, ((0, 0), (WINDOW, WINDOW), (0, 0), (0, 0)))
    v_pad = jnp.pad(v, ((0, 0), (WINDOW, WINDOW), (0, 0), (0, 0)))
    p_idx = jnp.arange(ATT_BLOCK)
    r_idx = jnp.arange(span)
    band = (r_idx[None, :] >= p_idx[:, None]) & (r_idx[None, :] <= p_idx[:, None] + 2 * WINDOW)

    def attend_block(blk):
        start = blk * ATT_BLOCK
        qb = lax.dynamic_slice_in_dim(q, start, ATT_BLOCK, axis=1).reshape(
            b, ATT_BLOCK, ATT_KV_HEADS, ATT_GROUP, ATT_HEAD_DIM)
        kb = lax.dynamic_slice_in_dim(k_pad, start, span, axis=1)
        vb = lax.dynamic_slice_in_dim(v_pad, start, span, axis=1)
        key_pos = start - WINDOW + r_idx
        valid = band & ((key_pos >= 0) & (key_pos < n_lat))[None, :]
        s_win = jnp.where(valid, jnp.einsum('bqkgd,bskd->bkgqs', qb, kb).astype(jnp.float32), NEG_INF)
        s_ctx = jnp.einsum('bqkgd,bskd->bkgqs', qb, k_c).astype(jnp.float32)
        s_sink = jnp.broadcast_to(sink[None, :, :, None, None], (b, ATT_KV_HEADS, ATT_GROUP, ATT_BLOCK, 1))
        probs = jax.nn.softmax(jnp.concatenate([s_win, s_ctx, s_sink], axis=-1), axis=-1).astype(v.dtype)
        o = (jnp.einsum('bkgqs,bskd->bqkgd', probs[..., :span], vb)
             + jnp.einsum('bkgqs,bskd->bqkgd', probs[..., span:span + n_ctx], v_c))
        return o.reshape(b, ATT_BLOCK, ATT_Q_W)

    o_lat = lax.map(attend_block, jnp.arange(n_lat // ATT_BLOCK))
    out_lat = jnp.moveaxis(o_lat, 0, 1).reshape(b, n_lat, ATT_Q_W) @ w_out
    if need_ctx:
        qc = q_c.reshape(b, n_ctx, ATT_KV_HEADS, ATT_GROUP, ATT_HEAD_DIM) * scale
        s = jnp.einsum('bqkgd,bskd->bkgqs', qc, k_c).astype(jnp.float32)
        s_sink = jnp.broadcast_to(sink[None, :, :, None, None], (b, ATT_KV_HEADS, ATT_GROUP, n_ctx, 1))
        probs = jax.nn.softmax(jnp.concatenate([s, s_sink], axis=-1), axis=-1).astype(v_c.dtype)
        o_c = jnp.einsum('bkgqs,bskd->bqkgd', probs[..., :n_ctx], v_c)
        out_ctx = o_c.reshape(b, n_ctx, ATT_Q_W) @ w_out
    else:
        out_ctx = None
    return out_lat, out_ctx


def peer_ffn(xn, wq, keys1, keys2, u_tab, v_tab):
    t, d = xn.shape
    half = PEER_D_KEY // 2
    q = (xn @ wq).reshape(t, PEER_HEADS, PEER_D_KEY)
    s1 = jnp.einsum('thd,hkd->thk', q[..., :half], keys1).astype(jnp.float32)
    s2 = jnp.einsum('thd,hkd->thk', q[..., half:], keys2).astype(jnp.float32)
    v1, i1 = lax.top_k(s1, PEER_TOPK)
    v2, i2 = lax.top_k(s2, PEER_TOPK)
    cand = (v1[..., :, None] + v2[..., None, :]).reshape(t, PEER_HEADS, PEER_TOPK * PEER_TOPK)
    cs, ci = lax.top_k(cand, PEER_TOPK)
    e1 = jnp.take_along_axis(i1, ci // PEER_TOPK, axis=-1)
    e2 = jnp.take_along_axis(i2, ci % PEER_TOPK, axis=-1)
    expert = e1 * PEER_N_KEYS + e2
    gate = jax.nn.softmax(cs, axis=-1).astype(xn.dtype)
    nb = t // PEER_TOKEN_BLOCK

    def block(args):
        xb, eb, gb = args
        ub = u_tab[eb]
        vb = v_tab[eb]
        act = jax.nn.gelu(jnp.einsum('td,thkd->thk', xb, ub), approximate=False)
        return jnp.einsum('thk,thkd->td', gb * act, vb)

    out = lax.map(block, (xn.reshape(nb, PEER_TOKEN_BLOCK, d),
                          expert.reshape(nb, PEER_TOKEN_BLOCK, PEER_HEADS, PEER_TOPK),
                          gate.reshape(nb, PEER_TOKEN_BLOCK, PEER_HEADS, PEER_TOPK)))
    return out.reshape(t, d)


def setup_inputs(seed: int = 0) -> dict:
    key = jax.random.key(seed)
    ks = jax.random.split(key, 24)
    f32 = jnp.float32
    nrm = lambda k, shape, s: jax.random.normal(k, shape, f32) * s
    ret_base = jnp.log(2.0 ** (5.0 + jnp.arange(RET_HEADS, dtype=f32)) - 1.0)
    return {
        'x': nrm(ks[0], (BATCH, SEQ, D_MODEL), 1.0),
        'c': nrm(ks[1], (BATCH, D_MODEL), 1.0),
        'ctx': nrm(ks[2], (BATCH, CTX_LEN, D_MODEL), 1.0),
        'c_ctx': nrm(ks[3], (D_MODEL,), 1.0),
        'ada_w': nrm(ks[4], (DEPTH, D_MODEL, N_ADA * D_MODEL), 0.5 * D_MODEL ** -0.5),
        'ada_b': nrm(ks[5], (DEPTH, N_ADA * D_MODEL), 0.01),
        'mix_norm_g': 1.0 + nrm(ks[6], (DEPTH, D_MODEL), 0.02),
        'ffn_norm_g': 1.0 + nrm(ks[7], (DEPTH, D_MODEL), 0.02),
        'ev_w_in': nrm(ks[8], (N_EVEN, D_MODEL, EV_IN_COLS), D_MODEL ** -0.5),
        'ev_w_out': nrm(ks[9], (N_EVEN, MIX_WIDTH, D_MODEL), MIX_WIDTH ** -0.5),
        'ret_decay_logit_f': ret_base[None] + nrm(ks[10], (N_EVEN, RET_HEADS), 0.1),
        'ret_decay_logit_b': ret_base[None] + nrm(ks[11], (N_EVEN, RET_HEADS), 0.1),
        'conv_w': nrm(ks[12], (N_EVEN, CONV_K, CONV_CH), CONV_K ** -0.5),
        'od_w_in': nrm(ks[13], (N_ODD, D_MODEL, OD_IN_COLS), D_MODEL ** -0.5),
        'od_w_out': nrm(ks[14], (N_ODD, MIX_WIDTH, D_MODEL), MIX_WIDTH ** -0.5),
        'attn_sinks': nrm(ks[15], (N_ODD, ATT_HEADS), 0.5),
        'peer_wq': nrm(ks[16], (DEPTH, D_MODEL, PEER_HEADS * PEER_D_KEY), D_MODEL ** -0.5),
        'peer_keys1': nrm(ks[17], (DEPTH, PEER_HEADS, PEER_N_KEYS, PEER_D_KEY // 2), (PEER_D_KEY // 2) ** -0.5),
        'peer_keys2': nrm(ks[18], (DEPTH, PEER_HEADS, PEER_N_KEYS, PEER_D_KEY // 2), (PEER_D_KEY // 2) ** -0.5),
        'peer_u': nrm(ks[19], (DEPTH, PEER_N_EXPERTS, D_MODEL), D_MODEL ** -0.5),
        'peer_v': nrm(ks[20], (DEPTH, PEER_N_EXPERTS, D_MODEL), PEER_HEADS ** -0.5),
        'final_norm_g': 1.0 + nrm(ks[21], (D_MODEL,), 0.02),
    }


def reference(x, c, ctx, c_ctx, ada_w, ada_b, mix_norm_g, ffn_norm_g, ev_w_in, ev_w_out,
              ret_decay_logit_f, ret_decay_logit_b, conv_w, od_w_in, od_w_out, attn_sinks,
              peer_wq, peer_keys1, peer_keys2, peer_u, peer_v, final_norm_g):
    h_lat, h_ctx = x, ctx
    silu_c = jax.nn.silu(c)
    silu_cc = jax.nn.silu(c_ctx)
    for layer in range(DEPTH):
        need_ctx = layer < DEPTH - 1
        j = layer // 2
        mod_lat = (silu_c @ ada_w[layer] + ada_b[layer])[:, None, :]
        mod_ctx = silu_cc @ ada_w[layer] + ada_b[layer]
        sh1, sc1, g1, sh2, sc2, g2 = jnp.split(mod_lat, N_ADA, axis=-1)
        csh1, csc1, cg1, csh2, csc2, cg2 = jnp.split(mod_ctx, N_ADA, axis=-1)
        a_lat = modulate(rmsnorm(h_lat, mix_norm_g[layer]), sh1, sc1)
        a_ctx = modulate(rmsnorm(h_ctx, mix_norm_g[layer]), csh1, csc1)
        if layer % 2 == 0:
            m_lat, m_ctx = even_mixer(a_lat, a_ctx, ev_w_in[j], ev_w_out[j], ret_decay_logit_f[j],
                                      ret_decay_logit_b[j], conv_w[j], need_ctx)
        else:
            m_lat, m_ctx = odd_mixer(a_lat, a_ctx, od_w_in[j], od_w_out[j], attn_sinks[j], need_ctx)
        h_lat = h_lat + g1 * m_lat
        f_lat = modulate(rmsnorm(h_lat, ffn_norm_g[layer]), sh2, sc2)
        if need_ctx:
            h_ctx = h_ctx + cg1 * m_ctx
            f_ctx = modulate(rmsnorm(h_ctx, ffn_norm_g[layer]), csh2, csc2)
            n_ctx_tok = f_ctx.shape[0] * f_ctx.shape[1]
            tokens = jnp.concatenate([f_ctx.reshape(-1, D_MODEL), f_lat.reshape(-1, D_MODEL)], axis=0)
            y = peer_ffn(tokens, peer_wq[layer], peer_keys1[layer], peer_keys2[layer], peer_u[layer], peer_v[layer])
            h_ctx = h_ctx + cg2 * y[:n_ctx_tok].reshape(h_ctx.shape)
            y_lat = y[n_ctx_tok:].reshape(h_lat.shape)
        else:
            y_lat = peer_ffn(f_lat.reshape(-1, D_MODEL), peer_wq[layer], peer_keys1[layer], peer_keys2[layer],
                             peer_u[layer], peer_v[layer]).reshape(h_lat.shape)
        h_lat = h_lat + g2 * y_lat
    return rmsnorm(h_lat, final_norm_g)
```

```cpp
#include <hip/hip_runtime.h>
#include <hip/hip_cooperative_groups.h>
#include <cstdio>
#include <cstdint>
namespace cg = cooperative_groups;

#ifndef MK_ONE_LAUNCH
#define MK_ONE_LAUNCH 0
#endif

typedef unsigned short bf16_t;
typedef short bf16x8 __attribute__((ext_vector_type(8)));
typedef short bf16x2v __attribute__((ext_vector_type(2)));
typedef float f32x4 __attribute__((ext_vector_type(4)));
typedef unsigned u32x4 __attribute__((ext_vector_type(4)));
typedef unsigned u32x2 __attribute__((ext_vector_type(2)));

constexpr int D = 1024, BATCH = 32, SEQ = 2048, CTXL = 256;
constexpr int NCTX = BATCH * CTXL;
constexpr int NLAT = BATCH * SEQ;
constexpr int NTOK = NCTX + NLAT;
constexpr int MODW = 6 * D;
constexpr int NEXP = 16384;
constexpr float EPS = 1e-6f;
constexpr int NTHREADS = 512;
constexpr int LDS_BYTES = 140 * 1024;

struct Params {
  const float *x, *c, *ctx, *c_ctx, *ada_w, *ada_b, *mix_g, *ffn_g, *ev_w_in, *ev_w_out, *logit_f, *logit_b, *conv_w,
      *od_w_in, *od_w_out, *sinks, *peer_wq, *keys1, *keys2, *peer_u, *peer_v, *final_g;
  float* out;
  float* mod;
  float* ropec;
  float* ropes;
  bf16_t* winT0;
  bf16_t* woutT0;
  bf16_t* winT1;
  bf16_t* woutT1;
  bf16_t* wqT;
  bf16_t* ubf;
  bf16_t* vbf;
  float* hctx;
  bf16_t* act;
  bf16_t* proj;
  bf16_t* pq;
  u32x2* sel;
  float* kv;
  bf16_t* sprev;
};

typedef __bf16 bf16x2n __attribute__((ext_vector_type(2)));
typedef float f32x2 __attribute__((ext_vector_type(2)));
__device__ __forceinline__ unsigned cvt_pk_bf16(float lo, float hi) {
  f32x2 v = {lo, hi};
  return __builtin_bit_cast(unsigned, __builtin_convertvector(v, bf16x2n));
}
__device__ __forceinline__ float bf_lo(unsigned u) { return __uint_as_float(u << 16); }
__device__ __forceinline__ float bf_hi(unsigned u) { return __uint_as_float(u & 0xffff0000u); }
__device__ __forceinline__ float bf2f(bf16_t h) { return __uint_as_float(((unsigned)h) << 16); }
__device__ __forceinline__ bf16_t f2bf(float f) { return __builtin_bit_cast(unsigned short, (__bf16)f); }

template <int CTRL>
__device__ __forceinline__ float dppf(float x) {
  return __builtin_bit_cast(float, __builtin_amdgcn_mov_dpp(__builtin_bit_cast(int, x), CTRL, 0xf, 0xf, true));
}
__device__ __forceinline__ float row16_sum(float x) {
  x += dppf<0xB1>(x); x += dppf<0x4E>(x); x += dppf<0x141>(x); x += dppf<0x128>(x);
  return x;
}
__device__ __forceinline__ float row16_max(float x) {
  x = fmaxf(x, dppf<0xB1>(x)); x = fmaxf(x, dppf<0x4E>(x)); x = fmaxf(x, dppf<0x141>(x)); x = fmaxf(x, dppf<0x128>(x));
  return x;
}
__device__ __forceinline__ float xrow16_sum(float x) {
  auto s = __builtin_amdgcn_permlane16_swap(__float_as_uint(x), __float_as_uint(x), false, false);
  x = __uint_as_float(s[0]) + __uint_as_float(s[1]);
  auto t = __builtin_amdgcn_permlane32_swap(__float_as_uint(x), __float_as_uint(x), false, false);
  return __uint_as_float(t[0]) + __uint_as_float(t[1]);
}
__device__ __forceinline__ float wave_sum(float x) { return xrow16_sum(row16_sum(x)); }

__device__ __forceinline__ float siluf(float v) { return v / (1.f + __expf(-v)); }
__device__ __forceinline__ float log_sigmoidf(float v) { return -log1pf(expf(-v)); }

#define LAS __attribute__((address_space(3)))
constexpr int BM = 256, BK = 64, HALF = 128, HTB = HALF * BK * 2, NXCD = 8, WGM = 8;
constexpr int KDIM = 1024;

__device__ __forceinline__ int lds_byte(int r, int c) {
  const int st = (r >> 4) * 2 + (c >> 5), rr = r & 15, cc = c & 31, ob = rr * 64 + cc * 2;
  return st * 1024 + (ob ^ (((ob >> 9) & 1) << 5));
}
__device__ __forceinline__ void stage_rc(int b, int& R, int& C) {
  const int st = b / 1024, sb = b % 1024, swz = sb ^ (((sb >> 9) & 1) << 5);
  R = (st >> 1) * 16 + swz / 64;
  C = (st & 1) * 32 + (swz % 64) / 2;
}
struct Sched {
  int pm0, pn0, nM, nN, G, c;
  __device__ __forceinline__ bool next(int i, int& pm, int& pn) const {
    const int nwg = nM * nN;
    const long L = (long)i * G + c;
    if (L >= nwg) return false;
    int wgid = (int)L;
    { const int q = nwg / NXCD, r = nwg % NXCD, xcd = wgid % NXCD, off = wgid / NXCD; wgid = (xcd < r ? xcd * (q + 1) : r * (q + 1) + (xcd - r) * q) + off; }
    const int nig = WGM * nN, gid = wgid / nig, fm = gid * WGM, gsz = (nM - fm) < WGM ? (nM - fm) : WGM;
    pm = pm0 + fm + ((wgid % nig) % gsz);
    pn = pn0 + (wgid % nig) / gsz;
    return true;
  }
};

template <class Epi>
__device__ __forceinline__ void gemm_phase(LAS unsigned char* lds, const bf16_t* __restrict__ Ag, const bf16_t* __restrict__ Btg, const Sched& S, const Epi& E) {
  const int tid = threadIdx.x, wid = __builtin_amdgcn_readfirstlane(tid >> 6), lane = tid & 63, wr = wid >> 2, wc = wid & 3, fr = lane & 15, fq = lane >> 4;
  constexpr int K = KDIM, nt = K / BK;
  unsigned voffA[2];
#pragma unroll
  for (int i = 0; i < 2; ++i) { int R, C; stage_rc(tid * 16 + i * 8192, R, C); voffA[i] = (unsigned)(R * K + C) * 2u; }
  const size_t kstep = (size_t)(BK * 2);
  const size_t hstep = (size_t)HALF * K * 2;
  const size_t tstep = 2 * hstep;
  const unsigned ldsw = (unsigned)wid * 1024u;
  const int aoff = lds_byte(wr * 64 + fr, fq * 8), boff = lds_byte(wc * 32 + fr, fq * 8);
#define G_SA(b, h) (((b) * 2 + (h)) * HTB)
#define G_SB(b, h) ((4 + (b) * 2 + (h)) * HTB)
#define G_STAGE(bufoff, gbase) do { _Pragma("unroll") for (int _i = 0; _i < 2; ++_i) \
    __builtin_amdgcn_global_load_lds((const unsigned*)((const char*)(gbase) + voffA[_i]), (LAS unsigned*)(lds + (bufoff) + ldsw + _i * 8192), 16, 0, 0); } while (0)
#define G_LDA(dst, b, h) do { _Pragma("unroll") for (int m = 0; m < 4; ++m) _Pragma("unroll") for (int k = 0; k < 2; ++k) dst[m][k] = *(const LAS bf16x8*)(lds + G_SA(b, h) + aoff + m * 2048 + k * 1024); } while (0)
#define G_LDB(dst, b, h) do { _Pragma("unroll") for (int n = 0; n < 2; ++n) _Pragma("unroll") for (int k = 0; k < 2; ++k) dst[n][k] = *(const LAS bf16x8*)(lds + G_SB(b, h) + boff + n * 2048 + k * 1024); } while (0)
#define G_MMA(ai, bj, At, Bt) do { __builtin_amdgcn_s_setprio(1); _Pragma("unroll") for (int m = 0; m < 4; ++m) _Pragma("unroll") for (int n = 0; n < 2; ++n) _Pragma("unroll") for (int k = 0; k < 2; ++k) \
    acc[ai][bj][m][n] = __builtin_amdgcn_mfma_f32_16x16x32_bf16(Bt[n][k], At[m][k], acc[ai][bj][m][n], 0, 0, 0); __builtin_amdgcn_s_setprio(0); } while (0)
#define G_WAIT_V(n) asm volatile("s_waitcnt vmcnt(" #n ")" ::: "memory")
#define G_WAIT_L(n) asm volatile("s_waitcnt lgkmcnt(" #n ")" ::: "memory")
#define G_BAR __builtin_amdgcn_s_barrier()
#define G_SCHED __builtin_amdgcn_sched_barrier(0)
  int cpm, cpn, npm, npn, ui = 0;
  if (!S.next(0, cpm, cpn)) return;
  f32x4 acc[2][2][4][2];
#pragma unroll
  for (int a = 0; a < 2; ++a)
#pragma unroll
    for (int b = 0; b < 2; ++b)
#pragma unroll
      for (int m = 0; m < 4; ++m)
#pragma unroll
        for (int n = 0; n < 2; ++n) acc[a][b][m][n] = (f32x4){0.f, 0.f, 0.f, 0.f};
  bf16x8 At[4][2], B0[2][2], B1[2][2];
  const char* cA = (const char*)Ag + (size_t)cpm * tstep;
  const char* cB = (const char*)Btg + (size_t)cpn * tstep;
  G_STAGE(G_SB(0, 0), cB); G_STAGE(G_SA(0, 0), cA); G_STAGE(G_SB(0, 1), cB + hstep); G_STAGE(G_SA(0, 1), cA + hstep);
  if (wr == 1) G_BAR;
  G_WAIT_V(4); G_BAR;
  G_STAGE(G_SB(1, 0), cB + kstep); G_STAGE(G_SA(1, 0), cA + kstep); G_STAGE(G_SB(1, 1), cB + hstep + kstep);
  G_WAIT_V(6); G_BAR;
  for (;;) {
    const bool has_next = S.next(ui + 1, npm, npn);
    const char* nA = has_next ? (const char*)Ag + (size_t)npm * tstep : cA;
    const char* nB = has_next ? (const char*)Btg + (size_t)npn * tstep : cB;
    for (int t = 0; t < nt; t += 2) {
      const bool last = (t == nt - 2);
      const char* a1 = cA + (size_t)(t + 1) * kstep;
      const char* a2 = last ? nA : cA + (size_t)(t + 2) * kstep;
      const char* b2 = last ? nB : cB + (size_t)(t + 2) * kstep;
      const char* a3 = a2 + kstep;
      const char* b3 = b2 + kstep;
      G_LDB(B0, 0, 0); G_SCHED; G_LDA(At, 0, 0); G_STAGE(G_SA(1, 1), a1 + hstep);
      G_WAIT_L(8); G_BAR; G_WAIT_L(0); G_MMA(0, 0, At, B0); G_BAR; G_SCHED;
      G_LDB(B1, 0, 1); G_STAGE(G_SB(0, 0), b2);
      G_BAR; G_WAIT_L(0); G_MMA(0, 1, At, B1); G_BAR;
      G_LDA(At, 0, 1); G_STAGE(G_SA(0, 0), a2);
      G_BAR; G_WAIT_L(0); G_MMA(1, 0, At, B0); G_BAR; G_SCHED;
      G_STAGE(G_SB(0, 1), b2 + hstep);
      G_WAIT_V(6); G_BAR; G_MMA(1, 1, At, B1); G_BAR;
      G_LDB(B0, 1, 0); G_SCHED; G_LDA(At, 1, 0); G_STAGE(G_SA(0, 1), a2 + hstep);
      G_WAIT_L(8); G_BAR; G_WAIT_L(0); G_MMA(0, 0, At, B0); G_BAR; G_SCHED;
      G_LDB(B1, 1, 1); G_STAGE(G_SB(1, 0), b3);
      G_BAR; G_WAIT_L(0); G_MMA(0, 1, At, B1); G_BAR;
      G_LDA(At, 1, 1); G_STAGE(G_SA(1, 0), a3);
      G_BAR; G_WAIT_L(0); G_MMA(1, 0, At, B0); G_BAR; G_SCHED;
      G_STAGE(G_SB(1, 1), b3 + hstep);
      G_WAIT_V(6); G_BAR; G_MMA(1, 1, At, B1); G_BAR;
    }
    E(acc, cpm * BM, cpn * BM, wr, wc, fr, fq);
    if (!has_next) break;
#pragma unroll
    for (int a = 0; a < 2; ++a)
#pragma unroll
      for (int b = 0; b < 2; ++b)
#pragma unroll
        for (int m = 0; m < 4; ++m)
#pragma unroll
          for (int n = 0; n < 2; ++n) acc[a][b][m][n] = (f32x4){0.f, 0.f, 0.f, 0.f};
    cpm = npm; cpn = npn; cA = nA; cB = nB; ++ui;
  }
  G_WAIT_V(0);
  if (wr == 0) G_BAR;
  G_BAR;
#undef G_SA
#undef G_SB
#undef G_STAGE
#undef G_LDA
#undef G_LDB
#undef G_MMA
}

struct EpiInProj {
  bf16_t* P; int ldc; int layer; const float* cosT; const float* sinT;
  __device__ __forceinline__ void operator()(const f32x4 (&acc)[2][2][4][2], int brow, int bcol, int wr, int wc, int fr, int fq) const {
#pragma unroll
    for (int bj = 0; bj < 2; ++bj) {
      const int colbase = bcol + bj * HALF + wc * 32;
      bool rope, scl;
      if (layer == 0) { rope = colbase < 512; scl = (colbase >= 256 && colbase < 512); }
      else { rope = colbase < 1280; scl = colbase < 1024; }
#pragma unroll
      for (int ai = 0; ai < 2; ++ai)
#pragma unroll
        for (int m = 0; m < 4; ++m) {
          const int row = brow + ai * HALF + wr * 64 + m * 16 + fr;
          f32x4 v0 = acc[ai][bj][m][0], v1 = acc[ai][bj][m][1];
          if (rope && row >= NCTX) {
            const int t = (row - NCTX) & (SEQ - 1);
            const int pos = (wc & 1) ? (t & 63) : (t >> 6);
            const f32x4 cs = *(const f32x4*)(cosT + pos * 16 + fq * 4);
            const f32x4 sn = *(const f32x4*)(sinT + pos * 16 + fq * 4);
            const f32x4 o0 = v0 * cs - v1 * sn, o1 = v1 * cs + v0 * sn;
            v0 = o0; v1 = o1;
          }
          if (scl) { v0 *= 0.125f; v1 *= 0.125f; }
          bf16_t* rp = P + (size_t)row * ldc + colbase + fq * 4;
          u32x2 w0, w1;
          w0.x = cvt_pk_bf16(v0[0], v0[1]); w0.y = cvt_pk_bf16(v0[2], v0[3]);
          w1.x = cvt_pk_bf16(v1[0], v1[1]); w1.y = cvt_pk_bf16(v1[2], v1[3]);
          *(u32x2*)rp = w0;
          *(u32x2*)(rp + 16) = w1;
        }
    }
  }
};
struct EpiBf16 {
  bf16_t* P; int ldc;
  __device__ __forceinline__ void operator()(const f32x4 (&acc)[2][2][4][2], int brow, int bcol, int wr, int wc, int fr, int fq) const {
#pragma unroll
    for (int ai = 0; ai < 2; ++ai)
#pragma unroll
      for (int m = 0; m < 4; ++m) {
        const int row = brow + ai * HALF + wr * 64 + m * 16 + fr;
#pragma unroll
        for (int bj = 0; bj < 2; ++bj)
#pragma unroll
          for (int n = 0; n < 2; ++n) {
            const f32x4 v = acc[ai][bj][m][n];
            u32x2 w; w.x = cvt_pk_bf16(v[0], v[1]); w.y = cvt_pk_bf16(v[2], v[3]);
            *(u32x2*)(P + (size_t)row * ldc + bcol + bj * HALF + wc * 32 + n * 16 + fq * 4) = w;
          }
      }
  }
};
struct EpiResid {
  const float* hin_ctx; const float* hin_lat; float* hout_ctx; float* hout_lat; const float* gate;
  __device__ __forceinline__ void operator()(const f32x4 (&acc)[2][2][4][2], int brow, int bcol, int wr, int wc, int fr, int fq) const {
    const bool isctx = brow < NCTX;
    const int b = isctx ? 32 : ((brow - NCTX) >> 11);
    const float* hin = isctx ? hin_ctx + (size_t)brow * D : hin_lat + (size_t)(brow - NCTX) * D;
    float* hout = isctx ? hout_ctx + (size_t)brow * D : hout_lat + (size_t)(brow - NCTX) * D;
    const float* g = gate + (size_t)b * MODW;
#pragma unroll
    for (int bj = 0; bj < 2; ++bj)
#pragma unroll
      for (int n = 0; n < 2; ++n) {
        const int col = bcol + bj * HALF + wc * 32 + n * 16 + fq * 4;
        const f32x4 gv = *(const f32x4*)(g + col);
#pragma unroll
        for (int ai = 0; ai < 2; ++ai)
#pragma unroll
          for (int m = 0; m < 4; ++m) {
            const int r = ai * HALF + wr * 64 + m * 16 + fr;
            const f32x4 h = *(const f32x4*)(hin + (size_t)r * D + col);
            *(f32x4*)(hout + (size_t)r * D + col) = h + gv * acc[ai][bj][m][n];
          }
      }
  }
};

template <int MT, int NT>
__device__ __forceinline__ void mm_lds(const bf16_t* A, int lda, const bf16_t* B, int ldb, int K, f32x4 (&acc)[MT][NT], int fr, int fq) {
  for (int k0 = 0; k0 < K; k0 += 32) {
    bf16x8 af[MT], bf[NT];
#pragma unroll
    for (int m = 0; m < MT; ++m) af[m] = *(const bf16x8*)(A + (m * 16 + fr) * lda + k0 + fq * 8);
#pragma unroll
    for (int n = 0; n < NT; ++n) bf[n] = *(const bf16x8*)(B + (n * 16 + fr) * ldb + k0 + fq * 8);
#pragma unroll
    for (int m = 0; m < MT; ++m)
#pragma unroll
      for (int n = 0; n < NT; ++n) acc[m][n] = __builtin_amdgcn_mfma_f32_16x16x32_bf16(af[m], bf[n], acc[m][n], 0, 0, 0);
  }
}

__device__ void phase_prep(const Params& p, unsigned char* smem, int bid, int nb) {
  const int tid = threadIdx.x;
  for (int it = bid; it < 2 * 96; it += nb) {
    const int layer = it / 96, n0 = (it % 96) * 64;
    float* s = (float*)smem;
    for (int i = tid; i < 33 * 1024; i += NTHREADS) {
      const int b = i >> 10, k = i & 1023;
      const float v = (b < 32) ? p.c[b * 1024 + k] : p.c_ctx[k];
      s[k * 33 + b] = siluf(v);
    }
    __syncthreads();
    const int col = tid & 63, kg = tid >> 6;
    float acc[33];
#pragma unroll
    for (int b = 0; b < 33; ++b) acc[b] = 0.f;
    const float* W = p.ada_w + (size_t)layer * 1024 * MODW + n0 + col;
    for (int k = kg * 128; k < kg * 128 + 128; ++k) {
      const float w = W[(size_t)k * MODW];
      const float* sk = s + k * 33;
#pragma unroll
      for (int b = 0; b < 33; ++b) acc[b] += sk[b] * w;
    }
    __syncthreads();
    float* red = (float*)smem;
#pragma unroll
    for (int b = 0; b < 33; ++b) red[(kg * 33 + b) * 64 + col] = acc[b];
    __syncthreads();
    for (int i = tid; i < 33 * 64; i += NTHREADS) {
      const int b = i >> 6, cc = i & 63;
      float t = p.ada_b[layer * MODW + n0 + cc];
#pragma unroll
      for (int g = 0; g < 8; ++g) t += red[(g * 33 + b) * 64 + cc];
      p.mod[((size_t)layer * 33 + b) * MODW + n0 + cc] = t;
    }
    __syncthreads();
  }
  if (bid == nb - 1) {
    for (int i = tid; i < 1024; i += NTHREADS) {
      const int pos = i >> 4, f = i & 15;
      const float inv = powf(10000.f, -(float)f / 16.f);
      const float ang = (float)pos * inv;
      p.ropec[i] = cosf(ang);
      p.ropes[i] = sinf(ang);
    }
  }
  {
    float* tile = (float*)smem;
    const int ntile_total = 768 + 256 + 384 + 256 + 512;
    for (int it = bid; it < ntile_total; it += nb) {
      const float* src; bf16_t* dst; int N, ti;
      if (it < 768) { src = p.ev_w_in; dst = p.winT0; N = 3072; ti = it; }
      else if (it < 1024) { src = p.ev_w_out; dst = p.woutT0; N = 1024; ti = it - 768; }
      else if (it < 1408) { src = p.od_w_in; dst = p.winT1; N = 1536; ti = it - 1024; }
      else if (it < 1664) { src = p.od_w_out; dst = p.woutT1; N = 1024; ti = it - 1408; }
      else { const int l = (it - 1664) / 256; src = p.peer_wq + (size_t)l * 1024 * 1024; dst = p.wqT + (size_t)l * 1024 * 1024; N = 1024; ti = (it - 1664) % 256; }
      const int ntn = N / 64, tk = ti / ntn, tn = ti % ntn;
      __syncthreads();
      for (int i = tid; i < 64 * 64; i += NTHREADS) {
        const int r = i >> 6, cc = i & 63;
        tile[r * 65 + cc] = src[(size_t)(tk * 64 + r) * N + tn * 64 + cc];
      }
      __syncthreads();
      for (int i = tid; i < 64 * 32; i += NTHREADS) {
        const int nn = i >> 5, kk = (i & 31) * 2;
        const unsigned w = cvt_pk_bf16(tile[kk * 65 + nn], tile[(kk + 1) * 65 + nn]);
        *(unsigned*)(dst + (size_t)(tn * 64 + nn) * 1024 + tk * 64 + kk) = w;
      }
    }
    __syncthreads();
  }
  {
    const size_t n8 = (size_t)2 * NEXP * D / 8;
    for (size_t i = (size_t)bid * NTHREADS + tid; i < 2 * n8; i += (size_t)nb * NTHREADS) {
      const bool isv = i >= n8;
      const size_t j = isv ? i - n8 : i;
      const float* src = (isv ? p.peer_v : p.peer_u) + j * 8;
      bf16_t* dst = (isv ? p.vbf : p.ubf) + j * 8;
      const f32x4 a = *(const f32x4*)src, b = *(const f32x4*)(src + 4);
      u32x4 w; w.x = cvt_pk_bf16(a[0], a[1]); w.y = cvt_pk_bf16(a[2], a[3]); w.z = cvt_pk_bf16(b[0], b[1]); w.w = cvt_pk_bf16(b[2], b[3]);
      *(u32x4*)dst = w;
    }
  }
}

__device__ void phase_norm(const Params& p, int bid, int nb, int row0, int row1, const float* hctx, const float* hlat,
                           const float* gain, const float* modl, int ish, int isc) {
  const int wid = threadIdx.x >> 6, lane = threadIdx.x & 63;
  for (int row = row0 + bid * 8 + wid; row < row1; row += nb * 8) {
    const bool isctx = row < NCTX;
    const float* h = isctx ? hctx + (size_t)row * D : hlat + (size_t)(row - NCTX) * D;
    const int b = isctx ? 32 : ((row - NCTX) >> 11);
    const float* sh = modl + (size_t)b * MODW + ish * D;
    const float* sc = modl + (size_t)b * MODW + isc * D;
    f32x4 v[4];
    float ss = 0.f;
#pragma unroll
    for (int i = 0; i < 4; ++i) {
      v[i] = *(const f32x4*)(h + i * 256 + lane * 4);
      ss += v[i][0] * v[i][0] + v[i][1] * v[i][1] + v[i][2] * v[i][2] + v[i][3] * v[i][3];
    }
    ss = wave_sum(ss);
    const float rstd = rsqrtf(ss * (1.f / D) + EPS);
#pragma unroll
    for (int i = 0; i < 4; ++i) {
      const int col = i * 256 + lane * 4;
      const f32x4 g = *(const f32x4*)(gain + col), s1 = *(const f32x4*)(sc + col), s0 = *(const f32x4*)(sh + col);
      f32x4 y = v[i] * rstd * g;
      y = y * (1.f + s1) + s0;
      u32x2 w; w.x = cvt_pk_bf16(y[0], y[1]); w.y = cvt_pk_bf16(y[2], y[3]);
      *(u32x2*)(p.act + (size_t)row * D + col) = w;
    }
  }
}

__device__ __forceinline__ void phase_gemm_inproj(const Params& p, unsigned char* smem, int bid, int nb, int layer) {
  LAS unsigned char* lds = (LAS unsigned char*)smem;
  if (layer == 0) {
    EpiInProj epi{p.proj, 3072, 0, p.ropec, p.ropes};
    Sched s{0, 0, NTOK / BM, 12, nb, bid};
    gemm_phase(lds, p.act, p.winT0, s, epi);
  } else {
    EpiInProj epi{p.proj, 1536, 1, p.ropec, p.ropes};
    Sched s{NCTX / BM, 0, NLAT / BM, 6, nb, bid};
    gemm_phase(lds, p.act, p.winT1, s, epi);
    Sched s2{0, 4, NCTX / BM, 2, nb, bid};
    gemm_phase(lds, p.act, p.winT1, s2, epi);
  }
}
__device__ __forceinline__ void phase_gemm_outproj(const Params& p, unsigned char* smem, int bid, int nb, int layer) {
  LAS unsigned char* lds = (LAS unsigned char*)smem;
  if (layer == 0) {
    EpiResid epi{p.ctx, p.x, p.hctx, p.out, p.mod + 2 * D};
    Sched s{0, 0, NTOK / BM, 4, nb, bid};
    gemm_phase(lds, p.act, p.woutT0, s, epi);
  } else {
    EpiResid epi{p.hctx, p.out, p.hctx, p.out, p.mod + (size_t)33 * MODW + 2 * D};
    Sched s{NCTX / BM, 0, NLAT / BM, 4, nb, bid};
    gemm_phase(lds, p.act, p.woutT1, s, epi);
  }
}
__device__ __forceinline__ void phase_gemm_pq(const Params& p, unsigned char* smem, int bid, int nb, int layer) {
  LAS unsigned char* lds = (LAS unsigned char*)smem;
  EpiBf16 epi{p.pq, D};
  const int pm0 = layer == 0 ? 0 : NCTX / BM;
  Sched s{pm0, 0, NTOK / BM - pm0, 4, nb, bid};
  gemm_phase(lds, p.act, p.wqT + (size_t)layer * D * D, s, epi);
}

__device__ __forceinline__ int chunk_row0(int b, int cc) { return cc < 2 ? b * CTXL + cc * 128 : NCTX + b * SEQ + (cc - 2) * 128; }

constexpr int LDP = 136;
constexpr int LDK = 72;

__device__ void phase_ret_kv(const Params& p, unsigned char* smem, int bid, int nb) {
  const int tid = threadIdx.x, wid = tid >> 6, lane = tid & 63, fr = lane & 15, fq = lane >> 4;
  bf16_t* KxT = (bf16_t*)smem;
  bf16_t* VT = KxT + 128 * LDP;
  for (int it = bid; it < BATCH * 4 * 18; it += nb) {
    const int cc = it % 18, h = (it / 18) & 3, b = it / 72;
    const int row0 = chunk_row0(b, cc);
    const float lf = log_sigmoidf(p.logit_f[h]), lb = log_sigmoidf(p.logit_b[h]);
    __syncthreads();
    for (int task = tid; task < 128 * 8; task += NTHREADS) {
      const int j = task >> 3, d0 = (task & 7) * 8;
      const u32x4 kk = *(const u32x4*)(p.proj + (size_t)(row0 + j) * 3072 + 256 + h * 64 + d0);
      const float zf = __expf(lf * (float)(127 - j)), zb = __expf(lb * (float)j);
#pragma unroll
      for (int q = 0; q < 4; ++q) {
        const float lo = bf_lo(kk[q]), hi = bf_hi(kk[q]);
        KxT[(d0 + 2 * q) * LDP + j] = f2bf(lo * zf);
        KxT[(d0 + 2 * q + 1) * LDP + j] = f2bf(hi * zf);
        KxT[(64 + d0 + 2 * q) * LDP + j] = f2bf(lo * zb);
        KxT[(64 + d0 + 2 * q + 1) * LDP + j] = f2bf(hi * zb);
      }
    }
    for (int task = tid; task < 128 * 16; task += NTHREADS) {
      const int j = task >> 4, e0 = (task & 15) * 8;
      const u32x4 vv = *(const u32x4*)(p.proj + (size_t)(row0 + j) * 3072 + 512 + h * 128 + e0);
#pragma unroll
      for (int q = 0; q < 4; ++q) {
        VT[(e0 + 2 * q) * LDP + j] = (bf16_t)(vv[q] & 0xffffu);
        VT[(e0 + 2 * q + 1) * LDP + j] = (bf16_t)(vv[q] >> 16);
      }
    }
    __syncthreads();
    f32x4 acc[1][8] = {};
    mm_lds<1, 8>(VT + wid * 16 * LDP, LDP, KxT, LDP, 128, acc, fr, fq);
    float* out = p.kv + (size_t)it * 16384;
#pragma unroll
    for (int n = 0; n < 8; ++n)
#pragma unroll
      for (int j = 0; j < 4; ++j) out[(wid * 16 + fq * 4 + j) * 128 + n * 16 + fr] = acc[0][n][j];
  }
  for (size_t task = (size_t)bid * NTHREADS + tid; task < (size_t)NTOK * 64; task += (size_t)nb * NTHREADS) {
    const int row = (int)(task >> 6), c0 = (int)(task & 63) * 8;
    const int tin = row < NCTX ? (row & (CTXL - 1)) : ((row - NCTX) & (SEQ - 1));
    const int tlen = row < NCTX ? CTXL : SEQ;
    const bf16_t* pr = p.proj + (size_t)row * 3072;
    const u32x4 gb = *(const u32x4*)(pr + 1536 + c0);
    float accv[8];
#pragma unroll
    for (int q = 0; q < 8; ++q) accv[q] = 0.f;
#pragma unroll
    for (int dt = -1; dt <= 1; ++dt) {
      if (tin + dt < 0 || tin + dt >= tlen) continue;
      const bf16_t* pr2 = pr + (ptrdiff_t)dt * 3072;
      const u32x4 gc = *(const u32x4*)(pr2 + 2048 + c0), xt = *(const u32x4*)(pr2 + 2560 + c0);
      const float* w = p.conv_w + (dt + 1) * 512 + c0;
      const f32x4 wa = *(const f32x4*)w, wb = *(const f32x4*)(w + 4);
#pragma unroll
      for (int q = 0; q < 4; ++q) {
        const float u0 = bf_lo(gc[q]) * bf_lo(xt[q]), u1 = bf_hi(gc[q]) * bf_hi(xt[q]);
        const float w0 = (2 * q < 4) ? wa[2 * q] : wb[2 * q - 4], w1 = (2 * q + 1 < 4) ? wa[2 * q + 1] : wb[2 * q + 1 - 4];
        accv[2 * q] += w0 * u0;
        accv[2 * q + 1] += w1 * u1;
      }
    }
    u32x4 o;
#pragma unroll
    for (int q = 0; q < 4; ++q) o[q] = cvt_pk_bf16(bf_lo(gb[q]) * accv[2 * q], bf_hi(gb[q]) * accv[2 * q + 1]);
#ifdef ZERO_CONV
    o = (u32x4){0u, 0u, 0u, 0u};
#endif
    *(u32x4*)(p.act + (size_t)row * D + 512 + c0) = o;
  }
}

__device__ void phase_ret_scan(const Params& p, int bid, int nb) {
  for (size_t idx = (size_t)bid * NTHREADS + threadIdx.x; idx < (size_t)BATCH * 4 * 16384; idx += (size_t)nb * NTHREADS) {
    const int el = (int)(idx & 16383), bh = (int)(idx >> 14), h = bh & 3;
    const bool fwd = (el & 127) < 64;
    const float lg = log_sigmoidf(fwd ? p.logit_f[h] : p.logit_b[h]);
    const float dec = __expf(lg * 128.f);
    float st = 0.f;
    for (int s = 0; s < 18; ++s) {
      const int cc = fwd ? s : (s < 2 ? 1 - s : 19 - s);
      const size_t off = ((size_t)bh * 18 + cc) * 16384 + el;
      p.sprev[off] = f2bf(st);
      st = dec * st + p.kv[off];
    }
  }
}

__device__ void phase_ret_out(const Params& p, unsigned char* smem, int bid, int nb) {
  const int tid = threadIdx.x, wid = tid >> 6, lane = tid & 63, fr = lane & 15, fq = lane >> 4;
  bf16_t* Kt = (bf16_t*)smem;
  bf16_t* VT = Kt + 128 * LDK;
  bf16_t* ST = VT + 128 * LDP;
  bf16_t* Pb = ST + 128 * LDP;
  for (int it = bid; it < BATCH * 4 * 18; it += nb) {
    const int cc = it % 18, h = (it / 18) & 3, b = it / 72;
    const int row0 = chunk_row0(b, cc);
    const float lf = log_sigmoidf(p.logit_f[h]), lb = log_sigmoidf(p.logit_b[h]);
    __syncthreads();
    for (int task = tid; task < 128 * 8; task += NTHREADS) {
      const int j = task >> 3, d0 = (task & 7) * 8;
      *(u32x4*)(Kt + j * LDK + d0) = *(const u32x4*)(p.proj + (size_t)(row0 + j) * 3072 + 256 + h * 64 + d0);
    }
    for (int task = tid; task < 128 * 16; task += NTHREADS) {
      const int j = task >> 4, e0 = (task & 15) * 8;
      const u32x4 vv = *(const u32x4*)(p.proj + (size_t)(row0 + j) * 3072 + 512 + h * 128 + e0);
#pragma unroll
      for (int q = 0; q < 4; ++q) {
        VT[(e0 + 2 * q) * LDP + j] = (bf16_t)(vv[q] & 0xffffu);
        VT[(e0 + 2 * q + 1) * LDP + j] = (bf16_t)(vv[q] >> 16);
      }
      const int e = j;
      *(u32x4*)(ST + e * LDP + e0) = *(const u32x4*)(p.sprev + (size_t)it * 16384 + e * 128 + e0);
    }
    const int irow = wid * 16 + fr;
    bf16x8 qf[2];
#pragma unroll
    for (int ks = 0; ks < 2; ++ks) qf[ks] = *(const bf16x8*)(p.proj + (size_t)(row0 + irow) * 3072 + h * 64 + ks * 32 + fq * 8);
    __syncthreads();
    f32x4 sacc[8] = {};
#pragma unroll
    for (int ks = 0; ks < 2; ++ks)
#pragma unroll
      for (int n = 0; n < 8; ++n) {
        const bf16x8 kf = *(const bf16x8*)(Kt + (n * 16 + fr) * LDK + ks * 32 + fq * 8);
        sacc[n] = __builtin_amdgcn_mfma_f32_16x16x32_bf16(qf[ks], kf, sacc[n], 0, 0, 0);
      }
#pragma unroll
    for (int n = 0; n < 8; ++n)
#pragma unroll
      for (int jj = 0; jj < 4; ++jj) {
        const int i = wid * 16 + fq * 4 + jj, j = n * 16 + fr;
        const int df = i - j;
        const float dm = df > 0 ? __expf(lf * (float)df) : (df < 0 ? __expf(lb * (float)(-df)) : 2.f);
        Pb[i * LDP + j] = f2bf(sacc[n][jj] * dm);
      }
    __syncthreads();
    f32x4 oacc[1][8] = {};
    mm_lds<1, 8>(Pb + wid * 16 * LDP, LDP, VT, LDP, 128, oacc, fr, fq);
    {
      const float xf = __expf(lf * (float)(irow + 1)), xb = __expf(lb * (float)(128 - irow));
#pragma unroll
      for (int ks = 0; ks < 4; ++ks) {
        const float sc = ks < 2 ? xf : xb;
        const bf16x8 qs = qf[ks & 1];
        u32x4 qu = __builtin_bit_cast(u32x4, qs), qo;
#pragma unroll
        for (int q = 0; q < 4; ++q) qo[q] = cvt_pk_bf16(bf_lo(qu[q]) * sc, bf_hi(qu[q]) * sc);
        const bf16x8 qx = __builtin_bit_cast(bf16x8, qo);
#pragma unroll
        for (int n = 0; n < 8; ++n) {
          const bf16x8 sf = *(const bf16x8*)(ST + (n * 16 + fr) * LDP + ks * 32 + fq * 8);
          oacc[0][n] = __builtin_amdgcn_mfma_f32_16x16x32_bf16(qx, sf, oacc[0][n], 0, 0, 0);
        }
      }
    }
#pragma unroll
    for (int jj = 0; jj < 4; ++jj) {
      float ss = 0.f;
#pragma unroll
      for (int n = 0; n < 8; ++n) ss += oacc[0][n][jj] * oacc[0][n][jj];
      ss = row16_sum(ss);
      const float rstd = rsqrtf(ss * (1.f / 128.f) + EPS);
      const int row = row0 + wid * 16 + fq * 4 + jj;
#pragma unroll
      for (int n = 0; n < 8; ++n) {
        const int e = n * 16 + fr;
        const float g = bf2f(p.proj[(size_t)row * 3072 + 1024 + h * 128 + e]);
#ifdef ZERO_RET
        p.act[(size_t)row * D + h * 128 + e] = 0;
#else
        p.act[(size_t)row * D + h * 128 + e] = f2bf(oacc[0][n][jj] * rstd * siluf(g));
#endif
      }
    }
  }
}

__device__ void phase_attn(const Params& p, unsigned char* smem, int bid, int nb) {
  const int tid = threadIdx.x, wid = tid >> 6, lane = tid & 63, fr = lane & 15, fq = lane >> 4;
  bf16_t* Kt = (bf16_t*)smem;
  bf16_t* VT = Kt + 64 * LDK;
  bf16_t* Pw = VT + 64 * LDK + wid * 64 * LDK;
  for (int it = bid; it < BATCH * 16 * 4; it += nb) {
    const int kvh = it & 3, qb = (it >> 2) & 15, b = it >> 6;
    const int hq = kvh * 4 + (wid >> 1);
    const int q0 = qb * 128 + (wid & 1) * 64;
    const size_t latrow0 = (size_t)NCTX + (size_t)b * SEQ;
    bf16x8 qf[4][2];
#pragma unroll
    for (int m = 0; m < 4; ++m)
#pragma unroll
      for (int ks = 0; ks < 2; ++ks)
        qf[m][ks] = *(const bf16x8*)(p.proj + (latrow0 + q0 + m * 16 + fr) * 1536 + hq * 64 + ks * 32 + fq * 8);
    const float sink = p.sinks[hq];
    float mrow[4][4], lrow[4][4];
    f32x4 oacc[4][4] = {};
#pragma unroll
    for (int m = 0; m < 4; ++m)
#pragma unroll
      for (int jj = 0; jj < 4; ++jj) { mrow[m][jj] = sink; lrow[m][jj] = (fr == 0) ? 1.f : 0.f; }
    for (int tt = 0; tt < 10; ++tt) {
      const bool win = tt < 6;
      const int kpos0 = win ? qb * 128 - 128 + 64 * tt : (tt - 6) * 64;
      if (win && (kpos0 < 0 || kpos0 >= SEQ)) continue;
      const size_t krow0 = win ? latrow0 + kpos0 : (size_t)b * CTXL + kpos0;
      __syncthreads();
      {
        const int j = tid >> 3, d0 = (tid & 7) * 8;
        *(u32x4*)(Kt + j * LDK + d0) = *(const u32x4*)(p.proj + (krow0 + j) * 1536 + 1024 + kvh * 64 + d0);
        const u32x4 vv = *(const u32x4*)(p.proj + (krow0 + j) * 1536 + 1280 + kvh * 64 + d0);
#pragma unroll
        for (int q = 0; q < 4; ++q) {
          VT[(d0 + 2 * q) * LDK + j] = (bf16_t)(vv[q] & 0xffffu);
          VT[(d0 + 2 * q + 1) * LDK + j] = (bf16_t)(vv[q] >> 16);
        }
      }
      __syncthreads();
#pragma unroll
      for (int m = 0; m < 4; ++m) {
        f32x4 sacc[4];
#pragma unroll
        for (int n = 0; n < 4; ++n) sacc[n] = (f32x4){0.f, 0.f, 0.f, 0.f};
#pragma unroll
        for (int ks = 0; ks < 2; ++ks)
#pragma unroll
          for (int n = 0; n < 4; ++n) {
            const bf16x8 kf = *(const bf16x8*)(Kt + (n * 16 + fr) * LDK + ks * 32 + fq * 8);
            sacc[n] = __builtin_amdgcn_mfma_f32_16x16x32_bf16(qf[m][ks], kf, sacc[n], 0, 0, 0);
          }
#pragma unroll
        for (int jj = 0; jj < 4; ++jj) {
          const int qpos = q0 + m * 16 + fq * 4 + jj;
          float mx = -3.0e38f;
#pragma unroll
          for (int n = 0; n < 4; ++n) {
            float s = sacc[n][jj];
            if (win) { const int dd = qpos - (kpos0 + n * 16 + fr); if (dd > 128 || dd < -128) s = -1e30f; }
            sacc[n][jj] = s;
            mx = fmaxf(mx, s);
          }
          mx = row16_max(mx);
          const float mnew = fmaxf(mrow[m][jj], mx);
          const float alpha = __expf(mrow[m][jj] - mnew);
          mrow[m][jj] = mnew;
          float ls = 0.f;
#pragma unroll
          for (int n = 0; n < 4; ++n) {
            const float pv = __expf(sacc[n][jj] - mnew);
            ls += pv;
            Pw[(m * 16 + fq * 4 + jj) * LDK + n * 16 + fr] = f2bf(pv);
          }
          lrow[m][jj] = lrow[m][jj] * alpha + ls;
#pragma unroll
          for (int n = 0; n < 4; ++n) oacc[m][n][jj] *= alpha;
        }
      }
      __syncthreads();
      mm_lds<4, 4>(Pw, LDK, VT, LDK, 64, oacc, fr, fq);
    }
#pragma unroll
    for (int m = 0; m < 4; ++m)
#pragma unroll
      for (int jj = 0; jj < 4; ++jj) {
        const float l = row16_sum(lrow[m][jj]);
        const float inv = 1.f / l;
        const size_t row = latrow0 + q0 + m * 16 + fq * 4 + jj;
#pragma unroll
        for (int n = 0; n < 4; ++n) {
#ifdef ZERO_ATTN
          p.act[row * D + hq * 64 + n * 16 + fr] = 0;
#else
          p.act[row * D + hq * 64 + n * 16 + fr] = f2bf(oacc[m][n][jj] * inv);
#endif
        }
      }
  }
}

__device__ __forceinline__ unsigned f2ord(float f) { const unsigned u = __float_as_uint(f); return (u & 0x80000000u) ? ~u : (u | 0x80000000u); }
__device__ __forceinline__ float ord2f(unsigned k) { const unsigned u = (k & 0x80000000u) ? (k & 0x7fffffffu) : ~k; return __uint_as_float(u); }

__device__ void phase_peer_topk(const Params& p, unsigned char* smem, int bid, int nb, int layer, int tok0, int ntok) {
  const int tid = threadIdx.x, wid = tid >> 6, lane = tid & 63;
  float* keys = (float*)smem;
  unsigned* lists = (unsigned*)(smem + 65536);
  const int nitem = (ntok / 256) * 8;
  for (int it = bid; it < nitem; it += nb) {
    const int h = it & 7, tile = it >> 3;
    const int set = wid >> 2, tl = (wid & 3) * 64 + lane;
    const int token = tok0 + tile * 256 + tl;
    __syncthreads();
    {
      const float* k1 = p.keys1 + ((size_t)layer * 8 + h) * 8192;
      const float* k2 = p.keys2 + ((size_t)layer * 8 + h) * 8192;
      for (int i = tid; i < 2048; i += NTHREADS) {
        *(f32x4*)(keys + i * 4) = *(const f32x4*)(k1 + i * 4);
        *(f32x4*)(keys + 8192 + i * 4) = *(const f32x4*)(k2 + i * 4);
      }
    }
    float q[64];
    {
      const bf16_t* qp = p.pq + (size_t)token * D + h * 128 + set * 64;
#pragma unroll
      for (int c8 = 0; c8 < 8; ++c8) {
        const u32x4 w = *(const u32x4*)(qp + c8 * 8);
#pragma unroll
        for (int qq = 0; qq < 4; ++qq) { q[c8 * 8 + 2 * qq] = bf_lo(w[qq]); q[c8 * 8 + 2 * qq + 1] = bf_hi(w[qq]); }
      }
    }
    __syncthreads();
    unsigned top[16];
#pragma unroll
    for (int i = 0; i < 16; ++i) top[i] = 0u;
    const float* kb = keys + set * 8192;
    for (int k = 0; k < 128; ++k) {
      float s0 = 0.f, s1 = 0.f;
#pragma unroll
      for (int d4 = 0; d4 < 16; ++d4) {
        const f32x4 kv = *(const f32x4*)(kb + k * 64 + d4 * 4);
        s0 += q[d4 * 4] * kv[0]; s1 += q[d4 * 4 + 1] * kv[1];
        s0 += q[d4 * 4 + 2] * kv[2]; s1 += q[d4 * 4 + 3] * kv[3];
      }
      unsigned v = (f2ord(s0 + s1) & 0xffffff80u) | (unsigned)(127 - k);
#pragma unroll
      for (int i = 0; i < 16; ++i) { const unsigned hi = max(top[i], v); v = min(top[i], v); top[i] = hi; }
    }
    unsigned* mylist = lists + ((size_t)set * 256 + tl) * 16;
#pragma unroll
    for (int i = 0; i < 4; ++i) { u32x4 w; w.x = top[4 * i]; w.y = top[4 * i + 1]; w.z = top[4 * i + 2]; w.w = top[4 * i + 3]; *(u32x4*)(mylist + 4 * i) = w; }
    __syncthreads();
    if (set == 0) {
      unsigned o2[16];
      const unsigned* other = lists + ((size_t)256 + tl) * 16;
#pragma unroll
      for (int i = 0; i < 4; ++i) { const u32x4 w = *(const u32x4*)(other + 4 * i); o2[4 * i] = w.x; o2[4 * i + 1] = w.y; o2[4 * i + 2] = w.z; o2[4 * i + 3] = w.w; }
      float v1[16], v2[16];
#pragma unroll
      for (int i = 0; i < 16; ++i) { v1[i] = ord2f(top[i] & 0xffffff80u); v2[i] = ord2f(o2[i] & 0xffffff80u); }
      unsigned ct[16];
#pragma unroll
      for (int i = 0; i < 16; ++i) ct[i] = 0u;
#pragma unroll
      for (int i = 0; i < 16; ++i)
#pragma unroll
        for (int j = 0; j < 16; ++j) {
          if ((i + 1) * (j + 1) <= 16) {
            unsigned v = (f2ord(v1[i] + v2[j]) & 0xffffff00u) | (unsigned)(255 - (i * 16 + j));
#pragma unroll
            for (int r = 0; r < 16; ++r) { const unsigned hi = max(ct[r], v); v = min(ct[r], v); ct[r] = hi; }
          }
        }
      float cs[16], den = 0.f;
      const float mx = ord2f(ct[0] & 0xffffff00u);
#pragma unroll
      for (int r = 0; r < 16; ++r) { cs[r] = __expf(ord2f(ct[r] & 0xffffff00u) - mx); den += cs[r]; }
      const float inv = 1.f / den;
      u32x2* so = p.sel + (size_t)token * 128 + h * 16;
      const unsigned* l1 = lists + (size_t)tl * 16;
#pragma unroll
      for (int r = 0; r < 16; ++r) {
        const unsigned ci = 255u - (ct[r] & 0xffu);
        const unsigned e1 = 127u - (l1[ci >> 4] & 0x7fu), e2 = 127u - (other[ci & 15u] & 0x7fu);
        u32x2 w; w.x = e1 * 128u + e2; w.y = __float_as_uint(cs[r] * inv);
        so[r] = w;
      }
    }
  }
}

typedef __bf16 bf16x2t __attribute__((ext_vector_type(2)));
__device__ __forceinline__ float dot2bf(unsigned a, unsigned b, float c) {
  return __builtin_amdgcn_fdot2_f32_bf16(__builtin_bit_cast(bf16x2t, a), __builtin_bit_cast(bf16x2t, b), c, false);
}
__device__ __forceinline__ void peer_experts(const u32x2 se, const bf16_t* __restrict__ U, const bf16_t* __restrict__ V,
                                             const u32x4 x0, const u32x4 x1, float (&y)[16], int lane) {
  for (int j0 = 0; j0 < 64; j0 += 4) {
    u32x4 ua[4], ub[4], va[4], vb[4];
    float gate[4];
#pragma unroll
    for (int u = 0; u < 4; ++u) {
      const unsigned e = (unsigned)__builtin_amdgcn_readlane((int)se.x, j0 + u);
      gate[u] = __uint_as_float((unsigned)__builtin_amdgcn_readlane((int)se.y, j0 + u));
      const bf16_t* ur = U + (size_t)e * D;
      const bf16_t* vr = V + (size_t)e * D;
      ua[u] = *(const u32x4*)(ur + lane * 8); ub[u] = *(const u32x4*)(ur + 512 + lane * 8);
      va[u] = *(const u32x4*)(vr + lane * 8); vb[u] = *(const u32x4*)(vr + 512 + lane * 8);
    }
#pragma unroll
    for (int u = 0; u < 4; ++u) {
      float d = 0.f;
#pragma unroll
      for (int q = 0; q < 4; ++q) {
        const unsigned a0 = ua[u][q], b0 = x0[q], a1 = ub[u][q], b1 = x1[q];
        d = dot2bf(a0, b0, d);
        d = dot2bf(a1, b1, d);
      }
      d = wave_sum(d);
      const float a = gate[u] * 0.5f * d * (1.f + erff(d * 0.70710678118f));
#pragma unroll
      for (int q = 0; q < 4; ++q) {
        const unsigned w0 = va[u][q], w1 = vb[u][q];
        y[2 * q] += a * bf_lo(w0); y[2 * q + 1] += a * bf_hi(w0);
        y[8 + 2 * q] += a * bf_lo(w1); y[8 + 2 * q + 1] += a * bf_hi(w1);
      }
    }
  }
}

__device__ void phase_peer_gather(const Params& p, int bid, int nb, int layer, int tok0, int ntok) {
  const int wid = threadIdx.x >> 6, lane = threadIdx.x & 63;
  const bf16_t* U = p.ubf + (size_t)layer * NEXP * D;
  const bf16_t* V = p.vbf + (size_t)layer * NEXP * D;
  const float* modl = p.mod + (size_t)layer * 33 * MODW;
  for (int t = bid * 8 + wid; t < ntok; t += nb * 8) {
    const int token = tok0 + t;
    const bf16_t* xr = p.act + (size_t)token * D;
    const u32x4 x0 = *(const u32x4*)(xr + lane * 8), x1 = *(const u32x4*)(xr + 512 + lane * 8);
    const u32x2 se0 = p.sel[(size_t)token * 128 + lane], se1 = p.sel[(size_t)token * 128 + 64 + lane];
    float y[16];
#pragma unroll
    for (int i = 0; i < 16; ++i) y[i] = 0.f;
    peer_experts(se0, U, V, x0, x1, y, lane);
    peer_experts(se1, U, V, x0, x1, y, lane);
#ifdef ZERO_PEER
    if (layer == ZERO_PEER) {
#pragma unroll
      for (int i = 0; i < 16; ++i) y[i] = 0.f;
    }
#endif
    const bool isctx = token < NCTX;
    const int b = isctx ? 32 : ((token - NCTX) >> 11);
    const float* g2 = modl + (size_t)b * MODW + 5 * D;
    float* hrow = isctx ? p.hctx + (size_t)token * D : p.out + (size_t)(token - NCTX) * D;
    float hn[16];
    float ss = 0.f;
#pragma unroll
    for (int half = 0; half < 2; ++half)
#pragma unroll
      for (int q4 = 0; q4 < 2; ++q4) {
        const int col = half * 512 + lane * 8 + q4 * 4;
        const f32x4 hv = *(const f32x4*)(hrow + col), gv = *(const f32x4*)(g2 + col);
#pragma unroll
        for (int e = 0; e < 4; ++e) { const float v = hv[e] + gv[e] * y[half * 8 + q4 * 4 + e]; hn[half * 8 + q4 * 4 + e] = v; ss += v * v; }
      }
    ss = wave_sum(ss);
    const float rstd = rsqrtf(ss * (1.f / D) + EPS);
    if (layer == 0) {
      const float* modn = p.mod + (size_t)33 * MODW + (size_t)b * MODW;
      const float* gain = p.mix_g + D;
#pragma unroll
      for (int half = 0; half < 2; ++half) {
        u32x4 w;
#pragma unroll
        for (int q4 = 0; q4 < 2; ++q4) {
          const int col = half * 512 + lane * 8 + q4 * 4;
          f32x4 hv; hv[0] = hn[half * 8 + q4 * 4]; hv[1] = hn[half * 8 + q4 * 4 + 1]; hv[2] = hn[half * 8 + q4 * 4 + 2]; hv[3] = hn[half * 8 + q4 * 4 + 3];
          *(f32x4*)(hrow + col) = hv;
          const f32x4 g = *(const f32x4*)(gain + col), s0 = *(const f32x4*)(modn + col), s1 = *(const f32x4*)(modn + D + col);
          f32x4 yv = hv * rstd * g;
          yv = yv * (1.f + s1) + s0;
          w[q4 * 2] = cvt_pk_bf16(yv[0], yv[1]); w[q4 * 2 + 1] = cvt_pk_bf16(yv[2], yv[3]);
        }
        *(u32x4*)(p.act + (size_t)token * D + half * 512 + lane * 8) = w;
      }
    } else {
      const float* gain = p.final_g;
#pragma unroll
      for (int half = 0; half < 2; ++half)
#pragma unroll
        for (int q4 = 0; q4 < 2; ++q4) {
          const int col = half * 512 + lane * 8 + q4 * 4;
          const f32x4 g = *(const f32x4*)(gain + col);
          f32x4 o;
#pragma unroll
          for (int e = 0; e < 4; ++e) o[e] = hn[half * 8 + q4 * 4 + e] * rstd * g[e];
          *(f32x4*)(hrow + col) = o;
        }
    }
  }
}

constexpr int NPH = 18;
template <int PH>
__device__ __forceinline__ void run_phase(const Params& p, unsigned char* smem, int bid, int nb) {
  if constexpr (PH == 0) phase_prep(p, smem, bid, nb);
  else if constexpr (PH == 1) phase_norm(p, bid, nb, 0, NTOK, p.ctx, p.x, p.mix_g, p.mod, 0, 1);
  else if constexpr (PH == 2) phase_gemm_inproj(p, smem, bid, nb, 0);
  else if constexpr (PH == 3) phase_ret_kv(p, smem, bid, nb);
  else if constexpr (PH == 4) phase_ret_scan(p, bid, nb);
  else if constexpr (PH == 5) phase_ret_out(p, smem, bid, nb);
  else if constexpr (PH == 6) phase_gemm_outproj(p, smem, bid, nb, 0);
  else if constexpr (PH == 7) phase_norm(p, bid, nb, 0, NTOK, p.hctx, p.out, p.ffn_g, p.mod, 3, 4);
  else if constexpr (PH == 8) phase_gemm_pq(p, smem, bid, nb, 0);
  else if constexpr (PH == 9) phase_peer_topk(p, smem, bid, nb, 0, 0, NTOK);
  else if constexpr (PH == 10) phase_peer_gather(p, bid, nb, 0, 0, NTOK);
  else if constexpr (PH == 11) phase_gemm_inproj(p, smem, bid, nb, 1);
  else if constexpr (PH == 12) phase_attn(p, smem, bid, nb);
  else if constexpr (PH == 13) phase_gemm_outproj(p, smem, bid, nb, 1);
  else if constexpr (PH == 14) phase_norm(p, bid, nb, NCTX, NTOK, p.hctx, p.out, p.ffn_g + D, p.mod + (size_t)33 * MODW, 3, 4);
  else if constexpr (PH == 15) phase_gemm_pq(p, smem, bid, nb, 1);
  else if constexpr (PH == 16) phase_peer_topk(p, smem, bid, nb, 1, NCTX, NLAT);
  else if constexpr (PH == 17) phase_peer_gather(p, bid, nb, 1, NCTX, NLAT);
}
template <int PH>
__global__ void __launch_bounds__(NTHREADS) phase_k(Params p) {
  extern __shared__ __attribute__((aligned(16))) unsigned char smem[];
  run_phase<PH>(p, smem, blockIdx.x, gridDim.x);
}
#if MK_ONE_LAUNCH
template <int PH>
__device__ __forceinline__ void run_from(const Params& p, unsigned char* smem, int bid, int nb) {
  run_phase<PH>(p, smem, bid, nb);
  if constexpr (PH + 1 < NPH) {
    cg::this_grid().sync();
    run_from<PH + 1>(p, smem, bid, nb);
  }
}
__global__ void __launch_bounds__(NTHREADS) mega(Params p) {
  extern __shared__ __attribute__((aligned(16))) unsigned char smem[];
  run_from<0>(p, smem, blockIdx.x, gridDim.x);
}
#endif
#ifndef DBG_NPH
#define DBG_NPH 0
#endif
#if DBG_NPH
__global__ void __launch_bounds__(NTHREADS) dbg_sums(Params p, float* scr, int nph) {
  const int wid = threadIdx.x >> 6, lane = threadIdx.x & 63;
  const int gw = blockIdx.x * 8 + wid, nw = gridDim.x * 8;
  if (nph >= 2) for (int r = gw; r < NTOK; r += nw) { float s = 0.f; for (int c = lane; c < D; c += 64) s += bf2f(p.act[(size_t)r * D + c]) * (1 + (c & 7)); s = wave_sum(s); if (lane == 0) scr[r] = s; }
  if (nph >= 3 && nph <= 8) for (int r = gw; r < NTOK; r += nw) { float s = 0.f; for (int c = lane; c < 3072; c += 64) s += bf2f(p.proj[(size_t)r * 3072 + c]) * (1 + (c & 7)); s = wave_sum(s); if (lane == 0) scr[(1 << 20) + r] = s; }
  if (nph >= 12 && nph <= 15) for (int r = gw; r < NTOK; r += nw) { float s = 0.f; for (int c = lane + (r < NCTX ? 1024 : 0); c < 1536; c += 64) s += bf2f(p.proj[(size_t)r * 1536 + c]) * (1 + (c & 7)); s = wave_sum(s); if (lane == 0) scr[(1 << 20) + r] = s; }
  if (nph >= 4) for (int r = gw; r < 2304 * 128; r += nw) { float s = 0.f; for (int c = lane; c < 128; c += 64) s += p.kv[(size_t)r * 128 + c] * (1 + (c & 7)); s = wave_sum(s); if (lane == 0) scr[(2 << 20) + r] = s; }
  if (nph >= 5) for (int r = gw; r < 2304 * 128; r += nw) { float s = 0.f; for (int c = lane; c < 128; c += 64) s += bf2f(p.sprev[(size_t)r * 128 + c]) * (1 + (c & 7)); s = wave_sum(s); if (lane == 0) scr[(3 << 20) + r] = s; }
  if (nph >= 7) for (int r = gw; r < NCTX; r += nw) { float s = 0.f; for (int c = lane; c < D; c += 64) s += p.hctx[(size_t)r * D + c] * (1 + (c & 7)); s = wave_sum(s); if (lane == 0) scr[(4 << 20) + r] = s; }
  if (nph >= 1) for (int i = blockIdx.x * NTHREADS + threadIdx.x; i < 2 * 33 * MODW; i += gridDim.x * NTHREADS) scr[(5 << 20) + i] = p.mod[i];
  if (nph >= 7) for (int r = gw; r < NLAT; r += nw) { float s = 0.f; for (int c = lane; c < D; c += 64) s += p.out[(size_t)r * D + c] * (1 + (c & 7)); s = wave_sum(s); if (lane == 0) scr[(6 << 20) + r] = s; }
  if (nph >= 10 && nph <= 11) for (int r = gw; r < NTOK; r += nw) { float s = 0.f; for (int c = lane; c < 128; c += 64) { const u32x2 e = p.sel[(size_t)r * 128 + c]; s += __uint_as_float(e.y) * (float)(e.x & 1023); } s = wave_sum(s); if (lane == 0) scr[(7 << 20) + r] = s; }
}
__global__ void __launch_bounds__(NTHREADS) dbg_out(Params p, const float* scr) {
  for (size_t i = (size_t)blockIdx.x * NTHREADS + threadIdx.x; i < (size_t)NLAT * D; i += (size_t)gridDim.x * NTHREADS) p.out[i] = (i < (size_t)(8 << 20)) ? scr[i] : 0.f;
}
__global__ void __launch_bounds__(NTHREADS) dbg_zero(float* scr) {
  for (size_t i = (size_t)blockIdx.x * NTHREADS + threadIdx.x; i < (size_t)(8 << 20); i += (size_t)gridDim.x * NTHREADS) scr[i] = 0.f;
}
#endif
template <int PH>
static void launch_phases(const Params& p, int grid, hipStream_t stream) {
  static bool attr_set = false;
  if (!attr_set) { (void)hipFuncSetAttribute((const void*)phase_k<PH>, hipFuncAttributeMaxDynamicSharedMemorySize, LDS_BYTES); attr_set = true; }
  phase_k<PH><<<grid, NTHREADS, LDS_BYTES, stream>>>(p);
  if constexpr (PH + 1 < (DBG_NPH ? DBG_NPH : NPH)) launch_phases<PH + 1>(p, grid, stream);
}

extern "C" void kernel_launch(void* const* d_in, const int* in_sizes, int n_in, void* d_out, int out_size, void* d_ws,
                              size_t ws_size, hipStream_t stream) {
  Params p{};
  const float* const* in = (const float* const*)d_in;
  p.x = in[0]; p.c = in[1]; p.ctx = in[2]; p.c_ctx = in[3]; p.ada_w = in[4]; p.ada_b = in[5]; p.mix_g = in[6]; p.ffn_g = in[7];
  p.ev_w_in = in[8]; p.ev_w_out = in[9]; p.logit_f = in[10]; p.logit_b = in[11]; p.conv_w = in[12]; p.od_w_in = in[13];
  p.od_w_out = in[14]; p.sinks = in[15]; p.peer_wq = in[16]; p.keys1 = in[17]; p.keys2 = in[18]; p.peer_u = in[19];
  p.peer_v = in[20]; p.final_g = in[21];
  p.out = (float*)d_out;
  unsigned char* w = (unsigned char*)d_ws;
  size_t off = 0;
  auto take = [&](size_t bytes) { unsigned char* r = w + off; off += (bytes + 255) & ~(size_t)255; return r; };
  p.mod = (float*)take((size_t)2 * 33 * MODW * 4);
  p.ropec = (float*)take(1024 * 4);
  p.ropes = (float*)take(1024 * 4);
  p.winT0 = (bf16_t*)take((size_t)3072 * 1024 * 2);
  p.woutT0 = (bf16_t*)take((size_t)1024 * 1024 * 2);
  p.winT1 = (bf16_t*)take((size_t)1536 * 1024 * 2);
  p.woutT1 = (bf16_t*)take((size_t)1024 * 1024 * 2);
  p.wqT = (bf16_t*)take((size_t)2 * 1024 * 1024 * 2);
  p.ubf = (bf16_t*)take((size_t)2 * NEXP * D * 2);
  p.vbf = (bf16_t*)take((size_t)2 * NEXP * D * 2);
  p.hctx = (float*)take((size_t)NCTX * D * 4);
  p.act = (bf16_t*)take((size_t)NTOK * D * 2);
  p.kv = (float*)take((size_t)2304 * 16384 * 4);
  p.sprev = (bf16_t*)take((size_t)2304 * 16384 * 2);
  p.proj = (bf16_t*)take((size_t)NTOK * 3072 * 2);
  p.pq = p.proj;
  p.sel = (u32x2*)((unsigned char*)p.proj + (size_t)NTOK * D * 2);
  if (off > ws_size) { fprintf(stderr, "workspace too small: need %zu have %zu\n", off, ws_size); }

  const int grid = 256;
#if MK_ONE_LAUNCH
  static bool attr_set = false;
  if (!attr_set) { (void)hipFuncSetAttribute((const void*)mega, hipFuncAttributeMaxDynamicSharedMemorySize, LDS_BYTES); attr_set = true; }
  void* args[] = {&p};
  hipError_t e = hipLaunchCooperativeKernel((const void*)mega, dim3(grid), dim3(NTHREADS), args, LDS_BYTES, stream);
  if (e != hipSuccess) fprintf(stderr, "cooperative launch failed: %s\n", hipGetErrorString(e));
#else
  launch_phases<0>(p, grid, stream);
#if DBG_NPH
  float* scr = (float*)(w + off);
  dbg_zero<<<grid, NTHREADS, 0, stream>>>(scr);
  dbg_sums<<<grid, NTHREADS, 0, stream>>>(p, scr, DBG_NPH);
  dbg_out<<<grid, NTHREADS, 0, stream>>>(p, scr);
#endif
#endif
}
```

```cpp
#include <hip/hip_runtime.h>
#include <hip/hip_cooperative_groups.h>
#include <cstdio>
#include <cstdint>
namespace cg = cooperative_groups;

#ifndef MK_ONE_LAUNCH
#define MK_ONE_LAUNCH 1
#endif

typedef unsigned short bf16_t;
typedef short bf16x8 __attribute__((ext_vector_type(8)));
typedef short bf16x2v __attribute__((ext_vector_type(2)));
typedef float f32x4 __attribute__((ext_vector_type(4)));
typedef unsigned u32x4 __attribute__((ext_vector_type(4)));
typedef unsigned u32x2 __attribute__((ext_vector_type(2)));

constexpr int D = 1024, BATCH = 32, SEQ = 2048, CTXL = 256;
constexpr int NCTX = BATCH * CTXL;
constexpr int NLAT = BATCH * SEQ;
constexpr int NTOK = NCTX + NLAT;
constexpr int MODW = 6 * D;
constexpr int NEXP = 16384;
constexpr float EPS = 1e-6f;
constexpr int NTHREADS = 512;
constexpr int LDS_BYTES = 140 * 1024;

struct Params {
  const float *x, *c, *ctx, *c_ctx, *ada_w, *ada_b, *mix_g, *ffn_g, *ev_w_in, *ev_w_out, *logit_f, *logit_b, *conv_w,
      *od_w_in, *od_w_out, *sinks, *peer_wq, *keys1, *keys2, *peer_u, *peer_v, *final_g;
  float* out;
  float* mod;
  float* ropec;
  float* ropes;
  bf16_t* winT0;
  bf16_t* woutT0;
  bf16_t* winT1;
  bf16_t* woutT1;
  bf16_t* wqT;
  bf16_t* ubf;
  bf16_t* vbf;
  float* hctx;
  bf16_t* act;
  bf16_t* proj;
  bf16_t* pq;
  u32x2* sel;
  float* kv;
  bf16_t* sprev;
};

typedef __bf16 bf16x2n __attribute__((ext_vector_type(2)));
typedef float f32x2 __attribute__((ext_vector_type(2)));
__device__ __forceinline__ unsigned cvt_pk_bf16(float lo, float hi) {
  f32x2 v = {lo, hi};
  return __builtin_bit_cast(unsigned, __builtin_convertvector(v, bf16x2n));
}
__device__ __forceinline__ float bf_lo(unsigned u) { return __uint_as_float(u << 16); }
__device__ __forceinline__ float bf_hi(unsigned u) { return __uint_as_float(u & 0xffff0000u); }
__device__ __forceinline__ float bf2f(bf16_t h) { return __uint_as_float(((unsigned)h) << 16); }
__device__ __forceinline__ bf16_t f2bf(float f) { return __builtin_bit_cast(unsigned short, (__bf16)f); }

template <int CTRL>
__device__ __forceinline__ float dppf(float x) {
  return __builtin_bit_cast(float, __builtin_amdgcn_mov_dpp(__builtin_bit_cast(int, x), CTRL, 0xf, 0xf, true));
}
__device__ __forceinline__ float row16_sum(float x) {
  x += dppf<0xB1>(x); x += dppf<0x4E>(x); x += dppf<0x141>(x); x += dppf<0x128>(x);
  return x;
}
__device__ __forceinline__ float row16_max(float x) {
  x = fmaxf(x, dppf<0xB1>(x)); x = fmaxf(x, dppf<0x4E>(x)); x = fmaxf(x, dppf<0x141>(x)); x = fmaxf(x, dppf<0x128>(x));
  return x;
}
__device__ __forceinline__ float xrow16_sum(float x) {
  auto s = __builtin_amdgcn_permlane16_swap(__float_as_uint(x), __float_as_uint(x), false, false);
  x = __uint_as_float(s[0]) + __uint_as_float(s[1]);
  auto t = __builtin_amdgcn_permlane32_swap(__float_as_uint(x), __float_as_uint(x), false, false);
  return __uint_as_float(t[0]) + __uint_as_float(t[1]);
}
__device__ __forceinline__ float wave_sum(float x) { return xrow16_sum(row16_sum(x)); }

__device__ __forceinline__ int tidx() {
  int t = threadIdx.x;
  asm volatile("" : "+v"(t));
  __builtin_assume(t >= 0 && t < NTHREADS);
  return t;
}
__device__ __forceinline__ float siluf(float v) { return v / (1.f + __expf(-v)); }
__device__ __forceinline__ float log_sigmoidf(float v) { return -log1pf(expf(-v)); }

#define LAS __attribute__((address_space(3)))
constexpr int BM = 256, BK = 64, HALF = 128, HTB = HALF * BK * 2, NXCD = 8, WGM = 8;
constexpr int KDIM = 1024;

__device__ __forceinline__ int lds_byte(int r, int c) {
  const int st = (r >> 4) * 2 + (c >> 5), rr = r & 15, cc = c & 31, ob = rr * 64 + cc * 2;
  return st * 1024 + (ob ^ (((ob >> 9) & 1) << 5));
}
__device__ __forceinline__ void stage_rc(int b, int& R, int& C) {
  const int st = b / 1024, sb = b % 1024, swz = sb ^ (((sb >> 9) & 1) << 5);
  R = (st >> 1) * 16 + swz / 64;
  C = (st & 1) * 32 + (swz % 64) / 2;
}
struct Sched {
  int pm0, pn0, nM, nN, G, c;
  __device__ __forceinline__ bool next(int i, int& pm, int& pn) const {
    const int nwg = nM * nN;
    const long L = (long)i * G + c;
    if (L >= nwg) return false;
    int wgid = (int)L;
    { const int q = nwg / NXCD, r = nwg % NXCD, xcd = wgid % NXCD, off = wgid / NXCD; wgid = (xcd < r ? xcd * (q + 1) : r * (q + 1) + (xcd - r) * q) + off; }
    const int nig = WGM * nN, gid = wgid / nig, fm = gid * WGM, gsz = (nM - fm) < WGM ? (nM - fm) : WGM;
    pm = pm0 + fm + ((wgid % nig) % gsz);
    pn = pn0 + (wgid % nig) / gsz;
    return true;
  }
};

template <class Epi>
__device__ __forceinline__ void gemm_phase(LAS unsigned char* lds, const bf16_t* __restrict__ Ag, const bf16_t* __restrict__ Btg, const Sched& S, const Epi& E) {
  const int tid = tidx(), wid = __builtin_amdgcn_readfirstlane(tid >> 6), lane = tid & 63, wr = wid >> 2, wc = wid & 3, fr = lane & 15, fq = lane >> 4;
  constexpr int K = KDIM, nt = K / BK;
  unsigned voffA[2];
#pragma unroll
  for (int i = 0; i < 2; ++i) { int R, C; stage_rc(tid * 16 + i * 8192, R, C); voffA[i] = (unsigned)(R * K + C) * 2u; }
  const size_t kstep = (size_t)(BK * 2);
  const size_t hstep = (size_t)HALF * K * 2;
  const size_t tstep = 2 * hstep;
  const unsigned ldsw = (unsigned)wid * 1024u;
  const int aoff = lds_byte(wr * 64 + fr, fq * 8), boff = lds_byte(wc * 32 + fr, fq * 8);
#define G_SA(b, h) (((b) * 2 + (h)) * HTB)
#define G_SB(b, h) ((4 + (b) * 2 + (h)) * HTB)
#define G_STAGE(bufoff, gbase) do { _Pragma("unroll") for (int _i = 0; _i < 2; ++_i) \
    __builtin_amdgcn_global_load_lds((const unsigned*)((const char*)(gbase) + voffA[_i]), (LAS unsigned*)(lds + (bufoff) + ldsw + _i * 8192), 16, 0, 0); } while (0)
#define G_LDA(dst, b, h) do { _Pragma("unroll") for (int m = 0; m < 4; ++m) _Pragma("unroll") for (int k = 0; k < 2; ++k) dst[m][k] = *(const LAS bf16x8*)(lds + G_SA(b, h) + aoff + m * 2048 + k * 1024); } while (0)
#define G_LDB(dst, b, h) do { _Pragma("unroll") for (int n = 0; n < 2; ++n) _Pragma("unroll") for (int k = 0; k < 2; ++k) dst[n][k] = *(const LAS bf16x8*)(lds + G_SB(b, h) + boff + n * 2048 + k * 1024); } while (0)
#define G_MMA(ai, bj, At, Bt) do { __builtin_amdgcn_s_setprio(1); _Pragma("unroll") for (int m = 0; m < 4; ++m) _Pragma("unroll") for (int n = 0; n < 2; ++n) _Pragma("unroll") for (int k = 0; k < 2; ++k) \
    acc[ai][bj][m][n] = __builtin_amdgcn_mfma_f32_16x16x32_bf16(Bt[n][k], At[m][k], acc[ai][bj][m][n], 0, 0, 0); __builtin_amdgcn_s_setprio(0); } while (0)
#define G_WAIT_V(n) asm volatile("s_waitcnt vmcnt(" #n ")" ::: "memory")
#define G_WAIT_L(n) asm volatile("s_waitcnt lgkmcnt(" #n ")" ::: "memory")
#define G_BAR __builtin_amdgcn_s_barrier()
#define G_SCHED __builtin_amdgcn_sched_barrier(0)
  int cpm, cpn, npm, npn, ui = 0;
  if (!S.next(0, cpm, cpn)) return;
  f32x4 acc[2][2][4][2];
#pragma unroll
  for (int a = 0; a < 2; ++a)
#pragma unroll
    for (int b = 0; b < 2; ++b)
#pragma unroll
      for (int m = 0; m < 4; ++m)
#pragma unroll
        for (int n = 0; n < 2; ++n) acc[a][b][m][n] = (f32x4){0.f, 0.f, 0.f, 0.f};
  bf16x8 At[4][2], B0[2][2], B1[2][2];
  const char* cA = (const char*)Ag + (size_t)cpm * tstep;
  const char* cB = (const char*)Btg + (size_t)cpn * tstep;
  G_STAGE(G_SB(0, 0), cB); G_STAGE(G_SA(0, 0), cA); G_STAGE(G_SB(0, 1), cB + hstep); G_STAGE(G_SA(0, 1), cA + hstep);
  if (wr == 1) G_BAR;
  G_WAIT_V(4); G_BAR;
  G_STAGE(G_SB(1, 0), cB + kstep); G_STAGE(G_SA(1, 0), cA + kstep); G_STAGE(G_SB(1, 1), cB + hstep + kstep);
  G_WAIT_V(6); G_BAR;
  for (;;) {
    const bool has_next = S.next(ui + 1, npm, npn);
    const char* nA = has_next ? (const char*)Ag + (size_t)npm * tstep : cA;
    const char* nB = has_next ? (const char*)Btg + (size_t)npn * tstep : cB;
    for (int t = 0; t < nt; t += 2) {
      const bool last = (t == nt - 2);
      const char* a1 = cA + (size_t)(t + 1) * kstep;
      const char* a2 = last ? nA : cA + (size_t)(t + 2) * kstep;
      const char* b2 = last ? nB : cB + (size_t)(t + 2) * kstep;
      const char* a3 = a2 + kstep;
      const char* b3 = b2 + kstep;
      G_LDB(B0, 0, 0); G_SCHED; G_LDA(At, 0, 0); G_STAGE(G_SA(1, 1), a1 + hstep);
      G_WAIT_L(8); G_BAR; G_WAIT_L(0); G_MMA(0, 0, At, B0); G_BAR; G_SCHED;
      G_LDB(B1, 0, 1); G_STAGE(G_SB(0, 0), b2);
      G_BAR; G_WAIT_L(0); G_MMA(0, 1, At, B1); G_BAR;
      G_LDA(At, 0, 1); G_STAGE(G_SA(0, 0), a2);
      G_BAR; G_WAIT_L(0); G_MMA(1, 0, At, B0); G_BAR; G_SCHED;
      G_STAGE(G_SB(0, 1), b2 + hstep);
      G_WAIT_V(6); G_BAR; G_MMA(1, 1, At, B1); G_BAR;
      G_LDB(B0, 1, 0); G_SCHED; G_LDA(At, 1, 0); G_STAGE(G_SA(0, 1), a2 + hstep);
      G_WAIT_L(8); G_BAR; G_WAIT_L(0); G_MMA(0, 0, At, B0); G_BAR; G_SCHED;
      G_LDB(B1, 1, 1); G_STAGE(G_SB(1, 0), b3);
      G_BAR; G_WAIT_L(0); G_MMA(0, 1, At, B1); G_BAR;
      G_LDA(At, 1, 1); G_STAGE(G_SA(1, 0), a3);
      G_BAR; G_WAIT_L(0); G_MMA(1, 0, At, B0); G_BAR; G_SCHED;
      G_STAGE(G_SB(1, 1), b3 + hstep);
      G_WAIT_V(6); G_BAR; G_MMA(1, 1, At, B1); G_BAR;
    }
    E(acc, cpm * BM, cpn * BM, wr, wc, fr, fq);
    if (!has_next) break;
#pragma unroll
    for (int a = 0; a < 2; ++a)
#pragma unroll
      for (int b = 0; b < 2; ++b)
#pragma unroll
        for (int m = 0; m < 4; ++m)
#pragma unroll
          for (int n = 0; n < 2; ++n) acc[a][b][m][n] = (f32x4){0.f, 0.f, 0.f, 0.f};
    cpm = npm; cpn = npn; cA = nA; cB = nB; ++ui;
  }
  G_WAIT_V(0);
  if (wr == 0) G_BAR;
  G_BAR;
#undef G_SA
#undef G_SB
#undef G_STAGE
#undef G_LDA
#undef G_LDB
#undef G_MMA
}

struct EpiInProj {
  bf16_t* P; int ldc; int layer; const float* cosT; const float* sinT;
  __device__ __forceinline__ void operator()(const f32x4 (&acc)[2][2][4][2], int brow, int bcol, int wr, int wc, int fr, int fq) const {
#pragma unroll
    for (int bj = 0; bj < 2; ++bj) {
      const int colbase = bcol + bj * HALF + wc * 32;
      bool rope, scl;
      if (layer == 0) { rope = colbase < 512; scl = (colbase >= 256 && colbase < 512); }
      else { rope = colbase < 1280; scl = colbase < 1024; }
#pragma unroll
      for (int ai = 0; ai < 2; ++ai)
#pragma unroll
        for (int m = 0; m < 4; ++m) {
          const int row = brow + ai * HALF + wr * 64 + m * 16 + fr;
          f32x4 v0 = acc[ai][bj][m][0], v1 = acc[ai][bj][m][1];
          if (rope && row >= NCTX) {
            const int t = (row - NCTX) & (SEQ - 1);
            const int pos = (wc & 1) ? (t & 63) : (t >> 6);
            const f32x4 cs = *(const f32x4*)(cosT + pos * 16 + fq * 4);
            const f32x4 sn = *(const f32x4*)(sinT + pos * 16 + fq * 4);
            const f32x4 o0 = v0 * cs - v1 * sn, o1 = v1 * cs + v0 * sn;
            v0 = o0; v1 = o1;
          }
          if (scl) { v0 *= 0.125f; v1 *= 0.125f; }
          bf16_t* rp = P + (size_t)row * ldc + colbase + fq * 4;
          u32x2 w0, w1;
          w0.x = cvt_pk_bf16(v0[0], v0[1]); w0.y = cvt_pk_bf16(v0[2], v0[3]);
          w1.x = cvt_pk_bf16(v1[0], v1[1]); w1.y = cvt_pk_bf16(v1[2], v1[3]);
          *(u32x2*)rp = w0;
          *(u32x2*)(rp + 16) = w1;
        }
    }
  }
};
struct EpiBf16 {
  bf16_t* P; int ldc;
  __device__ __forceinline__ void operator()(const f32x4 (&acc)[2][2][4][2], int brow, int bcol, int wr, int wc, int fr, int fq) const {
#pragma unroll
    for (int ai = 0; ai < 2; ++ai)
#pragma unroll
      for (int m = 0; m < 4; ++m) {
        const int row = brow + ai * HALF + wr * 64 + m * 16 + fr;
#pragma unroll
        for (int bj = 0; bj < 2; ++bj)
#pragma unroll
          for (int n = 0; n < 2; ++n) {
            const f32x4 v = acc[ai][bj][m][n];
            u32x2 w; w.x = cvt_pk_bf16(v[0], v[1]); w.y = cvt_pk_bf16(v[2], v[3]);
            *(u32x2*)(P + (size_t)row * ldc + bcol + bj * HALF + wc * 32 + n * 16 + fq * 4) = w;
          }
      }
  }
};
struct EpiResid {
  const float* hin_ctx; const float* hin_lat; float* hout_ctx; float* hout_lat; const float* gate;
  __device__ __forceinline__ void operator()(const f32x4 (&acc)[2][2][4][2], int brow, int bcol, int wr, int wc, int fr, int fq) const {
    const bool isctx = brow < NCTX;
    const int b = isctx ? 32 : ((brow - NCTX) >> 11);
    const float* hin = isctx ? hin_ctx + (size_t)brow * D : hin_lat + (size_t)(brow - NCTX) * D;
    float* hout = isctx ? hout_ctx + (size_t)brow * D : hout_lat + (size_t)(brow - NCTX) * D;
    const float* g = gate + (size_t)b * MODW;
#pragma unroll
    for (int bj = 0; bj < 2; ++bj)
#pragma unroll
      for (int n = 0; n < 2; ++n) {
        const int col = bcol + bj * HALF + wc * 32 + n * 16 + fq * 4;
        const f32x4 gv = *(const f32x4*)(g + col);
#pragma unroll
        for (int ai = 0; ai < 2; ++ai)
#pragma unroll
          for (int m = 0; m < 4; ++m) {
            const int r = ai * HALF + wr * 64 + m * 16 + fr;
            const f32x4 h = *(const f32x4*)(hin + (size_t)r * D + col);
            *(f32x4*)(hout + (size_t)r * D + col) = h + gv * acc[ai][bj][m][n];
          }
      }
  }
};

template <int MT, int NT>
__device__ __forceinline__ void mm_lds(const bf16_t* A, int lda, const bf16_t* B, int ldb, int K, f32x4 (&acc)[MT][NT], int fr, int fq) {
  for (int k0 = 0; k0 < K; k0 += 32) {
    bf16x8 af[MT], bf[NT];
#pragma unroll
    for (int m = 0; m < MT; ++m) af[m] = *(const bf16x8*)(A + (m * 16 + fr) * lda + k0 + fq * 8);
#pragma unroll
    for (int n = 0; n < NT; ++n) bf[n] = *(const bf16x8*)(B + (n * 16 + fr) * ldb + k0 + fq * 8);
#pragma unroll
    for (int m = 0; m < MT; ++m)
#pragma unroll
      for (int n = 0; n < NT; ++n) acc[m][n] = __builtin_amdgcn_mfma_f32_16x16x32_bf16(af[m], bf[n], acc[m][n], 0, 0, 0);
  }
}

__device__ void phase_prep(const Params& p, unsigned char* smem, int bid, int nb) {
  const int tid = tidx();
  for (int it = bid; it < 2 * 96; it += nb) {
    const int layer = it / 96, n0 = (it % 96) * 64;
    float* s = (float*)smem;
    for (int i = tid; i < 33 * 1024; i += NTHREADS) {
      const int b = i >> 10, k = i & 1023;
      const float v = (b < 32) ? p.c[b * 1024 + k] : p.c_ctx[k];
      s[k * 33 + b] = siluf(v);
    }
    __syncthreads();
    const int col = tid & 63, kg = tid >> 6;
    float acc[33];
#pragma unroll
    for (int b = 0; b < 33; ++b) acc[b] = 0.f;
    const float* W = p.ada_w + (size_t)layer * 1024 * MODW + n0 + col;
    for (int k = kg * 128; k < kg * 128 + 128; ++k) {
      const float w = W[(size_t)k * MODW];
      const float* sk = s + k * 33;
#pragma unroll
      for (int b = 0; b < 33; ++b) acc[b] += sk[b] * w;
    }
    __syncthreads();
    float* red = (float*)smem;
#pragma unroll
    for (int b = 0; b < 33; ++b) red[(kg * 33 + b) * 64 + col] = acc[b];
    __syncthreads();
    for (int i = tid; i < 33 * 64; i += NTHREADS) {
      const int b = i >> 6, cc = i & 63;
      float t = p.ada_b[layer * MODW + n0 + cc];
#pragma unroll
      for (int g = 0; g < 8; ++g) t += red[(g * 33 + b) * 64 + cc];
      p.mod[((size_t)layer * 33 + b) * MODW + n0 + cc] = t;
    }
    __syncthreads();
  }
  if (bid == nb - 1) {
    for (int i = tid; i < 1024; i += NTHREADS) {
      const int pos = i >> 4, f = i & 15;
      const float inv = powf(10000.f, -(float)f / 16.f);
      const float ang = (float)pos * inv;
      p.ropec[i] = cosf(ang);
      p.ropes[i] = sinf(ang);
    }
  }
  {
    float* tile = (float*)smem;
    const int ntile_total = 768 + 256 + 384 + 256 + 512;
    for (int it = bid; it < ntile_total; it += nb) {
      const float* src; bf16_t* dst; int N, ti;
      if (it < 768) { src = p.ev_w_in; dst = p.winT0; N = 3072; ti = it; }
      else if (it < 1024) { src = p.ev_w_out; dst = p.woutT0; N = 1024; ti = it - 768; }
      else if (it < 1408) { src = p.od_w_in; dst = p.winT1; N = 1536; ti = it - 1024; }
      else if (it < 1664) { src = p.od_w_out; dst = p.woutT1; N = 1024; ti = it - 1408; }
      else { const int l = (it - 1664) / 256; src = p.peer_wq + (size_t)l * 1024 * 1024; dst = p.wqT + (size_t)l * 1024 * 1024; N = 1024; ti = (it - 1664) % 256; }
      const int ntn = N / 64, tk = ti / ntn, tn = ti % ntn;
      __syncthreads();
      for (int i = tid; i < 64 * 64; i += NTHREADS) {
        const int r = i >> 6, cc = i & 63;
        tile[r * 65 + cc] = src[(size_t)(tk * 64 + r) * N + tn * 64 + cc];
      }
      __syncthreads();
      for (int i = tid; i < 64 * 32; i += NTHREADS) {
        const int nn = i >> 5, kk = (i & 31) * 2;
        const unsigned w = cvt_pk_bf16(tile[kk * 65 + nn], tile[(kk + 1) * 65 + nn]);
        *(unsigned*)(dst + (size_t)(tn * 64 + nn) * 1024 + tk * 64 + kk) = w;
      }
    }
    __syncthreads();
  }
  {
    const size_t n8 = (size_t)2 * NEXP * D / 8;
    for (size_t i = (size_t)bid * NTHREADS + tid; i < 2 * n8; i += (size_t)nb * NTHREADS) {
      const bool isv = i >= n8;
      const size_t j = isv ? i - n8 : i;
      const float* src = (isv ? p.peer_v : p.peer_u) + j * 8;
      bf16_t* dst = (isv ? p.vbf : p.ubf) + j * 8;
      const f32x4 a = *(const f32x4*)src, b = *(const f32x4*)(src + 4);
      u32x4 w; w.x = cvt_pk_bf16(a[0], a[1]); w.y = cvt_pk_bf16(a[2], a[3]); w.z = cvt_pk_bf16(b[0], b[1]); w.w = cvt_pk_bf16(b[2], b[3]);
      *(u32x4*)dst = w;
    }
  }
}

__device__ void phase_norm(const Params& p, int bid, int nb, int row0, int row1, const float* hctx, const float* hlat,
                           const float* gain, const float* modl, int ish, int isc) {
  const int tid0 = tidx();
  const int wid = tid0 >> 6, lane = tid0 & 63;
  for (int row = row0 + bid * 8 + wid; row < row1; row += nb * 8) {
    const bool isctx = row < NCTX;
    const float* h = isctx ? hctx + (size_t)row * D : hlat + (size_t)(row - NCTX) * D;
    const int b = isctx ? 32 : ((row - NCTX) >> 11);
    const float* sh = modl + (size_t)b * MODW + ish * D;
    const float* sc = modl + (size_t)b * MODW + isc * D;
    f32x4 v[4];
    float ss = 0.f;
#pragma unroll
    for (int i = 0; i < 4; ++i) {
      v[i] = *(const f32x4*)(h + i * 256 + lane * 4);
      ss += v[i][0] * v[i][0] + v[i][1] * v[i][1] + v[i][2] * v[i][2] + v[i][3] * v[i][3];
    }
    ss = wave_sum(ss);
    const float rstd = rsqrtf(ss * (1.f / D) + EPS);
#pragma unroll
    for (int i = 0; i < 4; ++i) {
      const int col = i * 256 + lane * 4;
      const f32x4 g = *(const f32x4*)(gain + col), s1 = *(const f32x4*)(sc + col), s0 = *(const f32x4*)(sh + col);
      f32x4 y = v[i] * rstd * g;
      y = y * (1.f + s1) + s0;
      u32x2 w; w.x = cvt_pk_bf16(y[0], y[1]); w.y = cvt_pk_bf16(y[2], y[3]);
      *(u32x2*)(p.act + (size_t)row * D + col) = w;
    }
  }
}

__device__ __forceinline__ void phase_gemm_inproj(const Params& p, unsigned char* smem, int bid, int nb, int layer) {
  LAS unsigned char* lds = (LAS unsigned char*)smem;
  if (layer == 0) {
    EpiInProj epi{p.proj, 3072, 0, p.ropec, p.ropes};
    Sched s{0, 0, NTOK / BM, 12, nb, bid};
    gemm_phase(lds, p.act, p.winT0, s, epi);
  } else {
    EpiInProj epi{p.proj, 1536, 1, p.ropec, p.ropes};
    Sched s{NCTX / BM, 0, NLAT / BM, 6, nb, bid};
    gemm_phase(lds, p.act, p.winT1, s, epi);
    Sched s2{0, 4, NCTX / BM, 2, nb, bid};
    gemm_phase(lds, p.act, p.winT1, s2, epi);
  }
}
__device__ __forceinline__ void phase_gemm_outproj(const Params& p, unsigned char* smem, int bid, int nb, int layer) {
  LAS unsigned char* lds = (LAS unsigned char*)smem;
  if (layer == 0) {
    EpiResid epi{p.ctx, p.x, p.hctx, p.out, p.mod + 2 * D};
    Sched s{0, 0, NTOK / BM, 4, nb, bid};
    gemm_phase(lds, p.act, p.woutT0, s, epi);
  } else {
    EpiResid epi{p.hctx, p.out, p.hctx, p.out, p.mod + (size_t)33 * MODW + 2 * D};
    Sched s{NCTX / BM, 0, NLAT / BM, 4, nb, bid};
    gemm_phase(lds, p.act, p.woutT1, s, epi);
  }
}
__device__ __forceinline__ void phase_gemm_pq(const Params& p, unsigned char* smem, int bid, int nb, int layer) {
  LAS unsigned char* lds = (LAS unsigned char*)smem;
  EpiBf16 epi{p.pq, D};
  const int pm0 = layer == 0 ? 0 : NCTX / BM;
  Sched s{pm0, 0, NTOK / BM - pm0, 4, nb, bid};
  gemm_phase(lds, p.act, p.wqT + (size_t)layer * D * D, s, epi);
}

__device__ __forceinline__ int chunk_row0(int b, int cc) { return cc < 2 ? b * CTXL + cc * 128 : NCTX + b * SEQ + (cc - 2) * 128; }

constexpr int LDP = 136;
constexpr int LDK = 72;

__device__ void phase_ret_kv(const Params& p, unsigned char* smem, int bid, int nb) {
  const int tid = tidx(), wid = tid >> 6, lane = tid & 63, fr = lane & 15, fq = lane >> 4;
  bf16_t* KxT = (bf16_t*)smem;
  bf16_t* VT = KxT + 128 * LDP;
  for (int it = bid; it < BATCH * 4 * 18; it += nb) {
    const int cc = it % 18, h = (it / 18) & 3, b = it / 72;
    const int row0 = chunk_row0(b, cc);
    const float lf = log_sigmoidf(p.logit_f[h]), lb = log_sigmoidf(p.logit_b[h]);
    __syncthreads();
    for (int task = tid; task < 128 * 8; task += NTHREADS) {
      const int j = task >> 3, d0 = (task & 7) * 8;
      const u32x4 kk = *(const u32x4*)(p.proj + (size_t)(row0 + j) * 3072 + 256 + h * 64 + d0);
      const float zf = __expf(lf * (float)(127 - j)), zb = __expf(lb * (float)j);
#pragma unroll
      for (int q = 0; q < 4; ++q) {
        const float lo = bf_lo(kk[q]), hi = bf_hi(kk[q]);
        KxT[(d0 + 2 * q) * LDP + j] = f2bf(lo * zf);
        KxT[(d0 + 2 * q + 1) * LDP + j] = f2bf(hi * zf);
        KxT[(64 + d0 + 2 * q) * LDP + j] = f2bf(lo * zb);
        KxT[(64 + d0 + 2 * q + 1) * LDP + j] = f2bf(hi * zb);
      }
    }
    for (int task = tid; task < 128 * 16; task += NTHREADS) {
      const int j = task >> 4, e0 = (task & 15) * 8;
      const u32x4 vv = *(const u32x4*)(p.proj + (size_t)(row0 + j) * 3072 + 512 + h * 128 + e0);
#pragma unroll
      for (int q = 0; q < 4; ++q) {
        VT[(e0 + 2 * q) * LDP + j] = (bf16_t)(vv[q] & 0xffffu);
        VT[(e0 + 2 * q + 1) * LDP + j] = (bf16_t)(vv[q] >> 16);
      }
    }
    __syncthreads();
    f32x4 acc[1][8] = {};
    mm_lds<1, 8>(VT + wid * 16 * LDP, LDP, KxT, LDP, 128, acc, fr, fq);
    float* out = p.kv + (size_t)it * 16384;
#pragma unroll
    for (int n = 0; n < 8; ++n)
#pragma unroll
      for (int j = 0; j < 4; ++j) out[(wid * 16 + fq * 4 + j) * 128 + n * 16 + fr] = acc[0][n][j];
  }
  for (size_t task = (size_t)bid * NTHREADS + tid; task < (size_t)NTOK * 64; task += (size_t)nb * NTHREADS) {
    const int row = (int)(task >> 6), c0 = (int)(task & 63) * 8;
    const int tin = row < NCTX ? (row & (CTXL - 1)) : ((row - NCTX) & (SEQ - 1));
    const int tlen = row < NCTX ? CTXL : SEQ;
    const bf16_t* pr = p.proj + (size_t)row * 3072;
    const u32x4 gb = *(const u32x4*)(pr + 1536 + c0);
    float accv[8];
#pragma unroll
    for (int q = 0; q < 8; ++q) accv[q] = 0.f;
#pragma unroll
    for (int dt = -1; dt <= 1; ++dt) {
      if (tin + dt < 0 || tin + dt >= tlen) continue;
      const bf16_t* pr2 = pr + (ptrdiff_t)dt * 3072;
      const u32x4 gc = *(const u32x4*)(pr2 + 2048 + c0), xt = *(const u32x4*)(pr2 + 2560 + c0);
      const float* w = p.conv_w + (dt + 1) * 512 + c0;
      const f32x4 wa = *(const f32x4*)w, wb = *(const f32x4*)(w + 4);
#pragma unroll
      for (int q = 0; q < 4; ++q) {
        const float u0 = bf_lo(gc[q]) * bf_lo(xt[q]), u1 = bf_hi(gc[q]) * bf_hi(xt[q]);
        const float w0 = (2 * q < 4) ? wa[2 * q] : wb[2 * q - 4], w1 = (2 * q + 1 < 4) ? wa[2 * q + 1] : wb[2 * q + 1 - 4];
        accv[2 * q] += w0 * u0;
        accv[2 * q + 1] += w1 * u1;
      }
    }
    u32x4 o;
#pragma unroll
    for (int q = 0; q < 4; ++q) o[q] = cvt_pk_bf16(bf_lo(gb[q]) * accv[2 * q], bf_hi(gb[q]) * accv[2 * q + 1]);
#ifdef ZERO_CONV
    o = (u32x4){0u, 0u, 0u, 0u};
#endif
    *(u32x4*)(p.act + (size_t)row * D + 512 + c0) = o;
  }
}

__device__ void phase_ret_scan(const Params& p, int bid, int nb) {
  const int tid = tidx();
  for (size_t idx = (size_t)bid * NTHREADS + tid; idx < (size_t)BATCH * 4 * 16384; idx += (size_t)nb * NTHREADS) {
    const int el = (int)(idx & 16383), bh = (int)(idx >> 14), h = bh & 3;
    const bool fwd = (el & 127) < 64;
    const float lg = log_sigmoidf(fwd ? p.logit_f[h] : p.logit_b[h]);
    const float dec = __expf(lg * 128.f);
    float st = 0.f;
    for (int s = 0; s < 18; ++s) {
      const int cc = fwd ? s : (s < 2 ? 1 - s : 19 - s);
      const size_t off = ((size_t)bh * 18 + cc) * 16384 + el;
      p.sprev[off] = f2bf(st);
      st = dec * st + p.kv[off];
    }
  }
}

__device__ void phase_ret_out(const Params& p, unsigned char* smem, int bid, int nb) {
  const int tid = tidx(), wid = tid >> 6, lane = tid & 63, fr = lane & 15, fq = lane >> 4;
  bf16_t* Kt = (bf16_t*)smem;
  bf16_t* VT = Kt + 128 * LDK;
  bf16_t* ST = VT + 128 * LDP;
  bf16_t* Pb = ST + 128 * LDP;
  for (int it = bid; it < BATCH * 4 * 18; it += nb) {
    const int cc = it % 18, h = (it / 18) & 3, b = it / 72;
    const int row0 = chunk_row0(b, cc);
    const float lf = log_sigmoidf(p.logit_f[h]), lb = log_sigmoidf(p.logit_b[h]);
    __syncthreads();
    for (int task = tid; task < 128 * 8; task += NTHREADS) {
      const int j = task >> 3, d0 = (task & 7) * 8;
      *(u32x4*)(Kt + j * LDK + d0) = *(const u32x4*)(p.proj + (size_t)(row0 + j) * 3072 + 256 + h * 64 + d0);
    }
    for (int task = tid; task < 128 * 16; task += NTHREADS) {
      const int j = task >> 4, e0 = (task & 15) * 8;
      const u32x4 vv = *(const u32x4*)(p.proj + (size_t)(row0 + j) * 3072 + 512 + h * 128 + e0);
#pragma unroll
      for (int q = 0; q < 4; ++q) {
        VT[(e0 + 2 * q) * LDP + j] = (bf16_t)(vv[q] & 0xffffu);
        VT[(e0 + 2 * q + 1) * LDP + j] = (bf16_t)(vv[q] >> 16);
      }
      const int e = j;
      *(u32x4*)(ST + e * LDP + e0) = *(const u32x4*)(p.sprev + (size_t)it * 16384 + e * 128 + e0);
    }
    const int irow = wid * 16 + fr;
    bf16x8 qf[2];
#pragma unroll
    for (int ks = 0; ks < 2; ++ks) qf[ks] = *(const bf16x8*)(p.proj + (size_t)(row0 + irow) * 3072 + h * 64 + ks * 32 + fq * 8);
    __syncthreads();
    f32x4 sacc[8] = {};
#pragma unroll
    for (int ks = 0; ks < 2; ++ks)
#pragma unroll
      for (int n = 0; n < 8; ++n) {
        const bf16x8 kf = *(const bf16x8*)(Kt + (n * 16 + fr) * LDK + ks * 32 + fq * 8);
        sacc[n] = __builtin_amdgcn_mfma_f32_16x16x32_bf16(qf[ks], kf, sacc[n], 0, 0, 0);
      }
#pragma unroll
    for (int n = 0; n < 8; ++n)
#pragma unroll
      for (int jj = 0; jj < 4; ++jj) {
        const int i = wid * 16 + fq * 4 + jj, j = n * 16 + fr;
        const int df = i - j;
        const float dm = df > 0 ? __expf(lf * (float)df) : (df < 0 ? __expf(lb * (float)(-df)) : 2.f);
        Pb[i * LDP + j] = f2bf(sacc[n][jj] * dm);
      }
    __syncthreads();
    f32x4 oacc[1][8] = {};
    mm_lds<1, 8>(Pb + wid * 16 * LDP, LDP, VT, LDP, 128, oacc, fr, fq);
    {
      const float xf = __expf(lf * (float)(irow + 1)), xb = __expf(lb * (float)(128 - irow));
#pragma unroll
      for (int ks = 0; ks < 4; ++ks) {
        const float sc = ks < 2 ? xf : xb;
        const bf16x8 qs = qf[ks & 1];
        u32x4 qu = __builtin_bit_cast(u32x4, qs), qo;
#pragma unroll
        for (int q = 0; q < 4; ++q) qo[q] = cvt_pk_bf16(bf_lo(qu[q]) * sc, bf_hi(qu[q]) * sc);
        const bf16x8 qx = __builtin_bit_cast(bf16x8, qo);
#pragma unroll
        for (int n = 0; n < 8; ++n) {
          const bf16x8 sf = *(const bf16x8*)(ST + (n * 16 + fr) * LDP + ks * 32 + fq * 8);
          oacc[0][n] = __builtin_amdgcn_mfma_f32_16x16x32_bf16(qx, sf, oacc[0][n], 0, 0, 0);
        }
      }
    }
#pragma unroll
    for (int jj = 0; jj < 4; ++jj) {
      float ss = 0.f;
#pragma unroll
      for (int n = 0; n < 8; ++n) ss += oacc[0][n][jj] * oacc[0][n][jj];
      ss = row16_sum(ss);
      const float rstd = rsqrtf(ss * (1.f / 128.f) + EPS);
      const int row = row0 + wid * 16 + fq * 4 + jj;
#pragma unroll
      for (int n = 0; n < 8; ++n) {
        const int e = n * 16 + fr;
        const float g = bf2f(p.proj[(size_t)row * 3072 + 1024 + h * 128 + e]);
#ifdef ZERO_RET
        p.act[(size_t)row * D + h * 128 + e] = 0;
#else
        p.act[(size_t)row * D + h * 128 + e] = f2bf(oacc[0][n][jj] * rstd * siluf(g));
#endif
      }
    }
  }
}

__device__ void phase_attn(const Params& p, unsigned char* smem, int bid, int nb) {
  const int tid = tidx(), wid = tid >> 6, lane = tid & 63, fr = lane & 15, fq = lane >> 4;
  bf16_t* Kt = (bf16_t*)smem;
  bf16_t* VT = Kt + 64 * LDK;
  bf16_t* Pw = VT + 64 * LDK + wid * 64 * LDK;
  for (int it = bid; it < BATCH * 16 * 4; it += nb) {
    const int kvh = it & 3, qb = (it >> 2) & 15, b = it >> 6;
    const int hq = kvh * 4 + (wid >> 1);
    const int q0 = qb * 128 + (wid & 1) * 64;
    const size_t latrow0 = (size_t)NCTX + (size_t)b * SEQ;
    bf16x8 qf[4][2];
#pragma unroll
    for (int m = 0; m < 4; ++m)
#pragma unroll
      for (int ks = 0; ks < 2; ++ks)
        qf[m][ks] = *(const bf16x8*)(p.proj + (latrow0 + q0 + m * 16 + fr) * 1536 + hq * 64 + ks * 32 + fq * 8);
    const float sink = p.sinks[hq];
    float mrow[4][4], lrow[4][4];
    f32x4 oacc[4][4] = {};
#pragma unroll
    for (int m = 0; m < 4; ++m)
#pragma unroll
      for (int jj = 0; jj < 4; ++jj) { mrow[m][jj] = sink; lrow[m][jj] = (fr == 0) ? 1.f : 0.f; }
    for (int tt = 0; tt < 10; ++tt) {
      const bool win = tt < 6;
      const int kpos0 = win ? qb * 128 - 128 + 64 * tt : (tt - 6) * 64;
      if (win && (kpos0 < 0 || kpos0 >= SEQ)) continue;
      const size_t krow0 = win ? latrow0 + kpos0 : (size_t)b * CTXL + kpos0;
      __syncthreads();
      {
        const int j = tid >> 3, d0 = (tid & 7) * 8;
        *(u32x4*)(Kt + j * LDK + d0) = *(const u32x4*)(p.proj + (krow0 + j) * 1536 + 1024 + kvh * 64 + d0);
        const u32x4 vv = *(const u32x4*)(p.proj + (krow0 + j) * 1536 + 1280 + kvh * 64 + d0);
#pragma unroll
        for (int q = 0; q < 4; ++q) {
          VT[(d0 + 2 * q) * LDK + j] = (bf16_t)(vv[q] & 0xffffu);
          VT[(d0 + 2 * q + 1) * LDK + j] = (bf16_t)(vv[q] >> 16);
        }
      }
      __syncthreads();
#pragma unroll
      for (int m = 0; m < 4; ++m) {
        f32x4 sacc[4];
#pragma unroll
        for (int n = 0; n < 4; ++n) sacc[n] = (f32x4){0.f, 0.f, 0.f, 0.f};
#pragma unroll
        for (int ks = 0; ks < 2; ++ks)
#pragma unroll
          for (int n = 0; n < 4; ++n) {
            const bf16x8 kf = *(const bf16x8*)(Kt + (n * 16 + fr) * LDK + ks * 32 + fq * 8);
            sacc[n] = __builtin_amdgcn_mfma_f32_16x16x32_bf16(qf[m][ks], kf, sacc[n], 0, 0, 0);
          }
#pragma unroll
        for (int jj = 0; jj < 4; ++jj) {
          const int qpos = q0 + m * 16 + fq * 4 + jj;
          float mx = -3.0e38f;
#pragma unroll
          for (int n = 0; n < 4; ++n) {
            float s = sacc[n][jj];
            if (win) { const int dd = qpos - (kpos0 + n * 16 + fr); if (dd > 128 || dd < -128) s = -1e30f; }
            sacc[n][jj] = s;
            mx = fmaxf(mx, s);
          }
          mx = row16_max(mx);
          const float mnew = fmaxf(mrow[m][jj], mx);
          const float alpha = __expf(mrow[m][jj] - mnew);
          mrow[m][jj] = mnew;
          float ls = 0.f;
#pragma unroll
          for (int n = 0; n < 4; ++n) {
            const float pv = __expf(sacc[n][jj] - mnew);
            ls += pv;
            Pw[(m * 16 + fq * 4 + jj) * LDK + n * 16 + fr] = f2bf(pv);
          }
          lrow[m][jj] = lrow[m][jj] * alpha + ls;
#pragma unroll
          for (int n = 0; n < 4; ++n) oacc[m][n][jj] *= alpha;
        }
      }
      __syncthreads();
      mm_lds<4, 4>(Pw, LDK, VT, LDK, 64, oacc, fr, fq);
    }
#pragma unroll
    for (int m = 0; m < 4; ++m)
#pragma unroll
      for (int jj = 0; jj < 4; ++jj) {
        const float l = row16_sum(lrow[m][jj]);
        const float inv = 1.f / l;
        const size_t row = latrow0 + q0 + m * 16 + fq * 4 + jj;
#pragma unroll
        for (int n = 0; n < 4; ++n) {
#ifdef ZERO_ATTN
          p.act[row * D + hq * 64 + n * 16 + fr] = 0;
#else
          p.act[row * D + hq * 64 + n * 16 + fr] = f2bf(oacc[m][n][jj] * inv);
#endif
        }
      }
  }
}

__device__ __forceinline__ unsigned f2ord(float f) { const unsigned u = __float_as_uint(f); return (u & 0x80000000u) ? ~u : (u | 0x80000000u); }
__device__ __forceinline__ float ord2f(unsigned k) { const unsigned u = (k & 0x80000000u) ? (k & 0x7fffffffu) : ~k; return __uint_as_float(u); }

__device__ void phase_peer_topk(const Params& p, unsigned char* smem, int bid, int nb, int layer, int tok0, int ntok) {
  const int tid = tidx(), wid = tid >> 6, lane = tid & 63;
  float* keys = (float*)smem;
  unsigned* lists = (unsigned*)(smem + 65536);
  const int nitem = (ntok / 256) * 8;
  for (int it = bid; it < nitem; it += nb) {
    const int h = it & 7, tile = it >> 3;
    const int set = wid >> 2, tl = (wid & 3) * 64 + lane;
    const int token = tok0 + tile * 256 + tl;
    __syncthreads();
    {
      const float* k1 = p.keys1 + ((size_t)layer * 8 + h) * 8192;
      const float* k2 = p.keys2 + ((size_t)layer * 8 + h) * 8192;
      for (int i = tid; i < 2048; i += NTHREADS) {
        *(f32x4*)(keys + i * 4) = *(const f32x4*)(k1 + i * 4);
        *(f32x4*)(keys + 8192 + i * 4) = *(const f32x4*)(k2 + i * 4);
      }
    }
    float q[64];
    {
      const bf16_t* qp = p.pq + (size_t)token * D + h * 128 + set * 64;
#pragma unroll
      for (int c8 = 0; c8 < 8; ++c8) {
        const u32x4 w = *(const u32x4*)(qp + c8 * 8);
#pragma unroll
        for (int qq = 0; qq < 4; ++qq) { q[c8 * 8 + 2 * qq] = bf_lo(w[qq]); q[c8 * 8 + 2 * qq + 1] = bf_hi(w[qq]); }
      }
    }
    __syncthreads();
    unsigned top[16];
#pragma unroll
    for (int i = 0; i < 16; ++i) top[i] = 0u;
    const float* kb = keys + set * 8192;
    for (int k = 0; k < 128; ++k) {
      float s0 = 0.f, s1 = 0.f;
#pragma unroll
      for (int d4 = 0; d4 < 16; ++d4) {
        const f32x4 kv = *(const f32x4*)(kb + k * 64 + d4 * 4);
        s0 += q[d4 * 4] * kv[0]; s1 += q[d4 * 4 + 1] * kv[1];
        s0 += q[d4 * 4 + 2] * kv[2]; s1 += q[d4 * 4 + 3] * kv[3];
      }
      unsigned v = (f2ord(s0 + s1) & 0xffffff80u) | (unsigned)(127 - k);
#pragma unroll
      for (int i = 0; i < 16; ++i) { const unsigned hi = max(top[i], v); v = min(top[i], v); top[i] = hi; }
    }
    unsigned* mylist = lists + ((size_t)set * 256 + tl) * 16;
#pragma unroll
    for (int i = 0; i < 4; ++i) { u32x4 w; w.x = top[4 * i]; w.y = top[4 * i + 1]; w.z = top[4 * i + 2]; w.w = top[4 * i + 3]; *(u32x4*)(mylist + 4 * i) = w; }
    __syncthreads();
    if (set == 0) {
      unsigned o2[16];
      const unsigned* other = lists + ((size_t)256 + tl) * 16;
#pragma unroll
      for (int i = 0; i < 4; ++i) { const u32x4 w = *(const u32x4*)(other + 4 * i); o2[4 * i] = w.x; o2[4 * i + 1] = w.y; o2[4 * i + 2] = w.z; o2[4 * i + 3] = w.w; }
      float v1[16], v2[16];
#pragma unroll
      for (int i = 0; i < 16; ++i) { v1[i] = ord2f(top[i] & 0xffffff80u); v2[i] = ord2f(o2[i] & 0xffffff80u); }
      unsigned ct[16];
#pragma unroll
      for (int i = 0; i < 16; ++i) ct[i] = 0u;
#pragma unroll
      for (int i = 0; i < 16; ++i)
#pragma unroll
        for (int j = 0; j < 16; ++j) {
          if ((i + 1) * (j + 1) <= 16) {
            unsigned v = (f2ord(v1[i] + v2[j]) & 0xffffff00u) | (unsigned)(255 - (i * 16 + j));
#pragma unroll
            for (int r = 0; r < 16; ++r) { const unsigned hi = max(ct[r], v); v = min(ct[r], v); ct[r] = hi; }
          }
        }
      float cs[16], den = 0.f;
      const float mx = ord2f(ct[0] & 0xffffff00u);
#pragma unroll
      for (int r = 0; r < 16; ++r) { cs[r] = __expf(ord2f(ct[r] & 0xffffff00u) - mx); den += cs[r]; }
      const float inv = 1.f / den;
      u32x2* so = p.sel + (size_t)token * 128 + h * 16;
      const unsigned* l1 = lists + (size_t)tl * 16;
#pragma unroll
      for (int r = 0; r < 16; ++r) {
        const unsigned ci = 255u - (ct[r] & 0xffu);
        const unsigned e1 = 127u - (l1[ci >> 4] & 0x7fu), e2 = 127u - (other[ci & 15u] & 0x7fu);
        u32x2 w; w.x = e1 * 128u + e2; w.y = __float_as_uint(cs[r] * inv);
        so[r] = w;
      }
    }
  }
}

typedef __bf16 bf16x2t __attribute__((ext_vector_type(2)));
__device__ __forceinline__ float dot2bf(unsigned a, unsigned b, float c) {
  return __builtin_amdgcn_fdot2_f32_bf16(__builtin_bit_cast(bf16x2t, a), __builtin_bit_cast(bf16x2t, b), c, false);
}
__device__ __forceinline__ void peer_experts(const u32x2 se, const bf16_t* __restrict__ U, const bf16_t* __restrict__ V,
                                             const u32x4 x0, const u32x4 x1, float (&y)[16], int lane) {
  for (int j0 = 0; j0 < 64; j0 += 4) {
    u32x4 ua[4], ub[4], va[4], vb[4];
    float gate[4];
#pragma unroll
    for (int u = 0; u < 4; ++u) {
      const unsigned e = (unsigned)__builtin_amdgcn_readlane((int)se.x, j0 + u);
      gate[u] = __uint_as_float((unsigned)__builtin_amdgcn_readlane((int)se.y, j0 + u));
      const bf16_t* ur = U + (size_t)e * D;
      const bf16_t* vr = V + (size_t)e * D;
      ua[u] = *(const u32x4*)(ur + lane * 8); ub[u] = *(const u32x4*)(ur + 512 + lane * 8);
      va[u] = *(const u32x4*)(vr + lane * 8); vb[u] = *(const u32x4*)(vr + 512 + lane * 8);
    }
#pragma unroll
    for (int u = 0; u < 4; ++u) {
      float d = 0.f;
#pragma unroll
      for (int q = 0; q < 4; ++q) {
        const unsigned a0 = ua[u][q], b0 = x0[q], a1 = ub[u][q], b1 = x1[q];
        d = dot2bf(a0, b0, d);
        d = dot2bf(a1, b1, d);
      }
      d = wave_sum(d);
      const float a = gate[u] * 0.5f * d * (1.f + erff(d * 0.70710678118f));
#pragma unroll
      for (int q = 0; q < 4; ++q) {
        const unsigned w0 = va[u][q], w1 = vb[u][q];
        y[2 * q] += a * bf_lo(w0); y[2 * q + 1] += a * bf_hi(w0);
        y[8 + 2 * q] += a * bf_lo(w1); y[8 + 2 * q + 1] += a * bf_hi(w1);
      }
    }
  }
}

__device__ void phase_peer_gather(const Params& p, int bid, int nb, int layer, int tok0, int ntok) {
  const int tid0 = tidx();
  const int wid = tid0 >> 6, lane = tid0 & 63;
  const bf16_t* U = p.ubf + (size_t)layer * NEXP * D;
  const bf16_t* V = p.vbf + (size_t)layer * NEXP * D;
  const float* modl = p.mod + (size_t)layer * 33 * MODW;
  for (int t = bid * 8 + wid; t < ntok; t += nb * 8) {
    const int token = tok0 + t;
    const bf16_t* xr = p.act + (size_t)token * D;
    const u32x4 x0 = *(const u32x4*)(xr + lane * 8), x1 = *(const u32x4*)(xr + 512 + lane * 8);
    const u32x2 se0 = p.sel[(size_t)token * 128 + lane], se1 = p.sel[(size_t)token * 128 + 64 + lane];
    float y[16];
#pragma unroll
    for (int i = 0; i < 16; ++i) y[i] = 0.f;
    peer_experts(se0, U, V, x0, x1, y, lane);
    peer_experts(se1, U, V, x0, x1, y, lane);
#ifdef ZERO_PEER
    if (layer == ZERO_PEER) {
#pragma unroll
      for (int i = 0; i < 16; ++i) y[i] = 0.f;
    }
#endif
    const bool isctx = token < NCTX;
    const int b = isctx ? 32 : ((token - NCTX) >> 11);
    const float* g2 = modl + (size_t)b * MODW + 5 * D;
    float* hrow = isctx ? p.hctx + (size_t)token * D : p.out + (size_t)(token - NCTX) * D;
    float hn[16];
    float ss = 0.f;
#pragma unroll
    for (int half = 0; half < 2; ++half)
#pragma unroll
      for (int q4 = 0; q4 < 2; ++q4) {
        const int col = half * 512 + lane * 8 + q4 * 4;
        const f32x4 hv = *(const f32x4*)(hrow + col), gv = *(const f32x4*)(g2 + col);
#pragma unroll
        for (int e = 0; e < 4; ++e) { const float v = hv[e] + gv[e] * y[half * 8 + q4 * 4 + e]; hn[half * 8 + q4 * 4 + e] = v; ss += v * v; }
      }
    ss = wave_sum(ss);
    const float rstd = rsqrtf(ss * (1.f / D) + EPS);
    if (layer == 0) {
      const float* modn = p.mod + (size_t)33 * MODW + (size_t)b * MODW;
      const float* gain = p.mix_g + D;
#pragma unroll
      for (int half = 0; half < 2; ++half) {
        u32x4 w;
#pragma unroll
        for (int q4 = 0; q4 < 2; ++q4) {
          const int col = half * 512 + lane * 8 + q4 * 4;
          f32x4 hv; hv[0] = hn[half * 8 + q4 * 4]; hv[1] = hn[half * 8 + q4 * 4 + 1]; hv[2] = hn[half * 8 + q4 * 4 + 2]; hv[3] = hn[half * 8 + q4 * 4 + 3];
          *(f32x4*)(hrow + col) = hv;
          const f32x4 g = *(const f32x4*)(gain + col), s0 = *(const f32x4*)(modn + col), s1 = *(const f32x4*)(modn + D + col);
          f32x4 yv = hv * rstd * g;
          yv = yv * (1.f + s1) + s0;
          w[q4 * 2] = cvt_pk_bf16(yv[0], yv[1]); w[q4 * 2 + 1] = cvt_pk_bf16(yv[2], yv[3]);
        }
        *(u32x4*)(p.act + (size_t)token * D + half * 512 + lane * 8) = w;
      }
    } else {
      const float* gain = p.final_g;
#pragma unroll
      for (int half = 0; half < 2; ++half)
#pragma unroll
        for (int q4 = 0; q4 < 2; ++q4) {
          const int col = half * 512 + lane * 8 + q4 * 4;
          const f32x4 g = *(const f32x4*)(gain + col);
          f32x4 o;
#pragma unroll
          for (int e = 0; e < 4; ++e) o[e] = hn[half * 8 + q4 * 4 + e] * rstd * g[e];
          *(f32x4*)(hrow + col) = o;
        }
    }
  }
}

constexpr int NPH = 18;
template <int PH>
__device__ __forceinline__ void run_phase(const Params& p, unsigned char* smem, int bid, int nb) {
  if constexpr (PH == 0) phase_prep(p, smem, bid, nb);
  else if constexpr (PH == 1) phase_norm(p, bid, nb, 0, NTOK, p.ctx, p.x, p.mix_g, p.mod, 0, 1);
  else if constexpr (PH == 2) phase_gemm_inproj(p, smem, bid, nb, 0);
  else if constexpr (PH == 3) phase_ret_kv(p, smem, bid, nb);
  else if constexpr (PH == 4) phase_ret_scan(p, bid, nb);
  else if constexpr (PH == 5) phase_ret_out(p, smem, bid, nb);
  else if constexpr (PH == 6) phase_gemm_outproj(p, smem, bid, nb, 0);
  else if constexpr (PH == 7) phase_norm(p, bid, nb, 0, NTOK, p.hctx, p.out, p.ffn_g, p.mod, 3, 4);
  else if constexpr (PH == 8) phase_gemm_pq(p, smem, bid, nb, 0);
  else if constexpr (PH == 9) phase_peer_topk(p, smem, bid, nb, 0, 0, NTOK);
  else if constexpr (PH == 10) phase_peer_gather(p, bid, nb, 0, 0, NTOK);
  else if constexpr (PH == 11) phase_gemm_inproj(p, smem, bid, nb, 1);
  else if constexpr (PH == 12) phase_attn(p, smem, bid, nb);
  else if constexpr (PH == 13) phase_gemm_outproj(p, smem, bid, nb, 1);
  else if constexpr (PH == 14) phase_norm(p, bid, nb, NCTX, NTOK, p.hctx, p.out, p.ffn_g + D, p.mod + (size_t)33 * MODW, 3, 4);
  else if constexpr (PH == 15) phase_gemm_pq(p, smem, bid, nb, 1);
  else if constexpr (PH == 16) phase_peer_topk(p, smem, bid, nb, 1, NCTX, NLAT);
  else if constexpr (PH == 17) phase_peer_gather(p, bid, nb, 1, NCTX, NLAT);
}
template <int PH>
__global__ void __launch_bounds__(NTHREADS) phase_k(Params p) {
  extern __shared__ __attribute__((aligned(16))) unsigned char smem[];
  run_phase<PH>(p, smem, blockIdx.x, gridDim.x);
}
#if MK_ONE_LAUNCH
constexpr int PARAMS_OFF = LDS_BYTES - 512;
static_assert(sizeof(Params) <= 512, "params block");
template <class T>
__device__ __forceinline__ T* uni(T* q) {
  const unsigned long long v = (unsigned long long)q;
  const unsigned lo = __builtin_amdgcn_readfirstlane((unsigned)v), hi = __builtin_amdgcn_readfirstlane((unsigned)(v >> 32));
  return (T*)(((unsigned long long)hi << 32) | lo);
}
__device__ __forceinline__ Params load_params(const unsigned char* smem) {
  const Params* l = (const Params*)(smem + PARAMS_OFF);
  Params q;
  q.x = uni(l->x); q.c = uni(l->c); q.ctx = uni(l->ctx); q.c_ctx = uni(l->c_ctx); q.ada_w = uni(l->ada_w); q.ada_b = uni(l->ada_b);
  q.mix_g = uni(l->mix_g); q.ffn_g = uni(l->ffn_g); q.ev_w_in = uni(l->ev_w_in); q.ev_w_out = uni(l->ev_w_out);
  q.logit_f = uni(l->logit_f); q.logit_b = uni(l->logit_b); q.conv_w = uni(l->conv_w); q.od_w_in = uni(l->od_w_in);
  q.od_w_out = uni(l->od_w_out); q.sinks = uni(l->sinks); q.peer_wq = uni(l->peer_wq); q.keys1 = uni(l->keys1); q.keys2 = uni(l->keys2);
  q.peer_u = uni(l->peer_u); q.peer_v = uni(l->peer_v); q.final_g = uni(l->final_g); q.out = uni(l->out); q.mod = uni(l->mod);
  q.ropec = uni(l->ropec); q.ropes = uni(l->ropes); q.winT0 = uni(l->winT0); q.woutT0 = uni(l->woutT0); q.winT1 = uni(l->winT1);
  q.woutT1 = uni(l->woutT1); q.wqT = uni(l->wqT); q.ubf = uni(l->ubf); q.vbf = uni(l->vbf); q.hctx = uni(l->hctx); q.act = uni(l->act);
  q.proj = uni(l->proj); q.pq = uni(l->pq); q.sel = uni(l->sel); q.kv = uni(l->kv); q.sprev = uni(l->sprev);
  return q;
}
template <int PH>
__device__ __forceinline__ void run_from(unsigned char* smem, int bid, int nb) {
  {
    const Params q = load_params(smem);
    run_phase<PH>(q, smem, bid, nb);
  }
  if constexpr (PH + 1 < NPH) {
    cg::this_grid().sync();
    run_from<PH + 1>(smem, bid, nb);
  }
}
__global__ void __launch_bounds__(NTHREADS) mega(Params p) {
  extern __shared__ __attribute__((aligned(16))) unsigned char smem[];
  if (threadIdx.x == 0) *(Params*)(smem + PARAMS_OFF) = p;
  __syncthreads();
  run_from<0>(smem, blockIdx.x, gridDim.x);
}
#endif
#ifndef DBG_NPH
#define DBG_NPH 0
#endif
#if DBG_NPH
__global__ void __launch_bounds__(NTHREADS) dbg_sums(Params p, float* scr, int nph) {
  const int wid = threadIdx.x >> 6, lane = threadIdx.x & 63;
  const int gw = blockIdx.x * 8 + wid, nw = gridDim.x * 8;
  if (nph >= 2) for (int r = gw; r < NTOK; r += nw) { float s = 0.f; for (int c = lane; c < D; c += 64) s += bf2f(p.act[(size_t)r * D + c]) * (1 + (c & 7)); s = wave_sum(s); if (lane == 0) scr[r] = s; }
  if (nph >= 3 && nph <= 8) for (int r = gw; r < NTOK; r += nw) { float s = 0.f; for (int c = lane; c < 3072; c += 64) s += bf2f(p.proj[(size_t)r * 3072 + c]) * (1 + (c & 7)); s = wave_sum(s); if (lane == 0) scr[(1 << 20) + r] = s; }
  if (nph >= 12 && nph <= 15) for (int r = gw; r < NTOK; r += nw) { float s = 0.f; for (int c = lane + (r < NCTX ? 1024 : 0); c < 1536; c += 64) s += bf2f(p.proj[(size_t)r * 1536 + c]) * (1 + (c & 7)); s = wave_sum(s); if (lane == 0) scr[(1 << 20) + r] = s; }
  if (nph >= 4) for (int r = gw; r < 2304 * 128; r += nw) { float s = 0.f; for (int c = lane; c < 128; c += 64) s += p.kv[(size_t)r * 128 + c] * (1 + (c & 7)); s = wave_sum(s); if (lane == 0) scr[(2 << 20) + r] = s; }
  if (nph >= 5) for (int r = gw; r < 2304 * 128; r += nw) { float s = 0.f; for (int c = lane; c < 128; c += 64) s += bf2f(p.sprev[(size_t)r * 128 + c]) * (1 + (c & 7)); s = wave_sum(s); if (lane == 0) scr[(3 << 20) + r] = s; }
  if (nph >= 7) for (int r = gw; r < NCTX; r += nw) { float s = 0.f; for (int c = lane; c < D; c += 64) s += p.hctx[(size_t)r * D + c] * (1 + (c & 7)); s = wave_sum(s); if (lane == 0) scr[(4 << 20) + r] = s; }
  if (nph >= 1) for (int i = blockIdx.x * NTHREADS + threadIdx.x; i < 2 * 33 * MODW; i += gridDim.x * NTHREADS) scr[(5 << 20) + i] = p.mod[i];
  if (nph >= 7) for (int r = gw; r < NLAT; r += nw) { float s = 0.f; for (int c = lane; c < D; c += 64) s += p.out[(size_t)r * D + c] * (1 + (c & 7)); s = wave_sum(s); if (lane == 0) scr[(6 << 20) + r] = s; }
  if (nph >= 10 && nph <= 11) for (int r = gw; r < NTOK; r += nw) { float s = 0.f; for (int c = lane; c < 128; c += 64) { const u32x2 e = p.sel[(size_t)r * 128 + c]; s += __uint_as_float(e.y) * (float)(e.x & 1023); } s = wave_sum(s); if (lane == 0) scr[(7 << 20) + r] = s; }
}
__global__ void __launch_bounds__(NTHREADS) dbg_out(Params p, const float* scr) {
  for (size_t i = (size_t)blockIdx.x * NTHREADS + threadIdx.x; i < (size_t)NLAT * D; i += (size_t)gridDim.x * NTHREADS) p.out[i] = (i < (size_t)(8 << 20)) ? scr[i] : 0.f;
}
__global__ void __launch_bounds__(NTHREADS) dbg_zero(float* scr) {
  for (size_t i = (size_t)blockIdx.x * NTHREADS + threadIdx.x; i < (size_t)(8 << 20); i += (size_t)gridDim.x * NTHREADS) scr[i] = 0.f;
}
#endif
template <int PH>
static void launch_phases(const Params& p, int grid, hipStream_t stream) {
  static bool attr_set = false;
  if (!attr_set) { (void)hipFuncSetAttribute((const void*)phase_k<PH>, hipFuncAttributeMaxDynamicSharedMemorySize, LDS_BYTES); attr_set = true; }
  phase_k<PH><<<grid, NTHREADS, LDS_BYTES, stream>>>(p);
  if constexpr (PH + 1 < (DBG_NPH ? DBG_NPH : NPH)) launch_phases<PH + 1>(p, grid, stream);
}

extern "C" void kernel_launch(void* const* d_in, const int* in_sizes, int n_in, void* d_out, int out_size, void* d_ws,
                              size_t ws_size, hipStream_t stream) {
  Params p{};
  const float* const* in = (const float* const*)d_in;
  p.x = in[0]; p.c = in[1]; p.ctx = in[2]; p.c_ctx = in[3]; p.ada_w = in[4]; p.ada_b = in[5]; p.mix_g = in[6]; p.ffn_g = in[7];
  p.ev_w_in = in[8]; p.ev_w_out = in[9]; p.logit_f = in[10]; p.logit_b = in[11]; p.conv_w = in[12]; p.od_w_in = in[13];
  p.od_w_out = in[14]; p.sinks = in[15]; p.peer_wq = in[16]; p.keys1 = in[17]; p.keys2 = in[18]; p.peer_u = in[19];
  p.peer_v = in[20]; p.final_g = in[21];
  p.out = (float*)d_out;
  unsigned char* w = (unsigned char*)d_ws;
  size_t off = 0;
  auto take = [&](size_t bytes) { unsigned char* r = w + off; off += (bytes + 255) & ~(size_t)255; return r; };
  p.mod = (float*)take((size_t)2 * 33 * MODW * 4);
  p.ropec = (float*)take(1024 * 4);
  p.ropes = (float*)take(1024 * 4);
  p.winT0 = (bf16_t*)take((size_t)3072 * 1024 * 2);
  p.woutT0 = (bf16_t*)take((size_t)1024 * 1024 * 2);
  p.winT1 = (bf16_t*)take((size_t)1536 * 1024 * 2);
  p.woutT1 = (bf16_t*)take((size_t)1024 * 1024 * 2);
  p.wqT = (bf16_t*)take((size_t)2 * 1024 * 1024 * 2);
  p.ubf = (bf16_t*)take((size_t)2 * NEXP * D * 2);
  p.vbf = (bf16_t*)take((size_t)2 * NEXP * D * 2);
  p.hctx = (float*)take((size_t)NCTX * D * 4);
  p.act = (bf16_t*)take((size_t)NTOK * D * 2);
  p.kv = (float*)take((size_t)2304 * 16384 * 4);
  p.sprev = (bf16_t*)take((size_t)2304 * 16384 * 2);
  p.proj = (bf16_t*)take((size_t)NTOK * 3072 * 2);
  p.pq = p.proj;
  p.sel = (u32x2*)((unsigned char*)p.proj + (size_t)NTOK * D * 2);
  if (off > ws_size) { fprintf(stderr, "workspace too small: need %zu have %zu\n", off, ws_size); }

  int grid = 256;
#if MK_ONE_LAUNCH
  static int grid_blocks = 0;
  if (!grid_blocks) {
    (void)hipFuncSetAttribute((const void*)mega, hipFuncAttributeMaxDynamicSharedMemorySize, LDS_BYTES);
    int dev = 0, cus = 0, per_cu = 0;
    (void)hipGetDevice(&dev);
    (void)hipDeviceGetAttribute(&cus, hipDeviceAttributeMultiprocessorCount, dev);
    (void)hipOccupancyMaxActiveBlocksPerMultiprocessor(&per_cu, mega, NTHREADS, LDS_BYTES);
    if (per_cu > 1) per_cu = 1;
    grid_blocks = cus * per_cu;
    if (grid_blocks <= 0) grid_blocks = 256;
  }
  grid = grid_blocks;
  void* args[] = {&p};
  hipError_t e = hipLaunchCooperativeKernel((const void*)mega, dim3(grid), dim3(NTHREADS), args, LDS_BYTES, stream);
  if (e != hipSuccess) fprintf(stderr, "cooperative launch failed: %s\n", hipGetErrorString(e));
#else
  launch_phases<0>(p, grid, stream);
#if DBG_NPH
  float* scr = (float*)(w + off);
  dbg_zero<<<grid, NTHREADS, 0, stream>>>(scr);
  dbg_sums<<<grid, NTHREADS, 0, stream>>>(p, scr, DBG_NPH);
  dbg_out<<<grid, NTHREADS, 0, stream>>>(p, scr);
#endif
#endif
}
```

```cpp
#include <hip/hip_runtime.h>
#include <hip/hip_cooperative_groups.h>
#include <cstdio>
#include <cstdint>
namespace cg = cooperative_groups;

#ifndef MK_ONE_LAUNCH
#define MK_ONE_LAUNCH 1
#endif

typedef unsigned short bf16_t;
typedef short bf16x8 __attribute__((ext_vector_type(8)));
typedef short bf16x2v __attribute__((ext_vector_type(2)));
typedef float f32x4 __attribute__((ext_vector_type(4)));
typedef unsigned u32x4 __attribute__((ext_vector_type(4)));
typedef unsigned u32x2 __attribute__((ext_vector_type(2)));

constexpr int D = 1024, BATCH = 32, SEQ = 2048, CTXL = 256;
constexpr int NCTX = BATCH * CTXL;
constexpr int NLAT = BATCH * SEQ;
constexpr int NTOK = NCTX + NLAT;
constexpr int MODW = 6 * D;
constexpr int NEXP = 16384;
constexpr float EPS = 1e-6f;
constexpr int NTHREADS = 512;
constexpr int LDS_BYTES = 140 * 1024;

struct Params {
  const float *x, *c, *ctx, *c_ctx, *ada_w, *ada_b, *mix_g, *ffn_g, *ev_w_in, *ev_w_out, *logit_f, *logit_b, *conv_w,
      *od_w_in, *od_w_out, *sinks, *peer_wq, *keys1, *keys2, *peer_u, *peer_v, *final_g;
  float* out;
  float* mod;
  float* ropec;
  float* ropes;
  bf16_t* winT0;
  bf16_t* woutT0;
  bf16_t* winT1;
  bf16_t* woutT1;
  bf16_t* wqT;
  unsigned char* u8;
  unsigned char* v8;
  float* uscale;
  float* vscale;
  float* hctx;
  bf16_t* act;
  bf16_t* proj;
  bf16_t* pq;
  u32x2* sel;
  float* kv;
  bf16_t* sprev;
};

typedef __bf16 bf16x2n __attribute__((ext_vector_type(2)));
typedef float f32x2 __attribute__((ext_vector_type(2)));
__device__ __forceinline__ unsigned cvt_pk_bf16(float lo, float hi) {
  f32x2 v = {lo, hi};
  return __builtin_bit_cast(unsigned, __builtin_convertvector(v, bf16x2n));
}
__device__ __forceinline__ float bf_lo(unsigned u) { return __uint_as_float(u << 16); }
__device__ __forceinline__ float bf_hi(unsigned u) { return __uint_as_float(u & 0xffff0000u); }
__device__ __forceinline__ float bf2f(bf16_t h) { return __uint_as_float(((unsigned)h) << 16); }
__device__ __forceinline__ bf16_t f2bf(float f) { return __builtin_bit_cast(unsigned short, (__bf16)f); }

template <int CTRL>
__device__ __forceinline__ float dppf(float x) {
  return __builtin_bit_cast(float, __builtin_amdgcn_mov_dpp(__builtin_bit_cast(int, x), CTRL, 0xf, 0xf, true));
}
__device__ __forceinline__ float row16_sum(float x) {
  x += dppf<0xB1>(x); x += dppf<0x4E>(x); x += dppf<0x141>(x); x += dppf<0x128>(x);
  return x;
}
__device__ __forceinline__ float row16_max(float x) {
  x = fmaxf(x, dppf<0xB1>(x)); x = fmaxf(x, dppf<0x4E>(x)); x = fmaxf(x, dppf<0x141>(x)); x = fmaxf(x, dppf<0x128>(x));
  return x;
}
__device__ __forceinline__ float xrow16_sum(float x) {
  auto s = __builtin_amdgcn_permlane16_swap(__float_as_uint(x), __float_as_uint(x), false, false);
  x = __uint_as_float(s[0]) + __uint_as_float(s[1]);
  auto t = __builtin_amdgcn_permlane32_swap(__float_as_uint(x), __float_as_uint(x), false, false);
  return __uint_as_float(t[0]) + __uint_as_float(t[1]);
}
__device__ __forceinline__ float wave_sum(float x) { return xrow16_sum(row16_sum(x)); }
__device__ __forceinline__ float wave_max(float x) {
  x = row16_max(x);
  auto s = __builtin_amdgcn_permlane16_swap(__float_as_uint(x), __float_as_uint(x), false, false);
  x = fmaxf(__uint_as_float(s[0]), __uint_as_float(s[1]));
  auto t = __builtin_amdgcn_permlane32_swap(__float_as_uint(x), __float_as_uint(x), false, false);
  return fmaxf(__uint_as_float(t[0]), __uint_as_float(t[1]));
}

__device__ __forceinline__ int tidx() {
  int t = threadIdx.x;
  asm volatile("" : "+v"(t));
  __builtin_assume(t >= 0 && t < NTHREADS);
  return t;
}
__device__ __forceinline__ float siluf(float v) { return v / (1.f + __expf(-v)); }
__device__ __forceinline__ float log_sigmoidf(float v) { return -log1pf(expf(-v)); }

#define LAS __attribute__((address_space(3)))
constexpr int BM = 256, BK = 64, HALF = 128, HTB = HALF * BK * 2, NXCD = 8, WGM = 8;
constexpr int KDIM = 1024;

__device__ __forceinline__ int lds_byte(int r, int c) {
  const int st = (r >> 4) * 2 + (c >> 5), rr = r & 15, cc = c & 31, ob = rr * 64 + cc * 2;
  return st * 1024 + (ob ^ (((ob >> 9) & 1) << 5));
}
__device__ __forceinline__ void stage_rc(int b, int& R, int& C) {
  const int st = b / 1024, sb = b % 1024, swz = sb ^ (((sb >> 9) & 1) << 5);
  R = (st >> 1) * 16 + swz / 64;
  C = (st & 1) * 32 + (swz % 64) / 2;
}
struct Sched {
  int pm0, pn0, nM, nN, G, c;
  __device__ __forceinline__ bool next(int i, int& pm, int& pn) const {
    const int nwg = nM * nN;
    const long L = (long)i * G + c;
    if (L >= nwg) return false;
    int wgid = (int)L;
    { const int q = nwg / NXCD, r = nwg % NXCD, xcd = wgid % NXCD, off = wgid / NXCD; wgid = (xcd < r ? xcd * (q + 1) : r * (q + 1) + (xcd - r) * q) + off; }
    const int nig = WGM * nN, gid = wgid / nig, fm = gid * WGM, gsz = (nM - fm) < WGM ? (nM - fm) : WGM;
    pm = pm0 + fm + ((wgid % nig) % gsz);
    pn = pn0 + (wgid % nig) / gsz;
    return true;
  }
};

template <class Epi>
__device__ __forceinline__ void gemm_phase(LAS unsigned char* lds, const bf16_t* __restrict__ Ag, const bf16_t* __restrict__ Btg, const Sched& S, const Epi& E) {
  const int tid = tidx(), wid = __builtin_amdgcn_readfirstlane(tid >> 6), lane = tid & 63, wr = wid >> 2, wc = wid & 3, fr = lane & 15, fq = lane >> 4;
  constexpr int K = KDIM, nt = K / BK;
  unsigned voffA[2];
#pragma unroll
  for (int i = 0; i < 2; ++i) { int R, C; stage_rc(tid * 16 + i * 8192, R, C); voffA[i] = (unsigned)(R * K + C) * 2u; }
  const size_t kstep = (size_t)(BK * 2);
  const size_t hstep = (size_t)HALF * K * 2;
  const size_t tstep = 2 * hstep;
  const unsigned ldsw = (unsigned)wid * 1024u;
  const int aoff = lds_byte(wr * 64 + fr, fq * 8), boff = lds_byte(wc * 32 + fr, fq * 8);
#define G_SA(b, h) (((b) * 2 + (h)) * HTB)
#define G_SB(b, h) ((4 + (b) * 2 + (h)) * HTB)
#define G_STAGE(bufoff, gbase) do { _Pragma("unroll") for (int _i = 0; _i < 2; ++_i) \
    __builtin_amdgcn_global_load_lds((const unsigned*)((const char*)(gbase) + voffA[_i]), (LAS unsigned*)(lds + (bufoff) + ldsw + _i * 8192), 16, 0, 0); } while (0)
#define G_LDA(dst, b, h) do { _Pragma("unroll") for (int m = 0; m < 4; ++m) _Pragma("unroll") for (int k = 0; k < 2; ++k) dst[m][k] = *(const LAS bf16x8*)(lds + G_SA(b, h) + aoff + m * 2048 + k * 1024); } while (0)
#define G_LDB(dst, b, h) do { _Pragma("unroll") for (int n = 0; n < 2; ++n) _Pragma("unroll") for (int k = 0; k < 2; ++k) dst[n][k] = *(const LAS bf16x8*)(lds + G_SB(b, h) + boff + n * 2048 + k * 1024); } while (0)
#define G_MMA(ai, bj, At, Bt) do { __builtin_amdgcn_s_setprio(1); _Pragma("unroll") for (int m = 0; m < 4; ++m) _Pragma("unroll") for (int n = 0; n < 2; ++n) _Pragma("unroll") for (int k = 0; k < 2; ++k) \
    acc[ai][bj][m][n] = __builtin_amdgcn_mfma_f32_16x16x32_bf16(Bt[n][k], At[m][k], acc[ai][bj][m][n], 0, 0, 0); __builtin_amdgcn_s_setprio(0); } while (0)
#define G_WAIT_V(n) asm volatile("s_waitcnt vmcnt(" #n ")" ::: "memory")
#define G_WAIT_L(n) asm volatile("s_waitcnt lgkmcnt(" #n ")" ::: "memory")
#define G_BAR __builtin_amdgcn_s_barrier()
#define G_SCHED __builtin_amdgcn_sched_barrier(0)
  int cpm, cpn, npm, npn, ui = 0;
  if (!S.next(0, cpm, cpn)) return;
  f32x4 acc[2][2][4][2];
#pragma unroll
  for (int a = 0; a < 2; ++a)
#pragma unroll
    for (int b = 0; b < 2; ++b)
#pragma unroll
      for (int m = 0; m < 4; ++m)
#pragma unroll
        for (int n = 0; n < 2; ++n) acc[a][b][m][n] = (f32x4){0.f, 0.f, 0.f, 0.f};
  bf16x8 At[4][2], B0[2][2], B1[2][2];
  const char* cA = (const char*)Ag + (size_t)cpm * tstep;
  const char* cB = (const char*)Btg + (size_t)cpn * tstep;
  G_STAGE(G_SB(0, 0), cB); G_STAGE(G_SA(0, 0), cA); G_STAGE(G_SB(0, 1), cB + hstep); G_STAGE(G_SA(0, 1), cA + hstep);
  if (wr == 1) G_BAR;
  G_WAIT_V(4); G_BAR;
  G_STAGE(G_SB(1, 0), cB + kstep); G_STAGE(G_SA(1, 0), cA + kstep); G_STAGE(G_SB(1, 1), cB + hstep + kstep);
  G_WAIT_V(6); G_BAR;
  for (;;) {
    const bool has_next = S.next(ui + 1, npm, npn);
    const char* nA = has_next ? (const char*)Ag + (size_t)npm * tstep : cA;
    const char* nB = has_next ? (const char*)Btg + (size_t)npn * tstep : cB;
    for (int t = 0; t < nt; t += 2) {
      const bool last = (t == nt - 2);
      const char* a1 = cA + (size_t)(t + 1) * kstep;
      const char* a2 = last ? nA : cA + (size_t)(t + 2) * kstep;
      const char* b2 = last ? nB : cB + (size_t)(t + 2) * kstep;
      const char* a3 = a2 + kstep;
      const char* b3 = b2 + kstep;
      G_LDB(B0, 0, 0); G_SCHED; G_LDA(At, 0, 0); G_STAGE(G_SA(1, 1), a1 + hstep);
      G_WAIT_L(8); G_BAR; G_WAIT_L(0); G_MMA(0, 0, At, B0); G_BAR; G_SCHED;
      G_LDB(B1, 0, 1); G_STAGE(G_SB(0, 0), b2);
      G_BAR; G_WAIT_L(0); G_MMA(0, 1, At, B1); G_BAR;
      G_LDA(At, 0, 1); G_STAGE(G_SA(0, 0), a2);
      G_BAR; G_WAIT_L(0); G_MMA(1, 0, At, B0); G_BAR; G_SCHED;
      G_STAGE(G_SB(0, 1), b2 + hstep);
      G_WAIT_V(6); G_BAR; G_MMA(1, 1, At, B1); G_BAR;
      G_LDB(B0, 1, 0); G_SCHED; G_LDA(At, 1, 0); G_STAGE(G_SA(0, 1), a2 + hstep);
      G_WAIT_L(8); G_BAR; G_WAIT_L(0); G_MMA(0, 0, At, B0); G_BAR; G_SCHED;
      G_LDB(B1, 1, 1); G_STAGE(G_SB(1, 0), b3);
      G_BAR; G_WAIT_L(0); G_MMA(0, 1, At, B1); G_BAR;
      G_LDA(At, 1, 1); G_STAGE(G_SA(1, 0), a3);
      G_BAR; G_WAIT_L(0); G_MMA(1, 0, At, B0); G_BAR; G_SCHED;
      G_STAGE(G_SB(1, 1), b3 + hstep);
      G_WAIT_V(6); G_BAR; G_MMA(1, 1, At, B1); G_BAR;
    }
    E(acc, cpm * BM, cpn * BM, wr, wc, fr, fq);
    if (!has_next) break;
#pragma unroll
    for (int a = 0; a < 2; ++a)
#pragma unroll
      for (int b = 0; b < 2; ++b)
#pragma unroll
        for (int m = 0; m < 4; ++m)
#pragma unroll
          for (int n = 0; n < 2; ++n) acc[a][b][m][n] = (f32x4){0.f, 0.f, 0.f, 0.f};
    cpm = npm; cpn = npn; cA = nA; cB = nB; ++ui;
  }
  G_WAIT_V(0);
  if (wr == 0) G_BAR;
  G_BAR;
#undef G_SA
#undef G_SB
#undef G_STAGE
#undef G_LDA
#undef G_LDB
#undef G_MMA
}

struct EpiInProj {
  bf16_t* P; int ldc; int layer; const float* cosT; const float* sinT;
  __device__ __forceinline__ void operator()(const f32x4 (&acc)[2][2][4][2], int brow, int bcol, int wr, int wc, int fr, int fq) const {
#pragma unroll
    for (int bj = 0; bj < 2; ++bj) {
      const int colbase = bcol + bj * HALF + wc * 32;
      bool rope, scl;
      if (layer == 0) { rope = colbase < 512; scl = (colbase >= 256 && colbase < 512); }
      else { rope = colbase < 1280; scl = colbase < 1024; }
#pragma unroll
      for (int ai = 0; ai < 2; ++ai)
#pragma unroll
        for (int m = 0; m < 4; ++m) {
          const int row = brow + ai * HALF + wr * 64 + m * 16 + fr;
          f32x4 v0 = acc[ai][bj][m][0], v1 = acc[ai][bj][m][1];
          if (rope && row >= NCTX) {
            const int t = (row - NCTX) & (SEQ - 1);
            const int pos = (wc & 1) ? (t & 63) : (t >> 6);
            const f32x4 cs = *(const f32x4*)(cosT + pos * 16 + fq * 4);
            const f32x4 sn = *(const f32x4*)(sinT + pos * 16 + fq * 4);
            const f32x4 o0 = v0 * cs - v1 * sn, o1 = v1 * cs + v0 * sn;
            v0 = o0; v1 = o1;
          }
          if (scl) { v0 *= 0.125f; v1 *= 0.125f; }
          bf16_t* rp = P + (size_t)row * ldc + colbase + fq * 4;
          u32x2 w0, w1;
          w0.x = cvt_pk_bf16(v0[0], v0[1]); w0.y = cvt_pk_bf16(v0[2], v0[3]);
          w1.x = cvt_pk_bf16(v1[0], v1[1]); w1.y = cvt_pk_bf16(v1[2], v1[3]);
          *(u32x2*)rp = w0;
          *(u32x2*)(rp + 16) = w1;
        }
    }
  }
};
struct EpiBf16 {
  bf16_t* P; int ldc;
  __device__ __forceinline__ void operator()(const f32x4 (&acc)[2][2][4][2], int brow, int bcol, int wr, int wc, int fr, int fq) const {
#pragma unroll
    for (int ai = 0; ai < 2; ++ai)
#pragma unroll
      for (int m = 0; m < 4; ++m) {
        const int row = brow + ai * HALF + wr * 64 + m * 16 + fr;
#pragma unroll
        for (int bj = 0; bj < 2; ++bj)
#pragma unroll
          for (int n = 0; n < 2; ++n) {
            const f32x4 v = acc[ai][bj][m][n];
            u32x2 w; w.x = cvt_pk_bf16(v[0], v[1]); w.y = cvt_pk_bf16(v[2], v[3]);
            *(u32x2*)(P + (size_t)row * ldc + bcol + bj * HALF + wc * 32 + n * 16 + fq * 4) = w;
          }
      }
  }
};
struct EpiResid {
  const float* hin_ctx; const float* hin_lat; float* hout_ctx; float* hout_lat; const float* gate;
  __device__ __forceinline__ void operator()(const f32x4 (&acc)[2][2][4][2], int brow, int bcol, int wr, int wc, int fr, int fq) const {
    const bool isctx = brow < NCTX;
    const int b = isctx ? 32 : ((brow - NCTX) >> 11);
    const float* hin = isctx ? hin_ctx + (size_t)brow * D : hin_lat + (size_t)(brow - NCTX) * D;
    float* hout = isctx ? hout_ctx + (size_t)brow * D : hout_lat + (size_t)(brow - NCTX) * D;
    const float* g = gate + (size_t)b * MODW;
#pragma unroll
    for (int bj = 0; bj < 2; ++bj)
#pragma unroll
      for (int n = 0; n < 2; ++n) {
        const int col = bcol + bj * HALF + wc * 32 + n * 16 + fq * 4;
        const f32x4 gv = *(const f32x4*)(g + col);
#pragma unroll
        for (int ai = 0; ai < 2; ++ai)
#pragma unroll
          for (int m = 0; m < 4; ++m) {
            const int r = ai * HALF + wr * 64 + m * 16 + fr;
            const f32x4 h = *(const f32x4*)(hin + (size_t)r * D + col);
            *(f32x4*)(hout + (size_t)r * D + col) = h + gv * acc[ai][bj][m][n];
          }
      }
  }
};

template <int MT, int NT>
__device__ __forceinline__ void mm_lds(const bf16_t* A, int lda, const bf16_t* B, int ldb, int K, f32x4 (&acc)[MT][NT], int fr, int fq) {
  for (int k0 = 0; k0 < K; k0 += 32) {
    bf16x8 af[MT], bf[NT];
#pragma unroll
    for (int m = 0; m < MT; ++m) af[m] = *(const bf16x8*)(A + (m * 16 + fr) * lda + k0 + fq * 8);
#pragma unroll
    for (int n = 0; n < NT; ++n) bf[n] = *(const bf16x8*)(B + (n * 16 + fr) * ldb + k0 + fq * 8);
#pragma unroll
    for (int m = 0; m < MT; ++m)
#pragma unroll
      for (int n = 0; n < NT; ++n) acc[m][n] = __builtin_amdgcn_mfma_f32_16x16x32_bf16(af[m], bf[n], acc[m][n], 0, 0, 0);
  }
}

__device__ void phase_prep(const Params& p, unsigned char* smem, int bid, int nb) {
  const int tid = tidx();
  for (int it = bid; it < 2 * 96; it += nb) {
    const int layer = it / 96, n0 = (it % 96) * 64;
    float* s = (float*)smem;
    for (int i = tid; i < 33 * 1024; i += NTHREADS) {
      const int b = i >> 10, k = i & 1023;
      const float v = (b < 32) ? p.c[b * 1024 + k] : p.c_ctx[k];
      s[k * 33 + b] = siluf(v);
    }
    __syncthreads();
    const int col = tid & 63, kg = tid >> 6;
    float acc[33];
#pragma unroll
    for (int b = 0; b < 33; ++b) acc[b] = 0.f;
    const float* W = p.ada_w + (size_t)layer * 1024 * MODW + n0 + col;
    for (int k = kg * 128; k < kg * 128 + 128; ++k) {
      const float w = W[(size_t)k * MODW];
      const float* sk = s + k * 33;
#pragma unroll
      for (int b = 0; b < 33; ++b) acc[b] += sk[b] * w;
    }
    __syncthreads();
    float* red = (float*)smem;
#pragma unroll
    for (int b = 0; b < 33; ++b) red[(kg * 33 + b) * 64 + col] = acc[b];
    __syncthreads();
    for (int i = tid; i < 33 * 64; i += NTHREADS) {
      const int b = i >> 6, cc = i & 63;
      float t = p.ada_b[layer * MODW + n0 + cc];
#pragma unroll
      for (int g = 0; g < 8; ++g) t += red[(g * 33 + b) * 64 + cc];
      p.mod[((size_t)layer * 33 + b) * MODW + n0 + cc] = t;
    }
    __syncthreads();
  }
  if (bid == nb - 1) {
    for (int i = tid; i < 1024; i += NTHREADS) {
      const int pos = i >> 4, f = i & 15;
      const float inv = powf(10000.f, -(float)f / 16.f);
      const float ang = (float)pos * inv;
      p.ropec[i] = cosf(ang);
      p.ropes[i] = sinf(ang);
    }
  }
  {
    float* tile = (float*)smem;
    const int ntile_total = 768 + 256 + 384 + 256 + 512;
    for (int it = bid; it < ntile_total; it += nb) {
      const float* src; bf16_t* dst; int N, ti;
      if (it < 768) { src = p.ev_w_in; dst = p.winT0; N = 3072; ti = it; }
      else if (it < 1024) { src = p.ev_w_out; dst = p.woutT0; N = 1024; ti = it - 768; }
      else if (it < 1408) { src = p.od_w_in; dst = p.winT1; N = 1536; ti = it - 1024; }
      else if (it < 1664) { src = p.od_w_out; dst = p.woutT1; N = 1024; ti = it - 1408; }
      else { const int l = (it - 1664) / 256; src = p.peer_wq + (size_t)l * 1024 * 1024; dst = p.wqT + (size_t)l * 1024 * 1024; N = 1024; ti = (it - 1664) % 256; }
      const int ntn = N / 64, tk = ti / ntn, tn = ti % ntn;
      __syncthreads();
      for (int i = tid; i < 64 * 64; i += NTHREADS) {
        const int r = i >> 6, cc = i & 63;
        tile[r * 65 + cc] = src[(size_t)(tk * 64 + r) * N + tn * 64 + cc];
      }
      __syncthreads();
      for (int i = tid; i < 64 * 32; i += NTHREADS) {
        const int nn = i >> 5, kk = (i & 31) * 2;
        const unsigned w = cvt_pk_bf16(tile[kk * 65 + nn], tile[(kk + 1) * 65 + nn]);
        *(unsigned*)(dst + (size_t)(tn * 64 + nn) * 1024 + tk * 64 + kk) = w;
      }
    }
    __syncthreads();
  }
  {
    const int wid = tid >> 6, lane = tid & 63;
    for (int r = bid * 8 + wid; r < 4 * NEXP; r += nb * 8) {
      const bool isv = r >= 2 * NEXP;
      const int rr = isv ? r - 2 * NEXP : r;
      const float* src = (isv ? p.peer_v : p.peer_u) + (size_t)rr * D + lane * 16;
      f32x4 a[4];
      float mx = 0.f;
#pragma unroll
      for (int i = 0; i < 4; ++i) {
        a[i] = *(const f32x4*)(src + i * 4);
        mx = fmaxf(mx, fmaxf(fmaxf(fabsf(a[i][0]), fabsf(a[i][1])), fmaxf(fabsf(a[i][2]), fabsf(a[i][3]))));
      }
      mx = wave_max(mx);
      const float sc = mx > 0.f ? 240.f / mx : 1.f;
      u32x4 w;
#pragma unroll
      for (int i = 0; i < 4; ++i) {
        int t = __builtin_amdgcn_cvt_pk_fp8_f32(a[i][0] * sc, a[i][1] * sc, 0, false);
        t = __builtin_amdgcn_cvt_pk_fp8_f32(a[i][2] * sc, a[i][3] * sc, t, true);
        w[i] = (unsigned)t;
      }
      *(u32x4*)((isv ? p.v8 : p.u8) + (size_t)rr * D + lane * 16) = w;
      if (lane == 0) (isv ? p.vscale : p.uscale)[rr] = mx > 0.f ? mx / 240.f : 1.f;
    }
  }
}

__device__ void phase_norm(const Params& p, int bid, int nb, int row0, int row1, const float* hctx, const float* hlat,
                           const float* gain, const float* modl, int ish, int isc) {
  const int tid0 = tidx();
  const int wid = tid0 >> 6, lane = tid0 & 63;
  for (int row = row0 + bid * 8 + wid; row < row1; row += nb * 8) {
    const bool isctx = row < NCTX;
    const float* h = isctx ? hctx + (size_t)row * D : hlat + (size_t)(row - NCTX) * D;
    const int b = isctx ? 32 : ((row - NCTX) >> 11);
    const float* sh = modl + (size_t)b * MODW + ish * D;
    const float* sc = modl + (size_t)b * MODW + isc * D;
    f32x4 v[4];
    float ss = 0.f;
#pragma unroll
    for (int i = 0; i < 4; ++i) {
      v[i] = *(const f32x4*)(h + i * 256 + lane * 4);
      ss += v[i][0] * v[i][0] + v[i][1] * v[i][1] + v[i][2] * v[i][2] + v[i][3] * v[i][3];
    }
    ss = wave_sum(ss);
    const float rstd = rsqrtf(ss * (1.f / D) + EPS);
#pragma unroll
    for (int i = 0; i < 4; ++i) {
      const int col = i * 256 + lane * 4;
      const f32x4 g = *(const f32x4*)(gain + col), s1 = *(const f32x4*)(sc + col), s0 = *(const f32x4*)(sh + col);
      f32x4 y = v[i] * rstd * g;
      y = y * (1.f + s1) + s0;
      u32x2 w; w.x = cvt_pk_bf16(y[0], y[1]); w.y = cvt_pk_bf16(y[2], y[3]);
      *(u32x2*)(p.act + (size_t)row * D + col) = w;
    }
  }
}

__device__ __forceinline__ void phase_gemm_inproj(const Params& p, unsigned char* smem, int bid, int nb, int layer) {
  LAS unsigned char* lds = (LAS unsigned char*)smem;
  if (layer == 0) {
    EpiInProj epi{p.proj, 3072, 0, p.ropec, p.ropes};
    Sched s{0, 0, NTOK / BM, 12, nb, bid};
    gemm_phase(lds, p.act, p.winT0, s, epi);
  } else {
    EpiInProj epi{p.proj, 1536, 1, p.ropec, p.ropes};
    Sched s{NCTX / BM, 0, NLAT / BM, 6, nb, bid};
    gemm_phase(lds, p.act, p.winT1, s, epi);
    Sched s2{0, 4, NCTX / BM, 2, nb, bid};
    gemm_phase(lds, p.act, p.winT1, s2, epi);
  }
}
__device__ __forceinline__ void phase_gemm_outproj(const Params& p, unsigned char* smem, int bid, int nb, int layer) {
  LAS unsigned char* lds = (LAS unsigned char*)smem;
  if (layer == 0) {
    EpiResid epi{p.ctx, p.x, p.hctx, p.out, p.mod + 2 * D};
    Sched s{0, 0, NTOK / BM, 4, nb, bid};
    gemm_phase(lds, p.act, p.woutT0, s, epi);
  } else {
    EpiResid epi{p.hctx, p.out, p.hctx, p.out, p.mod + (size_t)33 * MODW + 2 * D};
    Sched s{NCTX / BM, 0, NLAT / BM, 4, nb, bid};
    gemm_phase(lds, p.act, p.woutT1, s, epi);
  }
}
__device__ __forceinline__ void phase_gemm_pq(const Params& p, unsigned char* smem, int bid, int nb, int layer) {
  LAS unsigned char* lds = (LAS unsigned char*)smem;
  EpiBf16 epi{p.pq, D};
  const int pm0 = layer == 0 ? 0 : NCTX / BM;
  Sched s{pm0, 0, NTOK / BM - pm0, 4, nb, bid};
  gemm_phase(lds, p.act, p.wqT + (size_t)layer * D * D, s, epi);
}

__device__ __forceinline__ int chunk_row0(int b, int cc) { return cc < 2 ? b * CTXL + cc * 128 : NCTX + b * SEQ + (cc - 2) * 128; }

constexpr int LDP = 136;
constexpr int LDK = 72;

__device__ void phase_ret_kv(const Params& p, unsigned char* smem, int bid, int nb) {
  const int tid = tidx(), wid = tid >> 6, lane = tid & 63, fr = lane & 15, fq = lane >> 4;
  bf16_t* KxT = (bf16_t*)smem;
  bf16_t* VT = KxT + 128 * LDP;
  for (int it = bid; it < BATCH * 4 * 18; it += nb) {
    const int cc = it % 18, h = (it / 18) & 3, b = it / 72;
    const int row0 = chunk_row0(b, cc);
    const float lf = log_sigmoidf(p.logit_f[h]), lb = log_sigmoidf(p.logit_b[h]);
    __syncthreads();
    for (int task = tid; task < 128 * 8; task += NTHREADS) {
      const int j = task >> 3, d0 = (task & 7) * 8;
      const u32x4 kk = *(const u32x4*)(p.proj + (size_t)(row0 + j) * 3072 + 256 + h * 64 + d0);
      const float zf = __expf(lf * (float)(127 - j)), zb = __expf(lb * (float)j);
#pragma unroll
      for (int q = 0; q < 4; ++q) {
        const float lo = bf_lo(kk[q]), hi = bf_hi(kk[q]);
        KxT[(d0 + 2 * q) * LDP + j] = f2bf(lo * zf);
        KxT[(d0 + 2 * q + 1) * LDP + j] = f2bf(hi * zf);
        KxT[(64 + d0 + 2 * q) * LDP + j] = f2bf(lo * zb);
        KxT[(64 + d0 + 2 * q + 1) * LDP + j] = f2bf(hi * zb);
      }
    }
    for (int task = tid; task < 128 * 16; task += NTHREADS) {
      const int j = task >> 4, e0 = (task & 15) * 8;
      const u32x4 vv = *(const u32x4*)(p.proj + (size_t)(row0 + j) * 3072 + 512 + h * 128 + e0);
#pragma unroll
      for (int q = 0; q < 4; ++q) {
        VT[(e0 + 2 * q) * LDP + j] = (bf16_t)(vv[q] & 0xffffu);
        VT[(e0 + 2 * q + 1) * LDP + j] = (bf16_t)(vv[q] >> 16);
      }
    }
    __syncthreads();
    f32x4 acc[1][8] = {};
    mm_lds<1, 8>(VT + wid * 16 * LDP, LDP, KxT, LDP, 128, acc, fr, fq);
    float* out = p.kv + (size_t)it * 16384;
#pragma unroll
    for (int n = 0; n < 8; ++n)
#pragma unroll
      for (int j = 0; j < 4; ++j) out[(wid * 16 + fq * 4 + j) * 128 + n * 16 + fr] = acc[0][n][j];
  }
  for (size_t task = (size_t)bid * NTHREADS + tid; task < (size_t)NTOK * 64; task += (size_t)nb * NTHREADS) {
    const int row = (int)(task >> 6), c0 = (int)(task & 63) * 8;
    const int tin = row < NCTX ? (row & (CTXL - 1)) : ((row - NCTX) & (SEQ - 1));
    const int tlen = row < NCTX ? CTXL : SEQ;
    const bf16_t* pr = p.proj + (size_t)row * 3072;
    const u32x4 gb = *(const u32x4*)(pr + 1536 + c0);
    float accv[8];
#pragma unroll
    for (int q = 0; q < 8; ++q) accv[q] = 0.f;
#pragma unroll
    for (int dt = -1; dt <= 1; ++dt) {
      if (tin + dt < 0 || tin + dt >= tlen) continue;
      const bf16_t* pr2 = pr + (ptrdiff_t)dt * 3072;
      const u32x4 gc = *(const u32x4*)(pr2 + 2048 + c0), xt = *(const u32x4*)(pr2 + 2560 + c0);
      const float* w = p.conv_w + (dt + 1) * 512 + c0;
      const f32x4 wa = *(const f32x4*)w, wb = *(const f32x4*)(w + 4);
#pragma unroll
      for (int q = 0; q < 4; ++q) {
        const float u0 = bf_lo(gc[q]) * bf_lo(xt[q]), u1 = bf_hi(gc[q]) * bf_hi(xt[q]);
        const float w0 = (2 * q < 4) ? wa[2 * q] : wb[2 * q - 4], w1 = (2 * q + 1 < 4) ? wa[2 * q + 1] : wb[2 * q + 1 - 4];
        accv[2 * q] += w0 * u0;
        accv[2 * q + 1] += w1 * u1;
      }
    }
    u32x4 o;
#pragma unroll
    for (int q = 0; q < 4; ++q) o[q] = cvt_pk_bf16(bf_lo(gb[q]) * accv[2 * q], bf_hi(gb[q]) * accv[2 * q + 1]);
#ifdef ZERO_CONV
    o = (u32x4){0u, 0u, 0u, 0u};
#endif
    *(u32x4*)(p.act + (size_t)row * D + 512 + c0) = o;
  }
}

__device__ void phase_ret_scan(const Params& p, int bid, int nb) {
  const int tid = tidx();
  for (size_t idx = (size_t)bid * NTHREADS + tid; idx < (size_t)BATCH * 4 * 16384; idx += (size_t)nb * NTHREADS) {
    const int el = (int)(idx & 16383), bh = (int)(idx >> 14), h = bh & 3;
    const bool fwd = (el & 127) < 64;
    const float lg = log_sigmoidf(fwd ? p.logit_f[h] : p.logit_b[h]);
    const float dec = __expf(lg * 128.f);
    float st = 0.f;
    for (int s = 0; s < 18; ++s) {
      const int cc = fwd ? s : (s < 2 ? 1 - s : 19 - s);
      const size_t off = ((size_t)bh * 18 + cc) * 16384 + el;
      p.sprev[off] = f2bf(st);
      st = dec * st + p.kv[off];
    }
  }
}

__device__ void phase_ret_out(const Params& p, unsigned char* smem, int bid, int nb) {
  const int tid = tidx(), wid = tid >> 6, lane = tid & 63, fr = lane & 15, fq = lane >> 4;
  bf16_t* Kt = (bf16_t*)smem;
  bf16_t* VT = Kt + 128 * LDK;
  bf16_t* ST = VT + 128 * LDP;
  bf16_t* Pb = ST + 128 * LDP;
  for (int it = bid; it < BATCH * 4 * 18; it += nb) {
    const int cc = it % 18, h = (it / 18) & 3, b = it / 72;
    const int row0 = chunk_row0(b, cc);
    const float lf = log_sigmoidf(p.logit_f[h]), lb = log_sigmoidf(p.logit_b[h]);
    __syncthreads();
    for (int task = tid; task < 128 * 8; task += NTHREADS) {
      const int j = task >> 3, d0 = (task & 7) * 8;
      *(u32x4*)(Kt + j * LDK + d0) = *(const u32x4*)(p.proj + (size_t)(row0 + j) * 3072 + 256 + h * 64 + d0);
    }
    for (int task = tid; task < 128 * 16; task += NTHREADS) {
      const int j = task >> 4, e0 = (task & 15) * 8;
      const u32x4 vv = *(const u32x4*)(p.proj + (size_t)(row0 + j) * 3072 + 512 + h * 128 + e0);
#pragma unroll
      for (int q = 0; q < 4; ++q) {
        VT[(e0 + 2 * q) * LDP + j] = (bf16_t)(vv[q] & 0xffffu);
        VT[(e0 + 2 * q + 1) * LDP + j] = (bf16_t)(vv[q] >> 16);
      }
      const int e = j;
      *(u32x4*)(ST + e * LDP + e0) = *(const u32x4*)(p.sprev + (size_t)it * 16384 + e * 128 + e0);
    }
    const int irow = wid * 16 + fr;
    bf16x8 qf[2];
#pragma unroll
    for (int ks = 0; ks < 2; ++ks) qf[ks] = *(const bf16x8*)(p.proj + (size_t)(row0 + irow) * 3072 + h * 64 + ks * 32 + fq * 8);
    __syncthreads();
    f32x4 sacc[8] = {};
#pragma unroll
    for (int ks = 0; ks < 2; ++ks)
#pragma unroll
      for (int n = 0; n < 8; ++n) {
        const bf16x8 kf = *(const bf16x8*)(Kt + (n * 16 + fr) * LDK + ks * 32 + fq * 8);
        sacc[n] = __builtin_amdgcn_mfma_f32_16x16x32_bf16(qf[ks], kf, sacc[n], 0, 0, 0);
      }
#pragma unroll
    for (int n = 0; n < 8; ++n)
#pragma unroll
      for (int jj = 0; jj < 4; ++jj) {
        const int i = wid * 16 + fq * 4 + jj, j = n * 16 + fr;
        const int df = i - j;
        const float dm = df > 0 ? __expf(lf * (float)df) : (df < 0 ? __expf(lb * (float)(-df)) : 2.f);
        Pb[i * LDP + j] = f2bf(sacc[n][jj] * dm);
      }
    __syncthreads();
    f32x4 oacc[1][8] = {};
    mm_lds<1, 8>(Pb + wid * 16 * LDP, LDP, VT, LDP, 128, oacc, fr, fq);
    {
      const float xf = __expf(lf * (float)(irow + 1)), xb = __expf(lb * (float)(128 - irow));
#pragma unroll
      for (int ks = 0; ks < 4; ++ks) {
        const float sc = ks < 2 ? xf : xb;
        const bf16x8 qs = qf[ks & 1];
        u32x4 qu = __builtin_bit_cast(u32x4, qs), qo;
#pragma unroll
        for (int q = 0; q < 4; ++q) qo[q] = cvt_pk_bf16(bf_lo(qu[q]) * sc, bf_hi(qu[q]) * sc);
        const bf16x8 qx = __builtin_bit_cast(bf16x8, qo);
#pragma unroll
        for (int n = 0; n < 8; ++n) {
          const bf16x8 sf = *(const bf16x8*)(ST + (n * 16 + fr) * LDP + ks * 32 + fq * 8);
          oacc[0][n] = __builtin_amdgcn_mfma_f32_16x16x32_bf16(qx, sf, oacc[0][n], 0, 0, 0);
        }
      }
    }
#pragma unroll
    for (int jj = 0; jj < 4; ++jj) {
      float ss = 0.f;
#pragma unroll
      for (int n = 0; n < 8; ++n) ss += oacc[0][n][jj] * oacc[0][n][jj];
      ss = row16_sum(ss);
      const float rstd = rsqrtf(ss * (1.f / 128.f) + EPS);
      const int row = row0 + wid * 16 + fq * 4 + jj;
#pragma unroll
      for (int n = 0; n < 8; ++n) {
        const int e = n * 16 + fr;
        const float g = bf2f(p.proj[(size_t)row * 3072 + 1024 + h * 128 + e]);
#ifdef ZERO_RET
        p.act[(size_t)row * D + h * 128 + e] = 0;
#else
        p.act[(size_t)row * D + h * 128 + e] = f2bf(oacc[0][n][jj] * rstd * siluf(g));
#endif
      }
    }
  }
}

__device__ void phase_attn(const Params& p, unsigned char* smem, int bid, int nb) {
  const int tid = tidx(), wid = tid >> 6, lane = tid & 63, fr = lane & 15, fq = lane >> 4;
  bf16_t* Kt = (bf16_t*)smem;
  bf16_t* VT = Kt + 64 * LDK;
  bf16_t* Pw = VT + 64 * LDK + wid * 64 * LDK;
  for (int it = bid; it < BATCH * 16 * 4; it += nb) {
    const int kvh = it & 3, qb = (it >> 2) & 15, b = it >> 6;
    const int hq = kvh * 4 + (wid >> 1);
    const int q0 = qb * 128 + (wid & 1) * 64;
    const size_t latrow0 = (size_t)NCTX + (size_t)b * SEQ;
    bf16x8 qf[4][2];
#pragma unroll
    for (int m = 0; m < 4; ++m)
#pragma unroll
      for (int ks = 0; ks < 2; ++ks)
        qf[m][ks] = *(const bf16x8*)(p.proj + (latrow0 + q0 + m * 16 + fr) * 1536 + hq * 64 + ks * 32 + fq * 8);
    const float sink = p.sinks[hq];
    float mrow[4][4], lrow[4][4];
    f32x4 oacc[4][4] = {};
#pragma unroll
    for (int m = 0; m < 4; ++m)
#pragma unroll
      for (int jj = 0; jj < 4; ++jj) { mrow[m][jj] = sink; lrow[m][jj] = (fr == 0) ? 1.f : 0.f; }
    for (int tt = 0; tt < 10; ++tt) {
      const bool win = tt < 6;
      const int kpos0 = win ? qb * 128 - 128 + 64 * tt : (tt - 6) * 64;
      if (win && (kpos0 < 0 || kpos0 >= SEQ)) continue;
      const size_t krow0 = win ? latrow0 + kpos0 : (size_t)b * CTXL + kpos0;
      __syncthreads();
      {
        const int j = tid >> 3, d0 = (tid & 7) * 8;
        *(u32x4*)(Kt + j * LDK + d0) = *(const u32x4*)(p.proj + (krow0 + j) * 1536 + 1024 + kvh * 64 + d0);
        const u32x4 vv = *(const u32x4*)(p.proj + (krow0 + j) * 1536 + 1280 + kvh * 64 + d0);
#pragma unroll
        for (int q = 0; q < 4; ++q) {
          VT[(d0 + 2 * q) * LDK + j] = (bf16_t)(vv[q] & 0xffffu);
          VT[(d0 + 2 * q + 1) * LDK + j] = (bf16_t)(vv[q] >> 16);
        }
      }
      __syncthreads();
#pragma unroll
      for (int m = 0; m < 4; ++m) {
        f32x4 sacc[4];
#pragma unroll
        for (int n = 0; n < 4; ++n) sacc[n] = (f32x4){0.f, 0.f, 0.f, 0.f};
#pragma unroll
        for (int ks = 0; ks < 2; ++ks)
#pragma unroll
          for (int n = 0; n < 4; ++n) {
            const bf16x8 kf = *(const bf16x8*)(Kt + (n * 16 + fr) * LDK + ks * 32 + fq * 8);
            sacc[n] = __builtin_amdgcn_mfma_f32_16x16x32_bf16(qf[m][ks], kf, sacc[n], 0, 0, 0);
          }
#pragma unroll
        for (int jj = 0; jj < 4; ++jj) {
          const int qpos = q0 + m * 16 + fq * 4 + jj;
          float mx = -3.0e38f;
#pragma unroll
          for (int n = 0; n < 4; ++n) {
            float s = sacc[n][jj];
            if (win) { const int dd = qpos - (kpos0 + n * 16 + fr); if (dd > 128 || dd < -128) s = -1e30f; }
            sacc[n][jj] = s;
            mx = fmaxf(mx, s);
          }
          mx = row16_max(mx);
          const float mnew = fmaxf(mrow[m][jj], mx);
          const float alpha = __expf(mrow[m][jj] - mnew);
          mrow[m][jj] = mnew;
          float ls = 0.f;
#pragma unroll
          for (int n = 0; n < 4; ++n) {
            const float pv = __expf(sacc[n][jj] - mnew);
            ls += pv;
            Pw[(m * 16 + fq * 4 + jj) * LDK + n * 16 + fr] = f2bf(pv);
          }
          lrow[m][jj] = lrow[m][jj] * alpha + ls;
#pragma unroll
          for (int n = 0; n < 4; ++n) oacc[m][n][jj] *= alpha;
        }
      }
      __syncthreads();
      mm_lds<4, 4>(Pw, LDK, VT, LDK, 64, oacc, fr, fq);
    }
#pragma unroll
    for (int m = 0; m < 4; ++m)
#pragma unroll
      for (int jj = 0; jj < 4; ++jj) {
        const float l = row16_sum(lrow[m][jj]);
        const float inv = 1.f / l;
        const size_t row = latrow0 + q0 + m * 16 + fq * 4 + jj;
#pragma unroll
        for (int n = 0; n < 4; ++n) {
#ifdef ZERO_ATTN
          p.act[row * D + hq * 64 + n * 16 + fr] = 0;
#else
          p.act[row * D + hq * 64 + n * 16 + fr] = f2bf(oacc[m][n][jj] * inv);
#endif
        }
      }
  }
}

__device__ __forceinline__ unsigned f2ord(float f) { const unsigned u = __float_as_uint(f); return (u & 0x80000000u) ? ~u : (u | 0x80000000u); }
__device__ __forceinline__ float ord2f(unsigned k) { const unsigned u = (k & 0x80000000u) ? (k & 0x7fffffffu) : ~k; return __uint_as_float(u); }

__device__ void phase_peer_topk(const Params& p, unsigned char* smem, int bid, int nb, int layer, int tok0, int ntok) {
  const int tid = tidx(), wid = tid >> 6, lane = tid & 63;
  float* keys = (float*)smem;
  unsigned* lists = (unsigned*)(smem + 65536);
  const int nitem = (ntok / 256) * 8;
  for (int it = bid; it < nitem; it += nb) {
    const int h = it & 7, tile = it >> 3;
    const int set = wid >> 2, tl = (wid & 3) * 64 + lane;
    const int token = tok0 + tile * 256 + tl;
    __syncthreads();
    {
      const float* k1 = p.keys1 + ((size_t)layer * 8 + h) * 8192;
      const float* k2 = p.keys2 + ((size_t)layer * 8 + h) * 8192;
      for (int i = tid; i < 2048; i += NTHREADS) {
        *(f32x4*)(keys + i * 4) = *(const f32x4*)(k1 + i * 4);
        *(f32x4*)(keys + 8192 + i * 4) = *(const f32x4*)(k2 + i * 4);
      }
    }
    float q[64];
    {
      const bf16_t* qp = p.pq + (size_t)token * D + h * 128 + set * 64;
#pragma unroll
      for (int c8 = 0; c8 < 8; ++c8) {
        const u32x4 w = *(const u32x4*)(qp + c8 * 8);
#pragma unroll
        for (int qq = 0; qq < 4; ++qq) { q[c8 * 8 + 2 * qq] = bf_lo(w[qq]); q[c8 * 8 + 2 * qq + 1] = bf_hi(w[qq]); }
      }
    }
    __syncthreads();
    unsigned top[16];
#pragma unroll
    for (int i = 0; i < 16; ++i) top[i] = 0u;
    const float* kb = keys + set * 8192;
    for (int k = 0; k < 128; ++k) {
      float s0 = 0.f, s1 = 0.f;
#pragma unroll
      for (int d4 = 0; d4 < 16; ++d4) {
        const f32x4 kv = *(const f32x4*)(kb + k * 64 + d4 * 4);
        s0 += q[d4 * 4] * kv[0]; s1 += q[d4 * 4 + 1] * kv[1];
        s0 += q[d4 * 4 + 2] * kv[2]; s1 += q[d4 * 4 + 3] * kv[3];
      }
      unsigned v = (f2ord(s0 + s1) & 0xffffff80u) | (unsigned)(127 - k);
#pragma unroll
      for (int i = 0; i < 16; ++i) { const unsigned hi = max(top[i], v); v = min(top[i], v); top[i] = hi; }
    }
    unsigned* mylist = lists + ((size_t)set * 256 + tl) * 16;
#pragma unroll
    for (int i = 0; i < 4; ++i) { u32x4 w; w.x = top[4 * i]; w.y = top[4 * i + 1]; w.z = top[4 * i + 2]; w.w = top[4 * i + 3]; *(u32x4*)(mylist + 4 * i) = w; }
    __syncthreads();
    if (set == 0) {
      unsigned o2[16];
      const unsigned* other = lists + ((size_t)256 + tl) * 16;
#pragma unroll
      for (int i = 0; i < 4; ++i) { const u32x4 w = *(const u32x4*)(other + 4 * i); o2[4 * i] = w.x; o2[4 * i + 1] = w.y; o2[4 * i + 2] = w.z; o2[4 * i + 3] = w.w; }
      float v1[16], v2[16];
#pragma unroll
      for (int i = 0; i < 16; ++i) { v1[i] = ord2f(top[i] & 0xffffff80u); v2[i] = ord2f(o2[i] & 0xffffff80u); }
      unsigned ct[16];
#pragma unroll
      for (int i = 0; i < 16; ++i) ct[i] = 0u;
#pragma unroll
      for (int i = 0; i < 16; ++i)
#pragma unroll
        for (int j = 0; j < 16; ++j) {
          if ((i + 1) * (j + 1) <= 16) {
            unsigned v = (f2ord(v1[i] + v2[j]) & 0xffffff00u) | (unsigned)(255 - (i * 16 + j));
#pragma unroll
            for (int r = 0; r < 16; ++r) { const unsigned hi = max(ct[r], v); v = min(ct[r], v); ct[r] = hi; }
          }
        }
      float cs[16], den = 0.f;
      const float mx = ord2f(ct[0] & 0xffffff00u);
#pragma unroll
      for (int r = 0; r < 16; ++r) { cs[r] = __expf(ord2f(ct[r] & 0xffffff00u) - mx); den += cs[r]; }
      const float inv = 1.f / den;
      u32x2* so = p.sel + (size_t)token * 128 + h * 16;
      const unsigned* l1 = lists + (size_t)tl * 16;
#pragma unroll
      for (int r = 0; r < 16; ++r) {
        const unsigned ci = 255u - (ct[r] & 0xffu);
        const unsigned e1 = 127u - (l1[ci >> 4] & 0x7fu), e2 = 127u - (other[ci & 15u] & 0x7fu);
        u32x2 w; w.x = e1 * 128u + e2; w.y = __float_as_uint(cs[r] * inv);
        so[r] = w;
      }
    }
  }
}

__device__ __forceinline__ void peer_experts(const u32x2 se, const unsigned char* __restrict__ U, const unsigned char* __restrict__ V,
                                             const float* __restrict__ us, const float* __restrict__ vs, const float (&x)[16], float (&y)[16], int lane) {
  for (int j0 = 0; j0 < 64; j0 += 4) {
    u32x4 uw[4], vw[4];
    float gate[4], su[4], sv[4];
#pragma unroll
    for (int u = 0; u < 4; ++u) {
      const unsigned e = (unsigned)__builtin_amdgcn_readlane((int)se.x, j0 + u);
      gate[u] = __uint_as_float((unsigned)__builtin_amdgcn_readlane((int)se.y, j0 + u));
      uw[u] = *(const u32x4*)(U + (size_t)e * D + lane * 16);
      vw[u] = *(const u32x4*)(V + (size_t)e * D + lane * 16);
      su[u] = us[e];
      sv[u] = vs[e];
    }
#pragma unroll
    for (int u = 0; u < 4; ++u) {
      float d0 = 0.f, d1 = 0.f;
#pragma unroll
      for (int q = 0; q < 4; ++q) {
        const int w = (int)uw[u][q];
        const f32x2 lo = __builtin_amdgcn_cvt_pk_f32_fp8(w, false), hi = __builtin_amdgcn_cvt_pk_f32_fp8(w, true);
        d0 += lo.x * x[4 * q]; d1 += lo.y * x[4 * q + 1];
        d0 += hi.x * x[4 * q + 2]; d1 += hi.y * x[4 * q + 3];
      }
      const float d = wave_sum(d0 + d1) * su[u];
      const float a = gate[u] * sv[u] * 0.5f * d * (1.f + erff(d * 0.70710678118f));
#pragma unroll
      for (int q = 0; q < 4; ++q) {
        const int w = (int)vw[u][q];
        const f32x2 lo = __builtin_amdgcn_cvt_pk_f32_fp8(w, false), hi = __builtin_amdgcn_cvt_pk_f32_fp8(w, true);
        y[4 * q] += a * lo.x; y[4 * q + 1] += a * lo.y;
        y[4 * q + 2] += a * hi.x; y[4 * q + 3] += a * hi.y;
      }
    }
  }
}

__device__ void phase_peer_gather(const Params& p, int bid, int nb, int layer, int tok0, int ntok) {
  const int tid0 = tidx();
  const int wid = tid0 >> 6, lane = tid0 & 63;
  const unsigned char* U = p.u8 + (size_t)layer * NEXP * D;
  const unsigned char* V = p.v8 + (size_t)layer * NEXP * D;
  const float* us = p.uscale + (size_t)layer * NEXP;
  const float* vs = p.vscale + (size_t)layer * NEXP;
  const float* modl = p.mod + (size_t)layer * 33 * MODW;
  for (int t = bid * 8 + wid; t < ntok; t += nb * 8) {
    const int token = tok0 + t;
    const bf16_t* xr = p.act + (size_t)token * D + lane * 16;
    const u32x4 xa = *(const u32x4*)xr, xb = *(const u32x4*)(xr + 8);
    float x[16];
#pragma unroll
    for (int q = 0; q < 4; ++q) {
      const unsigned wa = xa[q], wb = xb[q];
      x[2 * q] = bf_lo(wa); x[2 * q + 1] = bf_hi(wa);
      x[8 + 2 * q] = bf_lo(wb); x[8 + 2 * q + 1] = bf_hi(wb);
    }
    const u32x2 se0 = p.sel[(size_t)token * 128 + lane], se1 = p.sel[(size_t)token * 128 + 64 + lane];
    float y[16];
#pragma unroll
    for (int i = 0; i < 16; ++i) y[i] = 0.f;
    peer_experts(se0, U, V, us, vs, x, y, lane);
    peer_experts(se1, U, V, us, vs, x, y, lane);
#ifdef ZERO_PEER
    if (layer == ZERO_PEER) {
#pragma unroll
      for (int i = 0; i < 16; ++i) y[i] = 0.f;
    }
#endif
    const bool isctx = token < NCTX;
    const int b = isctx ? 32 : ((token - NCTX) >> 11);
    const float* g2 = modl + (size_t)b * MODW + 5 * D + lane * 16;
    float* hrow = (isctx ? p.hctx + (size_t)token * D : p.out + (size_t)(token - NCTX) * D) + lane * 16;
    float hn[16];
    float ss = 0.f;
#pragma unroll
    for (int q4 = 0; q4 < 4; ++q4) {
      const f32x4 hv = *(const f32x4*)(hrow + q4 * 4), gv = *(const f32x4*)(g2 + q4 * 4);
#pragma unroll
      for (int e = 0; e < 4; ++e) { const float v = hv[e] + gv[e] * y[q4 * 4 + e]; hn[q4 * 4 + e] = v; ss += v * v; }
    }
    ss = wave_sum(ss);
    const float rstd = rsqrtf(ss * (1.f / D) + EPS);
    if (layer == 0) {
      const float* modn = p.mod + (size_t)33 * MODW + (size_t)b * MODW + lane * 16;
      const float* gain = p.mix_g + D + lane * 16;
      u32x4 w[2];
#pragma unroll
      for (int q4 = 0; q4 < 4; ++q4) {
        f32x4 hv; hv[0] = hn[q4 * 4]; hv[1] = hn[q4 * 4 + 1]; hv[2] = hn[q4 * 4 + 2]; hv[3] = hn[q4 * 4 + 3];
        *(f32x4*)(hrow + q4 * 4) = hv;
        const f32x4 g = *(const f32x4*)(gain + q4 * 4), s0 = *(const f32x4*)(modn + q4 * 4), s1 = *(const f32x4*)(modn + D + q4 * 4);
        f32x4 yv = hv * rstd * g;
        yv = yv * (1.f + s1) + s0;
        w[q4 >> 1][(q4 & 1) * 2] = cvt_pk_bf16(yv[0], yv[1]); w[q4 >> 1][(q4 & 1) * 2 + 1] = cvt_pk_bf16(yv[2], yv[3]);
      }
      *(u32x4*)(p.act + (size_t)token * D + lane * 16) = w[0];
      *(u32x4*)(p.act + (size_t)token * D + lane * 16 + 8) = w[1];
    } else {
      const float* gain = p.final_g + lane * 16;
#pragma unroll
      for (int q4 = 0; q4 < 4; ++q4) {
        const f32x4 g = *(const f32x4*)(gain + q4 * 4);
        f32x4 o;
#pragma unroll
        for (int e = 0; e < 4; ++e) o[e] = hn[q4 * 4 + e] * rstd * g[e];
        *(f32x4*)(hrow + q4 * 4) = o;
      }
    }
  }
}

constexpr int NPH = 18;
template <int PH>
__device__ __forceinline__ void run_phase(const Params& p, unsigned char* smem, int bid, int nb) {
  if constexpr (PH == 0) phase_prep(p, smem, bid, nb);
  else if constexpr (PH == 1) phase_norm(p, bid, nb, 0, NTOK, p.ctx, p.x, p.mix_g, p.mod, 0, 1);
  else if constexpr (PH == 2) phase_gemm_inproj(p, smem, bid, nb, 0);
  else if constexpr (PH == 3) phase_ret_kv(p, smem, bid, nb);
  else if constexpr (PH == 4) phase_ret_scan(p, bid, nb);
  else if constexpr (PH == 5) phase_ret_out(p, smem, bid, nb);
  else if constexpr (PH == 6) phase_gemm_outproj(p, smem, bid, nb, 0);
  else if constexpr (PH == 7) phase_norm(p, bid, nb, 0, NTOK, p.hctx, p.out, p.ffn_g, p.mod, 3, 4);
  else if constexpr (PH == 8) phase_gemm_pq(p, smem, bid, nb, 0);
  else if constexpr (PH == 9) phase_peer_topk(p, smem, bid, nb, 0, 0, NTOK);
  else if constexpr (PH == 10) phase_peer_gather(p, bid, nb, 0, 0, NTOK);
  else if constexpr (PH == 11) phase_gemm_inproj(p, smem, bid, nb, 1);
  else if constexpr (PH == 12) phase_attn(p, smem, bid, nb);
  else if constexpr (PH == 13) phase_gemm_outproj(p, smem, bid, nb, 1);
  else if constexpr (PH == 14) phase_norm(p, bid, nb, NCTX, NTOK, p.hctx, p.out, p.ffn_g + D, p.mod + (size_t)33 * MODW, 3, 4);
  else if constexpr (PH == 15) phase_gemm_pq(p, smem, bid, nb, 1);
  else if constexpr (PH == 16) phase_peer_topk(p, smem, bid, nb, 1, NCTX, NLAT);
  else if constexpr (PH == 17) phase_peer_gather(p, bid, nb, 1, NCTX, NLAT);
}
template <int PH>
__global__ void __launch_bounds__(NTHREADS) phase_k(Params p) {
  extern __shared__ __attribute__((aligned(16))) unsigned char smem[];
  run_phase<PH>(p, smem, blockIdx.x, gridDim.x);
}
#if MK_ONE_LAUNCH
constexpr int PARAMS_OFF = LDS_BYTES - 512;
static_assert(sizeof(Params) <= 512, "params block");
template <class T>
__device__ __forceinline__ T* uni(T* q) {
  const unsigned long long v = (unsigned long long)q;
  const unsigned lo = __builtin_amdgcn_readfirstlane((unsigned)v), hi = __builtin_amdgcn_readfirstlane((unsigned)(v >> 32));
  return (T*)(((unsigned long long)hi << 32) | lo);
}
__device__ __forceinline__ Params load_params(const unsigned char* smem) {
  const Params* l = (const Params*)(smem + PARAMS_OFF);
  Params q;
  q.x = uni(l->x); q.c = uni(l->c); q.ctx = uni(l->ctx); q.c_ctx = uni(l->c_ctx); q.ada_w = uni(l->ada_w); q.ada_b = uni(l->ada_b);
  q.mix_g = uni(l->mix_g); q.ffn_g = uni(l->ffn_g); q.ev_w_in = uni(l->ev_w_in); q.ev_w_out = uni(l->ev_w_out);
  q.logit_f = uni(l->logit_f); q.logit_b = uni(l->logit_b); q.conv_w = uni(l->conv_w); q.od_w_in = uni(l->od_w_in);
  q.od_w_out = uni(l->od_w_out); q.sinks = uni(l->sinks); q.peer_wq = uni(l->peer_wq); q.keys1 = uni(l->keys1); q.keys2 = uni(l->keys2);
  q.peer_u = uni(l->peer_u); q.peer_v = uni(l->peer_v); q.final_g = uni(l->final_g); q.out = uni(l->out); q.mod = uni(l->mod);
  q.ropec = uni(l->ropec); q.ropes = uni(l->ropes); q.winT0 = uni(l->winT0); q.woutT0 = uni(l->woutT0); q.winT1 = uni(l->winT1);
  q.woutT1 = uni(l->woutT1); q.wqT = uni(l->wqT); q.u8 = uni(l->u8); q.v8 = uni(l->v8); q.uscale = uni(l->uscale); q.vscale = uni(l->vscale); q.hctx = uni(l->hctx); q.act = uni(l->act);
  q.proj = uni(l->proj); q.pq = uni(l->pq); q.sel = uni(l->sel); q.kv = uni(l->kv); q.sprev = uni(l->sprev);
  return q;
}
template <int PH>
__device__ __forceinline__ void run_from(unsigned char* smem, int bid, int nb) {
  {
    const Params q = load_params(smem);
    run_phase<PH>(q, smem, bid, nb);
  }
  if constexpr (PH + 1 < NPH) {
    cg::this_grid().sync();
    run_from<PH + 1>(smem, bid, nb);
  }
}
__global__ void __launch_bounds__(NTHREADS) mega(Params p) {
  extern __shared__ __attribute__((aligned(16))) unsigned char smem[];
  if (threadIdx.x == 0) *(Params*)(smem + PARAMS_OFF) = p;
  __syncthreads();
  run_from<0>(smem, blockIdx.x, gridDim.x);
}
#endif
#ifndef DBG_NPH
#define DBG_NPH 0
#endif
#if DBG_NPH
__global__ void __launch_bounds__(NTHREADS) dbg_sums(Params p, float* scr, int nph) {
  const int wid = threadIdx.x >> 6, lane = threadIdx.x & 63;
  const int gw = blockIdx.x * 8 + wid, nw = gridDim.x * 8;
  if (nph >= 2) for (int r = gw; r < NTOK; r += nw) { float s = 0.f; for (int c = lane; c < D; c += 64) s += bf2f(p.act[(size_t)r * D + c]) * (1 + (c & 7)); s = wave_sum(s); if (lane == 0) scr[r] = s; }
  if (nph >= 3 && nph <= 8) for (int r = gw; r < NTOK; r += nw) { float s = 0.f; for (int c = lane; c < 3072; c += 64) s += bf2f(p.proj[(size_t)r * 3072 + c]) * (1 + (c & 7)); s = wave_sum(s); if (lane == 0) scr[(1 << 20) + r] = s; }
  if (nph >= 12 && nph <= 15) for (int r = gw; r < NTOK; r += nw) { float s = 0.f; for (int c = lane + (r < NCTX ? 1024 : 0); c < 1536; c += 64) s += bf2f(p.proj[(size_t)r * 1536 + c]) * (1 + (c & 7)); s = wave_sum(s); if (lane == 0) scr[(1 << 20) + r] = s; }
  if (nph >= 4) for (int r = gw; r < 2304 * 128; r += nw) { float s = 0.f; for (int c = lane; c < 128; c += 64) s += p.kv[(size_t)r * 128 + c] * (1 + (c & 7)); s = wave_sum(s); if (lane == 0) scr[(2 << 20) + r] = s; }
  if (nph >= 5) for (int r = gw; r < 2304 * 128; r += nw) { float s = 0.f; for (int c = lane; c < 128; c += 64) s += bf2f(p.sprev[(size_t)r * 128 + c]) * (1 + (c & 7)); s = wave_sum(s); if (lane == 0) scr[(3 << 20) + r] = s; }
  if (nph >= 7) for (int r = gw; r < NCTX; r += nw) { float s = 0.f; for (int c = lane; c < D; c += 64) s += p.hctx[(size_t)r * D + c] * (1 + (c & 7)); s = wave_sum(s); if (lane == 0) scr[(4 << 20) + r] = s; }
  if (nph >= 1) for (int i = blockIdx.x * NTHREADS + threadIdx.x; i < 2 * 33 * MODW; i += gridDim.x * NTHREADS) scr[(5 << 20) + i] = p.mod[i];
  if (nph >= 7) for (int r = gw; r < NLAT; r += nw) { float s = 0.f; for (int c = lane; c < D; c += 64) s += p.out[(size_t)r * D + c] * (1 + (c & 7)); s = wave_sum(s); if (lane == 0) scr[(6 << 20) + r] = s; }
  if (nph >= 10 && nph <= 11) for (int r = gw; r < NTOK; r += nw) { float s = 0.f; for (int c = lane; c < 128; c += 64) { const u32x2 e = p.sel[(size_t)r * 128 + c]; s += __uint_as_float(e.y) * (float)(e.x & 1023); } s = wave_sum(s); if (lane == 0) scr[(7 << 20) + r] = s; }
}
__global__ void __launch_bounds__(NTHREADS) dbg_out(Params p, const float* scr) {
  for (size_t i = (size_t)blockIdx.x * NTHREADS + threadIdx.x; i < (size_t)NLAT * D; i += (size_t)gridDim.x * NTHREADS) p.out[i] = (i < (size_t)(8 << 20)) ? scr[i] : 0.f;
}
__global__ void __launch_bounds__(NTHREADS) dbg_zero(float* scr) {
  for (size_t i = (size_t)blockIdx.x * NTHREADS + threadIdx.x; i < (size_t)(8 << 20); i += (size_t)gridDim.x * NTHREADS) scr[i] = 0.f;
}
#endif
template <int PH>
static void launch_phases(const Params& p, int grid, hipStream_t stream) {
  static bool attr_set = false;
  if (!attr_set) { (void)hipFuncSetAttribute((const void*)phase_k<PH>, hipFuncAttributeMaxDynamicSharedMemorySize, LDS_BYTES); attr_set = true; }
  phase_k<PH><<<grid, NTHREADS, LDS_BYTES, stream>>>(p);
  if constexpr (PH + 1 < (DBG_NPH ? DBG_NPH : NPH)) launch_phases<PH + 1>(p, grid, stream);
}

extern "C" void kernel_launch(void* const* d_in, const int* in_sizes, int n_in, void* d_out, int out_size, void* d_ws,
                              size_t ws_size, hipStream_t stream) {
  Params p{};
  const float* const* in = (const float* const*)d_in;
  p.x = in[0]; p.c = in[1]; p.ctx = in[2]; p.c_ctx = in[3]; p.ada_w = in[4]; p.ada_b = in[5]; p.mix_g = in[6]; p.ffn_g = in[7];
  p.ev_w_in = in[8]; p.ev_w_out = in[9]; p.logit_f = in[10]; p.logit_b = in[11]; p.conv_w = in[12]; p.od_w_in = in[13];
  p.od_w_out = in[14]; p.sinks = in[15]; p.peer_wq = in[16]; p.keys1 = in[17]; p.keys2 = in[18]; p.peer_u = in[19];
  p.peer_v = in[20]; p.final_g = in[21];
  p.out = (float*)d_out;
  unsigned char* w = (unsigned char*)d_ws;
  size_t off = 0;
  auto take = [&](size_t bytes) { unsigned char* r = w + off; off += (bytes + 255) & ~(size_t)255; return r; };
  p.mod = (float*)take((size_t)2 * 33 * MODW * 4);
  p.ropec = (float*)take(1024 * 4);
  p.ropes = (float*)take(1024 * 4);
  p.winT0 = (bf16_t*)take((size_t)3072 * 1024 * 2);
  p.woutT0 = (bf16_t*)take((size_t)1024 * 1024 * 2);
  p.winT1 = (bf16_t*)take((size_t)1536 * 1024 * 2);
  p.woutT1 = (bf16_t*)take((size_t)1024 * 1024 * 2);
  p.wqT = (bf16_t*)take((size_t)2 * 1024 * 1024 * 2);
  p.u8 = (unsigned char*)take((size_t)2 * NEXP * D);
  p.v8 = (unsigned char*)take((size_t)2 * NEXP * D);
  p.uscale = (float*)take((size_t)2 * NEXP * 4);
  p.vscale = (float*)take((size_t)2 * NEXP * 4);
  p.hctx = (float*)take((size_t)NCTX * D * 4);
  p.act = (bf16_t*)take((size_t)NTOK * D * 2);
  p.kv = (float*)take((size_t)2304 * 16384 * 4);
  p.sprev = (bf16_t*)take((size_t)2304 * 16384 * 2);
  p.proj = (bf16_t*)take((size_t)NTOK * 3072 * 2);
  p.pq = p.proj;
  p.sel = (u32x2*)((unsigned char*)p.proj + (size_t)NTOK * D * 2);
  if (off > ws_size) { fprintf(stderr, "workspace too small: need %zu have %zu\n", off, ws_size); }

  int grid = 256;
#if MK_ONE_LAUNCH
  static int grid_blocks = 0;
  if (!grid_blocks) {
    (void)hipFuncSetAttribute((const void*)mega, hipFuncAttributeMaxDynamicSharedMemorySize, LDS_BYTES);
    int dev = 0, cus = 0, per_cu = 0;
    (void)hipGetDevice(&dev);
    (void)hipDeviceGetAttribute(&cus, hipDeviceAttributeMultiprocessorCount, dev);
    (void)hipOccupancyMaxActiveBlocksPerMultiprocessor(&per_cu, mega, NTHREADS, LDS_BYTES);
    if (per_cu > 1) per_cu = 1;
    grid_blocks = cus * per_cu;
    if (grid_blocks <= 0) grid_blocks = 256;
  }
  grid = grid_blocks;
  void* args[] = {&p};
  hipError_t e = hipLaunchCooperativeKernel((const void*)mega, dim3(grid), dim3(NTHREADS), args, LDS_BYTES, stream);
  if (e != hipSuccess) fprintf(stderr, "cooperative launch failed: %s\n", hipGetErrorString(e));
#else
  launch_phases<0>(p, grid, stream);
#if DBG_NPH
  float* scr = (float*)(w + off);
  dbg_zero<<<grid, NTHREADS, 0, stream>>>(scr);
  dbg_sums<<<grid, NTHREADS, 0, stream>>>(p, scr, DBG_NPH);
  dbg_out<<<grid, NTHREADS, 0, stream>>>(p, scr);
#endif
#endif
}
```

```cpp
#include <hip/hip_runtime.h>
#include <hip/hip_cooperative_groups.h>
#include <cstdio>
#include <cstdint>
namespace cg = cooperative_groups;

#ifndef MK_ONE_LAUNCH
#define MK_ONE_LAUNCH 1
#endif

typedef unsigned short bf16_t;
typedef short bf16x8 __attribute__((ext_vector_type(8)));
typedef short bf16x2v __attribute__((ext_vector_type(2)));
typedef float f32x4 __attribute__((ext_vector_type(4)));
typedef unsigned u32x4 __attribute__((ext_vector_type(4)));
typedef unsigned u32x2 __attribute__((ext_vector_type(2)));

constexpr int D = 1024, BATCH = 32, SEQ = 2048, CTXL = 256;
constexpr int NCTX = BATCH * CTXL;
constexpr int NLAT = BATCH * SEQ;
constexpr int NTOK = NCTX + NLAT;
constexpr int MODW = 6 * D;
constexpr int NEXP = 16384;
constexpr float EPS = 1e-6f;
constexpr int NTHREADS = 512;
constexpr int LDS_BYTES = 140 * 1024;

struct Params {
  const float *x, *c, *ctx, *c_ctx, *ada_w, *ada_b, *mix_g, *ffn_g, *ev_w_in, *ev_w_out, *logit_f, *logit_b, *conv_w,
      *od_w_in, *od_w_out, *sinks, *peer_wq, *keys1, *keys2, *peer_u, *peer_v, *final_g;
  float* out;
  float* mod;
  float* ropec;
  float* ropes;
  bf16_t* winT0;
  bf16_t* woutT0;
  bf16_t* winT1;
  bf16_t* woutT1;
  bf16_t* wqT;
  unsigned char* u8;
  unsigned char* v8;
  float* uscale;
  float* vscale;
  float* hctx;
  bf16_t* act;
  bf16_t* proj;
  bf16_t* pq;
  u32x2* sel;
  float* kv;
  bf16_t* sprev;
};

typedef __bf16 bf16x2n __attribute__((ext_vector_type(2)));
typedef float f32x2 __attribute__((ext_vector_type(2)));
__device__ __forceinline__ unsigned cvt_pk_bf16(float lo, float hi) {
  f32x2 v = {lo, hi};
  return __builtin_bit_cast(unsigned, __builtin_convertvector(v, bf16x2n));
}
__device__ __forceinline__ float bf_lo(unsigned u) { return __uint_as_float(u << 16); }
__device__ __forceinline__ float bf_hi(unsigned u) { return __uint_as_float(u & 0xffff0000u); }
__device__ __forceinline__ float bf2f(bf16_t h) { return __uint_as_float(((unsigned)h) << 16); }
__device__ __forceinline__ bf16_t f2bf(float f) { return __builtin_bit_cast(unsigned short, (__bf16)f); }

template <int CTRL>
__device__ __forceinline__ float dppf(float x) {
  return __builtin_bit_cast(float, __builtin_amdgcn_mov_dpp(__builtin_bit_cast(int, x), CTRL, 0xf, 0xf, true));
}
__device__ __forceinline__ float row16_sum(float x) {
  x += dppf<0xB1>(x); x += dppf<0x4E>(x); x += dppf<0x141>(x); x += dppf<0x128>(x);
  return x;
}
__device__ __forceinline__ float row16_max(float x) {
  x = fmaxf(x, dppf<0xB1>(x)); x = fmaxf(x, dppf<0x4E>(x)); x = fmaxf(x, dppf<0x141>(x)); x = fmaxf(x, dppf<0x128>(x));
  return x;
}
__device__ __forceinline__ float xrow16_sum(float x) {
  auto s = __builtin_amdgcn_permlane16_swap(__float_as_uint(x), __float_as_uint(x), false, false);
  x = __uint_as_float(s[0]) + __uint_as_float(s[1]);
  auto t = __builtin_amdgcn_permlane32_swap(__float_as_uint(x), __float_as_uint(x), false, false);
  return __uint_as_float(t[0]) + __uint_as_float(t[1]);
}
__device__ __forceinline__ float wave_sum(float x) { return xrow16_sum(row16_sum(x)); }
__device__ __forceinline__ float wave_max(float x) {
  x = row16_max(x);
  auto s = __builtin_amdgcn_permlane16_swap(__float_as_uint(x), __float_as_uint(x), false, false);
  x = fmaxf(__uint_as_float(s[0]), __uint_as_float(s[1]));
  auto t = __builtin_amdgcn_permlane32_swap(__float_as_uint(x), __float_as_uint(x), false, false);
  return fmaxf(__uint_as_float(t[0]), __uint_as_float(t[1]));
}

__device__ __forceinline__ int tidx() {
  int t = threadIdx.x;
  asm volatile("" : "+v"(t));
  __builtin_assume(t >= 0 && t < NTHREADS);
  return t;
}
__device__ __forceinline__ float siluf(float v) { return v / (1.f + __expf(-v)); }
__device__ __forceinline__ float log_sigmoidf(float v) { return -log1pf(expf(-v)); }

#define LAS __attribute__((address_space(3)))
constexpr int BM = 256, BK = 64, HALF = 128, HTB = HALF * BK * 2, NXCD = 8, WGM = 8;
constexpr int KDIM = 1024;

__device__ __forceinline__ int lds_byte(int r, int c) {
  const int st = (r >> 4) * 2 + (c >> 5), rr = r & 15, cc = c & 31, ob = rr * 64 + cc * 2;
  return st * 1024 + (ob ^ (((ob >> 9) & 1) << 5));
}
__device__ __forceinline__ void stage_rc(int b, int& R, int& C) {
  const int st = b / 1024, sb = b % 1024, swz = sb ^ (((sb >> 9) & 1) << 5);
  R = (st >> 1) * 16 + swz / 64;
  C = (st & 1) * 32 + (swz % 64) / 2;
}
struct Sched {
  int pm0, pn0, nM, nN, G, c;
  __device__ __forceinline__ bool next(int i, int& pm, int& pn) const {
    const int nwg = nM * nN;
    const long L = (long)i * G + c;
    if (L >= nwg) return false;
    int wgid = (int)L;
    { const int q = nwg / NXCD, r = nwg % NXCD, xcd = wgid % NXCD, off = wgid / NXCD; wgid = (xcd < r ? xcd * (q + 1) : r * (q + 1) + (xcd - r) * q) + off; }
    const int nig = WGM * nN, gid = wgid / nig, fm = gid * WGM, gsz = (nM - fm) < WGM ? (nM - fm) : WGM;
    pm = pm0 + fm + ((wgid % nig) % gsz);
    pn = pn0 + (wgid % nig) / gsz;
    return true;
  }
};

template <class Epi>
__device__ __forceinline__ void gemm_phase(LAS unsigned char* lds, const bf16_t* __restrict__ Ag, const bf16_t* __restrict__ Btg, const Sched& S, const Epi& E) {
  const int tid = tidx(), wid = __builtin_amdgcn_readfirstlane(tid >> 6), lane = tid & 63, wr = wid >> 2, wc = wid & 3, fr = lane & 15, fq = lane >> 4;
  constexpr int K = KDIM, nt = K / BK;
  unsigned voffA[2];
#pragma unroll
  for (int i = 0; i < 2; ++i) { int R, C; stage_rc(tid * 16 + i * 8192, R, C); voffA[i] = (unsigned)(R * K + C) * 2u; }
  const size_t kstep = (size_t)(BK * 2);
  const size_t hstep = (size_t)HALF * K * 2;
  const size_t tstep = 2 * hstep;
  const unsigned ldsw = (unsigned)wid * 1024u;
  const int aoff = lds_byte(wr * 64 + fr, fq * 8), boff = lds_byte(wc * 32 + fr, fq * 8);
#define G_SA(b, h) (((b) * 2 + (h)) * HTB)
#define G_SB(b, h) ((4 + (b) * 2 + (h)) * HTB)
#define G_STAGE(bufoff, gbase) do { _Pragma("unroll") for (int _i = 0; _i < 2; ++_i) \
    __builtin_amdgcn_global_load_lds((const unsigned*)((const char*)(gbase) + voffA[_i]), (LAS unsigned*)(lds + (bufoff) + ldsw + _i * 8192), 16, 0, 0); } while (0)
#define G_LDA(dst, b, h) do { _Pragma("unroll") for (int m = 0; m < 4; ++m) _Pragma("unroll") for (int k = 0; k < 2; ++k) dst[m][k] = *(const LAS bf16x8*)(lds + G_SA(b, h) + aoff + m * 2048 + k * 1024); } while (0)
#define G_LDB(dst, b, h) do { _Pragma("unroll") for (int n = 0; n < 2; ++n) _Pragma("unroll") for (int k = 0; k < 2; ++k) dst[n][k] = *(const LAS bf16x8*)(lds + G_SB(b, h) + boff + n * 2048 + k * 1024); } while (0)
#define G_MMA(ai, bj, At, Bt) do { __builtin_amdgcn_s_setprio(1); _Pragma("unroll") for (int m = 0; m < 4; ++m) _Pragma("unroll") for (int n = 0; n < 2; ++n) _Pragma("unroll") for (int k = 0; k < 2; ++k) \
    acc[ai][bj][m][n] = __builtin_amdgcn_mfma_f32_16x16x32_bf16(Bt[n][k], At[m][k], acc[ai][bj][m][n], 0, 0, 0); __builtin_amdgcn_s_setprio(0); } while (0)
#define G_WAIT_V(n) asm volatile("s_waitcnt vmcnt(" #n ")" ::: "memory")
#define G_WAIT_L(n) asm volatile("s_waitcnt lgkmcnt(" #n ")" ::: "memory")
#define G_BAR __builtin_amdgcn_s_barrier()
#define G_SCHED __builtin_amdgcn_sched_barrier(0)
  int cpm, cpn, npm, npn, ui = 0;
  if (!S.next(0, cpm, cpn)) return;
  f32x4 acc[2][2][4][2];
#pragma unroll
  for (int a = 0; a < 2; ++a)
#pragma unroll
    for (int b = 0; b < 2; ++b)
#pragma unroll
      for (int m = 0; m < 4; ++m)
#pragma unroll
        for (int n = 0; n < 2; ++n) acc[a][b][m][n] = (f32x4){0.f, 0.f, 0.f, 0.f};
  bf16x8 At[4][2], B0[2][2], B1[2][2];
  const char* cA = (const char*)Ag + (size_t)cpm * tstep;
  const char* cB = (const char*)Btg + (size_t)cpn * tstep;
  G_STAGE(G_SB(0, 0), cB); G_STAGE(G_SA(0, 0), cA); G_STAGE(G_SB(0, 1), cB + hstep); G_STAGE(G_SA(0, 1), cA + hstep);
  if (wr == 1) G_BAR;
  G_WAIT_V(4); G_BAR;
  G_STAGE(G_SB(1, 0), cB + kstep); G_STAGE(G_SA(1, 0), cA + kstep); G_STAGE(G_SB(1, 1), cB + hstep + kstep);
  G_WAIT_V(6); G_BAR;
  for (;;) {
    const bool has_next = S.next(ui + 1, npm, npn);
    const char* nA = has_next ? (const char*)Ag + (size_t)npm * tstep : cA;
    const char* nB = has_next ? (const char*)Btg + (size_t)npn * tstep : cB;
    for (int t = 0; t < nt; t += 2) {
      const bool last = (t == nt - 2);
      const char* a1 = cA + (size_t)(t + 1) * kstep;
      const char* a2 = last ? nA : cA + (size_t)(t + 2) * kstep;
      const char* b2 = last ? nB : cB + (size_t)(t + 2) * kstep;
      const char* a3 = a2 + kstep;
      const char* b3 = b2 + kstep;
      G_LDB(B0, 0, 0); G_SCHED; G_LDA(At, 0, 0); G_STAGE(G_SA(1, 1), a1 + hstep);
      G_WAIT_L(8); G_BAR; G_WAIT_L(0); G_MMA(0, 0, At, B0); G_BAR; G_SCHED;
      G_LDB(B1, 0, 1); G_STAGE(G_SB(0, 0), b2);
      G_BAR; G_WAIT_L(0); G_MMA(0, 1, At, B1); G_BAR;
      G_LDA(At, 0, 1); G_STAGE(G_SA(0, 0), a2);
      G_BAR; G_WAIT_L(0); G_MMA(1, 0, At, B0); G_BAR; G_SCHED;
      G_STAGE(G_SB(0, 1), b2 + hstep);
      G_WAIT_V(6); G_BAR; G_MMA(1, 1, At, B1); G_BAR;
      G_LDB(B0, 1, 0); G_SCHED; G_LDA(At, 1, 0); G_STAGE(G_SA(0, 1), a2 + hstep);
      G_WAIT_L(8); G_BAR; G_WAIT_L(0); G_MMA(0, 0, At, B0); G_BAR; G_SCHED;
      G_LDB(B1, 1, 1); G_STAGE(G_SB(1, 0), b3);
      G_BAR; G_WAIT_L(0); G_MMA(0, 1, At, B1); G_BAR;
      G_LDA(At, 1, 1); G_STAGE(G_SA(1, 0), a3);
      G_BAR; G_WAIT_L(0); G_MMA(1, 0, At, B0); G_BAR; G_SCHED;
      G_STAGE(G_SB(1, 1), b3 + hstep);
      G_WAIT_V(6); G_BAR; G_MMA(1, 1, At, B1); G_BAR;
    }
    E(acc, cpm * BM, cpn * BM, wr, wc, fr, fq);
    if (!has_next) break;
#pragma unroll
    for (int a = 0; a < 2; ++a)
#pragma unroll
      for (int b = 0; b < 2; ++b)
#pragma unroll
        for (int m = 0; m < 4; ++m)
#pragma unroll
          for (int n = 0; n < 2; ++n) acc[a][b][m][n] = (f32x4){0.f, 0.f, 0.f, 0.f};
    cpm = npm; cpn = npn; cA = nA; cB = nB; ++ui;
  }
  G_WAIT_V(0);
  if (wr == 0) G_BAR;
  G_BAR;
#undef G_SA
#undef G_SB
#undef G_STAGE
#undef G_LDA
#undef G_LDB
#undef G_MMA
}

struct EpiInProj {
  bf16_t* P; int ldc; int layer; const float* cosT; const float* sinT;
  __device__ __forceinline__ void operator()(const f32x4 (&acc)[2][2][4][2], int brow, int bcol, int wr, int wc, int fr, int fq) const {
#pragma unroll
    for (int bj = 0; bj < 2; ++bj) {
      const int colbase = bcol + bj * HALF + wc * 32;
      bool rope, scl;
      if (layer == 0) { rope = colbase < 512; scl = (colbase >= 256 && colbase < 512); }
      else { rope = colbase < 1280; scl = colbase < 1024; }
#pragma unroll
      for (int ai = 0; ai < 2; ++ai)
#pragma unroll
        for (int m = 0; m < 4; ++m) {
          const int row = brow + ai * HALF + wr * 64 + m * 16 + fr;
          f32x4 v0 = acc[ai][bj][m][0], v1 = acc[ai][bj][m][1];
          if (rope && row >= NCTX) {
            const int t = (row - NCTX) & (SEQ - 1);
            const int pos = (wc & 1) ? (t & 63) : (t >> 6);
            const f32x4 cs = *(const f32x4*)(cosT + pos * 16 + fq * 4);
            const f32x4 sn = *(const f32x4*)(sinT + pos * 16 + fq * 4);
            const f32x4 o0 = v0 * cs - v1 * sn, o1 = v1 * cs + v0 * sn;
            v0 = o0; v1 = o1;
          }
          if (scl) { v0 *= 0.125f; v1 *= 0.125f; }
          bf16_t* rp = P + (size_t)row * ldc + colbase + fq * 4;
          u32x2 w0, w1;
          w0.x = cvt_pk_bf16(v0[0], v0[1]); w0.y = cvt_pk_bf16(v0[2], v0[3]);
          w1.x = cvt_pk_bf16(v1[0], v1[1]); w1.y = cvt_pk_bf16(v1[2], v1[3]);
          *(u32x2*)rp = w0;
          *(u32x2*)(rp + 16) = w1;
        }
    }
  }
};
struct EpiBf16 {
  bf16_t* P; int ldc;
  __device__ __forceinline__ void operator()(const f32x4 (&acc)[2][2][4][2], int brow, int bcol, int wr, int wc, int fr, int fq) const {
#pragma unroll
    for (int ai = 0; ai < 2; ++ai)
#pragma unroll
      for (int m = 0; m < 4; ++m) {
        const int row = brow + ai * HALF + wr * 64 + m * 16 + fr;
#pragma unroll
        for (int bj = 0; bj < 2; ++bj)
#pragma unroll
          for (int n = 0; n < 2; ++n) {
            const f32x4 v = acc[ai][bj][m][n];
            u32x2 w; w.x = cvt_pk_bf16(v[0], v[1]); w.y = cvt_pk_bf16(v[2], v[3]);
            *(u32x2*)(P + (size_t)row * ldc + bcol + bj * HALF + wc * 32 + n * 16 + fq * 4) = w;
          }
      }
  }
};
struct EpiResid {
  const float* hin_ctx; const float* hin_lat; float* hout_ctx; float* hout_lat; const float* gate;
  __device__ __forceinline__ void operator()(const f32x4 (&acc)[2][2][4][2], int brow, int bcol, int wr, int wc, int fr, int fq) const {
    const bool isctx = brow < NCTX;
    const int b = isctx ? 32 : ((brow - NCTX) >> 11);
    const float* hin = isctx ? hin_ctx + (size_t)brow * D : hin_lat + (size_t)(brow - NCTX) * D;
    float* hout = isctx ? hout_ctx + (size_t)brow * D : hout_lat + (size_t)(brow - NCTX) * D;
    const float* g = gate + (size_t)b * MODW;
#pragma unroll
    for (int bj = 0; bj < 2; ++bj)
#pragma unroll
      for (int n = 0; n < 2; ++n) {
        const int col = bcol + bj * HALF + wc * 32 + n * 16 + fq * 4;
        const f32x4 gv = *(const f32x4*)(g + col);
#pragma unroll
        for (int ai = 0; ai < 2; ++ai)
#pragma unroll
          for (int m = 0; m < 4; ++m) {
            const int r = ai * HALF + wr * 64 + m * 16 + fr;
            const f32x4 h = *(const f32x4*)(hin + (size_t)r * D + col);
            *(f32x4*)(hout + (size_t)r * D + col) = h + gv * acc[ai][bj][m][n];
          }
      }
  }
};

template <int MT, int NT>
__device__ __forceinline__ void mm_lds(const bf16_t* A, int lda, const bf16_t* B, int ldb, int K, f32x4 (&acc)[MT][NT], int fr, int fq) {
  for (int k0 = 0; k0 < K; k0 += 32) {
    bf16x8 af[MT], bf[NT];
#pragma unroll
    for (int m = 0; m < MT; ++m) af[m] = *(const bf16x8*)(A + (m * 16 + fr) * lda + k0 + fq * 8);
#pragma unroll
    for (int n = 0; n < NT; ++n) bf[n] = *(const bf16x8*)(B + (n * 16 + fr) * ldb + k0 + fq * 8);
#pragma unroll
    for (int m = 0; m < MT; ++m)
#pragma unroll
      for (int n = 0; n < NT; ++n) acc[m][n] = __builtin_amdgcn_mfma_f32_16x16x32_bf16(af[m], bf[n], acc[m][n], 0, 0, 0);
  }
}

__device__ void phase_prep(const Params& p, unsigned char* smem, int bid, int nb) {
  const int tid = tidx();
  for (int it = bid; it < 2 * 96; it += nb) {
    const int layer = it / 96, n0 = (it % 96) * 64;
    float* s = (float*)smem;
    for (int i = tid; i < 33 * 1024; i += NTHREADS) {
      const int b = i >> 10, k = i & 1023;
      const float v = (b < 32) ? p.c[b * 1024 + k] : p.c_ctx[k];
      s[k * 33 + b] = siluf(v);
    }
    __syncthreads();
    const int col = tid & 63, kg = tid >> 6;
    float acc[33];
#pragma unroll
    for (int b = 0; b < 33; ++b) acc[b] = 0.f;
    const float* W = p.ada_w + (size_t)layer * 1024 * MODW + n0 + col;
    for (int k = kg * 128; k < kg * 128 + 128; ++k) {
      const float w = W[(size_t)k * MODW];
      const float* sk = s + k * 33;
#pragma unroll
      for (int b = 0; b < 33; ++b) acc[b] += sk[b] * w;
    }
    __syncthreads();
    float* red = (float*)smem;
#pragma unroll
    for (int b = 0; b < 33; ++b) red[(kg * 33 + b) * 64 + col] = acc[b];
    __syncthreads();
    for (int i = tid; i < 33 * 64; i += NTHREADS) {
      const int b = i >> 6, cc = i & 63;
      float t = p.ada_b[layer * MODW + n0 + cc];
#pragma unroll
      for (int g = 0; g < 8; ++g) t += red[(g * 33 + b) * 64 + cc];
      p.mod[((size_t)layer * 33 + b) * MODW + n0 + cc] = t;
    }
    __syncthreads();
  }
  if (bid == nb - 1) {
    for (int i = tid; i < 1024; i += NTHREADS) {
      const int pos = i >> 4, f = i & 15;
      const float inv = powf(10000.f, -(float)f / 16.f);
      const float ang = (float)pos * inv;
      p.ropec[i] = cosf(ang);
      p.ropes[i] = sinf(ang);
    }
  }
  {
    float* tile = (float*)smem;
    const int ntile_total = 768 + 256 + 384 + 256 + 512;
    for (int it = bid; it < ntile_total; it += nb) {
      const float* src; bf16_t* dst; int N, ti;
      if (it < 768) { src = p.ev_w_in; dst = p.winT0; N = 3072; ti = it; }
      else if (it < 1024) { src = p.ev_w_out; dst = p.woutT0; N = 1024; ti = it - 768; }
      else if (it < 1408) { src = p.od_w_in; dst = p.winT1; N = 1536; ti = it - 1024; }
      else if (it < 1664) { src = p.od_w_out; dst = p.woutT1; N = 1024; ti = it - 1408; }
      else { const int l = (it - 1664) / 256; src = p.peer_wq + (size_t)l * 1024 * 1024; dst = p.wqT + (size_t)l * 1024 * 1024; N = 1024; ti = (it - 1664) % 256; }
      const int ntn = N / 64, tk = ti / ntn, tn = ti % ntn;
      __syncthreads();
      for (int i = tid; i < 64 * 64; i += NTHREADS) {
        const int r = i >> 6, cc = i & 63;
        tile[r * 65 + cc] = src[(size_t)(tk * 64 + r) * N + tn * 64 + cc];
      }
      __syncthreads();
      for (int i = tid; i < 64 * 32; i += NTHREADS) {
        const int nn = i >> 5, kk = (i & 31) * 2;
        const unsigned w = cvt_pk_bf16(tile[kk * 65 + nn], tile[(kk + 1) * 65 + nn]);
        *(unsigned*)(dst + (size_t)(tn * 64 + nn) * 1024 + tk * 64 + kk) = w;
      }
    }
    __syncthreads();
  }
  {
    const int wid = tid >> 6, lane = tid & 63;
    for (int r = bid * 8 + wid; r < 4 * NEXP; r += nb * 8) {
      const bool isv = r >= 2 * NEXP;
      const int rr = isv ? r - 2 * NEXP : r;
      const float* src = (isv ? p.peer_v : p.peer_u) + (size_t)rr * D + lane * 16;
      f32x4 a[4];
      float mx = 0.f;
#pragma unroll
      for (int i = 0; i < 4; ++i) {
        a[i] = *(const f32x4*)(src + i * 4);
        mx = fmaxf(mx, fmaxf(fmaxf(fabsf(a[i][0]), fabsf(a[i][1])), fmaxf(fabsf(a[i][2]), fabsf(a[i][3]))));
      }
      mx = wave_max(mx);
      const float sc = mx > 0.f ? 240.f / mx : 1.f;
      u32x4 w;
#pragma unroll
      for (int i = 0; i < 4; ++i) {
        int t = __builtin_amdgcn_cvt_pk_fp8_f32(a[i][0] * sc, a[i][1] * sc, 0, false);
        t = __builtin_amdgcn_cvt_pk_fp8_f32(a[i][2] * sc, a[i][3] * sc, t, true);
        w[i] = (unsigned)t;
      }
      *(u32x4*)((isv ? p.v8 : p.u8) + (size_t)rr * D + lane * 16) = w;
      if (lane == 0) (isv ? p.vscale : p.uscale)[rr] = mx > 0.f ? mx / 240.f : 1.f;
    }
  }
}

__device__ void phase_norm(const Params& p, int bid, int nb, int row0, int row1, const float* hctx, const float* hlat,
                           const float* gain, const float* modl, int ish, int isc) {
  const int tid0 = tidx();
  const int wid = tid0 >> 6, lane = tid0 & 63;
  for (int row = row0 + bid * 8 + wid; row < row1; row += nb * 8) {
    const bool isctx = row < NCTX;
    const float* h = isctx ? hctx + (size_t)row * D : hlat + (size_t)(row - NCTX) * D;
    const int b = isctx ? 32 : ((row - NCTX) >> 11);
    const float* sh = modl + (size_t)b * MODW + ish * D;
    const float* sc = modl + (size_t)b * MODW + isc * D;
    f32x4 v[4];
    float ss = 0.f;
#pragma unroll
    for (int i = 0; i < 4; ++i) {
      v[i] = *(const f32x4*)(h + i * 256 + lane * 4);
      ss += v[i][0] * v[i][0] + v[i][1] * v[i][1] + v[i][2] * v[i][2] + v[i][3] * v[i][3];
    }
    ss = wave_sum(ss);
    const float rstd = rsqrtf(ss * (1.f / D) + EPS);
#pragma unroll
    for (int i = 0; i < 4; ++i) {
      const int col = i * 256 + lane * 4;
      const f32x4 g = *(const f32x4*)(gain + col), s1 = *(const f32x4*)(sc + col), s0 = *(const f32x4*)(sh + col);
      f32x4 y = v[i] * rstd * g;
      y = y * (1.f + s1) + s0;
      u32x2 w; w.x = cvt_pk_bf16(y[0], y[1]); w.y = cvt_pk_bf16(y[2], y[3]);
      *(u32x2*)(p.act + (size_t)row * D + col) = w;
    }
  }
}

__device__ __forceinline__ void phase_gemm_inproj(const Params& p, unsigned char* smem, int bid, int nb, int layer) {
  LAS unsigned char* lds = (LAS unsigned char*)smem;
  if (layer == 0) {
    EpiInProj epi{p.proj, 3072, 0, p.ropec, p.ropes};
    Sched s{0, 0, NTOK / BM, 12, nb, bid};
    gemm_phase(lds, p.act, p.winT0, s, epi);
  } else {
    EpiInProj epi{p.proj, 1536, 1, p.ropec, p.ropes};
    Sched s{NCTX / BM, 0, NLAT / BM, 6, nb, bid};
    gemm_phase(lds, p.act, p.winT1, s, epi);
    Sched s2{0, 4, NCTX / BM, 2, nb, bid};
    gemm_phase(lds, p.act, p.winT1, s2, epi);
  }
}
__device__ __forceinline__ void phase_gemm_outproj(const Params& p, unsigned char* smem, int bid, int nb, int layer) {
  LAS unsigned char* lds = (LAS unsigned char*)smem;
  if (layer == 0) {
    EpiResid epi{p.ctx, p.x, p.hctx, p.out, p.mod + 2 * D};
    Sched s{0, 0, NTOK / BM, 4, nb, bid};
    gemm_phase(lds, p.act, p.woutT0, s, epi);
  } else {
    EpiResid epi{p.hctx, p.out, p.hctx, p.out, p.mod + (size_t)33 * MODW + 2 * D};
    Sched s{NCTX / BM, 0, NLAT / BM, 4, nb, bid};
    gemm_phase(lds, p.act, p.woutT1, s, epi);
  }
}
__device__ __forceinline__ void phase_gemm_pq(const Params& p, unsigned char* smem, int bid, int nb, int layer) {
  LAS unsigned char* lds = (LAS unsigned char*)smem;
  EpiBf16 epi{p.pq, D};
  const int pm0 = layer == 0 ? 0 : NCTX / BM;
  Sched s{pm0, 0, NTOK / BM - pm0, 4, nb, bid};
  gemm_phase(lds, p.act, p.wqT + (size_t)layer * D * D, s, epi);
}

__device__ __forceinline__ int chunk_row0(int b, int cc) { return cc < 2 ? b * CTXL + cc * 128 : NCTX + b * SEQ + (cc - 2) * 128; }

constexpr int LDP = 136;
constexpr int LDK = 72;

__device__ void phase_ret_kv(const Params& p, unsigned char* smem, int bid, int nb) {
  const int tid = tidx(), wid = tid >> 6, lane = tid & 63, fr = lane & 15, fq = lane >> 4;
  bf16_t* KxT = (bf16_t*)smem;
  bf16_t* VT = KxT + 128 * LDP;
  for (int it = bid; it < BATCH * 4 * 18; it += nb) {
    const int cc = it % 18, h = (it / 18) & 3, b = it / 72;
    const int row0 = chunk_row0(b, cc);
    const float lf = log_sigmoidf(p.logit_f[h]), lb = log_sigmoidf(p.logit_b[h]);
    __syncthreads();
    for (int task = tid; task < 128 * 8; task += NTHREADS) {
      const int j = task >> 3, d0 = (task & 7) * 8;
      const u32x4 kk = *(const u32x4*)(p.proj + (size_t)(row0 + j) * 3072 + 256 + h * 64 + d0);
      const float zf = __expf(lf * (float)(127 - j)), zb = __expf(lb * (float)j);
#pragma unroll
      for (int q = 0; q < 4; ++q) {
        const float lo = bf_lo(kk[q]), hi = bf_hi(kk[q]);
        KxT[(d0 + 2 * q) * LDP + j] = f2bf(lo * zf);
        KxT[(d0 + 2 * q + 1) * LDP + j] = f2bf(hi * zf);
        KxT[(64 + d0 + 2 * q) * LDP + j] = f2bf(lo * zb);
        KxT[(64 + d0 + 2 * q + 1) * LDP + j] = f2bf(hi * zb);
      }
    }
    for (int task = tid; task < 128 * 16; task += NTHREADS) {
      const int j = task >> 4, e0 = (task & 15) * 8;
      const u32x4 vv = *(const u32x4*)(p.proj + (size_t)(row0 + j) * 3072 + 512 + h * 128 + e0);
#pragma unroll
      for (int q = 0; q < 4; ++q) {
        VT[(e0 + 2 * q) * LDP + j] = (bf16_t)(vv[q] & 0xffffu);
        VT[(e0 + 2 * q + 1) * LDP + j] = (bf16_t)(vv[q] >> 16);
      }
    }
    __syncthreads();
    f32x4 acc[1][8] = {};
    mm_lds<1, 8>(VT + wid * 16 * LDP, LDP, KxT, LDP, 128, acc, fr, fq);
    float* out = p.kv + (size_t)it * 16384;
#pragma unroll
    for (int n = 0; n < 8; ++n)
#pragma unroll
      for (int j = 0; j < 4; ++j) out[(wid * 16 + fq * 4 + j) * 128 + n * 16 + fr] = acc[0][n][j];
  }
  for (size_t task = (size_t)bid * NTHREADS + tid; task < (size_t)NTOK * 64; task += (size_t)nb * NTHREADS) {
    const int row = (int)(task >> 6), c0 = (int)(task & 63) * 8;
    const int tin = row < NCTX ? (row & (CTXL - 1)) : ((row - NCTX) & (SEQ - 1));
    const int tlen = row < NCTX ? CTXL : SEQ;
    const bf16_t* pr = p.proj + (size_t)row * 3072;
    const u32x4 gb = *(const u32x4*)(pr + 1536 + c0);
    float accv[8];
#pragma unroll
    for (int q = 0; q < 8; ++q) accv[q] = 0.f;
#pragma unroll
    for (int dt = -1; dt <= 1; ++dt) {
      if (tin + dt < 0 || tin + dt >= tlen) continue;
      const bf16_t* pr2 = pr + (ptrdiff_t)dt * 3072;
      const u32x4 gc = *(const u32x4*)(pr2 + 2048 + c0), xt = *(const u32x4*)(pr2 + 2560 + c0);
      const float* w = p.conv_w + (dt + 1) * 512 + c0;
      const f32x4 wa = *(const f32x4*)w, wb = *(const f32x4*)(w + 4);
#pragma unroll
      for (int q = 0; q < 4; ++q) {
        const float u0 = bf_lo(gc[q]) * bf_lo(xt[q]), u1 = bf_hi(gc[q]) * bf_hi(xt[q]);
        const float w0 = (2 * q < 4) ? wa[2 * q] : wb[2 * q - 4], w1 = (2 * q + 1 < 4) ? wa[2 * q + 1] : wb[2 * q + 1 - 4];
        accv[2 * q] += w0 * u0;
        accv[2 * q + 1] += w1 * u1;
      }
    }
    u32x4 o;
#pragma unroll
    for (int q = 0; q < 4; ++q) o[q] = cvt_pk_bf16(bf_lo(gb[q]) * accv[2 * q], bf_hi(gb[q]) * accv[2 * q + 1]);
#ifdef ZERO_CONV
    o = (u32x4){0u, 0u, 0u, 0u};
#endif
    *(u32x4*)(p.act + (size_t)row * D + 512 + c0) = o;
  }
}

__device__ void phase_ret_scan(const Params& p, int bid, int nb) {
  const int tid = tidx();
  for (size_t idx = (size_t)bid * NTHREADS + tid; idx < (size_t)BATCH * 4 * 16384; idx += (size_t)nb * NTHREADS) {
    const int el = (int)(idx & 16383), bh = (int)(idx >> 14), h = bh & 3;
    const bool fwd = (el & 127) < 64;
    const float lg = log_sigmoidf(fwd ? p.logit_f[h] : p.logit_b[h]);
    const float dec = __expf(lg * 128.f);
    float st = 0.f;
    for (int s = 0; s < 18; ++s) {
      const int cc = fwd ? s : (s < 2 ? 1 - s : 19 - s);
      const size_t off = ((size_t)bh * 18 + cc) * 16384 + el;
      p.sprev[off] = f2bf(st);
      st = dec * st + p.kv[off];
    }
  }
}

__device__ void phase_ret_out(const Params& p, unsigned char* smem, int bid, int nb) {
  const int tid = tidx(), wid = tid >> 6, lane = tid & 63, fr = lane & 15, fq = lane >> 4;
  bf16_t* Kt = (bf16_t*)smem;
  bf16_t* VT = Kt + 128 * LDK;
  bf16_t* ST = VT + 128 * LDP;
  bf16_t* Pb = ST + 128 * LDP;
  for (int it = bid; it < BATCH * 4 * 18; it += nb) {
    const int cc = it % 18, h = (it / 18) & 3, b = it / 72;
    const int row0 = chunk_row0(b, cc);
    const float lf = log_sigmoidf(p.logit_f[h]), lb = log_sigmoidf(p.logit_b[h]);
    __syncthreads();
    for (int task = tid; task < 128 * 8; task += NTHREADS) {
      const int j = task >> 3, d0 = (task & 7) * 8;
      *(u32x4*)(Kt + j * LDK + d0) = *(const u32x4*)(p.proj + (size_t)(row0 + j) * 3072 + 256 + h * 64 + d0);
    }
    for (int task = tid; task < 128 * 16; task += NTHREADS) {
      const int j = task >> 4, e0 = (task & 15) * 8;
      const u32x4 vv = *(const u32x4*)(p.proj + (size_t)(row0 + j) * 3072 + 512 + h * 128 + e0);
#pragma unroll
      for (int q = 0; q < 4; ++q) {
        VT[(e0 + 2 * q) * LDP + j] = (bf16_t)(vv[q] & 0xffffu);
        VT[(e0 + 2 * q + 1) * LDP + j] = (bf16_t)(vv[q] >> 16);
      }
      const int e = j;
      *(u32x4*)(ST + e * LDP + e0) = *(const u32x4*)(p.sprev + (size_t)it * 16384 + e * 128 + e0);
    }
    const int irow = wid * 16 + fr;
    bf16x8 qf[2];
#pragma unroll
    for (int ks = 0; ks < 2; ++ks) qf[ks] = *(const bf16x8*)(p.proj + (size_t)(row0 + irow) * 3072 + h * 64 + ks * 32 + fq * 8);
    __syncthreads();
    f32x4 sacc[8] = {};
#pragma unroll
    for (int ks = 0; ks < 2; ++ks)
#pragma unroll
      for (int n = 0; n < 8; ++n) {
        const bf16x8 kf = *(const bf16x8*)(Kt + (n * 16 + fr) * LDK + ks * 32 + fq * 8);
        sacc[n] = __builtin_amdgcn_mfma_f32_16x16x32_bf16(qf[ks], kf, sacc[n], 0, 0, 0);
      }
#pragma unroll
    for (int n = 0; n < 8; ++n)
#pragma unroll
      for (int jj = 0; jj < 4; ++jj) {
        const int i = wid * 16 + fq * 4 + jj, j = n * 16 + fr;
        const int df = i - j;
        const float dm = df > 0 ? __expf(lf * (float)df) : (df < 0 ? __expf(lb * (float)(-df)) : 2.f);
        Pb[i * LDP + j] = f2bf(sacc[n][jj] * dm);
      }
    __syncthreads();
    f32x4 oacc[1][8] = {};
    mm_lds<1, 8>(Pb + wid * 16 * LDP, LDP, VT, LDP, 128, oacc, fr, fq);
    {
      const float xf = __expf(lf * (float)(irow + 1)), xb = __expf(lb * (float)(128 - irow));
#pragma unroll
      for (int ks = 0; ks < 4; ++ks) {
        const float sc = ks < 2 ? xf : xb;
        const bf16x8 qs = qf[ks & 1];
        u32x4 qu = __builtin_bit_cast(u32x4, qs), qo;
#pragma unroll
        for (int q = 0; q < 4; ++q) qo[q] = cvt_pk_bf16(bf_lo(qu[q]) * sc, bf_hi(qu[q]) * sc);
        const bf16x8 qx = __builtin_bit_cast(bf16x8, qo);
#pragma unroll
        for (int n = 0; n < 8; ++n) {
          const bf16x8 sf = *(const bf16x8*)(ST + (n * 16 + fr) * LDP + ks * 32 + fq * 8);
          oacc[0][n] = __builtin_amdgcn_mfma_f32_16x16x32_bf16(qx, sf, oacc[0][n], 0, 0, 0);
        }
      }
    }
#pragma unroll
    for (int jj = 0; jj < 4; ++jj) {
      float ss = 0.f;
#pragma unroll
      for (int n = 0; n < 8; ++n) ss += oacc[0][n][jj] * oacc[0][n][jj];
      ss = row16_sum(ss);
      const float rstd = rsqrtf(ss * (1.f / 128.f) + EPS);
      const int row = row0 + wid * 16 + fq * 4 + jj;
#pragma unroll
      for (int n = 0; n < 8; ++n) {
        const int e = n * 16 + fr;
        const float g = bf2f(p.proj[(size_t)row * 3072 + 1024 + h * 128 + e]);
#ifdef ZERO_RET
        p.act[(size_t)row * D + h * 128 + e] = 0;
#else
        p.act[(size_t)row * D + h * 128 + e] = f2bf(oacc[0][n][jj] * rstd * siluf(g));
#endif
      }
    }
  }
}

__device__ void phase_attn(const Params& p, unsigned char* smem, int bid, int nb) {
  const int tid = tidx(), wid = tid >> 6, lane = tid & 63, fr = lane & 15, fq = lane >> 4;
  bf16_t* Kt = (bf16_t*)smem;
  bf16_t* VT = Kt + 64 * LDK;
  bf16_t* Pw = VT + 64 * LDK + wid * 64 * LDK;
  for (int it = bid; it < BATCH * 16 * 4; it += nb) {
    const int kvh = it & 3, qb = (it >> 2) & 15, b = it >> 6;
    const int hq = kvh * 4 + (wid >> 1);
    const int q0 = qb * 128 + (wid & 1) * 64;
    const size_t latrow0 = (size_t)NCTX + (size_t)b * SEQ;
    bf16x8 qf[4][2];
#pragma unroll
    for (int m = 0; m < 4; ++m)
#pragma unroll
      for (int ks = 0; ks < 2; ++ks)
        qf[m][ks] = *(const bf16x8*)(p.proj + (latrow0 + q0 + m * 16 + fr) * 1536 + hq * 64 + ks * 32 + fq * 8);
    const float sink = p.sinks[hq];
    float mrow[4][4], lrow[4][4];
    f32x4 oacc[4][4] = {};
#pragma unroll
    for (int m = 0; m < 4; ++m)
#pragma unroll
      for (int jj = 0; jj < 4; ++jj) { mrow[m][jj] = sink; lrow[m][jj] = (fr == 0) ? 1.f : 0.f; }
    for (int tt = 0; tt < 10; ++tt) {
      const bool win = tt < 6;
      const int kpos0 = win ? qb * 128 - 128 + 64 * tt : (tt - 6) * 64;
      if (win && (kpos0 < 0 || kpos0 >= SEQ)) continue;
      const size_t krow0 = win ? latrow0 + kpos0 : (size_t)b * CTXL + kpos0;
      __syncthreads();
      {
        const int j = tid >> 3, d0 = (tid & 7) * 8;
        *(u32x4*)(Kt + j * LDK + d0) = *(const u32x4*)(p.proj + (krow0 + j) * 1536 + 1024 + kvh * 64 + d0);
        const u32x4 vv = *(const u32x4*)(p.proj + (krow0 + j) * 1536 + 1280 + kvh * 64 + d0);
#pragma unroll
        for (int q = 0; q < 4; ++q) {
          VT[(d0 + 2 * q) * LDK + j] = (bf16_t)(vv[q] & 0xffffu);
          VT[(d0 + 2 * q + 1) * LDK + j] = (bf16_t)(vv[q] >> 16);
        }
      }
      __syncthreads();
#pragma unroll
      for (int m = 0; m < 4; ++m) {
        f32x4 sacc[4];
#pragma unroll
        for (int n = 0; n < 4; ++n) sacc[n] = (f32x4){0.f, 0.f, 0.f, 0.f};
#pragma unroll
        for (int ks = 0; ks < 2; ++ks)
#pragma unroll
          for (int n = 0; n < 4; ++n) {
            const bf16x8 kf = *(const bf16x8*)(Kt + (n * 16 + fr) * LDK + ks * 32 + fq * 8);
            sacc[n] = __builtin_amdgcn_mfma_f32_16x16x32_bf16(qf[m][ks], kf, sacc[n], 0, 0, 0);
          }
#pragma unroll
        for (int jj = 0; jj < 4; ++jj) {
          const int qpos = q0 + m * 16 + fq * 4 + jj;
          float mx = -3.0e38f;
#pragma unroll
          for (int n = 0; n < 4; ++n) {
            float s = sacc[n][jj];
            if (win) { const int dd = qpos - (kpos0 + n * 16 + fr); if (dd > 128 || dd < -128) s = -1e30f; }
            sacc[n][jj] = s;
            mx = fmaxf(mx, s);
          }
          mx = row16_max(mx);
          const float mnew = fmaxf(mrow[m][jj], mx);
          const float alpha = __expf(mrow[m][jj] - mnew);
          mrow[m][jj] = mnew;
          float ls = 0.f;
#pragma unroll
          for (int n = 0; n < 4; ++n) {
            const float pv = __expf(sacc[n][jj] - mnew);
            ls += pv;
            Pw[(m * 16 + fq * 4 + jj) * LDK + n * 16 + fr] = f2bf(pv);
          }
          lrow[m][jj] = lrow[m][jj] * alpha + ls;
#pragma unroll
          for (int n = 0; n < 4; ++n) oacc[m][n][jj] *= alpha;
        }
      }
      __syncthreads();
      mm_lds<4, 4>(Pw, LDK, VT, LDK, 64, oacc, fr, fq);
    }
#pragma unroll
    for (int m = 0; m < 4; ++m)
#pragma unroll
      for (int jj = 0; jj < 4; ++jj) {
        const float l = row16_sum(lrow[m][jj]);
        const float inv = 1.f / l;
        const size_t row = latrow0 + q0 + m * 16 + fq * 4 + jj;
#pragma unroll
        for (int n = 0; n < 4; ++n) {
#ifdef ZERO_ATTN
          p.act[row * D + hq * 64 + n * 16 + fr] = 0;
#else
          p.act[row * D + hq * 64 + n * 16 + fr] = f2bf(oacc[m][n][jj] * inv);
#endif
        }
      }
  }
}

__device__ __forceinline__ unsigned f2ord(float f) { const unsigned u = __float_as_uint(f); return (u & 0x80000000u) ? ~u : (u | 0x80000000u); }
__device__ __forceinline__ float ord2f(unsigned k) { const unsigned u = (k & 0x80000000u) ? (k & 0x7fffffffu) : ~k; return __uint_as_float(u); }

__device__ void phase_peer_topk(const Params& p, unsigned char* smem, int bid, int nb, int layer, int tok0, int ntok) {
  const int tid = tidx(), wid = tid >> 6, lane = tid & 63;
  float* keys = (float*)smem;
  unsigned* lists = (unsigned*)(smem + 65536);
  const int nitem = (ntok / 256) * 8;
  for (int it = bid; it < nitem; it += nb) {
    const int h = it & 7, tile = it >> 3;
    const int set = wid >> 2, tl = (wid & 3) * 64 + lane;
    const int token = tok0 + tile * 256 + tl;
    __syncthreads();
    {
      const float* k1 = p.keys1 + ((size_t)layer * 8 + h) * 8192;
      const float* k2 = p.keys2 + ((size_t)layer * 8 + h) * 8192;
      for (int i = tid; i < 2048; i += NTHREADS) {
        *(f32x4*)(keys + i * 4) = *(const f32x4*)(k1 + i * 4);
        *(f32x4*)(keys + 8192 + i * 4) = *(const f32x4*)(k2 + i * 4);
      }
    }
    float q[64];
    {
      const bf16_t* qp = p.pq + (size_t)token * D + h * 128 + set * 64;
#pragma unroll
      for (int c8 = 0; c8 < 8; ++c8) {
        const u32x4 w = *(const u32x4*)(qp + c8 * 8);
#pragma unroll
        for (int qq = 0; qq < 4; ++qq) { q[c8 * 8 + 2 * qq] = bf_lo(w[qq]); q[c8 * 8 + 2 * qq + 1] = bf_hi(w[qq]); }
      }
    }
    __syncthreads();
    unsigned top[16];
#pragma unroll
    for (int i = 0; i < 16; ++i) top[i] = 0u;
    const float* kb = keys + set * 8192;
    for (int k = 0; k < 128; ++k) {
      float s0 = 0.f, s1 = 0.f;
#pragma unroll
      for (int d4 = 0; d4 < 16; ++d4) {
        const f32x4 kv = *(const f32x4*)(kb + k * 64 + d4 * 4);
        s0 += q[d4 * 4] * kv[0]; s1 += q[d4 * 4 + 1] * kv[1];
        s0 += q[d4 * 4 + 2] * kv[2]; s1 += q[d4 * 4 + 3] * kv[3];
      }
      unsigned v = (f2ord(s0 + s1) & 0xffffff80u) | (unsigned)(127 - k);
#pragma unroll
      for (int i = 0; i < 16; ++i) { const unsigned hi = max(top[i], v); v = min(top[i], v); top[i] = hi; }
    }
    unsigned* mylist = lists + ((size_t)set * 256 + tl) * 16;
#pragma unroll
    for (int i = 0; i < 4; ++i) { u32x4 w; w.x = top[4 * i]; w.y = top[4 * i + 1]; w.z = top[4 * i + 2]; w.w = top[4 * i + 3]; *(u32x4*)(mylist + 4 * i) = w; }
    __syncthreads();
    if (set == 0) {
      unsigned o2[16];
      const unsigned* other = lists + ((size_t)256 + tl) * 16;
#pragma unroll
      for (int i = 0; i < 4; ++i) { const u32x4 w = *(const u32x4*)(other + 4 * i); o2[4 * i] = w.x; o2[4 * i + 1] = w.y; o2[4 * i + 2] = w.z; o2[4 * i + 3] = w.w; }
      float v1[16], v2[16];
#pragma unroll
      for (int i = 0; i < 16; ++i) { v1[i] = ord2f(top[i] & 0xffffff80u); v2[i] = ord2f(o2[i] & 0xffffff80u); }
      unsigned ct[16];
#pragma unroll
      for (int i = 0; i < 16; ++i) ct[i] = 0u;
#pragma unroll
      for (int i = 0; i < 16; ++i)
#pragma unroll
        for (int j = 0; j < 16; ++j) {
          if ((i + 1) * (j + 1) <= 16) {
            unsigned v = (f2ord(v1[i] + v2[j]) & 0xffffff00u) | (unsigned)(255 - (i * 16 + j));
#pragma unroll
            for (int r = 0; r < 16; ++r) { const unsigned hi = max(ct[r], v); v = min(ct[r], v); ct[r] = hi; }
          }
        }
      float cs[16], den = 0.f;
      const float mx = ord2f(ct[0] & 0xffffff00u);
#pragma unroll
      for (int r = 0; r < 16; ++r) { cs[r] = __expf(ord2f(ct[r] & 0xffffff00u) - mx); den += cs[r]; }
      const float inv = 1.f / den;
      u32x2* so = p.sel + (size_t)token * 128 + h * 16;
      const unsigned* l1 = lists + (size_t)tl * 16;
#pragma unroll
      for (int r = 0; r < 16; ++r) {
        const unsigned ci = 255u - (ct[r] & 0xffu);
        const unsigned e1 = 127u - (l1[ci >> 4] & 0x7fu), e2 = 127u - (other[ci & 15u] & 0x7fu);
        u32x2 w; w.x = e1 * 128u + e2; w.y = __float_as_uint(cs[r] * inv);
        so[r] = w;
      }
    }
  }
}

__device__ __forceinline__ float gelu_as(float v) {
  const float av = fabsf(v), t = __builtin_amdgcn_rcpf(av * 0.2316418882f + 1.0f);
  float q = t * 0.5307027145f + (-0.7265760135f);
  q = q * t + 0.7107068705f; q = q * t + (-0.142248368f); q = q * t + 0.127414796f; q = q * t;
  const float ee = __builtin_amdgcn_exp2f((v * v) * (-0.72134752044f));
  const float m = v * (q * ee);
  return v < 0.f ? m : v - m;
}
typedef __bf16 bf16x2t __attribute__((ext_vector_type(2)));
__device__ __forceinline__ unsigned rl2(unsigned lo, unsigned hi, int j) {
  const unsigned a = (unsigned)__builtin_amdgcn_readlane((int)lo, j & 63), b = (unsigned)__builtin_amdgcn_readlane((int)hi, j & 63);
  return j < 64 ? a : b;
}
constexpr int PG_NSLOT = 8, PG_SLOT = 2048;

__device__ void phase_peer_gather(const Params& p, unsigned char* smem, int bid, int nb, int layer, int tok0, int ntok) {
  const int tid0 = tidx();
  const int wid = __builtin_amdgcn_readfirstlane(tid0 >> 6), lane = tid0 & 63;
  const __amdgpu_buffer_rsrc_t U = __builtin_amdgcn_make_buffer_rsrc((void*)(p.u8 + (size_t)layer * NEXP * D), (short)0, NEXP * D, 0x00020000);
  const __amdgpu_buffer_rsrc_t V = __builtin_amdgcn_make_buffer_rsrc((void*)(p.v8 + (size_t)layer * NEXP * D), (short)0, NEXP * D, 0x00020000);
  const float* us = p.uscale + (size_t)layer * NEXP;
  const float* vs = p.vscale + (size_t)layer * NEXP;
  const float* modl = p.mod + (size_t)layer * 33 * MODW;
  LAS unsigned char* ring = (LAS unsigned char*)smem + wid * (PG_NSLOT * PG_SLOT);
  LAS unsigned* srt = (LAS unsigned*)ring;
  const int voff = lane * 16;
  for (int g = bid * 8 + wid; g < ntok / 4; g += nb * 8) {
    const int token0 = tok0 + g * 4;
    unsigned x[4][8];
    float y[4][16];
    unsigned kLo[4], kHi[4], gLo[4], gHi[4], sLo[4], sHi[4];
#pragma unroll
    for (int t = 0; t < 4; ++t) {
      const int token = token0 + t;
      const bf16_t* xr = p.act + (size_t)token * D + lane * 16;
      const u32x4 xa = *(const u32x4*)xr, xb = *(const u32x4*)(xr + 8);
#pragma unroll
      for (int q = 0; q < 4; ++q) { const unsigned wa = xa[q], wb = xb[q]; x[t][q] = wa; x[t][4 + q] = wb; }
#pragma unroll
      for (int i = 0; i < 16; ++i) y[t][i] = 0.f;
      const u32x2 se0 = p.sel[(size_t)token * 128 + lane], se1 = p.sel[(size_t)token * 128 + 64 + lane];
      const unsigned k0 = (se0.x << 7) | (unsigned)lane, k1 = (se1.x << 7) | (unsigned)(lane + 64);
      const float g0 = __uint_as_float(se0.y) * vs[se0.x], g1 = __uint_as_float(se1.y) * vs[se1.x];
      const float s0 = us[se0.x], s1 = us[se1.x];
      unsigned r0 = 0, r1 = 0;
      for (int i = 0; i < 64; ++i) {
        const unsigned b0 = (unsigned)__builtin_amdgcn_readlane((int)k0, i), b1 = (unsigned)__builtin_amdgcn_readlane((int)k1, i);
        r0 += (b0 < k0) ? 1u : 0u; r0 += (b1 < k0) ? 1u : 0u;
        r1 += (b0 < k1) ? 1u : 0u; r1 += (b1 < k1) ? 1u : 0u;
      }
      srt[t * 384 + r0] = k0; srt[t * 384 + r1] = k1;
      srt[t * 384 + 128 + r0] = __float_as_uint(g0); srt[t * 384 + 128 + r1] = __float_as_uint(g1);
      srt[t * 384 + 256 + r0] = __float_as_uint(s0); srt[t * 384 + 256 + r1] = __float_as_uint(s1);
    }
#pragma unroll
    for (int t = 0; t < 4; ++t) {
      kLo[t] = srt[t * 384 + lane]; kHi[t] = srt[t * 384 + 64 + lane];
      gLo[t] = srt[t * 384 + 128 + lane]; gHi[t] = srt[t * 384 + 192 + lane];
      sLo[t] = srt[t * 384 + 256 + lane]; sHi[t] = srt[t * 384 + 320 + lane];
    }
    asm volatile("s_waitcnt vmcnt(0) lgkmcnt(0)" ::: "memory");
#define PG_DMA(JJ, TT, SLOT)                                                                                            \
    do {                                                                                                                \
      const int _j = (JJ) < 128 ? (JJ) : 127;                                                                           \
      const unsigned _e = rl2(kLo[TT], kHi[TT], _j) >> 7;                                                               \
      __builtin_amdgcn_raw_ptr_buffer_load_lds(U, (LAS void*)(ring + (SLOT) * PG_SLOT), 16, voff, (int)(_e * 1024u), 0, 0);        \
      __builtin_amdgcn_raw_ptr_buffer_load_lds(V, (LAS void*)(ring + (SLOT) * PG_SLOT + 1024), 16, voff, (int)(_e * 1024u), 0, 0); \
    } while (0)
#define PG_MATH(JJ, TT, SLOT)                                                                                           \
    do {                                                                                                                \
      asm volatile("s_waitcnt vmcnt(14)" ::: "memory");                                                                 \
      const u32x4 _uw = *(const LAS u32x4*)(ring + (SLOT) * PG_SLOT + voff);                                            \
      const u32x4 _vw = *(const LAS u32x4*)(ring + (SLOT) * PG_SLOT + 1024 + voff);                                     \
      const float _gsv = __uint_as_float(rl2(gLo[TT], gHi[TT], (JJ))), _su = __uint_as_float(rl2(sLo[TT], sHi[TT], (JJ))); \
      float _d0 = 0.f, _d1 = 0.f;                                                                                       \
      _Pragma("unroll") for (int q = 0; q < 4; ++q) {                                                                   \
        const unsigned w = _uw[q];                                                                                      \
        const bf16x2t lo = __builtin_amdgcn_cvt_scalef32_pk_bf16_fp8(w, 1.0f, false), hi = __builtin_amdgcn_cvt_scalef32_pk_bf16_fp8(w, 1.0f, true); \
        const unsigned xl = x[TT][2 * q], xh = x[TT][2 * q + 1];                                                        \
        _d0 = __builtin_amdgcn_fdot2_f32_bf16(lo, __builtin_bit_cast(bf16x2t, xl), _d0, false);                         \
        _d1 = __builtin_amdgcn_fdot2_f32_bf16(hi, __builtin_bit_cast(bf16x2t, xh), _d1, false);                         \
      }                                                                                                                 \
      const float _d = wave_sum(_d0 + _d1) * _su;                                                                       \
      const float _a = _gsv * gelu_as(_d);                                                                              \
      _Pragma("unroll") for (int q = 0; q < 4; ++q) {                                                                   \
        const int w = (int)_vw[q];                                                                                      \
        const f32x2 lo = __builtin_amdgcn_cvt_pk_f32_fp8(w, false), hi = __builtin_amdgcn_cvt_pk_f32_fp8(w, true);      \
        y[TT][4 * q] += _a * lo.x; y[TT][4 * q + 1] += _a * lo.y;                                                       \
        y[TT][4 * q + 2] += _a * hi.x; y[TT][4 * q + 3] += _a * hi.y;                                                   \
      }                                                                                                                 \
    } while (0)
    PG_DMA(0, 0, 0); PG_DMA(0, 1, 1); PG_DMA(0, 2, 2); PG_DMA(0, 3, 3); PG_DMA(1, 0, 4); PG_DMA(1, 1, 5); PG_DMA(1, 2, 6);
#pragma unroll 1
    for (int j = 0; j < 128; j += 2) {
      PG_DMA(j + 1, 3, 7); PG_MATH(j, 0, 0);
      PG_DMA(j + 2, 0, 0); PG_MATH(j, 1, 1);
      PG_DMA(j + 2, 1, 1); PG_MATH(j, 2, 2);
      PG_DMA(j + 2, 2, 2); PG_MATH(j, 3, 3);
      PG_DMA(j + 2, 3, 3); PG_MATH(j + 1, 0, 4);
      PG_DMA(j + 3, 0, 4); PG_MATH(j + 1, 1, 5);
      PG_DMA(j + 3, 1, 5); PG_MATH(j + 1, 2, 6);
      PG_DMA(j + 3, 2, 6); PG_MATH(j + 1, 3, 7);
    }
    asm volatile("s_waitcnt vmcnt(0)" ::: "memory");
#undef PG_DMA
#undef PG_MATH
#pragma unroll
    for (int t = 0; t < 4; ++t) {
      const int token = token0 + t;
#ifdef ZERO_PEER
      if (layer == ZERO_PEER) {
#pragma unroll
        for (int i = 0; i < 16; ++i) y[t][i] = 0.f;
      }
#endif
      const bool isctx = token < NCTX;
      const int b = isctx ? 32 : ((token - NCTX) >> 11);
      const float* g2 = modl + (size_t)b * MODW + 5 * D + lane * 16;
      float* hrow = (isctx ? p.hctx + (size_t)token * D : p.out + (size_t)(token - NCTX) * D) + lane * 16;
      float hn[16];
      float ss = 0.f;
#pragma unroll
      for (int q4 = 0; q4 < 4; ++q4) {
        const f32x4 hv = *(const f32x4*)(hrow + q4 * 4), gv = *(const f32x4*)(g2 + q4 * 4);
#pragma unroll
        for (int e = 0; e < 4; ++e) { const float v = hv[e] + gv[e] * y[t][q4 * 4 + e]; hn[q4 * 4 + e] = v; ss += v * v; }
      }
      ss = wave_sum(ss);
      const float rstd = rsqrtf(ss * (1.f / D) + EPS);
      if (layer == 0) {
        const float* modn = p.mod + (size_t)33 * MODW + (size_t)b * MODW + lane * 16;
        const float* gain = p.mix_g + D + lane * 16;
        u32x4 w[2];
#pragma unroll
        for (int q4 = 0; q4 < 4; ++q4) {
          f32x4 hv; hv[0] = hn[q4 * 4]; hv[1] = hn[q4 * 4 + 1]; hv[2] = hn[q4 * 4 + 2]; hv[3] = hn[q4 * 4 + 3];
          *(f32x4*)(hrow + q4 * 4) = hv;
          const f32x4 gg = *(const f32x4*)(gain + q4 * 4), s0 = *(const f32x4*)(modn + q4 * 4), s1 = *(const f32x4*)(modn + D + q4 * 4);
          f32x4 yv = hv * rstd * gg;
          yv = yv * (1.f + s1) + s0;
          w[q4 >> 1][(q4 & 1) * 2] = cvt_pk_bf16(yv[0], yv[1]); w[q4 >> 1][(q4 & 1) * 2 + 1] = cvt_pk_bf16(yv[2], yv[3]);
        }
        *(u32x4*)(p.act + (size_t)token * D + lane * 16) = w[0];
        *(u32x4*)(p.act + (size_t)token * D + lane * 16 + 8) = w[1];
      } else {
        const float* gain = p.final_g + lane * 16;
#pragma unroll
        for (int q4 = 0; q4 < 4; ++q4) {
          const f32x4 gg = *(const f32x4*)(gain + q4 * 4);
          f32x4 o;
#pragma unroll
          for (int e = 0; e < 4; ++e) o[e] = hn[q4 * 4 + e] * rstd * gg[e];
          *(f32x4*)(hrow + q4 * 4) = o;
        }
      }
    }
  }
}

constexpr int NPH = 18;
template <int PH>
__device__ __forceinline__ void run_phase(const Params& p, unsigned char* smem, int bid, int nb) {
  if constexpr (PH == 0) phase_prep(p, smem, bid, nb);
  else if constexpr (PH == 1) phase_norm(p, bid, nb, 0, NTOK, p.ctx, p.x, p.mix_g, p.mod, 0, 1);
  else if constexpr (PH == 2) phase_gemm_inproj(p, smem, bid, nb, 0);
  else if constexpr (PH == 3) phase_ret_kv(p, smem, bid, nb);
  else if constexpr (PH == 4) phase_ret_scan(p, bid, nb);
  else if constexpr (PH == 5) phase_ret_out(p, smem, bid, nb);
  else if constexpr (PH == 6) phase_gemm_outproj(p, smem, bid, nb, 0);
  else if constexpr (PH == 7) phase_norm(p, bid, nb, 0, NTOK, p.hctx, p.out, p.ffn_g, p.mod, 3, 4);
  else if constexpr (PH == 8) phase_gemm_pq(p, smem, bid, nb, 0);
  else if constexpr (PH == 9) phase_peer_topk(p, smem, bid, nb, 0, 0, NTOK);
  else if constexpr (PH == 10) phase_peer_gather(p, smem, bid, nb, 0, 0, NTOK);
  else if constexpr (PH == 11) phase_gemm_inproj(p, smem, bid, nb, 1);
  else if constexpr (PH == 12) phase_attn(p, smem, bid, nb);
  else if constexpr (PH == 13) phase_gemm_outproj(p, smem, bid, nb, 1);
  else if constexpr (PH == 14) phase_norm(p, bid, nb, NCTX, NTOK, p.hctx, p.out, p.ffn_g + D, p.mod + (size_t)33 * MODW, 3, 4);
  else if constexpr (PH == 15) phase_gemm_pq(p, smem, bid, nb, 1);
  else if constexpr (PH == 16) phase_peer_topk(p, smem, bid, nb, 1, NCTX, NLAT);
  else if constexpr (PH == 17) phase_peer_gather(p, smem, bid, nb, 1, NCTX, NLAT);
}
template <int PH>
__global__ void __launch_bounds__(NTHREADS) phase_k(Params p) {
  extern __shared__ __attribute__((aligned(16))) unsigned char smem[];
  run_phase<PH>(p, smem, blockIdx.x, gridDim.x);
}
#if MK_ONE_LAUNCH
constexpr int PARAMS_OFF = LDS_BYTES - 512;
static_assert(sizeof(Params) <= 512, "params block");
template <class T>
__device__ __forceinline__ T* uni(T* q) {
  const unsigned long long v = (unsigned long long)q;
  const unsigned lo = __builtin_amdgcn_readfirstlane((unsigned)v), hi = __builtin_amdgcn_readfirstlane((unsigned)(v >> 32));
  return (T*)(((unsigned long long)hi << 32) | lo);
}
__device__ __forceinline__ Params load_params(const unsigned char* smem) {
  const Params* l = (const Params*)(smem + PARAMS_OFF);
  Params q;
  q.x = uni(l->x); q.c = uni(l->c); q.ctx = uni(l->ctx); q.c_ctx = uni(l->c_ctx); q.ada_w = uni(l->ada_w); q.ada_b = uni(l->ada_b);
  q.mix_g = uni(l->mix_g); q.ffn_g = uni(l->ffn_g); q.ev_w_in = uni(l->ev_w_in); q.ev_w_out = uni(l->ev_w_out);
  q.logit_f = uni(l->logit_f); q.logit_b = uni(l->logit_b); q.conv_w = uni(l->conv_w); q.od_w_in = uni(l->od_w_in);
  q.od_w_out = uni(l->od_w_out); q.sinks = uni(l->sinks); q.peer_wq = uni(l->peer_wq); q.keys1 = uni(l->keys1); q.keys2 = uni(l->keys2);
  q.peer_u = uni(l->peer_u); q.peer_v = uni(l->peer_v); q.final_g = uni(l->final_g); q.out = uni(l->out); q.mod = uni(l->mod);
  q.ropec = uni(l->ropec); q.ropes = uni(l->ropes); q.winT0 = uni(l->winT0); q.woutT0 = uni(l->woutT0); q.winT1 = uni(l->winT1);
  q.woutT1 = uni(l->woutT1); q.wqT = uni(l->wqT); q.u8 = uni(l->u8); q.v8 = uni(l->v8); q.uscale = uni(l->uscale); q.vscale = uni(l->vscale); q.hctx = uni(l->hctx); q.act = uni(l->act);
  q.proj = uni(l->proj); q.pq = uni(l->pq); q.sel = uni(l->sel); q.kv = uni(l->kv); q.sprev = uni(l->sprev);
  return q;
}
template <int PH>
__device__ __forceinline__ void run_from(unsigned char* smem, int bid, int nb) {
  {
    const Params q = load_params(smem);
    run_phase<PH>(q, smem, bid, nb);
  }
#ifdef DUP_PH
  if constexpr (PH == DUP_PH) {
    cg::this_grid().sync();
    const Params q = load_params(smem);
    run_phase<PH>(q, smem, bid, nb);
  }
#endif
  if constexpr (PH + 1 < NPH) {
    cg::this_grid().sync();
    run_from<PH + 1>(smem, bid, nb);
  }
}
__global__ void __launch_bounds__(NTHREADS) mega(Params p) {
  extern __shared__ __attribute__((aligned(16))) unsigned char smem[];
  if (threadIdx.x == 0) *(Params*)(smem + PARAMS_OFF) = p;
  __syncthreads();
  run_from<0>(smem, blockIdx.x, gridDim.x);
}
#endif
#ifndef DBG_NPH
#define DBG_NPH 0
#endif
#if DBG_NPH
__global__ void __launch_bounds__(NTHREADS) dbg_sums(Params p, float* scr, int nph) {
  const int wid = threadIdx.x >> 6, lane = threadIdx.x & 63;
  const int gw = blockIdx.x * 8 + wid, nw = gridDim.x * 8;
  if (nph >= 2) for (int r = gw; r < NTOK; r += nw) { float s = 0.f; for (int c = lane; c < D; c += 64) s += bf2f(p.act[(size_t)r * D + c]) * (1 + (c & 7)); s = wave_sum(s); if (lane == 0) scr[r] = s; }
  if (nph >= 3 && nph <= 8) for (int r = gw; r < NTOK; r += nw) { float s = 0.f; for (int c = lane; c < 3072; c += 64) s += bf2f(p.proj[(size_t)r * 3072 + c]) * (1 + (c & 7)); s = wave_sum(s); if (lane == 0) scr[(1 << 20) + r] = s; }
  if (nph >= 12 && nph <= 15) for (int r = gw; r < NTOK; r += nw) { float s = 0.f; for (int c = lane + (r < NCTX ? 1024 : 0); c < 1536; c += 64) s += bf2f(p.proj[(size_t)r * 1536 + c]) * (1 + (c & 7)); s = wave_sum(s); if (lane == 0) scr[(1 << 20) + r] = s; }
  if (nph >= 4) for (int r = gw; r < 2304 * 128; r += nw) { float s = 0.f; for (int c = lane; c < 128; c += 64) s += p.kv[(size_t)r * 128 + c] * (1 + (c & 7)); s = wave_sum(s); if (lane == 0) scr[(2 << 20) + r] = s; }
  if (nph >= 5) for (int r = gw; r < 2304 * 128; r += nw) { float s = 0.f; for (int c = lane; c < 128; c += 64) s += bf2f(p.sprev[(size_t)r * 128 + c]) * (1 + (c & 7)); s = wave_sum(s); if (lane == 0) scr[(3 << 20) + r] = s; }
  if (nph >= 7) for (int r = gw; r < NCTX; r += nw) { float s = 0.f; for (int c = lane; c < D; c += 64) s += p.hctx[(size_t)r * D + c] * (1 + (c & 7)); s = wave_sum(s); if (lane == 0) scr[(4 << 20) + r] = s; }
  if (nph >= 1) for (int i = blockIdx.x * NTHREADS + threadIdx.x; i < 2 * 33 * MODW; i += gridDim.x * NTHREADS) scr[(5 << 20) + i] = p.mod[i];
  if (nph >= 7) for (int r = gw; r < NLAT; r += nw) { float s = 0.f; for (int c = lane; c < D; c += 64) s += p.out[(size_t)r * D + c] * (1 + (c & 7)); s = wave_sum(s); if (lane == 0) scr[(6 << 20) + r] = s; }
  if (nph >= 10 && nph <= 11) for (int r = gw; r < NTOK; r += nw) { float s = 0.f; for (int c = lane; c < 128; c += 64) { const u32x2 e = p.sel[(size_t)r * 128 + c]; s += __uint_as_float(e.y) * (float)(e.x & 1023); } s = wave_sum(s); if (lane == 0) scr[(7 << 20) + r] = s; }
}
__global__ void __launch_bounds__(NTHREADS) dbg_out(Params p, const float* scr) {
  for (size_t i = (size_t)blockIdx.x * NTHREADS + threadIdx.x; i < (size_t)NLAT * D; i += (size_t)gridDim.x * NTHREADS) p.out[i] = (i < (size_t)(8 << 20)) ? scr[i] : 0.f;
}
__global__ void __launch_bounds__(NTHREADS) dbg_zero(float* scr) {
  for (size_t i = (size_t)blockIdx.x * NTHREADS + threadIdx.x; i < (size_t)(8 << 20); i += (size_t)gridDim.x * NTHREADS) scr[i] = 0.f;
}
#endif
template <int PH>
static void launch_phases(const Params& p, int grid, hipStream_t stream) {
  static bool attr_set = false;
  if (!attr_set) { (void)hipFuncSetAttribute((const void*)phase_k<PH>, hipFuncAttributeMaxDynamicSharedMemorySize, LDS_BYTES); attr_set = true; }
  phase_k<PH><<<grid, NTHREADS, LDS_BYTES, stream>>>(p);
  if constexpr (PH + 1 < (DBG_NPH ? DBG_NPH : NPH)) launch_phases<PH + 1>(p, grid, stream);
}

extern "C" void kernel_launch(void* const* d_in, const int* in_sizes, int n_in, void* d_out, int out_size, void* d_ws,
                              size_t ws_size, hipStream_t stream) {
  Params p{};
  const float* const* in = (const float* const*)d_in;
  p.x = in[0]; p.c = in[1]; p.ctx = in[2]; p.c_ctx = in[3]; p.ada_w = in[4]; p.ada_b = in[5]; p.mix_g = in[6]; p.ffn_g = in[7];
  p.ev_w_in = in[8]; p.ev_w_out = in[9]; p.logit_f = in[10]; p.logit_b = in[11]; p.conv_w = in[12]; p.od_w_in = in[13];
  p.od_w_out = in[14]; p.sinks = in[15]; p.peer_wq = in[16]; p.keys1 = in[17]; p.keys2 = in[18]; p.peer_u = in[19];
  p.peer_v = in[20]; p.final_g = in[21];
  p.out = (float*)d_out;
  unsigned char* w = (unsigned char*)d_ws;
  size_t off = 0;
  auto take = [&](size_t bytes) { unsigned char* r = w + off; off += (bytes + 255) & ~(size_t)255; return r; };
  p.mod = (float*)take((size_t)2 * 33 * MODW * 4);
  p.ropec = (float*)take(1024 * 4);
  p.ropes = (float*)take(1024 * 4);
  p.winT0 = (bf16_t*)take((size_t)3072 * 1024 * 2);
  p.woutT0 = (bf16_t*)take((size_t)1024 * 1024 * 2);
  p.winT1 = (bf16_t*)take((size_t)1536 * 1024 * 2);
  p.woutT1 = (bf16_t*)take((size_t)1024 * 1024 * 2);
  p.wqT = (bf16_t*)take((size_t)2 * 1024 * 1024 * 2);
  p.u8 = (unsigned char*)take((size_t)2 * NEXP * D);
  p.v8 = (unsigned char*)take((size_t)2 * NEXP * D);
  p.uscale = (float*)take((size_t)2 * NEXP * 4);
  p.vscale = (float*)take((size_t)2 * NEXP * 4);
  p.hctx = (float*)take((size_t)NCTX * D * 4);
  p.act = (bf16_t*)take((size_t)NTOK * D * 2);
  p.kv = (float*)take((size_t)2304 * 16384 * 4);
  p.sprev = (bf16_t*)take((size_t)2304 * 16384 * 2);
  p.proj = (bf16_t*)take((size_t)NTOK * 3072 * 2);
  p.pq = p.proj;
  p.sel = (u32x2*)((unsigned char*)p.proj + (size_t)NTOK * D * 2);
  if (off > ws_size) { fprintf(stderr, "workspace too small: need %zu have %zu\n", off, ws_size); }

  int grid = 256;
#if MK_ONE_LAUNCH
  static int grid_blocks = 0;
  if (!grid_blocks) {
    (void)hipFuncSetAttribute((const void*)mega, hipFuncAttributeMaxDynamicSharedMemorySize, LDS_BYTES);
    int dev = 0, cus = 0, per_cu = 0;
    (void)hipGetDevice(&dev);
    (void)hipDeviceGetAttribute(&cus, hipDeviceAttributeMultiprocessorCount, dev);
    (void)hipOccupancyMaxActiveBlocksPerMultiprocessor(&per_cu, mega, NTHREADS, LDS_BYTES);
    if (per_cu > 1) per_cu = 1;
    grid_blocks = cus * per_cu;
    if (grid_blocks <= 0) grid_blocks = 256;
  }
  grid = grid_blocks;
  void* args[] = {&p};
  hipError_t e = hipLaunchCooperativeKernel((const void*)mega, dim3(grid), dim3(NTHREADS), args, LDS_BYTES, stream);
  if (e != hipSuccess) fprintf(stderr, "cooperative launch failed: %s\n", hipGetErrorString(e));
#else
  launch_phases<0>(p, grid, stream);
#if DBG_NPH
  float* scr = (float*)(w + off);
  dbg_zero<<<grid, NTHREADS, 0, stream>>>(scr);
  dbg_sums<<<grid, NTHREADS, 0, stream>>>(p, scr, DBG_NPH);
  dbg_out<<<grid, NTHREADS, 0, stream>>>(p, scr);
#endif
#endif
}
```

```cpp
#include <hip/hip_runtime.h>
#include <hip/hip_cooperative_groups.h>
#include <cstdio>
#include <cstdint>
namespace cg = cooperative_groups;

#ifndef MK_ONE_LAUNCH
#define MK_ONE_LAUNCH 1
#endif

typedef unsigned short bf16_t;
typedef short bf16x8 __attribute__((ext_vector_type(8)));
typedef short bf16x2v __attribute__((ext_vector_type(2)));
typedef float f32x4 __attribute__((ext_vector_type(4)));
typedef unsigned u32x4 __attribute__((ext_vector_type(4)));
typedef unsigned u32x2 __attribute__((ext_vector_type(2)));

constexpr int D = 1024, BATCH = 32, SEQ = 2048, CTXL = 256;
constexpr int NCTX = BATCH * CTXL;
constexpr int NLAT = BATCH * SEQ;
constexpr int NTOK = NCTX + NLAT;
constexpr int MODW = 6 * D;
constexpr int NEXP = 16384;
constexpr float EPS = 1e-6f;
constexpr int NTHREADS = 512;
constexpr int LDS_BYTES = 140 * 1024;

struct Params {
  const float *x, *c, *ctx, *c_ctx, *ada_w, *ada_b, *mix_g, *ffn_g, *ev_w_in, *ev_w_out, *logit_f, *logit_b, *conv_w,
      *od_w_in, *od_w_out, *sinks, *peer_wq, *keys1, *keys2, *peer_u, *peer_v, *final_g;
  float* out;
  float* mod;
  float* ropec;
  float* ropes;
  bf16_t* winT0;
  bf16_t* woutT0;
  bf16_t* winT1;
  bf16_t* woutT1;
  bf16_t* wqT;
  unsigned char* u8;
  unsigned char* v8;
  float* uscale;
  float* vscale;
  float* hctx;
  bf16_t* act;
  bf16_t* proj;
  bf16_t* pq;
  u32x2* sel;
  float* kv;
  bf16_t* sprev;
  unsigned* bar;
};

typedef __bf16 bf16x2n __attribute__((ext_vector_type(2)));
typedef float f32x2 __attribute__((ext_vector_type(2)));
__device__ __forceinline__ unsigned cvt_pk_bf16(float lo, float hi) {
  f32x2 v = {lo, hi};
  return __builtin_bit_cast(unsigned, __builtin_convertvector(v, bf16x2n));
}
__device__ __forceinline__ float bf_lo(unsigned u) { return __uint_as_float(u << 16); }
__device__ __forceinline__ float bf_hi(unsigned u) { return __uint_as_float(u & 0xffff0000u); }
__device__ __forceinline__ float bf2f(bf16_t h) { return __uint_as_float(((unsigned)h) << 16); }
__device__ __forceinline__ bf16_t f2bf(float f) { return __builtin_bit_cast(unsigned short, (__bf16)f); }

template <int CTRL>
__device__ __forceinline__ float dppf(float x) {
  return __builtin_bit_cast(float, __builtin_amdgcn_mov_dpp(__builtin_bit_cast(int, x), CTRL, 0xf, 0xf, true));
}
__device__ __forceinline__ float row16_sum(float x) {
  x += dppf<0xB1>(x); x += dppf<0x4E>(x); x += dppf<0x141>(x); x += dppf<0x128>(x);
  return x;
}
__device__ __forceinline__ float row16_max(float x) {
  x = fmaxf(x, dppf<0xB1>(x)); x = fmaxf(x, dppf<0x4E>(x)); x = fmaxf(x, dppf<0x141>(x)); x = fmaxf(x, dppf<0x128>(x));
  return x;
}
__device__ __forceinline__ float xrow16_sum(float x) {
  auto s = __builtin_amdgcn_permlane16_swap(__float_as_uint(x), __float_as_uint(x), false, false);
  x = __uint_as_float(s[0]) + __uint_as_float(s[1]);
  auto t = __builtin_amdgcn_permlane32_swap(__float_as_uint(x), __float_as_uint(x), false, false);
  return __uint_as_float(t[0]) + __uint_as_float(t[1]);
}
__device__ __forceinline__ float wave_sum(float x) { return xrow16_sum(row16_sum(x)); }
__device__ __forceinline__ float wave_max(float x) {
  x = row16_max(x);
  auto s = __builtin_amdgcn_permlane16_swap(__float_as_uint(x), __float_as_uint(x), false, false);
  x = fmaxf(__uint_as_float(s[0]), __uint_as_float(s[1]));
  auto t = __builtin_amdgcn_permlane32_swap(__float_as_uint(x), __float_as_uint(x), false, false);
  return fmaxf(__uint_as_float(t[0]), __uint_as_float(t[1]));
}

__device__ __forceinline__ int tidx() {
  int t = threadIdx.x;
  asm volatile("" : "+v"(t));
  __builtin_assume(t >= 0 && t < NTHREADS);
  return t;
}
__device__ __forceinline__ float siluf(float v) { return v / (1.f + __expf(-v)); }
__device__ __forceinline__ float log_sigmoidf(float v) { return -log1pf(expf(-v)); }

#define LAS __attribute__((address_space(3)))
constexpr int BM = 256, BK = 64, HALF = 128, HTB = HALF * BK * 2, NXCD = 8, WGM = 8;
constexpr int KDIM = 1024;

__device__ __forceinline__ int lds_byte(int r, int c) {
  const int st = (r >> 4) * 2 + (c >> 5), rr = r & 15, cc = c & 31, ob = rr * 64 + cc * 2;
  return st * 1024 + (ob ^ (((ob >> 9) & 1) << 5));
}
__device__ __forceinline__ void stage_rc(int b, int& R, int& C) {
  const int st = b / 1024, sb = b % 1024, swz = sb ^ (((sb >> 9) & 1) << 5);
  R = (st >> 1) * 16 + swz / 64;
  C = (st & 1) * 32 + (swz % 64) / 2;
}
struct Sched {
  int pm0, pn0, nM, nN, G, c;
  __device__ __forceinline__ bool next(int i, int& pm, int& pn) const {
    const int nwg = nM * nN;
    const long L = (long)i * G + c;
    if (L >= nwg) return false;
    int wgid = (int)L;
    { const int q = nwg / NXCD, r = nwg % NXCD, xcd = wgid % NXCD, off = wgid / NXCD; wgid = (xcd < r ? xcd * (q + 1) : r * (q + 1) + (xcd - r) * q) + off; }
    const int nig = WGM * nN, gid = wgid / nig, fm = gid * WGM, gsz = (nM - fm) < WGM ? (nM - fm) : WGM;
    pm = pm0 + fm + ((wgid % nig) % gsz);
    pn = pn0 + (wgid % nig) / gsz;
    return true;
  }
};

template <class Epi>
__device__ __forceinline__ void gemm_phase(LAS unsigned char* lds, const bf16_t* __restrict__ Ag, const bf16_t* __restrict__ Btg, const Sched& S, const Epi& E) {
  const int tid = tidx(), wid = __builtin_amdgcn_readfirstlane(tid >> 6), lane = tid & 63, wr = wid >> 2, wc = wid & 3, fr = lane & 15, fq = lane >> 4;
  constexpr int K = KDIM, nt = K / BK;
  unsigned voffA[2];
#pragma unroll
  for (int i = 0; i < 2; ++i) { int R, C; stage_rc(tid * 16 + i * 8192, R, C); voffA[i] = (unsigned)(R * K + C) * 2u; }
  const size_t kstep = (size_t)(BK * 2);
  const size_t hstep = (size_t)HALF * K * 2;
  const size_t tstep = 2 * hstep;
  const unsigned ldsw = (unsigned)wid * 1024u;
  const int aoff = lds_byte(wr * 64 + fr, fq * 8), boff = lds_byte(wc * 32 + fr, fq * 8);
#define G_SA(b, h) (((b) * 2 + (h)) * HTB)
#define G_SB(b, h) ((4 + (b) * 2 + (h)) * HTB)
#define G_STAGE(bufoff, gbase) do { _Pragma("unroll") for (int _i = 0; _i < 2; ++_i) \
    __builtin_amdgcn_global_load_lds((const unsigned*)((const char*)(gbase) + voffA[_i]), (LAS unsigned*)(lds + (bufoff) + ldsw + _i * 8192), 16, 0, 0); } while (0)
#define G_LDA(dst, b, h) do { _Pragma("unroll") for (int m = 0; m < 4; ++m) _Pragma("unroll") for (int k = 0; k < 2; ++k) dst[m][k] = *(const LAS bf16x8*)(lds + G_SA(b, h) + aoff + m * 2048 + k * 1024); } while (0)
#define G_LDB(dst, b, h) do { _Pragma("unroll") for (int n = 0; n < 2; ++n) _Pragma("unroll") for (int k = 0; k < 2; ++k) dst[n][k] = *(const LAS bf16x8*)(lds + G_SB(b, h) + boff + n * 2048 + k * 1024); } while (0)
#define G_MMA(ai, bj, At, Bt) do { __builtin_amdgcn_s_setprio(1); _Pragma("unroll") for (int m = 0; m < 4; ++m) _Pragma("unroll") for (int n = 0; n < 2; ++n) _Pragma("unroll") for (int k = 0; k < 2; ++k) \
    acc[ai][bj][m][n] = __builtin_amdgcn_mfma_f32_16x16x32_bf16(Bt[n][k], At[m][k], acc[ai][bj][m][n], 0, 0, 0); __builtin_amdgcn_s_setprio(0); } while (0)
#define G_WAIT_V(n) asm volatile("s_waitcnt vmcnt(" #n ")" ::: "memory")
#define G_WAIT_L(n) asm volatile("s_waitcnt lgkmcnt(" #n ")" ::: "memory")
#define G_BAR __builtin_amdgcn_s_barrier()
#define G_SCHED __builtin_amdgcn_sched_barrier(0)
  int cpm, cpn, npm, npn, ui = 0;
  if (!S.next(0, cpm, cpn)) return;
  f32x4 acc[2][2][4][2];
#pragma unroll
  for (int a = 0; a < 2; ++a)
#pragma unroll
    for (int b = 0; b < 2; ++b)
#pragma unroll
      for (int m = 0; m < 4; ++m)
#pragma unroll
        for (int n = 0; n < 2; ++n) acc[a][b][m][n] = (f32x4){0.f, 0.f, 0.f, 0.f};
  bf16x8 At[4][2], B0[2][2], B1[2][2];
  const char* cA = (const char*)Ag + (size_t)cpm * tstep;
  const char* cB = (const char*)Btg + (size_t)cpn * tstep;
  G_STAGE(G_SB(0, 0), cB); G_STAGE(G_SA(0, 0), cA); G_STAGE(G_SB(0, 1), cB + hstep); G_STAGE(G_SA(0, 1), cA + hstep);
  if (wr == 1) G_BAR;
  G_WAIT_V(4); G_BAR;
  G_STAGE(G_SB(1, 0), cB + kstep); G_STAGE(G_SA(1, 0), cA + kstep); G_STAGE(G_SB(1, 1), cB + hstep + kstep);
  G_WAIT_V(6); G_BAR;
  for (;;) {
    const bool has_next = S.next(ui + 1, npm, npn);
    const char* nA = has_next ? (const char*)Ag + (size_t)npm * tstep : cA;
    const char* nB = has_next ? (const char*)Btg + (size_t)npn * tstep : cB;
    for (int t = 0; t < nt; t += 2) {
      const bool last = (t == nt - 2);
      const char* a1 = cA + (size_t)(t + 1) * kstep;
      const char* a2 = last ? nA : cA + (size_t)(t + 2) * kstep;
      const char* b2 = last ? nB : cB + (size_t)(t + 2) * kstep;
      const char* a3 = a2 + kstep;
      const char* b3 = b2 + kstep;
      G_LDB(B0, 0, 0); G_SCHED; G_LDA(At, 0, 0); G_STAGE(G_SA(1, 1), a1 + hstep);
      G_WAIT_L(8); G_BAR; G_WAIT_L(0); G_MMA(0, 0, At, B0); G_BAR; G_SCHED;
      G_LDB(B1, 0, 1); G_STAGE(G_SB(0, 0), b2);
      G_BAR; G_WAIT_L(0); G_MMA(0, 1, At, B1); G_BAR;
      G_LDA(At, 0, 1); G_STAGE(G_SA(0, 0), a2);
      G_BAR; G_WAIT_L(0); G_MMA(1, 0, At, B0); G_BAR; G_SCHED;
      G_STAGE(G_SB(0, 1), b2 + hstep);
      G_WAIT_V(6); G_BAR; G_MMA(1, 1, At, B1); G_BAR;
      G_LDB(B0, 1, 0); G_SCHED; G_LDA(At, 1, 0); G_STAGE(G_SA(0, 1), a2 + hstep);
      G_WAIT_L(8); G_BAR; G_WAIT_L(0); G_MMA(0, 0, At, B0); G_BAR; G_SCHED;
      G_LDB(B1, 1, 1); G_STAGE(G_SB(1, 0), b3);
      G_BAR; G_WAIT_L(0); G_MMA(0, 1, At, B1); G_BAR;
      G_LDA(At, 1, 1); G_STAGE(G_SA(1, 0), a3);
      G_BAR; G_WAIT_L(0); G_MMA(1, 0, At, B0); G_BAR; G_SCHED;
      G_STAGE(G_SB(1, 1), b3 + hstep);
      G_WAIT_V(6); G_BAR; G_MMA(1, 1, At, B1); G_BAR;
    }
    E(acc, cpm * BM, cpn * BM, wr, wc, fr, fq);
    if (!has_next) break;
#pragma unroll
    for (int a = 0; a < 2; ++a)
#pragma unroll
      for (int b = 0; b < 2; ++b)
#pragma unroll
        for (int m = 0; m < 4; ++m)
#pragma unroll
          for (int n = 0; n < 2; ++n) acc[a][b][m][n] = (f32x4){0.f, 0.f, 0.f, 0.f};
    cpm = npm; cpn = npn; cA = nA; cB = nB; ++ui;
  }
  G_WAIT_V(0);
  if (wr == 0) G_BAR;
  G_BAR;
#undef G_SA
#undef G_SB
#undef G_STAGE
#undef G_LDA
#undef G_LDB
#undef G_MMA
}

struct EpiInProj {
  bf16_t* P; int ldc; int layer; const float* cosT; const float* sinT;
  __device__ __forceinline__ void operator()(const f32x4 (&acc)[2][2][4][2], int brow, int bcol, int wr, int wc, int fr, int fq) const {
#pragma unroll
    for (int bj = 0; bj < 2; ++bj) {
      const int colbase = bcol + bj * HALF + wc * 32;
      bool rope, scl;
      if (layer == 0) { rope = colbase < 512; scl = (colbase >= 256 && colbase < 512); }
      else { rope = colbase < 1280; scl = colbase < 1024; }
#pragma unroll
      for (int ai = 0; ai < 2; ++ai)
#pragma unroll
        for (int m = 0; m < 4; ++m) {
          const int row = brow + ai * HALF + wr * 64 + m * 16 + fr;
          f32x4 v0 = acc[ai][bj][m][0], v1 = acc[ai][bj][m][1];
          if (rope && row >= NCTX) {
            const int t = (row - NCTX) & (SEQ - 1);
            const int pos = (wc & 1) ? (t & 63) : (t >> 6);
            const f32x4 cs = *(const f32x4*)(cosT + pos * 16 + fq * 4);
            const f32x4 sn = *(const f32x4*)(sinT + pos * 16 + fq * 4);
            const f32x4 o0 = v0 * cs - v1 * sn, o1 = v1 * cs + v0 * sn;
            v0 = o0; v1 = o1;
          }
          if (scl) { v0 *= 0.125f; v1 *= 0.125f; }
          bf16_t* rp = P + (size_t)row * ldc + colbase + fq * 4;
          u32x2 w0, w1;
          w0.x = cvt_pk_bf16(v0[0], v0[1]); w0.y = cvt_pk_bf16(v0[2], v0[3]);
          w1.x = cvt_pk_bf16(v1[0], v1[1]); w1.y = cvt_pk_bf16(v1[2], v1[3]);
          *(u32x2*)rp = w0;
          *(u32x2*)(rp + 16) = w1;
        }
    }
  }
};
struct EpiBf16 {
  bf16_t* P; int ldc;
  __device__ __forceinline__ void operator()(const f32x4 (&acc)[2][2][4][2], int brow, int bcol, int wr, int wc, int fr, int fq) const {
#pragma unroll
    for (int ai = 0; ai < 2; ++ai)
#pragma unroll
      for (int m = 0; m < 4; ++m) {
        const int row = brow + ai * HALF + wr * 64 + m * 16 + fr;
#pragma unroll
        for (int bj = 0; bj < 2; ++bj)
#pragma unroll
          for (int n = 0; n < 2; ++n) {
            const f32x4 v = acc[ai][bj][m][n];
            u32x2 w; w.x = cvt_pk_bf16(v[0], v[1]); w.y = cvt_pk_bf16(v[2], v[3]);
            *(u32x2*)(P + (size_t)row * ldc + bcol + bj * HALF + wc * 32 + n * 16 + fq * 4) = w;
          }
      }
  }
};
struct EpiResid {
  const float* hin_ctx; const float* hin_lat; float* hout_ctx; float* hout_lat; const float* gate;
  __device__ __forceinline__ void operator()(const f32x4 (&acc)[2][2][4][2], int brow, int bcol, int wr, int wc, int fr, int fq) const {
    const bool isctx = brow < NCTX;
    const int b = isctx ? 32 : ((brow - NCTX) >> 11);
    const float* hin = isctx ? hin_ctx + (size_t)brow * D : hin_lat + (size_t)(brow - NCTX) * D;
    float* hout = isctx ? hout_ctx + (size_t)brow * D : hout_lat + (size_t)(brow - NCTX) * D;
    const float* g = gate + (size_t)b * MODW;
#pragma unroll
    for (int bj = 0; bj < 2; ++bj)
#pragma unroll
      for (int n = 0; n < 2; ++n) {
        const int col = bcol + bj * HALF + wc * 32 + n * 16 + fq * 4;
        const f32x4 gv = *(const f32x4*)(g + col);
#pragma unroll
        for (int ai = 0; ai < 2; ++ai)
#pragma unroll
          for (int m = 0; m < 4; ++m) {
            const int r = ai * HALF + wr * 64 + m * 16 + fr;
            const f32x4 h = *(const f32x4*)(hin + (size_t)r * D + col);
            *(f32x4*)(hout + (size_t)r * D + col) = h + gv * acc[ai][bj][m][n];
          }
      }
  }
};

template <int MT, int NT>
__device__ __forceinline__ void mm_lds(const bf16_t* A, int lda, const bf16_t* B, int ldb, int K, f32x4 (&acc)[MT][NT], int fr, int fq) {
  for (int k0 = 0; k0 < K; k0 += 32) {
    bf16x8 af[MT], bf[NT];
#pragma unroll
    for (int m = 0; m < MT; ++m) af[m] = *(const bf16x8*)(A + (m * 16 + fr) * lda + k0 + fq * 8);
#pragma unroll
    for (int n = 0; n < NT; ++n) bf[n] = *(const bf16x8*)(B + (n * 16 + fr) * ldb + k0 + fq * 8);
#pragma unroll
    for (int m = 0; m < MT; ++m)
#pragma unroll
      for (int n = 0; n < NT; ++n) acc[m][n] = __builtin_amdgcn_mfma_f32_16x16x32_bf16(af[m], bf[n], acc[m][n], 0, 0, 0);
  }
}

__device__ void phase_prep(const Params& p, unsigned char* smem, int bid, int nb) {
  const int tid = tidx();
  for (int it = bid; it < 2 * 96; it += nb) {
    const int layer = it / 96, n0 = (it % 96) * 64;
    float* s = (float*)smem;
    for (int i = tid; i < 33 * 1024; i += NTHREADS) {
      const int b = i >> 10, k = i & 1023;
      const float v = (b < 32) ? p.c[b * 1024 + k] : p.c_ctx[k];
      s[k * 33 + b] = siluf(v);
    }
    __syncthreads();
    const int col = tid & 63, kg = tid >> 6;
    float acc[33];
#pragma unroll
    for (int b = 0; b < 33; ++b) acc[b] = 0.f;
    const float* W = p.ada_w + (size_t)layer * 1024 * MODW + n0 + col;
    for (int k = kg * 128; k < kg * 128 + 128; ++k) {
      const float w = W[(size_t)k * MODW];
      const float* sk = s + k * 33;
#pragma unroll
      for (int b = 0; b < 33; ++b) acc[b] += sk[b] * w;
    }
    __syncthreads();
    float* red = (float*)smem;
#pragma unroll
    for (int b = 0; b < 33; ++b) red[(kg * 33 + b) * 64 + col] = acc[b];
    __syncthreads();
    for (int i = tid; i < 33 * 64; i += NTHREADS) {
      const int b = i >> 6, cc = i & 63;
      float t = p.ada_b[layer * MODW + n0 + cc];
#pragma unroll
      for (int g = 0; g < 8; ++g) t += red[(g * 33 + b) * 64 + cc];
      p.mod[((size_t)layer * 33 + b) * MODW + n0 + cc] = t;
    }
    __syncthreads();
  }
  if (bid == nb - 1) {
    for (int i = tid; i < 1024; i += NTHREADS) {
      const int pos = i >> 4, f = i & 15;
      const float inv = powf(10000.f, -(float)f / 16.f);
      const float ang = (float)pos * inv;
      p.ropec[i] = cosf(ang);
      p.ropes[i] = sinf(ang);
    }
  }
  {
    float* tile = (float*)smem;
    const int ntile_total = 768 + 256 + 384 + 256 + 512;
    for (int it = bid; it < ntile_total; it += nb) {
      const float* src; bf16_t* dst; int N, ti;
      if (it < 768) { src = p.ev_w_in; dst = p.winT0; N = 3072; ti = it; }
      else if (it < 1024) { src = p.ev_w_out; dst = p.woutT0; N = 1024; ti = it - 768; }
      else if (it < 1408) { src = p.od_w_in; dst = p.winT1; N = 1536; ti = it - 1024; }
      else if (it < 1664) { src = p.od_w_out; dst = p.woutT1; N = 1024; ti = it - 1408; }
      else { const int l = (it - 1664) / 256; src = p.peer_wq + (size_t)l * 1024 * 1024; dst = p.wqT + (size_t)l * 1024 * 1024; N = 1024; ti = (it - 1664) % 256; }
      const int ntn = N / 64, tk = ti / ntn, tn = ti % ntn;
      __syncthreads();
      for (int i = tid; i < 64 * 64; i += NTHREADS) {
        const int r = i >> 6, cc = i & 63;
        tile[r * 65 + cc] = src[(size_t)(tk * 64 + r) * N + tn * 64 + cc];
      }
      __syncthreads();
      for (int i = tid; i < 64 * 32; i += NTHREADS) {
        const int nn = i >> 5, kk = (i & 31) * 2;
        const unsigned w = cvt_pk_bf16(tile[kk * 65 + nn], tile[(kk + 1) * 65 + nn]);
        *(unsigned*)(dst + (size_t)(tn * 64 + nn) * 1024 + tk * 64 + kk) = w;
      }
    }
    __syncthreads();
  }
  {
    const int wid = tid >> 6, lane = tid & 63;
    for (int r = bid * 8 + wid; r < 4 * NEXP; r += nb * 8) {
      const bool isv = r >= 2 * NEXP;
      const int rr = isv ? r - 2 * NEXP : r;
      const float* src = (isv ? p.peer_v : p.peer_u) + (size_t)rr * D + lane * 16;
      f32x4 a[4];
      float mx = 0.f;
#pragma unroll
      for (int i = 0; i < 4; ++i) {
        a[i] = *(const f32x4*)(src + i * 4);
        mx = fmaxf(mx, fmaxf(fmaxf(fabsf(a[i][0]), fabsf(a[i][1])), fmaxf(fabsf(a[i][2]), fabsf(a[i][3]))));
      }
      mx = wave_max(mx);
      const float sc = mx > 0.f ? 240.f / mx : 1.f;
      u32x4 w;
#pragma unroll
      for (int i = 0; i < 4; ++i) {
        int t = __builtin_amdgcn_cvt_pk_fp8_f32(a[i][0] * sc, a[i][1] * sc, 0, false);
        t = __builtin_amdgcn_cvt_pk_fp8_f32(a[i][2] * sc, a[i][3] * sc, t, true);
        w[i] = (unsigned)t;
      }
      *(u32x4*)((isv ? p.v8 : p.u8) + (size_t)rr * D + lane * 16) = w;
      if (lane == 0) (isv ? p.vscale : p.uscale)[rr] = mx > 0.f ? mx / 240.f : 1.f;
    }
  }
}

__device__ void phase_norm(const Params& p, int bid, int nb, int row0, int row1, const float* hctx, const float* hlat,
                           const float* gain, const float* modl, int ish, int isc) {
  const int tid0 = tidx();
  const int wid = tid0 >> 6, lane = tid0 & 63;
  for (int row = row0 + bid * 8 + wid; row < row1; row += nb * 8) {
    const bool isctx = row < NCTX;
    const float* h = isctx ? hctx + (size_t)row * D : hlat + (size_t)(row - NCTX) * D;
    const int b = isctx ? 32 : ((row - NCTX) >> 11);
    const float* sh = modl + (size_t)b * MODW + ish * D;
    const float* sc = modl + (size_t)b * MODW + isc * D;
    f32x4 v[4];
    float ss = 0.f;
#pragma unroll
    for (int i = 0; i < 4; ++i) {
      v[i] = *(const f32x4*)(h + i * 256 + lane * 4);
      ss += v[i][0] * v[i][0] + v[i][1] * v[i][1] + v[i][2] * v[i][2] + v[i][3] * v[i][3];
    }
    ss = wave_sum(ss);
    const float rstd = rsqrtf(ss * (1.f / D) + EPS);
#pragma unroll
    for (int i = 0; i < 4; ++i) {
      const int col = i * 256 + lane * 4;
      const f32x4 g = *(const f32x4*)(gain + col), s1 = *(const f32x4*)(sc + col), s0 = *(const f32x4*)(sh + col);
      f32x4 y = v[i] * rstd * g;
      y = y * (1.f + s1) + s0;
      u32x2 w; w.x = cvt_pk_bf16(y[0], y[1]); w.y = cvt_pk_bf16(y[2], y[3]);
      *(u32x2*)(p.act + (size_t)row * D + col) = w;
    }
  }
}

__device__ __forceinline__ void phase_gemm_inproj(const Params& p, unsigned char* smem, int bid, int nb, int layer) {
  LAS unsigned char* lds = (LAS unsigned char*)smem;
  if (layer == 0) {
    EpiInProj epi{p.proj, 3072, 0, p.ropec, p.ropes};
    Sched s{0, 0, NTOK / BM, 12, nb, bid};
    gemm_phase(lds, p.act, p.winT0, s, epi);
  } else {
    EpiInProj epi{p.proj, 1536, 1, p.ropec, p.ropes};
    Sched s{NCTX / BM, 0, NLAT / BM, 6, nb, bid};
    gemm_phase(lds, p.act, p.winT1, s, epi);
    Sched s2{0, 4, NCTX / BM, 2, nb, bid};
    gemm_phase(lds, p.act, p.winT1, s2, epi);
  }
}
__device__ __forceinline__ void phase_gemm_outproj(const Params& p, unsigned char* smem, int bid, int nb, int layer) {
  LAS unsigned char* lds = (LAS unsigned char*)smem;
  if (layer == 0) {
    EpiResid epi{p.ctx, p.x, p.hctx, p.out, p.mod + 2 * D};
    Sched s{0, 0, NTOK / BM, 4, nb, bid};
    gemm_phase(lds, p.act, p.woutT0, s, epi);
  } else {
    EpiResid epi{p.hctx, p.out, p.hctx, p.out, p.mod + (size_t)33 * MODW + 2 * D};
    Sched s{NCTX / BM, 0, NLAT / BM, 4, nb, bid};
    gemm_phase(lds, p.act, p.woutT1, s, epi);
  }
}
__device__ __forceinline__ void phase_gemm_pq(const Params& p, unsigned char* smem, int bid, int nb, int layer) {
  LAS unsigned char* lds = (LAS unsigned char*)smem;
  EpiBf16 epi{p.pq, D};
  const int pm0 = layer == 0 ? 0 : NCTX / BM;
  Sched s{pm0, 0, NTOK / BM - pm0, 4, nb, bid};
  gemm_phase(lds, p.act, p.wqT + (size_t)layer * D * D, s, epi);
}

__device__ __forceinline__ int chunk_row0(int b, int cc) { return cc < 2 ? b * CTXL + cc * 128 : NCTX + b * SEQ + (cc - 2) * 128; }

constexpr int LDP = 136;
constexpr int LDK = 72;

__device__ void phase_ret_kv(const Params& p, unsigned char* smem, int bid, int nb) {
  const int tid = tidx(), wid = tid >> 6, lane = tid & 63, fr = lane & 15, fq = lane >> 4;
  bf16_t* KxT = (bf16_t*)smem;
  bf16_t* VT = KxT + 128 * LDP;
  for (int it = bid; it < BATCH * 4 * 18; it += nb) {
    const int cc = it % 18, h = (it / 18) & 3, b = it / 72;
    const int row0 = chunk_row0(b, cc);
    const float lf = log_sigmoidf(p.logit_f[h]), lb = log_sigmoidf(p.logit_b[h]);
    __syncthreads();
    for (int task = tid; task < 128 * 8; task += NTHREADS) {
      const int j = task >> 3, d0 = (task & 7) * 8;
      const u32x4 kk = *(const u32x4*)(p.proj + (size_t)(row0 + j) * 3072 + 256 + h * 64 + d0);
      const float zf = __expf(lf * (float)(127 - j)), zb = __expf(lb * (float)j);
#pragma unroll
      for (int q = 0; q < 4; ++q) {
        const float lo = bf_lo(kk[q]), hi = bf_hi(kk[q]);
        KxT[(d0 + 2 * q) * LDP + j] = f2bf(lo * zf);
        KxT[(d0 + 2 * q + 1) * LDP + j] = f2bf(hi * zf);
        KxT[(64 + d0 + 2 * q) * LDP + j] = f2bf(lo * zb);
        KxT[(64 + d0 + 2 * q + 1) * LDP + j] = f2bf(hi * zb);
      }
    }
    for (int task = tid; task < 128 * 16; task += NTHREADS) {
      const int j = task >> 4, e0 = (task & 15) * 8;
      const u32x4 vv = *(const u32x4*)(p.proj + (size_t)(row0 + j) * 3072 + 512 + h * 128 + e0);
#pragma unroll
      for (int q = 0; q < 4; ++q) {
        VT[(e0 + 2 * q) * LDP + j] = (bf16_t)(vv[q] & 0xffffu);
        VT[(e0 + 2 * q + 1) * LDP + j] = (bf16_t)(vv[q] >> 16);
      }
    }
    __syncthreads();
    f32x4 acc[1][8] = {};
    mm_lds<1, 8>(VT + wid * 16 * LDP, LDP, KxT, LDP, 128, acc, fr, fq);
    float* out = p.kv + (size_t)it * 16384;
#pragma unroll
    for (int n = 0; n < 8; ++n)
#pragma unroll
      for (int j = 0; j < 4; ++j) out[(wid * 16 + fq * 4 + j) * 128 + n * 16 + fr] = acc[0][n][j];
  }
  for (size_t task = (size_t)bid * NTHREADS + tid; task < (size_t)NTOK * 64; task += (size_t)nb * NTHREADS) {
    const int row = (int)(task >> 6), c0 = (int)(task & 63) * 8;
    const int tin = row < NCTX ? (row & (CTXL - 1)) : ((row - NCTX) & (SEQ - 1));
    const int tlen = row < NCTX ? CTXL : SEQ;
    const bf16_t* pr = p.proj + (size_t)row * 3072;
    const u32x4 gb = *(const u32x4*)(pr + 1536 + c0);
    float accv[8];
#pragma unroll
    for (int q = 0; q < 8; ++q) accv[q] = 0.f;
#pragma unroll
    for (int dt = -1; dt <= 1; ++dt) {
      if (tin + dt < 0 || tin + dt >= tlen) continue;
      const bf16_t* pr2 = pr + (ptrdiff_t)dt * 3072;
      const u32x4 gc = *(const u32x4*)(pr2 + 2048 + c0), xt = *(const u32x4*)(pr2 + 2560 + c0);
      const float* w = p.conv_w + (dt + 1) * 512 + c0;
      const f32x4 wa = *(const f32x4*)w, wb = *(const f32x4*)(w + 4);
#pragma unroll
      for (int q = 0; q < 4; ++q) {
        const float u0 = bf_lo(gc[q]) * bf_lo(xt[q]), u1 = bf_hi(gc[q]) * bf_hi(xt[q]);
        const float w0 = (2 * q < 4) ? wa[2 * q] : wb[2 * q - 4], w1 = (2 * q + 1 < 4) ? wa[2 * q + 1] : wb[2 * q + 1 - 4];
        accv[2 * q] += w0 * u0;
        accv[2 * q + 1] += w1 * u1;
      }
    }
    u32x4 o;
#pragma unroll
    for (int q = 0; q < 4; ++q) o[q] = cvt_pk_bf16(bf_lo(gb[q]) * accv[2 * q], bf_hi(gb[q]) * accv[2 * q + 1]);
#ifdef ZERO_CONV
    o = (u32x4){0u, 0u, 0u, 0u};
#endif
    *(u32x4*)(p.act + (size_t)row * D + 512 + c0) = o;
  }
}

__device__ void phase_ret_scan(const Params& p, int bid, int nb) {
  const int tid = tidx();
  for (size_t idx = (size_t)bid * NTHREADS + tid; idx < (size_t)BATCH * 4 * 16384; idx += (size_t)nb * NTHREADS) {
    const int el = (int)(idx & 16383), bh = (int)(idx >> 14), h = bh & 3;
    const bool fwd = (el & 127) < 64;
    const float lg = log_sigmoidf(fwd ? p.logit_f[h] : p.logit_b[h]);
    const float dec = __expf(lg * 128.f);
    float st = 0.f;
    for (int s = 0; s < 18; ++s) {
      const int cc = fwd ? s : (s < 2 ? 1 - s : 19 - s);
      const size_t off = ((size_t)bh * 18 + cc) * 16384 + el;
      p.sprev[off] = f2bf(st);
      st = dec * st + p.kv[off];
    }
  }
}

__device__ void phase_ret_out(const Params& p, unsigned char* smem, int bid, int nb) {
  const int tid = tidx(), wid = tid >> 6, lane = tid & 63, fr = lane & 15, fq = lane >> 4;
  bf16_t* Kt = (bf16_t*)smem;
  bf16_t* VT = Kt + 128 * LDK;
  bf16_t* ST = VT + 128 * LDP;
  bf16_t* Pb = ST + 128 * LDP;
  for (int it = bid; it < BATCH * 4 * 18; it += nb) {
    const int cc = it % 18, h = (it / 18) & 3, b = it / 72;
    const int row0 = chunk_row0(b, cc);
    const float lf = log_sigmoidf(p.logit_f[h]), lb = log_sigmoidf(p.logit_b[h]);
    __syncthreads();
    for (int task = tid; task < 128 * 8; task += NTHREADS) {
      const int j = task >> 3, d0 = (task & 7) * 8;
      *(u32x4*)(Kt + j * LDK + d0) = *(const u32x4*)(p.proj + (size_t)(row0 + j) * 3072 + 256 + h * 64 + d0);
    }
    for (int task = tid; task < 128 * 16; task += NTHREADS) {
      const int j = task >> 4, e0 = (task & 15) * 8;
      const u32x4 vv = *(const u32x4*)(p.proj + (size_t)(row0 + j) * 3072 + 512 + h * 128 + e0);
#pragma unroll
      for (int q = 0; q < 4; ++q) {
        VT[(e0 + 2 * q) * LDP + j] = (bf16_t)(vv[q] & 0xffffu);
        VT[(e0 + 2 * q + 1) * LDP + j] = (bf16_t)(vv[q] >> 16);
      }
      const int e = j;
      *(u32x4*)(ST + e * LDP + e0) = *(const u32x4*)(p.sprev + (size_t)it * 16384 + e * 128 + e0);
    }
    const int irow = wid * 16 + fr;
    bf16x8 qf[2];
#pragma unroll
    for (int ks = 0; ks < 2; ++ks) qf[ks] = *(const bf16x8*)(p.proj + (size_t)(row0 + irow) * 3072 + h * 64 + ks * 32 + fq * 8);
    __syncthreads();
    f32x4 sacc[8] = {};
#pragma unroll
    for (int ks = 0; ks < 2; ++ks)
#pragma unroll
      for (int n = 0; n < 8; ++n) {
        const bf16x8 kf = *(const bf16x8*)(Kt + (n * 16 + fr) * LDK + ks * 32 + fq * 8);
        sacc[n] = __builtin_amdgcn_mfma_f32_16x16x32_bf16(qf[ks], kf, sacc[n], 0, 0, 0);
      }
#pragma unroll
    for (int n = 0; n < 8; ++n)
#pragma unroll
      for (int jj = 0; jj < 4; ++jj) {
        const int i = wid * 16 + fq * 4 + jj, j = n * 16 + fr;
        const int df = i - j;
        const float dm = df > 0 ? __expf(lf * (float)df) : (df < 0 ? __expf(lb * (float)(-df)) : 2.f);
        Pb[i * LDP + j] = f2bf(sacc[n][jj] * dm);
      }
    __syncthreads();
    f32x4 oacc[1][8] = {};
    mm_lds<1, 8>(Pb + wid * 16 * LDP, LDP, VT, LDP, 128, oacc, fr, fq);
    {
      const float xf = __expf(lf * (float)(irow + 1)), xb = __expf(lb * (float)(128 - irow));
#pragma unroll
      for (int ks = 0; ks < 4; ++ks) {
        const float sc = ks < 2 ? xf : xb;
        const bf16x8 qs = qf[ks & 1];
        u32x4 qu = __builtin_bit_cast(u32x4, qs), qo;
#pragma unroll
        for (int q = 0; q < 4; ++q) qo[q] = cvt_pk_bf16(bf_lo(qu[q]) * sc, bf_hi(qu[q]) * sc);
        const bf16x8 qx = __builtin_bit_cast(bf16x8, qo);
#pragma unroll
        for (int n = 0; n < 8; ++n) {
          const bf16x8 sf = *(const bf16x8*)(ST + (n * 16 + fr) * LDP + ks * 32 + fq * 8);
          oacc[0][n] = __builtin_amdgcn_mfma_f32_16x16x32_bf16(qx, sf, oacc[0][n], 0, 0, 0);
        }
      }
    }
#pragma unroll
    for (int jj = 0; jj < 4; ++jj) {
      float ss = 0.f;
#pragma unroll
      for (int n = 0; n < 8; ++n) ss += oacc[0][n][jj] * oacc[0][n][jj];
      ss = row16_sum(ss);
      const float rstd = rsqrtf(ss * (1.f / 128.f) + EPS);
      const int row = row0 + wid * 16 + fq * 4 + jj;
#pragma unroll
      for (int n = 0; n < 8; ++n) {
        const int e = n * 16 + fr;
        const float g = bf2f(p.proj[(size_t)row * 3072 + 1024 + h * 128 + e]);
#ifdef ZERO_RET
        p.act[(size_t)row * D + h * 128 + e] = 0;
#else
        p.act[(size_t)row * D + h * 128 + e] = f2bf(oacc[0][n][jj] * rstd * siluf(g));
#endif
      }
    }
  }
}

__device__ void phase_attn(const Params& p, unsigned char* smem, int bid, int nb) {
  const int tid = tidx(), wid = tid >> 6, lane = tid & 63, fr = lane & 15, fq = lane >> 4;
  bf16_t* Kt = (bf16_t*)smem;
  bf16_t* VT = Kt + 64 * LDK;
  bf16_t* Pw = VT + 64 * LDK + wid * 64 * LDK;
  for (int it = bid; it < BATCH * 16 * 4; it += nb) {
    const int kvh = it & 3, qb = (it >> 2) & 15, b = it >> 6;
    const int hq = kvh * 4 + (wid >> 1);
    const int q0 = qb * 128 + (wid & 1) * 64;
    const size_t latrow0 = (size_t)NCTX + (size_t)b * SEQ;
    bf16x8 qf[4][2];
#pragma unroll
    for (int m = 0; m < 4; ++m)
#pragma unroll
      for (int ks = 0; ks < 2; ++ks)
        qf[m][ks] = *(const bf16x8*)(p.proj + (latrow0 + q0 + m * 16 + fr) * 1536 + hq * 64 + ks * 32 + fq * 8);
    const float sink = p.sinks[hq];
    float mrow[4][4], lrow[4][4];
    f32x4 oacc[4][4] = {};
#pragma unroll
    for (int m = 0; m < 4; ++m)
#pragma unroll
      for (int jj = 0; jj < 4; ++jj) { mrow[m][jj] = sink; lrow[m][jj] = (fr == 0) ? 1.f : 0.f; }
    for (int tt = 0; tt < 10; ++tt) {
      const bool win = tt < 6;
      const int kpos0 = win ? qb * 128 - 128 + 64 * tt : (tt - 6) * 64;
      if (win && (kpos0 < 0 || kpos0 >= SEQ)) continue;
      const size_t krow0 = win ? latrow0 + kpos0 : (size_t)b * CTXL + kpos0;
      __syncthreads();
      {
        const int j = tid >> 3, d0 = (tid & 7) * 8;
        *(u32x4*)(Kt + j * LDK + d0) = *(const u32x4*)(p.proj + (krow0 + j) * 1536 + 1024 + kvh * 64 + d0);
        const u32x4 vv = *(const u32x4*)(p.proj + (krow0 + j) * 1536 + 1280 + kvh * 64 + d0);
#pragma unroll
        for (int q = 0; q < 4; ++q) {
          VT[(d0 + 2 * q) * LDK + j] = (bf16_t)(vv[q] & 0xffffu);
          VT[(d0 + 2 * q + 1) * LDK + j] = (bf16_t)(vv[q] >> 16);
        }
      }
      __syncthreads();
#pragma unroll
      for (int m = 0; m < 4; ++m) {
        f32x4 sacc[4];
#pragma unroll
        for (int n = 0; n < 4; ++n) sacc[n] = (f32x4){0.f, 0.f, 0.f, 0.f};
#pragma unroll
        for (int ks = 0; ks < 2; ++ks)
#pragma unroll
          for (int n = 0; n < 4; ++n) {
            const bf16x8 kf = *(const bf16x8*)(Kt + (n * 16 + fr) * LDK + ks * 32 + fq * 8);
            sacc[n] = __builtin_amdgcn_mfma_f32_16x16x32_bf16(qf[m][ks], kf, sacc[n], 0, 0, 0);
          }
#pragma unroll
        for (int jj = 0; jj < 4; ++jj) {
          const int qpos = q0 + m * 16 + fq * 4 + jj;
          float mx = -3.0e38f;
#pragma unroll
          for (int n = 0; n < 4; ++n) {
            float s = sacc[n][jj];
            if (win) { const int dd = qpos - (kpos0 + n * 16 + fr); if (dd > 128 || dd < -128) s = -1e30f; }
            sacc[n][jj] = s;
            mx = fmaxf(mx, s);
          }
          mx = row16_max(mx);
          const float mnew = fmaxf(mrow[m][jj], mx);
          const float alpha = __expf(mrow[m][jj] - mnew);
          mrow[m][jj] = mnew;
          float ls = 0.f;
#pragma unroll
          for (int n = 0; n < 4; ++n) {
            const float pv = __expf(sacc[n][jj] - mnew);
            ls += pv;
            Pw[(m * 16 + fq * 4 + jj) * LDK + n * 16 + fr] = f2bf(pv);
          }
          lrow[m][jj] = lrow[m][jj] * alpha + ls;
#pragma unroll
          for (int n = 0; n < 4; ++n) oacc[m][n][jj] *= alpha;
        }
      }
      __syncthreads();
      mm_lds<4, 4>(Pw, LDK, VT, LDK, 64, oacc, fr, fq);
    }
#pragma unroll
    for (int m = 0; m < 4; ++m)
#pragma unroll
      for (int jj = 0; jj < 4; ++jj) {
        const float l = row16_sum(lrow[m][jj]);
        const float inv = 1.f / l;
        const size_t row = latrow0 + q0 + m * 16 + fq * 4 + jj;
#pragma unroll
        for (int n = 0; n < 4; ++n) {
#ifdef ZERO_ATTN
          p.act[row * D + hq * 64 + n * 16 + fr] = 0;
#else
          p.act[row * D + hq * 64 + n * 16 + fr] = f2bf(oacc[m][n][jj] * inv);
#endif
        }
      }
  }
}

__device__ __forceinline__ unsigned f2ord(float f) { const unsigned u = __float_as_uint(f); return (u & 0x80000000u) ? ~u : (u | 0x80000000u); }
__device__ __forceinline__ float ord2f(unsigned k) { const unsigned u = (k & 0x80000000u) ? (k & 0x7fffffffu) : ~k; return __uint_as_float(u); }

__device__ void phase_peer_topk(const Params& p, unsigned char* smem, int bid, int nb, int layer, int tok0, int ntok) {
  const int tid = tidx(), wid = tid >> 6, lane = tid & 63;
  float* keys = (float*)smem;
  unsigned* lists = (unsigned*)(smem + 65536);
  const int nitem = (ntok / 256) * 8;
  for (int it = bid; it < nitem; it += nb) {
    const int h = it & 7, tile = it >> 3;
    const int set = wid >> 2, tl = (wid & 3) * 64 + lane;
    const int token = tok0 + tile * 256 + tl;
    __syncthreads();
    {
      const float* k1 = p.keys1 + ((size_t)layer * 8 + h) * 8192;
      const float* k2 = p.keys2 + ((size_t)layer * 8 + h) * 8192;
      for (int i = tid; i < 2048; i += NTHREADS) {
        *(f32x4*)(keys + i * 4) = *(const f32x4*)(k1 + i * 4);
        *(f32x4*)(keys + 8192 + i * 4) = *(const f32x4*)(k2 + i * 4);
      }
    }
    float q[64];
    {
      const bf16_t* qp = p.pq + (size_t)token * D + h * 128 + set * 64;
#pragma unroll
      for (int c8 = 0; c8 < 8; ++c8) {
        const u32x4 w = *(const u32x4*)(qp + c8 * 8);
#pragma unroll
        for (int qq = 0; qq < 4; ++qq) { q[c8 * 8 + 2 * qq] = bf_lo(w[qq]); q[c8 * 8 + 2 * qq + 1] = bf_hi(w[qq]); }
      }
    }
    __syncthreads();
    unsigned top[16];
#pragma unroll
    for (int i = 0; i < 16; ++i) top[i] = 0u;
    const float* kb = keys + set * 8192;
    for (int k = 0; k < 128; ++k) {
      float s0 = 0.f, s1 = 0.f;
#pragma unroll
      for (int d4 = 0; d4 < 16; ++d4) {
        const f32x4 kv = *(const f32x4*)(kb + k * 64 + d4 * 4);
        s0 += q[d4 * 4] * kv[0]; s1 += q[d4 * 4 + 1] * kv[1];
        s0 += q[d4 * 4 + 2] * kv[2]; s1 += q[d4 * 4 + 3] * kv[3];
      }
      unsigned v = (f2ord(s0 + s1) & 0xffffff80u) | (unsigned)(127 - k);
#pragma unroll
      for (int i = 0; i < 16; ++i) { const unsigned hi = max(top[i], v); v = min(top[i], v); top[i] = hi; }
    }
    unsigned* mylist = lists + ((size_t)set * 256 + tl) * 16;
#pragma unroll
    for (int i = 0; i < 4; ++i) { u32x4 w; w.x = top[4 * i]; w.y = top[4 * i + 1]; w.z = top[4 * i + 2]; w.w = top[4 * i + 3]; *(u32x4*)(mylist + 4 * i) = w; }
    __syncthreads();
    if (set == 0) {
      unsigned o2[16];
      const unsigned* other = lists + ((size_t)256 + tl) * 16;
#pragma unroll
      for (int i = 0; i < 4; ++i) { const u32x4 w = *(const u32x4*)(other + 4 * i); o2[4 * i] = w.x; o2[4 * i + 1] = w.y; o2[4 * i + 2] = w.z; o2[4 * i + 3] = w.w; }
      float v1[16], v2[16];
#pragma unroll
      for (int i = 0; i < 16; ++i) { v1[i] = ord2f(top[i] & 0xffffff80u); v2[i] = ord2f(o2[i] & 0xffffff80u); }
      unsigned ct[16];
#pragma unroll
      for (int i = 0; i < 16; ++i) ct[i] = 0u;
#pragma unroll
      for (int i = 0; i < 16; ++i)
#pragma unroll
        for (int j = 0; j < 16; ++j) {
          if ((i + 1) * (j + 1) <= 16) {
            unsigned v = (f2ord(v1[i] + v2[j]) & 0xffffff00u) | (unsigned)(255 - (i * 16 + j));
#pragma unroll
            for (int r = 0; r < 16; ++r) { const unsigned hi = max(ct[r], v); v = min(ct[r], v); ct[r] = hi; }
          }
        }
      float cs[16], den = 0.f;
      const float mx = ord2f(ct[0] & 0xffffff00u);
#pragma unroll
      for (int r = 0; r < 16; ++r) { cs[r] = __expf(ord2f(ct[r] & 0xffffff00u) - mx); den += cs[r]; }
      const float inv = 1.f / den;
      u32x2* so = p.sel + (size_t)token * 128 + h * 16;
      const unsigned* l1 = lists + (size_t)tl * 16;
#pragma unroll
      for (int r = 0; r < 16; ++r) {
        const unsigned ci = 255u - (ct[r] & 0xffu);
        const unsigned e1 = 127u - (l1[ci >> 4] & 0x7fu), e2 = 127u - (other[ci & 15u] & 0x7fu);
        u32x2 w; w.x = e1 * 128u + e2; w.y = __float_as_uint(cs[r] * inv);
        so[r] = w;
      }
    }
  }
}

__device__ __forceinline__ float gelu_as(float v) {
  const float av = fabsf(v), t = __builtin_amdgcn_rcpf(av * 0.2316418882f + 1.0f);
  float q = t * 0.5307027145f + (-0.7265760135f);
  q = q * t + 0.7107068705f; q = q * t + (-0.142248368f); q = q * t + 0.127414796f; q = q * t;
  const float ee = __builtin_amdgcn_exp2f((v * v) * (-0.72134752044f));
  const float m = v * (q * ee);
  return v < 0.f ? m : v - m;
}
typedef __bf16 bf16x2t __attribute__((ext_vector_type(2)));
__device__ __forceinline__ unsigned rl2(unsigned lo, unsigned hi, int j) {
  const unsigned a = (unsigned)__builtin_amdgcn_readlane((int)lo, j & 63), b = (unsigned)__builtin_amdgcn_readlane((int)hi, j & 63);
  return j < 64 ? a : b;
}
__device__ __forceinline__ float group8_sum(float x) { x += dppf<0xB1>(x); x += dppf<0x4E>(x); x += dppf<0x141>(x); return x; }
__device__ void phase_peer_gather(const Params& p, unsigned char* smem, int bid, int nb, int layer, int tok0, int ntok) {
  const int tid0 = tidx();
  const int wid = __builtin_amdgcn_readfirstlane(tid0 >> 6), lane = tid0 & 63, g = lane >> 3, i = lane & 7;
  const __amdgpu_buffer_rsrc_t U = __builtin_amdgcn_make_buffer_rsrc((void*)(p.u8 + (size_t)layer * NEXP * D), (short)0, NEXP * D, 0x00020000);
  const __amdgpu_buffer_rsrc_t V = __builtin_amdgcn_make_buffer_rsrc((void*)(p.v8 + (size_t)layer * NEXP * D), (short)0, NEXP * D, 0x00020000);
  const float* us = p.uscale + (size_t)layer * NEXP;
  const float* vs = p.vscale + (size_t)layer * NEXP;
  const float* modl = p.mod + (size_t)layer * 33 * MODW;
  LAS unsigned* lst = (LAS unsigned*)smem + wid * 3072;
  for (int grp = bid * 8 + wid; grp < ntok / 8; grp += nb * 8) {
    const int token0 = tok0 + grp * 8;
#pragma unroll 1
    for (int t = 0; t < 8; ++t) {
      const int token = token0 + t;
      const u32x2 se0 = p.sel[(size_t)token * 128 + lane], se1 = p.sel[(size_t)token * 128 + 64 + lane];
      const unsigned k0 = (se0.x << 7) | (unsigned)lane, k1 = (se1.x << 7) | (unsigned)(lane + 64);
      const float g0 = __uint_as_float(se0.y) * vs[se0.x], g1 = __uint_as_float(se1.y) * vs[se1.x];
      const float s0 = us[se0.x], s1 = us[se1.x];
      unsigned r0 = 0, r1 = 0;
      for (int q = 0; q < 64; ++q) {
        const unsigned b0 = (unsigned)__builtin_amdgcn_readlane((int)k0, q), b1 = (unsigned)__builtin_amdgcn_readlane((int)k1, q);
        r0 += (b0 < k0) ? 1u : 0u; r0 += (b1 < k0) ? 1u : 0u;
        r1 += (b0 < k1) ? 1u : 0u; r1 += (b1 < k1) ? 1u : 0u;
      }
      lst[t * 128 + r0] = k0; lst[t * 128 + r1] = k1;
      lst[1024 + t * 128 + r0] = __float_as_uint(g0); lst[1024 + t * 128 + r1] = __float_as_uint(g1);
      lst[2048 + t * 128 + r0] = __float_as_uint(s0); lst[2048 + t * 128 + r1] = __float_as_uint(s1);
    }
    const int token = token0 + g;
    {
      unsigned x[8][8];
#pragma unroll
      for (int k = 0; k < 8; ++k) {
        const bf16_t* xr = p.act + (size_t)token * D + k * 128 + i * 16;
        const u32x4 xa = *(const u32x4*)xr, xb = *(const u32x4*)(xr + 8);
#pragma unroll
        for (int q = 0; q < 4; ++q) { const unsigned wa = xa[q], wb = xb[q]; x[k][q] = wa; x[k][4 + q] = wb; }
      }
      u32x4 ub[8];
      {
        const int voff = (int)((lst[g * 128] >> 7) * 1024u) + i * 16;
#pragma unroll
        for (int k = 0; k < 8; ++k) ub[k] = __builtin_bit_cast(u32x4, __builtin_amdgcn_raw_buffer_load_b128(U, voff + k * 128, 0, 0));
      }
#pragma unroll 1
      for (int j = 0; j < 128; ++j) {
        const int jn = j < 127 ? j + 1 : 127;
        const int voffn = (int)((lst[g * 128 + jn] >> 7) * 1024u) + i * 16;
        const float su = __uint_as_float(lst[2048 + g * 128 + j]), gsv = __uint_as_float(lst[1024 + g * 128 + j]);
        float d0 = 0.f, d1 = 0.f;
#pragma unroll
        for (int k = 0; k < 8; ++k) {
#pragma unroll
          for (int q = 0; q < 4; ++q) {
            const unsigned w = ub[k][q];
            const bf16x2t lo = __builtin_amdgcn_cvt_scalef32_pk_bf16_fp8(w, 1.0f, false), hi = __builtin_amdgcn_cvt_scalef32_pk_bf16_fp8(w, 1.0f, true);
            const unsigned xl = x[k][2 * q], xh = x[k][2 * q + 1];
            d0 = __builtin_amdgcn_fdot2_f32_bf16(lo, __builtin_bit_cast(bf16x2t, xl), d0, false);
            d1 = __builtin_amdgcn_fdot2_f32_bf16(hi, __builtin_bit_cast(bf16x2t, xh), d1, false);
          }
          ub[k] = __builtin_bit_cast(u32x4, __builtin_amdgcn_raw_buffer_load_b128(U, voffn + k * 128, 0, 0));
          __builtin_amdgcn_sched_barrier(0);
        }
        const float d = group8_sum(d0 + d1) * su;
        lst[1024 + g * 128 + j] = __float_as_uint(gsv * gelu_as(d));
      }
    }
    const bool isctx = token < NCTX;
    const int b = isctx ? 32 : ((token - NCTX) >> 11);
    const float* g2 = modl + (size_t)b * MODW + 5 * D + i * 16;
    float* hrow = (isctx ? p.hctx + (size_t)token * D : p.out + (size_t)(token - NCTX) * D) + i * 16;
    float ss = 0.f;
#pragma unroll 1
    for (int hf = 0; hf < 2; ++hf) {
      float y[4][16];
#pragma unroll
      for (int k = 0; k < 4; ++k)
#pragma unroll
        for (int c = 0; c < 16; ++c) y[k][c] = 0.f;
      const int hoff = hf * 512 + i * 16;
      u32x4 vb[4];
      {
        const int voff = (int)((lst[g * 128] >> 7) * 1024u) + hoff;
#pragma unroll
        for (int k = 0; k < 4; ++k) vb[k] = __builtin_bit_cast(u32x4, __builtin_amdgcn_raw_buffer_load_b128(V, voff + k * 128, 0, 0));
      }
#pragma unroll 1
      for (int j = 0; j < 128; ++j) {
        const int jn = j < 127 ? j + 1 : 127;
        const int voffn = (int)((lst[g * 128 + jn] >> 7) * 1024u) + hoff;
        const float a = __uint_as_float(lst[1024 + g * 128 + j]);
#pragma unroll
        for (int k = 0; k < 4; ++k) {
#pragma unroll
          for (int q = 0; q < 4; ++q) {
            const int w = (int)vb[k][q];
            const f32x2 lo = __builtin_amdgcn_cvt_pk_f32_fp8(w, false), hi = __builtin_amdgcn_cvt_pk_f32_fp8(w, true);
            y[k][4 * q] += a * lo.x; y[k][4 * q + 1] += a * lo.y;
            y[k][4 * q + 2] += a * hi.x; y[k][4 * q + 3] += a * hi.y;
          }
          vb[k] = __builtin_bit_cast(u32x4, __builtin_amdgcn_raw_buffer_load_b128(V, voffn + k * 128, 0, 0));
        }
      }
#ifdef ZERO_PEER
      if (layer == ZERO_PEER) {
#pragma unroll
        for (int k = 0; k < 4; ++k)
#pragma unroll
          for (int c = 0; c < 16; ++c) y[k][c] = 0.f;
      }
#endif
#pragma unroll
      for (int k = 0; k < 4; ++k)
#pragma unroll
        for (int q4 = 0; q4 < 4; ++q4) {
          const int co = hf * 512 + k * 128 + q4 * 4;
          const f32x4 hv = *(const f32x4*)(hrow + co), gv = *(const f32x4*)(g2 + co);
          f32x4 o;
#pragma unroll
          for (int e = 0; e < 4; ++e) { const float v = hv[e] + gv[e] * y[k][q4 * 4 + e]; o[e] = v; ss += v * v; }
          *(f32x4*)(hrow + co) = o;
        }
    }
    {
      ss = group8_sum(ss);
      const float rstd = rsqrtf(ss * (1.f / D) + EPS);
      if (layer == 0) {
        const float* modn = p.mod + (size_t)33 * MODW + (size_t)b * MODW + i * 16;
        const float* gain = p.mix_g + D + i * 16;
#pragma unroll 2
        for (int k = 0; k < 8; ++k) {
          u32x4 w[2];
#pragma unroll
          for (int q4 = 0; q4 < 4; ++q4) {
            const int co = k * 128 + q4 * 4;
            const f32x4 hv = *(const f32x4*)(hrow + co);
            const f32x4 gg = *(const f32x4*)(gain + co), s0 = *(const f32x4*)(modn + co), s1 = *(const f32x4*)(modn + D + co);
            f32x4 yv = hv * rstd * gg;
            yv = yv * (1.f + s1) + s0;
            w[q4 >> 1][(q4 & 1) * 2] = cvt_pk_bf16(yv[0], yv[1]); w[q4 >> 1][(q4 & 1) * 2 + 1] = cvt_pk_bf16(yv[2], yv[3]);
          }
          bf16_t* ar = p.act + (size_t)token * D + k * 128 + i * 16;
          *(u32x4*)ar = w[0];
          *(u32x4*)(ar + 8) = w[1];
        }
      } else {
        const float* gain = p.final_g + i * 16;
#pragma unroll 2
        for (int k = 0; k < 8; ++k)
#pragma unroll
          for (int q4 = 0; q4 < 4; ++q4) {
            const int co = k * 128 + q4 * 4;
            const f32x4 hv = *(const f32x4*)(hrow + co), gg = *(const f32x4*)(gain + co);
            *(f32x4*)(hrow + co) = hv * rstd * gg;
          }
      }
    }
    __syncthreads();
  }
}

constexpr int NPH = 18;
template <int PH>
__device__ __forceinline__ void run_phase(const Params& p, unsigned char* smem, int bid, int nb) {
  if constexpr (PH == 0) phase_prep(p, smem, bid, nb);
  else if constexpr (PH == 1) phase_norm(p, bid, nb, 0, NTOK, p.ctx, p.x, p.mix_g, p.mod, 0, 1);
  else if constexpr (PH == 2) phase_gemm_inproj(p, smem, bid, nb, 0);
  else if constexpr (PH == 3) phase_ret_kv(p, smem, bid, nb);
  else if constexpr (PH == 4) phase_ret_scan(p, bid, nb);
  else if constexpr (PH == 5) phase_ret_out(p, smem, bid, nb);
  else if constexpr (PH == 6) phase_gemm_outproj(p, smem, bid, nb, 0);
  else if constexpr (PH == 7) phase_norm(p, bid, nb, 0, NTOK, p.hctx, p.out, p.ffn_g, p.mod, 3, 4);
  else if constexpr (PH == 8) phase_gemm_pq(p, smem, bid, nb, 0);
  else if constexpr (PH == 9) phase_peer_topk(p, smem, bid, nb, 0, 0, NTOK);
  else if constexpr (PH == 10) phase_peer_gather(p, smem, bid, nb, 0, 0, NTOK);
  else if constexpr (PH == 11) phase_gemm_inproj(p, smem, bid, nb, 1);
  else if constexpr (PH == 12) phase_attn(p, smem, bid, nb);
  else if constexpr (PH == 13) phase_gemm_outproj(p, smem, bid, nb, 1);
  else if constexpr (PH == 14) phase_norm(p, bid, nb, NCTX, NTOK, p.hctx, p.out, p.ffn_g + D, p.mod + (size_t)33 * MODW, 3, 4);
  else if constexpr (PH == 15) phase_gemm_pq(p, smem, bid, nb, 1);
  else if constexpr (PH == 16) phase_peer_topk(p, smem, bid, nb, 1, NCTX, NLAT);
  else if constexpr (PH == 17) phase_peer_gather(p, smem, bid, nb, 1, NCTX, NLAT);
}
template <int PH>
__global__ void __launch_bounds__(NTHREADS) phase_k(Params p) {
  extern __shared__ __attribute__((aligned(16))) unsigned char smem[];
  run_phase<PH>(p, smem, blockIdx.x, gridDim.x);
}
#define XB_TMO      128
#define XB_XCNT(j)  (256  + 64 * (j))
#define XB_XSUB(j)  (1280 + 64 * (j))
#define XB_XGEN(j)  (2304 + 64 * (j))
#define XB_TOP      3328
#define XB_TOPGEN   3392
#define XCD_BAR_WORDS 3456
#define XB_SPIN_CAP (1u << 22)
__device__ __forceinline__ unsigned xb_ld(unsigned* p)              { return __hip_atomic_load(p, __ATOMIC_RELAXED, __HIP_MEMORY_SCOPE_AGENT); }
__device__ __forceinline__ unsigned xb_add(unsigned* p, unsigned v) { return __hip_atomic_fetch_add(p, v, __ATOMIC_RELAXED, __HIP_MEMORY_SCOPE_AGENT); }
__device__ __forceinline__ unsigned xb_xcc_id() { return (unsigned)__builtin_amdgcn_s_getreg((3 << 11) | 20) & 0xFu; }
#define XB_SPIN(cond, bar) do { unsigned _sp = 0; while (cond) { __builtin_amdgcn_s_sleep(1); \
    if ((++_sp & 255u) == 0u) { if (xb_ld(&(bar)[XB_TMO])) break; if (_sp > XB_SPIN_CAP) { atomicAdd(&(bar)[XB_TMO], 1u); break; } } } } while (0)
struct XcdBarrier { unsigned* bar; unsigned x; volatile LAS unsigned* st; };
__device__ __forceinline__ XcdBarrier xcd_barrier_post(unsigned* bar, volatile LAS unsigned* st) {
  XcdBarrier b; b.bar = bar; b.x = xb_xcc_id(); b.st = st;
  if (threadIdx.x == 0) (void)xb_add(&bar[XB_XCNT(b.x)], 1u);
  return b;
}
__device__ __forceinline__ void xcd_barrier_complete(unsigned* bar, unsigned x, unsigned& nloc, unsigned& nx) {
  const unsigned G = gridDim.x * gridDim.y * gridDim.z;
  unsigned sum, cnt, mine, sp = 0u;
  for (;;) {
    sum = 0u; cnt = 0u; mine = 0u;
#pragma unroll
    for (unsigned j = 0; j < 16; ++j) { const unsigned c = xb_ld(&bar[XB_XCNT(j)]); sum += c; cnt += (c > 0u) ? 1u : 0u; mine = (j == x) ? c : mine; }
    if (sum == G) break;
    __builtin_amdgcn_s_sleep(1);
    if ((++sp & 255u) == 0u) { if (xb_ld(&bar[XB_TMO])) break; if (sp > XB_SPIN_CAP) { atomicAdd(&bar[XB_TMO], 1u); break; } }
  }
  nloc = mine > 0u ? mine : 1u; nx = cnt > 0u ? cnt : 1u;
}
__device__ __forceinline__ void xcd_barrier(const XcdBarrier& b) {
  asm volatile("s_waitcnt vmcnt(0)" ::: "memory");
  __syncthreads();
  if (threadIdx.x == 0) {
    unsigned* bar = b.bar;
    __builtin_amdgcn_s_waitcnt(0);
    unsigned nloc = b.st[0], nx = b.st[1];
    if (nloc == 0u) { xcd_barrier_complete(bar, b.x, nloc, nx); b.st[0] = nloc; b.st[1] = nx; }
    const unsigned old = xb_add(&bar[XB_XSUB(b.x)], 1u);
    const unsigned gen = old / nloc;
    if (old + 1u == (gen + 1u) * nloc) {
      __builtin_amdgcn_fence(__ATOMIC_RELEASE, "agent");
      asm volatile("s_waitcnt vmcnt(0)" ::: "memory");
      const unsigned og = xb_add(&bar[XB_TOP], 1u);
      const unsigned tg = og / nx;
      if (og + 1u == (tg + 1u) * nx) xb_add(&bar[XB_TOPGEN], 1u);
      else XB_SPIN(xb_ld(&bar[XB_TOPGEN]) == tg, bar);
      __builtin_amdgcn_fence(__ATOMIC_ACQUIRE, "agent");
      xb_add(&bar[XB_XGEN(b.x)], 1u);
      asm volatile("s_waitcnt vmcnt(0)" ::: "memory");
    } else {
      XB_SPIN(xb_ld(&bar[XB_XGEN(b.x)]) == gen, bar);
      __builtin_amdgcn_fence(__ATOMIC_ACQUIRE, "agent");
      asm volatile("s_waitcnt vmcnt(0)" ::: "memory");
    }
  }
  __syncthreads();
}

#if MK_ONE_LAUNCH
constexpr int PARAMS_OFF = LDS_BYTES - 512;
static_assert(sizeof(Params) <= 480, "params block");
template <class T>
__device__ __forceinline__ T* uni(T* q) {
  const unsigned long long v = (unsigned long long)q;
  const unsigned lo = __builtin_amdgcn_readfirstlane((unsigned)v), hi = __builtin_amdgcn_readfirstlane((unsigned)(v >> 32));
  return (T*)(((unsigned long long)hi << 32) | lo);
}
__device__ __forceinline__ Params load_params(const unsigned char* smem) {
  const Params* l = (const Params*)(smem + PARAMS_OFF);
  Params q;
  q.x = uni(l->x); q.c = uni(l->c); q.ctx = uni(l->ctx); q.c_ctx = uni(l->c_ctx); q.ada_w = uni(l->ada_w); q.ada_b = uni(l->ada_b);
  q.mix_g = uni(l->mix_g); q.ffn_g = uni(l->ffn_g); q.ev_w_in = uni(l->ev_w_in); q.ev_w_out = uni(l->ev_w_out);
  q.logit_f = uni(l->logit_f); q.logit_b = uni(l->logit_b); q.conv_w = uni(l->conv_w); q.od_w_in = uni(l->od_w_in);
  q.od_w_out = uni(l->od_w_out); q.sinks = uni(l->sinks); q.peer_wq = uni(l->peer_wq); q.keys1 = uni(l->keys1); q.keys2 = uni(l->keys2);
  q.peer_u = uni(l->peer_u); q.peer_v = uni(l->peer_v); q.final_g = uni(l->final_g); q.out = uni(l->out); q.mod = uni(l->mod);
  q.ropec = uni(l->ropec); q.ropes = uni(l->ropes); q.winT0 = uni(l->winT0); q.woutT0 = uni(l->woutT0); q.winT1 = uni(l->winT1);
  q.woutT1 = uni(l->woutT1); q.wqT = uni(l->wqT); q.u8 = uni(l->u8); q.v8 = uni(l->v8); q.uscale = uni(l->uscale); q.vscale = uni(l->vscale); q.hctx = uni(l->hctx); q.act = uni(l->act);
  q.proj = uni(l->proj); q.pq = uni(l->pq); q.sel = uni(l->sel); q.kv = uni(l->kv); q.sprev = uni(l->sprev); q.bar = uni(l->bar);
  return q;
}
template <int PH>
__device__ __forceinline__ void run_from(unsigned char* smem, int bid, int nb, const XcdBarrier& xb) {
  {
    const Params q = load_params(smem);
    run_phase<PH>(q, smem, bid, nb);
  }
#ifdef DUP_PH
  if constexpr (PH == DUP_PH) {
    xcd_barrier(xb);
    const Params q = load_params(smem);
    run_phase<PH>(q, smem, bid, nb);
  }
#endif
  if constexpr (PH + 1 < NPH) {
    if constexpr (PH == 0) cg::this_grid().sync();
    else xcd_barrier(xb);
    run_from<PH + 1>(smem, bid, nb, xb);
  }
}
__global__ void __launch_bounds__(NTHREADS) mega(Params p) {
  extern __shared__ __attribute__((aligned(16))) unsigned char smem[];
  volatile LAS unsigned* st = (volatile LAS unsigned*)((LAS unsigned char*)smem + PARAMS_OFF + 480);
  if (threadIdx.x == 0) { *(Params*)(smem + PARAMS_OFF) = p; st[0] = 0u; st[1] = 0u; }
  __syncthreads();
  const XcdBarrier xb = xcd_barrier_post(p.bar, st);
  run_from<0>(smem, blockIdx.x, gridDim.x, xb);
}
#endif
#ifndef DBG_NPH
#define DBG_NPH 0
#endif
#if DBG_NPH
__global__ void __launch_bounds__(NTHREADS) dbg_sums(Params p, float* scr, int nph) {
  const int wid = threadIdx.x >> 6, lane = threadIdx.x & 63;
  const int gw = blockIdx.x * 8 + wid, nw = gridDim.x * 8;
  if (nph >= 2) for (int r = gw; r < NTOK; r += nw) { float s = 0.f; for (int c = lane; c < D; c += 64) s += bf2f(p.act[(size_t)r * D + c]) * (1 + (c & 7)); s = wave_sum(s); if (lane == 0) scr[r] = s; }
  if (nph >= 3 && nph <= 8) for (int r = gw; r < NTOK; r += nw) { float s = 0.f; for (int c = lane; c < 3072; c += 64) s += bf2f(p.proj[(size_t)r * 3072 + c]) * (1 + (c & 7)); s = wave_sum(s); if (lane == 0) scr[(1 << 20) + r] = s; }
  if (nph >= 12 && nph <= 15) for (int r = gw; r < NTOK; r += nw) { float s = 0.f; for (int c = lane + (r < NCTX ? 1024 : 0); c < 1536; c += 64) s += bf2f(p.proj[(size_t)r * 1536 + c]) * (1 + (c & 7)); s = wave_sum(s); if (lane == 0) scr[(1 << 20) + r] = s; }
  if (nph >= 4) for (int r = gw; r < 2304 * 128; r += nw) { float s = 0.f; for (int c = lane; c < 128; c += 64) s += p.kv[(size_t)r * 128 + c] * (1 + (c & 7)); s = wave_sum(s); if (lane == 0) scr[(2 << 20) + r] = s; }
  if (nph >= 5) for (int r = gw; r < 2304 * 128; r += nw) { float s = 0.f; for (int c = lane; c < 128; c += 64) s += bf2f(p.sprev[(size_t)r * 128 + c]) * (1 + (c & 7)); s = wave_sum(s); if (lane == 0) scr[(3 << 20) + r] = s; }
  if (nph >= 7) for (int r = gw; r < NCTX; r += nw) { float s = 0.f; for (int c = lane; c < D; c += 64) s += p.hctx[(size_t)r * D + c] * (1 + (c & 7)); s = wave_sum(s); if (lane == 0) scr[(4 << 20) + r] = s; }
  if (nph >= 1) for (int i = blockIdx.x * NTHREADS + threadIdx.x; i < 2 * 33 * MODW; i += gridDim.x * NTHREADS) scr[(5 << 20) + i] = p.mod[i];
  if (nph >= 7) for (int r = gw; r < NLAT; r += nw) { float s = 0.f; for (int c = lane; c < D; c += 64) s += p.out[(size_t)r * D + c] * (1 + (c & 7)); s = wave_sum(s); if (lane == 0) scr[(6 << 20) + r] = s; }
  if (nph >= 10 && nph <= 11) for (int r = gw; r < NTOK; r += nw) { float s = 0.f; for (int c = lane; c < 128; c += 64) { const u32x2 e = p.sel[(size_t)r * 128 + c]; s += __uint_as_float(e.y) * (float)(e.x & 1023); } s = wave_sum(s); if (lane == 0) scr[(7 << 20) + r] = s; }
}
__global__ void __launch_bounds__(NTHREADS) dbg_out(Params p, const float* scr) {
  for (size_t i = (size_t)blockIdx.x * NTHREADS + threadIdx.x; i < (size_t)NLAT * D; i += (size_t)gridDim.x * NTHREADS) p.out[i] = (i < (size_t)(8 << 20)) ? scr[i] : 0.f;
}
__global__ void __launch_bounds__(NTHREADS) dbg_zero(float* scr) {
  for (size_t i = (size_t)blockIdx.x * NTHREADS + threadIdx.x; i < (size_t)(8 << 20); i += (size_t)gridDim.x * NTHREADS) scr[i] = 0.f;
}
#endif
template <int PH>
static void launch_phases(const Params& p, int grid, hipStream_t stream) {
  static bool attr_set = false;
  if (!attr_set) { (void)hipFuncSetAttribute((const void*)phase_k<PH>, hipFuncAttributeMaxDynamicSharedMemorySize, LDS_BYTES); attr_set = true; }
  phase_k<PH><<<grid, NTHREADS, LDS_BYTES, stream>>>(p);
  if constexpr (PH + 1 < (DBG_NPH ? DBG_NPH : NPH)) launch_phases<PH + 1>(p, grid, stream);
}

extern "C" void kernel_launch(void* const* d_in, const int* in_sizes, int n_in, void* d_out, int out_size, void* d_ws,
                              size_t ws_size, hipStream_t stream) {
  Params p{};
  const float* const* in = (const float* const*)d_in;
  p.x = in[0]; p.c = in[1]; p.ctx = in[2]; p.c_ctx = in[3]; p.ada_w = in[4]; p.ada_b = in[5]; p.mix_g = in[6]; p.ffn_g = in[7];
  p.ev_w_in = in[8]; p.ev_w_out = in[9]; p.logit_f = in[10]; p.logit_b = in[11]; p.conv_w = in[12]; p.od_w_in = in[13];
  p.od_w_out = in[14]; p.sinks = in[15]; p.peer_wq = in[16]; p.keys1 = in[17]; p.keys2 = in[18]; p.peer_u = in[19];
  p.peer_v = in[20]; p.final_g = in[21];
  p.out = (float*)d_out;
  unsigned char* w = (unsigned char*)d_ws;
  size_t off = 0;
  auto take = [&](size_t bytes) { unsigned char* r = w + off; off += (bytes + 255) & ~(size_t)255; return r; };
  p.mod = (float*)take((size_t)2 * 33 * MODW * 4);
  p.ropec = (float*)take(1024 * 4);
  p.ropes = (float*)take(1024 * 4);
  p.winT0 = (bf16_t*)take((size_t)3072 * 1024 * 2);
  p.woutT0 = (bf16_t*)take((size_t)1024 * 1024 * 2);
  p.winT1 = (bf16_t*)take((size_t)1536 * 1024 * 2);
  p.woutT1 = (bf16_t*)take((size_t)1024 * 1024 * 2);
  p.wqT = (bf16_t*)take((size_t)2 * 1024 * 1024 * 2);
  p.u8 = (unsigned char*)take((size_t)2 * NEXP * D);
  p.v8 = (unsigned char*)take((size_t)2 * NEXP * D);
  p.uscale = (float*)take((size_t)2 * NEXP * 4);
  p.vscale = (float*)take((size_t)2 * NEXP * 4);
  p.hctx = (float*)take((size_t)NCTX * D * 4);
  p.act = (bf16_t*)take((size_t)NTOK * D * 2);
  p.kv = (float*)take((size_t)2304 * 16384 * 4);
  p.sprev = (bf16_t*)take((size_t)2304 * 16384 * 2);
  p.bar = (unsigned*)take((size_t)XCD_BAR_WORDS * 4);
  p.proj = (bf16_t*)take((size_t)NTOK * 3072 * 2);
  p.pq = p.proj;
  p.sel = (u32x2*)((unsigned char*)p.proj + (size_t)NTOK * D * 2);
  if (off > ws_size) { fprintf(stderr, "workspace too small: need %zu have %zu\n", off, ws_size); }

  int grid = 256;
#if MK_ONE_LAUNCH
  static int grid_blocks = 0;
  if (!grid_blocks) {
    (void)hipFuncSetAttribute((const void*)mega, hipFuncAttributeMaxDynamicSharedMemorySize, LDS_BYTES);
    int dev = 0, cus = 0, per_cu = 0;
    (void)hipGetDevice(&dev);
    (void)hipDeviceGetAttribute(&cus, hipDeviceAttributeMultiprocessorCount, dev);
    (void)hipOccupancyMaxActiveBlocksPerMultiprocessor(&per_cu, mega, NTHREADS, LDS_BYTES);
    if (per_cu > 1) per_cu = 1;
    grid_blocks = cus * per_cu;
    if (grid_blocks <= 0) grid_blocks = 256;
  }
  grid = grid_blocks;
  (void)hipMemsetAsync(p.bar, 0, (size_t)XCD_BAR_WORDS * 4, stream);
  void* args[] = {&p};
  hipError_t e = hipLaunchCooperativeKernel((const void*)mega, dim3(grid), dim3(NTHREADS), args, LDS_BYTES, stream);
  if (e != hipSuccess) fprintf(stderr, "cooperative launch failed: %s\n", hipGetErrorString(e));
#else
  launch_phases<0>(p, grid, stream);
#if DBG_NPH
  float* scr = (float*)(w + off);
  dbg_zero<<<grid, NTHREADS, 0, stream>>>(scr);
  dbg_sums<<<grid, NTHREADS, 0, stream>>>(p, scr, DBG_NPH);
  dbg_out<<<grid, NTHREADS, 0, stream>>>(p, scr);
#endif
#endif
}
```

```cpp
#include <hip/hip_runtime.h>
#include <hip/hip_cooperative_groups.h>
#include <cstdio>
#include <cstdint>
namespace cg = cooperative_groups;

#ifndef MK_ONE_LAUNCH
#define MK_ONE_LAUNCH 1
#endif

typedef unsigned short bf16_t;
typedef short bf16x8 __attribute__((ext_vector_type(8)));
typedef short bf16x2v __attribute__((ext_vector_type(2)));
typedef float f32x4 __attribute__((ext_vector_type(4)));
typedef unsigned u32x4 __attribute__((ext_vector_type(4)));
typedef unsigned u32x2 __attribute__((ext_vector_type(2)));

constexpr int D = 1024, BATCH = 32, SEQ = 2048, CTXL = 256;
constexpr int NCTX = BATCH * CTXL;
constexpr int NLAT = BATCH * SEQ;
constexpr int NTOK = NCTX + NLAT;
constexpr int MODW = 6 * D;
constexpr int NEXP = 16384;
constexpr float EPS = 1e-6f;
constexpr int NTHREADS = 512;
constexpr int LDS_BYTES = 140 * 1024;

struct Params {
  const float *x, *c, *ctx, *c_ctx, *ada_w, *ada_b, *mix_g, *ffn_g, *ev_w_in, *ev_w_out, *logit_f, *logit_b, *conv_w,
      *od_w_in, *od_w_out, *sinks, *peer_wq, *keys1, *keys2, *peer_u, *peer_v, *final_g;
  float* out;
  float* mod;
  float* ropec;
  float* ropes;
  bf16_t* winT0;
  bf16_t* woutT0;
  bf16_t* winT1;
  bf16_t* woutT1;
  bf16_t* wqT;
  unsigned char* u8;
  unsigned char* v8;
  float* uscale;
  float* vscale;
  float* hctx;
  bf16_t* act;
  bf16_t* proj;
  bf16_t* pq;
  u32x2* sel;
  float* kv;
  bf16_t* sprev;
  bf16_t* keysb;
  unsigned* bar;
};

typedef __bf16 bf16x2n __attribute__((ext_vector_type(2)));
typedef float f32x2 __attribute__((ext_vector_type(2)));
__device__ __forceinline__ unsigned cvt_pk_bf16(float lo, float hi) {
  f32x2 v = {lo, hi};
  return __builtin_bit_cast(unsigned, __builtin_convertvector(v, bf16x2n));
}
__device__ __forceinline__ float bf_lo(unsigned u) { return __uint_as_float(u << 16); }
__device__ __forceinline__ float bf_hi(unsigned u) { return __uint_as_float(u & 0xffff0000u); }
__device__ __forceinline__ float bf2f(bf16_t h) { return __uint_as_float(((unsigned)h) << 16); }
__device__ __forceinline__ bf16_t f2bf(float f) { return __builtin_bit_cast(unsigned short, (__bf16)f); }

template <int CTRL>
__device__ __forceinline__ float dppf(float x) {
  return __builtin_bit_cast(float, __builtin_amdgcn_mov_dpp(__builtin_bit_cast(int, x), CTRL, 0xf, 0xf, true));
}
__device__ __forceinline__ float row16_sum(float x) {
  x += dppf<0xB1>(x); x += dppf<0x4E>(x); x += dppf<0x141>(x); x += dppf<0x128>(x);
  return x;
}
__device__ __forceinline__ float row16_max(float x) {
  x = fmaxf(x, dppf<0xB1>(x)); x = fmaxf(x, dppf<0x4E>(x)); x = fmaxf(x, dppf<0x141>(x)); x = fmaxf(x, dppf<0x128>(x));
  return x;
}
__device__ __forceinline__ float xrow16_sum(float x) {
  auto s = __builtin_amdgcn_permlane16_swap(__float_as_uint(x), __float_as_uint(x), false, false);
  x = __uint_as_float(s[0]) + __uint_as_float(s[1]);
  auto t = __builtin_amdgcn_permlane32_swap(__float_as_uint(x), __float_as_uint(x), false, false);
  return __uint_as_float(t[0]) + __uint_as_float(t[1]);
}
__device__ __forceinline__ float wave_sum(float x) { return xrow16_sum(row16_sum(x)); }
__device__ __forceinline__ float wave_max(float x) {
  x = row16_max(x);
  auto s = __builtin_amdgcn_permlane16_swap(__float_as_uint(x), __float_as_uint(x), false, false);
  x = fmaxf(__uint_as_float(s[0]), __uint_as_float(s[1]));
  auto t = __builtin_amdgcn_permlane32_swap(__float_as_uint(x), __float_as_uint(x), false, false);
  return fmaxf(__uint_as_float(t[0]), __uint_as_float(t[1]));
}

__device__ __forceinline__ int tidx() {
  int t = threadIdx.x;
  asm volatile("" : "+v"(t));
  __builtin_assume(t >= 0 && t < NTHREADS);
  return t;
}
__device__ __forceinline__ float siluf(float v) { return v / (1.f + __expf(-v)); }
__device__ __forceinline__ float log_sigmoidf(float v) { return -log1pf(expf(-v)); }

#define LAS __attribute__((address_space(3)))
constexpr int BM = 256, BK = 64, HALF = 128, HTB = HALF * BK * 2, NXCD = 8, WGM = 8;
constexpr int KDIM = 1024;

__device__ __forceinline__ int lds_byte(int r, int c) {
  const int st = (r >> 4) * 2 + (c >> 5), rr = r & 15, cc = c & 31, ob = rr * 64 + cc * 2;
  return st * 1024 + (ob ^ (((ob >> 9) & 1) << 5));
}
__device__ __forceinline__ void stage_rc(int b, int& R, int& C) {
  const int st = b / 1024, sb = b % 1024, swz = sb ^ (((sb >> 9) & 1) << 5);
  R = (st >> 1) * 16 + swz / 64;
  C = (st & 1) * 32 + (swz % 64) / 2;
}
struct Sched {
  int pm0, pn0, nM, nN, G, c;
  __device__ __forceinline__ bool next(int i, int& pm, int& pn) const {
    const int nwg = nM * nN;
    const long L = (long)i * G + c;
    if (L >= nwg) return false;
    int wgid = (int)L;
    { const int q = nwg / NXCD, r = nwg % NXCD, xcd = wgid % NXCD, off = wgid / NXCD; wgid = (xcd < r ? xcd * (q + 1) : r * (q + 1) + (xcd - r) * q) + off; }
    const int nig = WGM * nN, gid = wgid / nig, fm = gid * WGM, gsz = (nM - fm) < WGM ? (nM - fm) : WGM;
    pm = pm0 + fm + ((wgid % nig) % gsz);
    pn = pn0 + (wgid % nig) / gsz;
    return true;
  }
};

template <class Epi>
__device__ __forceinline__ void gemm_phase(LAS unsigned char* lds, const bf16_t* __restrict__ Ag, const bf16_t* __restrict__ Btg, const Sched& S, const Epi& E) {
  const int tid = tidx(), wid = __builtin_amdgcn_readfirstlane(tid >> 6), lane = tid & 63, wr = wid >> 2, wc = wid & 3, fr = lane & 15, fq = lane >> 4;
  constexpr int K = KDIM, nt = K / BK;
  unsigned voffA[2];
#pragma unroll
  for (int i = 0; i < 2; ++i) { int R, C; stage_rc(tid * 16 + i * 8192, R, C); voffA[i] = (unsigned)(R * K + C) * 2u; }
  const size_t kstep = (size_t)(BK * 2);
  const size_t hstep = (size_t)HALF * K * 2;
  const size_t tstep = 2 * hstep;
  const unsigned ldsw = (unsigned)wid * 1024u;
  const int aoff = lds_byte(wr * 64 + fr, fq * 8), boff = lds_byte(wc * 32 + fr, fq * 8);
#define G_SA(b, h) (((b) * 2 + (h)) * HTB)
#define G_SB(b, h) ((4 + (b) * 2 + (h)) * HTB)
#define G_STAGE(bufoff, gbase) do { _Pragma("unroll") for (int _i = 0; _i < 2; ++_i) \
    __builtin_amdgcn_global_load_lds((const unsigned*)((const char*)(gbase) + voffA[_i]), (LAS unsigned*)(lds + (bufoff) + ldsw + _i * 8192), 16, 0, 0); } while (0)
#define G_LDA(dst, b, h) do { _Pragma("unroll") for (int m = 0; m < 4; ++m) _Pragma("unroll") for (int k = 0; k < 2; ++k) dst[m][k] = *(const LAS bf16x8*)(lds + G_SA(b, h) + aoff + m * 2048 + k * 1024); } while (0)
#define G_LDB(dst, b, h) do { _Pragma("unroll") for (int n = 0; n < 2; ++n) _Pragma("unroll") for (int k = 0; k < 2; ++k) dst[n][k] = *(const LAS bf16x8*)(lds + G_SB(b, h) + boff + n * 2048 + k * 1024); } while (0)
#define G_MMA(ai, bj, At, Bt) do { __builtin_amdgcn_s_setprio(1); _Pragma("unroll") for (int m = 0; m < 4; ++m) _Pragma("unroll") for (int n = 0; n < 2; ++n) _Pragma("unroll") for (int k = 0; k < 2; ++k) \
    acc[ai][bj][m][n] = __builtin_amdgcn_mfma_f32_16x16x32_bf16(Bt[n][k], At[m][k], acc[ai][bj][m][n], 0, 0, 0); __builtin_amdgcn_s_setprio(0); } while (0)
#define G_WAIT_V(n) asm volatile("s_waitcnt vmcnt(" #n ")" ::: "memory")
#define G_WAIT_L(n) asm volatile("s_waitcnt lgkmcnt(" #n ")" ::: "memory")
#define G_BAR __builtin_amdgcn_s_barrier()
#define G_SCHED __builtin_amdgcn_sched_barrier(0)
  int cpm, cpn, npm, npn, ui = 0;
  if (!S.next(0, cpm, cpn)) return;
  f32x4 acc[2][2][4][2];
#pragma unroll
  for (int a = 0; a < 2; ++a)
#pragma unroll
    for (int b = 0; b < 2; ++b)
#pragma unroll
      for (int m = 0; m < 4; ++m)
#pragma unroll
        for (int n = 0; n < 2; ++n) acc[a][b][m][n] = (f32x4){0.f, 0.f, 0.f, 0.f};
  bf16x8 At[4][2], B0[2][2], B1[2][2];
  const char* cA = (const char*)Ag + (size_t)cpm * tstep;
  const char* cB = (const char*)Btg + (size_t)cpn * tstep;
  G_STAGE(G_SB(0, 0), cB); G_STAGE(G_SA(0, 0), cA); G_STAGE(G_SB(0, 1), cB + hstep); G_STAGE(G_SA(0, 1), cA + hstep);
  if (wr == 1) G_BAR;
  G_WAIT_V(4); G_BAR;
  G_STAGE(G_SB(1, 0), cB + kstep); G_STAGE(G_SA(1, 0), cA + kstep); G_STAGE(G_SB(1, 1), cB + hstep + kstep);
  G_WAIT_V(6); G_BAR;
  for (;;) {
    const bool has_next = S.next(ui + 1, npm, npn);
    const char* nA = has_next ? (const char*)Ag + (size_t)npm * tstep : cA;
    const char* nB = has_next ? (const char*)Btg + (size_t)npn * tstep : cB;
    for (int t = 0; t < nt; t += 2) {
      const bool last = (t == nt - 2);
      const char* a1 = cA + (size_t)(t + 1) * kstep;
      const char* a2 = last ? nA : cA + (size_t)(t + 2) * kstep;
      const char* b2 = last ? nB : cB + (size_t)(t + 2) * kstep;
      const char* a3 = a2 + kstep;
      const char* b3 = b2 + kstep;
      G_LDB(B0, 0, 0); G_SCHED; G_LDA(At, 0, 0); G_STAGE(G_SA(1, 1), a1 + hstep);
      G_WAIT_L(8); G_BAR; G_WAIT_L(0); G_MMA(0, 0, At, B0); G_BAR; G_SCHED;
      G_LDB(B1, 0, 1); G_STAGE(G_SB(0, 0), b2);
      G_BAR; G_WAIT_L(0); G_MMA(0, 1, At, B1); G_BAR;
      G_LDA(At, 0, 1); G_STAGE(G_SA(0, 0), a2);
      G_BAR; G_WAIT_L(0); G_MMA(1, 0, At, B0); G_BAR; G_SCHED;
      G_STAGE(G_SB(0, 1), b2 + hstep);
      G_WAIT_V(6); G_BAR; G_MMA(1, 1, At, B1); G_BAR;
      G_LDB(B0, 1, 0); G_SCHED; G_LDA(At, 1, 0); G_STAGE(G_SA(0, 1), a2 + hstep);
      G_WAIT_L(8); G_BAR; G_WAIT_L(0); G_MMA(0, 0, At, B0); G_BAR; G_SCHED;
      G_LDB(B1, 1, 1); G_STAGE(G_SB(1, 0), b3);
      G_BAR; G_WAIT_L(0); G_MMA(0, 1, At, B1); G_BAR;
      G_LDA(At, 1, 1); G_STAGE(G_SA(1, 0), a3);
      G_BAR; G_WAIT_L(0); G_MMA(1, 0, At, B0); G_BAR; G_SCHED;
      G_STAGE(G_SB(1, 1), b3 + hstep);
      G_WAIT_V(6); G_BAR; G_MMA(1, 1, At, B1); G_BAR;
    }
    E(acc, cpm * BM, cpn * BM, wr, wc, fr, fq);
    if (!has_next) break;
#pragma unroll
    for (int a = 0; a < 2; ++a)
#pragma unroll
      for (int b = 0; b < 2; ++b)
#pragma unroll
        for (int m = 0; m < 4; ++m)
#pragma unroll
          for (int n = 0; n < 2; ++n) acc[a][b][m][n] = (f32x4){0.f, 0.f, 0.f, 0.f};
    cpm = npm; cpn = npn; cA = nA; cB = nB; ++ui;
  }
  G_WAIT_V(0);
  if (wr == 0) G_BAR;
  G_BAR;
#undef G_SA
#undef G_SB
#undef G_STAGE
#undef G_LDA
#undef G_LDB
#undef G_MMA
}

struct EpiInProj {
  bf16_t* P; int ldc; int layer; const float* cosT; const float* sinT;
  __device__ __forceinline__ void operator()(const f32x4 (&acc)[2][2][4][2], int brow, int bcol, int wr, int wc, int fr, int fq) const {
#pragma unroll
    for (int bj = 0; bj < 2; ++bj) {
      const int colbase = bcol + bj * HALF + wc * 32;
      bool rope, scl;
      if (layer == 0) { rope = colbase < 512; scl = (colbase >= 256 && colbase < 512); }
      else { rope = colbase < 1280; scl = colbase < 1024; }
#pragma unroll
      for (int ai = 0; ai < 2; ++ai)
#pragma unroll
        for (int m = 0; m < 4; ++m) {
          const int row = brow + ai * HALF + wr * 64 + m * 16 + fr;
          f32x4 v0 = acc[ai][bj][m][0], v1 = acc[ai][bj][m][1];
          if (rope && row >= NCTX) {
            const int t = (row - NCTX) & (SEQ - 1);
            const int pos = (wc & 1) ? (t & 63) : (t >> 6);
            const f32x4 cs = *(const f32x4*)(cosT + pos * 16 + fq * 4);
            const f32x4 sn = *(const f32x4*)(sinT + pos * 16 + fq * 4);
            const f32x4 o0 = v0 * cs - v1 * sn, o1 = v1 * cs + v0 * sn;
            v0 = o0; v1 = o1;
          }
          if (scl) { v0 *= 0.125f; v1 *= 0.125f; }
          bf16_t* rp = P + (size_t)row * ldc + colbase + fq * 4;
          u32x2 w0, w1;
          w0.x = cvt_pk_bf16(v0[0], v0[1]); w0.y = cvt_pk_bf16(v0[2], v0[3]);
          w1.x = cvt_pk_bf16(v1[0], v1[1]); w1.y = cvt_pk_bf16(v1[2], v1[3]);
          *(u32x2*)rp = w0;
          *(u32x2*)(rp + 16) = w1;
        }
    }
  }
};
struct EpiBf16 {
  bf16_t* P; int ldc;
  __device__ __forceinline__ void operator()(const f32x4 (&acc)[2][2][4][2], int brow, int bcol, int wr, int wc, int fr, int fq) const {
#pragma unroll
    for (int ai = 0; ai < 2; ++ai)
#pragma unroll
      for (int m = 0; m < 4; ++m) {
        const int row = brow + ai * HALF + wr * 64 + m * 16 + fr;
#pragma unroll
        for (int bj = 0; bj < 2; ++bj)
#pragma unroll
          for (int n = 0; n < 2; ++n) {
            const f32x4 v = acc[ai][bj][m][n];
            u32x2 w; w.x = cvt_pk_bf16(v[0], v[1]); w.y = cvt_pk_bf16(v[2], v[3]);
            *(u32x2*)(P + (size_t)row * ldc + bcol + bj * HALF + wc * 32 + n * 16 + fq * 4) = w;
          }
      }
  }
};
struct EpiResid {
  const float* hin_ctx; const float* hin_lat; float* hout_ctx; float* hout_lat; const float* gate;
  __device__ __forceinline__ void operator()(const f32x4 (&acc)[2][2][4][2], int brow, int bcol, int wr, int wc, int fr, int fq) const {
    const bool isctx = brow < NCTX;
    const int b = isctx ? 32 : ((brow - NCTX) >> 11);
    const float* hin = isctx ? hin_ctx + (size_t)brow * D : hin_lat + (size_t)(brow - NCTX) * D;
    float* hout = isctx ? hout_ctx + (size_t)brow * D : hout_lat + (size_t)(brow - NCTX) * D;
    const float* g = gate + (size_t)b * MODW;
#pragma unroll
    for (int bj = 0; bj < 2; ++bj)
#pragma unroll
      for (int n = 0; n < 2; ++n) {
        const int col = bcol + bj * HALF + wc * 32 + n * 16 + fq * 4;
        const f32x4 gv = *(const f32x4*)(g + col);
#pragma unroll
        for (int ai = 0; ai < 2; ++ai)
#pragma unroll
          for (int m = 0; m < 4; ++m) {
            const int r = ai * HALF + wr * 64 + m * 16 + fr;
            const f32x4 h = *(const f32x4*)(hin + (size_t)r * D + col);
            *(f32x4*)(hout + (size_t)r * D + col) = h + gv * acc[ai][bj][m][n];
          }
      }
  }
};

template <int MT, int NT>
__device__ __forceinline__ void mm_lds(const bf16_t* A, int lda, const bf16_t* B, int ldb, int K, f32x4 (&acc)[MT][NT], int fr, int fq) {
  for (int k0 = 0; k0 < K; k0 += 32) {
    bf16x8 af[MT], bf[NT];
#pragma unroll
    for (int m = 0; m < MT; ++m) af[m] = *(const bf16x8*)(A + (m * 16 + fr) * lda + k0 + fq * 8);
#pragma unroll
    for (int n = 0; n < NT; ++n) bf[n] = *(const bf16x8*)(B + (n * 16 + fr) * ldb + k0 + fq * 8);
#pragma unroll
    for (int m = 0; m < MT; ++m)
#pragma unroll
      for (int n = 0; n < NT; ++n) acc[m][n] = __builtin_amdgcn_mfma_f32_16x16x32_bf16(af[m], bf[n], acc[m][n], 0, 0, 0);
  }
}

__device__ void phase_prep(const Params& p, unsigned char* smem, int bid, int nb) {
  const int tid = tidx();
  for (int it = bid; it < 2 * 96; it += nb) {
    const int layer = it / 96, n0 = (it % 96) * 64;
    float* s = (float*)smem;
    for (int i = tid; i < 33 * 1024; i += NTHREADS) {
      const int b = i >> 10, k = i & 1023;
      const float v = (b < 32) ? p.c[b * 1024 + k] : p.c_ctx[k];
      s[k * 33 + b] = siluf(v);
    }
    __syncthreads();
    const int col = tid & 63, kg = tid >> 6;
    float acc[33];
#pragma unroll
    for (int b = 0; b < 33; ++b) acc[b] = 0.f;
    const float* W = p.ada_w + (size_t)layer * 1024 * MODW + n0 + col;
    for (int k = kg * 128; k < kg * 128 + 128; ++k) {
      const float w = W[(size_t)k * MODW];
      const float* sk = s + k * 33;
#pragma unroll
      for (int b = 0; b < 33; ++b) acc[b] += sk[b] * w;
    }
    __syncthreads();
    float* red = (float*)smem;
#pragma unroll
    for (int b = 0; b < 33; ++b) red[(kg * 33 + b) * 64 + col] = acc[b];
    __syncthreads();
    for (int i = tid; i < 33 * 64; i += NTHREADS) {
      const int b = i >> 6, cc = i & 63;
      float t = p.ada_b[layer * MODW + n0 + cc];
#pragma unroll
      for (int g = 0; g < 8; ++g) t += red[(g * 33 + b) * 64 + cc];
      p.mod[((size_t)layer * 33 + b) * MODW + n0 + cc] = t;
    }
    __syncthreads();
  }
  if (bid == nb - 1) {
    for (int i = tid; i < 1024; i += NTHREADS) {
      const int pos = i >> 4, f = i & 15;
      const float inv = powf(10000.f, -(float)f / 16.f);
      const float ang = (float)pos * inv;
      p.ropec[i] = cosf(ang);
      p.ropes[i] = sinf(ang);
    }
  }
  {
    float* tile = (float*)smem;
    const int ntile_total = 768 + 256 + 384 + 256 + 512;
    for (int it = bid; it < ntile_total; it += nb) {
      const float* src; bf16_t* dst; int N, ti;
      if (it < 768) { src = p.ev_w_in; dst = p.winT0; N = 3072; ti = it; }
      else if (it < 1024) { src = p.ev_w_out; dst = p.woutT0; N = 1024; ti = it - 768; }
      else if (it < 1408) { src = p.od_w_in; dst = p.winT1; N = 1536; ti = it - 1024; }
      else if (it < 1664) { src = p.od_w_out; dst = p.woutT1; N = 1024; ti = it - 1408; }
      else { const int l = (it - 1664) / 256; src = p.peer_wq + (size_t)l * 1024 * 1024; dst = p.wqT + (size_t)l * 1024 * 1024; N = 1024; ti = (it - 1664) % 256; }
      const int ntn = N / 64, tk = ti / ntn, tn = ti % ntn;
      __syncthreads();
      for (int i = tid; i < 64 * 64; i += NTHREADS) {
        const int r = i >> 6, cc = i & 63;
        tile[r * 65 + cc] = src[(size_t)(tk * 64 + r) * N + tn * 64 + cc];
      }
      __syncthreads();
      for (int i = tid; i < 64 * 32; i += NTHREADS) {
        const int nn = i >> 5, kk = (i & 31) * 2;
        const unsigned w = cvt_pk_bf16(tile[kk * 65 + nn], tile[(kk + 1) * 65 + nn]);
        *(unsigned*)(dst + (size_t)(tn * 64 + nn) * 1024 + tk * 64 + kk) = w;
      }
    }
    __syncthreads();
  }
  for (int idx = bid * NTHREADS + tid; idx < 2 * 8 * 2 * 128 * 64; idx += nb * NTHREADS) {
    const int d = idx & 63, k = (idx >> 6) & 127, s = (idx >> 13) & 1, hh = (idx >> 14) & 7, l = idx >> 17;
    const float v = (s ? p.keys2 : p.keys1)[((size_t)(l * 8 + hh) * 128 + k) * 64 + d];
    const bf16_t hi = f2bf(v);
    const bf16_t lo = f2bf(v - bf2f(hi));
    const size_t o = ((size_t)((l * 8 + hh) * 2 + s) * 2) * 8192 + (size_t)k * 64 + d;
    p.keysb[o] = hi;
    p.keysb[o + 8192] = lo;
  }
  {
    const int wid = tid >> 6, lane = tid & 63;
    for (int r = bid * 8 + wid; r < 4 * NEXP; r += nb * 8) {
      const bool isv = r >= 2 * NEXP;
      const int rr = isv ? r - 2 * NEXP : r;
      const float* src = (isv ? p.peer_v : p.peer_u) + (size_t)rr * D + lane * 16;
      f32x4 a[4];
      float mx = 0.f;
#pragma unroll
      for (int i = 0; i < 4; ++i) {
        a[i] = *(const f32x4*)(src + i * 4);
        mx = fmaxf(mx, fmaxf(fmaxf(fabsf(a[i][0]), fabsf(a[i][1])), fmaxf(fabsf(a[i][2]), fabsf(a[i][3]))));
      }
      mx = wave_max(mx);
      const float sc = mx > 0.f ? 240.f / mx : 1.f;
      u32x4 w;
#pragma unroll
      for (int i = 0; i < 4; ++i) {
        int t = __builtin_amdgcn_cvt_pk_fp8_f32(a[i][0] * sc, a[i][1] * sc, 0, false);
        t = __builtin_amdgcn_cvt_pk_fp8_f32(a[i][2] * sc, a[i][3] * sc, t, true);
        w[i] = (unsigned)t;
      }
      *(u32x4*)((isv ? p.v8 : p.u8) + (size_t)rr * D + lane * 16) = w;
      if (lane == 0) (isv ? p.vscale : p.uscale)[rr] = mx > 0.f ? mx / 240.f : 1.f;
    }
  }
}

__device__ void phase_norm(const Params& p, int bid, int nb, int row0, int row1, const float* hctx, const float* hlat,
                           const float* gain, const float* modl, int ish, int isc) {
  const int tid0 = tidx();
  const int wid = tid0 >> 6, lane = tid0 & 63;
  for (int row = row0 + bid * 8 + wid; row < row1; row += nb * 8) {
    const bool isctx = row < NCTX;
    const float* h = isctx ? hctx + (size_t)row * D : hlat + (size_t)(row - NCTX) * D;
    const int b = isctx ? 32 : ((row - NCTX) >> 11);
    const float* sh = modl + (size_t)b * MODW + ish * D;
    const float* sc = modl + (size_t)b * MODW + isc * D;
    f32x4 v[4];
    float ss = 0.f;
#pragma unroll
    for (int i = 0; i < 4; ++i) {
      v[i] = *(const f32x4*)(h + i * 256 + lane * 4);
      ss += v[i][0] * v[i][0] + v[i][1] * v[i][1] + v[i][2] * v[i][2] + v[i][3] * v[i][3];
    }
    ss = wave_sum(ss);
    const float rstd = rsqrtf(ss * (1.f / D) + EPS);
#pragma unroll
    for (int i = 0; i < 4; ++i) {
      const int col = i * 256 + lane * 4;
      const f32x4 g = *(const f32x4*)(gain + col), s1 = *(const f32x4*)(sc + col), s0 = *(const f32x4*)(sh + col);
      f32x4 y = v[i] * rstd * g;
      y = y * (1.f + s1) + s0;
      u32x2 w; w.x = cvt_pk_bf16(y[0], y[1]); w.y = cvt_pk_bf16(y[2], y[3]);
      *(u32x2*)(p.act + (size_t)row * D + col) = w;
    }
  }
}

__device__ __forceinline__ void phase_gemm_inproj(const Params& p, unsigned char* smem, int bid, int nb, int layer) {
  LAS unsigned char* lds = (LAS unsigned char*)smem;
  if (layer == 0) {
    EpiInProj epi{p.proj, 3072, 0, p.ropec, p.ropes};
    Sched s{0, 0, NTOK / BM, 12, nb, bid};
    gemm_phase(lds, p.act, p.winT0, s, epi);
  } else {
    EpiInProj epi{p.proj, 1536, 1, p.ropec, p.ropes};
    Sched s{NCTX / BM, 0, NLAT / BM, 6, nb, bid};
    gemm_phase(lds, p.act, p.winT1, s, epi);
    Sched s2{0, 4, NCTX / BM, 2, nb, bid};
    gemm_phase(lds, p.act, p.winT1, s2, epi);
  }
}
__device__ __forceinline__ void phase_gemm_outproj(const Params& p, unsigned char* smem, int bid, int nb, int layer) {
  LAS unsigned char* lds = (LAS unsigned char*)smem;
  if (layer == 0) {
    EpiResid epi{p.ctx, p.x, p.hctx, p.out, p.mod + 2 * D};
    Sched s{0, 0, NTOK / BM, 4, nb, bid};
    gemm_phase(lds, p.act, p.woutT0, s, epi);
  } else {
    EpiResid epi{p.hctx, p.out, p.hctx, p.out, p.mod + (size_t)33 * MODW + 2 * D};
    Sched s{NCTX / BM, 0, NLAT / BM, 4, nb, bid};
    gemm_phase(lds, p.act, p.woutT1, s, epi);
  }
}
__device__ __forceinline__ void phase_gemm_pq(const Params& p, unsigned char* smem, int bid, int nb, int layer) {
  LAS unsigned char* lds = (LAS unsigned char*)smem;
  EpiBf16 epi{p.pq, D};
  const int pm0 = layer == 0 ? 0 : NCTX / BM;
  Sched s{pm0, 0, NTOK / BM - pm0, 4, nb, bid};
  gemm_phase(lds, p.act, p.wqT + (size_t)layer * D * D, s, epi);
}

__device__ __forceinline__ int chunk_row0(int b, int cc) { return cc < 2 ? b * CTXL + cc * 128 : NCTX + b * SEQ + (cc - 2) * 128; }

constexpr int LDP = 136;
constexpr int LDK = 72;

__device__ void phase_ret_kv(const Params& p, unsigned char* smem, int bid, int nb) {
  const int tid = tidx(), wid = tid >> 6, lane = tid & 63, fr = lane & 15, fq = lane >> 4;
  bf16_t* KxT = (bf16_t*)smem;
  bf16_t* VT = KxT + 128 * LDP;
  for (int it = bid; it < BATCH * 4 * 18; it += nb) {
    const int cc = it % 18, h = (it / 18) & 3, b = it / 72;
    const int row0 = chunk_row0(b, cc);
    const float lf = log_sigmoidf(p.logit_f[h]), lb = log_sigmoidf(p.logit_b[h]);
    __syncthreads();
    for (int task = tid; task < 128 * 8; task += NTHREADS) {
      const int j = task >> 3, d0 = (task & 7) * 8;
      const u32x4 kk = *(const u32x4*)(p.proj + (size_t)(row0 + j) * 3072 + 256 + h * 64 + d0);
      const float zf = __expf(lf * (float)(127 - j)), zb = __expf(lb * (float)j);
#pragma unroll
      for (int q = 0; q < 4; ++q) {
        const float lo = bf_lo(kk[q]), hi = bf_hi(kk[q]);
        KxT[(d0 + 2 * q) * LDP + j] = f2bf(lo * zf);
        KxT[(d0 + 2 * q + 1) * LDP + j] = f2bf(hi * zf);
        KxT[(64 + d0 + 2 * q) * LDP + j] = f2bf(lo * zb);
        KxT[(64 + d0 + 2 * q + 1) * LDP + j] = f2bf(hi * zb);
      }
    }
    for (int task = tid; task < 128 * 16; task += NTHREADS) {
      const int j = task >> 4, e0 = (task & 15) * 8;
      const u32x4 vv = *(const u32x4*)(p.proj + (size_t)(row0 + j) * 3072 + 512 + h * 128 + e0);
#pragma unroll
      for (int q = 0; q < 4; ++q) {
        VT[(e0 + 2 * q) * LDP + j] = (bf16_t)(vv[q] & 0xffffu);
        VT[(e0 + 2 * q + 1) * LDP + j] = (bf16_t)(vv[q] >> 16);
      }
    }
    __syncthreads();
    f32x4 acc[1][8] = {};
    mm_lds<1, 8>(VT + wid * 16 * LDP, LDP, KxT, LDP, 128, acc, fr, fq);
    float* out = p.kv + (size_t)it * 16384;
#pragma unroll
    for (int n = 0; n < 8; ++n)
#pragma unroll
      for (int j = 0; j < 4; ++j) out[(wid * 16 + fq * 4 + j) * 128 + n * 16 + fr] = acc[0][n][j];
  }
  for (size_t task = (size_t)bid * NTHREADS + tid; task < (size_t)NTOK * 64; task += (size_t)nb * NTHREADS) {
    const int row = (int)(task >> 6), c0 = (int)(task & 63) * 8;
    const int tin = row < NCTX ? (row & (CTXL - 1)) : ((row - NCTX) & (SEQ - 1));
    const int tlen = row < NCTX ? CTXL : SEQ;
    const bf16_t* pr = p.proj + (size_t)row * 3072;
    const u32x4 gb = *(const u32x4*)(pr + 1536 + c0);
    float accv[8];
#pragma unroll
    for (int q = 0; q < 8; ++q) accv[q] = 0.f;
#pragma unroll
    for (int dt = -1; dt <= 1; ++dt) {
      if (tin + dt < 0 || tin + dt >= tlen) continue;
      const bf16_t* pr2 = pr + (ptrdiff_t)dt * 3072;
      const u32x4 gc = *(const u32x4*)(pr2 + 2048 + c0), xt = *(const u32x4*)(pr2 + 2560 + c0);
      const float* w = p.conv_w + (dt + 1) * 512 + c0;
      const f32x4 wa = *(const f32x4*)w, wb = *(const f32x4*)(w + 4);
#pragma unroll
      for (int q = 0; q < 4; ++q) {
        const float u0 = bf_lo(gc[q]) * bf_lo(xt[q]), u1 = bf_hi(gc[q]) * bf_hi(xt[q]);
        const float w0 = (2 * q < 4) ? wa[2 * q] : wb[2 * q - 4], w1 = (2 * q + 1 < 4) ? wa[2 * q + 1] : wb[2 * q + 1 - 4];
        accv[2 * q] += w0 * u0;
        accv[2 * q + 1] += w1 * u1;
      }
    }
    u32x4 o;
#pragma unroll
    for (int q = 0; q < 4; ++q) o[q] = cvt_pk_bf16(bf_lo(gb[q]) * accv[2 * q], bf_hi(gb[q]) * accv[2 * q + 1]);
#ifdef ZERO_CONV
    o = (u32x4){0u, 0u, 0u, 0u};
#endif
    *(u32x4*)(p.act + (size_t)row * D + 512 + c0) = o;
  }
}

__device__ void phase_ret_scan(const Params& p, int bid, int nb) {
  const int tid = tidx();
  for (size_t idx = (size_t)bid * NTHREADS + tid; idx < (size_t)BATCH * 4 * 16384; idx += (size_t)nb * NTHREADS) {
    const int el = (int)(idx & 16383), bh = (int)(idx >> 14), h = bh & 3;
    const bool fwd = (el & 127) < 64;
    const float lg = log_sigmoidf(fwd ? p.logit_f[h] : p.logit_b[h]);
    const float dec = __expf(lg * 128.f);
    float st = 0.f;
    for (int s = 0; s < 18; ++s) {
      const int cc = fwd ? s : (s < 2 ? 1 - s : 19 - s);
      const size_t off = ((size_t)bh * 18 + cc) * 16384 + el;
      p.sprev[off] = f2bf(st);
      st = dec * st + p.kv[off];
    }
  }
}

__device__ void phase_ret_out(const Params& p, unsigned char* smem, int bid, int nb) {
  const int tid = tidx(), wid = tid >> 6, lane = tid & 63, fr = lane & 15, fq = lane >> 4;
  bf16_t* Kt = (bf16_t*)smem;
  bf16_t* VT = Kt + 128 * LDK;
  bf16_t* ST = VT + 128 * LDP;
  bf16_t* Pb = ST + 128 * LDP;
  for (int it = bid; it < BATCH * 4 * 18; it += nb) {
    const int cc = it % 18, h = (it / 18) & 3, b = it / 72;
    const int row0 = chunk_row0(b, cc);
    const float lf = log_sigmoidf(p.logit_f[h]), lb = log_sigmoidf(p.logit_b[h]);
    __syncthreads();
    for (int task = tid; task < 128 * 8; task += NTHREADS) {
      const int j = task >> 3, d0 = (task & 7) * 8;
      *(u32x4*)(Kt + j * LDK + d0) = *(const u32x4*)(p.proj + (size_t)(row0 + j) * 3072 + 256 + h * 64 + d0);
    }
    for (int task = tid; task < 128 * 16; task += NTHREADS) {
      const int j = task >> 4, e0 = (task & 15) * 8;
      const u32x4 vv = *(const u32x4*)(p.proj + (size_t)(row0 + j) * 3072 + 512 + h * 128 + e0);
#pragma unroll
      for (int q = 0; q < 4; ++q) {
        VT[(e0 + 2 * q) * LDP + j] = (bf16_t)(vv[q] & 0xffffu);
        VT[(e0 + 2 * q + 1) * LDP + j] = (bf16_t)(vv[q] >> 16);
      }
      const int e = j;
      *(u32x4*)(ST + e * LDP + e0) = *(const u32x4*)(p.sprev + (size_t)it * 16384 + e * 128 + e0);
    }
    const int irow = wid * 16 + fr;
    bf16x8 qf[2];
#pragma unroll
    for (int ks = 0; ks < 2; ++ks) qf[ks] = *(const bf16x8*)(p.proj + (size_t)(row0 + irow) * 3072 + h * 64 + ks * 32 + fq * 8);
    __syncthreads();
    f32x4 sacc[8] = {};
#pragma unroll
    for (int ks = 0; ks < 2; ++ks)
#pragma unroll
      for (int n = 0; n < 8; ++n) {
        const bf16x8 kf = *(const bf16x8*)(Kt + (n * 16 + fr) * LDK + ks * 32 + fq * 8);
        sacc[n] = __builtin_amdgcn_mfma_f32_16x16x32_bf16(qf[ks], kf, sacc[n], 0, 0, 0);
      }
#pragma unroll
    for (int n = 0; n < 8; ++n)
#pragma unroll
      for (int jj = 0; jj < 4; ++jj) {
        const int i = wid * 16 + fq * 4 + jj, j = n * 16 + fr;
        const int df = i - j;
        const float dm = df > 0 ? __expf(lf * (float)df) : (df < 0 ? __expf(lb * (float)(-df)) : 2.f);
        Pb[i * LDP + j] = f2bf(sacc[n][jj] * dm);
      }
    __syncthreads();
    f32x4 oacc[1][8] = {};
    mm_lds<1, 8>(Pb + wid * 16 * LDP, LDP, VT, LDP, 128, oacc, fr, fq);
    {
      const float xf = __expf(lf * (float)(irow + 1)), xb = __expf(lb * (float)(128 - irow));
#pragma unroll
      for (int ks = 0; ks < 4; ++ks) {
        const float sc = ks < 2 ? xf : xb;
        const bf16x8 qs = qf[ks & 1];
        u32x4 qu = __builtin_bit_cast(u32x4, qs), qo;
#pragma unroll
        for (int q = 0; q < 4; ++q) qo[q] = cvt_pk_bf16(bf_lo(qu[q]) * sc, bf_hi(qu[q]) * sc);
        const bf16x8 qx = __builtin_bit_cast(bf16x8, qo);
#pragma unroll
        for (int n = 0; n < 8; ++n) {
          const bf16x8 sf = *(const bf16x8*)(ST + (n * 16 + fr) * LDP + ks * 32 + fq * 8);
          oacc[0][n] = __builtin_amdgcn_mfma_f32_16x16x32_bf16(qx, sf, oacc[0][n], 0, 0, 0);
        }
      }
    }
#pragma unroll
    for (int jj = 0; jj < 4; ++jj) {
      float ss = 0.f;
#pragma unroll
      for (int n = 0; n < 8; ++n) ss += oacc[0][n][jj] * oacc[0][n][jj];
      ss = row16_sum(ss);
      const float rstd = rsqrtf(ss * (1.f / 128.f) + EPS);
      const int row = row0 + wid * 16 + fq * 4 + jj;
#pragma unroll
      for (int n = 0; n < 8; ++n) {
        const int e = n * 16 + fr;
        const float g = bf2f(p.proj[(size_t)row * 3072 + 1024 + h * 128 + e]);
#ifdef ZERO_RET
        p.act[(size_t)row * D + h * 128 + e] = 0;
#else
        p.act[(size_t)row * D + h * 128 + e] = f2bf(oacc[0][n][jj] * rstd * siluf(g));
#endif
      }
    }
  }
}

__device__ void phase_attn(const Params& p, unsigned char* smem, int bid, int nb) {
  const int tid = tidx(), wid = tid >> 6, lane = tid & 63, fr = lane & 15, fq = lane >> 4;
  bf16_t* Kt = (bf16_t*)smem;
  bf16_t* VT = Kt + 64 * LDK;
  bf16_t* Pw = VT + 64 * LDK + wid * 64 * LDK;
  for (int it = bid; it < BATCH * 16 * 4; it += nb) {
    const int kvh = it & 3, qb = (it >> 2) & 15, b = it >> 6;
    const int hq = kvh * 4 + (wid >> 1);
    const int q0 = qb * 128 + (wid & 1) * 64;
    const size_t latrow0 = (size_t)NCTX + (size_t)b * SEQ;
    bf16x8 qf[4][2];
#pragma unroll
    for (int m = 0; m < 4; ++m)
#pragma unroll
      for (int ks = 0; ks < 2; ++ks)
        qf[m][ks] = *(const bf16x8*)(p.proj + (latrow0 + q0 + m * 16 + fr) * 1536 + hq * 64 + ks * 32 + fq * 8);
    const float sink = p.sinks[hq];
    float mrow[4][4], lrow[4][4];
    f32x4 oacc[4][4] = {};
#pragma unroll
    for (int m = 0; m < 4; ++m)
#pragma unroll
      for (int jj = 0; jj < 4; ++jj) { mrow[m][jj] = sink; lrow[m][jj] = (fr == 0) ? 1.f : 0.f; }
    for (int tt = 0; tt < 10; ++tt) {
      const bool win = tt < 6;
      const int kpos0 = win ? qb * 128 - 128 + 64 * tt : (tt - 6) * 64;
      if (win && (kpos0 < 0 || kpos0 >= SEQ)) continue;
      const size_t krow0 = win ? latrow0 + kpos0 : (size_t)b * CTXL + kpos0;
      __syncthreads();
      {
        const int j = tid >> 3, d0 = (tid & 7) * 8;
        *(u32x4*)(Kt + j * LDK + d0) = *(const u32x4*)(p.proj + (krow0 + j) * 1536 + 1024 + kvh * 64 + d0);
        const u32x4 vv = *(const u32x4*)(p.proj + (krow0 + j) * 1536 + 1280 + kvh * 64 + d0);
#pragma unroll
        for (int q = 0; q < 4; ++q) {
          VT[(d0 + 2 * q) * LDK + j] = (bf16_t)(vv[q] & 0xffffu);
          VT[(d0 + 2 * q + 1) * LDK + j] = (bf16_t)(vv[q] >> 16);
        }
      }
      __syncthreads();
#pragma unroll
      for (int m = 0; m < 4; ++m) {
        f32x4 sacc[4];
#pragma unroll
        for (int n = 0; n < 4; ++n) sacc[n] = (f32x4){0.f, 0.f, 0.f, 0.f};
#pragma unroll
        for (int ks = 0; ks < 2; ++ks)
#pragma unroll
          for (int n = 0; n < 4; ++n) {
            const bf16x8 kf = *(const bf16x8*)(Kt + (n * 16 + fr) * LDK + ks * 32 + fq * 8);
            sacc[n] = __builtin_amdgcn_mfma_f32_16x16x32_bf16(qf[m][ks], kf, sacc[n], 0, 0, 0);
          }
#pragma unroll
        for (int jj = 0; jj < 4; ++jj) {
          const int qpos = q0 + m * 16 + fq * 4 + jj;
          float mx = -3.0e38f;
#pragma unroll
          for (int n = 0; n < 4; ++n) {
            float s = sacc[n][jj];
            if (win) { const int dd = qpos - (kpos0 + n * 16 + fr); if (dd > 128 || dd < -128) s = -1e30f; }
            sacc[n][jj] = s;
            mx = fmaxf(mx, s);
          }
          mx = row16_max(mx);
          const float mnew = fmaxf(mrow[m][jj], mx);
          const float alpha = __expf(mrow[m][jj] - mnew);
          mrow[m][jj] = mnew;
          float ls = 0.f;
#pragma unroll
          for (int n = 0; n < 4; ++n) {
            const float pv = __expf(sacc[n][jj] - mnew);
            ls += pv;
            Pw[(m * 16 + fq * 4 + jj) * LDK + n * 16 + fr] = f2bf(pv);
          }
          lrow[m][jj] = lrow[m][jj] * alpha + ls;
#pragma unroll
          for (int n = 0; n < 4; ++n) oacc[m][n][jj] *= alpha;
        }
      }
      __syncthreads();
      mm_lds<4, 4>(Pw, LDK, VT, LDK, 64, oacc, fr, fq);
    }
#pragma unroll
    for (int m = 0; m < 4; ++m)
#pragma unroll
      for (int jj = 0; jj < 4; ++jj) {
        const float l = row16_sum(lrow[m][jj]);
        const float inv = 1.f / l;
        const size_t row = latrow0 + q0 + m * 16 + fq * 4 + jj;
#pragma unroll
        for (int n = 0; n < 4; ++n) {
#ifdef ZERO_ATTN
          p.act[row * D + hq * 64 + n * 16 + fr] = 0;
#else
          p.act[row * D + hq * 64 + n * 16 + fr] = f2bf(oacc[m][n][jj] * inv);
#endif
        }
      }
  }
}

#define CEX(a, b) do { const unsigned _h = max(a, b), _l = min(a, b); a = _h; b = _l; } while (0)
__device__ __forceinline__ void sort16_desc(unsigned (&v)[16]) { CEX(v[0], v[1]); CEX(v[2], v[3]); CEX(v[0], v[2]); CEX(v[1], v[3]); CEX(v[1], v[2]); CEX(v[4], v[5]); CEX(v[6], v[7]); CEX(v[4], v[6]); CEX(v[5], v[7]); CEX(v[5], v[6]); CEX(v[0], v[4]); CEX(v[2], v[6]); CEX(v[2], v[4]); CEX(v[1], v[5]); CEX(v[3], v[7]); CEX(v[3], v[5]); CEX(v[1], v[2]); CEX(v[3], v[4]); CEX(v[5], v[6]); CEX(v[8], v[9]); CEX(v[10], v[11]); CEX(v[8], v[10]); CEX(v[9], v[11]); CEX(v[9], v[10]); CEX(v[12], v[13]); CEX(v[14], v[15]); CEX(v[12], v[14]); CEX(v[13], v[15]); CEX(v[13], v[14]); CEX(v[8], v[12]); CEX(v[10], v[14]); CEX(v[10], v[12]); CEX(v[9], v[13]); CEX(v[11], v[15]); CEX(v[11], v[13]); CEX(v[9], v[10]); CEX(v[11], v[12]); CEX(v[13], v[14]); CEX(v[0], v[8]); CEX(v[4], v[12]); CEX(v[4], v[8]); CEX(v[2], v[10]); CEX(v[6], v[14]); CEX(v[6], v[10]); CEX(v[2], v[4]); CEX(v[6], v[8]); CEX(v[10], v[12]); CEX(v[1], v[9]); CEX(v[5], v[13]); CEX(v[5], v[9]); CEX(v[3], v[11]); CEX(v[7], v[15]); CEX(v[7], v[11]); CEX(v[3], v[5]); CEX(v[7], v[9]); CEX(v[11], v[13]); CEX(v[1], v[2]); CEX(v[3], v[4]); CEX(v[5], v[6]); CEX(v[7], v[8]); CEX(v[9], v[10]); CEX(v[11], v[12]); CEX(v[13], v[14]); }
__device__ __forceinline__ void merge16_desc(unsigned (&t)[16], const unsigned (&b)[16]) {
#pragma unroll
  for (int i = 0; i < 16; ++i) t[i] = max(t[i], b[15 - i]);
  CEX(t[0], t[8]); CEX(t[1], t[9]); CEX(t[2], t[10]); CEX(t[3], t[11]); CEX(t[4], t[12]); CEX(t[5], t[13]); CEX(t[6], t[14]); CEX(t[7], t[15]); CEX(t[0], t[4]); CEX(t[1], t[5]); CEX(t[2], t[6]); CEX(t[3], t[7]); CEX(t[8], t[12]); CEX(t[9], t[13]); CEX(t[10], t[14]); CEX(t[11], t[15]); CEX(t[0], t[2]); CEX(t[1], t[3]); CEX(t[4], t[6]); CEX(t[5], t[7]); CEX(t[8], t[10]); CEX(t[9], t[11]); CEX(t[12], t[14]); CEX(t[13], t[15]); CEX(t[0], t[1]); CEX(t[2], t[3]); CEX(t[4], t[5]); CEX(t[6], t[7]); CEX(t[8], t[9]); CEX(t[10], t[11]); CEX(t[12], t[13]); CEX(t[14], t[15]);
}

__device__ __forceinline__ unsigned f2ord(float f) { const unsigned u = __float_as_uint(f); return (u & 0x80000000u) ? ~u : (u | 0x80000000u); }
__device__ __forceinline__ float ord2f(unsigned k) { const unsigned u = (k & 0x80000000u) ? (k & 0x7fffffffu) : ~k; return __uint_as_float(u); }
__device__ __forceinline__ unsigned dpp_xor1(unsigned x) { return (unsigned)__builtin_amdgcn_mov_dpp((int)x, 0xB1, 0xf, 0xf, true); }

__device__ void phase_peer_topk(const Params& p, unsigned char* smem, int bid, int nb, int layer, int tok0, int ntok) {
  const int tid = tidx(), wid = __builtin_amdgcn_readfirstlane(tid >> 6), lane = tid & 63, fr = lane & 15, fq = lane >> 4;
  LAS unsigned* sc = (LAS unsigned*)smem + wid * (64 * 36 + 64 * 16);
  LAS unsigned* fl = sc + 64 * 36;
  const int ls = lane & 1;
  const int nitem = (ntok / 256) * 8;
  for (int it = bid; it < nitem; it += nb) {
    const int h = it & 7, tile = it >> 3;
    const int tokw0 = tok0 + tile * 256 + wid * 32;
    bf16x8 qa[2][2][2];
#pragma unroll
    for (int m = 0; m < 2; ++m)
#pragma unroll
      for (int s = 0; s < 2; ++s)
#pragma unroll
        for (int ks = 0; ks < 2; ++ks)
          qa[m][s][ks] = *(const bf16x8*)(p.pq + (size_t)(tokw0 + m * 16 + fr) * D + h * 128 + s * 64 + ks * 32 + fq * 8);
    unsigned top[16];
#pragma unroll
    for (int i = 0; i < 16; ++i) top[i] = 0u;
    const bf16_t* kb = p.keysb + (size_t)(layer * 8 + h) * (2 * 2 * 128 * 64);
#pragma unroll 1
    for (int c = 0; c < 4; ++c) {
      f32x4 acc[2][2][2];
#pragma unroll
      for (int m = 0; m < 2; ++m)
#pragma unroll
        for (int s = 0; s < 2; ++s)
#pragma unroll
          for (int n = 0; n < 2; ++n) acc[m][s][n] = (f32x4){0.f, 0.f, 0.f, 0.f};
#pragma unroll
      for (int s = 0; s < 2; ++s)
#pragma unroll
        for (int hl = 0; hl < 2; ++hl)
#pragma unroll
          for (int n = 0; n < 2; ++n)
#pragma unroll
            for (int ks = 0; ks < 2; ++ks) {
              const bf16x8 bfr = *(const bf16x8*)(kb + (size_t)((s * 2 + hl) * 128 + c * 32 + n * 16 + fr) * 64 + ks * 32 + fq * 8);
#pragma unroll
              for (int m = 0; m < 2; ++m) acc[m][s][n] = __builtin_amdgcn_mfma_f32_16x16x32_bf16(qa[m][s][ks], bfr, acc[m][s][n], 0, 0, 0);
            }
#pragma unroll
      for (int m = 0; m < 2; ++m)
#pragma unroll
        for (int s = 0; s < 2; ++s)
#pragma unroll
          for (int n = 0; n < 2; ++n)
#pragma unroll
            for (int j = 0; j < 4; ++j)
              sc[((m * 16 + fq * 4 + j) * 2 + s) * 36 + n * 16 + fr] = (f2ord(acc[m][s][n][j]) & 0xffffff80u) | (unsigned)(127 - (c * 32 + n * 16 + fr));
      unsigned b0[16], b1[16];
#pragma unroll
      for (int q = 0; q < 4; ++q) {
        const u32x4 w0 = *(const LAS u32x4*)(sc + lane * 36 + q * 4), w1 = *(const LAS u32x4*)(sc + lane * 36 + 16 + q * 4);
        b0[4 * q] = w0.x; b0[4 * q + 1] = w0.y; b0[4 * q + 2] = w0.z; b0[4 * q + 3] = w0.w;
        b1[4 * q] = w1.x; b1[4 * q + 1] = w1.y; b1[4 * q + 2] = w1.z; b1[4 * q + 3] = w1.w;
      }
      sort16_desc(b0); merge16_desc(top, b0);
      sort16_desc(b1); merge16_desc(top, b1);
    }
#pragma unroll
    for (int q = 0; q < 4; ++q) { u32x4 w; w.x = top[4 * q]; w.y = top[4 * q + 1]; w.z = top[4 * q + 2]; w.w = top[4 * q + 3]; *(LAS u32x4*)(fl + lane * 16 + q * 4) = w; }
    float own[16], oth[16];
#pragma unroll
    for (int q = 0; q < 4; ++q) {
      const u32x4 w = *(const LAS u32x4*)(fl + (lane ^ 1) * 16 + q * 4);
      oth[4 * q] = ord2f(w.x & 0xffffff80u); oth[4 * q + 1] = ord2f(w.y & 0xffffff80u); oth[4 * q + 2] = ord2f(w.z & 0xffffff80u); oth[4 * q + 3] = ord2f(w.w & 0xffffff80u);
    }
#pragma unroll
    for (int i = 0; i < 16; ++i) own[i] = ord2f(top[i] & 0xffffff80u);
    unsigned ck[32];
    ck[0] = (f2ord(own[0] + oth[1]) & 0xffffff00u) | (255u - (ls ? 16u : 1u));
    ck[1] = (f2ord(own[0] + oth[2]) & 0xffffff00u) | (255u - (ls ? 32u : 2u));
    ck[2] = (f2ord(own[0] + oth[3]) & 0xffffff00u) | (255u - (ls ? 48u : 3u));
    ck[3] = (f2ord(own[0] + oth[4]) & 0xffffff00u) | (255u - (ls ? 64u : 4u));
    ck[4] = (f2ord(own[0] + oth[5]) & 0xffffff00u) | (255u - (ls ? 80u : 5u));
    ck[5] = (f2ord(own[0] + oth[6]) & 0xffffff00u) | (255u - (ls ? 96u : 6u));
    ck[6] = (f2ord(own[0] + oth[7]) & 0xffffff00u) | (255u - (ls ? 112u : 7u));
    ck[7] = (f2ord(own[0] + oth[8]) & 0xffffff00u) | (255u - (ls ? 128u : 8u));
    ck[8] = (f2ord(own[0] + oth[9]) & 0xffffff00u) | (255u - (ls ? 144u : 9u));
    ck[9] = (f2ord(own[0] + oth[10]) & 0xffffff00u) | (255u - (ls ? 160u : 10u));
    ck[10] = (f2ord(own[0] + oth[11]) & 0xffffff00u) | (255u - (ls ? 176u : 11u));
    ck[11] = (f2ord(own[0] + oth[12]) & 0xffffff00u) | (255u - (ls ? 192u : 12u));
    ck[12] = (f2ord(own[0] + oth[13]) & 0xffffff00u) | (255u - (ls ? 208u : 13u));
    ck[13] = (f2ord(own[0] + oth[14]) & 0xffffff00u) | (255u - (ls ? 224u : 14u));
    ck[14] = (f2ord(own[0] + oth[15]) & 0xffffff00u) | (255u - (ls ? 240u : 15u));
    ck[15] = (f2ord(own[1] + oth[2]) & 0xffffff00u) | (255u - (ls ? 33u : 18u));
    ck[16] = (f2ord(own[1] + oth[3]) & 0xffffff00u) | (255u - (ls ? 49u : 19u));
    ck[17] = (f2ord(own[1] + oth[4]) & 0xffffff00u) | (255u - (ls ? 65u : 20u));
    ck[18] = (f2ord(own[1] + oth[5]) & 0xffffff00u) | (255u - (ls ? 81u : 21u));
    ck[19] = (f2ord(own[1] + oth[6]) & 0xffffff00u) | (255u - (ls ? 97u : 22u));
    ck[20] = (f2ord(own[1] + oth[7]) & 0xffffff00u) | (255u - (ls ? 113u : 23u));
    ck[21] = (f2ord(own[2] + oth[3]) & 0xffffff00u) | (255u - (ls ? 50u : 35u));
    ck[22] = (f2ord(own[2] + oth[4]) & 0xffffff00u) | (255u - (ls ? 66u : 36u));
    ck[23] = ls ? 0u : ((f2ord(own[0] + oth[0]) & 0xffffff00u) | (255u - 0u));
    ck[24] = ls ? 0u : ((f2ord(own[1] + oth[1]) & 0xffffff00u) | (255u - 17u));
    ck[25] = ls ? 0u : ((f2ord(own[2] + oth[2]) & 0xffffff00u) | (255u - 34u));
    ck[26] = ls ? 0u : ((f2ord(own[3] + oth[3]) & 0xffffff00u) | (255u - 51u));
    ck[27] = 0u;
    ck[28] = 0u;
    ck[29] = 0u;
    ck[30] = 0u;
    ck[31] = 0u;
    unsigned c0[16], c1[16];
#pragma unroll
    for (int i = 0; i < 16; ++i) { c0[i] = ck[i]; c1[i] = ck[16 + i]; }
    sort16_desc(c0); sort16_desc(c1); merge16_desc(c0, c1);
    unsigned pt[16];
#pragma unroll
    for (int i = 0; i < 16; ++i) pt[i] = dpp_xor1(c0[i]);
    merge16_desc(c0, pt);
    float cs[16], den = 0.f;
    const float mx = ord2f(c0[0] & 0xffffff00u);
#pragma unroll
    for (int r = 0; r < 16; ++r) { cs[r] = __expf(ord2f(c0[r] & 0xffffff00u) - mx); den += cs[r]; }
    const float inv = 1.f / den;
    const int token = tokw0 + (lane >> 1);
    if (ls == 0) {
      u32x2* so = p.sel + (size_t)token * 128 + h * 16;
      const LAS unsigned* l1 = fl + lane * 16;
      const LAS unsigned* l2 = fl + (lane + 1) * 16;
#pragma unroll
      for (int rr = 0; rr < 16; rr += 2) {
        u32x4 w;
        {
          const unsigned ci = 255u - (c0[rr] & 0xffu);
          w.x = (127u - (l1[ci >> 4] & 0x7fu)) * 128u + (127u - (l2[ci & 15u] & 0x7fu)); w.y = __float_as_uint(cs[rr] * inv);
        }
        {
          const unsigned ci = 255u - (c0[rr + 1] & 0xffu);
          w.z = (127u - (l1[ci >> 4] & 0x7fu)) * 128u + (127u - (l2[ci & 15u] & 0x7fu)); w.w = __float_as_uint(cs[rr + 1] * inv);
        }
        *(u32x4*)(so + rr) = w;
      }
    }
  }
}

__device__ __forceinline__ float gelu_as(float v) {
  const float av = fabsf(v), t = __builtin_amdgcn_rcpf(av * 0.2316418882f + 1.0f);
  float q = t * 0.5307027145f + (-0.7265760135f);
  q = q * t + 0.7107068705f; q = q * t + (-0.142248368f); q = q * t + 0.127414796f; q = q * t;
  const float ee = __builtin_amdgcn_exp2f((v * v) * (-0.72134752044f));
  const float m = v * (q * ee);
  return v < 0.f ? m : v - m;
}
typedef __bf16 bf16x2t __attribute__((ext_vector_type(2)));
__device__ __forceinline__ unsigned rl2(unsigned lo, unsigned hi, int j) {
  const unsigned a = (unsigned)__builtin_amdgcn_readlane((int)lo, j & 63), b = (unsigned)__builtin_amdgcn_readlane((int)hi, j & 63);
  return j < 64 ? a : b;
}
__device__ __forceinline__ float group8_sum(float x) { x += dppf<0xB1>(x); x += dppf<0x4E>(x); x += dppf<0x141>(x); return x; }
__device__ void phase_peer_gather(const Params& p, unsigned char* smem, int bid, int nb, int layer, int tok0, int ntok) {
  const int tid0 = tidx();
  const int wid = __builtin_amdgcn_readfirstlane(tid0 >> 6), lane = tid0 & 63, g = lane >> 3, i = lane & 7;
  const __amdgpu_buffer_rsrc_t U = __builtin_amdgcn_make_buffer_rsrc((void*)(p.u8 + (size_t)layer * NEXP * D), (short)0, NEXP * D, 0x00020000);
  const __amdgpu_buffer_rsrc_t V = __builtin_amdgcn_make_buffer_rsrc((void*)(p.v8 + (size_t)layer * NEXP * D), (short)0, NEXP * D, 0x00020000);
  const float* us = p.uscale + (size_t)layer * NEXP;
  const float* vs = p.vscale + (size_t)layer * NEXP;
  const float* modl = p.mod + (size_t)layer * 33 * MODW;
  LAS unsigned* lst = (LAS unsigned*)smem + wid * 3072;
  for (int grp = bid * 8 + wid; grp < ntok / 8; grp += nb * 8) {
    const int token0 = tok0 + grp * 8;
#pragma unroll 1
    for (int t = 0; t < 8; ++t) {
      const int token = token0 + t;
      const u32x2 se0 = p.sel[(size_t)token * 128 + lane], se1 = p.sel[(size_t)token * 128 + 64 + lane];
      const unsigned k0 = (se0.x << 7) | (unsigned)lane, k1 = (se1.x << 7) | (unsigned)(lane + 64);
      const float g0 = __uint_as_float(se0.y) * vs[se0.x], g1 = __uint_as_float(se1.y) * vs[se1.x];
      const float s0 = us[se0.x], s1 = us[se1.x];
      unsigned r0 = 0, r1 = 0;
      for (int q = 0; q < 64; ++q) {
        const unsigned b0 = (unsigned)__builtin_amdgcn_readlane((int)k0, q), b1 = (unsigned)__builtin_amdgcn_readlane((int)k1, q);
        r0 += (b0 < k0) ? 1u : 0u; r0 += (b1 < k0) ? 1u : 0u;
        r1 += (b0 < k1) ? 1u : 0u; r1 += (b1 < k1) ? 1u : 0u;
      }
      lst[t * 128 + r0] = k0; lst[t * 128 + r1] = k1;
      lst[1024 + t * 128 + r0] = __float_as_uint(g0); lst[1024 + t * 128 + r1] = __float_as_uint(g1);
      lst[2048 + t * 128 + r0] = __float_as_uint(s0); lst[2048 + t * 128 + r1] = __float_as_uint(s1);
    }
    const int token = token0 + g;
    {
      unsigned x[8][8];
#pragma unroll
      for (int k = 0; k < 8; ++k) {
        const bf16_t* xr = p.act + (size_t)token * D + k * 128 + i * 16;
        const u32x4 xa = *(const u32x4*)xr, xb = *(const u32x4*)(xr + 8);
#pragma unroll
        for (int q = 0; q < 4; ++q) { const unsigned wa = xa[q], wb = xb[q]; x[k][q] = wa; x[k][4 + q] = wb; }
      }
      u32x4 ub[8];
      {
        const int voff = (int)((lst[g * 128] >> 7) * 1024u) + i * 16;
#pragma unroll
        for (int k = 0; k < 8; ++k) ub[k] = __builtin_bit_cast(u32x4, __builtin_amdgcn_raw_buffer_load_b128(U, voff + k * 128, 0, 0));
      }
#pragma unroll 1
      for (int j = 0; j < 128; ++j) {
        const int jn = j < 127 ? j + 1 : 127;
        const int voffn = (int)((lst[g * 128 + jn] >> 7) * 1024u) + i * 16;
        const float su = __uint_as_float(lst[2048 + g * 128 + j]), gsv = __uint_as_float(lst[1024 + g * 128 + j]);
        float d0 = 0.f, d1 = 0.f;
#pragma unroll
        for (int k = 0; k < 8; ++k) {
#pragma unroll
          for (int q = 0; q < 4; ++q) {
            const unsigned w = ub[k][q];
            const bf16x2t lo = __builtin_amdgcn_cvt_scalef32_pk_bf16_fp8(w, 1.0f, false), hi = __builtin_amdgcn_cvt_scalef32_pk_bf16_fp8(w, 1.0f, true);
            const unsigned xl = x[k][2 * q], xh = x[k][2 * q + 1];
            d0 = __builtin_amdgcn_fdot2_f32_bf16(lo, __builtin_bit_cast(bf16x2t, xl), d0, false);
            d1 = __builtin_amdgcn_fdot2_f32_bf16(hi, __builtin_bit_cast(bf16x2t, xh), d1, false);
          }
          ub[k] = __builtin_bit_cast(u32x4, __builtin_amdgcn_raw_buffer_load_b128(U, voffn + k * 128, 0, 0));
          __builtin_amdgcn_sched_barrier(0);
        }
        const float d = group8_sum(d0 + d1) * su;
        lst[1024 + g * 128 + j] = __float_as_uint(gsv * gelu_as(d));
      }
    }
    const bool isctx = token < NCTX;
    const int b = isctx ? 32 : ((token - NCTX) >> 11);
    const float* g2 = modl + (size_t)b * MODW + 5 * D + i * 16;
    float* hrow = (isctx ? p.hctx + (size_t)token * D : p.out + (size_t)(token - NCTX) * D) + i * 16;
    float ss = 0.f;
#pragma unroll 1
    for (int hf = 0; hf < 2; ++hf) {
      float y[4][16];
#pragma unroll
      for (int k = 0; k < 4; ++k)
#pragma unroll
        for (int c = 0; c < 16; ++c) y[k][c] = 0.f;
      const int hoff = hf * 512 + i * 16;
      u32x4 vb[4];
      {
        const int voff = (int)((lst[g * 128] >> 7) * 1024u) + hoff;
#pragma unroll
        for (int k = 0; k < 4; ++k) vb[k] = __builtin_bit_cast(u32x4, __builtin_amdgcn_raw_buffer_load_b128(V, voff + k * 128, 0, 0));
      }
#pragma unroll 1
      for (int j = 0; j < 128; ++j) {
        const int jn = j < 127 ? j + 1 : 127;
        const int voffn = (int)((lst[g * 128 + jn] >> 7) * 1024u) + hoff;
        const float a = __uint_as_float(lst[1024 + g * 128 + j]);
#pragma unroll
        for (int k = 0; k < 4; ++k) {
#pragma unroll
          for (int q = 0; q < 4; ++q) {
            const int w = (int)vb[k][q];
            const f32x2 lo = __builtin_amdgcn_cvt_pk_f32_fp8(w, false), hi = __builtin_amdgcn_cvt_pk_f32_fp8(w, true);
            y[k][4 * q] += a * lo.x; y[k][4 * q + 1] += a * lo.y;
            y[k][4 * q + 2] += a * hi.x; y[k][4 * q + 3] += a * hi.y;
          }
          vb[k] = __builtin_bit_cast(u32x4, __builtin_amdgcn_raw_buffer_load_b128(V, voffn + k * 128, 0, 0));
        }
      }
#ifdef ZERO_PEER
      if (layer == ZERO_PEER) {
#pragma unroll
        for (int k = 0; k < 4; ++k)
#pragma unroll
          for (int c = 0; c < 16; ++c) y[k][c] = 0.f;
      }
#endif
#pragma unroll
      for (int k = 0; k < 4; ++k)
#pragma unroll
        for (int q4 = 0; q4 < 4; ++q4) {
          const int co = hf * 512 + k * 128 + q4 * 4;
          const f32x4 hv = *(const f32x4*)(hrow + co), gv = *(const f32x4*)(g2 + co);
          f32x4 o;
#pragma unroll
          for (int e = 0; e < 4; ++e) { const float v = hv[e] + gv[e] * y[k][q4 * 4 + e]; o[e] = v; ss += v * v; }
          *(f32x4*)(hrow + co) = o;
        }
    }
    {
      ss = group8_sum(ss);
      const float rstd = rsqrtf(ss * (1.f / D) + EPS);
      if (layer == 0) {
        const float* modn = p.mod + (size_t)33 * MODW + (size_t)b * MODW + i * 16;
        const float* gain = p.mix_g + D + i * 16;
#pragma unroll 2
        for (int k = 0; k < 8; ++k) {
          u32x4 w[2];
#pragma unroll
          for (int q4 = 0; q4 < 4; ++q4) {
            const int co = k * 128 + q4 * 4;
            const f32x4 hv = *(const f32x4*)(hrow + co);
            const f32x4 gg = *(const f32x4*)(gain + co), s0 = *(const f32x4*)(modn + co), s1 = *(const f32x4*)(modn + D + co);
            f32x4 yv = hv * rstd * gg;
            yv = yv * (1.f + s1) + s0;
            w[q4 >> 1][(q4 & 1) * 2] = cvt_pk_bf16(yv[0], yv[1]); w[q4 >> 1][(q4 & 1) * 2 + 1] = cvt_pk_bf16(yv[2], yv[3]);
          }
          bf16_t* ar = p.act + (size_t)token * D + k * 128 + i * 16;
          *(u32x4*)ar = w[0];
          *(u32x4*)(ar + 8) = w[1];
        }
      } else {
        const float* gain = p.final_g + i * 16;
#pragma unroll 2
        for (int k = 0; k < 8; ++k)
#pragma unroll
          for (int q4 = 0; q4 < 4; ++q4) {
            const int co = k * 128 + q4 * 4;
            const f32x4 hv = *(const f32x4*)(hrow + co), gg = *(const f32x4*)(gain + co);
            *(f32x4*)(hrow + co) = hv * rstd * gg;
          }
      }
    }
    __syncthreads();
  }
}

constexpr int NPH = 18;
template <int PH>
__device__ __forceinline__ void run_phase(const Params& p, unsigned char* smem, int bid, int nb) {
  if constexpr (PH == 0) phase_prep(p, smem, bid, nb);
  else if constexpr (PH == 1) phase_norm(p, bid, nb, 0, NTOK, p.ctx, p.x, p.mix_g, p.mod, 0, 1);
  else if constexpr (PH == 2) phase_gemm_inproj(p, smem, bid, nb, 0);
  else if constexpr (PH == 3) phase_ret_kv(p, smem, bid, nb);
  else if constexpr (PH == 4) phase_ret_scan(p, bid, nb);
  else if constexpr (PH == 5) phase_ret_out(p, smem, bid, nb);
  else if constexpr (PH == 6) phase_gemm_outproj(p, smem, bid, nb, 0);
  else if constexpr (PH == 7) phase_norm(p, bid, nb, 0, NTOK, p.hctx, p.out, p.ffn_g, p.mod, 3, 4);
  else if constexpr (PH == 8) phase_gemm_pq(p, smem, bid, nb, 0);
  else if constexpr (PH == 9) phase_peer_topk(p, smem, bid, nb, 0, 0, NTOK);
  else if constexpr (PH == 10) phase_peer_gather(p, smem, bid, nb, 0, 0, NTOK);
  else if constexpr (PH == 11) phase_gemm_inproj(p, smem, bid, nb, 1);
  else if constexpr (PH == 12) phase_attn(p, smem, bid, nb);
  else if constexpr (PH == 13) phase_gemm_outproj(p, smem, bid, nb, 1);
  else if constexpr (PH == 14) phase_norm(p, bid, nb, NCTX, NTOK, p.hctx, p.out, p.ffn_g + D, p.mod + (size_t)33 * MODW, 3, 4);
  else if constexpr (PH == 15) phase_gemm_pq(p, smem, bid, nb, 1);
  else if constexpr (PH == 16) phase_peer_topk(p, smem, bid, nb, 1, NCTX, NLAT);
  else if constexpr (PH == 17) phase_peer_gather(p, smem, bid, nb, 1, NCTX, NLAT);
}
template <int PH>
__global__ void __launch_bounds__(NTHREADS) phase_k(Params p) {
  extern __shared__ __attribute__((aligned(16))) unsigned char smem[];
  run_phase<PH>(p, smem, blockIdx.x, gridDim.x);
}
#define XB_TMO      128
#define XB_XCNT(j)  (256  + 64 * (j))
#define XB_XSUB(j)  (1280 + 64 * (j))
#define XB_XGEN(j)  (2304 + 64 * (j))
#define XB_TOP      3328
#define XB_TOPGEN   3392
#define XCD_BAR_WORDS 3456
#define XB_SPIN_CAP (1u << 22)
__device__ __forceinline__ unsigned xb_ld(unsigned* p)              { return __hip_atomic_load(p, __ATOMIC_RELAXED, __HIP_MEMORY_SCOPE_AGENT); }
__device__ __forceinline__ unsigned xb_add(unsigned* p, unsigned v) { return __hip_atomic_fetch_add(p, v, __ATOMIC_RELAXED, __HIP_MEMORY_SCOPE_AGENT); }
__device__ __forceinline__ unsigned xb_xcc_id() { return (unsigned)__builtin_amdgcn_s_getreg((3 << 11) | 20) & 0xFu; }
#define XB_SPIN(cond, bar) do { unsigned _sp = 0; while (cond) { __builtin_amdgcn_s_sleep(1); \
    if ((++_sp & 255u) == 0u) { if (xb_ld(&(bar)[XB_TMO])) break; if (_sp > XB_SPIN_CAP) { atomicAdd(&(bar)[XB_TMO], 1u); break; } } } } while (0)
struct XcdBarrier { unsigned* bar; unsigned x; volatile LAS unsigned* st; };
__device__ __forceinline__ XcdBarrier xcd_barrier_post(unsigned* bar, volatile LAS unsigned* st) {
  XcdBarrier b; b.bar = bar; b.x = xb_xcc_id(); b.st = st;
  if (threadIdx.x == 0) (void)xb_add(&bar[XB_XCNT(b.x)], 1u);
  return b;
}
__device__ __forceinline__ void xcd_barrier_complete(unsigned* bar, unsigned x, unsigned& nloc, unsigned& nx) {
  const unsigned G = gridDim.x * gridDim.y * gridDim.z;
  unsigned sum, cnt, mine, sp = 0u;
  for (;;) {
    sum = 0u; cnt = 0u; mine = 0u;
#pragma unroll
    for (unsigned j = 0; j < 16; ++j) { const unsigned c = xb_ld(&bar[XB_XCNT(j)]); sum += c; cnt += (c > 0u) ? 1u : 0u; mine = (j == x) ? c : mine; }
    if (sum == G) break;
    __builtin_amdgcn_s_sleep(1);
    if ((++sp & 255u) == 0u) { if (xb_ld(&bar[XB_TMO])) break; if (sp > XB_SPIN_CAP) { atomicAdd(&bar[XB_TMO], 1u); break; } }
  }
  nloc = mine > 0u ? mine : 1u; nx = cnt > 0u ? cnt : 1u;
}
__device__ __forceinline__ void xcd_barrier(const XcdBarrier& b) {
  asm volatile("s_waitcnt vmcnt(0)" ::: "memory");
  __syncthreads();
  if (threadIdx.x == 0) {
    unsigned* bar = b.bar;
    __builtin_amdgcn_s_waitcnt(0);
    unsigned nloc = b.st[0], nx = b.st[1];
    if (nloc == 0u) { xcd_barrier_complete(bar, b.x, nloc, nx); b.st[0] = nloc; b.st[1] = nx; }
    const unsigned old = xb_add(&bar[XB_XSUB(b.x)], 1u);
    const unsigned gen = old / nloc;
    if (old + 1u == (gen + 1u) * nloc) {
      __builtin_amdgcn_fence(__ATOMIC_RELEASE, "agent");
      asm volatile("s_waitcnt vmcnt(0)" ::: "memory");
      const unsigned og = xb_add(&bar[XB_TOP], 1u);
      const unsigned tg = og / nx;
      if (og + 1u == (tg + 1u) * nx) xb_add(&bar[XB_TOPGEN], 1u);
      else XB_SPIN(xb_ld(&bar[XB_TOPGEN]) == tg, bar);
      __builtin_amdgcn_fence(__ATOMIC_ACQUIRE, "agent");
      xb_add(&bar[XB_XGEN(b.x)], 1u);
      asm volatile("s_waitcnt vmcnt(0)" ::: "memory");
    } else {
      XB_SPIN(xb_ld(&bar[XB_XGEN(b.x)]) == gen, bar);
      __builtin_amdgcn_fence(__ATOMIC_ACQUIRE, "agent");
      asm volatile("s_waitcnt vmcnt(0)" ::: "memory");
    }
  }
  __syncthreads();
}

#if MK_ONE_LAUNCH
constexpr int PARAMS_OFF = LDS_BYTES - 512;
static_assert(sizeof(Params) <= 480, "params block");
template <class T>
__device__ __forceinline__ T* uni(T* q) {
  const unsigned long long v = (unsigned long long)q;
  const unsigned lo = __builtin_amdgcn_readfirstlane((unsigned)v), hi = __builtin_amdgcn_readfirstlane((unsigned)(v >> 32));
  return (T*)(((unsigned long long)hi << 32) | lo);
}
__device__ __forceinline__ Params load_params(const unsigned char* smem) {
  const Params* l = (const Params*)(smem + PARAMS_OFF);
  Params q;
  q.x = uni(l->x); q.c = uni(l->c); q.ctx = uni(l->ctx); q.c_ctx = uni(l->c_ctx); q.ada_w = uni(l->ada_w); q.ada_b = uni(l->ada_b);
  q.mix_g = uni(l->mix_g); q.ffn_g = uni(l->ffn_g); q.ev_w_in = uni(l->ev_w_in); q.ev_w_out = uni(l->ev_w_out);
  q.logit_f = uni(l->logit_f); q.logit_b = uni(l->logit_b); q.conv_w = uni(l->conv_w); q.od_w_in = uni(l->od_w_in);
  q.od_w_out = uni(l->od_w_out); q.sinks = uni(l->sinks); q.peer_wq = uni(l->peer_wq); q.keys1 = uni(l->keys1); q.keys2 = uni(l->keys2);
  q.peer_u = uni(l->peer_u); q.peer_v = uni(l->peer_v); q.final_g = uni(l->final_g); q.out = uni(l->out); q.mod = uni(l->mod);
  q.ropec = uni(l->ropec); q.ropes = uni(l->ropes); q.winT0 = uni(l->winT0); q.woutT0 = uni(l->woutT0); q.winT1 = uni(l->winT1);
  q.woutT1 = uni(l->woutT1); q.wqT = uni(l->wqT); q.u8 = uni(l->u8); q.v8 = uni(l->v8); q.uscale = uni(l->uscale); q.vscale = uni(l->vscale); q.hctx = uni(l->hctx); q.act = uni(l->act);
  q.proj = uni(l->proj); q.pq = uni(l->pq); q.sel = uni(l->sel); q.kv = uni(l->kv); q.sprev = uni(l->sprev); q.bar = uni(l->bar); q.keysb = uni(l->keysb);
  return q;
}
template <int PH>
__device__ __forceinline__ void run_from(unsigned char* smem, int bid, int nb, const XcdBarrier& xb) {
  {
    const Params q = load_params(smem);
    run_phase<PH>(q, smem, bid, nb);
  }
#ifdef DUP_PH
  if constexpr (PH == DUP_PH) {
    xcd_barrier(xb);
    const Params q = load_params(smem);
    run_phase<PH>(q, smem, bid, nb);
  }
#endif
  if constexpr (PH + 1 < NPH) {
    if constexpr (PH == 0) cg::this_grid().sync();
    else xcd_barrier(xb);
    run_from<PH + 1>(smem, bid, nb, xb);
  }
}
__global__ void __launch_bounds__(NTHREADS) mega(Params p) {
  extern __shared__ __attribute__((aligned(16))) unsigned char smem[];
  volatile LAS unsigned* st = (volatile LAS unsigned*)((LAS unsigned char*)smem + PARAMS_OFF + 480);
  if (threadIdx.x == 0) { *(Params*)(smem + PARAMS_OFF) = p; st[0] = 0u; st[1] = 0u; }
  __syncthreads();
  const XcdBarrier xb = xcd_barrier_post(p.bar, st);
  run_from<0>(smem, blockIdx.x, gridDim.x, xb);
}
#endif
#ifndef DBG_NPH
#define DBG_NPH 0
#endif
#if DBG_NPH
__global__ void __launch_bounds__(NTHREADS) dbg_sums(Params p, float* scr, int nph) {
  const int wid = threadIdx.x >> 6, lane = threadIdx.x & 63;
  const int gw = blockIdx.x * 8 + wid, nw = gridDim.x * 8;
  if (nph >= 2) for (int r = gw; r < NTOK; r += nw) { float s = 0.f; for (int c = lane; c < D; c += 64) s += bf2f(p.act[(size_t)r * D + c]) * (1 + (c & 7)); s = wave_sum(s); if (lane == 0) scr[r] = s; }
  if (nph >= 3 && nph <= 8) for (int r = gw; r < NTOK; r += nw) { float s = 0.f; for (int c = lane; c < 3072; c += 64) s += bf2f(p.proj[(size_t)r * 3072 + c]) * (1 + (c & 7)); s = wave_sum(s); if (lane == 0) scr[(1 << 20) + r] = s; }
  if (nph >= 12 && nph <= 15) for (int r = gw; r < NTOK; r += nw) { float s = 0.f; for (int c = lane + (r < NCTX ? 1024 : 0); c < 1536; c += 64) s += bf2f(p.proj[(size_t)r * 1536 + c]) * (1 + (c & 7)); s = wave_sum(s); if (lane == 0) scr[(1 << 20) + r] = s; }
  if (nph >= 4) for (int r = gw; r < 2304 * 128; r += nw) { float s = 0.f; for (int c = lane; c < 128; c += 64) s += p.kv[(size_t)r * 128 + c] * (1 + (c & 7)); s = wave_sum(s); if (lane == 0) scr[(2 << 20) + r] = s; }
  if (nph >= 5) for (int r = gw; r < 2304 * 128; r += nw) { float s = 0.f; for (int c = lane; c < 128; c += 64) s += bf2f(p.sprev[(size_t)r * 128 + c]) * (1 + (c & 7)); s = wave_sum(s); if (lane == 0) scr[(3 << 20) + r] = s; }
  if (nph >= 7) for (int r = gw; r < NCTX; r += nw) { float s = 0.f; for (int c = lane; c < D; c += 64) s += p.hctx[(size_t)r * D + c] * (1 + (c & 7)); s = wave_sum(s); if (lane == 0) scr[(4 << 20) + r] = s; }
  if (nph >= 1) for (int i = blockIdx.x * NTHREADS + threadIdx.x; i < 2 * 33 * MODW; i += gridDim.x * NTHREADS) scr[(5 << 20) + i] = p.mod[i];
  if (nph >= 7) for (int r = gw; r < NLAT; r += nw) { float s = 0.f; for (int c = lane; c < D; c += 64) s += p.out[(size_t)r * D + c] * (1 + (c & 7)); s = wave_sum(s); if (lane == 0) scr[(6 << 20) + r] = s; }
  if (nph >= 10 && nph <= 11) for (int r = gw; r < NTOK; r += nw) { float s = 0.f; for (int c = lane; c < 128; c += 64) { const u32x2 e = p.sel[(size_t)r * 128 + c]; s += __uint_as_float(e.y) * (float)(e.x & 1023); } s = wave_sum(s); if (lane == 0) scr[(7 << 20) + r] = s; }
}
__global__ void __launch_bounds__(NTHREADS) dbg_out(Params p, const float* scr) {
  for (size_t i = (size_t)blockIdx.x * NTHREADS + threadIdx.x; i < (size_t)NLAT * D; i += (size_t)gridDim.x * NTHREADS) p.out[i] = (i < (size_t)(8 << 20)) ? scr[i] : 0.f;
}
__global__ void __launch_bounds__(NTHREADS) dbg_zero(float* scr) {
  for (size_t i = (size_t)blockIdx.x * NTHREADS + threadIdx.x; i < (size_t)(8 << 20); i += (size_t)gridDim.x * NTHREADS) scr[i] = 0.f;
}
#endif
template <int PH>
static void launch_phases(const Params& p, int grid, hipStream_t stream) {
  static bool attr_set = false;
  if (!attr_set) { (void)hipFuncSetAttribute((const void*)phase_k<PH>, hipFuncAttributeMaxDynamicSharedMemorySize, LDS_BYTES); attr_set = true; }
  phase_k<PH><<<grid, NTHREADS, LDS_BYTES, stream>>>(p);
  if constexpr (PH + 1 < (DBG_NPH ? DBG_NPH : NPH)) launch_phases<PH + 1>(p, grid, stream);
}

extern "C" void kernel_launch(void* const* d_in, const int* in_sizes, int n_in, void* d_out, int out_size, void* d_ws,
                              size_t ws_size, hipStream_t stream) {
  Params p{};
  const float* const* in = (const float* const*)d_in;
  p.x = in[0]; p.c = in[1]; p.ctx = in[2]; p.c_ctx = in[3]; p.ada_w = in[4]; p.ada_b = in[5]; p.mix_g = in[6]; p.ffn_g = in[7];
  p.ev_w_in = in[8]; p.ev_w_out = in[9]; p.logit_f = in[10]; p.logit_b = in[11]; p.conv_w = in[12]; p.od_w_in = in[13];
  p.od_w_out = in[14]; p.sinks = in[15]; p.peer_wq = in[16]; p.keys1 = in[17]; p.keys2 = in[18]; p.peer_u = in[19];
  p.peer_v = in[20]; p.final_g = in[21];
  p.out = (float*)d_out;
  unsigned char* w = (unsigned char*)d_ws;
  size_t off = 0;
  auto take = [&](size_t bytes) { unsigned char* r = w + off; off += (bytes + 255) & ~(size_t)255; return r; };
  p.mod = (float*)take((size_t)2 * 33 * MODW * 4);
  p.ropec = (float*)take(1024 * 4);
  p.ropes = (float*)take(1024 * 4);
  p.winT0 = (bf16_t*)take((size_t)3072 * 1024 * 2);
  p.woutT0 = (bf16_t*)take((size_t)1024 * 1024 * 2);
  p.winT1 = (bf16_t*)take((size_t)1536 * 1024 * 2);
  p.woutT1 = (bf16_t*)take((size_t)1024 * 1024 * 2);
  p.wqT = (bf16_t*)take((size_t)2 * 1024 * 1024 * 2);
  p.u8 = (unsigned char*)take((size_t)2 * NEXP * D);
  p.v8 = (unsigned char*)take((size_t)2 * NEXP * D);
  p.uscale = (float*)take((size_t)2 * NEXP * 4);
  p.vscale = (float*)take((size_t)2 * NEXP * 4);
  p.hctx = (float*)take((size_t)NCTX * D * 4);
  p.act = (bf16_t*)take((size_t)NTOK * D * 2);
  p.kv = (float*)take((size_t)2304 * 16384 * 4);
  p.sprev = (bf16_t*)take((size_t)2304 * 16384 * 2);
  p.bar = (unsigned*)take((size_t)XCD_BAR_WORDS * 4);
  p.keysb = (bf16_t*)take((size_t)2 * 8 * 2 * 2 * 128 * 64 * 2);
  p.proj = (bf16_t*)take((size_t)NTOK * 3072 * 2);
  p.pq = p.proj;
  p.sel = (u32x2*)((unsigned char*)p.proj + (size_t)NTOK * D * 2);
  if (off > ws_size) { fprintf(stderr, "workspace too small: need %zu have %zu\n", off, ws_size); }

  int grid = 256;
#if MK_ONE_LAUNCH
  static int grid_blocks = 0;
  if (!grid_blocks) {
    (void)hipFuncSetAttribute((const void*)mega, hipFuncAttributeMaxDynamicSharedMemorySize, LDS_BYTES);
    int dev = 0, cus = 0, per_cu = 0;
    (void)hipGetDevice(&dev);
    (void)hipDeviceGetAttribute(&cus, hipDeviceAttributeMultiprocessorCount, dev);
    (void)hipOccupancyMaxActiveBlocksPerMultiprocessor(&per_cu, mega, NTHREADS, LDS_BYTES);
    if (per_cu > 1) per_cu = 1;
    grid_blocks = cus * per_cu;
    if (grid_blocks <= 0) grid_blocks = 256;
  }
  grid = grid_blocks;
  (void)hipMemsetAsync(p.bar, 0, (size_t)XCD_BAR_WORDS * 4, stream);
  void* args[] = {&p};
  hipError_t e = hipLaunchCooperativeKernel((const void*)mega, dim3(grid), dim3(NTHREADS), args, LDS_BYTES, stream);
  if (e != hipSuccess) fprintf(stderr, "cooperative launch failed: %s\n", hipGetErrorString(e));
#else
  launch_phases<0>(p, grid, stream);
#if DBG_NPH
  float* scr = (float*)(w + off);
  dbg_zero<<<grid, NTHREADS, 0, stream>>>(scr);
  dbg_sums<<<grid, NTHREADS, 0, stream>>>(p, scr, DBG_NPH);
  dbg_out<<<grid, NTHREADS, 0, stream>>>(p, scr);
#endif
#endif
}
```

```cpp
#include <hip/hip_runtime.h>
#include <hip/hip_cooperative_groups.h>
#include <cstdio>
#include <cstdint>
namespace cg = cooperative_groups;

#ifndef MK_ONE_LAUNCH
#define MK_ONE_LAUNCH 1
#endif

typedef unsigned short bf16_t;
typedef short bf16x8 __attribute__((ext_vector_type(8)));
typedef short bf16x2v __attribute__((ext_vector_type(2)));
typedef float f32x4 __attribute__((ext_vector_type(4)));
typedef unsigned u32x4 __attribute__((ext_vector_type(4)));
typedef unsigned u32x2 __attribute__((ext_vector_type(2)));
typedef unsigned u32x6 __attribute__((ext_vector_type(6)));
typedef unsigned u32x16 __attribute__((ext_vector_type(16)));
typedef float f32x32 __attribute__((ext_vector_type(32)));
typedef __bf16 bf16x32n __attribute__((ext_vector_type(32)));

constexpr int D = 1024, BATCH = 32, SEQ = 2048, CTXL = 256;
constexpr int NCTX = BATCH * CTXL;
constexpr int NLAT = BATCH * SEQ;
constexpr int NTOK = NCTX + NLAT;
constexpr int MODW = 6 * D;
constexpr int NEXP = 16384;
constexpr float EPS = 1e-6f;
constexpr int NTHREADS = 512;
constexpr int LDS_BYTES = 140 * 1024;

struct Params {
  const float *x, *c, *ctx, *c_ctx, *ada_w, *ada_b, *mix_g, *ffn_g, *ev_w_in, *ev_w_out, *logit_f, *logit_b, *conv_w,
      *od_w_in, *od_w_out, *sinks, *peer_wq, *keys1, *keys2, *peer_u, *peer_v, *final_g;
  float* out;
  float* mod;
  float* ropec;
  float* ropes;
  bf16_t* winT0;
  bf16_t* woutT0;
  bf16_t* winT1;
  bf16_t* woutT1;
  bf16_t* wqT;
  unsigned char* u8;
  unsigned char* v8;
  float* uscale;
  float* vscale;
  float* hctx;
  bf16_t* act;
  bf16_t* proj;
  bf16_t* pq;
  u32x2* sel;
  float* kv;
  bf16_t* sprev;
  bf16_t* keysb;
  unsigned* bar;
};

typedef __bf16 bf16x2n __attribute__((ext_vector_type(2)));
typedef float f32x2 __attribute__((ext_vector_type(2)));
__device__ __forceinline__ unsigned cvt_pk_bf16(float lo, float hi) {
  f32x2 v = {lo, hi};
  return __builtin_bit_cast(unsigned, __builtin_convertvector(v, bf16x2n));
}
__device__ __forceinline__ float bf_lo(unsigned u) { return __uint_as_float(u << 16); }
__device__ __forceinline__ float bf_hi(unsigned u) { return __uint_as_float(u & 0xffff0000u); }
__device__ __forceinline__ float bf2f(bf16_t h) { return __uint_as_float(((unsigned)h) << 16); }
__device__ __forceinline__ bf16_t f2bf(float f) { return __builtin_bit_cast(unsigned short, (__bf16)f); }

template <int CTRL>
__device__ __forceinline__ float dppf(float x) {
  return __builtin_bit_cast(float, __builtin_amdgcn_mov_dpp(__builtin_bit_cast(int, x), CTRL, 0xf, 0xf, true));
}
__device__ __forceinline__ float row16_sum(float x) {
  x += dppf<0xB1>(x); x += dppf<0x4E>(x); x += dppf<0x141>(x); x += dppf<0x128>(x);
  return x;
}
__device__ __forceinline__ float row16_max(float x) {
  x = fmaxf(x, dppf<0xB1>(x)); x = fmaxf(x, dppf<0x4E>(x)); x = fmaxf(x, dppf<0x141>(x)); x = fmaxf(x, dppf<0x128>(x));
  return x;
}
__device__ __forceinline__ float xrow16_sum(float x) {
  auto s = __builtin_amdgcn_permlane16_swap(__float_as_uint(x), __float_as_uint(x), false, false);
  x = __uint_as_float(s[0]) + __uint_as_float(s[1]);
  auto t = __builtin_amdgcn_permlane32_swap(__float_as_uint(x), __float_as_uint(x), false, false);
  return __uint_as_float(t[0]) + __uint_as_float(t[1]);
}
__device__ __forceinline__ float wave_sum(float x) { return xrow16_sum(row16_sum(x)); }
__device__ __forceinline__ float wave_max(float x) {
  x = row16_max(x);
  auto s = __builtin_amdgcn_permlane16_swap(__float_as_uint(x), __float_as_uint(x), false, false);
  x = fmaxf(__uint_as_float(s[0]), __uint_as_float(s[1]));
  auto t = __builtin_amdgcn_permlane32_swap(__float_as_uint(x), __float_as_uint(x), false, false);
  return fmaxf(__uint_as_float(t[0]), __uint_as_float(t[1]));
}

__device__ __forceinline__ int tidx() {
  int t = threadIdx.x;
  asm volatile("" : "+v"(t));
  __builtin_assume(t >= 0 && t < NTHREADS);
  return t;
}
__device__ __forceinline__ float siluf(float v) { return v / (1.f + __expf(-v)); }
__device__ __forceinline__ float log_sigmoidf(float v) { return -log1pf(expf(-v)); }

#define LAS __attribute__((address_space(3)))
constexpr int BM = 256, BK = 64, HALF = 128, HTB = HALF * BK * 2, NXCD = 8, WGM = 8;
constexpr int KDIM = 1024;

__device__ __forceinline__ int lds_byte(int r, int c) {
  const int st = (r >> 4) * 2 + (c >> 5), rr = r & 15, cc = c & 31, ob = rr * 64 + cc * 2;
  return st * 1024 + (ob ^ (((ob >> 9) & 1) << 5));
}
__device__ __forceinline__ void stage_rc(int b, int& R, int& C) {
  const int st = b / 1024, sb = b % 1024, swz = sb ^ (((sb >> 9) & 1) << 5);
  R = (st >> 1) * 16 + swz / 64;
  C = (st & 1) * 32 + (swz % 64) / 2;
}
struct Sched {
  int pm0, pn0, nM, nN, G, c;
  __device__ __forceinline__ bool next(int i, int& pm, int& pn) const {
    const int nwg = nM * nN;
    const long L = (long)i * G + c;
    if (L >= nwg) return false;
    int wgid = (int)L;
    { const int q = nwg / NXCD, r = nwg % NXCD, xcd = wgid % NXCD, off = wgid / NXCD; wgid = (xcd < r ? xcd * (q + 1) : r * (q + 1) + (xcd - r) * q) + off; }
    const int nig = WGM * nN, gid = wgid / nig, fm = gid * WGM, gsz = (nM - fm) < WGM ? (nM - fm) : WGM;
    pm = pm0 + fm + ((wgid % nig) % gsz);
    pn = pn0 + (wgid % nig) / gsz;
    return true;
  }
};

template <class Epi>
__device__ __forceinline__ void gemm_phase(LAS unsigned char* lds, const bf16_t* __restrict__ Ag, const bf16_t* __restrict__ Btg, const Sched& S, const Epi& E) {
  const int tid = tidx(), wid = __builtin_amdgcn_readfirstlane(tid >> 6), lane = tid & 63, wr = wid >> 2, wc = wid & 3, fr = lane & 15, fq = lane >> 4;
  constexpr int K = KDIM, nt = K / BK;
  unsigned voffA[2];
#pragma unroll
  for (int i = 0; i < 2; ++i) { int R, C; stage_rc(tid * 16 + i * 8192, R, C); voffA[i] = (unsigned)(R * K + C) * 2u; }
  const size_t kstep = (size_t)(BK * 2);
  const size_t hstep = (size_t)HALF * K * 2;
  const size_t tstep = 2 * hstep;
  const unsigned ldsw = (unsigned)wid * 1024u;
  const int aoff = lds_byte(wr * 64 + fr, fq * 8), boff = lds_byte(wc * 32 + fr, fq * 8);
#define G_SA(b, h) (((b) * 2 + (h)) * HTB)
#define G_SB(b, h) ((4 + (b) * 2 + (h)) * HTB)
#define G_STAGE(bufoff, gbase) do { _Pragma("unroll") for (int _i = 0; _i < 2; ++_i) \
    __builtin_amdgcn_global_load_lds((const unsigned*)((const char*)(gbase) + voffA[_i]), (LAS unsigned*)(lds + (bufoff) + ldsw + _i * 8192), 16, 0, 0); } while (0)
#define G_LDA(dst, b, h) do { _Pragma("unroll") for (int m = 0; m < 4; ++m) _Pragma("unroll") for (int k = 0; k < 2; ++k) dst[m][k] = *(const LAS bf16x8*)(lds + G_SA(b, h) + aoff + m * 2048 + k * 1024); } while (0)
#define G_LDB(dst, b, h) do { _Pragma("unroll") for (int n = 0; n < 2; ++n) _Pragma("unroll") for (int k = 0; k < 2; ++k) dst[n][k] = *(const LAS bf16x8*)(lds + G_SB(b, h) + boff + n * 2048 + k * 1024); } while (0)
#define G_MMA(ai, bj, At, Bt) do { __builtin_amdgcn_s_setprio(1); _Pragma("unroll") for (int m = 0; m < 4; ++m) _Pragma("unroll") for (int n = 0; n < 2; ++n) _Pragma("unroll") for (int k = 0; k < 2; ++k) \
    acc[ai][bj][m][n] = __builtin_amdgcn_mfma_f32_16x16x32_bf16(Bt[n][k], At[m][k], acc[ai][bj][m][n], 0, 0, 0); __builtin_amdgcn_s_setprio(0); } while (0)
#define G_WAIT_V(n) asm volatile("s_waitcnt vmcnt(" #n ")" ::: "memory")
#define G_WAIT_L(n) asm volatile("s_waitcnt lgkmcnt(" #n ")" ::: "memory")
#define G_BAR __builtin_amdgcn_s_barrier()
#define G_SCHED __builtin_amdgcn_sched_barrier(0)
  int cpm, cpn, npm, npn, ui = 0;
  if (!S.next(0, cpm, cpn)) return;
  f32x4 acc[2][2][4][2];
#pragma unroll
  for (int a = 0; a < 2; ++a)
#pragma unroll
    for (int b = 0; b < 2; ++b)
#pragma unroll
      for (int m = 0; m < 4; ++m)
#pragma unroll
        for (int n = 0; n < 2; ++n) acc[a][b][m][n] = (f32x4){0.f, 0.f, 0.f, 0.f};
  bf16x8 At[4][2], B0[2][2], B1[2][2];
  const char* cA = (const char*)Ag + (size_t)cpm * tstep;
  const char* cB = (const char*)Btg + (size_t)cpn * tstep;
  G_STAGE(G_SB(0, 0), cB); G_STAGE(G_SA(0, 0), cA); G_STAGE(G_SB(0, 1), cB + hstep); G_STAGE(G_SA(0, 1), cA + hstep);
  if (wr == 1) G_BAR;
  G_WAIT_V(4); G_BAR;
  G_STAGE(G_SB(1, 0), cB + kstep); G_STAGE(G_SA(1, 0), cA + kstep); G_STAGE(G_SB(1, 1), cB + hstep + kstep);
  G_WAIT_V(6); G_BAR;
  for (;;) {
    const bool has_next = S.next(ui + 1, npm, npn);
    const char* nA = has_next ? (const char*)Ag + (size_t)npm * tstep : cA;
    const char* nB = has_next ? (const char*)Btg + (size_t)npn * tstep : cB;
    for (int t = 0; t < nt; t += 2) {
      const bool last = (t == nt - 2);
      const char* a1 = cA + (size_t)(t + 1) * kstep;
      const char* a2 = last ? nA : cA + (size_t)(t + 2) * kstep;
      const char* b2 = last ? nB : cB + (size_t)(t + 2) * kstep;
      const char* a3 = a2 + kstep;
      const char* b3 = b2 + kstep;
      G_LDB(B0, 0, 0); G_SCHED; G_LDA(At, 0, 0); G_STAGE(G_SA(1, 1), a1 + hstep);
      G_WAIT_L(8); G_BAR; G_WAIT_L(0); G_MMA(0, 0, At, B0); G_BAR; G_SCHED;
      G_LDB(B1, 0, 1); G_STAGE(G_SB(0, 0), b2);
      G_BAR; G_WAIT_L(0); G_MMA(0, 1, At, B1); G_BAR;
      G_LDA(At, 0, 1); G_STAGE(G_SA(0, 0), a2);
      G_BAR; G_WAIT_L(0); G_MMA(1, 0, At, B0); G_BAR; G_SCHED;
      G_STAGE(G_SB(0, 1), b2 + hstep);
      G_WAIT_V(6); G_BAR; G_MMA(1, 1, At, B1); G_BAR;
      G_LDB(B0, 1, 0); G_SCHED; G_LDA(At, 1, 0); G_STAGE(G_SA(0, 1), a2 + hstep);
      G_WAIT_L(8); G_BAR; G_WAIT_L(0); G_MMA(0, 0, At, B0); G_BAR; G_SCHED;
      G_LDB(B1, 1, 1); G_STAGE(G_SB(1, 0), b3);
      G_BAR; G_WAIT_L(0); G_MMA(0, 1, At, B1); G_BAR;
      G_LDA(At, 1, 1); G_STAGE(G_SA(1, 0), a3);
      G_BAR; G_WAIT_L(0); G_MMA(1, 0, At, B0); G_BAR; G_SCHED;
      G_STAGE(G_SB(1, 1), b3 + hstep);
      G_WAIT_V(6); G_BAR; G_MMA(1, 1, At, B1); G_BAR;
    }
    E(acc, cpm * BM, cpn * BM, wr, wc, fr, fq);
    if (!has_next) break;
#pragma unroll
    for (int a = 0; a < 2; ++a)
#pragma unroll
      for (int b = 0; b < 2; ++b)
#pragma unroll
        for (int m = 0; m < 4; ++m)
#pragma unroll
          for (int n = 0; n < 2; ++n) acc[a][b][m][n] = (f32x4){0.f, 0.f, 0.f, 0.f};
    cpm = npm; cpn = npn; cA = nA; cB = nB; ++ui;
  }
  G_WAIT_V(0);
  if (wr == 0) G_BAR;
  G_BAR;
#undef G_SA
#undef G_SB
#undef G_STAGE
#undef G_LDA
#undef G_LDB
#undef G_MMA
}

struct EpiInProj {
  bf16_t* P; int ldc; int layer; const float* cosT; const float* sinT;
  __device__ __forceinline__ void operator()(const f32x4 (&acc)[2][2][4][2], int brow, int bcol, int wr, int wc, int fr, int fq) const {
#pragma unroll
    for (int bj = 0; bj < 2; ++bj) {
      const int colbase = bcol + bj * HALF + wc * 32;
      bool rope, scl;
      if (layer == 0) { rope = colbase < 512; scl = (colbase >= 256 && colbase < 512); }
      else { rope = colbase < 1280; scl = colbase < 1024; }
#pragma unroll
      for (int ai = 0; ai < 2; ++ai)
#pragma unroll
        for (int m = 0; m < 4; ++m) {
          const int row = brow + ai * HALF + wr * 64 + m * 16 + fr;
          f32x4 v0 = acc[ai][bj][m][0], v1 = acc[ai][bj][m][1];
          if (rope && row >= NCTX) {
            const int t = (row - NCTX) & (SEQ - 1);
            const int pos = (wc & 1) ? (t & 63) : (t >> 6);
            const f32x4 cs = *(const f32x4*)(cosT + pos * 16 + fq * 4);
            const f32x4 sn = *(const f32x4*)(sinT + pos * 16 + fq * 4);
            const f32x4 o0 = v0 * cs - v1 * sn, o1 = v1 * cs + v0 * sn;
            v0 = o0; v1 = o1;
          }
          if (scl) { v0 *= 0.125f; v1 *= 0.125f; }
          bf16_t* rp = P + (size_t)row * ldc + colbase + fq * 4;
          u32x2 w0, w1;
          w0.x = cvt_pk_bf16(v0[0], v0[1]); w0.y = cvt_pk_bf16(v0[2], v0[3]);
          w1.x = cvt_pk_bf16(v1[0], v1[1]); w1.y = cvt_pk_bf16(v1[2], v1[3]);
          *(u32x2*)rp = w0;
          *(u32x2*)(rp + 16) = w1;
        }
    }
  }
};
struct EpiBf16 {
  bf16_t* P; int ldc;
  __device__ __forceinline__ void operator()(const f32x4 (&acc)[2][2][4][2], int brow, int bcol, int wr, int wc, int fr, int fq) const {
#pragma unroll
    for (int ai = 0; ai < 2; ++ai)
#pragma unroll
      for (int m = 0; m < 4; ++m) {
        const int row = brow + ai * HALF + wr * 64 + m * 16 + fr;
#pragma unroll
        for (int bj = 0; bj < 2; ++bj)
#pragma unroll
          for (int n = 0; n < 2; ++n) {
            const f32x4 v = acc[ai][bj][m][n];
            u32x2 w; w.x = cvt_pk_bf16(v[0], v[1]); w.y = cvt_pk_bf16(v[2], v[3]);
            *(u32x2*)(P + (size_t)row * ldc + bcol + bj * HALF + wc * 32 + n * 16 + fq * 4) = w;
          }
      }
  }
};
struct EpiResid {
  const float* hin_ctx; const float* hin_lat; float* hout_ctx; float* hout_lat; const float* gate;
  __device__ __forceinline__ void operator()(const f32x4 (&acc)[2][2][4][2], int brow, int bcol, int wr, int wc, int fr, int fq) const {
    const bool isctx = brow < NCTX;
    const int b = isctx ? 32 : ((brow - NCTX) >> 11);
    const float* hin = isctx ? hin_ctx + (size_t)brow * D : hin_lat + (size_t)(brow - NCTX) * D;
    float* hout = isctx ? hout_ctx + (size_t)brow * D : hout_lat + (size_t)(brow - NCTX) * D;
    const float* g = gate + (size_t)b * MODW;
#pragma unroll
    for (int bj = 0; bj < 2; ++bj)
#pragma unroll
      for (int n = 0; n < 2; ++n) {
        const int col = bcol + bj * HALF + wc * 32 + n * 16 + fq * 4;
        const f32x4 gv = *(const f32x4*)(g + col);
#pragma unroll
        for (int ai = 0; ai < 2; ++ai)
#pragma unroll
          for (int m = 0; m < 4; ++m) {
            const int r = ai * HALF + wr * 64 + m * 16 + fr;
            const f32x4 h = *(const f32x4*)(hin + (size_t)r * D + col);
            *(f32x4*)(hout + (size_t)r * D + col) = h + gv * acc[ai][bj][m][n];
          }
      }
  }
};

template <int MT, int NT>
__device__ __forceinline__ void mm_lds(const bf16_t* A, int lda, const bf16_t* B, int ldb, int K, f32x4 (&acc)[MT][NT], int fr, int fq) {
  for (int k0 = 0; k0 < K; k0 += 32) {
    bf16x8 af[MT], bf[NT];
#pragma unroll
    for (int m = 0; m < MT; ++m) af[m] = *(const bf16x8*)(A + (m * 16 + fr) * lda + k0 + fq * 8);
#pragma unroll
    for (int n = 0; n < NT; ++n) bf[n] = *(const bf16x8*)(B + (n * 16 + fr) * ldb + k0 + fq * 8);
#pragma unroll
    for (int m = 0; m < MT; ++m)
#pragma unroll
      for (int n = 0; n < NT; ++n) acc[m][n] = __builtin_amdgcn_mfma_f32_16x16x32_bf16(af[m], bf[n], acc[m][n], 0, 0, 0);
  }
}

__device__ void phase_prep(const Params& p, unsigned char* smem, int bid, int nb) {
  const int tid = tidx();
  for (int it = bid; it < 2 * 96; it += nb) {
    const int layer = it / 96, n0 = (it % 96) * 64;
    float* s = (float*)smem;
    for (int i = tid; i < 33 * 1024; i += NTHREADS) {
      const int b = i >> 10, k = i & 1023;
      const float v = (b < 32) ? p.c[b * 1024 + k] : p.c_ctx[k];
      s[k * 33 + b] = siluf(v);
    }
    __syncthreads();
    const int col = tid & 63, kg = tid >> 6;
    float acc[33];
#pragma unroll
    for (int b = 0; b < 33; ++b) acc[b] = 0.f;
    const float* W = p.ada_w + (size_t)layer * 1024 * MODW + n0 + col;
    for (int k = kg * 128; k < kg * 128 + 128; ++k) {
      const float w = W[(size_t)k * MODW];
      const float* sk = s + k * 33;
#pragma unroll
      for (int b = 0; b < 33; ++b) acc[b] += sk[b] * w;
    }
    __syncthreads();
    float* red = (float*)smem;
#pragma unroll
    for (int b = 0; b < 33; ++b) red[(kg * 33 + b) * 64 + col] = acc[b];
    __syncthreads();
    for (int i = tid; i < 33 * 64; i += NTHREADS) {
      const int b = i >> 6, cc = i & 63;
      float t = p.ada_b[layer * MODW + n0 + cc];
#pragma unroll
      for (int g = 0; g < 8; ++g) t += red[(g * 33 + b) * 64 + cc];
      p.mod[((size_t)layer * 33 + b) * MODW + n0 + cc] = t;
    }
    __syncthreads();
  }
  if (bid == nb - 1) {
    for (int i = tid; i < 1024; i += NTHREADS) {
      const int pos = i >> 4, f = i & 15;
      const float inv = powf(10000.f, -(float)f / 16.f);
      const float ang = (float)pos * inv;
      p.ropec[i] = cosf(ang);
      p.ropes[i] = sinf(ang);
    }
  }
  {
    float* tile = (float*)smem;
    const int ntile_total = 768 + 256 + 384 + 256 + 512;
    for (int it = bid; it < ntile_total; it += nb) {
      const float* src; bf16_t* dst; int N, ti;
      if (it < 768) { src = p.ev_w_in; dst = p.winT0; N = 3072; ti = it; }
      else if (it < 1024) { src = p.ev_w_out; dst = p.woutT0; N = 1024; ti = it - 768; }
      else if (it < 1408) { src = p.od_w_in; dst = p.winT1; N = 1536; ti = it - 1024; }
      else if (it < 1664) { src = p.od_w_out; dst = p.woutT1; N = 1024; ti = it - 1408; }
      else { const int l = (it - 1664) / 256; src = p.peer_wq + (size_t)l * 1024 * 1024; dst = p.wqT + (size_t)l * 1024 * 1024; N = 1024; ti = (it - 1664) % 256; }
      const int ntn = N / 64, tk = ti / ntn, tn = ti % ntn;
      __syncthreads();
      for (int i = tid; i < 64 * 64; i += NTHREADS) {
        const int r = i >> 6, cc = i & 63;
        tile[r * 65 + cc] = src[(size_t)(tk * 64 + r) * N + tn * 64 + cc];
      }
      __syncthreads();
      for (int i = tid; i < 64 * 32; i += NTHREADS) {
        const int nn = i >> 5, kk = (i & 31) * 2;
        const unsigned w = cvt_pk_bf16(tile[kk * 65 + nn], tile[(kk + 1) * 65 + nn]);
        *(unsigned*)(dst + (size_t)(tn * 64 + nn) * 1024 + tk * 64 + kk) = w;
      }
    }
    __syncthreads();
  }
  for (int idx = bid * NTHREADS + tid; idx < 2 * 8 * 2 * 128 * 64; idx += nb * NTHREADS) {
    const int d = idx & 63, k = (idx >> 6) & 127, s = (idx >> 13) & 1, hh = (idx >> 14) & 7, l = idx >> 17;
    const float v = (s ? p.keys2 : p.keys1)[((size_t)(l * 8 + hh) * 128 + k) * 64 + d];
    const bf16_t hi = f2bf(v);
    const bf16_t lo = f2bf(v - bf2f(hi));
    const size_t o = ((size_t)((l * 8 + hh) * 2 + s) * 2) * 8192 + (size_t)k * 64 + d;
    p.keysb[o] = hi;
    p.keysb[o + 8192] = lo;
  }
  {
    const int wid = tid >> 6, lane = tid & 63, hw = lane >> 5, L = lane & 31, bb = L >> 3, ii = L & 7;
    for (int r = (bid * 8 + wid) * 2 + hw; r < 4 * NEXP; r += nb * 16) {
      const bool isv = r >= 2 * NEXP;
      const int rr = isv ? r - 2 * NEXP : r;
      const float* src = (isv ? p.peer_v : p.peer_u) + (size_t)rr * D + bb * 256 + ii * 32;
      f32x4 a[8];
      float mx = 0.f;
#pragma unroll
      for (int q = 0; q < 8; ++q) {
        a[q] = *(const f32x4*)(src + q * 4);
        mx = fmaxf(mx, fmaxf(fmaxf(fabsf(a[q][0]), fabsf(a[q][1])), fmaxf(fabsf(a[q][2]), fabsf(a[q][3]))));
      }
      mx = row16_max(mx);
      { auto sw = __builtin_amdgcn_permlane16_swap(__float_as_uint(mx), __float_as_uint(mx), false, false); mx = fmaxf(__uint_as_float(sw[0]), __uint_as_float(sw[1])); }
      const float sc = mx > 0.f ? 7.0f / mx : 1.f;
      u32x16 pk;
#pragma unroll
      for (int q = 0; q < 8; ++q) { pk[2 * q] = cvt_pk_bf16(a[q][0] * sc, a[q][1] * sc); pk[2 * q + 1] = cvt_pk_bf16(a[q][2] * sc, a[q][3] * sc); }
      const u32x6 w = __builtin_amdgcn_cvt_scalef32_pk32_fp6_bf16(__builtin_bit_cast(bf16x32n, pk), 1.0f);
      unsigned char* dst = (isv ? p.v8 : p.u8) + (size_t)rr * 768 + ii * 16;
#pragma unroll
      for (int m = 0; m < 6; ++m) {
        const int sidx = 6 * bb + m;
        const unsigned wm = w[m];
        *(unsigned*)(dst + (sidx >> 2) * 128 + (sidx & 3) * 4) = wm;
      }
      if (L == 0) (isv ? p.vscale : p.uscale)[rr] = mx > 0.f ? mx / 7.0f : 1.f;
    }
  }
}

__device__ void phase_norm(const Params& p, int bid, int nb, int row0, int row1, const float* hctx, const float* hlat,
                           const float* gain, const float* modl, int ish, int isc) {
  const int tid0 = tidx();
  const int wid = tid0 >> 6, lane = tid0 & 63;
  for (int row = row0 + bid * 8 + wid; row < row1; row += nb * 8) {
    const bool isctx = row < NCTX;
    const float* h = isctx ? hctx + (size_t)row * D : hlat + (size_t)(row - NCTX) * D;
    const int b = isctx ? 32 : ((row - NCTX) >> 11);
    const float* sh = modl + (size_t)b * MODW + ish * D;
    const float* sc = modl + (size_t)b * MODW + isc * D;
    f32x4 v[4];
    float ss = 0.f;
#pragma unroll
    for (int i = 0; i < 4; ++i) {
      v[i] = *(const f32x4*)(h + i * 256 + lane * 4);
      ss += v[i][0] * v[i][0] + v[i][1] * v[i][1] + v[i][2] * v[i][2] + v[i][3] * v[i][3];
    }
    ss = wave_sum(ss);
    const float rstd = rsqrtf(ss * (1.f / D) + EPS);
#pragma unroll
    for (int i = 0; i < 4; ++i) {
      const int col = i * 256 + lane * 4;
      const f32x4 g = *(const f32x4*)(gain + col), s1 = *(const f32x4*)(sc + col), s0 = *(const f32x4*)(sh + col);
      f32x4 y = v[i] * rstd * g;
      y = y * (1.f + s1) + s0;
      u32x2 w; w.x = cvt_pk_bf16(y[0], y[1]); w.y = cvt_pk_bf16(y[2], y[3]);
      *(u32x2*)(p.act + (size_t)row * D + col) = w;
    }
  }
}

__device__ __forceinline__ void phase_gemm_inproj(const Params& p, unsigned char* smem, int bid, int nb, int layer) {
  LAS unsigned char* lds = (LAS unsigned char*)smem;
  if (layer == 0) {
    EpiInProj epi{p.proj, 3072, 0, p.ropec, p.ropes};
    Sched s{0, 0, NTOK / BM, 12, nb, bid};
    gemm_phase(lds, p.act, p.winT0, s, epi);
  } else {
    EpiInProj epi{p.proj, 1536, 1, p.ropec, p.ropes};
    Sched s{NCTX / BM, 0, NLAT / BM, 6, nb, bid};
    gemm_phase(lds, p.act, p.winT1, s, epi);
    Sched s2{0, 4, NCTX / BM, 2, nb, bid};
    gemm_phase(lds, p.act, p.winT1, s2, epi);
  }
}
__device__ __forceinline__ void phase_gemm_outproj(const Params& p, unsigned char* smem, int bid, int nb, int layer) {
  LAS unsigned char* lds = (LAS unsigned char*)smem;
  if (layer == 0) {
    EpiResid epi{p.ctx, p.x, p.hctx, p.out, p.mod + 2 * D};
    Sched s{0, 0, NTOK / BM, 4, nb, bid};
    gemm_phase(lds, p.act, p.woutT0, s, epi);
  } else {
    EpiResid epi{p.hctx, p.out, p.hctx, p.out, p.mod + (size_t)33 * MODW + 2 * D};
    Sched s{NCTX / BM, 0, NLAT / BM, 4, nb, bid};
    gemm_phase(lds, p.act, p.woutT1, s, epi);
  }
}
__device__ __forceinline__ void phase_gemm_pq(const Params& p, unsigned char* smem, int bid, int nb, int layer) {
  LAS unsigned char* lds = (LAS unsigned char*)smem;
  EpiBf16 epi{p.pq, D};
  const int pm0 = layer == 0 ? 0 : NCTX / BM;
  Sched s{pm0, 0, NTOK / BM - pm0, 4, nb, bid};
  gemm_phase(lds, p.act, p.wqT + (size_t)layer * D * D, s, epi);
}

__device__ __forceinline__ int chunk_row0(int b, int cc) { return cc < 2 ? b * CTXL + cc * 128 : NCTX + b * SEQ + (cc - 2) * 128; }

constexpr int LDP = 136;
constexpr int LDK = 72;

typedef short s16x4 __attribute__((ext_vector_type(4)));
__device__ __forceinline__ bf16x8 tr_frag(const LAS bf16_t* base, int ld, int lane) {
  const int troff = ((lane & 15) >> 2) * ld + (lane & 3) * 4;
  const s16x4 v0 = __builtin_amdgcn_ds_read_tr16_b64_v4i16((LAS s16x4*)(base + troff));
  const s16x4 v1 = __builtin_amdgcn_ds_read_tr16_b64_v4i16((LAS s16x4*)(base + 16 * ld + troff));
  bf16x8 f;
  f[0] = v0[0]; f[1] = v0[1]; f[2] = v0[2]; f[3] = v0[3]; f[4] = v1[0]; f[5] = v1[1]; f[6] = v1[2]; f[7] = v1[3];
  return f;
}
__device__ void phase_ret_kv(const Params& p, unsigned char* smem, int bid, int nb) {
  const int tid = tidx(), wid = __builtin_amdgcn_readfirstlane(tid >> 6), lane = tid & 63, fr = lane & 15, fq = lane >> 4;
  LAS bf16_t* Kl = (LAS bf16_t*)smem;
  LAS bf16_t* Vl = Kl + 128 * LDK;
  for (int it = bid; it < BATCH * 4 * 18; it += nb) {
    const int cc = it % 18, h = (it / 18) & 3, b = it / 72;
    const int row0 = chunk_row0(b, cc);
    const float lf = log_sigmoidf(p.logit_f[h]), lb = log_sigmoidf(p.logit_b[h]);
    __syncthreads();
    for (int task = tid; task < 128 * 8; task += NTHREADS) {
      const int j = task >> 3, d0 = (task & 7) * 8;
      *(LAS u32x4*)(Kl + j * LDK + d0) = *(const u32x4*)(p.proj + (size_t)(row0 + j) * 3072 + 256 + h * 64 + d0);
    }
    for (int task = tid; task < 128 * 16; task += NTHREADS) {
      const int j = task >> 4, e0 = (task & 15) * 8;
      *(LAS u32x4*)(Vl + j * LDP + e0) = *(const u32x4*)(p.proj + (size_t)(row0 + j) * 3072 + 512 + h * 128 + e0);
    }
    __syncthreads();
    bf16x8 af[4], ab[4];
#pragma unroll
    for (int ks = 0; ks < 4; ++ks) {
      const bf16x8 vf = tr_frag(Vl + (ks * 32 + fq * 4) * LDP + wid * 16, LDP, lane);
      const u32x4 vu = __builtin_bit_cast(u32x4, vf);
      u32x4 wf, wb;
#pragma unroll
      for (int q = 0; q < 4; ++q) {
        const int j0 = ks * 32 + (q >> 1) * 16 + fq * 4 + (q & 1) * 2;
        const float lo = bf_lo(vu[q]), hi = bf_hi(vu[q]);
        wf[q] = cvt_pk_bf16(lo * __expf(lf * (float)(127 - j0)), hi * __expf(lf * (float)(126 - j0)));
        wb[q] = cvt_pk_bf16(lo * __expf(lb * (float)j0), hi * __expf(lb * (float)(j0 + 1)));
      }
      af[ks] = __builtin_bit_cast(bf16x8, wf);
      ab[ks] = __builtin_bit_cast(bf16x8, wb);
    }
    float* out = p.kv + (size_t)it * 16384;
#pragma unroll
    for (int n = 0; n < 4; ++n) {
      f32x4 accf = {0.f, 0.f, 0.f, 0.f}, accb = {0.f, 0.f, 0.f, 0.f};
#pragma unroll
      for (int ks = 0; ks < 4; ++ks) {
        const bf16x8 kf = tr_frag(Kl + (ks * 32 + fq * 4) * LDK + n * 16, LDK, lane);
        accf = __builtin_amdgcn_mfma_f32_16x16x32_bf16(af[ks], kf, accf, 0, 0, 0);
        accb = __builtin_amdgcn_mfma_f32_16x16x32_bf16(ab[ks], kf, accb, 0, 0, 0);
      }
#pragma unroll
      for (int j = 0; j < 4; ++j) {
        out[(wid * 16 + fq * 4 + j) * 128 + n * 16 + fr] = accf[j];
        out[(wid * 16 + fq * 4 + j) * 128 + 64 + n * 16 + fr] = accb[j];
      }
    }
  }
  for (size_t task = (size_t)bid * NTHREADS + tid; task < (size_t)NTOK * 64; task += (size_t)nb * NTHREADS) {
    const int row = (int)(task >> 6), c0 = (int)(task & 63) * 8;
    const int tin = row < NCTX ? (row & (CTXL - 1)) : ((row - NCTX) & (SEQ - 1));
    const int tlen = row < NCTX ? CTXL : SEQ;
    const bf16_t* pr = p.proj + (size_t)row * 3072;
    const u32x4 gb = *(const u32x4*)(pr + 1536 + c0);
    float accv[8];
#pragma unroll
    for (int q = 0; q < 8; ++q) accv[q] = 0.f;
#pragma unroll
    for (int dt = -1; dt <= 1; ++dt) {
      if (tin + dt < 0 || tin + dt >= tlen) continue;
      const bf16_t* pr2 = pr + (ptrdiff_t)dt * 3072;
      const u32x4 gc = *(const u32x4*)(pr2 + 2048 + c0), xt = *(const u32x4*)(pr2 + 2560 + c0);
      const float* w = p.conv_w + (dt + 1) * 512 + c0;
      const f32x4 wa = *(const f32x4*)w, wb = *(const f32x4*)(w + 4);
#pragma unroll
      for (int q = 0; q < 4; ++q) {
        const float u0 = bf_lo(gc[q]) * bf_lo(xt[q]), u1 = bf_hi(gc[q]) * bf_hi(xt[q]);
        const float w0 = (2 * q < 4) ? wa[2 * q] : wb[2 * q - 4], w1 = (2 * q + 1 < 4) ? wa[2 * q + 1] : wb[2 * q + 1 - 4];
        accv[2 * q] += w0 * u0;
        accv[2 * q + 1] += w1 * u1;
      }
    }
    u32x4 o;
#pragma unroll
    for (int q = 0; q < 4; ++q) o[q] = cvt_pk_bf16(bf_lo(gb[q]) * accv[2 * q], bf_hi(gb[q]) * accv[2 * q + 1]);
#ifdef ZERO_CONV
    o = (u32x4){0u, 0u, 0u, 0u};
#endif
    *(u32x4*)(p.act + (size_t)row * D + 512 + c0) = o;
  }
}

__device__ void phase_ret_scan(const Params& p, int bid, int nb) {
  const int tid = tidx();
  for (size_t idx = (size_t)bid * NTHREADS + tid; idx < (size_t)BATCH * 4 * 16384; idx += (size_t)nb * NTHREADS) {
    const int el = (int)(idx & 16383), bh = (int)(idx >> 14), h = bh & 3;
    const bool fwd = (el & 127) < 64;
    const float lg = log_sigmoidf(fwd ? p.logit_f[h] : p.logit_b[h]);
    const float dec = __expf(lg * 128.f);
    float st = 0.f;
    for (int s = 0; s < 18; ++s) {
      const int cc = fwd ? s : (s < 2 ? 1 - s : 19 - s);
      const size_t off = ((size_t)bh * 18 + cc) * 16384 + el;
      p.sprev[off] = f2bf(st);
      st = dec * st + p.kv[off];
    }
  }
}

__device__ void phase_ret_out(const Params& p, unsigned char* smem, int bid, int nb) {
  const int tid = tidx(), wid = __builtin_amdgcn_readfirstlane(tid >> 6), lane = tid & 63, fr = lane & 15, fq = lane >> 4;
  LAS bf16_t* Kl = (LAS bf16_t*)smem;
  LAS bf16_t* Vl = Kl + 128 * LDK;
  LAS bf16_t* Sl = Vl + 128 * LDP;
  const int NIT = BATCH * 4 * 18;
  u32x4 rk[2], rv[4], rs[4];
  bf16x8 qfn[2];
#define RO_LOAD(IT)                                                                                                      \
  do {                                                                                                                   \
    const int _cc = (IT) % 18, _h = ((IT) / 18) & 3, _b = (IT) / 72;                                                     \
    const int _row0 = chunk_row0(_b, _cc);                                                                               \
    _Pragma("unroll") for (int c = 0; c < 2; ++c) { const int task = tid + c * NTHREADS; const int j = task >> 3, d0 = (task & 7) * 8; \
      rk[c] = *(const u32x4*)(p.proj + (size_t)(_row0 + j) * 3072 + 256 + _h * 64 + d0); }                              \
    _Pragma("unroll") for (int c = 0; c < 4; ++c) { const int task = tid + c * NTHREADS; const int j = task >> 4, e0 = (task & 15) * 8; \
      rv[c] = *(const u32x4*)(p.proj + (size_t)(_row0 + j) * 3072 + 512 + _h * 128 + e0);                               \
      rs[c] = *(const u32x4*)(p.sprev + (size_t)(IT) * 16384 + j * 128 + e0); }                                          \
    _Pragma("unroll") for (int ks = 0; ks < 2; ++ks) qfn[ks] = *(const bf16x8*)(p.proj + (size_t)(_row0 + wid * 16 + fr) * 3072 + _h * 64 + ks * 32 + fq * 8); \
  } while (0)
#define RO_STORE()                                                                                                       \
  do {                                                                                                                   \
    _Pragma("unroll") for (int c = 0; c < 2; ++c) { const int task = tid + c * NTHREADS; const int j = task >> 3, d0 = (task & 7) * 8; \
      *(LAS u32x4*)(Kl + j * LDK + d0) = rk[c]; }                                                                        \
    _Pragma("unroll") for (int c = 0; c < 4; ++c) { const int task = tid + c * NTHREADS; const int j = task >> 4, e0 = (task & 15) * 8; \
      *(LAS u32x4*)(Vl + j * LDP + e0) = rv[c]; *(LAS u32x4*)(Sl + j * LDP + e0) = rs[c]; }                              \
  } while (0)
  if (bid < NIT) { RO_LOAD(bid); __syncthreads(); RO_STORE(); }
  __syncthreads();
  for (int it = bid; it < NIT; it += nb) {
    const int cc = it % 18, h = (it / 18) & 3, b = it / 72;
    const int row0 = chunk_row0(b, cc);
    const float lf = log_sigmoidf(p.logit_f[h]), lb = log_sigmoidf(p.logit_b[h]);
    const int irow = wid * 16 + fr;
    bf16x8 qf[2];
    qf[0] = qfn[0]; qf[1] = qfn[1];
    const bool more = it + nb < NIT;
    if (more) RO_LOAD(it + nb);
    const size_t row = (size_t)(row0 + irow);
    u32x2 gg[8];
#pragma unroll
    for (int dn = 0; dn < 8; ++dn) gg[dn] = *(const u32x2*)(p.proj + row * 3072 + 1024 + h * 128 + dn * 16 + fq * 4);
    bf16x8 pb[4];
    {
      f32x4 st[8];
#pragma unroll
      for (int n = 0; n < 8; ++n) st[n] = (f32x4){0.f, 0.f, 0.f, 0.f};
#pragma unroll
      for (int ks = 0; ks < 2; ++ks)
#pragma unroll
        for (int n = 0; n < 8; ++n) {
          const bf16x8 kf = *(const LAS bf16x8*)(Kl + (n * 16 + fr) * LDK + ks * 32 + fq * 8);
          st[n] = __builtin_amdgcn_mfma_f32_16x16x32_bf16(kf, qf[ks], st[n], 0, 0, 0);
        }
#pragma unroll
      for (int n = 0; n < 8; ++n)
#pragma unroll
        for (int r = 0; r < 4; ++r) {
          const int df = irow - (n * 16 + fq * 4 + r);
          const float lg = df > 0 ? lf : lb;
          const float ex = __expf(lg * fabsf((float)df));
          st[n][r] *= (df == 0) ? 2.f : ex;
        }
#pragma unroll
      for (int kk = 0; kk < 4; ++kk) {
        u32x4 w;
        w.x = cvt_pk_bf16(st[2 * kk][0], st[2 * kk][1]); w.y = cvt_pk_bf16(st[2 * kk][2], st[2 * kk][3]);
        w.z = cvt_pk_bf16(st[2 * kk + 1][0], st[2 * kk + 1][1]); w.w = cvt_pk_bf16(st[2 * kk + 1][2], st[2 * kk + 1][3]);
        pb[kk] = __builtin_bit_cast(bf16x8, w);
      }
    }
    bf16x8 qx[4];
    {
      const float xf = __expf(lf * (float)(irow + 1)), xb = __expf(lb * (float)(128 - irow));
#pragma unroll
      for (int ks = 0; ks < 4; ++ks) {
        const float sc = ks < 2 ? xf : xb;
        const u32x4 qu = __builtin_bit_cast(u32x4, qf[ks & 1]);
        u32x4 qo;
#pragma unroll
        for (int q = 0; q < 4; ++q) { const unsigned w = qu[q]; qo[q] = cvt_pk_bf16(bf_lo(w) * sc, bf_hi(w) * sc); }
        qx[ks] = __builtin_bit_cast(bf16x8, qo);
      }
    }
    f32x4 ot[8];
#pragma unroll
    for (int dn = 0; dn < 8; ++dn) {
      f32x4 o = {0.f, 0.f, 0.f, 0.f};
#pragma unroll
      for (int kk = 0; kk < 4; ++kk) {
        const bf16x8 vf = tr_frag(Vl + (kk * 32 + fq * 4) * LDP + dn * 16, LDP, lane);
        o = __builtin_amdgcn_mfma_f32_16x16x32_bf16(vf, pb[kk], o, 0, 0, 0);
      }
#pragma unroll
      for (int ks = 0; ks < 4; ++ks) {
        const bf16x8 sf = *(const LAS bf16x8*)(Sl + (dn * 16 + fr) * LDP + ks * 32 + fq * 8);
        o = __builtin_amdgcn_mfma_f32_16x16x32_bf16(sf, qx[ks], o, 0, 0, 0);
      }
      ot[dn] = o;
    }
    float ss = 0.f;
#pragma unroll
    for (int dn = 0; dn < 8; ++dn) ss += ot[dn][0] * ot[dn][0] + ot[dn][1] * ot[dn][1] + ot[dn][2] * ot[dn][2] + ot[dn][3] * ot[dn][3];
    ss = xrow16_sum(ss);
    const float rstd = rsqrtf(ss * (1.f / 128.f) + EPS);
#pragma unroll
    for (int dn = 0; dn < 8; ++dn) {
      const int e0 = dn * 16 + fq * 4;
      const u32x2 g = gg[dn];
      u32x2 w;
#ifdef ZERO_RET
      w.x = 0u; w.y = 0u;
#else
      w.x = cvt_pk_bf16(ot[dn][0] * rstd * siluf(bf_lo(g.x)), ot[dn][1] * rstd * siluf(bf_hi(g.x)));
      w.y = cvt_pk_bf16(ot[dn][2] * rstd * siluf(bf_lo(g.y)), ot[dn][3] * rstd * siluf(bf_hi(g.y)));
#endif
      *(u32x2*)(p.act + row * D + h * 128 + e0) = w;
    }
    __syncthreads();
    if (more) RO_STORE();
    __syncthreads();
  }
#undef RO_LOAD
#undef RO_STORE
}

__device__ __forceinline__ float xrow16_max(float x) {
  auto s = __builtin_amdgcn_permlane16_swap(__float_as_uint(x), __float_as_uint(x), false, false);
  x = fmaxf(__uint_as_float(s[0]), __uint_as_float(s[1]));
  auto t = __builtin_amdgcn_permlane32_swap(__float_as_uint(x), __float_as_uint(x), false, false);
  return fmaxf(__uint_as_float(t[0]), __uint_as_float(t[1]));
}
template <int VAR>
__device__ void phase_attn(const Params& p, unsigned char* smem, int bid, int nb, bf16_t* outp) {
  const int tid = tidx(), wid = __builtin_amdgcn_readfirstlane(tid >> 6), lane = tid & 63, fr = lane & 15, fq = lane >> 4;
  LAS bf16_t* Kl = (LAS bf16_t*)smem;
  LAS bf16_t* Vl = Kl + 2 * 64 * LDK;
  LAS bf16_t* Ql = Vl + 2 * 64 * LDK + wid * 64 * LDK;
  const int sj = tid >> 3, sc8 = (tid & 7) * 8;
  const int troff = ((lane & 15) >> 2) * LDK + (lane & 3) * 4;
  for (int it = bid; it < BATCH * 16 * 4; it += nb) {
    const int kvh = it & 3, qb = (it >> 2) & 15, b = it >> 6;
    const int hq = kvh * 4 + (wid >> 1);
    const int q0 = qb * 128 + (wid & 1) * 64;
    const size_t latrow0 = (size_t)NCTX + (size_t)b * SEQ;
    const int tlo = qb == 0 ? 2 : 0, nwin = (qb == 15 ? 4 : 6) - tlo, ntile = nwin + 4;
#pragma unroll
    for (int m = 0; m < 4; ++m)
#pragma unroll
      for (int ks = 0; ks < 2; ++ks)
        *(LAS bf16x8*)(Ql + (m * 16 + fr) * LDK + ks * 32 + fq * 8) = *(const bf16x8*)(p.proj + (latrow0 + q0 + m * 16 + fr) * 1536 + hq * 64 + ks * 32 + fq * 8);
    const float sink = p.sinks[hq];
    float mrow[4], lrow[4];
    f32x4 ot[4][4];
#pragma unroll
    for (int m = 0; m < 4; ++m) {
      mrow[m] = sink; lrow[m] = (fq == 0) ? 1.f : 0.f;
#pragma unroll
      for (int dn = 0; dn < 4; ++dn) ot[dn][m] = (f32x4){0.f, 0.f, 0.f, 0.f};
    }
    {
      const int tt = tlo;
      const size_t krow0 = latrow0 + (qb * 128 - 128 + 64 * tt);
      const u32x4 kk = *(const u32x4*)(p.proj + (krow0 + sj) * 1536 + 1024 + kvh * 64 + sc8);
      const u32x4 vv = *(const u32x4*)(p.proj + (krow0 + sj) * 1536 + 1280 + kvh * 64 + sc8);
      *(LAS u32x4*)(Kl + sj * LDK + sc8) = kk;
      *(LAS u32x4*)(Vl + sj * LDK + sc8) = vv;
    }
    __syncthreads();
#pragma unroll 1
    for (int s = 0; s < ntile; ++s) {
      const int cur = s & 1;
      const int tt = s < nwin ? tlo + s : 6 + (s - nwin);
      const bool win = tt < 6;
      const int kpos0 = win ? qb * 128 - 128 + 64 * tt : (tt - 6) * 64;
      u32x4 nk, nv;
      const bool more = s + 1 < ntile;
      if (more) {
        const int tn = (s + 1) < nwin ? tlo + s + 1 : 6 + (s + 1 - nwin);
        const size_t krow0 = tn < 6 ? latrow0 + (qb * 128 - 128 + 64 * tn) : (size_t)b * CTXL + (tn - 6) * 64;
        nk = *(const u32x4*)(p.proj + (krow0 + sj) * 1536 + 1024 + kvh * 64 + sc8);
        nv = *(const u32x4*)(p.proj + (krow0 + sj) * 1536 + 1280 + kvh * 64 + sc8);
      }
      const LAS bf16_t* Kc = Kl + cur * 64 * LDK;
      const LAS bf16_t* Vc = Vl + cur * 64 * LDK;
      bf16x8 pb[4][2];
      {
        bf16x8 kfr[2][4];
#pragma unroll
        for (int ks = 0; ks < 2; ++ks)
#pragma unroll
          for (int n = 0; n < 4; ++n) kfr[ks][n] = *(const LAS bf16x8*)(Kc + (n * 16 + fr) * LDK + ks * 32 + fq * 8);
#pragma unroll
        for (int m = 0; m < 4; ++m) {
          f32x4 st[4];
#pragma unroll
          for (int n = 0; n < 4; ++n) st[n] = (f32x4){0.f, 0.f, 0.f, 0.f};
#pragma unroll
          for (int ks = 0; ks < 2; ++ks) {
            const bf16x8 qfm = *(const LAS bf16x8*)(Ql + (m * 16 + fr) * LDK + ks * 32 + fq * 8);
#pragma unroll
            for (int n = 0; n < 4; ++n) st[n] = __builtin_amdgcn_mfma_f32_16x16x32_bf16(kfr[ks][n], qfm, st[n], 0, 0, 0);
          }
          const int qpos = q0 + m * 16 + fr;
          float mx = -3.0e38f;
#pragma unroll
          for (int n = 0; n < 4; ++n)
#pragma unroll
            for (int j = 0; j < 4; ++j) {
              float sv = st[n][j];
              if (!(VAR & 1)) { if (win) { const int dd = qpos - (kpos0 + n * 16 + fq * 4 + j); if (dd > 128 || dd < -128) sv = -1e30f; } }
              st[n][j] = sv;
              mx = fmaxf(mx, sv);
            }
          mx = xrow16_max(mx);
          const float mnew = fmaxf(mrow[m], mx);
          const float alpha = __expf(mrow[m] - mnew);
          mrow[m] = mnew;
          float ls = 0.f;
#pragma unroll
          for (int n = 0; n < 4; ++n)
#pragma unroll
            for (int j = 0; j < 4; ++j) { const float pv = (VAR & 2) ? (st[n][j] - mnew) : __expf(st[n][j] - mnew); st[n][j] = pv; ls += pv; }
          lrow[m] = lrow[m] * alpha + ls;
#pragma unroll
          for (int dn = 0; dn < 4; ++dn) ot[dn][m] *= alpha;
#pragma unroll
          for (int kk = 0; kk < 2; ++kk) {
            u32x4 w;
            w.x = cvt_pk_bf16(st[2 * kk][0], st[2 * kk][1]); w.y = cvt_pk_bf16(st[2 * kk][2], st[2 * kk][3]);
            w.z = cvt_pk_bf16(st[2 * kk + 1][0], st[2 * kk + 1][1]); w.w = cvt_pk_bf16(st[2 * kk + 1][2], st[2 * kk + 1][3]);
            pb[m][kk] = __builtin_bit_cast(bf16x8, w);
          }
          __builtin_amdgcn_sched_barrier(0);
        }
      }
#pragma unroll
      for (int kk = 0; kk < 2; ++kk) {
        bf16x8 vfr[4];
#pragma unroll
        for (int dn = 0; dn < 4; ++dn) {
          const s16x4 v0 = __builtin_amdgcn_ds_read_tr16_b64_v4i16((LAS s16x4*)(Vc + ((2 * kk) * 16 + fq * 4) * LDK + dn * 16 + troff));
          const s16x4 v1 = __builtin_amdgcn_ds_read_tr16_b64_v4i16((LAS s16x4*)(Vc + ((2 * kk + 1) * 16 + fq * 4) * LDK + dn * 16 + troff));
          bf16x8 vf;
          vf[0] = v0[0]; vf[1] = v0[1]; vf[2] = v0[2]; vf[3] = v0[3]; vf[4] = v1[0]; vf[5] = v1[1]; vf[6] = v1[2]; vf[7] = v1[3];
          vfr[dn] = vf;
        }
#pragma unroll
        for (int m = 0; m < 4; ++m)
#pragma unroll
          for (int dn = 0; dn < 4; ++dn) { if (VAR & 4) ot[dn][m][0] += __uint_as_float(__builtin_bit_cast(u32x4, vfr[dn]).x ^ __builtin_bit_cast(u32x4, pb[m][kk]).x); else ot[dn][m] = __builtin_amdgcn_mfma_f32_16x16x32_bf16(vfr[dn], pb[m][kk], ot[dn][m], 0, 0, 0); }
        __builtin_amdgcn_sched_barrier(0);
      }
      if (more) {
        *(LAS u32x4*)(Kl + ((cur ^ 1) * 64 + sj) * LDK + sc8) = nk;
        *(LAS u32x4*)(Vl + ((cur ^ 1) * 64 + sj) * LDK + sc8) = nv;
      }
      __syncthreads();
    }
    int fr2 = fr;
    asm volatile("" : "+v"(fr2));
#pragma unroll
    for (int m = 0; m < 4; ++m) {
      const float l = xrow16_sum(lrow[m]);
      const float inv = 1.f / l;
      bf16_t* orow = outp + (latrow0 + q0 + m * 16 + fr2) * D + hq * 64 + fq * 4;
#pragma unroll
      for (int dn = 0; dn < 4; ++dn) {
        u32x2 w;
#ifdef ZERO_ATTN
        w.x = 0u; w.y = 0u;
#else
        w.x = cvt_pk_bf16(ot[dn][m][0] * inv, ot[dn][m][1] * inv); w.y = cvt_pk_bf16(ot[dn][m][2] * inv, ot[dn][m][3] * inv);
#endif
        *(u32x2*)(orow + dn * 16) = w;
      }
    }
  }
}

#define CEX(a, b) do { const unsigned _h = max(a, b), _l = min(a, b); a = _h; b = _l; } while (0)
__device__ __forceinline__ void sort16_desc(unsigned (&v)[16]) { CEX(v[0], v[1]); CEX(v[2], v[3]); CEX(v[0], v[2]); CEX(v[1], v[3]); CEX(v[1], v[2]); CEX(v[4], v[5]); CEX(v[6], v[7]); CEX(v[4], v[6]); CEX(v[5], v[7]); CEX(v[5], v[6]); CEX(v[0], v[4]); CEX(v[2], v[6]); CEX(v[2], v[4]); CEX(v[1], v[5]); CEX(v[3], v[7]); CEX(v[3], v[5]); CEX(v[1], v[2]); CEX(v[3], v[4]); CEX(v[5], v[6]); CEX(v[8], v[9]); CEX(v[10], v[11]); CEX(v[8], v[10]); CEX(v[9], v[11]); CEX(v[9], v[10]); CEX(v[12], v[13]); CEX(v[14], v[15]); CEX(v[12], v[14]); CEX(v[13], v[15]); CEX(v[13], v[14]); CEX(v[8], v[12]); CEX(v[10], v[14]); CEX(v[10], v[12]); CEX(v[9], v[13]); CEX(v[11], v[15]); CEX(v[11], v[13]); CEX(v[9], v[10]); CEX(v[11], v[12]); CEX(v[13], v[14]); CEX(v[0], v[8]); CEX(v[4], v[12]); CEX(v[4], v[8]); CEX(v[2], v[10]); CEX(v[6], v[14]); CEX(v[6], v[10]); CEX(v[2], v[4]); CEX(v[6], v[8]); CEX(v[10], v[12]); CEX(v[1], v[9]); CEX(v[5], v[13]); CEX(v[5], v[9]); CEX(v[3], v[11]); CEX(v[7], v[15]); CEX(v[7], v[11]); CEX(v[3], v[5]); CEX(v[7], v[9]); CEX(v[11], v[13]); CEX(v[1], v[2]); CEX(v[3], v[4]); CEX(v[5], v[6]); CEX(v[7], v[8]); CEX(v[9], v[10]); CEX(v[11], v[12]); CEX(v[13], v[14]); }
__device__ __forceinline__ void merge16_desc(unsigned (&t)[16], const unsigned (&b)[16]) {
#pragma unroll
  for (int i = 0; i < 16; ++i) t[i] = max(t[i], b[15 - i]);
  CEX(t[0], t[8]); CEX(t[1], t[9]); CEX(t[2], t[10]); CEX(t[3], t[11]); CEX(t[4], t[12]); CEX(t[5], t[13]); CEX(t[6], t[14]); CEX(t[7], t[15]); CEX(t[0], t[4]); CEX(t[1], t[5]); CEX(t[2], t[6]); CEX(t[3], t[7]); CEX(t[8], t[12]); CEX(t[9], t[13]); CEX(t[10], t[14]); CEX(t[11], t[15]); CEX(t[0], t[2]); CEX(t[1], t[3]); CEX(t[4], t[6]); CEX(t[5], t[7]); CEX(t[8], t[10]); CEX(t[9], t[11]); CEX(t[12], t[14]); CEX(t[13], t[15]); CEX(t[0], t[1]); CEX(t[2], t[3]); CEX(t[4], t[5]); CEX(t[6], t[7]); CEX(t[8], t[9]); CEX(t[10], t[11]); CEX(t[12], t[13]); CEX(t[14], t[15]);
}

__device__ __forceinline__ unsigned f2ord(float f) { const unsigned u = __float_as_uint(f); return (u & 0x80000000u) ? ~u : (u | 0x80000000u); }
__device__ __forceinline__ float ord2f(unsigned k) { const unsigned u = (k & 0x80000000u) ? (k & 0x7fffffffu) : ~k; return __uint_as_float(u); }
__device__ __forceinline__ unsigned dpp_xor1(unsigned x) { return (unsigned)__builtin_amdgcn_mov_dpp((int)x, 0xB1, 0xf, 0xf, true); }

__device__ void phase_peer_topk(const Params& p, unsigned char* smem, int bid, int nb, int layer, int tok0, int ntok) {
  const int tid = tidx(), wid = __builtin_amdgcn_readfirstlane(tid >> 6), lane = tid & 63, fr = lane & 15, fq = lane >> 4;
  LAS unsigned* sc = (LAS unsigned*)smem + wid * (64 * 36 + 64 * 16);
  LAS unsigned* fl = sc + 64 * 36;
  const int ls = lane & 1;
  const int nitem = (ntok / 256) * 8;
  for (int it = bid; it < nitem; it += nb) {
    const int h = it & 7, tile = it >> 3;
    const int tokw0 = tok0 + tile * 256 + wid * 32;
    bf16x8 qa[2][2][2];
#pragma unroll
    for (int m = 0; m < 2; ++m)
#pragma unroll
      for (int s = 0; s < 2; ++s)
#pragma unroll
        for (int ks = 0; ks < 2; ++ks)
          qa[m][s][ks] = *(const bf16x8*)(p.pq + (size_t)(tokw0 + m * 16 + fr) * D + h * 128 + s * 64 + ks * 32 + fq * 8);
    unsigned top[16];
#pragma unroll
    for (int i = 0; i < 16; ++i) top[i] = 0u;
    const bf16_t* kb = p.keysb + (size_t)(layer * 8 + h) * (2 * 2 * 128 * 64);
#pragma unroll 1
    for (int c = 0; c < 4; ++c) {
      f32x4 acc[2][2][2];
#pragma unroll
      for (int m = 0; m < 2; ++m)
#pragma unroll
        for (int s = 0; s < 2; ++s)
#pragma unroll
          for (int n = 0; n < 2; ++n) acc[m][s][n] = (f32x4){0.f, 0.f, 0.f, 0.f};
#pragma unroll
      for (int s = 0; s < 2; ++s)
#pragma unroll
        for (int hl = 0; hl < 2; ++hl)
#pragma unroll
          for (int n = 0; n < 2; ++n)
#pragma unroll
            for (int ks = 0; ks < 2; ++ks) {
              const bf16x8 bfr = *(const bf16x8*)(kb + (size_t)((s * 2 + hl) * 128 + c * 32 + n * 16 + fr) * 64 + ks * 32 + fq * 8);
#pragma unroll
              for (int m = 0; m < 2; ++m) acc[m][s][n] = __builtin_amdgcn_mfma_f32_16x16x32_bf16(qa[m][s][ks], bfr, acc[m][s][n], 0, 0, 0);
            }
#pragma unroll
      for (int m = 0; m < 2; ++m)
#pragma unroll
        for (int s = 0; s < 2; ++s)
#pragma unroll
          for (int n = 0; n < 2; ++n)
#pragma unroll
            for (int j = 0; j < 4; ++j)
              sc[((m * 16 + fq * 4 + j) * 2 + s) * 36 + n * 16 + fr] = (f2ord(acc[m][s][n][j]) & 0xffffff80u) | (unsigned)(127 - (c * 32 + n * 16 + fr));
      unsigned b0[16], b1[16];
#pragma unroll
      for (int q = 0; q < 4; ++q) {
        const u32x4 w0 = *(const LAS u32x4*)(sc + lane * 36 + q * 4), w1 = *(const LAS u32x4*)(sc + lane * 36 + 16 + q * 4);
        b0[4 * q] = w0.x; b0[4 * q + 1] = w0.y; b0[4 * q + 2] = w0.z; b0[4 * q + 3] = w0.w;
        b1[4 * q] = w1.x; b1[4 * q + 1] = w1.y; b1[4 * q + 2] = w1.z; b1[4 * q + 3] = w1.w;
      }
      sort16_desc(b0); merge16_desc(top, b0);
      sort16_desc(b1); merge16_desc(top, b1);
    }
#pragma unroll
    for (int q = 0; q < 4; ++q) { u32x4 w; w.x = top[4 * q]; w.y = top[4 * q + 1]; w.z = top[4 * q + 2]; w.w = top[4 * q + 3]; *(LAS u32x4*)(fl + lane * 16 + q * 4) = w; }
    float own[16], oth[16];
#pragma unroll
    for (int q = 0; q < 4; ++q) {
      const u32x4 w = *(const LAS u32x4*)(fl + (lane ^ 1) * 16 + q * 4);
      oth[4 * q] = ord2f(w.x & 0xffffff80u); oth[4 * q + 1] = ord2f(w.y & 0xffffff80u); oth[4 * q + 2] = ord2f(w.z & 0xffffff80u); oth[4 * q + 3] = ord2f(w.w & 0xffffff80u);
    }
#pragma unroll
    for (int i = 0; i < 16; ++i) own[i] = ord2f(top[i] & 0xffffff80u);
    unsigned ck[32];
    ck[0] = (f2ord(own[0] + oth[1]) & 0xffffff00u) | (255u - (ls ? 16u : 1u));
    ck[1] = (f2ord(own[0] + oth[2]) & 0xffffff00u) | (255u - (ls ? 32u : 2u));
    ck[2] = (f2ord(own[0] + oth[3]) & 0xffffff00u) | (255u - (ls ? 48u : 3u));
    ck[3] = (f2ord(own[0] + oth[4]) & 0xffffff00u) | (255u - (ls ? 64u : 4u));
    ck[4] = (f2ord(own[0] + oth[5]) & 0xffffff00u) | (255u - (ls ? 80u : 5u));
    ck[5] = (f2ord(own[0] + oth[6]) & 0xffffff00u) | (255u - (ls ? 96u : 6u));
    ck[6] = (f2ord(own[0] + oth[7]) & 0xffffff00u) | (255u - (ls ? 112u : 7u));
    ck[7] = (f2ord(own[0] + oth[8]) & 0xffffff00u) | (255u - (ls ? 128u : 8u));
    ck[8] = (f2ord(own[0] + oth[9]) & 0xffffff00u) | (255u - (ls ? 144u : 9u));
    ck[9] = (f2ord(own[0] + oth[10]) & 0xffffff00u) | (255u - (ls ? 160u : 10u));
    ck[10] = (f2ord(own[0] + oth[11]) & 0xffffff00u) | (255u - (ls ? 176u : 11u));
    ck[11] = (f2ord(own[0] + oth[12]) & 0xffffff00u) | (255u - (ls ? 192u : 12u));
    ck[12] = (f2ord(own[0] + oth[13]) & 0xffffff00u) | (255u - (ls ? 208u : 13u));
    ck[13] = (f2ord(own[0] + oth[14]) & 0xffffff00u) | (255u - (ls ? 224u : 14u));
    ck[14] = (f2ord(own[0] + oth[15]) & 0xffffff00u) | (255u - (ls ? 240u : 15u));
    ck[15] = (f2ord(own[1] + oth[2]) & 0xffffff00u) | (255u - (ls ? 33u : 18u));
    ck[16] = (f2ord(own[1] + oth[3]) & 0xffffff00u) | (255u - (ls ? 49u : 19u));
    ck[17] = (f2ord(own[1] + oth[4]) & 0xffffff00u) | (255u - (ls ? 65u : 20u));
    ck[18] = (f2ord(own[1] + oth[5]) & 0xffffff00u) | (255u - (ls ? 81u : 21u));
    ck[19] = (f2ord(own[1] + oth[6]) & 0xffffff00u) | (255u - (ls ? 97u : 22u));
    ck[20] = (f2ord(own[1] + oth[7]) & 0xffffff00u) | (255u - (ls ? 113u : 23u));
    ck[21] = (f2ord(own[2] + oth[3]) & 0xffffff00u) | (255u - (ls ? 50u : 35u));
    ck[22] = (f2ord(own[2] + oth[4]) & 0xffffff00u) | (255u - (ls ? 66u : 36u));
    ck[23] = ls ? 0u : ((f2ord(own[0] + oth[0]) & 0xffffff00u) | (255u - 0u));
    ck[24] = ls ? 0u : ((f2ord(own[1] + oth[1]) & 0xffffff00u) | (255u - 17u));
    ck[25] = ls ? 0u : ((f2ord(own[2] + oth[2]) & 0xffffff00u) | (255u - 34u));
    ck[26] = ls ? 0u : ((f2ord(own[3] + oth[3]) & 0xffffff00u) | (255u - 51u));
    ck[27] = 0u;
    ck[28] = 0u;
    ck[29] = 0u;
    ck[30] = 0u;
    ck[31] = 0u;
    unsigned c0[16], c1[16];
#pragma unroll
    for (int i = 0; i < 16; ++i) { c0[i] = ck[i]; c1[i] = ck[16 + i]; }
    sort16_desc(c0); sort16_desc(c1); merge16_desc(c0, c1);
    unsigned pt[16];
#pragma unroll
    for (int i = 0; i < 16; ++i) pt[i] = dpp_xor1(c0[i]);
    merge16_desc(c0, pt);
    float cs[16], den = 0.f;
    const float mx = ord2f(c0[0] & 0xffffff00u);
#pragma unroll
    for (int r = 0; r < 16; ++r) { cs[r] = __expf(ord2f(c0[r] & 0xffffff00u) - mx); den += cs[r]; }
    const float inv = 1.f / den;
    const int token = tokw0 + (lane >> 1);
    if (ls == 0) {
      u32x2* so = p.sel + (size_t)token * 128 + h * 16;
      const LAS unsigned* l1 = fl + lane * 16;
      const LAS unsigned* l2 = fl + (lane + 1) * 16;
#pragma unroll
      for (int rr = 0; rr < 16; rr += 2) {
        u32x4 w;
        {
          const unsigned ci = 255u - (c0[rr] & 0xffu);
          w.x = (127u - (l1[ci >> 4] & 0x7fu)) * 128u + (127u - (l2[ci & 15u] & 0x7fu)); w.y = __float_as_uint(cs[rr] * inv);
        }
        {
          const unsigned ci = 255u - (c0[rr + 1] & 0xffu);
          w.z = (127u - (l1[ci >> 4] & 0x7fu)) * 128u + (127u - (l2[ci & 15u] & 0x7fu)); w.w = __float_as_uint(cs[rr + 1] * inv);
        }
        *(u32x4*)(so + rr) = w;
      }
    }
  }
}

__device__ __forceinline__ float gelu_as(float v) {
  const float av = fabsf(v), t = __builtin_amdgcn_rcpf(av * 0.2316418882f + 1.0f);
  float q = t * 0.5307027145f + (-0.7265760135f);
  q = q * t + 0.7107068705f; q = q * t + (-0.142248368f); q = q * t + 0.127414796f; q = q * t;
  const float ee = __builtin_amdgcn_exp2f((v * v) * (-0.72134752044f));
  const float m = v * (q * ee);
  return v < 0.f ? m : v - m;
}
typedef __bf16 bf16x2t __attribute__((ext_vector_type(2)));
__device__ __forceinline__ unsigned rl2(unsigned lo, unsigned hi, int j) {
  const unsigned a = (unsigned)__builtin_amdgcn_readlane((int)lo, j & 63), b = (unsigned)__builtin_amdgcn_readlane((int)hi, j & 63);
  return j < 64 ? a : b;
}
__device__ __forceinline__ float group8_sum(float x) { x += dppf<0xB1>(x); x += dppf<0x4E>(x); x += dppf<0x141>(x); return x; }
__device__ __forceinline__ float dot2u(unsigned a, unsigned b, float c) {
  return __builtin_amdgcn_fdot2_f32_bf16(__builtin_bit_cast(bf16x2t, a), __builtin_bit_cast(bf16x2t, b), c, false);
}
__device__ void phase_peer_gather(const Params& p, unsigned char* smem, int bid, int nb, int layer, int tok0, int ntok) {
  const int tid0 = tidx();
  const int wid = __builtin_amdgcn_readfirstlane(tid0 >> 6), lane = tid0 & 63, g = lane >> 3, i = lane & 7;
  const __amdgpu_buffer_rsrc_t U = __builtin_amdgcn_make_buffer_rsrc((void*)(p.u8 + (size_t)layer * NEXP * 768), (short)0, NEXP * 768, 0x00020000);
  const __amdgpu_buffer_rsrc_t V = __builtin_amdgcn_make_buffer_rsrc((void*)(p.v8 + (size_t)layer * NEXP * 768), (short)0, NEXP * 768, 0x00020000);
  const float* us = p.uscale + (size_t)layer * NEXP;
  const float* vs = p.vscale + (size_t)layer * NEXP;
  const float* modl = p.mod + (size_t)layer * 33 * MODW;
  LAS unsigned* lst = (LAS unsigned*)smem + wid * 3072;
#define PIECE(R, VOFF, K) __builtin_bit_cast(u32x4, __builtin_amdgcn_raw_buffer_load_b128(R, (VOFF) + (K) * 128, 0, 0))
  for (int grp = bid * 8 + wid; grp < ntok / 8; grp += nb * 8) {
    const int token0 = tok0 + grp * 8;
#pragma unroll 1
    for (int t = 0; t < 8; ++t) {
      const int token = token0 + t;
      const u32x2 se0 = p.sel[(size_t)token * 128 + lane], se1 = p.sel[(size_t)token * 128 + 64 + lane];
      const unsigned k0 = (se0.x << 7) | (unsigned)lane, k1 = (se1.x << 7) | (unsigned)(lane + 64);
      const float g0 = __uint_as_float(se0.y) * vs[se0.x], g1 = __uint_as_float(se1.y) * vs[se1.x];
      const float s0 = us[se0.x], s1 = us[se1.x];
      unsigned r0 = 0, r1 = 0;
      for (int q = 0; q < 64; ++q) {
        const unsigned b0 = (unsigned)__builtin_amdgcn_readlane((int)k0, q), b1 = (unsigned)__builtin_amdgcn_readlane((int)k1, q);
        r0 += (b0 < k0) ? 1u : 0u; r0 += (b1 < k0) ? 1u : 0u;
        r1 += (b0 < k1) ? 1u : 0u; r1 += (b1 < k1) ? 1u : 0u;
      }
      lst[t * 128 + r0] = k0; lst[t * 128 + r1] = k1;
      lst[1024 + t * 128 + r0] = __float_as_uint(g0); lst[1024 + t * 128 + r1] = __float_as_uint(g1);
      lst[2048 + t * 128 + r0] = __float_as_uint(s0); lst[2048 + t * 128 + r1] = __float_as_uint(s1);
    }
    const int token = token0 + g;
    {
      u32x4 x[4][4];
#pragma unroll
      for (int b = 0; b < 4; ++b) {
        const bf16_t* xr = p.act + (size_t)token * D + b * 256 + i * 32;
#pragma unroll
        for (int q = 0; q < 4; ++q) x[b][q] = *(const u32x4*)(xr + q * 8);
      }
      constexpr int NB1 = 4;
      u32x4 pk[NB1][6];
#pragma unroll
      for (int s = 0; s < NB1; ++s) {
        const int voff = (int)((lst[g * 128 + s] >> 7) * 768u) + i * 16;
#pragma unroll
        for (int k = 0; k < 6; ++k) pk[s][k] = PIECE(U, voff, k);
      }
#define P1_BLOCK(B, W0, W1, W2, W3, W4, W5)                                                                              \
      do {                                                                                                               \
        u32x6 w6; w6[0] = (W0); w6[1] = (W1); w6[2] = (W2); w6[3] = (W3); w6[4] = (W4); w6[5] = (W5);                    \
        const u32x16 bw = __builtin_bit_cast(u32x16, __builtin_amdgcn_cvt_scalef32_pk32_bf16_fp6(w6, 1.0f));             \
        _Pragma("unroll") for (int q = 0; q < 4; ++q) {                                                                  \
          const u32x4 xv = x[B][q];                                                                                      \
          const unsigned b0 = bw[4 * q], b1 = bw[4 * q + 1], b2 = bw[4 * q + 2], b3 = bw[4 * q + 3];                     \
          const unsigned x0 = xv[0], x1 = xv[1], x2 = xv[2], x3 = xv[3];                                                 \
          d0 = dot2u(b0, x0, d0); d1 = dot2u(b1, x1, d1); d2 = dot2u(b2, x2, d2); d3 = dot2u(b3, x3, d3);                \
        }                                                                                                                \
      } while (0)
#define P1_STEP(S, J)                                                                                                    \
      do {                                                                                                               \
        const int jn = (J) + NB1 < 128 ? (J) + NB1 : 127;                                                                \
        const int voffn = (int)((lst[g * 128 + jn] >> 7) * 768u) + i * 16;                                               \
        const float su = __uint_as_float(lst[2048 + g * 128 + (J)]), gsv = __uint_as_float(lst[1024 + g * 128 + (J)]);   \
        float d0 = 0.f, d1 = 0.f, d2 = 0.f, d3 = 0.f;                                                                    \
        P1_BLOCK(0, pk[S][0][0], pk[S][0][1], pk[S][0][2], pk[S][0][3], pk[S][1][0], pk[S][1][1]);                       \
        P1_BLOCK(1, pk[S][1][2], pk[S][1][3], pk[S][2][0], pk[S][2][1], pk[S][2][2], pk[S][2][3]);                       \
        pk[S][0] = PIECE(U, voffn, 0); pk[S][1] = PIECE(U, voffn, 1); pk[S][2] = PIECE(U, voffn, 2);                     \
        __builtin_amdgcn_sched_barrier(0);                                                                               \
        P1_BLOCK(2, pk[S][3][0], pk[S][3][1], pk[S][3][2], pk[S][3][3], pk[S][4][0], pk[S][4][1]);                       \
        P1_BLOCK(3, pk[S][4][2], pk[S][4][3], pk[S][5][0], pk[S][5][1], pk[S][5][2], pk[S][5][3]);                       \
        pk[S][3] = PIECE(U, voffn, 3); pk[S][4] = PIECE(U, voffn, 4); pk[S][5] = PIECE(U, voffn, 5);                     \
        __builtin_amdgcn_sched_barrier(0);                                                                               \
        const float d = group8_sum((d0 + d1) + (d2 + d3)) * su;                                                          \
        lst[1024 + g * 128 + (J)] = __float_as_uint(gsv * gelu_as(d));                                                   \
      } while (0)
#pragma unroll 1
      for (int j = 0; j < 128; j += 4) { P1_STEP(0, j); P1_STEP(1, j + 1); P1_STEP(2, j + 2); P1_STEP(3, j + 3); }
#undef P1_STEP
#undef P1_BLOCK
    }
    const bool isctx = token < NCTX;
    const int b = isctx ? 32 : ((token - NCTX) >> 11);
    const float* g2 = modl + (size_t)b * MODW + 5 * D + i * 32;
    float* hrow = (isctx ? p.hctx + (size_t)token * D : p.out + (size_t)(token - NCTX) * D) + i * 32;
    float ss = 0.f;
#pragma unroll 1
    for (int hf = 0; hf < 2; ++hf) {
      f32x32 y0, y1;
#pragma unroll
      for (int c = 0; c < 32; ++c) { y0[c] = 0.f; y1[c] = 0.f; }
      const int hoff = hf * 384 + i * 16;
      constexpr int NB2 = 8;
      u32x4 pk[NB2][3];
#pragma unroll
      for (int s = 0; s < NB2; ++s) {
        const int voff = (int)((lst[g * 128 + s] >> 7) * 768u) + hoff;
#pragma unroll
        for (int k = 0; k < 3; ++k) pk[s][k] = PIECE(V, voff, k);
      }
#define P2_STEP(S, J)                                                                                                    \
      do {                                                                                                               \
        const int jn = (J) + NB2 < 128 ? (J) + NB2 : 127;                                                                \
        const int voffn = (int)((lst[g * 128 + jn] >> 7) * 768u) + hoff;                                                 \
        const float a = __uint_as_float(lst[1024 + g * 128 + (J)]);                                                      \
        {                                                                                                                \
          u32x6 w6; w6[0] = pk[S][0][0]; w6[1] = pk[S][0][1]; w6[2] = pk[S][0][2]; w6[3] = pk[S][0][3]; w6[4] = pk[S][1][0]; w6[5] = pk[S][1][1]; \
          const f32x32 f = __builtin_amdgcn_cvt_scalef32_pk32_f32_fp6(w6, 1.0f);                                         \
          y0 += f * a;                                                                                                   \
        }                                                                                                                \
        __builtin_amdgcn_sched_barrier(0);                                                                               \
        {                                                                                                                \
          u32x6 w6; w6[0] = pk[S][1][2]; w6[1] = pk[S][1][3]; w6[2] = pk[S][2][0]; w6[3] = pk[S][2][1]; w6[4] = pk[S][2][2]; w6[5] = pk[S][2][3]; \
          const f32x32 f = __builtin_amdgcn_cvt_scalef32_pk32_f32_fp6(w6, 1.0f);                                         \
          y1 += f * a;                                                                                                   \
        }                                                                                                                \
        pk[S][0] = PIECE(V, voffn, 0); pk[S][1] = PIECE(V, voffn, 1); pk[S][2] = PIECE(V, voffn, 2);                     \
        __builtin_amdgcn_sched_barrier(0);                                                                               \
      } while (0)
#pragma unroll 1
      for (int j = 0; j < 128; j += 8) { P2_STEP(0, j); P2_STEP(1, j + 1); P2_STEP(2, j + 2); P2_STEP(3, j + 3); P2_STEP(4, j + 4); P2_STEP(5, j + 5); P2_STEP(6, j + 6); P2_STEP(7, j + 7); }
#undef P2_STEP
#ifdef ZERO_PEER
      if (layer == ZERO_PEER) {
#pragma unroll
        for (int c = 0; c < 32; ++c) { y0[c] = 0.f; y1[c] = 0.f; }
      }
#endif
#pragma unroll
      for (int bb = 0; bb < 2; ++bb)
#pragma unroll
        for (int q4 = 0; q4 < 8; ++q4) {
          const int co = (2 * hf + bb) * 256 + q4 * 4;
          const f32x4 hv = *(const f32x4*)(hrow + co), gv = *(const f32x4*)(g2 + co);
          f32x4 o;
#pragma unroll
          for (int e = 0; e < 4; ++e) { const float yv = bb ? y1[q4 * 4 + e] : y0[q4 * 4 + e]; const float v = hv[e] + gv[e] * yv; o[e] = v; ss += v * v; }
          *(f32x4*)(hrow + co) = o;
        }
    }
    {
      ss = group8_sum(ss);
      const float rstd = rsqrtf(ss * (1.f / D) + EPS);
      if (layer == 0) {
        const float* modn = p.mod + (size_t)33 * MODW + (size_t)b * MODW + i * 32;
        const float* gain = p.mix_g + D + i * 32;
#pragma unroll 2
        for (int k = 0; k < 16; ++k) {
          const int co = (k >> 2) * 256 + (k & 3) * 8;
          u32x4 w;
#pragma unroll
          for (int q4 = 0; q4 < 2; ++q4) {
            const f32x4 hv = *(const f32x4*)(hrow + co + q4 * 4);
            const f32x4 gg = *(const f32x4*)(gain + co + q4 * 4), s0 = *(const f32x4*)(modn + co + q4 * 4), s1 = *(const f32x4*)(modn + D + co + q4 * 4);
            f32x4 yv = hv * rstd * gg;
            yv = yv * (1.f + s1) + s0;
            w[q4 * 2] = cvt_pk_bf16(yv[0], yv[1]); w[q4 * 2 + 1] = cvt_pk_bf16(yv[2], yv[3]);
          }
          *(u32x4*)(p.act + (size_t)token * D + i * 32 + co) = w;
        }
      } else {
        const float* gain = p.final_g + i * 32;
#pragma unroll 2
        for (int k = 0; k < 32; ++k) {
          const int co = (k >> 3) * 256 + (k & 7) * 4;
          const f32x4 hv = *(const f32x4*)(hrow + co), gg = *(const f32x4*)(gain + co);
          *(f32x4*)(hrow + co) = hv * rstd * gg;
        }
      }
    }
    __syncthreads();
  }
#undef PIECE
}

constexpr int NPH = 18;
template <int PH>
__device__ __forceinline__ void run_phase(const Params& p, unsigned char* smem, int bid, int nb) {
  if constexpr (PH == 0) phase_prep(p, smem, bid, nb);
  else if constexpr (PH == 1) phase_norm(p, bid, nb, 0, NTOK, p.ctx, p.x, p.mix_g, p.mod, 0, 1);
  else if constexpr (PH == 2) phase_gemm_inproj(p, smem, bid, nb, 0);
  else if constexpr (PH == 3) phase_ret_kv(p, smem, bid, nb);
  else if constexpr (PH == 4) phase_ret_scan(p, bid, nb);
  else if constexpr (PH == 5) phase_ret_out(p, smem, bid, nb);
  else if constexpr (PH == 6) phase_gemm_outproj(p, smem, bid, nb, 0);
  else if constexpr (PH == 7) phase_norm(p, bid, nb, 0, NTOK, p.hctx, p.out, p.ffn_g, p.mod, 3, 4);
  else if constexpr (PH == 8) phase_gemm_pq(p, smem, bid, nb, 0);
  else if constexpr (PH == 9) phase_peer_topk(p, smem, bid, nb, 0, 0, NTOK);
  else if constexpr (PH == 10) phase_peer_gather(p, smem, bid, nb, 0, 0, NTOK);
  else if constexpr (PH == 11) phase_gemm_inproj(p, smem, bid, nb, 1);
  else if constexpr (PH == 12) phase_attn<0>(p, smem, bid, nb, p.act);
  else if constexpr (PH == 13) phase_gemm_outproj(p, smem, bid, nb, 1);
  else if constexpr (PH == 14) phase_norm(p, bid, nb, NCTX, NTOK, p.hctx, p.out, p.ffn_g + D, p.mod + (size_t)33 * MODW, 3, 4);
  else if constexpr (PH == 15) phase_gemm_pq(p, smem, bid, nb, 1);
  else if constexpr (PH == 16) phase_peer_topk(p, smem, bid, nb, 1, NCTX, NLAT);
  else if constexpr (PH == 17) phase_peer_gather(p, smem, bid, nb, 1, NCTX, NLAT);
}
template <int PH>
__global__ void __launch_bounds__(NTHREADS) phase_k(Params p) {
  extern __shared__ __attribute__((aligned(16))) unsigned char smem[];
  run_phase<PH>(p, smem, blockIdx.x, gridDim.x);
}
#define XB_TMO      128
#define XB_XCNT(j)  (256  + 64 * (j))
#define XB_XSUB(j)  (1280 + 64 * (j))
#define XB_XGEN(j)  (2304 + 64 * (j))
#define XB_TOP      3328
#define XB_TOPGEN   3392
#define XCD_BAR_WORDS 3456
#define XB_SPIN_CAP (1u << 22)
__device__ __forceinline__ unsigned xb_ld(unsigned* p)              { return __hip_atomic_load(p, __ATOMIC_RELAXED, __HIP_MEMORY_SCOPE_AGENT); }
__device__ __forceinline__ unsigned xb_add(unsigned* p, unsigned v) { return __hip_atomic_fetch_add(p, v, __ATOMIC_RELAXED, __HIP_MEMORY_SCOPE_AGENT); }
__device__ __forceinline__ unsigned xb_xcc_id() { return (unsigned)__builtin_amdgcn_s_getreg((3 << 11) | 20) & 0xFu; }
#define XB_SPIN(cond, bar) do { unsigned _sp = 0; while (cond) { __builtin_amdgcn_s_sleep(1); \
    if ((++_sp & 255u) == 0u) { if (xb_ld(&(bar)[XB_TMO])) break; if (_sp > XB_SPIN_CAP) { atomicAdd(&(bar)[XB_TMO], 1u); break; } } } } while (0)
struct XcdBarrier { unsigned* bar; unsigned x; volatile LAS unsigned* st; };
__device__ __forceinline__ XcdBarrier xcd_barrier_post(unsigned* bar, volatile LAS unsigned* st) {
  XcdBarrier b; b.bar = bar; b.x = xb_xcc_id(); b.st = st;
  if (threadIdx.x == 0) (void)xb_add(&bar[XB_XCNT(b.x)], 1u);
  return b;
}
__device__ __forceinline__ void xcd_barrier_complete(unsigned* bar, unsigned x, unsigned& nloc, unsigned& nx) {
  const unsigned G = gridDim.x * gridDim.y * gridDim.z;
  unsigned sum, cnt, mine, sp = 0u;
  for (;;) {
    sum = 0u; cnt = 0u; mine = 0u;
#pragma unroll
    for (unsigned j = 0; j < 16; ++j) { const unsigned c = xb_ld(&bar[XB_XCNT(j)]); sum += c; cnt += (c > 0u) ? 1u : 0u; mine = (j == x) ? c : mine; }
    if (sum == G) break;
    __builtin_amdgcn_s_sleep(1);
    if ((++sp & 255u) == 0u) { if (xb_ld(&bar[XB_TMO])) break; if (sp > XB_SPIN_CAP) { atomicAdd(&bar[XB_TMO], 1u); break; } }
  }
  nloc = mine > 0u ? mine : 1u; nx = cnt > 0u ? cnt : 1u;
}
__device__ __forceinline__ void xcd_barrier(const XcdBarrier& b) {
  asm volatile("s_waitcnt vmcnt(0)" ::: "memory");
  __syncthreads();
  if (threadIdx.x == 0) {
    unsigned* bar = b.bar;
    __builtin_amdgcn_s_waitcnt(0);
    unsigned nloc = b.st[0], nx = b.st[1];
    if (nloc == 0u) { xcd_barrier_complete(bar, b.x, nloc, nx); b.st[0] = nloc; b.st[1] = nx; }
    const unsigned old = xb_add(&bar[XB_XSUB(b.x)], 1u);
    const unsigned gen = old / nloc;
    if (old + 1u == (gen + 1u) * nloc) {
      __builtin_amdgcn_fence(__ATOMIC_RELEASE, "agent");
      asm volatile("s_waitcnt vmcnt(0)" ::: "memory");
      const unsigned og = xb_add(&bar[XB_TOP], 1u);
      const unsigned tg = og / nx;
      if (og + 1u == (tg + 1u) * nx) xb_add(&bar[XB_TOPGEN], 1u);
      else XB_SPIN(xb_ld(&bar[XB_TOPGEN]) == tg, bar);
      __builtin_amdgcn_fence(__ATOMIC_ACQUIRE, "agent");
      xb_add(&bar[XB_XGEN(b.x)], 1u);
      asm volatile("s_waitcnt vmcnt(0)" ::: "memory");
    } else {
      XB_SPIN(xb_ld(&bar[XB_XGEN(b.x)]) == gen, bar);
      __builtin_amdgcn_fence(__ATOMIC_ACQUIRE, "agent");
      asm volatile("s_waitcnt vmcnt(0)" ::: "memory");
    }
  }
  __syncthreads();
}

#if MK_ONE_LAUNCH
constexpr int PARAMS_OFF = LDS_BYTES - 512;
static_assert(sizeof(Params) <= 480, "params block");
template <class T>
__device__ __forceinline__ T* uni(T* q) {
  const unsigned long long v = (unsigned long long)q;
  const unsigned lo = __builtin_amdgcn_readfirstlane((unsigned)v), hi = __builtin_amdgcn_readfirstlane((unsigned)(v >> 32));
  return (T*)(((unsigned long long)hi << 32) | lo);
}
__device__ __forceinline__ Params load_params(const unsigned char* smem) {
  const Params* l = (const Params*)(smem + PARAMS_OFF);
  Params q;
  q.x = uni(l->x); q.c = uni(l->c); q.ctx = uni(l->ctx); q.c_ctx = uni(l->c_ctx); q.ada_w = uni(l->ada_w); q.ada_b = uni(l->ada_b);
  q.mix_g = uni(l->mix_g); q.ffn_g = uni(l->ffn_g); q.ev_w_in = uni(l->ev_w_in); q.ev_w_out = uni(l->ev_w_out);
  q.logit_f = uni(l->logit_f); q.logit_b = uni(l->logit_b); q.conv_w = uni(l->conv_w); q.od_w_in = uni(l->od_w_in);
  q.od_w_out = uni(l->od_w_out); q.sinks = uni(l->sinks); q.peer_wq = uni(l->peer_wq); q.keys1 = uni(l->keys1); q.keys2 = uni(l->keys2);
  q.peer_u = uni(l->peer_u); q.peer_v = uni(l->peer_v); q.final_g = uni(l->final_g); q.out = uni(l->out); q.mod = uni(l->mod);
  q.ropec = uni(l->ropec); q.ropes = uni(l->ropes); q.winT0 = uni(l->winT0); q.woutT0 = uni(l->woutT0); q.winT1 = uni(l->winT1);
  q.woutT1 = uni(l->woutT1); q.wqT = uni(l->wqT); q.u8 = uni(l->u8); q.v8 = uni(l->v8); q.uscale = uni(l->uscale); q.vscale = uni(l->vscale); q.hctx = uni(l->hctx); q.act = uni(l->act);
  q.proj = uni(l->proj); q.pq = uni(l->pq); q.sel = uni(l->sel); q.kv = uni(l->kv); q.sprev = uni(l->sprev); q.bar = uni(l->bar); q.keysb = uni(l->keysb);
  return q;
}
template <int PH>
__device__ __forceinline__ void run_from(unsigned char* smem, int bid, int nb, const XcdBarrier& xb) {
  {
    const Params q = load_params(smem);
    run_phase<PH>(q, smem, bid, nb);
  }
#ifdef DUP_PH
  if constexpr (PH == DUP_PH) {
    xcd_barrier(xb);
    const Params q = load_params(smem);
#ifdef DUP_ATTN_VAR
    phase_attn<DUP_ATTN_VAR>(q, smem, bid, nb, q.proj + (size_t)113246208);
#else
    run_phase<PH>(q, smem, bid, nb);
#endif
  }
#endif
  if constexpr (PH + 1 < NPH) {
    if constexpr (PH == 0) cg::this_grid().sync();
    else xcd_barrier(xb);
    run_from<PH + 1>(smem, bid, nb, xb);
  }
}
__global__ void __launch_bounds__(NTHREADS) mega(Params p) {
  extern __shared__ __attribute__((aligned(16))) unsigned char smem[];
  volatile LAS unsigned* st = (volatile LAS unsigned*)((LAS unsigned char*)smem + PARAMS_OFF + 480);
  if (threadIdx.x == 0) { *(Params*)(smem + PARAMS_OFF) = p; st[0] = 0u; st[1] = 0u; }
  __syncthreads();
  const XcdBarrier xb = xcd_barrier_post(p.bar, st);
  run_from<0>(smem, blockIdx.x, gridDim.x, xb);
}
#endif
#ifndef DBG_NPH
#define DBG_NPH 0
#endif
#if DBG_NPH
__global__ void __launch_bounds__(NTHREADS) dbg_sums(Params p, float* scr, int nph) {
  const int wid = threadIdx.x >> 6, lane = threadIdx.x & 63;
  const int gw = blockIdx.x * 8 + wid, nw = gridDim.x * 8;
  if (nph >= 2) for (int r = gw; r < NTOK; r += nw) { float s = 0.f; for (int c = lane; c < D; c += 64) s += bf2f(p.act[(size_t)r * D + c]) * (1 + (c & 7)); s = wave_sum(s); if (lane == 0) scr[r] = s; }
  if (nph >= 3 && nph <= 8) for (int r = gw; r < NTOK; r += nw) { float s = 0.f; for (int c = lane; c < 3072; c += 64) s += bf2f(p.proj[(size_t)r * 3072 + c]) * (1 + (c & 7)); s = wave_sum(s); if (lane == 0) scr[(1 << 20) + r] = s; }
  if (nph >= 12 && nph <= 15) for (int r = gw; r < NTOK; r += nw) { float s = 0.f; for (int c = lane + (r < NCTX ? 1024 : 0); c < 1536; c += 64) s += bf2f(p.proj[(size_t)r * 1536 + c]) * (1 + (c & 7)); s = wave_sum(s); if (lane == 0) scr[(1 << 20) + r] = s; }
  if (nph >= 4) for (int r = gw; r < 2304 * 128; r += nw) { float s = 0.f; for (int c = lane; c < 128; c += 64) s += p.kv[(size_t)r * 128 + c] * (1 + (c & 7)); s = wave_sum(s); if (lane == 0) scr[(2 << 20) + r] = s; }
  if (nph >= 5) for (int r = gw; r < 2304 * 128; r += nw) { float s = 0.f; for (int c = lane; c < 128; c += 64) s += bf2f(p.sprev[(size_t)r * 128 + c]) * (1 + (c & 7)); s = wave_sum(s); if (lane == 0) scr[(3 << 20) + r] = s; }
  if (nph >= 7) for (int r = gw; r < NCTX; r += nw) { float s = 0.f; for (int c = lane; c < D; c += 64) s += p.hctx[(size_t)r * D + c] * (1 + (c & 7)); s = wave_sum(s); if (lane == 0) scr[(4 << 20) + r] = s; }
  if (nph >= 1) for (int i = blockIdx.x * NTHREADS + threadIdx.x; i < 2 * 33 * MODW; i += gridDim.x * NTHREADS) scr[(5 << 20) + i] = p.mod[i];
  if (nph >= 7) for (int r = gw; r < NLAT; r += nw) { float s = 0.f; for (int c = lane; c < D; c += 64) s += p.out[(size_t)r * D + c] * (1 + (c & 7)); s = wave_sum(s); if (lane == 0) scr[(6 << 20) + r] = s; }
  if (nph >= 10 && nph <= 11) for (int r = gw; r < NTOK; r += nw) { float s = 0.f; for (int c = lane; c < 128; c += 64) { const u32x2 e = p.sel[(size_t)r * 128 + c]; s += __uint_as_float(e.y) * (float)(e.x & 1023); } s = wave_sum(s); if (lane == 0) scr[(7 << 20) + r] = s; }
}
__global__ void __launch_bounds__(NTHREADS) dbg_out(Params p, const float* scr) {
  for (size_t i = (size_t)blockIdx.x * NTHREADS + threadIdx.x; i < (size_t)NLAT * D; i += (size_t)gridDim.x * NTHREADS) p.out[i] = (i < (size_t)(8 << 20)) ? scr[i] : 0.f;
}
__global__ void __launch_bounds__(NTHREADS) dbg_zero(float* scr) {
  for (size_t i = (size_t)blockIdx.x * NTHREADS + threadIdx.x; i < (size_t)(8 << 20); i += (size_t)gridDim.x * NTHREADS) scr[i] = 0.f;
}
#endif
template <int PH>
static void launch_phases(const Params& p, int grid, hipStream_t stream) {
  static bool attr_set = false;
  if (!attr_set) { (void)hipFuncSetAttribute((const void*)phase_k<PH>, hipFuncAttributeMaxDynamicSharedMemorySize, LDS_BYTES); attr_set = true; }
  phase_k<PH><<<grid, NTHREADS, LDS_BYTES, stream>>>(p);
  if constexpr (PH + 1 < (DBG_NPH ? DBG_NPH : NPH)) launch_phases<PH + 1>(p, grid, stream);
}

extern "C" void kernel_launch(void* const* d_in, const int* in_sizes, int n_in, void* d_out, int out_size, void* d_ws,
                              size_t ws_size, hipStream_t stream) {
  Params p{};
  const float* const* in = (const float* const*)d_in;
  p.x = in[0]; p.c = in[1]; p.ctx = in[2]; p.c_ctx = in[3]; p.ada_w = in[4]; p.ada_b = in[5]; p.mix_g = in[6]; p.ffn_g = in[7];
  p.ev_w_in = in[8]; p.ev_w_out = in[9]; p.logit_f = in[10]; p.logit_b = in[11]; p.conv_w = in[12]; p.od_w_in = in[13];
  p.od_w_out = in[14]; p.sinks = in[15]; p.peer_wq = in[16]; p.keys1 = in[17]; p.keys2 = in[18]; p.peer_u = in[19];
  p.peer_v = in[20]; p.final_g = in[21];
  p.out = (float*)d_out;
  unsigned char* w = (unsigned char*)d_ws;
  size_t off = 0;
  auto take = [&](size_t bytes) { unsigned char* r = w + off; off += (bytes + 255) & ~(size_t)255; return r; };
  p.mod = (float*)take((size_t)2 * 33 * MODW * 4);
  p.ropec = (float*)take(1024 * 4);
  p.ropes = (float*)take(1024 * 4);
  p.winT0 = (bf16_t*)take((size_t)3072 * 1024 * 2);
  p.woutT0 = (bf16_t*)take((size_t)1024 * 1024 * 2);
  p.winT1 = (bf16_t*)take((size_t)1536 * 1024 * 2);
  p.woutT1 = (bf16_t*)take((size_t)1024 * 1024 * 2);
  p.wqT = (bf16_t*)take((size_t)2 * 1024 * 1024 * 2);
  p.u8 = (unsigned char*)take((size_t)2 * NEXP * 768);
  p.v8 = (unsigned char*)take((size_t)2 * NEXP * 768);
  p.uscale = (float*)take((size_t)2 * NEXP * 4);
  p.vscale = (float*)take((size_t)2 * NEXP * 4);
  p.hctx = (float*)take((size_t)NCTX * D * 4);
  p.act = (bf16_t*)take((size_t)NTOK * D * 2);
  p.kv = (float*)take((size_t)2304 * 16384 * 4);
  p.sprev = (bf16_t*)take((size_t)2304 * 16384 * 2);
  p.bar = (unsigned*)take((size_t)XCD_BAR_WORDS * 4);
  p.keysb = (bf16_t*)take((size_t)2 * 8 * 2 * 2 * 128 * 64 * 2);
  p.proj = (bf16_t*)take((size_t)NTOK * 3072 * 2);
  p.pq = p.proj;
  p.sel = (u32x2*)((unsigned char*)p.proj + (size_t)NTOK * D * 2);
  if (off > ws_size) { fprintf(stderr, "workspace too small: need %zu have %zu\n", off, ws_size); }

  int grid = 256;
#if MK_ONE_LAUNCH
  static int grid_blocks = 0;
  if (!grid_blocks) {
    (void)hipFuncSetAttribute((const void*)mega, hipFuncAttributeMaxDynamicSharedMemorySize, LDS_BYTES);
    int dev = 0, cus = 0, per_cu = 0;
    (void)hipGetDevice(&dev);
    (void)hipDeviceGetAttribute(&cus, hipDeviceAttributeMultiprocessorCount, dev);
    (void)hipOccupancyMaxActiveBlocksPerMultiprocessor(&per_cu, mega, NTHREADS, LDS_BYTES);
    if (per_cu > 1) per_cu = 1;
    grid_blocks = cus * per_cu;
    if (grid_blocks <= 0) grid_blocks = 256;
  }
  grid = grid_blocks;
  (void)hipMemsetAsync(p.bar, 0, (size_t)XCD_BAR_WORDS * 4, stream);
  void* args[] = {&p};
  hipError_t e = hipLaunchCooperativeKernel((const void*)mega, dim3(grid), dim3(NTHREADS), args, LDS_BYTES, stream);
  if (e != hipSuccess) fprintf(stderr, "cooperative launch failed: %s\n", hipGetErrorString(e));
#else
  launch_phases<0>(p, grid, stream);
#if DBG_NPH
  float* scr = (float*)(w + off);
  dbg_zero<<<grid, NTHREADS, 0, stream>>>(scr);
  dbg_sums<<<grid, NTHREADS, 0, stream>>>(p, scr, DBG_NPH);
  dbg_out<<<grid, NTHREADS, 0, stream>>>(p, scr);
#endif
#endif
}
```

```cpp
#include <hip/hip_runtime.h>
#include <hip/hip_cooperative_groups.h>
#include <cstdio>
#include <cstdint>
namespace cg = cooperative_groups;

#ifndef MK_ONE_LAUNCH
#define MK_ONE_LAUNCH 1
#endif

typedef unsigned short bf16_t;
typedef short bf16x8 __attribute__((ext_vector_type(8)));
typedef short bf16x2v __attribute__((ext_vector_type(2)));
typedef float f32x4 __attribute__((ext_vector_type(4)));
typedef unsigned u32x4 __attribute__((ext_vector_type(4)));
typedef unsigned u32x2 __attribute__((ext_vector_type(2)));
typedef unsigned u32x6 __attribute__((ext_vector_type(6)));
typedef unsigned u32x16 __attribute__((ext_vector_type(16)));
typedef float f32x32 __attribute__((ext_vector_type(32)));
typedef __bf16 bf16x32n __attribute__((ext_vector_type(32)));

constexpr int D = 1024, BATCH = 32, SEQ = 2048, CTXL = 256;
constexpr int NCTX = BATCH * CTXL;
constexpr int NLAT = BATCH * SEQ;
constexpr int NTOK = NCTX + NLAT;
constexpr int MODW = 6 * D;
constexpr int NEXP = 16384;
constexpr float EPS = 1e-6f;
constexpr int NTHREADS = 512;
constexpr int LDS_BYTES = 140 * 1024;

struct Params {
  const float *x, *c, *ctx, *c_ctx, *ada_w, *ada_b, *mix_g, *ffn_g, *ev_w_in, *ev_w_out, *logit_f, *logit_b, *conv_w,
      *od_w_in, *od_w_out, *sinks, *peer_wq, *keys1, *keys2, *peer_u, *peer_v, *final_g;
  float* out;
  float* mod;
  float* ropec;
  float* ropes;
  bf16_t* winT0;
  bf16_t* woutT0;
  bf16_t* winT1;
  bf16_t* woutT1;
  bf16_t* wqT;
  unsigned char* u8;
  unsigned char* v8;
  float* uscale;
  float* vscale;
  float* hctx;
  bf16_t* act;
  bf16_t* proj;
  bf16_t* pq;
  u32x2* sel;
  float* kv;
  bf16_t* sprev;
  bf16_t* keysb;
  unsigned* bar;
};

typedef __bf16 bf16x2n __attribute__((ext_vector_type(2)));
typedef float f32x2 __attribute__((ext_vector_type(2)));
__device__ __forceinline__ unsigned cvt_pk_bf16(float lo, float hi) {
  f32x2 v = {lo, hi};
  return __builtin_bit_cast(unsigned, __builtin_convertvector(v, bf16x2n));
}
__device__ __forceinline__ float bf_lo(unsigned u) { return __uint_as_float(u << 16); }
__device__ __forceinline__ float bf_hi(unsigned u) { return __uint_as_float(u & 0xffff0000u); }
__device__ __forceinline__ float bf2f(bf16_t h) { return __uint_as_float(((unsigned)h) << 16); }
__device__ __forceinline__ bf16_t f2bf(float f) { return __builtin_bit_cast(unsigned short, (__bf16)f); }

template <int CTRL>
__device__ __forceinline__ float dppf(float x) {
  return __builtin_bit_cast(float, __builtin_amdgcn_mov_dpp(__builtin_bit_cast(int, x), CTRL, 0xf, 0xf, true));
}
__device__ __forceinline__ float row16_sum(float x) {
  x += dppf<0xB1>(x); x += dppf<0x4E>(x); x += dppf<0x141>(x); x += dppf<0x128>(x);
  return x;
}
__device__ __forceinline__ float row16_max(float x) {
  x = fmaxf(x, dppf<0xB1>(x)); x = fmaxf(x, dppf<0x4E>(x)); x = fmaxf(x, dppf<0x141>(x)); x = fmaxf(x, dppf<0x128>(x));
  return x;
}
__device__ __forceinline__ float xrow16_sum(float x) {
  auto s = __builtin_amdgcn_permlane16_swap(__float_as_uint(x), __float_as_uint(x), false, false);
  x = __uint_as_float(s[0]) + __uint_as_float(s[1]);
  auto t = __builtin_amdgcn_permlane32_swap(__float_as_uint(x), __float_as_uint(x), false, false);
  return __uint_as_float(t[0]) + __uint_as_float(t[1]);
}
__device__ __forceinline__ float wave_sum(float x) { return xrow16_sum(row16_sum(x)); }
__device__ __forceinline__ float wave_max(float x) {
  x = row16_max(x);
  auto s = __builtin_amdgcn_permlane16_swap(__float_as_uint(x), __float_as_uint(x), false, false);
  x = fmaxf(__uint_as_float(s[0]), __uint_as_float(s[1]));
  auto t = __builtin_amdgcn_permlane32_swap(__float_as_uint(x), __float_as_uint(x), false, false);
  return fmaxf(__uint_as_float(t[0]), __uint_as_float(t[1]));
}

__device__ __forceinline__ int tidx() {
  int t = threadIdx.x;
  asm volatile("" : "+v"(t));
  __builtin_assume(t >= 0 && t < NTHREADS);
  return t;
}
__device__ __forceinline__ float siluf(float v) { return v / (1.f + __expf(-v)); }
__device__ __forceinline__ float log_sigmoidf(float v) { return -log1pf(expf(-v)); }

#define LAS __attribute__((address_space(3)))
constexpr int BM = 256, BK = 64, HALF = 128, HTB = HALF * BK * 2, NXCD = 8, WGM = 8;
constexpr int KDIM = 1024;

__device__ __forceinline__ int lds_byte(int r, int c) {
  const int st = (r >> 4) * 2 + (c >> 5), rr = r & 15, cc = c & 31, ob = rr * 64 + cc * 2;
  return st * 1024 + (ob ^ (((ob >> 9) & 1) << 5));
}
__device__ __forceinline__ void stage_rc(int b, int& R, int& C) {
  const int st = b / 1024, sb = b % 1024, swz = sb ^ (((sb >> 9) & 1) << 5);
  R = (st >> 1) * 16 + swz / 64;
  C = (st & 1) * 32 + (swz % 64) / 2;
}
__device__ __forceinline__ int perm32(int rho) { const int n = rho >> 4, i = rho & 15; return 8 * (i >> 2) + 4 * n + (i & 3); }
struct Sched {
  int pm0, pn0, nM, nN, G, c;
  __device__ __forceinline__ bool next(int i, int& pm, int& pn) const {
    const int nwg = nM * nN;
    const long L = (long)i * G + c;
    if (L >= nwg) return false;
    int wgid = (int)L;
    { const int q = nwg / NXCD, r = nwg % NXCD, xcd = wgid % NXCD, off = wgid / NXCD; wgid = (xcd < r ? xcd * (q + 1) : r * (q + 1) + (xcd - r) * q) + off; }
    const int nig = WGM * nN, gid = wgid / nig, fm = gid * WGM, gsz = (nM - fm) < WGM ? (nM - fm) : WGM;
    pm = pm0 + fm + ((wgid % nig) % gsz);
    pn = pn0 + (wgid % nig) / gsz;
    return true;
  }
};

template <class Epi>
__device__ __forceinline__ void gemm_phase(LAS unsigned char* lds, const bf16_t* __restrict__ Ag, const bf16_t* __restrict__ Btg, const Sched& S, const Epi& E) {
  const int tid = tidx(), wid = __builtin_amdgcn_readfirstlane(tid >> 6), lane = tid & 63, wr = wid >> 2, wc = wid & 3, fr = lane & 15, fq = lane >> 4;
  constexpr int K = KDIM, nt = K / BK;
  unsigned voffA[2], voffB[2];
#pragma unroll
  for (int i = 0; i < 2; ++i) { int R, C; stage_rc(tid * 16 + i * 8192, R, C); const int Rb = Epi::PERM ? ((R & ~31) + perm32(R & 31)) : R;
    voffA[i] = (unsigned)(R * K + C) * 2u; voffB[i] = (unsigned)(Rb * K + C) * 2u; }
  const size_t kstep = (size_t)(BK * 2);
  const size_t hstep = (size_t)HALF * K * 2;
  const size_t tstep = 2 * hstep;
  const unsigned ldsw = (unsigned)wid * 1024u;
  const int aoff = lds_byte(wr * 64 + fr, fq * 8), boff = lds_byte(wc * 32 + fr, fq * 8);
#define G_SA(b, h) (((b) * 2 + (h)) * HTB)
#define G_SB(b, h) ((4 + (b) * 2 + (h)) * HTB)
#define G_STAGEX(bufoff, gbase, VO) do { _Pragma("unroll") for (int _i = 0; _i < 2; ++_i) \
    __builtin_amdgcn_global_load_lds((const unsigned*)((const char*)(gbase) + VO[_i]), (LAS unsigned*)(lds + (bufoff) + ldsw + _i * 8192), 16, 0, 0); } while (0)
#define G_STAGE(bufoff, gbase) G_STAGEX(bufoff, gbase, voffA)
#define G_STAGEB(bufoff, gbase) G_STAGEX(bufoff, gbase, voffB)
#define G_LDA(dst, b, h) do { _Pragma("unroll") for (int m = 0; m < 4; ++m) _Pragma("unroll") for (int k = 0; k < 2; ++k) dst[m][k] = *(const LAS bf16x8*)(lds + G_SA(b, h) + aoff + m * 2048 + k * 1024); } while (0)
#define G_LDB(dst, b, h) do { _Pragma("unroll") for (int n = 0; n < 2; ++n) _Pragma("unroll") for (int k = 0; k < 2; ++k) dst[n][k] = *(const LAS bf16x8*)(lds + G_SB(b, h) + boff + n * 2048 + k * 1024); } while (0)
#define G_MMA(ai, bj, At, Bt) do { __builtin_amdgcn_s_setprio(1); _Pragma("unroll") for (int m = 0; m < 4; ++m) _Pragma("unroll") for (int n = 0; n < 2; ++n) _Pragma("unroll") for (int k = 0; k < 2; ++k) \
    acc[ai][bj][m][n] = __builtin_amdgcn_mfma_f32_16x16x32_bf16(Bt[n][k], At[m][k], acc[ai][bj][m][n], 0, 0, 0); __builtin_amdgcn_s_setprio(0); } while (0)
#define G_WAIT_V(n) asm volatile("s_waitcnt vmcnt(" #n ")" ::: "memory")
#define G_WAIT_L(n) asm volatile("s_waitcnt lgkmcnt(" #n ")" ::: "memory")
#define G_BAR __builtin_amdgcn_s_barrier()
#define G_SCHED __builtin_amdgcn_sched_barrier(0)
  int cpm, cpn, npm, npn, ui = 0;
  if (!S.next(0, cpm, cpn)) return;
  f32x4 acc[2][2][4][2];
#pragma unroll
  for (int a = 0; a < 2; ++a)
#pragma unroll
    for (int b = 0; b < 2; ++b)
#pragma unroll
      for (int m = 0; m < 4; ++m)
#pragma unroll
        for (int n = 0; n < 2; ++n) acc[a][b][m][n] = (f32x4){0.f, 0.f, 0.f, 0.f};
  bf16x8 At[4][2], B0[2][2], B1[2][2];
  const char* cA = (const char*)Ag + (size_t)cpm * tstep;
  const char* cB = (const char*)Btg + (size_t)cpn * tstep;
  G_STAGEB(G_SB(0, 0), cB); G_STAGE(G_SA(0, 0), cA); G_STAGEB(G_SB(0, 1), cB + hstep); G_STAGE(G_SA(0, 1), cA + hstep);
  if (wr == 1) G_BAR;
  G_WAIT_V(4); G_BAR;
  G_STAGEB(G_SB(1, 0), cB + kstep); G_STAGE(G_SA(1, 0), cA + kstep); G_STAGEB(G_SB(1, 1), cB + hstep + kstep);
  G_WAIT_V(6); G_BAR;
  for (;;) {
    const bool has_next = S.next(ui + 1, npm, npn);
    const char* nA = has_next ? (const char*)Ag + (size_t)npm * tstep : cA;
    const char* nB = has_next ? (const char*)Btg + (size_t)npn * tstep : cB;
    for (int t = 0; t < nt; t += 2) {
      const bool last = (t == nt - 2);
      const char* a1 = cA + (size_t)(t + 1) * kstep;
      const char* a2 = last ? nA : cA + (size_t)(t + 2) * kstep;
      const char* b2 = last ? nB : cB + (size_t)(t + 2) * kstep;
      const char* a3 = a2 + kstep;
      const char* b3 = b2 + kstep;
      G_LDB(B0, 0, 0); G_SCHED; G_LDA(At, 0, 0); G_STAGE(G_SA(1, 1), a1 + hstep);
      G_WAIT_L(8); G_BAR; G_WAIT_L(0); G_MMA(0, 0, At, B0); G_BAR; G_SCHED;
      G_LDB(B1, 0, 1); G_STAGEB(G_SB(0, 0), b2);
      G_BAR; G_WAIT_L(0); G_MMA(0, 1, At, B1); G_BAR;
      G_LDA(At, 0, 1); G_STAGE(G_SA(0, 0), a2);
      G_BAR; G_WAIT_L(0); G_MMA(1, 0, At, B0); G_BAR; G_SCHED;
      G_STAGEB(G_SB(0, 1), b2 + hstep);
      G_WAIT_V(6); G_BAR; G_MMA(1, 1, At, B1); G_BAR;
      G_LDB(B0, 1, 0); G_SCHED; G_LDA(At, 1, 0); G_STAGE(G_SA(0, 1), a2 + hstep);
      G_WAIT_L(8); G_BAR; G_WAIT_L(0); G_MMA(0, 0, At, B0); G_BAR; G_SCHED;
      G_LDB(B1, 1, 1); G_STAGEB(G_SB(1, 0), b3);
      G_BAR; G_WAIT_L(0); G_MMA(0, 1, At, B1); G_BAR;
      G_LDA(At, 1, 1); G_STAGE(G_SA(1, 0), a3);
      G_BAR; G_WAIT_L(0); G_MMA(1, 0, At, B0); G_BAR; G_SCHED;
      G_STAGEB(G_SB(1, 1), b3 + hstep);
      G_WAIT_V(6); G_BAR; G_MMA(1, 1, At, B1); G_BAR;
    }
    E(acc, cpm * BM, cpn * BM, wr, wc, fr, fq);
    if (!has_next) break;
#pragma unroll
    for (int a = 0; a < 2; ++a)
#pragma unroll
      for (int b = 0; b < 2; ++b)
#pragma unroll
        for (int m = 0; m < 4; ++m)
#pragma unroll
          for (int n = 0; n < 2; ++n) acc[a][b][m][n] = (f32x4){0.f, 0.f, 0.f, 0.f};
    cpm = npm; cpn = npn; cA = nA; cB = nB; ++ui;
  }
  G_WAIT_V(0);
  if (wr == 0) G_BAR;
  G_BAR;
#undef G_SA
#undef G_SB
#undef G_STAGE
#undef G_STAGEB
#undef G_STAGEX
#undef G_LDA
#undef G_LDB
#undef G_MMA
}

__device__ __forceinline__ f32x4 xlane32(const f32x4 v, const bool upper) {
  f32x4 r;
#pragma unroll
  for (int j = 0; j < 4; ++j) {
    const float x = v[j];
    auto t = __builtin_amdgcn_permlane32_swap(__float_as_uint(x), __float_as_uint(x), false, false);
    r[j] = __uint_as_float(upper ? t[0] : t[1]);
  }
  return r;
}
struct EpiInProj {
  static constexpr bool PERM = true;
  bf16_t* P; int ldc; int layer; const float* cosT; const float* sinT;
  __device__ __forceinline__ void operator()(const f32x4 (&acc)[2][2][4][2], int brow, int bcol, int wr, int wc, int fr, int fq) const {
#pragma unroll
    for (int bj = 0; bj < 2; ++bj) {
      const int colbase = bcol + bj * HALF + wc * 32;
      bool rope, scl;
      if (layer == 0) { rope = colbase < 512; scl = (colbase >= 256 && colbase < 512); }
      else { rope = colbase < 1280; scl = colbase < 1024; }
      const float sq = layer == 1 ? 0.125f * 1.44269504089f : 0.125f;
#pragma unroll
      for (int ai = 0; ai < 2; ++ai)
#pragma unroll
        for (int m = 0; m < 4; ++m) {
          const int row = brow + ai * HALF + wr * 64 + m * 16 + fr;
          f32x4 v0 = acc[ai][bj][m][0], v1 = acc[ai][bj][m][1];
          if (rope && brow >= NCTX) {
            const bool upper = fq >= 2;
            const f32x4 o0 = xlane32(v0, upper), o1 = xlane32(v1, upper);
            const int t = (row - NCTX) & (SEQ - 1);
            const int pos = (wc & 1) ? (t & 63) : (t >> 6);
            const float* ct = cosT + pos * 16 + (fq & 1) * 8;
            const float* st = sinT + pos * 16 + (fq & 1) * 8;
            const f32x4 c0 = *(const f32x4*)ct, c1 = *(const f32x4*)(ct + 4);
            f32x4 s0 = *(const f32x4*)st, s1 = *(const f32x4*)(st + 4);
            if (!upper) { s0 = -s0; s1 = -s1; }
            v0 = v0 * c0 + o0 * s0;
            v1 = v1 * c1 + o1 * s1;
          }
          if (scl) { v0 *= sq; v1 *= sq; }
          u32x4 w;
          w.x = cvt_pk_bf16(v0[0], v0[1]); w.y = cvt_pk_bf16(v0[2], v0[3]);
          w.z = cvt_pk_bf16(v1[0], v1[1]); w.w = cvt_pk_bf16(v1[2], v1[3]);
          *(u32x4*)(P + (size_t)row * ldc + colbase + fq * 8) = w;
        }
    }
  }
};
struct EpiBf16 {
  static constexpr bool PERM = true;
  bf16_t* P; int ldc;
  __device__ __forceinline__ void operator()(const f32x4 (&acc)[2][2][4][2], int brow, int bcol, int wr, int wc, int fr, int fq) const {
#pragma unroll
    for (int ai = 0; ai < 2; ++ai)
#pragma unroll
      for (int m = 0; m < 4; ++m) {
        const int row = brow + ai * HALF + wr * 64 + m * 16 + fr;
#pragma unroll
        for (int bj = 0; bj < 2; ++bj) {
          const f32x4 v0 = acc[ai][bj][m][0], v1 = acc[ai][bj][m][1];
          u32x4 w;
          w.x = cvt_pk_bf16(v0[0], v0[1]); w.y = cvt_pk_bf16(v0[2], v0[3]);
          w.z = cvt_pk_bf16(v1[0], v1[1]); w.w = cvt_pk_bf16(v1[2], v1[3]);
          *(u32x4*)(P + (size_t)row * ldc + bcol + bj * HALF + wc * 32 + fq * 8) = w;
        }
      }
  }
};
struct EpiGate {
  static constexpr bool PERM = true;
  bf16_t* M; const float* gate;
  __device__ __forceinline__ void operator()(const f32x4 (&acc)[2][2][4][2], int brow, int bcol, int wr, int wc, int fr, int fq) const {
    const int b = brow < NCTX ? 32 : ((brow - NCTX) >> 11);
    const float* g = gate + (size_t)b * MODW;
#pragma unroll
    for (int bj = 0; bj < 2; ++bj) {
      const int col = bcol + bj * HALF + wc * 32 + fq * 8;
      const f32x4 g0 = *(const f32x4*)(g + col), g1 = *(const f32x4*)(g + col + 4);
#pragma unroll
      for (int ai = 0; ai < 2; ++ai)
#pragma unroll
        for (int m = 0; m < 4; ++m) {
          const int row = brow + ai * HALF + wr * 64 + m * 16 + fr;
          const f32x4 v0 = acc[ai][bj][m][0] * g0, v1 = acc[ai][bj][m][1] * g1;
          u32x4 w;
          w.x = cvt_pk_bf16(v0[0], v0[1]); w.y = cvt_pk_bf16(v0[2], v0[3]);
          w.z = cvt_pk_bf16(v1[0], v1[1]); w.w = cvt_pk_bf16(v1[2], v1[3]);
          *(u32x4*)(M + (size_t)row * D + col) = w;
        }
    }
  }
};
struct EpiResid {
  static constexpr bool PERM = false;
  const float* hin_ctx; const float* hin_lat; float* hout_ctx; float* hout_lat; const float* gate;
  __device__ __forceinline__ void operator()(const f32x4 (&acc)[2][2][4][2], int brow, int bcol, int wr, int wc, int fr, int fq) const {
    const bool isctx = brow < NCTX;
    const int b = isctx ? 32 : ((brow - NCTX) >> 11);
    const float* hin = isctx ? hin_ctx + (size_t)brow * D : hin_lat + (size_t)(brow - NCTX) * D;
    float* hout = isctx ? hout_ctx + (size_t)brow * D : hout_lat + (size_t)(brow - NCTX) * D;
    const float* g = gate + (size_t)b * MODW;
#pragma unroll
    for (int bj = 0; bj < 2; ++bj)
#pragma unroll
      for (int n = 0; n < 2; ++n) {
        const int col = bcol + bj * HALF + wc * 32 + n * 16 + fq * 4;
        const f32x4 gv = *(const f32x4*)(g + col);
#pragma unroll
        for (int ai = 0; ai < 2; ++ai)
#pragma unroll
          for (int m = 0; m < 4; ++m) {
            const int r = ai * HALF + wr * 64 + m * 16 + fr;
            const f32x4 h = *(const f32x4*)(hin + (size_t)r * D + col);
            *(f32x4*)(hout + (size_t)r * D + col) = h + gv * acc[ai][bj][m][n];
          }
      }
  }
};

template <int MT, int NT>
__device__ __forceinline__ void mm_lds(const bf16_t* A, int lda, const bf16_t* B, int ldb, int K, f32x4 (&acc)[MT][NT], int fr, int fq) {
  for (int k0 = 0; k0 < K; k0 += 32) {
    bf16x8 af[MT], bf[NT];
#pragma unroll
    for (int m = 0; m < MT; ++m) af[m] = *(const bf16x8*)(A + (m * 16 + fr) * lda + k0 + fq * 8);
#pragma unroll
    for (int n = 0; n < NT; ++n) bf[n] = *(const bf16x8*)(B + (n * 16 + fr) * ldb + k0 + fq * 8);
#pragma unroll
    for (int m = 0; m < MT; ++m)
#pragma unroll
      for (int n = 0; n < NT; ++n) acc[m][n] = __builtin_amdgcn_mfma_f32_16x16x32_bf16(af[m], bf[n], acc[m][n], 0, 0, 0);
  }
}

__device__ void phase_prep(const Params& p, unsigned char* smem, int bid, int nb) {
  const int tid = tidx();
  for (int it = bid; it < 2 * 96; it += nb) {
    const int layer = it / 96, n0 = (it % 96) * 64;
    float* s = (float*)smem;
    for (int i = tid; i < 33 * 1024; i += NTHREADS) {
      const int b = i >> 10, k = i & 1023;
      const float v = (b < 32) ? p.c[b * 1024 + k] : p.c_ctx[k];
      s[k * 33 + b] = siluf(v);
    }
    __syncthreads();
    const int col = tid & 63, kg = tid >> 6;
    float acc[33];
#pragma unroll
    for (int b = 0; b < 33; ++b) acc[b] = 0.f;
    const float* W = p.ada_w + (size_t)layer * 1024 * MODW + n0 + col;
    for (int k = kg * 128; k < kg * 128 + 128; ++k) {
      const float w = W[(size_t)k * MODW];
      const float* sk = s + k * 33;
#pragma unroll
      for (int b = 0; b < 33; ++b) acc[b] += sk[b] * w;
    }
    __syncthreads();
    float* red = (float*)smem;
#pragma unroll
    for (int b = 0; b < 33; ++b) red[(kg * 33 + b) * 64 + col] = acc[b];
    __syncthreads();
    for (int i = tid; i < 33 * 64; i += NTHREADS) {
      const int b = i >> 6, cc = i & 63;
      float t = p.ada_b[layer * MODW + n0 + cc];
#pragma unroll
      for (int g = 0; g < 8; ++g) t += red[(g * 33 + b) * 64 + cc];
      p.mod[((size_t)layer * 33 + b) * MODW + n0 + cc] = t;
    }
    __syncthreads();
  }
  if (bid == nb - 1) {
    for (int i = tid; i < 1024; i += NTHREADS) {
      const int pos = i >> 4, f = i & 15;
      const float inv = powf(10000.f, -(float)f / 16.f);
      const float ang = (float)pos * inv;
      p.ropec[i] = cosf(ang);
      p.ropes[i] = sinf(ang);
    }
  }
  {
    float* tile = (float*)smem;
    const int ntile_total = 768 + 256 + 384 + 256 + 512;
    for (int it = bid; it < ntile_total; it += nb) {
      const float* src; bf16_t* dst; int N, ti;
      if (it < 768) { src = p.ev_w_in; dst = p.winT0; N = 3072; ti = it; }
      else if (it < 1024) { src = p.ev_w_out; dst = p.woutT0; N = 1024; ti = it - 768; }
      else if (it < 1408) { src = p.od_w_in; dst = p.winT1; N = 1536; ti = it - 1024; }
      else if (it < 1664) { src = p.od_w_out; dst = p.woutT1; N = 1024; ti = it - 1408; }
      else { const int l = (it - 1664) / 256; src = p.peer_wq + (size_t)l * 1024 * 1024; dst = p.wqT + (size_t)l * 1024 * 1024; N = 1024; ti = (it - 1664) % 256; }
      const int ntn = N / 64, tk = ti / ntn, tn = ti % ntn;
      __syncthreads();
      for (int i = tid; i < 64 * 64; i += NTHREADS) {
        const int r = i >> 6, cc = i & 63;
        tile[r * 65 + cc] = src[(size_t)(tk * 64 + r) * N + tn * 64 + cc];
      }
      __syncthreads();
      for (int i = tid; i < 64 * 32; i += NTHREADS) {
        const int nn = i >> 5, kk = (i & 31) * 2;
        const unsigned w = cvt_pk_bf16(tile[kk * 65 + nn], tile[(kk + 1) * 65 + nn]);
        *(unsigned*)(dst + (size_t)(tn * 64 + nn) * 1024 + tk * 64 + kk) = w;
      }
    }
    __syncthreads();
  }
  for (int idx = bid * NTHREADS + tid; idx < 2 * 8 * 2 * 128 * 64; idx += nb * NTHREADS) {
    const int d = idx & 63, k = (idx >> 6) & 127, s = (idx >> 13) & 1, hh = (idx >> 14) & 7, l = idx >> 17;
    const float v = (s ? p.keys2 : p.keys1)[((size_t)(l * 8 + hh) * 128 + k) * 64 + d];
    const bf16_t hi = f2bf(v);
    const bf16_t lo = f2bf(v - bf2f(hi));
    const size_t o = ((size_t)((l * 8 + hh) * 2 + s) * 2) * 8192 + (size_t)k * 64 + d;
    p.keysb[o] = hi;
    p.keysb[o + 8192] = lo;
  }
  {
    const int wid = tid >> 6, lane = tid & 63, hw = lane >> 5, L = lane & 31, bb = L >> 3, ii = L & 7;
    for (int r = (bid * 8 + wid) * 2 + hw; r < 4 * NEXP; r += nb * 16) {
      const bool isv = r >= 2 * NEXP;
      const int rr = isv ? r - 2 * NEXP : r;
      const float* src = (isv ? p.peer_v : p.peer_u) + (size_t)rr * D + bb * 256 + ii * 32;
      f32x4 a[8];
      float mx = 0.f;
#pragma unroll
      for (int q = 0; q < 8; ++q) {
        a[q] = *(const f32x4*)(src + q * 4);
        mx = fmaxf(mx, fmaxf(fmaxf(fabsf(a[q][0]), fabsf(a[q][1])), fmaxf(fabsf(a[q][2]), fabsf(a[q][3]))));
      }
      mx = row16_max(mx);
      { auto sw = __builtin_amdgcn_permlane16_swap(__float_as_uint(mx), __float_as_uint(mx), false, false); mx = fmaxf(__uint_as_float(sw[0]), __uint_as_float(sw[1])); }
      const float sc = mx > 0.f ? 7.0f / mx : 1.f;
      u32x16 pk;
#pragma unroll
      for (int q = 0; q < 8; ++q) { pk[2 * q] = cvt_pk_bf16(a[q][0] * sc, a[q][1] * sc); pk[2 * q + 1] = cvt_pk_bf16(a[q][2] * sc, a[q][3] * sc); }
      const u32x6 w = __builtin_amdgcn_cvt_scalef32_pk32_fp6_bf16(__builtin_bit_cast(bf16x32n, pk), 1.0f);
      unsigned char* dst = (isv ? p.v8 : p.u8) + (size_t)rr * 768 + ii * 16;
#pragma unroll
      for (int m = 0; m < 6; ++m) {
        const int sidx = 6 * bb + m;
        const unsigned wm = w[m];
        *(unsigned*)(dst + (sidx >> 2) * 128 + (sidx & 3) * 4) = wm;
      }
      if (L == 0) (isv ? p.vscale : p.uscale)[rr] = mx > 0.f ? mx / 7.0f : 1.f;
    }
  }
}

__device__ void phase_resid_norm(const Params& p, int bid, int nb, int row0, int row1, const float* hin_ctx, const float* hin_lat,
                                 const float* gain, const float* modl) {
  const int tid0 = tidx();
  const int wid = tid0 >> 6, lane = tid0 & 63;
  for (int rowa = row0 + (bid * 8 + wid) * 2; rowa < row1; rowa += nb * 16) {
    f32x4 v[2][4];
    float ss[2] = {0.f, 0.f};
#pragma unroll
    for (int r = 0; r < 2; ++r) {
      const int row = rowa + r;
      const bool isctx = row < NCTX;
      const float* h = isctx ? hin_ctx + (size_t)row * D : hin_lat + (size_t)(row - NCTX) * D;
      const bf16_t* mrow = p.pq + (size_t)row * D;
#pragma unroll
      for (int i = 0; i < 4; ++i) {
        const f32x4 hv = *(const f32x4*)(h + i * 256 + lane * 4);
        const u32x2 mv = *(const u32x2*)(mrow + i * 256 + lane * 4);
        v[r][i][0] = hv[0] + bf_lo(mv.x); v[r][i][1] = hv[1] + bf_hi(mv.x); v[r][i][2] = hv[2] + bf_lo(mv.y); v[r][i][3] = hv[3] + bf_hi(mv.y);
      }
    }
#pragma unroll
    for (int r = 0; r < 2; ++r) {
      const int row = rowa + r;
      const bool isctx = row < NCTX;
      float* ho = isctx ? p.hctx + (size_t)row * D : p.out + (size_t)(row - NCTX) * D;
      const int b = isctx ? 32 : ((row - NCTX) >> 11);
      const float* sh = modl + (size_t)b * MODW + 3 * D;
      const float* sc = modl + (size_t)b * MODW + 4 * D;
#pragma unroll
      for (int i = 0; i < 4; ++i) {
        *(f32x4*)(ho + i * 256 + lane * 4) = v[r][i];
        ss[r] += v[r][i][0] * v[r][i][0] + v[r][i][1] * v[r][i][1] + v[r][i][2] * v[r][i][2] + v[r][i][3] * v[r][i][3];
      }
      const float rstd = rsqrtf(wave_sum(ss[r]) * (1.f / D) + EPS);
#pragma unroll
      for (int i = 0; i < 4; ++i) {
        const int col = i * 256 + lane * 4;
        const f32x4 g = *(const f32x4*)(gain + col), s1 = *(const f32x4*)(sc + col), s0 = *(const f32x4*)(sh + col);
        f32x4 y = v[r][i] * rstd * g;
        y = y * (1.f + s1) + s0;
        u32x2 w; w.x = cvt_pk_bf16(y[0], y[1]); w.y = cvt_pk_bf16(y[2], y[3]);
        *(u32x2*)(p.act + (size_t)row * D + col) = w;
      }
    }
  }
}
__device__ void phase_norm(const Params& p, int bid, int nb, int row0, int row1, const float* hctx, const float* hlat,
                           const float* gain, const float* modl, int ish, int isc) {
  const int tid0 = tidx();
  const int wid = tid0 >> 6, lane = tid0 & 63;
  for (int rowa = row0 + (bid * 8 + wid) * 2; rowa < row1; rowa += nb * 16) {
    f32x4 v[2][4];
#pragma unroll
    for (int r = 0; r < 2; ++r) {
      const int row = rowa + r;
      const float* h = row < NCTX ? hctx + (size_t)row * D : hlat + (size_t)(row - NCTX) * D;
#pragma unroll
      for (int i = 0; i < 4; ++i) v[r][i] = *(const f32x4*)(h + i * 256 + lane * 4);
    }
#pragma unroll
    for (int r = 0; r < 2; ++r) {
      const int row = rowa + r;
      const int b = row < NCTX ? 32 : ((row - NCTX) >> 11);
      const float* sh = modl + (size_t)b * MODW + ish * D;
      const float* sc = modl + (size_t)b * MODW + isc * D;
      float ss = 0.f;
#pragma unroll
      for (int i = 0; i < 4; ++i) ss += v[r][i][0] * v[r][i][0] + v[r][i][1] * v[r][i][1] + v[r][i][2] * v[r][i][2] + v[r][i][3] * v[r][i][3];
      const float rstd = rsqrtf(wave_sum(ss) * (1.f / D) + EPS);
#pragma unroll
      for (int i = 0; i < 4; ++i) {
        const int col = i * 256 + lane * 4;
        const f32x4 g = *(const f32x4*)(gain + col), s1 = *(const f32x4*)(sc + col), s0 = *(const f32x4*)(sh + col);
        f32x4 y = v[r][i] * rstd * g;
        y = y * (1.f + s1) + s0;
        u32x2 w; w.x = cvt_pk_bf16(y[0], y[1]); w.y = cvt_pk_bf16(y[2], y[3]);
        *(u32x2*)(p.act + (size_t)row * D + col) = w;
      }
    }
  }
}

__device__ __forceinline__ void phase_gemm_inproj(const Params& p, unsigned char* smem, int bid, int nb, int layer) {
  LAS unsigned char* lds = (LAS unsigned char*)smem;
  if (layer == 0) {
    EpiInProj epi{p.proj, 3072, 0, p.ropec, p.ropes};
    Sched s{0, 0, NTOK / BM, 12, nb, bid};
    gemm_phase(lds, p.act, p.winT0, s, epi);
  } else {
    EpiInProj epi{p.proj, 1536, 1, p.ropec, p.ropes};
    Sched s{NCTX / BM, 0, NLAT / BM, 6, nb, bid};
    gemm_phase(lds, p.act, p.winT1, s, epi);
    Sched s2{0, 4, NCTX / BM, 2, nb, bid};
    gemm_phase(lds, p.act, p.winT1, s2, epi);
  }
}
__device__ __forceinline__ void phase_gemm_outproj(const Params& p, unsigned char* smem, int bid, int nb, int layer) {
  LAS unsigned char* lds = (LAS unsigned char*)smem;
  EpiGate epi{p.pq, p.mod + (size_t)layer * 33 * MODW + 2 * D};
  const int pm0 = layer == 0 ? 0 : NCTX / BM;
  Sched s{pm0, 0, NTOK / BM - pm0, 4, nb, bid};
  gemm_phase(lds, p.act, layer == 0 ? p.woutT0 : p.woutT1, s, epi);
}
__device__ __forceinline__ void phase_gemm_pq(const Params& p, unsigned char* smem, int bid, int nb, int layer) {
  LAS unsigned char* lds = (LAS unsigned char*)smem;
  EpiBf16 epi{p.pq, D};
  const int pm0 = layer == 0 ? 0 : NCTX / BM;
  Sched s{pm0, 0, NTOK / BM - pm0, 4, nb, bid};
  gemm_phase(lds, p.act, p.wqT + (size_t)layer * D * D, s, epi);
}

__device__ __forceinline__ int chunk_row0(int b, int cc) { return cc < 2 ? b * CTXL + cc * 128 : NCTX + b * SEQ + (cc - 2) * 128; }

constexpr int LDP = 136;
constexpr int LDK = 72;

typedef short s16x4 __attribute__((ext_vector_type(4)));
__device__ __forceinline__ bf16x8 tr_frag(const LAS bf16_t* base, int ld, int lane) {
  const int troff = ((lane & 15) >> 2) * ld + (lane & 3) * 4;
  const s16x4 v0 = __builtin_amdgcn_ds_read_tr16_b64_v4i16((LAS s16x4*)(base + troff));
  const s16x4 v1 = __builtin_amdgcn_ds_read_tr16_b64_v4i16((LAS s16x4*)(base + 16 * ld + troff));
  bf16x8 f;
  f[0] = v0[0]; f[1] = v0[1]; f[2] = v0[2]; f[3] = v0[3]; f[4] = v1[0]; f[5] = v1[1]; f[6] = v1[2]; f[7] = v1[3];
  return f;
}
__device__ void phase_ret_kv(const Params& p, unsigned char* smem, int bid, int nb) {
  const int tid = tidx(), wid = __builtin_amdgcn_readfirstlane(tid >> 6), lane = tid & 63, fr = lane & 15, fq = lane >> 4;
  LAS bf16_t* Kl = (LAS bf16_t*)smem;
  LAS bf16_t* Vl = Kl + 128 * LDK;
  for (int it = bid; it < BATCH * 4 * 18; it += nb) {
    const int cc = it % 18, h = (it / 18) & 3, b = it / 72;
    const int row0 = chunk_row0(b, cc);
    const float lf = log_sigmoidf(p.logit_f[h]), lb = log_sigmoidf(p.logit_b[h]);
    __syncthreads();
    for (int task = tid; task < 128 * 8; task += NTHREADS) {
      const int j = task >> 3, d0 = (task & 7) * 8;
      *(LAS u32x4*)(Kl + j * LDK + d0) = *(const u32x4*)(p.proj + (size_t)(row0 + j) * 3072 + 256 + h * 64 + d0);
    }
    for (int task = tid; task < 128 * 16; task += NTHREADS) {
      const int j = task >> 4, e0 = (task & 15) * 8;
      *(LAS u32x4*)(Vl + j * LDP + e0) = *(const u32x4*)(p.proj + (size_t)(row0 + j) * 3072 + 512 + h * 128 + e0);
    }
    __syncthreads();
    bf16x8 af[4], ab[4];
#pragma unroll
    for (int ks = 0; ks < 4; ++ks) {
      const bf16x8 vf = tr_frag(Vl + (ks * 32 + fq * 4) * LDP + wid * 16, LDP, lane);
      const u32x4 vu = __builtin_bit_cast(u32x4, vf);
      u32x4 wf, wb;
#pragma unroll
      for (int q = 0; q < 4; ++q) {
        const int j0 = ks * 32 + (q >> 1) * 16 + fq * 4 + (q & 1) * 2;
        const float lo = bf_lo(vu[q]), hi = bf_hi(vu[q]);
        wf[q] = cvt_pk_bf16(lo * __expf(lf * (float)(127 - j0)), hi * __expf(lf * (float)(126 - j0)));
        wb[q] = cvt_pk_bf16(lo * __expf(lb * (float)j0), hi * __expf(lb * (float)(j0 + 1)));
      }
      af[ks] = __builtin_bit_cast(bf16x8, wf);
      ab[ks] = __builtin_bit_cast(bf16x8, wb);
    }
    float* out = p.kv + (size_t)it * 16384;
#pragma unroll
    for (int n = 0; n < 4; ++n) {
      f32x4 accf = {0.f, 0.f, 0.f, 0.f}, accb = {0.f, 0.f, 0.f, 0.f};
#pragma unroll
      for (int ks = 0; ks < 4; ++ks) {
        const bf16x8 kf = tr_frag(Kl + (ks * 32 + fq * 4) * LDK + n * 16, LDK, lane);
        accf = __builtin_amdgcn_mfma_f32_16x16x32_bf16(af[ks], kf, accf, 0, 0, 0);
        accb = __builtin_amdgcn_mfma_f32_16x16x32_bf16(ab[ks], kf, accb, 0, 0, 0);
      }
#pragma unroll
      for (int j = 0; j < 4; ++j) {
        out[(wid * 16 + fq * 4 + j) * 128 + n * 16 + fr] = accf[j];
        out[(wid * 16 + fq * 4 + j) * 128 + 64 + n * 16 + fr] = accb[j];
      }
    }
  }
  for (size_t task = (size_t)bid * NTHREADS + tid; task < (size_t)NTOK * 64; task += (size_t)nb * NTHREADS) {
    const int row = (int)(task >> 6), c0 = (int)(task & 63) * 8;
    const int tin = row < NCTX ? (row & (CTXL - 1)) : ((row - NCTX) & (SEQ - 1));
    const int tlen = row < NCTX ? CTXL : SEQ;
    const bf16_t* pr = p.proj + (size_t)row * 3072;
    const u32x4 gb = *(const u32x4*)(pr + 1536 + c0);
    float accv[8];
#pragma unroll
    for (int q = 0; q < 8; ++q) accv[q] = 0.f;
#pragma unroll
    for (int dt = -1; dt <= 1; ++dt) {
      if (tin + dt < 0 || tin + dt >= tlen) continue;
      const bf16_t* pr2 = pr + (ptrdiff_t)dt * 3072;
      const u32x4 gc = *(const u32x4*)(pr2 + 2048 + c0), xt = *(const u32x4*)(pr2 + 2560 + c0);
      const float* w = p.conv_w + (dt + 1) * 512 + c0;
      const f32x4 wa = *(const f32x4*)w, wb = *(const f32x4*)(w + 4);
#pragma unroll
      for (int q = 0; q < 4; ++q) {
        const float u0 = bf_lo(gc[q]) * bf_lo(xt[q]), u1 = bf_hi(gc[q]) * bf_hi(xt[q]);
        const float w0 = (2 * q < 4) ? wa[2 * q] : wb[2 * q - 4], w1 = (2 * q + 1 < 4) ? wa[2 * q + 1] : wb[2 * q + 1 - 4];
        accv[2 * q] += w0 * u0;
        accv[2 * q + 1] += w1 * u1;
      }
    }
    u32x4 o;
#pragma unroll
    for (int q = 0; q < 4; ++q) o[q] = cvt_pk_bf16(bf_lo(gb[q]) * accv[2 * q], bf_hi(gb[q]) * accv[2 * q + 1]);
#ifdef ZERO_CONV
    o = (u32x4){0u, 0u, 0u, 0u};
#endif
    *(u32x4*)(p.act + (size_t)row * D + 512 + c0) = o;
  }
}

__device__ void phase_ret_scan(const Params& p, int bid, int nb) {
  const int tid = tidx();
  for (size_t idx = (size_t)bid * NTHREADS + tid; idx < (size_t)BATCH * 4 * 16384; idx += (size_t)nb * NTHREADS) {
    const int el = (int)(idx & 16383), bh = (int)(idx >> 14), h = bh & 3;
    const bool fwd = (el & 127) < 64;
    const float lg = log_sigmoidf(fwd ? p.logit_f[h] : p.logit_b[h]);
    const float dec = __expf(lg * 128.f);
    float st = 0.f;
    for (int s = 0; s < 18; ++s) {
      const int cc = fwd ? s : (s < 2 ? 1 - s : 19 - s);
      const size_t off = ((size_t)bh * 18 + cc) * 16384 + el;
      p.sprev[off] = f2bf(st);
      st = dec * st + p.kv[off];
    }
  }
}

__device__ void phase_ret_out(const Params& p, unsigned char* smem, int bid, int nb) {
  const int tid = tidx(), wid = __builtin_amdgcn_readfirstlane(tid >> 6), lane = tid & 63, fr = lane & 15, fq = lane >> 4;
  LAS bf16_t* Kl = (LAS bf16_t*)smem;
  LAS bf16_t* Vl = Kl + 128 * LDK;
  LAS bf16_t* Sl = Vl + 128 * LDP;
  const int NIT = BATCH * 4 * 18;
  u32x4 rk[2], rv[4], rs[4];
  bf16x8 qfn[2];
#define RO_LOAD(IT)                                                                                                      \
  do {                                                                                                                   \
    const int _cc = (IT) % 18, _h = ((IT) / 18) & 3, _b = (IT) / 72;                                                     \
    const int _row0 = chunk_row0(_b, _cc);                                                                               \
    _Pragma("unroll") for (int c = 0; c < 2; ++c) { const int task = tid + c * NTHREADS; const int j = task >> 3, d0 = (task & 7) * 8; \
      rk[c] = *(const u32x4*)(p.proj + (size_t)(_row0 + j) * 3072 + 256 + _h * 64 + d0); }                              \
    _Pragma("unroll") for (int c = 0; c < 4; ++c) { const int task = tid + c * NTHREADS; const int j = task >> 4, e0 = (task & 15) * 8; \
      rv[c] = *(const u32x4*)(p.proj + (size_t)(_row0 + j) * 3072 + 512 + _h * 128 + e0);                               \
      rs[c] = *(const u32x4*)(p.sprev + (size_t)(IT) * 16384 + j * 128 + e0); }                                          \
    _Pragma("unroll") for (int ks = 0; ks < 2; ++ks) qfn[ks] = *(const bf16x8*)(p.proj + (size_t)(_row0 + wid * 16 + fr) * 3072 + _h * 64 + ks * 32 + fq * 8); \
  } while (0)
#define RO_STORE()                                                                                                       \
  do {                                                                                                                   \
    _Pragma("unroll") for (int c = 0; c < 2; ++c) { const int task = tid + c * NTHREADS; const int j = task >> 3, d0 = (task & 7) * 8; \
      *(LAS u32x4*)(Kl + j * LDK + d0) = rk[c]; }                                                                        \
    _Pragma("unroll") for (int c = 0; c < 4; ++c) { const int task = tid + c * NTHREADS; const int j = task >> 4, e0 = (task & 15) * 8; \
      *(LAS u32x4*)(Vl + j * LDP + e0) = rv[c]; *(LAS u32x4*)(Sl + j * LDP + e0) = rs[c]; }                              \
  } while (0)
  if (bid < NIT) { RO_LOAD(bid); __syncthreads(); RO_STORE(); }
  __syncthreads();
  for (int it = bid; it < NIT; it += nb) {
    const int cc = it % 18, h = (it / 18) & 3, b = it / 72;
    const int row0 = chunk_row0(b, cc);
    const float lf = log_sigmoidf(p.logit_f[h]), lb = log_sigmoidf(p.logit_b[h]);
    const int irow = wid * 16 + fr;
    bf16x8 qf[2];
    qf[0] = qfn[0]; qf[1] = qfn[1];
    const bool more = it + nb < NIT;
    if (more) RO_LOAD(it + nb);
    const size_t row = (size_t)(row0 + irow);
    u32x2 gg[8];
#pragma unroll
    for (int dn = 0; dn < 8; ++dn) gg[dn] = *(const u32x2*)(p.proj + row * 3072 + 1024 + h * 128 + dn * 16 + fq * 4);
    bf16x8 pb[4];
    {
      f32x4 st[8];
#pragma unroll
      for (int n = 0; n < 8; ++n) st[n] = (f32x4){0.f, 0.f, 0.f, 0.f};
#pragma unroll
      for (int ks = 0; ks < 2; ++ks)
#pragma unroll
        for (int n = 0; n < 8; ++n) {
          const bf16x8 kf = *(const LAS bf16x8*)(Kl + (n * 16 + fr) * LDK + ks * 32 + fq * 8);
          st[n] = __builtin_amdgcn_mfma_f32_16x16x32_bf16(kf, qf[ks], st[n], 0, 0, 0);
        }
#pragma unroll
      for (int n = 0; n < 8; ++n)
#pragma unroll
        for (int r = 0; r < 4; ++r) {
          const int df = irow - (n * 16 + fq * 4 + r);
          const float lg = df > 0 ? lf : lb;
          const float ex = __expf(lg * fabsf((float)df));
          st[n][r] *= (df == 0) ? 2.f : ex;
        }
#pragma unroll
      for (int kk = 0; kk < 4; ++kk) {
        u32x4 w;
        w.x = cvt_pk_bf16(st[2 * kk][0], st[2 * kk][1]); w.y = cvt_pk_bf16(st[2 * kk][2], st[2 * kk][3]);
        w.z = cvt_pk_bf16(st[2 * kk + 1][0], st[2 * kk + 1][1]); w.w = cvt_pk_bf16(st[2 * kk + 1][2], st[2 * kk + 1][3]);
        pb[kk] = __builtin_bit_cast(bf16x8, w);
      }
    }
    bf16x8 qx[4];
    {
      const float xf = __expf(lf * (float)(irow + 1)), xb = __expf(lb * (float)(128 - irow));
#pragma unroll
      for (int ks = 0; ks < 4; ++ks) {
        const float sc = ks < 2 ? xf : xb;
        const u32x4 qu = __builtin_bit_cast(u32x4, qf[ks & 1]);
        u32x4 qo;
#pragma unroll
        for (int q = 0; q < 4; ++q) { const unsigned w = qu[q]; qo[q] = cvt_pk_bf16(bf_lo(w) * sc, bf_hi(w) * sc); }
        qx[ks] = __builtin_bit_cast(bf16x8, qo);
      }
    }
    f32x4 ot[8];
#pragma unroll
    for (int dn = 0; dn < 8; ++dn) {
      f32x4 o = {0.f, 0.f, 0.f, 0.f};
#pragma unroll
      for (int kk = 0; kk < 4; ++kk) {
        const bf16x8 vf = tr_frag(Vl + (kk * 32 + fq * 4) * LDP + dn * 16, LDP, lane);
        o = __builtin_amdgcn_mfma_f32_16x16x32_bf16(vf, pb[kk], o, 0, 0, 0);
      }
#pragma unroll
      for (int ks = 0; ks < 4; ++ks) {
        const bf16x8 sf = *(const LAS bf16x8*)(Sl + (dn * 16 + fr) * LDP + ks * 32 + fq * 8);
        o = __builtin_amdgcn_mfma_f32_16x16x32_bf16(sf, qx[ks], o, 0, 0, 0);
      }
      ot[dn] = o;
    }
    float ss = 0.f;
#pragma unroll
    for (int dn = 0; dn < 8; ++dn) ss += ot[dn][0] * ot[dn][0] + ot[dn][1] * ot[dn][1] + ot[dn][2] * ot[dn][2] + ot[dn][3] * ot[dn][3];
    ss = xrow16_sum(ss);
    const float rstd = rsqrtf(ss * (1.f / 128.f) + EPS);
#pragma unroll
    for (int dn = 0; dn < 8; ++dn) {
      const int e0 = dn * 16 + fq * 4;
      const u32x2 g = gg[dn];
      u32x2 w;
#ifdef ZERO_RET
      w.x = 0u; w.y = 0u;
#else
      w.x = cvt_pk_bf16(ot[dn][0] * rstd * siluf(bf_lo(g.x)), ot[dn][1] * rstd * siluf(bf_hi(g.x)));
      w.y = cvt_pk_bf16(ot[dn][2] * rstd * siluf(bf_lo(g.y)), ot[dn][3] * rstd * siluf(bf_hi(g.y)));
#endif
      *(u32x2*)(p.act + row * D + h * 128 + e0) = w;
    }
    __syncthreads();
    if (more) RO_STORE();
    __syncthreads();
  }
#undef RO_LOAD
#undef RO_STORE
}

__device__ __forceinline__ float xrow16_max(float x) {
  auto s = __builtin_amdgcn_permlane16_swap(__float_as_uint(x), __float_as_uint(x), false, false);
  x = fmaxf(__uint_as_float(s[0]), __uint_as_float(s[1]));
  auto t = __builtin_amdgcn_permlane32_swap(__float_as_uint(x), __float_as_uint(x), false, false);
  return fmaxf(__uint_as_float(t[0]), __uint_as_float(t[1]));
}
template <int VAR>
__device__ void phase_attn(const Params& p, unsigned char* smem, int bid, int nb, bf16_t* outp) {
  const int tid = tidx(), wid = __builtin_amdgcn_readfirstlane(tid >> 6), lane = tid & 63, fr = lane & 15, fq = lane >> 4;
  LAS bf16_t* Kl = (LAS bf16_t*)smem;
  LAS bf16_t* Vl = Kl + 2 * 64 * LDK;
  LAS bf16_t* Ql = Vl + 2 * 64 * LDK + wid * 64 * LDK;
  const int sj = tid >> 3, sc8 = (tid & 7) * 8;
  const int troff = ((lane & 15) >> 2) * LDK + (lane & 3) * 4;
  for (int it = bid; it < BATCH * 16 * 4; it += nb) {
    const int kvh = it & 3, qb = (it >> 2) & 15, b = it >> 6;
    const int hq = kvh * 4 + (wid >> 1);
    const int q0 = qb * 128 + (wid & 1) * 64;
    const size_t latrow0 = (size_t)NCTX + (size_t)b * SEQ;
    const int tlo = qb == 0 ? 2 : 0, nwin = (qb == 15 ? 4 : 6) - tlo, ntile = nwin + 4;
#pragma unroll
    for (int m = 0; m < 4; ++m)
#pragma unroll
      for (int ks = 0; ks < 2; ++ks)
        *(LAS bf16x8*)(Ql + (m * 16 + fr) * LDK + ks * 32 + fq * 8) = *(const bf16x8*)(p.proj + (latrow0 + q0 + m * 16 + fr) * 1536 + hq * 64 + ks * 32 + fq * 8);
    const float sink = p.sinks[hq] * 1.44269504089f;
    float mrow[4], lrow[4];
    f32x4 ot[4][4];
#pragma unroll
    for (int m = 0; m < 4; ++m) {
      mrow[m] = sink; lrow[m] = (fq == 0) ? 1.f : 0.f;
#pragma unroll
      for (int dn = 0; dn < 4; ++dn) ot[dn][m] = (f32x4){0.f, 0.f, 0.f, 0.f};
    }
#define AT_KROW(T) ((T) < nwin ? latrow0 + (qb * 128 - 128 + 64 * (tlo + (T))) : (size_t)b * CTXL + ((T) - nwin) * 64)
#define AT_LOAD(RK, RV, T) do { const size_t _kr = AT_KROW(T);                                                            \
      RK = *(const u32x4*)(p.proj + (_kr + sj) * 1536 + 1024 + kvh * 64 + sc8);                                          \
      RV = *(const u32x4*)(p.proj + (_kr + sj) * 1536 + 1280 + kvh * 64 + sc8); } while (0)
    u32x4 rk0, rv0, rk1, rv1;
    rk0 = rk1 = rv0 = rv1 = (u32x4){0u, 0u, 0u, 0u};
    {
      u32x4 kk, vv;
      AT_LOAD(kk, vv, 0);
      AT_LOAD(rk1, rv1, 1);
      *(LAS u32x4*)(Kl + sj * LDK + sc8) = kk;
      *(LAS u32x4*)(Vl + sj * LDK + sc8) = vv;
    }
    __syncthreads();
    auto tile = [&](const int s, u32x4& ldK, u32x4& ldV, const u32x4& wrK, const u32x4& wrV) __attribute__((always_inline)) {
      const int cur = s & 1;
      const int tt = s < nwin ? tlo + s : 6 + (s - nwin);
      const bool win = tt < 6;
      const int kpos0 = win ? qb * 128 - 128 + 64 * tt : (tt - 6) * 64;
      const bool more = s + 1 < ntile;
      if (!(VAR & 16)) { if (s + 2 < ntile) AT_LOAD(ldK, ldV, s + 2); }
      const LAS bf16_t* Kc = Kl + cur * 64 * LDK;
      const LAS bf16_t* Vc = Vl + cur * 64 * LDK;
      const int dq = q0 - kpos0;
      const bool skip = win && (dq >= 192 || dq <= -192);
      const bool edge = win && !(dq <= 65 && dq >= -65);
      if (!skip && !(VAR & 8)) {
      bf16x8 pb[4][2];
      {
        bf16x8 kfr[2][4];
#pragma unroll
        for (int ks = 0; ks < 2; ++ks)
#pragma unroll
          for (int n = 0; n < 4; ++n) kfr[ks][n] = *(const LAS bf16x8*)(Kc + (n * 16 + fr) * LDK + ks * 32 + fq * 8);
#pragma unroll
        for (int m = 0; m < 4; ++m) {
          f32x4 st[4];
#pragma unroll
          for (int n = 0; n < 4; ++n) st[n] = (f32x4){0.f, 0.f, 0.f, 0.f};
#pragma unroll
          for (int ks = 0; ks < 2; ++ks) {
            const bf16x8 qfm = *(const LAS bf16x8*)(Ql + (m * 16 + fr) * LDK + ks * 32 + fq * 8);
#pragma unroll
            for (int n = 0; n < 4; ++n) st[n] = __builtin_amdgcn_mfma_f32_16x16x32_bf16(kfr[ks][n], qfm, st[n], 0, 0, 0);
          }
          const int qpos = q0 + m * 16 + fr;
          float mx = -3.0e38f;
#pragma unroll
          for (int n = 0; n < 4; ++n)
#pragma unroll
            for (int j = 0; j < 4; ++j) {
              float sv = st[n][j];
              if (edge) { const int dd = qpos - (kpos0 + n * 16 + fq * 4 + j); if (dd > 128 || dd < -128) sv = -1e30f; }
              st[n][j] = sv;
              mx = fmaxf(mx, sv);
            }
          mx = xrow16_max(mx);
          const float mnew = fmaxf(mrow[m], mx);
          const float alpha = __builtin_amdgcn_exp2f(mrow[m] - mnew);
          mrow[m] = mnew;
          float ls = 0.f;
#pragma unroll
          for (int n = 0; n < 4; ++n)
#pragma unroll
            for (int j = 0; j < 4; ++j) { const float pv = (VAR & 2) ? (st[n][j] - mnew) : __builtin_amdgcn_exp2f(st[n][j] - mnew); st[n][j] = pv; ls += pv; }
          lrow[m] = lrow[m] * alpha + ls;
#pragma unroll
          for (int dn = 0; dn < 4; ++dn) ot[dn][m] *= alpha;
#pragma unroll
          for (int kk = 0; kk < 2; ++kk) {
            u32x4 w;
            w.x = cvt_pk_bf16(st[2 * kk][0], st[2 * kk][1]); w.y = cvt_pk_bf16(st[2 * kk][2], st[2 * kk][3]);
            w.z = cvt_pk_bf16(st[2 * kk + 1][0], st[2 * kk + 1][1]); w.w = cvt_pk_bf16(st[2 * kk + 1][2], st[2 * kk + 1][3]);
            pb[m][kk] = __builtin_bit_cast(bf16x8, w);
          }
          __builtin_amdgcn_sched_barrier(0);
        }
      }
#pragma unroll
      for (int kk = 0; kk < 2; ++kk) {
        bf16x8 vfr[4];
#pragma unroll
        for (int dn = 0; dn < 4; ++dn) {
          const s16x4 v0 = __builtin_amdgcn_ds_read_tr16_b64_v4i16((LAS s16x4*)(Vc + ((2 * kk) * 16 + fq * 4) * LDK + dn * 16 + troff));
          const s16x4 v1 = __builtin_amdgcn_ds_read_tr16_b64_v4i16((LAS s16x4*)(Vc + ((2 * kk + 1) * 16 + fq * 4) * LDK + dn * 16 + troff));
          bf16x8 vf;
          vf[0] = v0[0]; vf[1] = v0[1]; vf[2] = v0[2]; vf[3] = v0[3]; vf[4] = v1[0]; vf[5] = v1[1]; vf[6] = v1[2]; vf[7] = v1[3];
          vfr[dn] = vf;
        }
#pragma unroll
        for (int m = 0; m < 4; ++m)
#pragma unroll
          for (int dn = 0; dn < 4; ++dn) { if (VAR & 4) ot[dn][m][0] += __uint_as_float(__builtin_bit_cast(u32x4, vfr[dn]).x ^ __builtin_bit_cast(u32x4, pb[m][kk]).x); else ot[dn][m] = __builtin_amdgcn_mfma_f32_16x16x32_bf16(vfr[dn], pb[m][kk], ot[dn][m], 0, 0, 0); }
        __builtin_amdgcn_sched_barrier(0);
      }
      }
      if (!(VAR & 16)) {
        if (more) {
          *(LAS u32x4*)(Kl + ((cur ^ 1) * 64 + sj) * LDK + sc8) = wrK;
          *(LAS u32x4*)(Vl + ((cur ^ 1) * 64 + sj) * LDK + sc8) = wrV;
        }
        __syncthreads();
      }
    };
#pragma unroll 1
    for (int s = 0; s < ntile; s += 2) {
      tile(s, rk0, rv0, rk1, rv1);
      tile(s + 1, rk1, rv1, rk0, rv0);
    }
#undef AT_LOAD
#undef AT_KROW
    int fr2 = fr;
    asm volatile("" : "+v"(fr2));
#pragma unroll
    for (int m = 0; m < 4; ++m) {
      const float l = xrow16_sum(lrow[m]);
      const float inv = 1.f / l;
      bf16_t* orow = outp + (latrow0 + q0 + m * 16 + fr2) * D + hq * 64 + fq * 4;
#pragma unroll
      for (int dn = 0; dn < 4; ++dn) {
        u32x2 w;
#ifdef ZERO_ATTN
        w.x = 0u; w.y = 0u;
#else
        w.x = cvt_pk_bf16(ot[dn][m][0] * inv, ot[dn][m][1] * inv); w.y = cvt_pk_bf16(ot[dn][m][2] * inv, ot[dn][m][3] * inv);
#endif
        *(u32x2*)(orow + dn * 16) = w;
      }
    }
  }
}

#define CEX(a, b) do { const unsigned _h = max(a, b), _l = min(a, b); a = _h; b = _l; } while (0)
__device__ __forceinline__ void sort16_desc(unsigned (&v)[16]) { CEX(v[0], v[1]); CEX(v[2], v[3]); CEX(v[0], v[2]); CEX(v[1], v[3]); CEX(v[1], v[2]); CEX(v[4], v[5]); CEX(v[6], v[7]); CEX(v[4], v[6]); CEX(v[5], v[7]); CEX(v[5], v[6]); CEX(v[0], v[4]); CEX(v[2], v[6]); CEX(v[2], v[4]); CEX(v[1], v[5]); CEX(v[3], v[7]); CEX(v[3], v[5]); CEX(v[1], v[2]); CEX(v[3], v[4]); CEX(v[5], v[6]); CEX(v[8], v[9]); CEX(v[10], v[11]); CEX(v[8], v[10]); CEX(v[9], v[11]); CEX(v[9], v[10]); CEX(v[12], v[13]); CEX(v[14], v[15]); CEX(v[12], v[14]); CEX(v[13], v[15]); CEX(v[13], v[14]); CEX(v[8], v[12]); CEX(v[10], v[14]); CEX(v[10], v[12]); CEX(v[9], v[13]); CEX(v[11], v[15]); CEX(v[11], v[13]); CEX(v[9], v[10]); CEX(v[11], v[12]); CEX(v[13], v[14]); CEX(v[0], v[8]); CEX(v[4], v[12]); CEX(v[4], v[8]); CEX(v[2], v[10]); CEX(v[6], v[14]); CEX(v[6], v[10]); CEX(v[2], v[4]); CEX(v[6], v[8]); CEX(v[10], v[12]); CEX(v[1], v[9]); CEX(v[5], v[13]); CEX(v[5], v[9]); CEX(v[3], v[11]); CEX(v[7], v[15]); CEX(v[7], v[11]); CEX(v[3], v[5]); CEX(v[7], v[9]); CEX(v[11], v[13]); CEX(v[1], v[2]); CEX(v[3], v[4]); CEX(v[5], v[6]); CEX(v[7], v[8]); CEX(v[9], v[10]); CEX(v[11], v[12]); CEX(v[13], v[14]); }
__device__ __forceinline__ void merge16_desc(unsigned (&t)[16], const unsigned (&b)[16]) {
#pragma unroll
  for (int i = 0; i < 16; ++i) t[i] = max(t[i], b[15 - i]);
  CEX(t[0], t[8]); CEX(t[1], t[9]); CEX(t[2], t[10]); CEX(t[3], t[11]); CEX(t[4], t[12]); CEX(t[5], t[13]); CEX(t[6], t[14]); CEX(t[7], t[15]); CEX(t[0], t[4]); CEX(t[1], t[5]); CEX(t[2], t[6]); CEX(t[3], t[7]); CEX(t[8], t[12]); CEX(t[9], t[13]); CEX(t[10], t[14]); CEX(t[11], t[15]); CEX(t[0], t[2]); CEX(t[1], t[3]); CEX(t[4], t[6]); CEX(t[5], t[7]); CEX(t[8], t[10]); CEX(t[9], t[11]); CEX(t[12], t[14]); CEX(t[13], t[15]); CEX(t[0], t[1]); CEX(t[2], t[3]); CEX(t[4], t[5]); CEX(t[6], t[7]); CEX(t[8], t[9]); CEX(t[10], t[11]); CEX(t[12], t[13]); CEX(t[14], t[15]);
}

__device__ __forceinline__ unsigned f2ord(float f) { const unsigned u = __float_as_uint(f); return (u & 0x80000000u) ? ~u : (u | 0x80000000u); }
__device__ __forceinline__ float ord2f(unsigned k) { const unsigned u = (k & 0x80000000u) ? (k & 0x7fffffffu) : ~k; return __uint_as_float(u); }
__device__ __forceinline__ unsigned dpp_xor1(unsigned x) { return (unsigned)__builtin_amdgcn_mov_dpp((int)x, 0xB1, 0xf, 0xf, true); }

__device__ void phase_peer_topk(const Params& p, unsigned char* smem, int bid, int nb, int layer, int tok0, int ntok) {
  const int tid = tidx(), wid = __builtin_amdgcn_readfirstlane(tid >> 6), lane = tid & 63, fr = lane & 15, fq = lane >> 4;
  LAS unsigned* sc = (LAS unsigned*)smem + wid * (64 * 36 + 64 * 16);
  LAS unsigned* fl = sc + 64 * 36;
  const int ls = lane & 1;
  const int nitem = (ntok / 256) * 8;
  for (int it = bid; it < nitem; it += nb) {
    const int h = it & 7, tile = it >> 3;
    const int tokw0 = tok0 + tile * 256 + wid * 32;
    bf16x8 qa[2][2][2];
#pragma unroll
    for (int m = 0; m < 2; ++m)
#pragma unroll
      for (int s = 0; s < 2; ++s)
#pragma unroll
        for (int ks = 0; ks < 2; ++ks)
          qa[m][s][ks] = *(const bf16x8*)(p.pq + (size_t)(tokw0 + m * 16 + fr) * D + h * 128 + s * 64 + ks * 32 + fq * 8);
    unsigned top[16];
#pragma unroll
    for (int i = 0; i < 16; ++i) top[i] = 0u;
    const bf16_t* kb = p.keysb + (size_t)(layer * 8 + h) * (2 * 2 * 128 * 64);
    bf16x8 kfr[2][2][2];
#define TK_LOADKEYS(C)                                                                                                   \
    _Pragma("unroll") for (int s = 0; s < 2; ++s) _Pragma("unroll") for (int n = 0; n < 2; ++n) _Pragma("unroll") for (int ks = 0; ks < 2; ++ks) \
      kfr[s][n][ks] = *(const bf16x8*)(kb + (size_t)((s * 2) * 128 + (C) * 32 + n * 16 + fr) * 64 + ks * 32 + fq * 8)
    TK_LOADKEYS(0);
#pragma unroll 1
    for (int c = 0; c < 4; ++c) {
      f32x4 acc[2][2][2];
#pragma unroll
      for (int m = 0; m < 2; ++m)
#pragma unroll
        for (int s = 0; s < 2; ++s)
#pragma unroll
          for (int n = 0; n < 2; ++n) acc[m][s][n] = (f32x4){0.f, 0.f, 0.f, 0.f};
#pragma unroll
      for (int s = 0; s < 2; ++s)
#pragma unroll
        for (int n = 0; n < 2; ++n)
#pragma unroll
          for (int ks = 0; ks < 2; ++ks)
#pragma unroll
            for (int m = 0; m < 2; ++m) acc[m][s][n] = __builtin_amdgcn_mfma_f32_16x16x32_bf16(qa[m][s][ks], kfr[s][n][ks], acc[m][s][n], 0, 0, 0);
      { const int cn = c < 3 ? c + 1 : 3; TK_LOADKEYS(cn); }
#pragma unroll
      for (int m = 0; m < 2; ++m)
#pragma unroll
        for (int s = 0; s < 2; ++s)
#pragma unroll
          for (int n = 0; n < 2; ++n)
#pragma unroll
            for (int j = 0; j < 4; ++j)
              sc[((m * 16 + fq * 4 + j) * 2 + s) * 36 + n * 16 + fr] = (f2ord(acc[m][s][n][j]) & 0xffffff80u) | (unsigned)(127 - (c * 32 + n * 16 + fr));
      unsigned b0[16], b1[16];
#pragma unroll
      for (int q = 0; q < 4; ++q) {
        const u32x4 w0 = *(const LAS u32x4*)(sc + lane * 36 + q * 4), w1 = *(const LAS u32x4*)(sc + lane * 36 + 16 + q * 4);
        b0[4 * q] = w0.x; b0[4 * q + 1] = w0.y; b0[4 * q + 2] = w0.z; b0[4 * q + 3] = w0.w;
        b1[4 * q] = w1.x; b1[4 * q + 1] = w1.y; b1[4 * q + 2] = w1.z; b1[4 * q + 3] = w1.w;
      }
      sort16_desc(b0); merge16_desc(top, b0);
      sort16_desc(b1); merge16_desc(top, b1);
    }
#undef TK_LOADKEYS
#pragma unroll
    for (int q = 0; q < 4; ++q) { u32x4 w; w.x = top[4 * q]; w.y = top[4 * q + 1]; w.z = top[4 * q + 2]; w.w = top[4 * q + 3]; *(LAS u32x4*)(fl + lane * 16 + q * 4) = w; }
    float own[16], oth[16];
#pragma unroll
    for (int q = 0; q < 4; ++q) {
      const u32x4 w = *(const LAS u32x4*)(fl + (lane ^ 1) * 16 + q * 4);
      oth[4 * q] = ord2f(w.x & 0xffffff80u); oth[4 * q + 1] = ord2f(w.y & 0xffffff80u); oth[4 * q + 2] = ord2f(w.z & 0xffffff80u); oth[4 * q + 3] = ord2f(w.w & 0xffffff80u);
    }
#pragma unroll
    for (int i = 0; i < 16; ++i) own[i] = ord2f(top[i] & 0xffffff80u);
    unsigned ck[32];
    ck[0] = (f2ord(own[0] + oth[1]) & 0xffffff00u) | (255u - (ls ? 16u : 1u));
    ck[1] = (f2ord(own[0] + oth[2]) & 0xffffff00u) | (255u - (ls ? 32u : 2u));
    ck[2] = (f2ord(own[0] + oth[3]) & 0xffffff00u) | (255u - (ls ? 48u : 3u));
    ck[3] = (f2ord(own[0] + oth[4]) & 0xffffff00u) | (255u - (ls ? 64u : 4u));
    ck[4] = (f2ord(own[0] + oth[5]) & 0xffffff00u) | (255u - (ls ? 80u : 5u));
    ck[5] = (f2ord(own[0] + oth[6]) & 0xffffff00u) | (255u - (ls ? 96u : 6u));
    ck[6] = (f2ord(own[0] + oth[7]) & 0xffffff00u) | (255u - (ls ? 112u : 7u));
    ck[7] = (f2ord(own[0] + oth[8]) & 0xffffff00u) | (255u - (ls ? 128u : 8u));
    ck[8] = (f2ord(own[0] + oth[9]) & 0xffffff00u) | (255u - (ls ? 144u : 9u));
    ck[9] = (f2ord(own[0] + oth[10]) & 0xffffff00u) | (255u - (ls ? 160u : 10u));
    ck[10] = (f2ord(own[0] + oth[11]) & 0xffffff00u) | (255u - (ls ? 176u : 11u));
    ck[11] = (f2ord(own[0] + oth[12]) & 0xffffff00u) | (255u - (ls ? 192u : 12u));
    ck[12] = (f2ord(own[0] + oth[13]) & 0xffffff00u) | (255u - (ls ? 208u : 13u));
    ck[13] = (f2ord(own[0] + oth[14]) & 0xffffff00u) | (255u - (ls ? 224u : 14u));
    ck[14] = (f2ord(own[0] + oth[15]) & 0xffffff00u) | (255u - (ls ? 240u : 15u));
    ck[15] = (f2ord(own[1] + oth[2]) & 0xffffff00u) | (255u - (ls ? 33u : 18u));
    ck[16] = (f2ord(own[1] + oth[3]) & 0xffffff00u) | (255u - (ls ? 49u : 19u));
    ck[17] = (f2ord(own[1] + oth[4]) & 0xffffff00u) | (255u - (ls ? 65u : 20u));
    ck[18] = (f2ord(own[1] + oth[5]) & 0xffffff00u) | (255u - (ls ? 81u : 21u));
    ck[19] = (f2ord(own[1] + oth[6]) & 0xffffff00u) | (255u - (ls ? 97u : 22u));
    ck[20] = (f2ord(own[1] + oth[7]) & 0xffffff00u) | (255u - (ls ? 113u : 23u));
    ck[21] = (f2ord(own[2] + oth[3]) & 0xffffff00u) | (255u - (ls ? 50u : 35u));
    ck[22] = (f2ord(own[2] + oth[4]) & 0xffffff00u) | (255u - (ls ? 66u : 36u));
    ck[23] = ls ? 0u : ((f2ord(own[0] + oth[0]) & 0xffffff00u) | (255u - 0u));
    ck[24] = ls ? 0u : ((f2ord(own[1] + oth[1]) & 0xffffff00u) | (255u - 17u));
    ck[25] = ls ? 0u : ((f2ord(own[2] + oth[2]) & 0xffffff00u) | (255u - 34u));
    ck[26] = ls ? 0u : ((f2ord(own[3] + oth[3]) & 0xffffff00u) | (255u - 51u));
    ck[27] = 0u;
    ck[28] = 0u;
    ck[29] = 0u;
    ck[30] = 0u;
    ck[31] = 0u;
    unsigned c0[16], c1[16];
#pragma unroll
    for (int i = 0; i < 16; ++i) { c0[i] = ck[i]; c1[i] = ck[16 + i]; }
    sort16_desc(c0); sort16_desc(c1); merge16_desc(c0, c1);
    unsigned pt[16];
#pragma unroll
    for (int i = 0; i < 16; ++i) pt[i] = dpp_xor1(c0[i]);
    merge16_desc(c0, pt);
    float cs[16], den = 0.f;
    const float mx = ord2f(c0[0] & 0xffffff00u);
#pragma unroll
    for (int r = 0; r < 16; ++r) { cs[r] = __expf(ord2f(c0[r] & 0xffffff00u) - mx); den += cs[r]; }
    const float inv = 1.f / den;
    const int token = tokw0 + (lane >> 1);
    if (ls == 0) {
      u32x2* so = p.sel + (size_t)token * 128 + h * 16;
      const LAS unsigned* l1 = fl + lane * 16;
      const LAS unsigned* l2 = fl + (lane + 1) * 16;
#pragma unroll
      for (int rr = 0; rr < 16; rr += 2) {
        u32x4 w;
        {
          const unsigned ci = 255u - (c0[rr] & 0xffu);
          w.x = (127u - (l1[ci >> 4] & 0x7fu)) * 128u + (127u - (l2[ci & 15u] & 0x7fu)); w.y = __float_as_uint(cs[rr] * inv);
        }
        {
          const unsigned ci = 255u - (c0[rr + 1] & 0xffu);
          w.z = (127u - (l1[ci >> 4] & 0x7fu)) * 128u + (127u - (l2[ci & 15u] & 0x7fu)); w.w = __float_as_uint(cs[rr + 1] * inv);
        }
        *(u32x4*)(so + rr) = w;
      }
    }
  }
}

__device__ __forceinline__ float gelu_as(float v) {
  const float av = fabsf(v), t = __builtin_amdgcn_rcpf(av * 0.2316418882f + 1.0f);
  float q = t * 0.5307027145f + (-0.7265760135f);
  q = q * t + 0.7107068705f; q = q * t + (-0.142248368f); q = q * t + 0.127414796f; q = q * t;
  const float ee = __builtin_amdgcn_exp2f((v * v) * (-0.72134752044f));
  const float m = v * (q * ee);
  return v < 0.f ? m : v - m;
}
typedef __bf16 bf16x2t __attribute__((ext_vector_type(2)));
__device__ __forceinline__ unsigned rl2(unsigned lo, unsigned hi, int j) {
  const unsigned a = (unsigned)__builtin_amdgcn_readlane((int)lo, j & 63), b = (unsigned)__builtin_amdgcn_readlane((int)hi, j & 63);
  return j < 64 ? a : b;
}
__device__ __forceinline__ float group8_sum(float x) { x += dppf<0xB1>(x); x += dppf<0x4E>(x); x += dppf<0x141>(x); return x; }
__device__ __forceinline__ float dot2u(unsigned a, unsigned b, float c) {
  return __builtin_amdgcn_fdot2_f32_bf16(__builtin_bit_cast(bf16x2t, a), __builtin_bit_cast(bf16x2t, b), c, false);
}
__device__ void phase_peer_gather(const Params& p, unsigned char* smem, int bid, int nb, int layer, int tok0, int ntok) {
  const int tid0 = tidx();
  const int wid = __builtin_amdgcn_readfirstlane(tid0 >> 6), lane = tid0 & 63, g = lane >> 3, i = lane & 7;
  const __amdgpu_buffer_rsrc_t U = __builtin_amdgcn_make_buffer_rsrc((void*)(p.u8 + (size_t)layer * NEXP * 768), (short)0, NEXP * 768, 0x00020000);
  const __amdgpu_buffer_rsrc_t V = __builtin_amdgcn_make_buffer_rsrc((void*)(p.v8 + (size_t)layer * NEXP * 768), (short)0, NEXP * 768, 0x00020000);
  const float* us = p.uscale + (size_t)layer * NEXP;
  const float* vs = p.vscale + (size_t)layer * NEXP;
  const float* modl = p.mod + (size_t)layer * 33 * MODW;
  LAS unsigned* lst = (LAS unsigned*)smem + wid * 3072;
#define PIECE(R, VOFF, K) __builtin_bit_cast(u32x4, __builtin_amdgcn_raw_buffer_load_b128(R, (VOFF) + (K) * 128, 0, 0))
  for (int grp = bid * 8 + wid; grp < ntok / 8; grp += nb * 8) {
    const int token0 = tok0 + grp * 8;
#pragma unroll 1
    for (int t = 0; t < 8; ++t) {
      const int token = token0 + t;
      const u32x2 se0 = p.sel[(size_t)token * 128 + lane], se1 = p.sel[(size_t)token * 128 + 64 + lane];
      const unsigned k0 = (se0.x << 7) | (unsigned)lane, k1 = (se1.x << 7) | (unsigned)(lane + 64);
      const float g0 = __uint_as_float(se0.y) * vs[se0.x], g1 = __uint_as_float(se1.y) * vs[se1.x];
      const float s0 = us[se0.x], s1 = us[se1.x];
      unsigned r0 = 0, r1 = 0;
      for (int q = 0; q < 64; ++q) {
        const unsigned b0 = (unsigned)__builtin_amdgcn_readlane((int)k0, q), b1 = (unsigned)__builtin_amdgcn_readlane((int)k1, q);
        r0 += (b0 < k0) ? 1u : 0u; r0 += (b1 < k0) ? 1u : 0u;
        r1 += (b0 < k1) ? 1u : 0u; r1 += (b1 < k1) ? 1u : 0u;
      }
      lst[t * 128 + r0] = k0; lst[t * 128 + r1] = k1;
      lst[1024 + t * 128 + r0] = __float_as_uint(g0); lst[1024 + t * 128 + r1] = __float_as_uint(g1);
      lst[2048 + t * 128 + r0] = __float_as_uint(s0); lst[2048 + t * 128 + r1] = __float_as_uint(s1);
    }
    const int token = token0 + g;
    {
      u32x4 x[4][4];
#pragma unroll
      for (int b = 0; b < 4; ++b) {
        const bf16_t* xr = p.act + (size_t)token * D + b * 256 + i * 32;
#pragma unroll
        for (int q = 0; q < 4; ++q) x[b][q] = *(const u32x4*)(xr + q * 8);
      }
      constexpr int NB1 = 4;
      u32x4 pk[NB1][6];
#pragma unroll
      for (int s = 0; s < NB1; ++s) {
        const int voff = (int)((lst[g * 128 + s] >> 7) * 768u) + i * 16;
#pragma unroll
        for (int k = 0; k < 6; ++k) pk[s][k] = PIECE(U, voff, k);
      }
#define P1_BLOCK(B, W0, W1, W2, W3, W4, W5)                                                                              \
      do {                                                                                                               \
        u32x6 w6; w6[0] = (W0); w6[1] = (W1); w6[2] = (W2); w6[3] = (W3); w6[4] = (W4); w6[5] = (W5);                    \
        const u32x16 bw = __builtin_bit_cast(u32x16, __builtin_amdgcn_cvt_scalef32_pk32_bf16_fp6(w6, 1.0f));             \
        _Pragma("unroll") for (int q = 0; q < 4; ++q) {                                                                  \
          const u32x4 xv = x[B][q];                                                                                      \
          const unsigned b0 = bw[4 * q], b1 = bw[4 * q + 1], b2 = bw[4 * q + 2], b3 = bw[4 * q + 3];                     \
          const unsigned x0 = xv[0], x1 = xv[1], x2 = xv[2], x3 = xv[3];                                                 \
          d0 = dot2u(b0, x0, d0); d1 = dot2u(b1, x1, d1); d2 = dot2u(b2, x2, d2); d3 = dot2u(b3, x3, d3);                \
        }                                                                                                                \
      } while (0)
#define P1_STEP(S, J)                                                                                                    \
      do {                                                                                                               \
        const int jn = (J) + NB1 < 128 ? (J) + NB1 : 127;                                                                \
        const int voffn = (int)((lst[g * 128 + jn] >> 7) * 768u) + i * 16;                                               \
        const float su = __uint_as_float(lst[2048 + g * 128 + (J)]), gsv = __uint_as_float(lst[1024 + g * 128 + (J)]);   \
        float d0 = 0.f, d1 = 0.f, d2 = 0.f, d3 = 0.f;                                                                    \
        P1_BLOCK(0, pk[S][0][0], pk[S][0][1], pk[S][0][2], pk[S][0][3], pk[S][1][0], pk[S][1][1]);                       \
        P1_BLOCK(1, pk[S][1][2], pk[S][1][3], pk[S][2][0], pk[S][2][1], pk[S][2][2], pk[S][2][3]);                       \
        pk[S][0] = PIECE(U, voffn, 0); pk[S][1] = PIECE(U, voffn, 1); pk[S][2] = PIECE(U, voffn, 2);                     \
        __builtin_amdgcn_sched_barrier(0);                                                                               \
        P1_BLOCK(2, pk[S][3][0], pk[S][3][1], pk[S][3][2], pk[S][3][3], pk[S][4][0], pk[S][4][1]);                       \
        P1_BLOCK(3, pk[S][4][2], pk[S][4][3], pk[S][5][0], pk[S][5][1], pk[S][5][2], pk[S][5][3]);                       \
        pk[S][3] = PIECE(U, voffn, 3); pk[S][4] = PIECE(U, voffn, 4); pk[S][5] = PIECE(U, voffn, 5);                     \
        __builtin_amdgcn_sched_barrier(0);                                                                               \
        const float d = group8_sum((d0 + d1) + (d2 + d3)) * su;                                                          \
        lst[1024 + g * 128 + (J)] = __float_as_uint(gsv * gelu_as(d));                                                   \
      } while (0)
#pragma unroll 1
      for (int j = 0; j < 128; j += 4) { P1_STEP(0, j); P1_STEP(1, j + 1); P1_STEP(2, j + 2); P1_STEP(3, j + 3); }
#undef P1_STEP
#undef P1_BLOCK
    }
    const bool isctx = token < NCTX;
    const int b = isctx ? 32 : ((token - NCTX) >> 11);
    const float* g2 = modl + (size_t)b * MODW + 5 * D + i * 32;
    float* hrow = (isctx ? p.hctx + (size_t)token * D : p.out + (size_t)(token - NCTX) * D) + i * 32;
    float ss = 0.f;
#pragma unroll 1
    for (int hf = 0; hf < 2; ++hf) {
      f32x32 y0, y1;
#pragma unroll
      for (int c = 0; c < 32; ++c) { y0[c] = 0.f; y1[c] = 0.f; }
      const int hoff = hf * 384 + i * 16;
      constexpr int NB2 = 8;
      u32x4 pk[NB2][3];
#pragma unroll
      for (int s = 0; s < NB2; ++s) {
        const int voff = (int)((lst[g * 128 + s] >> 7) * 768u) + hoff;
#pragma unroll
        for (int k = 0; k < 3; ++k) pk[s][k] = PIECE(V, voff, k);
      }
#define P2_STEP(S, J)                                                                                                    \
      do {                                                                                                               \
        const int jn = (J) + NB2 < 128 ? (J) + NB2 : 127;                                                                \
        const int voffn = (int)((lst[g * 128 + jn] >> 7) * 768u) + hoff;                                                 \
        const float a = __uint_as_float(lst[1024 + g * 128 + (J)]);                                                      \
        {                                                                                                                \
          u32x6 w6; w6[0] = pk[S][0][0]; w6[1] = pk[S][0][1]; w6[2] = pk[S][0][2]; w6[3] = pk[S][0][3]; w6[4] = pk[S][1][0]; w6[5] = pk[S][1][1]; \
          const f32x32 f = __builtin_amdgcn_cvt_scalef32_pk32_f32_fp6(w6, 1.0f);                                         \
          y0 += f * a;                                                                                                   \
        }                                                                                                                \
        __builtin_amdgcn_sched_barrier(0);                                                                               \
        {                                                                                                                \
          u32x6 w6; w6[0] = pk[S][1][2]; w6[1] = pk[S][1][3]; w6[2] = pk[S][2][0]; w6[3] = pk[S][2][1]; w6[4] = pk[S][2][2]; w6[5] = pk[S][2][3]; \
          const f32x32 f = __builtin_amdgcn_cvt_scalef32_pk32_f32_fp6(w6, 1.0f);                                         \
          y1 += f * a;                                                                                                   \
        }                                                                                                                \
        pk[S][0] = PIECE(V, voffn, 0); pk[S][1] = PIECE(V, voffn, 1); pk[S][2] = PIECE(V, voffn, 2);                     \
        __builtin_amdgcn_sched_barrier(0);                                                                               \
      } while (0)
#pragma unroll 1
      for (int j = 0; j < 128; j += 8) { P2_STEP(0, j); P2_STEP(1, j + 1); P2_STEP(2, j + 2); P2_STEP(3, j + 3); P2_STEP(4, j + 4); P2_STEP(5, j + 5); P2_STEP(6, j + 6); P2_STEP(7, j + 7); }
#undef P2_STEP
#ifdef ZERO_PEER
      if (layer == ZERO_PEER) {
#pragma unroll
        for (int c = 0; c < 32; ++c) { y0[c] = 0.f; y1[c] = 0.f; }
      }
#endif
#pragma unroll
      for (int bb = 0; bb < 2; ++bb)
#pragma unroll
        for (int q4 = 0; q4 < 8; ++q4) {
          const int co = (2 * hf + bb) * 256 + q4 * 4;
          const f32x4 hv = *(const f32x4*)(hrow + co), gv = *(const f32x4*)(g2 + co);
          f32x4 o;
#pragma unroll
          for (int e = 0; e < 4; ++e) { const float yv = bb ? y1[q4 * 4 + e] : y0[q4 * 4 + e]; const float v = hv[e] + gv[e] * yv; o[e] = v; ss += v * v; }
          *(f32x4*)(hrow + co) = o;
        }
    }
    {
      ss = group8_sum(ss);
      const float rstd = rsqrtf(ss * (1.f / D) + EPS);
      if (layer == 0) {
        const float* modn = p.mod + (size_t)33 * MODW + (size_t)b * MODW + i * 32;
        const float* gain = p.mix_g + D + i * 32;
#pragma unroll 2
        for (int k = 0; k < 16; ++k) {
          const int co = (k >> 2) * 256 + (k & 3) * 8;
          u32x4 w;
#pragma unroll
          for (int q4 = 0; q4 < 2; ++q4) {
            const f32x4 hv = *(const f32x4*)(hrow + co + q4 * 4);
            const f32x4 gg = *(const f32x4*)(gain + co + q4 * 4), s0 = *(const f32x4*)(modn + co + q4 * 4), s1 = *(const f32x4*)(modn + D + co + q4 * 4);
            f32x4 yv = hv * rstd * gg;
            yv = yv * (1.f + s1) + s0;
            w[q4 * 2] = cvt_pk_bf16(yv[0], yv[1]); w[q4 * 2 + 1] = cvt_pk_bf16(yv[2], yv[3]);
          }
          *(u32x4*)(p.act + (size_t)token * D + i * 32 + co) = w;
        }
      } else {
        const float* gain = p.final_g + i * 32;
#pragma unroll 2
        for (int k = 0; k < 32; ++k) {
          const int co = (k >> 3) * 256 + (k & 7) * 4;
          const f32x4 hv = *(const f32x4*)(hrow + co), gg = *(const f32x4*)(gain + co);
          *(f32x4*)(hrow + co) = hv * rstd * gg;
        }
      }
    }
    __syncthreads();
  }
#undef PIECE
}

constexpr int NPH = 18;
template <int PH>
__device__ __forceinline__ void run_phase(const Params& p, unsigned char* smem, int bid, int nb) {
  if constexpr (PH == 0) phase_prep(p, smem, bid, nb);
  else if constexpr (PH == 1) phase_norm(p, bid, nb, 0, NTOK, p.ctx, p.x, p.mix_g, p.mod, 0, 1);
  else if constexpr (PH == 2) phase_gemm_inproj(p, smem, bid, nb, 0);
  else if constexpr (PH == 3) phase_ret_kv(p, smem, bid, nb);
  else if constexpr (PH == 4) phase_ret_scan(p, bid, nb);
  else if constexpr (PH == 5) phase_ret_out(p, smem, bid, nb);
  else if constexpr (PH == 6) phase_gemm_outproj(p, smem, bid, nb, 0);
  else if constexpr (PH == 7) phase_resid_norm(p, bid, nb, 0, NTOK, p.ctx, p.x, p.ffn_g, p.mod);
  else if constexpr (PH == 8) phase_gemm_pq(p, smem, bid, nb, 0);
  else if constexpr (PH == 9) phase_peer_topk(p, smem, bid, nb, 0, 0, NTOK);
  else if constexpr (PH == 10) phase_peer_gather(p, smem, bid, nb, 0, 0, NTOK);
  else if constexpr (PH == 11) phase_gemm_inproj(p, smem, bid, nb, 1);
  else if constexpr (PH == 12) phase_attn<0>(p, smem, bid, nb, p.act);
  else if constexpr (PH == 13) phase_gemm_outproj(p, smem, bid, nb, 1);
  else if constexpr (PH == 14) phase_resid_norm(p, bid, nb, NCTX, NTOK, p.hctx, p.out, p.ffn_g + D, p.mod + (size_t)33 * MODW);
  else if constexpr (PH == 15) phase_gemm_pq(p, smem, bid, nb, 1);
  else if constexpr (PH == 16) phase_peer_topk(p, smem, bid, nb, 1, NCTX, NLAT);
  else if constexpr (PH == 17) phase_peer_gather(p, smem, bid, nb, 1, NCTX, NLAT);
}
template <int PH>
__global__ void __launch_bounds__(NTHREADS) phase_k(Params p) {
  extern __shared__ __attribute__((aligned(16))) unsigned char smem[];
  run_phase<PH>(p, smem, blockIdx.x, gridDim.x);
}
#define XB_TMO      128
#define XB_XCNT(j)  (256  + 64 * (j))
#define XB_XSUB(j)  (1280 + 64 * (j))
#define XB_XGEN(j)  (2304 + 64 * (j))
#define XB_TOP      3328
#define XB_TOPGEN   3392
#define XCD_BAR_WORDS 3456
#define XB_SPIN_CAP (1u << 22)
__device__ __forceinline__ unsigned xb_ld(unsigned* p)              { return __hip_atomic_load(p, __ATOMIC_RELAXED, __HIP_MEMORY_SCOPE_AGENT); }
__device__ __forceinline__ unsigned xb_add(unsigned* p, unsigned v) { return __hip_atomic_fetch_add(p, v, __ATOMIC_RELAXED, __HIP_MEMORY_SCOPE_AGENT); }
__device__ __forceinline__ unsigned xb_xcc_id() { return (unsigned)__builtin_amdgcn_s_getreg((3 << 11) | 20) & 0xFu; }
#define XB_SPIN(cond, bar) do { unsigned _sp = 0; while (cond) { __builtin_amdgcn_s_sleep(1); \
    if ((++_sp & 255u) == 0u) { if (xb_ld(&(bar)[XB_TMO])) break; if (_sp > XB_SPIN_CAP) { atomicAdd(&(bar)[XB_TMO], 1u); break; } } } } while (0)
struct XcdBarrier { unsigned* bar; unsigned x; volatile LAS unsigned* st; };
__device__ __forceinline__ XcdBarrier xcd_barrier_post(unsigned* bar, volatile LAS unsigned* st) {
  XcdBarrier b; b.bar = bar; b.x = xb_xcc_id(); b.st = st;
  if (threadIdx.x == 0) (void)xb_add(&bar[XB_XCNT(b.x)], 1u);
  return b;
}
__device__ __forceinline__ void xcd_barrier_complete(unsigned* bar, unsigned x, unsigned& nloc, unsigned& nx) {
  const unsigned G = gridDim.x * gridDim.y * gridDim.z;
  unsigned sum, cnt, mine, sp = 0u;
  for (;;) {
    sum = 0u; cnt = 0u; mine = 0u;
#pragma unroll
    for (unsigned j = 0; j < 16; ++j) { const unsigned c = xb_ld(&bar[XB_XCNT(j)]); sum += c; cnt += (c > 0u) ? 1u : 0u; mine = (j == x) ? c : mine; }
    if (sum == G) break;
    __builtin_amdgcn_s_sleep(1);
    if ((++sp & 255u) == 0u) { if (xb_ld(&bar[XB_TMO])) break; if (sp > XB_SPIN_CAP) { atomicAdd(&bar[XB_TMO], 1u); break; } }
  }
  nloc = mine > 0u ? mine : 1u; nx = cnt > 0u ? cnt : 1u;
}
__device__ __forceinline__ void xcd_barrier(const XcdBarrier& b) {
  asm volatile("s_waitcnt vmcnt(0)" ::: "memory");
  __syncthreads();
  if (threadIdx.x == 0) {
    unsigned* bar = b.bar;
    __builtin_amdgcn_s_waitcnt(0);
    unsigned nloc = b.st[0], nx = b.st[1];
    if (nloc == 0u) { xcd_barrier_complete(bar, b.x, nloc, nx); b.st[0] = nloc; b.st[1] = nx; }
    const unsigned old = xb_add(&bar[XB_XSUB(b.x)], 1u);
    const unsigned gen = old / nloc;
    if (old + 1u == (gen + 1u) * nloc) {
      __builtin_amdgcn_fence(__ATOMIC_RELEASE, "agent");
      asm volatile("s_waitcnt vmcnt(0)" ::: "memory");
      const unsigned og = xb_add(&bar[XB_TOP], 1u);
      const unsigned tg = og / nx;
      if (og + 1u == (tg + 1u) * nx) xb_add(&bar[XB_TOPGEN], 1u);
      else XB_SPIN(xb_ld(&bar[XB_TOPGEN]) == tg, bar);
      __builtin_amdgcn_fence(__ATOMIC_ACQUIRE, "agent");
      xb_add(&bar[XB_XGEN(b.x)], 1u);
      asm volatile("s_waitcnt vmcnt(0)" ::: "memory");
    } else {
      XB_SPIN(xb_ld(&bar[XB_XGEN(b.x)]) == gen, bar);
      __builtin_amdgcn_fence(__ATOMIC_ACQUIRE, "agent");
      asm volatile("s_waitcnt vmcnt(0)" ::: "memory");
    }
  }
  __syncthreads();
}

#if MK_ONE_LAUNCH
constexpr int PARAMS_OFF = LDS_BYTES - 512;
static_assert(sizeof(Params) <= 480, "params block");
template <class T>
__device__ __forceinline__ T* uni(T* q) {
  const unsigned long long v = (unsigned long long)q;
  const unsigned lo = __builtin_amdgcn_readfirstlane((unsigned)v), hi = __builtin_amdgcn_readfirstlane((unsigned)(v >> 32));
  return (T*)(((unsigned long long)hi << 32) | lo);
}
__device__ __forceinline__ Params load_params(const unsigned char* smem) {
  const Params* l = (const Params*)(smem + PARAMS_OFF);
  Params q;
  q.x = uni(l->x); q.c = uni(l->c); q.ctx = uni(l->ctx); q.c_ctx = uni(l->c_ctx); q.ada_w = uni(l->ada_w); q.ada_b = uni(l->ada_b);
  q.mix_g = uni(l->mix_g); q.ffn_g = uni(l->ffn_g); q.ev_w_in = uni(l->ev_w_in); q.ev_w_out = uni(l->ev_w_out);
  q.logit_f = uni(l->logit_f); q.logit_b = uni(l->logit_b); q.conv_w = uni(l->conv_w); q.od_w_in = uni(l->od_w_in);
  q.od_w_out = uni(l->od_w_out); q.sinks = uni(l->sinks); q.peer_wq = uni(l->peer_wq); q.keys1 = uni(l->keys1); q.keys2 = uni(l->keys2);
  q.peer_u = uni(l->peer_u); q.peer_v = uni(l->peer_v); q.final_g = uni(l->final_g); q.out = uni(l->out); q.mod = uni(l->mod);
  q.ropec = uni(l->ropec); q.ropes = uni(l->ropes); q.winT0 = uni(l->winT0); q.woutT0 = uni(l->woutT0); q.winT1 = uni(l->winT1);
  q.woutT1 = uni(l->woutT1); q.wqT = uni(l->wqT); q.u8 = uni(l->u8); q.v8 = uni(l->v8); q.uscale = uni(l->uscale); q.vscale = uni(l->vscale); q.hctx = uni(l->hctx); q.act = uni(l->act);
  q.proj = uni(l->proj); q.pq = uni(l->pq); q.sel = uni(l->sel); q.kv = uni(l->kv); q.sprev = uni(l->sprev); q.bar = uni(l->bar); q.keysb = uni(l->keysb);
  return q;
}
template <int PH>
__device__ __forceinline__ void run_from(unsigned char* smem, int bid, int nb, const XcdBarrier& xb) {
  {
    const Params q = load_params(smem);
    run_phase<PH>(q, smem, bid, nb);
  }
#ifdef DUP_PH
  if constexpr (PH == DUP_PH) {
    xcd_barrier(xb);
    const Params q = load_params(smem);
#ifdef DUP_ATTN_VAR
    phase_attn<DUP_ATTN_VAR>(q, smem, bid, nb, q.proj + (size_t)113246208);
#else
    run_phase<PH>(q, smem, bid, nb);
#endif
  }
#endif
  if constexpr (PH + 1 < NPH) {
    if constexpr (PH == 0) cg::this_grid().sync();
    else xcd_barrier(xb);
    run_from<PH + 1>(smem, bid, nb, xb);
  }
}
__global__ void __launch_bounds__(NTHREADS) mega(Params p) {
  extern __shared__ __attribute__((aligned(16))) unsigned char smem[];
  volatile LAS unsigned* st = (volatile LAS unsigned*)((LAS unsigned char*)smem + PARAMS_OFF + 480);
  if (threadIdx.x == 0) { *(Params*)(smem + PARAMS_OFF) = p; st[0] = 0u; st[1] = 0u; }
  __syncthreads();
  const XcdBarrier xb = xcd_barrier_post(p.bar, st);
  run_from<0>(smem, blockIdx.x, gridDim.x, xb);
}
#endif
#ifndef DBG_NPH
#define DBG_NPH 0
#endif
#if DBG_NPH
__global__ void __launch_bounds__(NTHREADS) dbg_sums(Params p, float* scr, int nph) {
  const int wid = threadIdx.x >> 6, lane = threadIdx.x & 63;
  const int gw = blockIdx.x * 8 + wid, nw = gridDim.x * 8;
  if (nph >= 2) for (int r = gw; r < NTOK; r += nw) { float s = 0.f; for (int c = lane; c < D; c += 64) s += bf2f(p.act[(size_t)r * D + c]) * (1 + (c & 7)); s = wave_sum(s); if (lane == 0) scr[r] = s; }
  if (nph >= 3 && nph <= 8) for (int r = gw; r < NTOK; r += nw) { float s = 0.f; for (int c = lane; c < 3072; c += 64) s += bf2f(p.proj[(size_t)r * 3072 + c]) * (1 + (c & 7)); s = wave_sum(s); if (lane == 0) scr[(1 << 20) + r] = s; }
  if (nph >= 12 && nph <= 15) for (int r = gw; r < NTOK; r += nw) { float s = 0.f; for (int c = lane + (r < NCTX ? 1024 : 0); c < 1536; c += 64) s += bf2f(p.proj[(size_t)r * 1536 + c]) * (1 + (c & 7)); s = wave_sum(s); if (lane == 0) scr[(1 << 20) + r] = s; }
  if (nph >= 4) for (int r = gw; r < 2304 * 128; r += nw) { float s = 0.f; for (int c = lane; c < 128; c += 64) s += p.kv[(size_t)r * 128 + c] * (1 + (c & 7)); s = wave_sum(s); if (lane == 0) scr[(2 << 20) + r] = s; }
  if (nph >= 5) for (int r = gw; r < 2304 * 128; r += nw) { float s = 0.f; for (int c = lane; c < 128; c += 64) s += bf2f(p.sprev[(size_t)r * 128 + c]) * (1 + (c & 7)); s = wave_sum(s); if (lane == 0) scr[(3 << 20) + r] = s; }
  if (nph >= 7) for (int r = gw; r < NCTX; r += nw) { float s = 0.f; for (int c = lane; c < D; c += 64) s += p.hctx[(size_t)r * D + c] * (1 + (c & 7)); s = wave_sum(s); if (lane == 0) scr[(4 << 20) + r] = s; }
  if (nph >= 1) for (int i = blockIdx.x * NTHREADS + threadIdx.x; i < 2 * 33 * MODW; i += gridDim.x * NTHREADS) scr[(5 << 20) + i] = p.mod[i];
  if (nph >= 7) for (int r = gw; r < NLAT; r += nw) { float s = 0.f; for (int c = lane; c < D; c += 64) s += p.out[(size_t)r * D + c] * (1 + (c & 7)); s = wave_sum(s); if (lane == 0) scr[(6 << 20) + r] = s; }
  if (nph >= 10 && nph <= 11) for (int r = gw; r < NTOK; r += nw) { float s = 0.f; for (int c = lane; c < 128; c += 64) { const u32x2 e = p.sel[(size_t)r * 128 + c]; s += __uint_as_float(e.y) * (float)(e.x & 1023); } s = wave_sum(s); if (lane == 0) scr[(7 << 20) + r] = s; }
}
__global__ void __launch_bounds__(NTHREADS) dbg_out(Params p, const float* scr) {
  for (size_t i = (size_t)blockIdx.x * NTHREADS + threadIdx.x; i < (size_t)NLAT * D; i += (size_t)gridDim.x * NTHREADS) p.out[i] = (i < (size_t)(8 << 20)) ? scr[i] : 0.f;
}
__global__ void __launch_bounds__(NTHREADS) dbg_zero(float* scr) {
  for (size_t i = (size_t)blockIdx.x * NTHREADS + threadIdx.x; i < (size_t)(8 << 20); i += (size_t)gridDim.x * NTHREADS) scr[i] = 0.f;
}
#endif
template <int PH>
static void launch_phases(const Params& p, int grid, hipStream_t stream) {
  static bool attr_set = false;
  if (!attr_set) { (void)hipFuncSetAttribute((const void*)phase_k<PH>, hipFuncAttributeMaxDynamicSharedMemorySize, LDS_BYTES); attr_set = true; }
  phase_k<PH><<<grid, NTHREADS, LDS_BYTES, stream>>>(p);
  if constexpr (PH + 1 < (DBG_NPH ? DBG_NPH : NPH)) launch_phases<PH + 1>(p, grid, stream);
}

extern "C" void kernel_launch(void* const* d_in, const int* in_sizes, int n_in, void* d_out, int out_size, void* d_ws,
                              size_t ws_size, hipStream_t stream) {
  Params p{};
  const float* const* in = (const float* const*)d_in;
  p.x = in[0]; p.c = in[1]; p.ctx = in[2]; p.c_ctx = in[3]; p.ada_w = in[4]; p.ada_b = in[5]; p.mix_g = in[6]; p.ffn_g = in[7];
  p.ev_w_in = in[8]; p.ev_w_out = in[9]; p.logit_f = in[10]; p.logit_b = in[11]; p.conv_w = in[12]; p.od_w_in = in[13];
  p.od_w_out = in[14]; p.sinks = in[15]; p.peer_wq = in[16]; p.keys1 = in[17]; p.keys2 = in[18]; p.peer_u = in[19];
  p.peer_v = in[20]; p.final_g = in[21];
  p.out = (float*)d_out;
  unsigned char* w = (unsigned char*)d_ws;
  size_t off = 0;
  auto take = [&](size_t bytes) { unsigned char* r = w + off; off += (bytes + 255) & ~(size_t)255; return r; };
  p.mod = (float*)take((size_t)2 * 33 * MODW * 4);
  p.ropec = (float*)take(1024 * 4);
  p.ropes = (float*)take(1024 * 4);
  p.winT0 = (bf16_t*)take((size_t)3072 * 1024 * 2);
  p.woutT0 = (bf16_t*)take((size_t)1024 * 1024 * 2);
  p.winT1 = (bf16_t*)take((size_t)1536 * 1024 * 2);
  p.woutT1 = (bf16_t*)take((size_t)1024 * 1024 * 2);
  p.wqT = (bf16_t*)take((size_t)2 * 1024 * 1024 * 2);
  p.u8 = (unsigned char*)take((size_t)2 * NEXP * 768);
  p.v8 = (unsigned char*)take((size_t)2 * NEXP * 768);
  p.uscale = (float*)take((size_t)2 * NEXP * 4);
  p.vscale = (float*)take((size_t)2 * NEXP * 4);
  p.hctx = (float*)take((size_t)NCTX * D * 4);
  p.act = (bf16_t*)take((size_t)NTOK * D * 2);
  p.kv = (float*)take((size_t)2304 * 16384 * 4);
  p.sprev = (bf16_t*)take((size_t)2304 * 16384 * 2);
  p.bar = (unsigned*)take((size_t)XCD_BAR_WORDS * 4);
  p.keysb = (bf16_t*)take((size_t)2 * 8 * 2 * 2 * 128 * 64 * 2);
  p.proj = (bf16_t*)take((size_t)NTOK * 3072 * 2);
  p.pq = p.proj;
  p.sel = (u32x2*)((unsigned char*)p.proj + (size_t)NTOK * D * 2);
  if (off > ws_size) { fprintf(stderr, "workspace too small: need %zu have %zu\n", off, ws_size); }

  int grid = 256;
#if MK_ONE_LAUNCH
  static int grid_blocks = 0;
  if (!grid_blocks) {
    (void)hipFuncSetAttribute((const void*)mega, hipFuncAttributeMaxDynamicSharedMemorySize, LDS_BYTES);
    int dev = 0, cus = 0, per_cu = 0;
    (void)hipGetDevice(&dev);
    (void)hipDeviceGetAttribute(&cus, hipDeviceAttributeMultiprocessorCount, dev);
    (void)hipOccupancyMaxActiveBlocksPerMultiprocessor(&per_cu, mega, NTHREADS, LDS_BYTES);
    if (per_cu > 1) per_cu = 1;
    grid_blocks = cus * per_cu;
    if (grid_blocks <= 0) grid_blocks = 256;
  }
  grid = grid_blocks;
  (void)hipMemsetAsync(p.bar, 0, (size_t)XCD_BAR_WORDS * 4, stream);
  void* args[] = {&p};
  hipError_t e = hipLaunchCooperativeKernel((const void*)mega, dim3(grid), dim3(NTHREADS), args, LDS_BYTES, stream);
  if (e != hipSuccess) fprintf(stderr, "cooperative launch failed: %s\n", hipGetErrorString(e));
#else
  launch_phases<0>(p, grid, stream);
#if DBG_NPH
  float* scr = (float*)(w + off);
  dbg_zero<<<grid, NTHREADS, 0, stream>>>(scr);
  dbg_sums<<<grid, NTHREADS, 0, stream>>>(p, scr, DBG_NPH);
  dbg_out<<<grid, NTHREADS, 0, stream>>>(p, scr);
#endif
#endif
}
```

```cpp
#include <hip/hip_runtime.h>
#include <hip/hip_cooperative_groups.h>
#include <cstdio>
#include <cstdint>
namespace cg = cooperative_groups;

#ifndef MK_ONE_LAUNCH
#define MK_ONE_LAUNCH 1
#endif

typedef unsigned short bf16_t;
typedef short bf16x8 __attribute__((ext_vector_type(8)));
typedef short bf16x2v __attribute__((ext_vector_type(2)));
typedef float f32x4 __attribute__((ext_vector_type(4)));
typedef unsigned u32x4 __attribute__((ext_vector_type(4)));
typedef unsigned u32x2 __attribute__((ext_vector_type(2)));
typedef unsigned u32x6 __attribute__((ext_vector_type(6)));
typedef unsigned u32x16 __attribute__((ext_vector_type(16)));
typedef float f32x32 __attribute__((ext_vector_type(32)));
typedef __bf16 bf16x32n __attribute__((ext_vector_type(32)));

constexpr int D = 1024, BATCH = 32, SEQ = 2048, CTXL = 256;
constexpr int NCTX = BATCH * CTXL;
constexpr int NLAT = BATCH * SEQ;
constexpr int NTOK = NCTX + NLAT;
constexpr int MODW = 6 * D;
constexpr int NEXP = 16384;
constexpr float EPS = 1e-6f;
constexpr int NTHREADS = 512;
constexpr int LDS_BYTES = 140 * 1024;

struct Params {
  const float *x, *c, *ctx, *c_ctx, *ada_w, *ada_b, *mix_g, *ffn_g, *ev_w_in, *ev_w_out, *logit_f, *logit_b, *conv_w,
      *od_w_in, *od_w_out, *sinks, *peer_wq, *keys1, *keys2, *peer_u, *peer_v, *final_g;
  float* out;
  float* mod;
  float* ropec;
  float* ropes;
  bf16_t* winT0;
  bf16_t* woutT0;
  bf16_t* winT1;
  bf16_t* woutT1;
  bf16_t* wqT;
  unsigned char* u8;
  unsigned char* v8;
  float* uscale;
  float* vscale;
  float* hctx;
  bf16_t* act;
  bf16_t* proj;
  bf16_t* pq;
  u32x2* sel;
  float* kv;
  bf16_t* sprev;
  bf16_t* keysb;
  unsigned* bar;
};

typedef __bf16 bf16x2n __attribute__((ext_vector_type(2)));
typedef float f32x2 __attribute__((ext_vector_type(2)));
__device__ __forceinline__ unsigned cvt_pk_bf16(float lo, float hi) {
  f32x2 v = {lo, hi};
  return __builtin_bit_cast(unsigned, __builtin_convertvector(v, bf16x2n));
}
__device__ __forceinline__ float bf_lo(unsigned u) { return __uint_as_float(u << 16); }
__device__ __forceinline__ float bf_hi(unsigned u) { return __uint_as_float(u & 0xffff0000u); }
__device__ __forceinline__ float bf2f(bf16_t h) { return __uint_as_float(((unsigned)h) << 16); }
__device__ __forceinline__ bf16_t f2bf(float f) { return __builtin_bit_cast(unsigned short, (__bf16)f); }

template <int CTRL>
__device__ __forceinline__ float dppf(float x) {
  return __builtin_bit_cast(float, __builtin_amdgcn_mov_dpp(__builtin_bit_cast(int, x), CTRL, 0xf, 0xf, true));
}
template <int CTRL>
__device__ __forceinline__ unsigned dppu(unsigned x) { return (unsigned)__builtin_amdgcn_mov_dpp((int)x, CTRL, 0xf, 0xf, true); }
__device__ __forceinline__ float row16_sum(float x) {
  x += dppf<0xB1>(x); x += dppf<0x4E>(x); x += dppf<0x141>(x); x += dppf<0x128>(x);
  return x;
}
__device__ __forceinline__ float row16_max(float x) {
  x = fmaxf(x, dppf<0xB1>(x)); x = fmaxf(x, dppf<0x4E>(x)); x = fmaxf(x, dppf<0x141>(x)); x = fmaxf(x, dppf<0x128>(x));
  return x;
}
__device__ __forceinline__ float xrow16_sum(float x) {
  auto s = __builtin_amdgcn_permlane16_swap(__float_as_uint(x), __float_as_uint(x), false, false);
  x = __uint_as_float(s[0]) + __uint_as_float(s[1]);
  auto t = __builtin_amdgcn_permlane32_swap(__float_as_uint(x), __float_as_uint(x), false, false);
  return __uint_as_float(t[0]) + __uint_as_float(t[1]);
}
__device__ __forceinline__ float wave_sum(float x) { return xrow16_sum(row16_sum(x)); }
__device__ __forceinline__ float wave_max(float x) {
  x = row16_max(x);
  auto s = __builtin_amdgcn_permlane16_swap(__float_as_uint(x), __float_as_uint(x), false, false);
  x = fmaxf(__uint_as_float(s[0]), __uint_as_float(s[1]));
  auto t = __builtin_amdgcn_permlane32_swap(__float_as_uint(x), __float_as_uint(x), false, false);
  return fmaxf(__uint_as_float(t[0]), __uint_as_float(t[1]));
}

__device__ __forceinline__ int tidx() {
  int t = threadIdx.x;
  asm volatile("" : "+v"(t));
  __builtin_assume(t >= 0 && t < NTHREADS);
  return t;
}
__device__ __forceinline__ float siluf(float v) { return v / (1.f + __expf(-v)); }
__device__ __forceinline__ float log_sigmoidf(float v) { return -log1pf(expf(-v)); }

#define LAS __attribute__((address_space(3)))
constexpr int BM = 256, BK = 64, HALF = 128, HTB = HALF * BK * 2, NXCD = 8, WGM = 8;
constexpr int KDIM = 1024;

__device__ __forceinline__ int lds_byte(int r, int c) {
  const int st = (r >> 4) * 2 + (c >> 5), rr = r & 15, cc = c & 31, ob = rr * 64 + cc * 2;
  return st * 1024 + (ob ^ (((ob >> 9) & 1) << 5));
}
__device__ __forceinline__ void stage_rc(int b, int& R, int& C) {
  const int st = b / 1024, sb = b % 1024, swz = sb ^ (((sb >> 9) & 1) << 5);
  R = (st >> 1) * 16 + swz / 64;
  C = (st & 1) * 32 + (swz % 64) / 2;
}
__device__ __forceinline__ int perm32(int rho) { const int n = rho >> 4, i = rho & 15; return 8 * (i >> 2) + 4 * n + (i & 3); }
struct Sched {
  int pm0, pn0, nM, nN, G, c;
  __device__ __forceinline__ bool next(int i, int& pm, int& pn) const {
    const int nwg = nM * nN;
    const long L = (long)i * G + c;
    if (L >= nwg) return false;
    int wgid = (int)L;
    { const int q = nwg / NXCD, r = nwg % NXCD, xcd = wgid % NXCD, off = wgid / NXCD; wgid = (xcd < r ? xcd * (q + 1) : r * (q + 1) + (xcd - r) * q) + off; }
    const int nig = WGM * nN, gid = wgid / nig, fm = gid * WGM, gsz = (nM - fm) < WGM ? (nM - fm) : WGM;
    pm = pm0 + fm + ((wgid % nig) % gsz);
    pn = pn0 + (wgid % nig) / gsz;
    return true;
  }
};

template <class Epi>
__device__ __forceinline__ void gemm_phase(LAS unsigned char* lds, const bf16_t* __restrict__ Ag, const bf16_t* __restrict__ Btg, const Sched& S, const Epi& E) {
  const int tid = tidx(), wid = __builtin_amdgcn_readfirstlane(tid >> 6), lane = tid & 63, wr = wid >> 2, wc = wid & 3, fr = lane & 15, fq = lane >> 4;
  constexpr int K = KDIM, nt = K / BK;
  unsigned voffA[2], voffB[2];
#pragma unroll
  for (int i = 0; i < 2; ++i) { int R, C; stage_rc(tid * 16 + i * 8192, R, C); const int Rb = Epi::PERM ? ((R & ~31) + perm32(R & 31)) : R;
    voffA[i] = (unsigned)(R * K + C) * 2u; voffB[i] = (unsigned)(Rb * K + C) * 2u; }
  const size_t kstep = (size_t)(BK * 2);
  const size_t hstep = (size_t)HALF * K * 2;
  const size_t tstep = 2 * hstep;
  const unsigned ldsw = (unsigned)wid * 1024u;
  const int aoff = lds_byte(wr * 64 + fr, fq * 8), boff = lds_byte(wc * 32 + fr, fq * 8);
#define G_SA(b, h) (((b) * 2 + (h)) * HTB)
#define G_SB(b, h) ((4 + (b) * 2 + (h)) * HTB)
#define G_STAGEX(bufoff, gbase, VO) do { _Pragma("unroll") for (int _i = 0; _i < 2; ++_i) \
    __builtin_amdgcn_global_load_lds((const unsigned*)((const char*)(gbase) + VO[_i]), (LAS unsigned*)(lds + (bufoff) + ldsw + _i * 8192), 16, 0, 0); } while (0)
#define G_STAGE(bufoff, gbase) G_STAGEX(bufoff, gbase, voffA)
#define G_STAGEB(bufoff, gbase) G_STAGEX(bufoff, gbase, voffB)
#define G_LDA(dst, b, h) do { _Pragma("unroll") for (int m = 0; m < 4; ++m) _Pragma("unroll") for (int k = 0; k < 2; ++k) dst[m][k] = *(const LAS bf16x8*)(lds + G_SA(b, h) + aoff + m * 2048 + k * 1024); } while (0)
#define G_LDB(dst, b, h) do { _Pragma("unroll") for (int n = 0; n < 2; ++n) _Pragma("unroll") for (int k = 0; k < 2; ++k) dst[n][k] = *(const LAS bf16x8*)(lds + G_SB(b, h) + boff + n * 2048 + k * 1024); } while (0)
#define G_MMA(ai, bj, At, Bt) do { __builtin_amdgcn_s_setprio(1); _Pragma("unroll") for (int m = 0; m < 4; ++m) _Pragma("unroll") for (int n = 0; n < 2; ++n) _Pragma("unroll") for (int k = 0; k < 2; ++k) \
    acc[ai][bj][m][n] = __builtin_amdgcn_mfma_f32_16x16x32_bf16(Bt[n][k], At[m][k], acc[ai][bj][m][n], 0, 0, 0); __builtin_amdgcn_s_setprio(0); } while (0)
#define G_WAIT_V(n) asm volatile("s_waitcnt vmcnt(" #n ")" ::: "memory")
#define G_WAIT_L(n) asm volatile("s_waitcnt lgkmcnt(" #n ")" ::: "memory")
#define G_BAR __builtin_amdgcn_s_barrier()
#define G_SCHED __builtin_amdgcn_sched_barrier(0)
  int cpm, cpn, npm, npn, ui = 0;
  if (!S.next(0, cpm, cpn)) return;
  f32x4 acc[2][2][4][2];
#pragma unroll
  for (int a = 0; a < 2; ++a)
#pragma unroll
    for (int b = 0; b < 2; ++b)
#pragma unroll
      for (int m = 0; m < 4; ++m)
#pragma unroll
        for (int n = 0; n < 2; ++n) acc[a][b][m][n] = (f32x4){0.f, 0.f, 0.f, 0.f};
  bf16x8 At[4][2], B0[2][2], B1[2][2];
  const char* cA = (const char*)Ag + (size_t)cpm * tstep;
  const char* cB = (const char*)Btg + (size_t)cpn * tstep;
  G_STAGEB(G_SB(0, 0), cB); G_STAGE(G_SA(0, 0), cA); G_STAGEB(G_SB(0, 1), cB + hstep); G_STAGE(G_SA(0, 1), cA + hstep);
  if (wr == 1) G_BAR;
  G_WAIT_V(4); G_BAR;
  G_STAGEB(G_SB(1, 0), cB + kstep); G_STAGE(G_SA(1, 0), cA + kstep); G_STAGEB(G_SB(1, 1), cB + hstep + kstep);
  G_WAIT_V(6); G_BAR;
  for (;;) {
    const bool has_next = S.next(ui + 1, npm, npn);
    const char* nA = has_next ? (const char*)Ag + (size_t)npm * tstep : cA;
    const char* nB = has_next ? (const char*)Btg + (size_t)npn * tstep : cB;
    for (int t = 0; t < nt; t += 2) {
      const bool last = (t == nt - 2);
      const char* a1 = cA + (size_t)(t + 1) * kstep;
      const char* a2 = last ? nA : cA + (size_t)(t + 2) * kstep;
      const char* b2 = last ? nB : cB + (size_t)(t + 2) * kstep;
      const char* a3 = a2 + kstep;
      const char* b3 = b2 + kstep;
      G_LDB(B0, 0, 0); G_SCHED; G_LDA(At, 0, 0); G_STAGE(G_SA(1, 1), a1 + hstep);
      G_WAIT_L(8); G_BAR; G_WAIT_L(0); G_MMA(0, 0, At, B0); G_BAR; G_SCHED;
      G_LDB(B1, 0, 1); G_STAGEB(G_SB(0, 0), b2);
      G_BAR; G_WAIT_L(0); G_MMA(0, 1, At, B1); G_BAR;
      G_LDA(At, 0, 1); G_STAGE(G_SA(0, 0), a2);
      G_BAR; G_WAIT_L(0); G_MMA(1, 0, At, B0); G_BAR; G_SCHED;
      G_STAGEB(G_SB(0, 1), b2 + hstep);
      G_WAIT_V(6); G_BAR; G_MMA(1, 1, At, B1); G_BAR;
      G_LDB(B0, 1, 0); G_SCHED; G_LDA(At, 1, 0); G_STAGE(G_SA(0, 1), a2 + hstep);
      G_WAIT_L(8); G_BAR; G_WAIT_L(0); G_MMA(0, 0, At, B0); G_BAR; G_SCHED;
      G_LDB(B1, 1, 1); G_STAGEB(G_SB(1, 0), b3);
      G_BAR; G_WAIT_L(0); G_MMA(0, 1, At, B1); G_BAR;
      G_LDA(At, 1, 1); G_STAGE(G_SA(1, 0), a3);
      G_BAR; G_WAIT_L(0); G_MMA(1, 0, At, B0); G_BAR; G_SCHED;
      G_STAGEB(G_SB(1, 1), b3 + hstep);
      G_WAIT_V(6); G_BAR; G_MMA(1, 1, At, B1); G_BAR;
    }
    E(acc, cpm * BM, cpn * BM, wr, wc, fr, fq);
    if (!has_next) break;
#pragma unroll
    for (int a = 0; a < 2; ++a)
#pragma unroll
      for (int b = 0; b < 2; ++b)
#pragma unroll
        for (int m = 0; m < 4; ++m)
#pragma unroll
          for (int n = 0; n < 2; ++n) acc[a][b][m][n] = (f32x4){0.f, 0.f, 0.f, 0.f};
    cpm = npm; cpn = npn; cA = nA; cB = nB; ++ui;
  }
  G_WAIT_V(0);
  if (wr == 0) G_BAR;
  G_BAR;
#undef G_SA
#undef G_SB
#undef G_STAGE
#undef G_STAGEB
#undef G_STAGEX
#undef G_LDA
#undef G_LDB
#undef G_MMA
}

__device__ __forceinline__ f32x4 xlane32(const f32x4 v, const bool upper) {
  f32x4 r;
#pragma unroll
  for (int j = 0; j < 4; ++j) {
    const float x = v[j];
    auto t = __builtin_amdgcn_permlane32_swap(__float_as_uint(x), __float_as_uint(x), false, false);
    r[j] = __uint_as_float(upper ? t[0] : t[1]);
  }
  return r;
}
struct EpiInProj {
  static constexpr bool PERM = true;
  bf16_t* P; int ldc; int layer; const float* cosT; const float* sinT;
  __device__ __forceinline__ void operator()(const f32x4 (&acc)[2][2][4][2], int brow, int bcol, int wr, int wc, int fr, int fq) const {
#pragma unroll
    for (int bj = 0; bj < 2; ++bj) {
      const int colbase = bcol + bj * HALF + wc * 32;
      bool rope, scl;
      if (layer == 0) { rope = colbase < 512; scl = (colbase >= 256 && colbase < 512); }
      else { rope = colbase < 1280; scl = colbase < 1024; }
      const float sq = layer == 1 ? 0.125f * 1.44269504089f : 0.125f;
#pragma unroll
      for (int ai = 0; ai < 2; ++ai)
#pragma unroll
        for (int m = 0; m < 4; ++m) {
          const int row = brow + ai * HALF + wr * 64 + m * 16 + fr;
          f32x4 v0 = acc[ai][bj][m][0], v1 = acc[ai][bj][m][1];
          if (rope && brow >= NCTX) {
            const bool upper = fq >= 2;
            const f32x4 o0 = xlane32(v0, upper), o1 = xlane32(v1, upper);
            const int t = (row - NCTX) & (SEQ - 1);
            const int pos = (wc & 1) ? (t & 63) : (t >> 6);
            const float* ct = cosT + pos * 16 + (fq & 1) * 8;
            const float* st = sinT + pos * 16 + (fq & 1) * 8;
            const f32x4 c0 = *(const f32x4*)ct, c1 = *(const f32x4*)(ct + 4);
            f32x4 s0 = *(const f32x4*)st, s1 = *(const f32x4*)(st + 4);
            if (!upper) { s0 = -s0; s1 = -s1; }
            v0 = v0 * c0 + o0 * s0;
            v1 = v1 * c1 + o1 * s1;
          }
          if (scl) { v0 *= sq; v1 *= sq; }
          u32x4 w;
          w.x = cvt_pk_bf16(v0[0], v0[1]); w.y = cvt_pk_bf16(v0[2], v0[3]);
          w.z = cvt_pk_bf16(v1[0], v1[1]); w.w = cvt_pk_bf16(v1[2], v1[3]);
          *(u32x4*)(P + (size_t)row * ldc + colbase + fq * 8) = w;
        }
    }
  }
};
struct EpiBf16 {
  static constexpr bool PERM = true;
  bf16_t* P; int ldc;
  __device__ __forceinline__ void operator()(const f32x4 (&acc)[2][2][4][2], int brow, int bcol, int wr, int wc, int fr, int fq) const {
#pragma unroll
    for (int ai = 0; ai < 2; ++ai)
#pragma unroll
      for (int m = 0; m < 4; ++m) {
        const int row = brow + ai * HALF + wr * 64 + m * 16 + fr;
#pragma unroll
        for (int bj = 0; bj < 2; ++bj) {
          const f32x4 v0 = acc[ai][bj][m][0], v1 = acc[ai][bj][m][1];
          u32x4 w;
          w.x = cvt_pk_bf16(v0[0], v0[1]); w.y = cvt_pk_bf16(v0[2], v0[3]);
          w.z = cvt_pk_bf16(v1[0], v1[1]); w.w = cvt_pk_bf16(v1[2], v1[3]);
          *(u32x4*)(P + (size_t)row * ldc + bcol + bj * HALF + wc * 32 + fq * 8) = w;
        }
      }
  }
};
struct EpiGate {
  static constexpr bool PERM = true;
  bf16_t* M; const float* gate;
  __device__ __forceinline__ void operator()(const f32x4 (&acc)[2][2][4][2], int brow, int bcol, int wr, int wc, int fr, int fq) const {
    const int b = brow < NCTX ? 32 : ((brow - NCTX) >> 11);
    const float* g = gate + (size_t)b * MODW;
#pragma unroll
    for (int bj = 0; bj < 2; ++bj) {
      const int col = bcol + bj * HALF + wc * 32 + fq * 8;
      const f32x4 g0 = *(const f32x4*)(g + col), g1 = *(const f32x4*)(g + col + 4);
#pragma unroll
      for (int ai = 0; ai < 2; ++ai)
#pragma unroll
        for (int m = 0; m < 4; ++m) {
          const int row = brow + ai * HALF + wr * 64 + m * 16 + fr;
          const f32x4 v0 = acc[ai][bj][m][0] * g0, v1 = acc[ai][bj][m][1] * g1;
          u32x4 w;
          w.x = cvt_pk_bf16(v0[0], v0[1]); w.y = cvt_pk_bf16(v0[2], v0[3]);
          w.z = cvt_pk_bf16(v1[0], v1[1]); w.w = cvt_pk_bf16(v1[2], v1[3]);
          *(u32x4*)(M + (size_t)row * D + col) = w;
        }
    }
  }
};
struct EpiResid {
  static constexpr bool PERM = false;
  const float* hin_ctx; const float* hin_lat; float* hout_ctx; float* hout_lat; const float* gate;
  __device__ __forceinline__ void operator()(const f32x4 (&acc)[2][2][4][2], int brow, int bcol, int wr, int wc, int fr, int fq) const {
    const bool isctx = brow < NCTX;
    const int b = isctx ? 32 : ((brow - NCTX) >> 11);
    const float* hin = isctx ? hin_ctx + (size_t)brow * D : hin_lat + (size_t)(brow - NCTX) * D;
    float* hout = isctx ? hout_ctx + (size_t)brow * D : hout_lat + (size_t)(brow - NCTX) * D;
    const float* g = gate + (size_t)b * MODW;
#pragma unroll
    for (int bj = 0; bj < 2; ++bj)
#pragma unroll
      for (int n = 0; n < 2; ++n) {
        const int col = bcol + bj * HALF + wc * 32 + n * 16 + fq * 4;
        const f32x4 gv = *(const f32x4*)(g + col);
#pragma unroll
        for (int ai = 0; ai < 2; ++ai)
#pragma unroll
          for (int m = 0; m < 4; ++m) {
            const int r = ai * HALF + wr * 64 + m * 16 + fr;
            const f32x4 h = *(const f32x4*)(hin + (size_t)r * D + col);
            *(f32x4*)(hout + (size_t)r * D + col) = h + gv * acc[ai][bj][m][n];
          }
      }
  }
};

template <int MT, int NT>
__device__ __forceinline__ void mm_lds(const bf16_t* A, int lda, const bf16_t* B, int ldb, int K, f32x4 (&acc)[MT][NT], int fr, int fq) {
  for (int k0 = 0; k0 < K; k0 += 32) {
    bf16x8 af[MT], bf[NT];
#pragma unroll
    for (int m = 0; m < MT; ++m) af[m] = *(const bf16x8*)(A + (m * 16 + fr) * lda + k0 + fq * 8);
#pragma unroll
    for (int n = 0; n < NT; ++n) bf[n] = *(const bf16x8*)(B + (n * 16 + fr) * ldb + k0 + fq * 8);
#pragma unroll
    for (int m = 0; m < MT; ++m)
#pragma unroll
      for (int n = 0; n < NT; ++n) acc[m][n] = __builtin_amdgcn_mfma_f32_16x16x32_bf16(af[m], bf[n], acc[m][n], 0, 0, 0);
  }
}

__device__ void phase_prep(const Params& p, unsigned char* smem, int bid, int nb) {
  const int tid = tidx();
  for (int it = bid; it < 2 * 96; it += nb) {
    const int layer = it / 96, n0 = (it % 96) * 64;
    float* s = (float*)smem;
    for (int i = tid; i < 33 * 1024; i += NTHREADS) {
      const int b = i >> 10, k = i & 1023;
      const float v = (b < 32) ? p.c[b * 1024 + k] : p.c_ctx[k];
      s[k * 33 + b] = siluf(v);
    }
    __syncthreads();
    const int col = tid & 63, kg = tid >> 6;
    float acc[33];
#pragma unroll
    for (int b = 0; b < 33; ++b) acc[b] = 0.f;
    const float* W = p.ada_w + (size_t)layer * 1024 * MODW + n0 + col;
    for (int k = kg * 128; k < kg * 128 + 128; ++k) {
      const float w = W[(size_t)k * MODW];
      const float* sk = s + k * 33;
#pragma unroll
      for (int b = 0; b < 33; ++b) acc[b] += sk[b] * w;
    }
    __syncthreads();
    float* red = (float*)smem;
#pragma unroll
    for (int b = 0; b < 33; ++b) red[(kg * 33 + b) * 64 + col] = acc[b];
    __syncthreads();
    for (int i = tid; i < 33 * 64; i += NTHREADS) {
      const int b = i >> 6, cc = i & 63;
      float t = p.ada_b[layer * MODW + n0 + cc];
#pragma unroll
      for (int g = 0; g < 8; ++g) t += red[(g * 33 + b) * 64 + cc];
      p.mod[((size_t)layer * 33 + b) * MODW + n0 + cc] = t;
    }
    __syncthreads();
  }
  if (bid == nb - 1) {
    for (int i = tid; i < 1024; i += NTHREADS) {
      const int pos = i >> 4, f = i & 15;
      const float inv = powf(10000.f, -(float)f / 16.f);
      const float ang = (float)pos * inv;
      p.ropec[i] = cosf(ang);
      p.ropes[i] = sinf(ang);
    }
  }
  {
    float* tile = (float*)smem;
    const int ntile_total = 768 + 256 + 384 + 256 + 512;
    for (int it = bid; it < ntile_total; it += nb) {
      const float* src; bf16_t* dst; int N, ti;
      if (it < 768) { src = p.ev_w_in; dst = p.winT0; N = 3072; ti = it; }
      else if (it < 1024) { src = p.ev_w_out; dst = p.woutT0; N = 1024; ti = it - 768; }
      else if (it < 1408) { src = p.od_w_in; dst = p.winT1; N = 1536; ti = it - 1024; }
      else if (it < 1664) { src = p.od_w_out; dst = p.woutT1; N = 1024; ti = it - 1408; }
      else { const int l = (it - 1664) / 256; src = p.peer_wq + (size_t)l * 1024 * 1024; dst = p.wqT + (size_t)l * 1024 * 1024; N = 1024; ti = (it - 1664) % 256; }
      const int ntn = N / 64, tk = ti / ntn, tn = ti % ntn;
      __syncthreads();
      for (int i = tid; i < 64 * 64; i += NTHREADS) {
        const int r = i >> 6, cc = i & 63;
        tile[r * 65 + cc] = src[(size_t)(tk * 64 + r) * N + tn * 64 + cc];
      }
      __syncthreads();
      for (int i = tid; i < 64 * 32; i += NTHREADS) {
        const int nn = i >> 5, kk = (i & 31) * 2;
        const unsigned w = cvt_pk_bf16(tile[kk * 65 + nn], tile[(kk + 1) * 65 + nn]);
        *(unsigned*)(dst + (size_t)(tn * 64 + nn) * 1024 + tk * 64 + kk) = w;
      }
    }
    __syncthreads();
  }
  for (int idx = bid * NTHREADS + tid; idx < 2 * 8 * 2 * 128 * 64; idx += nb * NTHREADS) {
    const int d = idx & 63, k = (idx >> 6) & 127, s = (idx >> 13) & 1, hh = (idx >> 14) & 7, l = idx >> 17;
    const float v = (s ? p.keys2 : p.keys1)[((size_t)(l * 8 + hh) * 128 + k) * 64 + d];
    const bf16_t hi = f2bf(v);
    const bf16_t lo = f2bf(v - bf2f(hi));
    const size_t o = ((size_t)((l * 8 + hh) * 2 + s) * 2) * 8192 + (size_t)k * 64 + d;
    p.keysb[o] = hi;
    p.keysb[o + 8192] = lo;
  }
  {
    const int wid = tid >> 6, lane = tid & 63, hw = lane >> 5, L = lane & 31, bb = L >> 3, ii = L & 7;
    for (int r = (bid * 8 + wid) * 2 + hw; r < 4 * NEXP; r += nb * 16) {
      const bool isv = r >= 2 * NEXP;
      const int rr = isv ? r - 2 * NEXP : r;
      const float* src = (isv ? p.peer_v : p.peer_u) + (size_t)rr * D + bb * 256 + ii * 32;
      f32x4 a[8];
      float mx = 0.f;
#pragma unroll
      for (int q = 0; q < 8; ++q) {
        a[q] = *(const f32x4*)(src + q * 4);
        mx = fmaxf(mx, fmaxf(fmaxf(fabsf(a[q][0]), fabsf(a[q][1])), fmaxf(fabsf(a[q][2]), fabsf(a[q][3]))));
      }
      mx = row16_max(mx);
      { auto sw = __builtin_amdgcn_permlane16_swap(__float_as_uint(mx), __float_as_uint(mx), false, false); mx = fmaxf(__uint_as_float(sw[0]), __uint_as_float(sw[1])); }
      const float sc = mx > 0.f ? 7.0f / mx : 1.f;
      u32x16 pk;
#pragma unroll
      for (int q = 0; q < 8; ++q) { pk[2 * q] = cvt_pk_bf16(a[q][0] * sc, a[q][1] * sc); pk[2 * q + 1] = cvt_pk_bf16(a[q][2] * sc, a[q][3] * sc); }
      const u32x6 w = __builtin_amdgcn_cvt_scalef32_pk32_fp6_bf16(__builtin_bit_cast(bf16x32n, pk), 1.0f);
      unsigned char* dst = (isv ? p.v8 : p.u8) + (size_t)rr * 768 + ii * 16;
#pragma unroll
      for (int m = 0; m < 6; ++m) {
        const int sidx = 6 * bb + m;
        const unsigned wm = w[m];
        *(unsigned*)(dst + (sidx >> 2) * 128 + (sidx & 3) * 4) = wm;
      }
      if (L == 0) (isv ? p.vscale : p.uscale)[rr] = mx > 0.f ? mx / 7.0f : 1.f;
    }
  }
}

__device__ void phase_resid_norm(const Params& p, int bid, int nb, int row0, int row1, const float* hin_ctx, const float* hin_lat,
                                 const float* gain, const float* modl) {
  const int tid0 = tidx();
  const int wid = tid0 >> 6, lane = tid0 & 63;
  for (int rowa = row0 + (bid * 8 + wid) * 2; rowa < row1; rowa += nb * 16) {
    f32x4 v[2][4];
    float ss[2] = {0.f, 0.f};
#pragma unroll
    for (int r = 0; r < 2; ++r) {
      const int row = rowa + r;
      const bool isctx = row < NCTX;
      const float* h = isctx ? hin_ctx + (size_t)row * D : hin_lat + (size_t)(row - NCTX) * D;
      const bf16_t* mrow = p.pq + (size_t)row * D;
#pragma unroll
      for (int i = 0; i < 4; ++i) {
        const f32x4 hv = *(const f32x4*)(h + i * 256 + lane * 4);
        const u32x2 mv = *(const u32x2*)(mrow + i * 256 + lane * 4);
        v[r][i][0] = hv[0] + bf_lo(mv.x); v[r][i][1] = hv[1] + bf_hi(mv.x); v[r][i][2] = hv[2] + bf_lo(mv.y); v[r][i][3] = hv[3] + bf_hi(mv.y);
      }
    }
#pragma unroll
    for (int r = 0; r < 2; ++r) {
      const int row = rowa + r;
      const bool isctx = row < NCTX;
      float* ho = isctx ? p.hctx + (size_t)row * D : p.out + (size_t)(row - NCTX) * D;
      const int b = isctx ? 32 : ((row - NCTX) >> 11);
      const float* sh = modl + (size_t)b * MODW + 3 * D;
      const float* sc = modl + (size_t)b * MODW + 4 * D;
#pragma unroll
      for (int i = 0; i < 4; ++i) {
        *(f32x4*)(ho + i * 256 + lane * 4) = v[r][i];
        ss[r] += v[r][i][0] * v[r][i][0] + v[r][i][1] * v[r][i][1] + v[r][i][2] * v[r][i][2] + v[r][i][3] * v[r][i][3];
      }
      const float rstd = rsqrtf(wave_sum(ss[r]) * (1.f / D) + EPS);
#pragma unroll
      for (int i = 0; i < 4; ++i) {
        const int col = i * 256 + lane * 4;
        const f32x4 g = *(const f32x4*)(gain + col), s1 = *(const f32x4*)(sc + col), s0 = *(const f32x4*)(sh + col);
        f32x4 y = v[r][i] * rstd * g;
        y = y * (1.f + s1) + s0;
        u32x2 w; w.x = cvt_pk_bf16(y[0], y[1]); w.y = cvt_pk_bf16(y[2], y[3]);
        *(u32x2*)(p.act + (size_t)row * D + col) = w;
      }
    }
  }
}
__device__ void phase_norm(const Params& p, int bid, int nb, int row0, int row1, const float* hctx, const float* hlat,
                           const float* gain, const float* modl, int ish, int isc) {
  const int tid0 = tidx();
  const int wid = tid0 >> 6, lane = tid0 & 63;
  for (int rowa = row0 + (bid * 8 + wid) * 2; rowa < row1; rowa += nb * 16) {
    f32x4 v[2][4];
#pragma unroll
    for (int r = 0; r < 2; ++r) {
      const int row = rowa + r;
      const float* h = row < NCTX ? hctx + (size_t)row * D : hlat + (size_t)(row - NCTX) * D;
#pragma unroll
      for (int i = 0; i < 4; ++i) v[r][i] = *(const f32x4*)(h + i * 256 + lane * 4);
    }
#pragma unroll
    for (int r = 0; r < 2; ++r) {
      const int row = rowa + r;
      const int b = row < NCTX ? 32 : ((row - NCTX) >> 11);
      const float* sh = modl + (size_t)b * MODW + ish * D;
      const float* sc = modl + (size_t)b * MODW + isc * D;
      float ss = 0.f;
#pragma unroll
      for (int i = 0; i < 4; ++i) ss += v[r][i][0] * v[r][i][0] + v[r][i][1] * v[r][i][1] + v[r][i][2] * v[r][i][2] + v[r][i][3] * v[r][i][3];
      const float rstd = rsqrtf(wave_sum(ss) * (1.f / D) + EPS);
#pragma unroll
      for (int i = 0; i < 4; ++i) {
        const int col = i * 256 + lane * 4;
        const f32x4 g = *(const f32x4*)(gain + col), s1 = *(const f32x4*)(sc + col), s0 = *(const f32x4*)(sh + col);
        f32x4 y = v[r][i] * rstd * g;
        y = y * (1.f + s1) + s0;
        u32x2 w; w.x = cvt_pk_bf16(y[0], y[1]); w.y = cvt_pk_bf16(y[2], y[3]);
        *(u32x2*)(p.act + (size_t)row * D + col) = w;
      }
    }
  }
}

__device__ __forceinline__ void phase_gemm_inproj(const Params& p, unsigned char* smem, int bid, int nb, int layer) {
  LAS unsigned char* lds = (LAS unsigned char*)smem;
  if (layer == 0) {
    EpiInProj epi{p.proj, 3072, 0, p.ropec, p.ropes};
    Sched s{0, 0, NTOK / BM, 12, nb, bid};
    gemm_phase(lds, p.act, p.winT0, s, epi);
  } else {
    EpiInProj epi{p.proj, 1536, 1, p.ropec, p.ropes};
    Sched s{NCTX / BM, 0, NLAT / BM, 6, nb, bid};
    gemm_phase(lds, p.act, p.winT1, s, epi);
    Sched s2{0, 4, NCTX / BM, 2, nb, bid};
    gemm_phase(lds, p.act, p.winT1, s2, epi);
  }
}
__device__ __forceinline__ void phase_gemm_outproj(const Params& p, unsigned char* smem, int bid, int nb, int layer) {
  LAS unsigned char* lds = (LAS unsigned char*)smem;
  EpiGate epi{p.pq, p.mod + (size_t)layer * 33 * MODW + 2 * D};
  const int pm0 = layer == 0 ? 0 : NCTX / BM;
  Sched s{pm0, 0, NTOK / BM - pm0, 4, nb, bid};
  gemm_phase(lds, p.act, layer == 0 ? p.woutT0 : p.woutT1, s, epi);
}
__device__ __forceinline__ void phase_gemm_pq(const Params& p, unsigned char* smem, int bid, int nb, int layer) {
  LAS unsigned char* lds = (LAS unsigned char*)smem;
  EpiBf16 epi{p.pq, D};
  const int pm0 = layer == 0 ? 0 : NCTX / BM;
  Sched s{pm0, 0, NTOK / BM - pm0, 4, nb, bid};
  gemm_phase(lds, p.act, p.wqT + (size_t)layer * D * D, s, epi);
}

__device__ __forceinline__ int chunk_row0(int b, int cc) { return cc < 2 ? b * CTXL + cc * 128 : NCTX + b * SEQ + (cc - 2) * 128; }

constexpr int LDP = 136;
constexpr int LDK = 72;

typedef short s16x4 __attribute__((ext_vector_type(4)));
__device__ __forceinline__ bf16x8 tr_frag(const LAS bf16_t* base, int ld, int lane) {
  const int troff = ((lane & 15) >> 2) * ld + (lane & 3) * 4;
  const s16x4 v0 = __builtin_amdgcn_ds_read_tr16_b64_v4i16((LAS s16x4*)(base + troff));
  const s16x4 v1 = __builtin_amdgcn_ds_read_tr16_b64_v4i16((LAS s16x4*)(base + 16 * ld + troff));
  bf16x8 f;
  f[0] = v0[0]; f[1] = v0[1]; f[2] = v0[2]; f[3] = v0[3]; f[4] = v1[0]; f[5] = v1[1]; f[6] = v1[2]; f[7] = v1[3];
  return f;
}
__device__ void phase_ret_kv(const Params& p, unsigned char* smem, int bid, int nb) {
  const int tid = tidx(), wid = __builtin_amdgcn_readfirstlane(tid >> 6), lane = tid & 63, fr = lane & 15, fq = lane >> 4;
  LAS bf16_t* Kl = (LAS bf16_t*)smem;
  LAS bf16_t* Vl = Kl + 128 * LDK;
  for (int it = bid; it < BATCH * 4 * 18; it += nb) {
    const int cc = it % 18, h = (it / 18) & 3, b = it / 72;
    const int row0 = chunk_row0(b, cc);
    const float lf = log_sigmoidf(p.logit_f[h]), lb = log_sigmoidf(p.logit_b[h]);
    __syncthreads();
    for (int task = tid; task < 128 * 8; task += NTHREADS) {
      const int j = task >> 3, d0 = (task & 7) * 8;
      *(LAS u32x4*)(Kl + j * LDK + d0) = *(const u32x4*)(p.proj + (size_t)(row0 + j) * 3072 + 256 + h * 64 + d0);
    }
    for (int task = tid; task < 128 * 16; task += NTHREADS) {
      const int j = task >> 4, e0 = (task & 15) * 8;
      *(LAS u32x4*)(Vl + j * LDP + e0) = *(const u32x4*)(p.proj + (size_t)(row0 + j) * 3072 + 512 + h * 128 + e0);
    }
    __syncthreads();
    bf16x8 af[4], ab[4];
#pragma unroll
    for (int ks = 0; ks < 4; ++ks) {
      const bf16x8 vf = tr_frag(Vl + (ks * 32 + fq * 4) * LDP + wid * 16, LDP, lane);
      const u32x4 vu = __builtin_bit_cast(u32x4, vf);
      u32x4 wf, wb;
#pragma unroll
      for (int q = 0; q < 4; ++q) {
        const int j0 = ks * 32 + (q >> 1) * 16 + fq * 4 + (q & 1) * 2;
        const float lo = bf_lo(vu[q]), hi = bf_hi(vu[q]);
        wf[q] = cvt_pk_bf16(lo * __expf(lf * (float)(127 - j0)), hi * __expf(lf * (float)(126 - j0)));
        wb[q] = cvt_pk_bf16(lo * __expf(lb * (float)j0), hi * __expf(lb * (float)(j0 + 1)));
      }
      af[ks] = __builtin_bit_cast(bf16x8, wf);
      ab[ks] = __builtin_bit_cast(bf16x8, wb);
    }
    float* out = p.kv + (size_t)it * 16384;
#pragma unroll
    for (int n = 0; n < 4; ++n) {
      f32x4 accf = {0.f, 0.f, 0.f, 0.f}, accb = {0.f, 0.f, 0.f, 0.f};
#pragma unroll
      for (int ks = 0; ks < 4; ++ks) {
        const bf16x8 kf = tr_frag(Kl + (ks * 32 + fq * 4) * LDK + n * 16, LDK, lane);
        accf = __builtin_amdgcn_mfma_f32_16x16x32_bf16(af[ks], kf, accf, 0, 0, 0);
        accb = __builtin_amdgcn_mfma_f32_16x16x32_bf16(ab[ks], kf, accb, 0, 0, 0);
      }
#pragma unroll
      for (int j = 0; j < 4; ++j) {
        out[(wid * 16 + fq * 4 + j) * 128 + n * 16 + fr] = accf[j];
        out[(wid * 16 + fq * 4 + j) * 128 + 64 + n * 16 + fr] = accb[j];
      }
    }
  }
  for (size_t task = (size_t)bid * NTHREADS + tid; task < (size_t)NTOK * 64; task += (size_t)nb * NTHREADS) {
    const int row = (int)(task >> 6), c0 = (int)(task & 63) * 8;
    const int tin = row < NCTX ? (row & (CTXL - 1)) : ((row - NCTX) & (SEQ - 1));
    const int tlen = row < NCTX ? CTXL : SEQ;
    const bf16_t* pr = p.proj + (size_t)row * 3072;
    const u32x4 gb = *(const u32x4*)(pr + 1536 + c0);
    float accv[8];
#pragma unroll
    for (int q = 0; q < 8; ++q) accv[q] = 0.f;
#pragma unroll
    for (int dt = -1; dt <= 1; ++dt) {
      if (tin + dt < 0 || tin + dt >= tlen) continue;
      const bf16_t* pr2 = pr + (ptrdiff_t)dt * 3072;
      const u32x4 gc = *(const u32x4*)(pr2 + 2048 + c0), xt = *(const u32x4*)(pr2 + 2560 + c0);
      const float* w = p.conv_w + (dt + 1) * 512 + c0;
      const f32x4 wa = *(const f32x4*)w, wb = *(const f32x4*)(w + 4);
#pragma unroll
      for (int q = 0; q < 4; ++q) {
        const float u0 = bf_lo(gc[q]) * bf_lo(xt[q]), u1 = bf_hi(gc[q]) * bf_hi(xt[q]);
        const float w0 = (2 * q < 4) ? wa[2 * q] : wb[2 * q - 4], w1 = (2 * q + 1 < 4) ? wa[2 * q + 1] : wb[2 * q + 1 - 4];
        accv[2 * q] += w0 * u0;
        accv[2 * q + 1] += w1 * u1;
      }
    }
    u32x4 o;
#pragma unroll
    for (int q = 0; q < 4; ++q) o[q] = cvt_pk_bf16(bf_lo(gb[q]) * accv[2 * q], bf_hi(gb[q]) * accv[2 * q + 1]);
#ifdef ZERO_CONV
    o = (u32x4){0u, 0u, 0u, 0u};
#endif
    *(u32x4*)(p.act + (size_t)row * D + 512 + c0) = o;
  }
}

__device__ void phase_ret_scan(const Params& p, int bid, int nb) {
  const int tid = tidx();
  for (size_t idx = (size_t)bid * NTHREADS + tid; idx < (size_t)BATCH * 4 * 16384; idx += (size_t)nb * NTHREADS) {
    const int el = (int)(idx & 16383), bh = (int)(idx >> 14), h = bh & 3;
    const bool fwd = (el & 127) < 64;
    const float lg = log_sigmoidf(fwd ? p.logit_f[h] : p.logit_b[h]);
    const float dec = __expf(lg * 128.f);
    float st = 0.f;
    for (int s = 0; s < 18; ++s) {
      const int cc = fwd ? s : (s < 2 ? 1 - s : 19 - s);
      const size_t off = ((size_t)bh * 18 + cc) * 16384 + el;
      p.sprev[off] = f2bf(st);
      st = dec * st + p.kv[off];
    }
  }
}

__device__ void phase_ret_out(const Params& p, unsigned char* smem, int bid, int nb) {
  const int tid = tidx(), wid = __builtin_amdgcn_readfirstlane(tid >> 6), lane = tid & 63, fr = lane & 15, fq = lane >> 4;
  LAS bf16_t* Kl = (LAS bf16_t*)smem;
  LAS bf16_t* Vl = Kl + 128 * LDK;
  LAS bf16_t* Sl = Vl + 128 * LDP;
  const int NIT = BATCH * 4 * 18;
  u32x4 rk[2], rv[4], rs[4];
  bf16x8 qfn[2];
#define RO_LOAD(IT)                                                                                                      \
  do {                                                                                                                   \
    const int _cc = (IT) % 18, _h = ((IT) / 18) & 3, _b = (IT) / 72;                                                     \
    const int _row0 = chunk_row0(_b, _cc);                                                                               \
    _Pragma("unroll") for (int c = 0; c < 2; ++c) { const int task = tid + c * NTHREADS; const int j = task >> 3, d0 = (task & 7) * 8; \
      rk[c] = *(const u32x4*)(p.proj + (size_t)(_row0 + j) * 3072 + 256 + _h * 64 + d0); }                              \
    _Pragma("unroll") for (int c = 0; c < 4; ++c) { const int task = tid + c * NTHREADS; const int j = task >> 4, e0 = (task & 15) * 8; \
      rv[c] = *(const u32x4*)(p.proj + (size_t)(_row0 + j) * 3072 + 512 + _h * 128 + e0);                               \
      rs[c] = *(const u32x4*)(p.sprev + (size_t)(IT) * 16384 + j * 128 + e0); }                                          \
    _Pragma("unroll") for (int ks = 0; ks < 2; ++ks) qfn[ks] = *(const bf16x8*)(p.proj + (size_t)(_row0 + wid * 16 + fr) * 3072 + _h * 64 + ks * 32 + fq * 8); \
  } while (0)
#define RO_STORE()                                                                                                       \
  do {                                                                                                                   \
    _Pragma("unroll") for (int c = 0; c < 2; ++c) { const int task = tid + c * NTHREADS; const int j = task >> 3, d0 = (task & 7) * 8; \
      *(LAS u32x4*)(Kl + j * LDK + d0) = rk[c]; }                                                                        \
    _Pragma("unroll") for (int c = 0; c < 4; ++c) { const int task = tid + c * NTHREADS; const int j = task >> 4, e0 = (task & 15) * 8; \
      *(LAS u32x4*)(Vl + j * LDP + e0) = rv[c]; *(LAS u32x4*)(Sl + j * LDP + e0) = rs[c]; }                              \
  } while (0)
  if (bid < NIT) { RO_LOAD(bid); __syncthreads(); RO_STORE(); }
  __syncthreads();
  for (int it = bid; it < NIT; it += nb) {
    const int cc = it % 18, h = (it / 18) & 3, b = it / 72;
    const int row0 = chunk_row0(b, cc);
    const float lf = log_sigmoidf(p.logit_f[h]), lb = log_sigmoidf(p.logit_b[h]);
    const int irow = wid * 16 + fr;
    bf16x8 qf[2];
    qf[0] = qfn[0]; qf[1] = qfn[1];
    const bool more = it + nb < NIT;
    if (more) RO_LOAD(it + nb);
    const size_t row = (size_t)(row0 + irow);
    u32x2 gg[8];
#pragma unroll
    for (int dn = 0; dn < 8; ++dn) gg[dn] = *(const u32x2*)(p.proj + row * 3072 + 1024 + h * 128 + dn * 16 + fq * 4);
    bf16x8 pb[4];
    {
      f32x4 st[8];
#pragma unroll
      for (int n = 0; n < 8; ++n) st[n] = (f32x4){0.f, 0.f, 0.f, 0.f};
#pragma unroll
      for (int ks = 0; ks < 2; ++ks)
#pragma unroll
        for (int n = 0; n < 8; ++n) {
          const bf16x8 kf = *(const LAS bf16x8*)(Kl + (n * 16 + fr) * LDK + ks * 32 + fq * 8);
          st[n] = __builtin_amdgcn_mfma_f32_16x16x32_bf16(kf, qf[ks], st[n], 0, 0, 0);
        }
#pragma unroll
      for (int n = 0; n < 8; ++n)
#pragma unroll
        for (int r = 0; r < 4; ++r) {
          const int df = irow - (n * 16 + fq * 4 + r);
          const float lg = df > 0 ? lf : lb;
          const float ex = __expf(lg * fabsf((float)df));
          st[n][r] *= (df == 0) ? 2.f : ex;
        }
#pragma unroll
      for (int kk = 0; kk < 4; ++kk) {
        u32x4 w;
        w.x = cvt_pk_bf16(st[2 * kk][0], st[2 * kk][1]); w.y = cvt_pk_bf16(st[2 * kk][2], st[2 * kk][3]);
        w.z = cvt_pk_bf16(st[2 * kk + 1][0], st[2 * kk + 1][1]); w.w = cvt_pk_bf16(st[2 * kk + 1][2], st[2 * kk + 1][3]);
        pb[kk] = __builtin_bit_cast(bf16x8, w);
      }
    }
    bf16x8 qx[4];
    {
      const float xf = __expf(lf * (float)(irow + 1)), xb = __expf(lb * (float)(128 - irow));
#pragma unroll
      for (int ks = 0; ks < 4; ++ks) {
        const float sc = ks < 2 ? xf : xb;
        const u32x4 qu = __builtin_bit_cast(u32x4, qf[ks & 1]);
        u32x4 qo;
#pragma unroll
        for (int q = 0; q < 4; ++q) { const unsigned w = qu[q]; qo[q] = cvt_pk_bf16(bf_lo(w) * sc, bf_hi(w) * sc); }
        qx[ks] = __builtin_bit_cast(bf16x8, qo);
      }
    }
    f32x4 ot[8];
#pragma unroll
    for (int dn = 0; dn < 8; ++dn) {
      f32x4 o = {0.f, 0.f, 0.f, 0.f};
#pragma unroll
      for (int kk = 0; kk < 4; ++kk) {
        const bf16x8 vf = tr_frag(Vl + (kk * 32 + fq * 4) * LDP + dn * 16, LDP, lane);
        o = __builtin_amdgcn_mfma_f32_16x16x32_bf16(vf, pb[kk], o, 0, 0, 0);
      }
#pragma unroll
      for (int ks = 0; ks < 4; ++ks) {
        const bf16x8 sf = *(const LAS bf16x8*)(Sl + (dn * 16 + fr) * LDP + ks * 32 + fq * 8);
        o = __builtin_amdgcn_mfma_f32_16x16x32_bf16(sf, qx[ks], o, 0, 0, 0);
      }
      ot[dn] = o;
    }
    float ss = 0.f;
#pragma unroll
    for (int dn = 0; dn < 8; ++dn) ss += ot[dn][0] * ot[dn][0] + ot[dn][1] * ot[dn][1] + ot[dn][2] * ot[dn][2] + ot[dn][3] * ot[dn][3];
    ss = xrow16_sum(ss);
    const float rstd = rsqrtf(ss * (1.f / 128.f) + EPS);
#pragma unroll
    for (int dn = 0; dn < 8; ++dn) {
      const int e0 = dn * 16 + fq * 4;
      const u32x2 g = gg[dn];
      u32x2 w;
#ifdef ZERO_RET
      w.x = 0u; w.y = 0u;
#else
      w.x = cvt_pk_bf16(ot[dn][0] * rstd * siluf(bf_lo(g.x)), ot[dn][1] * rstd * siluf(bf_hi(g.x)));
      w.y = cvt_pk_bf16(ot[dn][2] * rstd * siluf(bf_lo(g.y)), ot[dn][3] * rstd * siluf(bf_hi(g.y)));
#endif
      *(u32x2*)(p.act + row * D + h * 128 + e0) = w;
    }
    __syncthreads();
    if (more) RO_STORE();
    __syncthreads();
  }
#undef RO_LOAD
#undef RO_STORE
}

__device__ __forceinline__ float xrow16_max(float x) {
  auto s = __builtin_amdgcn_permlane16_swap(__float_as_uint(x), __float_as_uint(x), false, false);
  x = fmaxf(__uint_as_float(s[0]), __uint_as_float(s[1]));
  auto t = __builtin_amdgcn_permlane32_swap(__float_as_uint(x), __float_as_uint(x), false, false);
  return fmaxf(__uint_as_float(t[0]), __uint_as_float(t[1]));
}
template <int VAR>
__device__ void phase_attn(const Params& p, unsigned char* smem, int bid, int nb, bf16_t* outp) {
  const int tid = tidx(), wid = __builtin_amdgcn_readfirstlane(tid >> 6), lane = tid & 63, fr = lane & 15, fq = lane >> 4;
  LAS bf16_t* Kl = (LAS bf16_t*)smem;
  LAS bf16_t* Vl = Kl + 2 * 64 * LDK;
  LAS bf16_t* Ql = Vl + 2 * 64 * LDK + wid * 64 * LDK;
  const int sj = tid >> 3, sc8 = (tid & 7) * 8;
  const int troff = ((lane & 15) >> 2) * LDK + (lane & 3) * 4;
  for (int it = bid; it < BATCH * 16 * 4; it += nb) {
    const int kvh = it & 3, qb = (it >> 2) & 15, b = it >> 6;
    const int hq = kvh * 4 + (wid >> 1);
    const int q0 = qb * 128 + (wid & 1) * 64;
    const size_t latrow0 = (size_t)NCTX + (size_t)b * SEQ;
    const int tlo = qb == 0 ? 2 : 0, nwin = (qb == 15 ? 4 : 6) - tlo, ntile = nwin + 4;
#pragma unroll
    for (int m = 0; m < 4; ++m)
#pragma unroll
      for (int ks = 0; ks < 2; ++ks)
        *(LAS bf16x8*)(Ql + (m * 16 + fr) * LDK + ks * 32 + fq * 8) = *(const bf16x8*)(p.proj + (latrow0 + q0 + m * 16 + fr) * 1536 + hq * 64 + ks * 32 + fq * 8);
    const float sink = p.sinks[hq] * 1.44269504089f;
    float mrow[4], lrow[4];
    f32x4 ot[4][4];
#pragma unroll
    for (int m = 0; m < 4; ++m) {
      mrow[m] = sink; lrow[m] = (fq == 0) ? 1.f : 0.f;
#pragma unroll
      for (int dn = 0; dn < 4; ++dn) ot[dn][m] = (f32x4){0.f, 0.f, 0.f, 0.f};
    }
#define AT_KROW(T) ((T) < nwin ? latrow0 + (qb * 128 - 128 + 64 * (tlo + (T))) : (size_t)b * CTXL + ((T) - nwin) * 64)
#define AT_LOAD(RK, RV, T) do { const size_t _kr = AT_KROW(T);                                                            \
      RK = *(const u32x4*)(p.proj + (_kr + sj) * 1536 + 1024 + kvh * 64 + sc8);                                          \
      RV = *(const u32x4*)(p.proj + (_kr + sj) * 1536 + 1280 + kvh * 64 + sc8); } while (0)
    u32x4 rk0, rv0, rk1, rv1;
    rk0 = rk1 = rv0 = rv1 = (u32x4){0u, 0u, 0u, 0u};
    {
      u32x4 kk, vv;
      AT_LOAD(kk, vv, 0);
      AT_LOAD(rk1, rv1, 1);
      *(LAS u32x4*)(Kl + sj * LDK + sc8) = kk;
      *(LAS u32x4*)(Vl + sj * LDK + sc8) = vv;
    }
    __syncthreads();
    auto tile = [&](const int s, u32x4& ldK, u32x4& ldV, const u32x4& wrK, const u32x4& wrV) __attribute__((always_inline)) {
      const int cur = s & 1;
      const int tt = s < nwin ? tlo + s : 6 + (s - nwin);
      const bool win = tt < 6;
      const int kpos0 = win ? qb * 128 - 128 + 64 * tt : (tt - 6) * 64;
      const bool more = s + 1 < ntile;
      if (!(VAR & 16)) { if (s + 2 < ntile) AT_LOAD(ldK, ldV, s + 2); }
      const LAS bf16_t* Kc = Kl + cur * 64 * LDK;
      const LAS bf16_t* Vc = Vl + cur * 64 * LDK;
      const int dq = q0 - kpos0;
      const bool skip = win && (dq >= 192 || dq <= -192);
      const bool edge = win && !(dq <= 65 && dq >= -65);
      if (!skip && !(VAR & 8)) {
      bf16x8 pb[4][2];
      {
        bf16x8 kfr[2][4];
#pragma unroll
        for (int ks = 0; ks < 2; ++ks)
#pragma unroll
          for (int n = 0; n < 4; ++n) kfr[ks][n] = *(const LAS bf16x8*)(Kc + (n * 16 + fr) * LDK + ks * 32 + fq * 8);
#pragma unroll
        for (int m = 0; m < 4; ++m) {
          f32x4 st[4];
#pragma unroll
          for (int n = 0; n < 4; ++n) st[n] = (f32x4){0.f, 0.f, 0.f, 0.f};
#pragma unroll
          for (int ks = 0; ks < 2; ++ks) {
            const bf16x8 qfm = *(const LAS bf16x8*)(Ql + (m * 16 + fr) * LDK + ks * 32 + fq * 8);
#pragma unroll
            for (int n = 0; n < 4; ++n) st[n] = __builtin_amdgcn_mfma_f32_16x16x32_bf16(kfr[ks][n], qfm, st[n], 0, 0, 0);
          }
          const int qpos = q0 + m * 16 + fr;
          float mx = -3.0e38f;
#pragma unroll
          for (int n = 0; n < 4; ++n)
#pragma unroll
            for (int j = 0; j < 4; ++j) {
              float sv = st[n][j];
              if (edge) { const int dd = qpos - (kpos0 + n * 16 + fq * 4 + j); if (dd > 128 || dd < -128) sv = -1e30f; }
              st[n][j] = sv;
              mx = fmaxf(mx, sv);
            }
          mx = xrow16_max(mx);
          const float mnew = fmaxf(mrow[m], mx);
          const float alpha = __builtin_amdgcn_exp2f(mrow[m] - mnew);
          mrow[m] = mnew;
          float ls = 0.f;
#pragma unroll
          for (int n = 0; n < 4; ++n)
#pragma unroll
            for (int j = 0; j < 4; ++j) { const float pv = (VAR & 2) ? (st[n][j] - mnew) : __builtin_amdgcn_exp2f(st[n][j] - mnew); st[n][j] = pv; ls += pv; }
          lrow[m] = lrow[m] * alpha + ls;
#pragma unroll
          for (int dn = 0; dn < 4; ++dn) ot[dn][m] *= alpha;
#pragma unroll
          for (int kk = 0; kk < 2; ++kk) {
            u32x4 w;
            w.x = cvt_pk_bf16(st[2 * kk][0], st[2 * kk][1]); w.y = cvt_pk_bf16(st[2 * kk][2], st[2 * kk][3]);
            w.z = cvt_pk_bf16(st[2 * kk + 1][0], st[2 * kk + 1][1]); w.w = cvt_pk_bf16(st[2 * kk + 1][2], st[2 * kk + 1][3]);
            pb[m][kk] = __builtin_bit_cast(bf16x8, w);
          }
          __builtin_amdgcn_sched_barrier(0);
        }
      }
#pragma unroll
      for (int kk = 0; kk < 2; ++kk) {
        bf16x8 vfr[4];
#pragma unroll
        for (int dn = 0; dn < 4; ++dn) {
          const s16x4 v0 = __builtin_amdgcn_ds_read_tr16_b64_v4i16((LAS s16x4*)(Vc + ((2 * kk) * 16 + fq * 4) * LDK + dn * 16 + troff));
          const s16x4 v1 = __builtin_amdgcn_ds_read_tr16_b64_v4i16((LAS s16x4*)(Vc + ((2 * kk + 1) * 16 + fq * 4) * LDK + dn * 16 + troff));
          bf16x8 vf;
          vf[0] = v0[0]; vf[1] = v0[1]; vf[2] = v0[2]; vf[3] = v0[3]; vf[4] = v1[0]; vf[5] = v1[1]; vf[6] = v1[2]; vf[7] = v1[3];
          vfr[dn] = vf;
        }
#pragma unroll
        for (int m = 0; m < 4; ++m)
#pragma unroll
          for (int dn = 0; dn < 4; ++dn) { if (VAR & 4) ot[dn][m][0] += __uint_as_float(__builtin_bit_cast(u32x4, vfr[dn]).x ^ __builtin_bit_cast(u32x4, pb[m][kk]).x); else ot[dn][m] = __builtin_amdgcn_mfma_f32_16x16x32_bf16(vfr[dn], pb[m][kk], ot[dn][m], 0, 0, 0); }
        __builtin_amdgcn_sched_barrier(0);
      }
      }
      if (!(VAR & 16)) {
        if (more) {
          *(LAS u32x4*)(Kl + ((cur ^ 1) * 64 + sj) * LDK + sc8) = wrK;
          *(LAS u32x4*)(Vl + ((cur ^ 1) * 64 + sj) * LDK + sc8) = wrV;
        }
        __syncthreads();
      }
    };
#pragma unroll 1
    for (int s = 0; s < ntile; s += 2) {
      tile(s, rk0, rv0, rk1, rv1);
      tile(s + 1, rk1, rv1, rk0, rv0);
    }
#undef AT_LOAD
#undef AT_KROW
    int fr2 = fr;
    asm volatile("" : "+v"(fr2));
#pragma unroll
    for (int m = 0; m < 4; ++m) {
      const float l = xrow16_sum(lrow[m]);
      const float inv = 1.f / l;
      bf16_t* orow = outp + (latrow0 + q0 + m * 16 + fr2) * D + hq * 64 + fq * 4;
#pragma unroll
      for (int dn = 0; dn < 4; ++dn) {
        u32x2 w;
#ifdef ZERO_ATTN
        w.x = 0u; w.y = 0u;
#else
        w.x = cvt_pk_bf16(ot[dn][m][0] * inv, ot[dn][m][1] * inv); w.y = cvt_pk_bf16(ot[dn][m][2] * inv, ot[dn][m][3] * inv);
#endif
        *(u32x2*)(orow + dn * 16) = w;
      }
    }
  }
}

#define CEX(a, b) do { const unsigned _h = max(a, b), _l = min(a, b); a = _h; b = _l; } while (0)
__device__ __forceinline__ void sort16_desc(unsigned (&v)[16]) { CEX(v[0], v[1]); CEX(v[2], v[3]); CEX(v[0], v[2]); CEX(v[1], v[3]); CEX(v[1], v[2]); CEX(v[4], v[5]); CEX(v[6], v[7]); CEX(v[4], v[6]); CEX(v[5], v[7]); CEX(v[5], v[6]); CEX(v[0], v[4]); CEX(v[2], v[6]); CEX(v[2], v[4]); CEX(v[1], v[5]); CEX(v[3], v[7]); CEX(v[3], v[5]); CEX(v[1], v[2]); CEX(v[3], v[4]); CEX(v[5], v[6]); CEX(v[8], v[9]); CEX(v[10], v[11]); CEX(v[8], v[10]); CEX(v[9], v[11]); CEX(v[9], v[10]); CEX(v[12], v[13]); CEX(v[14], v[15]); CEX(v[12], v[14]); CEX(v[13], v[15]); CEX(v[13], v[14]); CEX(v[8], v[12]); CEX(v[10], v[14]); CEX(v[10], v[12]); CEX(v[9], v[13]); CEX(v[11], v[15]); CEX(v[11], v[13]); CEX(v[9], v[10]); CEX(v[11], v[12]); CEX(v[13], v[14]); CEX(v[0], v[8]); CEX(v[4], v[12]); CEX(v[4], v[8]); CEX(v[2], v[10]); CEX(v[6], v[14]); CEX(v[6], v[10]); CEX(v[2], v[4]); CEX(v[6], v[8]); CEX(v[10], v[12]); CEX(v[1], v[9]); CEX(v[5], v[13]); CEX(v[5], v[9]); CEX(v[3], v[11]); CEX(v[7], v[15]); CEX(v[7], v[11]); CEX(v[3], v[5]); CEX(v[7], v[9]); CEX(v[11], v[13]); CEX(v[1], v[2]); CEX(v[3], v[4]); CEX(v[5], v[6]); CEX(v[7], v[8]); CEX(v[9], v[10]); CEX(v[11], v[12]); CEX(v[13], v[14]); }
__device__ __forceinline__ void merge16_desc(unsigned (&t)[16], const unsigned (&b)[16]) {
#pragma unroll
  for (int i = 0; i < 16; ++i) t[i] = max(t[i], b[15 - i]);
  CEX(t[0], t[8]); CEX(t[1], t[9]); CEX(t[2], t[10]); CEX(t[3], t[11]); CEX(t[4], t[12]); CEX(t[5], t[13]); CEX(t[6], t[14]); CEX(t[7], t[15]); CEX(t[0], t[4]); CEX(t[1], t[5]); CEX(t[2], t[6]); CEX(t[3], t[7]); CEX(t[8], t[12]); CEX(t[9], t[13]); CEX(t[10], t[14]); CEX(t[11], t[15]); CEX(t[0], t[2]); CEX(t[1], t[3]); CEX(t[4], t[6]); CEX(t[5], t[7]); CEX(t[8], t[10]); CEX(t[9], t[11]); CEX(t[12], t[14]); CEX(t[13], t[15]); CEX(t[0], t[1]); CEX(t[2], t[3]); CEX(t[4], t[5]); CEX(t[6], t[7]); CEX(t[8], t[9]); CEX(t[10], t[11]); CEX(t[12], t[13]); CEX(t[14], t[15]);
}

__device__ __forceinline__ unsigned f2ord(float f) { const unsigned u = __float_as_uint(f); return (u & 0x80000000u) ? ~u : (u | 0x80000000u); }
__device__ __forceinline__ float ord2f(unsigned k) { const unsigned u = (k & 0x80000000u) ? (k & 0x7fffffffu) : ~k; return __uint_as_float(u); }
__device__ __forceinline__ unsigned dpp_xor1(unsigned x) { return (unsigned)__builtin_amdgcn_mov_dpp((int)x, 0xB1, 0xf, 0xf, true); }

__device__ void phase_peer_topk(const Params& p, unsigned char* smem, int bid, int nb, int layer, int tok0, int ntok) {
  const int tid = tidx(), wid = __builtin_amdgcn_readfirstlane(tid >> 6), lane = tid & 63, fr = lane & 15, fq = lane >> 4;
  LAS unsigned* sc = (LAS unsigned*)smem + wid * (64 * 36 + 64 * 16);
  LAS unsigned* fl = sc + 64 * 36;
  const int ls = lane & 1;
  const int nitem = (ntok / 256) * 8;
  for (int it = bid; it < nitem; it += nb) {
    const int h = it & 7, tile = it >> 3;
    const int tokw0 = tok0 + tile * 256 + wid * 32;
    bf16x8 qa[2][2][2];
#pragma unroll
    for (int m = 0; m < 2; ++m)
#pragma unroll
      for (int s = 0; s < 2; ++s)
#pragma unroll
        for (int ks = 0; ks < 2; ++ks)
          qa[m][s][ks] = *(const bf16x8*)(p.pq + (size_t)(tokw0 + m * 16 + fr) * D + h * 128 + s * 64 + ks * 32 + fq * 8);
    unsigned top[16];
#pragma unroll
    for (int i = 0; i < 16; ++i) top[i] = 0u;
    const bf16_t* kb = p.keysb + (size_t)(layer * 8 + h) * (2 * 2 * 128 * 64);
    bf16x8 kfr[2][2][2];
#define TK_LOADKEYS(C)                                                                                                   \
    _Pragma("unroll") for (int s = 0; s < 2; ++s) _Pragma("unroll") for (int n = 0; n < 2; ++n) _Pragma("unroll") for (int ks = 0; ks < 2; ++ks) \
      kfr[s][n][ks] = *(const bf16x8*)(kb + (size_t)((s * 2) * 128 + (C) * 32 + n * 16 + fr) * 64 + ks * 32 + fq * 8)
    TK_LOADKEYS(0);
#pragma unroll 1
    for (int c = 0; c < 4; ++c) {
      f32x4 acc[2][2][2];
#pragma unroll
      for (int m = 0; m < 2; ++m)
#pragma unroll
        for (int s = 0; s < 2; ++s)
#pragma unroll
          for (int n = 0; n < 2; ++n) acc[m][s][n] = (f32x4){0.f, 0.f, 0.f, 0.f};
#pragma unroll
      for (int s = 0; s < 2; ++s)
#pragma unroll
        for (int n = 0; n < 2; ++n)
#pragma unroll
          for (int ks = 0; ks < 2; ++ks)
#pragma unroll
            for (int m = 0; m < 2; ++m) acc[m][s][n] = __builtin_amdgcn_mfma_f32_16x16x32_bf16(qa[m][s][ks], kfr[s][n][ks], acc[m][s][n], 0, 0, 0);
      { const int cn = c < 3 ? c + 1 : 3; TK_LOADKEYS(cn); }
#pragma unroll
      for (int m = 0; m < 2; ++m)
#pragma unroll
        for (int s = 0; s < 2; ++s)
#pragma unroll
          for (int n = 0; n < 2; ++n)
#pragma unroll
            for (int j = 0; j < 4; ++j)
              sc[((m * 16 + fq * 4 + j) * 2 + s) * 36 + n * 16 + fr] = (f2ord(acc[m][s][n][j]) & 0xffffff80u) | (unsigned)(127 - (c * 32 + n * 16 + fr));
      unsigned b0[16], b1[16];
#pragma unroll
      for (int q = 0; q < 4; ++q) {
        const u32x4 w0 = *(const LAS u32x4*)(sc + lane * 36 + q * 4), w1 = *(const LAS u32x4*)(sc + lane * 36 + 16 + q * 4);
        b0[4 * q] = w0.x; b0[4 * q + 1] = w0.y; b0[4 * q + 2] = w0.z; b0[4 * q + 3] = w0.w;
        b1[4 * q] = w1.x; b1[4 * q + 1] = w1.y; b1[4 * q + 2] = w1.z; b1[4 * q + 3] = w1.w;
      }
      sort16_desc(b0); merge16_desc(top, b0);
      sort16_desc(b1); merge16_desc(top, b1);
    }
#undef TK_LOADKEYS
#pragma unroll
    for (int q = 0; q < 4; ++q) { u32x4 w; w.x = top[4 * q]; w.y = top[4 * q + 1]; w.z = top[4 * q + 2]; w.w = top[4 * q + 3]; *(LAS u32x4*)(fl + lane * 16 + q * 4) = w; }
    float own[16], oth[16];
#pragma unroll
    for (int q = 0; q < 4; ++q) {
      const u32x4 w = *(const LAS u32x4*)(fl + (lane ^ 1) * 16 + q * 4);
      oth[4 * q] = ord2f(w.x & 0xffffff80u); oth[4 * q + 1] = ord2f(w.y & 0xffffff80u); oth[4 * q + 2] = ord2f(w.z & 0xffffff80u); oth[4 * q + 3] = ord2f(w.w & 0xffffff80u);
    }
#pragma unroll
    for (int i = 0; i < 16; ++i) own[i] = ord2f(top[i] & 0xffffff80u);
    unsigned ck[32];
    ck[0] = (f2ord(own[0] + oth[1]) & 0xffffff00u) | (255u - (ls ? 16u : 1u));
    ck[1] = (f2ord(own[0] + oth[2]) & 0xffffff00u) | (255u - (ls ? 32u : 2u));
    ck[2] = (f2ord(own[0] + oth[3]) & 0xffffff00u) | (255u - (ls ? 48u : 3u));
    ck[3] = (f2ord(own[0] + oth[4]) & 0xffffff00u) | (255u - (ls ? 64u : 4u));
    ck[4] = (f2ord(own[0] + oth[5]) & 0xffffff00u) | (255u - (ls ? 80u : 5u));
    ck[5] = (f2ord(own[0] + oth[6]) & 0xffffff00u) | (255u - (ls ? 96u : 6u));
    ck[6] = (f2ord(own[0] + oth[7]) & 0xffffff00u) | (255u - (ls ? 112u : 7u));
    ck[7] = (f2ord(own[0] + oth[8]) & 0xffffff00u) | (255u - (ls ? 128u : 8u));
    ck[8] = (f2ord(own[0] + oth[9]) & 0xffffff00u) | (255u - (ls ? 144u : 9u));
    ck[9] = (f2ord(own[0] + oth[10]) & 0xffffff00u) | (255u - (ls ? 160u : 10u));
    ck[10] = (f2ord(own[0] + oth[11]) & 0xffffff00u) | (255u - (ls ? 176u : 11u));
    ck[11] = (f2ord(own[0] + oth[12]) & 0xffffff00u) | (255u - (ls ? 192u : 12u));
    ck[12] = (f2ord(own[0] + oth[13]) & 0xffffff00u) | (255u - (ls ? 208u : 13u));
    ck[13] = (f2ord(own[0] + oth[14]) & 0xffffff00u) | (255u - (ls ? 224u : 14u));
    ck[14] = (f2ord(own[0] + oth[15]) & 0xffffff00u) | (255u - (ls ? 240u : 15u));
    ck[15] = (f2ord(own[1] + oth[2]) & 0xffffff00u) | (255u - (ls ? 33u : 18u));
    ck[16] = (f2ord(own[1] + oth[3]) & 0xffffff00u) | (255u - (ls ? 49u : 19u));
    ck[17] = (f2ord(own[1] + oth[4]) & 0xffffff00u) | (255u - (ls ? 65u : 20u));
    ck[18] = (f2ord(own[1] + oth[5]) & 0xffffff00u) | (255u - (ls ? 81u : 21u));
    ck[19] = (f2ord(own[1] + oth[6]) & 0xffffff00u) | (255u - (ls ? 97u : 22u));
    ck[20] = (f2ord(own[1] + oth[7]) & 0xffffff00u) | (255u - (ls ? 113u : 23u));
    ck[21] = (f2ord(own[2] + oth[3]) & 0xffffff00u) | (255u - (ls ? 50u : 35u));
    ck[22] = (f2ord(own[2] + oth[4]) & 0xffffff00u) | (255u - (ls ? 66u : 36u));
    ck[23] = ls ? 0u : ((f2ord(own[0] + oth[0]) & 0xffffff00u) | (255u - 0u));
    ck[24] = ls ? 0u : ((f2ord(own[1] + oth[1]) & 0xffffff00u) | (255u - 17u));
    ck[25] = ls ? 0u : ((f2ord(own[2] + oth[2]) & 0xffffff00u) | (255u - 34u));
    ck[26] = ls ? 0u : ((f2ord(own[3] + oth[3]) & 0xffffff00u) | (255u - 51u));
    ck[27] = 0u;
    ck[28] = 0u;
    ck[29] = 0u;
    ck[30] = 0u;
    ck[31] = 0u;
    unsigned c0[16], c1[16];
#pragma unroll
    for (int i = 0; i < 16; ++i) { c0[i] = ck[i]; c1[i] = ck[16 + i]; }
    sort16_desc(c0); sort16_desc(c1); merge16_desc(c0, c1);
    unsigned pt[16];
#pragma unroll
    for (int i = 0; i < 16; ++i) pt[i] = dpp_xor1(c0[i]);
    merge16_desc(c0, pt);
    float cs[16], den = 0.f;
    const float mx = ord2f(c0[0] & 0xffffff00u);
#pragma unroll
    for (int r = 0; r < 16; ++r) { cs[r] = __expf(ord2f(c0[r] & 0xffffff00u) - mx); den += cs[r]; }
    const float inv = 1.f / den;
    const int token = tokw0 + (lane >> 1);
    if (ls == 0) {
      u32x2* so = p.sel + (size_t)token * 128 + h * 16;
      const LAS unsigned* l1 = fl + lane * 16;
      const LAS unsigned* l2 = fl + (lane + 1) * 16;
#pragma unroll
      for (int rr = 0; rr < 16; rr += 2) {
        u32x4 w;
        {
          const unsigned ci = 255u - (c0[rr] & 0xffu);
          w.x = (127u - (l1[ci >> 4] & 0x7fu)) * 128u + (127u - (l2[ci & 15u] & 0x7fu)); w.y = __float_as_uint(cs[rr] * inv);
        }
        {
          const unsigned ci = 255u - (c0[rr + 1] & 0xffu);
          w.z = (127u - (l1[ci >> 4] & 0x7fu)) * 128u + (127u - (l2[ci & 15u] & 0x7fu)); w.w = __float_as_uint(cs[rr + 1] * inv);
        }
        *(u32x4*)(so + rr) = w;
      }
    }
  }
}

__device__ __forceinline__ float gelu_as(float v) {
  const float av = fabsf(v), t = __builtin_amdgcn_rcpf(av * 0.2316418882f + 1.0f);
  float q = t * 0.5307027145f + (-0.7265760135f);
  q = q * t + 0.7107068705f; q = q * t + (-0.142248368f); q = q * t + 0.127414796f; q = q * t;
  const float ee = __builtin_amdgcn_exp2f((v * v) * (-0.72134752044f));
  const float m = v * (q * ee);
  return v < 0.f ? m : v - m;
}
typedef __bf16 bf16x2t __attribute__((ext_vector_type(2)));
__device__ __forceinline__ unsigned rl2(unsigned lo, unsigned hi, int j) {
  const unsigned a = (unsigned)__builtin_amdgcn_readlane((int)lo, j & 63), b = (unsigned)__builtin_amdgcn_readlane((int)hi, j & 63);
  return j < 64 ? a : b;
}
__device__ __forceinline__ float group8_sum(float x) { x += dppf<0xB1>(x); x += dppf<0x4E>(x); x += dppf<0x141>(x); return x; }
__device__ __forceinline__ float dot2u(unsigned a, unsigned b, float c) {
  return __builtin_amdgcn_fdot2_f32_bf16(__builtin_bit_cast(bf16x2t, a), __builtin_bit_cast(bf16x2t, b), c, false);
}
__device__ void phase_peer_gather(const Params& p, unsigned char* smem, int bid, int nb, int layer, int tok0, int ntok) {
  const int tid0 = tidx();
  const int wid = __builtin_amdgcn_readfirstlane(tid0 >> 6), lane = tid0 & 63, g = lane >> 3, i = lane & 7;
  const __amdgpu_buffer_rsrc_t U = __builtin_amdgcn_make_buffer_rsrc((void*)(p.u8 + (size_t)layer * NEXP * 768), (short)0, NEXP * 768, 0x00020000);
  const __amdgpu_buffer_rsrc_t V = __builtin_amdgcn_make_buffer_rsrc((void*)(p.v8 + (size_t)layer * NEXP * 768), (short)0, NEXP * 768, 0x00020000);
  const float* us = p.uscale + (size_t)layer * NEXP;
  const float* vs = p.vscale + (size_t)layer * NEXP;
  const float* modl = p.mod + (size_t)layer * 33 * MODW;
  LAS unsigned* lst = (LAS unsigned*)smem + wid * 3072;
#define PIECE(R, VOFF, K) __builtin_bit_cast(u32x4, __builtin_amdgcn_raw_buffer_load_b128(R, (VOFF) + (K) * 128, 0, 0))
  for (int grp = bid * 8 + wid; grp < ntok / 8; grp += nb * 8) {
    const int token0 = tok0 + grp * 8;
#pragma unroll 1
    for (int t = 0; t < 8; ++t) {
      const int token = token0 + t;
      const u32x2 se0 = p.sel[(size_t)token * 128 + lane], se1 = p.sel[(size_t)token * 128 + 64 + lane];
      unsigned ka = (se0.x << 7) | (unsigned)lane, kb = (se1.x << 7) | (unsigned)(lane + 64);
#define BSTEP(J, UPA, UPB)                                                                                               \
      do {                                                                                                               \
        unsigned oa, ob;                                                                                                 \
        if ((J) == 1) { oa = dppu<0xB1>(ka); ob = dppu<0xB1>(kb); }                                                      \
        else if ((J) == 2) { oa = dppu<0x4E>(ka); ob = dppu<0x4E>(kb); }                                                 \
        else if ((J) == 4) { const bool hi4 = (lane & 4) != 0;                                                           \
          const unsigned a0 = dppu<0x104>(ka), a1 = dppu<0x114>(ka), b0 = dppu<0x104>(kb), b1 = dppu<0x114>(kb);         \
          oa = hi4 ? a1 : a0; ob = hi4 ? b1 : b0; }                                                                      \
        else if ((J) == 8) { oa = dppu<0x128>(ka); ob = dppu<0x128>(kb); }                                               \
        else if ((J) == 16) { const bool odd = (lane & 16) != 0;                                                         \
          auto ta = __builtin_amdgcn_permlane16_swap(ka, ka, false, false); auto tb = __builtin_amdgcn_permlane16_swap(kb, kb, false, false); \
          oa = odd ? ta[0] : ta[1]; ob = odd ? tb[0] : tb[1]; }                                                          \
        else { const bool up32 = lane >= 32;                                                                             \
          auto ta = __builtin_amdgcn_permlane32_swap(ka, ka, false, false); auto tb = __builtin_amdgcn_permlane32_swap(kb, kb, false, false); \
          oa = up32 ? ta[0] : ta[1]; ob = up32 ? tb[0] : tb[1]; }                                                        \
        const bool lower = (lane & (J)) == 0;                                                                            \
        const unsigned mna = min(ka, oa), mxa = max(ka, oa), mnb = min(kb, ob), mxb = max(kb, ob);                       \
        ka = (lower == (UPA)) ? mna : mxa;                                                                               \
        kb = (lower == (UPB)) ? mnb : mxb;                                                                               \
      } while (0)
#define BLAYERS(K)                                                                                                       \
      do {                                                                                                               \
        const bool up = ((K) >= 64) ? true : ((lane & (K)) == 0);                                                        \
        const bool upa = up, upb = ((K) == 64) ? false : up;                                                             \
        if ((K) >= 64) BSTEP(32, upa, upb);                                                                              \
        if ((K) >= 32) BSTEP(16, upa, upb);                                                                              \
        if ((K) >= 16) BSTEP(8, upa, upb);                                                                               \
        if ((K) >= 8) BSTEP(4, upa, upb);                                                                                \
        if ((K) >= 4) BSTEP(2, upa, upb);                                                                                \
        BSTEP(1, upa, upb);                                                                                              \
      } while (0)
      BLAYERS(2); BLAYERS(4); BLAYERS(8); BLAYERS(16); BLAYERS(32); BLAYERS(64);
      { const unsigned mn = min(ka, kb), mx = max(ka, kb); ka = mn; kb = mx; }
      BLAYERS(128);
#undef BLAYERS
#undef BSTEP
      const unsigned sa = ka & 127u, sb = kb & 127u;
      const unsigned ga0 = (unsigned)__builtin_amdgcn_ds_bpermute((int)((sa & 63u) * 4u), (int)se0.y), ga1 = (unsigned)__builtin_amdgcn_ds_bpermute((int)((sa & 63u) * 4u), (int)se1.y);
      const unsigned gb0 = (unsigned)__builtin_amdgcn_ds_bpermute((int)((sb & 63u) * 4u), (int)se0.y), gb1 = (unsigned)__builtin_amdgcn_ds_bpermute((int)((sb & 63u) * 4u), (int)se1.y);
      const float gta = __uint_as_float((sa & 64u) ? ga1 : ga0), gtb = __uint_as_float((sb & 64u) ? gb1 : gb0);
      const unsigned ea = ka >> 7, eb = kb >> 7;
      lst[t * 128 + lane] = ka; lst[t * 128 + 64 + lane] = kb;
      lst[1024 + t * 128 + lane] = __float_as_uint(gta * vs[ea]); lst[1024 + t * 128 + 64 + lane] = __float_as_uint(gtb * vs[eb]);
      lst[2048 + t * 128 + lane] = __float_as_uint(us[ea]); lst[2048 + t * 128 + 64 + lane] = __float_as_uint(us[eb]);
    }
    const int token = token0 + g;
    {
      u32x4 x[4][4];
#pragma unroll
      for (int b = 0; b < 4; ++b) {
        const bf16_t* xr = p.act + (size_t)token * D + b * 256 + i * 32;
#pragma unroll
        for (int q = 0; q < 4; ++q) x[b][q] = *(const u32x4*)(xr + q * 8);
      }
      constexpr int NB1 = 4;
      u32x4 pk[NB1][6];
#pragma unroll
      for (int s = 0; s < NB1; ++s) {
        const int voff = (int)((lst[g * 128 + s] >> 7) * 768u) + i * 16;
#pragma unroll
        for (int k = 0; k < 6; ++k) pk[s][k] = PIECE(U, voff, k);
      }
#define P1_BLOCK(B, W0, W1, W2, W3, W4, W5)                                                                              \
      do {                                                                                                               \
        u32x6 w6; w6[0] = (W0); w6[1] = (W1); w6[2] = (W2); w6[3] = (W3); w6[4] = (W4); w6[5] = (W5);                    \
        const u32x16 bw = __builtin_bit_cast(u32x16, __builtin_amdgcn_cvt_scalef32_pk32_bf16_fp6(w6, 1.0f));             \
        _Pragma("unroll") for (int q = 0; q < 4; ++q) {                                                                  \
          const u32x4 xv = x[B][q];                                                                                      \
          const unsigned b0 = bw[4 * q], b1 = bw[4 * q + 1], b2 = bw[4 * q + 2], b3 = bw[4 * q + 3];                     \
          const unsigned x0 = xv[0], x1 = xv[1], x2 = xv[2], x3 = xv[3];                                                 \
          d0 = dot2u(b0, x0, d0); d1 = dot2u(b1, x1, d1); d2 = dot2u(b2, x2, d2); d3 = dot2u(b3, x3, d3);                \
        }                                                                                                                \
      } while (0)
#define P1_STEP(S, J)                                                                                                    \
      do {                                                                                                               \
        const int jn = (J) + NB1 < 128 ? (J) + NB1 : 127;                                                                \
        const int voffn = (int)((lst[g * 128 + jn] >> 7) * 768u) + i * 16;                                               \
        const float su = __uint_as_float(lst[2048 + g * 128 + (J)]), gsv = __uint_as_float(lst[1024 + g * 128 + (J)]);   \
        float d0 = 0.f, d1 = 0.f, d2 = 0.f, d3 = 0.f;                                                                    \
        P1_BLOCK(0, pk[S][0][0], pk[S][0][1], pk[S][0][2], pk[S][0][3], pk[S][1][0], pk[S][1][1]);                       \
        P1_BLOCK(1, pk[S][1][2], pk[S][1][3], pk[S][2][0], pk[S][2][1], pk[S][2][2], pk[S][2][3]);                       \
        pk[S][0] = PIECE(U, voffn, 0); pk[S][1] = PIECE(U, voffn, 1); pk[S][2] = PIECE(U, voffn, 2);                     \
        __builtin_amdgcn_sched_barrier(0);                                                                               \
        P1_BLOCK(2, pk[S][3][0], pk[S][3][1], pk[S][3][2], pk[S][3][3], pk[S][4][0], pk[S][4][1]);                       \
        P1_BLOCK(3, pk[S][4][2], pk[S][4][3], pk[S][5][0], pk[S][5][1], pk[S][5][2], pk[S][5][3]);                       \
        pk[S][3] = PIECE(U, voffn, 3); pk[S][4] = PIECE(U, voffn, 4); pk[S][5] = PIECE(U, voffn, 5);                     \
        __builtin_amdgcn_sched_barrier(0);                                                                               \
        const float d = group8_sum((d0 + d1) + (d2 + d3)) * su;                                                          \
        lst[1024 + g * 128 + (J)] = __float_as_uint(gsv * gelu_as(d));                                                   \
      } while (0)
#pragma unroll 1
      for (int j = 0; j < 128; j += 4) { P1_STEP(0, j); P1_STEP(1, j + 1); P1_STEP(2, j + 2); P1_STEP(3, j + 3); }
#undef P1_STEP
#undef P1_BLOCK
    }
    const bool isctx = token < NCTX;
    const int b = isctx ? 32 : ((token - NCTX) >> 11);
    const float* g2 = modl + (size_t)b * MODW + 5 * D + i * 32;
    float* hrow = (isctx ? p.hctx + (size_t)token * D : p.out + (size_t)(token - NCTX) * D) + i * 32;
    float ss = 0.f;
#pragma unroll 1
    for (int hf = 0; hf < 2; ++hf) {
      f32x32 y0, y1;
#pragma unroll
      for (int c = 0; c < 32; ++c) { y0[c] = 0.f; y1[c] = 0.f; }
      const int hoff = hf * 384 + i * 16;
      constexpr int NB2 = 8;
      u32x4 pk[NB2][3];
#pragma unroll
      for (int s = 0; s < NB2; ++s) {
        const int voff = (int)((lst[g * 128 + s] >> 7) * 768u) + hoff;
#pragma unroll
        for (int k = 0; k < 3; ++k) pk[s][k] = PIECE(V, voff, k);
      }
#define P2_STEP(S, J)                                                                                                    \
      do {                                                                                                               \
        const int jn = (J) + NB2 < 128 ? (J) + NB2 : 127;                                                                \
        const int voffn = (int)((lst[g * 128 + jn] >> 7) * 768u) + hoff;                                                 \
        const float a = __uint_as_float(lst[1024 + g * 128 + (J)]);                                                      \
        {                                                                                                                \
          u32x6 w6; w6[0] = pk[S][0][0]; w6[1] = pk[S][0][1]; w6[2] = pk[S][0][2]; w6[3] = pk[S][0][3]; w6[4] = pk[S][1][0]; w6[5] = pk[S][1][1]; \
          const f32x32 f = __builtin_amdgcn_cvt_scalef32_pk32_f32_fp6(w6, 1.0f);                                         \
          y0 += f * a;                                                                                                   \
        }                                                                                                                \
        __builtin_amdgcn_sched_barrier(0);                                                                               \
        {                                                                                                                \
          u32x6 w6; w6[0] = pk[S][1][2]; w6[1] = pk[S][1][3]; w6[2] = pk[S][2][0]; w6[3] = pk[S][2][1]; w6[4] = pk[S][2][2]; w6[5] = pk[S][2][3]; \
          const f32x32 f = __builtin_amdgcn_cvt_scalef32_pk32_f32_fp6(w6, 1.0f);                                         \
          y1 += f * a;                                                                                                   \
        }                                                                                                                \
        pk[S][0] = PIECE(V, voffn, 0); pk[S][1] = PIECE(V, voffn, 1); pk[S][2] = PIECE(V, voffn, 2);                     \
        __builtin_amdgcn_sched_barrier(0);                                                                               \
      } while (0)
#pragma unroll 1
      for (int j = 0; j < 128; j += 8) { P2_STEP(0, j); P2_STEP(1, j + 1); P2_STEP(2, j + 2); P2_STEP(3, j + 3); P2_STEP(4, j + 4); P2_STEP(5, j + 5); P2_STEP(6, j + 6); P2_STEP(7, j + 7); }
#undef P2_STEP
#ifdef ZERO_PEER
      if (layer == ZERO_PEER) {
#pragma unroll
        for (int c = 0; c < 32; ++c) { y0[c] = 0.f; y1[c] = 0.f; }
      }
#endif
#pragma unroll
      for (int bb = 0; bb < 2; ++bb)
#pragma unroll
        for (int q4 = 0; q4 < 8; ++q4) {
          const int co = (2 * hf + bb) * 256 + q4 * 4;
          const f32x4 hv = *(const f32x4*)(hrow + co), gv = *(const f32x4*)(g2 + co);
          f32x4 o;
#pragma unroll
          for (int e = 0; e < 4; ++e) { const float yv = bb ? y1[q4 * 4 + e] : y0[q4 * 4 + e]; const float v = hv[e] + gv[e] * yv; o[e] = v; ss += v * v; }
          *(f32x4*)(hrow + co) = o;
        }
    }
    {
      ss = group8_sum(ss);
      const float rstd = rsqrtf(ss * (1.f / D) + EPS);
      if (layer == 0) {
        const float* modn = p.mod + (size_t)33 * MODW + (size_t)b * MODW + i * 32;
        const float* gain = p.mix_g + D + i * 32;
#pragma unroll 2
        for (int k = 0; k < 16; ++k) {
          const int co = (k >> 2) * 256 + (k & 3) * 8;
          u32x4 w;
#pragma unroll
          for (int q4 = 0; q4 < 2; ++q4) {
            const f32x4 hv = *(const f32x4*)(hrow + co + q4 * 4);
            const f32x4 gg = *(const f32x4*)(gain + co + q4 * 4), s0 = *(const f32x4*)(modn + co + q4 * 4), s1 = *(const f32x4*)(modn + D + co + q4 * 4);
            f32x4 yv = hv * rstd * gg;
            yv = yv * (1.f + s1) + s0;
            w[q4 * 2] = cvt_pk_bf16(yv[0], yv[1]); w[q4 * 2 + 1] = cvt_pk_bf16(yv[2], yv[3]);
          }
          *(u32x4*)(p.act + (size_t)token * D + i * 32 + co) = w;
        }
      } else {
        const float* gain = p.final_g + i * 32;
#pragma unroll 2
        for (int k = 0; k < 32; ++k) {
          const int co = (k >> 3) * 256 + (k & 7) * 4;
          const f32x4 hv = *(const f32x4*)(hrow + co), gg = *(const f32x4*)(gain + co);
          *(f32x4*)(hrow + co) = hv * rstd * gg;
        }
      }
    }
    __syncthreads();
  }
#undef PIECE
}

constexpr int NPH = 18;
template <int PH>
__device__ __forceinline__ void run_phase(const Params& p, unsigned char* smem, int bid, int nb) {
  if constexpr (PH == 0) phase_prep(p, smem, bid, nb);
  else if constexpr (PH == 1) phase_norm(p, bid, nb, 0, NTOK, p.ctx, p.x, p.mix_g, p.mod, 0, 1);
  else if constexpr (PH == 2) phase_gemm_inproj(p, smem, bid, nb, 0);
  else if constexpr (PH == 3) phase_ret_kv(p, smem, bid, nb);
  else if constexpr (PH == 4) phase_ret_scan(p, bid, nb);
  else if constexpr (PH == 5) phase_ret_out(p, smem, bid, nb);
  else if constexpr (PH == 6) phase_gemm_outproj(p, smem, bid, nb, 0);
  else if constexpr (PH == 7) phase_resid_norm(p, bid, nb, 0, NTOK, p.ctx, p.x, p.ffn_g, p.mod);
  else if constexpr (PH == 8) phase_gemm_pq(p, smem, bid, nb, 0);
  else if constexpr (PH == 9) phase_peer_topk(p, smem, bid, nb, 0, 0, NTOK);
  else if constexpr (PH == 10) phase_peer_gather(p, smem, bid, nb, 0, 0, NTOK);
  else if constexpr (PH == 11) phase_gemm_inproj(p, smem, bid, nb, 1);
  else if constexpr (PH == 12) phase_attn<0>(p, smem, bid, nb, p.act);
  else if constexpr (PH == 13) phase_gemm_outproj(p, smem, bid, nb, 1);
  else if constexpr (PH == 14) phase_resid_norm(p, bid, nb, NCTX, NTOK, p.hctx, p.out, p.ffn_g + D, p.mod + (size_t)33 * MODW);
  else if constexpr (PH == 15) phase_gemm_pq(p, smem, bid, nb, 1);
  else if constexpr (PH == 16) phase_peer_topk(p, smem, bid, nb, 1, NCTX, NLAT);
  else if constexpr (PH == 17) phase_peer_gather(p, smem, bid, nb, 1, NCTX, NLAT);
}
template <int PH>
__global__ void __launch_bounds__(NTHREADS) phase_k(Params p) {
  extern __shared__ __attribute__((aligned(16))) unsigned char smem[];
  run_phase<PH>(p, smem, blockIdx.x, gridDim.x);
}
#define XB_TMO      128
#define XB_XCNT(j)  (256  + 64 * (j))
#define XB_XSUB(j)  (1280 + 64 * (j))
#define XB_XGEN(j)  (2304 + 64 * (j))
#define XB_TOP      3328
#define XB_TOPGEN   3392
#define XCD_BAR_WORDS 3456
#define XB_SPIN_CAP (1u << 22)
__device__ __forceinline__ unsigned xb_ld(unsigned* p)              { return __hip_atomic_load(p, __ATOMIC_RELAXED, __HIP_MEMORY_SCOPE_AGENT); }
__device__ __forceinline__ unsigned xb_add(unsigned* p, unsigned v) { return __hip_atomic_fetch_add(p, v, __ATOMIC_RELAXED, __HIP_MEMORY_SCOPE_AGENT); }
__device__ __forceinline__ unsigned xb_xcc_id() { return (unsigned)__builtin_amdgcn_s_getreg((3 << 11) | 20) & 0xFu; }
#define XB_SPIN(cond, bar) do { unsigned _sp = 0; while (cond) { __builtin_amdgcn_s_sleep(1); \
    if ((++_sp & 255u) == 0u) { if (xb_ld(&(bar)[XB_TMO])) break; if (_sp > XB_SPIN_CAP) { atomicAdd(&(bar)[XB_TMO], 1u); break; } } } } while (0)
struct XcdBarrier { unsigned* bar; unsigned x; volatile LAS unsigned* st; };
__device__ __forceinline__ XcdBarrier xcd_barrier_post(unsigned* bar, volatile LAS unsigned* st) {
  XcdBarrier b; b.bar = bar; b.x = xb_xcc_id(); b.st = st;
  if (threadIdx.x == 0) (void)xb_add(&bar[XB_XCNT(b.x)], 1u);
  return b;
}
__device__ __forceinline__ void xcd_barrier_complete(unsigned* bar, unsigned x, unsigned& nloc, unsigned& nx) {
  const unsigned G = gridDim.x * gridDim.y * gridDim.z;
  unsigned sum, cnt, mine, sp = 0u;
  for (;;) {
    sum = 0u; cnt = 0u; mine = 0u;
#pragma unroll
    for (unsigned j = 0; j < 16; ++j) { const unsigned c = xb_ld(&bar[XB_XCNT(j)]); sum += c; cnt += (c > 0u) ? 1u : 0u; mine = (j == x) ? c : mine; }
    if (sum == G) break;
    __builtin_amdgcn_s_sleep(1);
    if ((++sp & 255u) == 0u) { if (xb_ld(&bar[XB_TMO])) break; if (sp > XB_SPIN_CAP) { atomicAdd(&bar[XB_TMO], 1u); break; } }
  }
  nloc = mine > 0u ? mine : 1u; nx = cnt > 0u ? cnt : 1u;
}
__device__ __forceinline__ void xcd_barrier(const XcdBarrier& b) {
  asm volatile("s_waitcnt vmcnt(0)" ::: "memory");
  __syncthreads();
  if (threadIdx.x == 0) {
    unsigned* bar = b.bar;
    __builtin_amdgcn_s_waitcnt(0);
    unsigned nloc = b.st[0], nx = b.st[1];
    if (nloc == 0u) { xcd_barrier_complete(bar, b.x, nloc, nx); b.st[0] = nloc; b.st[1] = nx; }
    const unsigned old = xb_add(&bar[XB_XSUB(b.x)], 1u);
    const unsigned gen = old / nloc;
    if (old + 1u == (gen + 1u) * nloc) {
      __builtin_amdgcn_fence(__ATOMIC_RELEASE, "agent");
      asm volatile("s_waitcnt vmcnt(0)" ::: "memory");
      const unsigned og = xb_add(&bar[XB_TOP], 1u);
      const unsigned tg = og / nx;
      if (og + 1u == (tg + 1u) * nx) xb_add(&bar[XB_TOPGEN], 1u);
      else XB_SPIN(xb_ld(&bar[XB_TOPGEN]) == tg, bar);
      __builtin_amdgcn_fence(__ATOMIC_ACQUIRE, "agent");
      xb_add(&bar[XB_XGEN(b.x)], 1u);
      asm volatile("s_waitcnt vmcnt(0)" ::: "memory");
    } else {
      XB_SPIN(xb_ld(&bar[XB_XGEN(b.x)]) == gen, bar);
      __builtin_amdgcn_fence(__ATOMIC_ACQUIRE, "agent");
      asm volatile("s_waitcnt vmcnt(0)" ::: "memory");
    }
  }
  __syncthreads();
}

#if MK_ONE_LAUNCH
constexpr int PARAMS_OFF = LDS_BYTES - 512;
static_assert(sizeof(Params) <= 480, "params block");
template <class T>
__device__ __forceinline__ T* uni(T* q) {
  const unsigned long long v = (unsigned long long)q;
  const unsigned lo = __builtin_amdgcn_readfirstlane((unsigned)v), hi = __builtin_amdgcn_readfirstlane((unsigned)(v >> 32));
  return (T*)(((unsigned long long)hi << 32) | lo);
}
__device__ __forceinline__ Params load_params(const unsigned char* smem) {
  const Params* l = (const Params*)(smem + PARAMS_OFF);
  Params q;
  q.x = uni(l->x); q.c = uni(l->c); q.ctx = uni(l->ctx); q.c_ctx = uni(l->c_ctx); q.ada_w = uni(l->ada_w); q.ada_b = uni(l->ada_b);
  q.mix_g = uni(l->mix_g); q.ffn_g = uni(l->ffn_g); q.ev_w_in = uni(l->ev_w_in); q.ev_w_out = uni(l->ev_w_out);
  q.logit_f = uni(l->logit_f); q.logit_b = uni(l->logit_b); q.conv_w = uni(l->conv_w); q.od_w_in = uni(l->od_w_in);
  q.od_w_out = uni(l->od_w_out); q.sinks = uni(l->sinks); q.peer_wq = uni(l->peer_wq); q.keys1 = uni(l->keys1); q.keys2 = uni(l->keys2);
  q.peer_u = uni(l->peer_u); q.peer_v = uni(l->peer_v); q.final_g = uni(l->final_g); q.out = uni(l->out); q.mod = uni(l->mod);
  q.ropec = uni(l->ropec); q.ropes = uni(l->ropes); q.winT0 = uni(l->winT0); q.woutT0 = uni(l->woutT0); q.winT1 = uni(l->winT1);
  q.woutT1 = uni(l->woutT1); q.wqT = uni(l->wqT); q.u8 = uni(l->u8); q.v8 = uni(l->v8); q.uscale = uni(l->uscale); q.vscale = uni(l->vscale); q.hctx = uni(l->hctx); q.act = uni(l->act);
  q.proj = uni(l->proj); q.pq = uni(l->pq); q.sel = uni(l->sel); q.kv = uni(l->kv); q.sprev = uni(l->sprev); q.bar = uni(l->bar); q.keysb = uni(l->keysb);
  return q;
}
template <int PH>
__device__ __forceinline__ void run_from(unsigned char* smem, int bid, int nb, const XcdBarrier& xb) {
  {
    const Params q = load_params(smem);
    run_phase<PH>(q, smem, bid, nb);
  }
#ifdef DUP_PH
  if constexpr (PH == DUP_PH) {
    xcd_barrier(xb);
    const Params q = load_params(smem);
#ifdef DUP_ATTN_VAR
    phase_attn<DUP_ATTN_VAR>(q, smem, bid, nb, q.proj + (size_t)113246208);
#else
    run_phase<PH>(q, smem, bid, nb);
#endif
  }
#endif
  if constexpr (PH + 1 < NPH) {
    if constexpr (PH == 0) cg::this_grid().sync();
    else xcd_barrier(xb);
    run_from<PH + 1>(smem, bid, nb, xb);
  }
}
__global__ void __launch_bounds__(NTHREADS) mega(Params p) {
  extern __shared__ __attribute__((aligned(16))) unsigned char smem[];
  volatile LAS unsigned* st = (volatile LAS unsigned*)((LAS unsigned char*)smem + PARAMS_OFF + 480);
  if (threadIdx.x == 0) { *(Params*)(smem + PARAMS_OFF) = p; st[0] = 0u; st[1] = 0u; }
  __syncthreads();
  const XcdBarrier xb = xcd_barrier_post(p.bar, st);
  run_from<0>(smem, blockIdx.x, gridDim.x, xb);
}
#endif
#ifndef DBG_NPH
#define DBG_NPH 0
#endif
#if DBG_NPH
__global__ void __launch_bounds__(NTHREADS) dbg_sums(Params p, float* scr, int nph) {
  const int wid = threadIdx.x >> 6, lane = threadIdx.x & 63;
  const int gw = blockIdx.x * 8 + wid, nw = gridDim.x * 8;
  if (nph >= 2) for (int r = gw; r < NTOK; r += nw) { float s = 0.f; for (int c = lane; c < D; c += 64) s += bf2f(p.act[(size_t)r * D + c]) * (1 + (c & 7)); s = wave_sum(s); if (lane == 0) scr[r] = s; }
  if (nph >= 3 && nph <= 8) for (int r = gw; r < NTOK; r += nw) { float s = 0.f; for (int c = lane; c < 3072; c += 64) s += bf2f(p.proj[(size_t)r * 3072 + c]) * (1 + (c & 7)); s = wave_sum(s); if (lane == 0) scr[(1 << 20) + r] = s; }
  if (nph >= 12 && nph <= 15) for (int r = gw; r < NTOK; r += nw) { float s = 0.f; for (int c = lane + (r < NCTX ? 1024 : 0); c < 1536; c += 64) s += bf2f(p.proj[(size_t)r * 1536 + c]) * (1 + (c & 7)); s = wave_sum(s); if (lane == 0) scr[(1 << 20) + r] = s; }
  if (nph >= 4) for (int r = gw; r < 2304 * 128; r += nw) { float s = 0.f; for (int c = lane; c < 128; c += 64) s += p.kv[(size_t)r * 128 + c] * (1 + (c & 7)); s = wave_sum(s); if (lane == 0) scr[(2 << 20) + r] = s; }
  if (nph >= 5) for (int r = gw; r < 2304 * 128; r += nw) { float s = 0.f; for (int c = lane; c < 128; c += 64) s += bf2f(p.sprev[(size_t)r * 128 + c]) * (1 + (c & 7)); s = wave_sum(s); if (lane == 0) scr[(3 << 20) + r] = s; }
  if (nph >= 7) for (int r = gw; r < NCTX; r += nw) { float s = 0.f; for (int c = lane; c < D; c += 64) s += p.hctx[(size_t)r * D + c] * (1 + (c & 7)); s = wave_sum(s); if (lane == 0) scr[(4 << 20) + r] = s; }
  if (nph >= 1) for (int i = blockIdx.x * NTHREADS + threadIdx.x; i < 2 * 33 * MODW; i += gridDim.x * NTHREADS) scr[(5 << 20) + i] = p.mod[i];
  if (nph >= 7) for (int r = gw; r < NLAT; r += nw) { float s = 0.f; for (int c = lane; c < D; c += 64) s += p.out[(size_t)r * D + c] * (1 + (c & 7)); s = wave_sum(s); if (lane == 0) scr[(6 << 20) + r] = s; }
  if (nph >= 10 && nph <= 11) for (int r = gw; r < NTOK; r += nw) { float s = 0.f; for (int c = lane; c < 128; c += 64) { const u32x2 e = p.sel[(size_t)r * 128 + c]; s += __uint_as_float(e.y) * (float)(e.x & 1023); } s = wave_sum(s); if (lane == 0) scr[(7 << 20) + r] = s; }
}
__global__ void __launch_bounds__(NTHREADS) dbg_out(Params p, const float* scr) {
  for (size_t i = (size_t)blockIdx.x * NTHREADS + threadIdx.x; i < (size_t)NLAT * D; i += (size_t)gridDim.x * NTHREADS) p.out[i] = (i < (size_t)(8 << 20)) ? scr[i] : 0.f;
}
__global__ void __launch_bounds__(NTHREADS) dbg_zero(float* scr) {
  for (size_t i = (size_t)blockIdx.x * NTHREADS + threadIdx.x; i < (size_t)(8 << 20); i += (size_t)gridDim.x * NTHREADS) scr[i] = 0.f;
}
#endif
template <int PH>
static void launch_phases(const Params& p, int grid, hipStream_t stream) {
  static bool attr_set = false;
  if (!attr_set) { (void)hipFuncSetAttribute((const void*)phase_k<PH>, hipFuncAttributeMaxDynamicSharedMemorySize, LDS_BYTES); attr_set = true; }
  phase_k<PH><<<grid, NTHREADS, LDS_BYTES, stream>>>(p);
  if constexpr (PH + 1 < (DBG_NPH ? DBG_NPH : NPH)) launch_phases<PH + 1>(p, grid, stream);
}

extern "C" void kernel_launch(void* const* d_in, const int* in_sizes, int n_in, void* d_out, int out_size, void* d_ws,
                              size_t ws_size, hipStream_t stream) {
  Params p{};
  const float* const* in = (const float* const*)d_in;
  p.x = in[0]; p.c = in[1]; p.ctx = in[2]; p.c_ctx = in[3]; p.ada_w = in[4]; p.ada_b = in[5]; p.mix_g = in[6]; p.ffn_g = in[7];
  p.ev_w_in = in[8]; p.ev_w_out = in[9]; p.logit_f = in[10]; p.logit_b = in[11]; p.conv_w = in[12]; p.od_w_in = in[13];
  p.od_w_out = in[14]; p.sinks = in[15]; p.peer_wq = in[16]; p.keys1 = in[17]; p.keys2 = in[18]; p.peer_u = in[19];
  p.peer_v = in[20]; p.final_g = in[21];
  p.out = (float*)d_out;
  unsigned char* w = (unsigned char*)d_ws;
  size_t off = 0;
  auto take = [&](size_t bytes) { unsigned char* r = w + off; off += (bytes + 255) & ~(size_t)255; return r; };
  p.mod = (float*)take((size_t)2 * 33 * MODW * 4);
  p.ropec = (float*)take(1024 * 4);
  p.ropes = (float*)take(1024 * 4);
  p.winT0 = (bf16_t*)take((size_t)3072 * 1024 * 2);
  p.woutT0 = (bf16_t*)take((size_t)1024 * 1024 * 2);
  p.winT1 = (bf16_t*)take((size_t)1536 * 1024 * 2);
  p.woutT1 = (bf16_t*)take((size_t)1024 * 1024 * 2);
  p.wqT = (bf16_t*)take((size_t)2 * 1024 * 1024 * 2);
  p.u8 = (unsigned char*)take((size_t)2 * NEXP * 768);
  p.v8 = (unsigned char*)take((size_t)2 * NEXP * 768);
  p.uscale = (float*)take((size_t)2 * NEXP * 4);
  p.vscale = (float*)take((size_t)2 * NEXP * 4);
  p.hctx = (float*)take((size_t)NCTX * D * 4);
  p.act = (bf16_t*)take((size_t)NTOK * D * 2);
  p.kv = (float*)take((size_t)2304 * 16384 * 4);
  p.sprev = (bf16_t*)take((size_t)2304 * 16384 * 2);
  p.bar = (unsigned*)take((size_t)XCD_BAR_WORDS * 4);
  p.keysb = (bf16_t*)take((size_t)2 * 8 * 2 * 2 * 128 * 64 * 2);
  p.proj = (bf16_t*)take((size_t)NTOK * 3072 * 2);
  p.pq = p.proj;
  p.sel = (u32x2*)((unsigned char*)p.proj + (size_t)NTOK * D * 2);
  if (off > ws_size) { fprintf(stderr, "workspace too small: need %zu have %zu\n", off, ws_size); }

  int grid = 256;
#if MK_ONE_LAUNCH
  static int grid_blocks = 0;
  if (!grid_blocks) {
    (void)hipFuncSetAttribute((const void*)mega, hipFuncAttributeMaxDynamicSharedMemorySize, LDS_BYTES);
    int dev = 0, cus = 0, per_cu = 0;
    (void)hipGetDevice(&dev);
    (void)hipDeviceGetAttribute(&cus, hipDeviceAttributeMultiprocessorCount, dev);
    (void)hipOccupancyMaxActiveBlocksPerMultiprocessor(&per_cu, mega, NTHREADS, LDS_BYTES);
    if (per_cu > 1) per_cu = 1;
    grid_blocks = cus * per_cu;
    if (grid_blocks <= 0) grid_blocks = 256;
  }
  grid = grid_blocks;
  (void)hipMemsetAsync(p.bar, 0, (size_t)XCD_BAR_WORDS * 4, stream);
  void* args[] = {&p};
  hipError_t e = hipLaunchCooperativeKernel((const void*)mega, dim3(grid), dim3(NTHREADS), args, LDS_BYTES, stream);
  if (e != hipSuccess) fprintf(stderr, "cooperative launch failed: %s\n", hipGetErrorString(e));
#else
  launch_phases<0>(p, grid, stream);
#if DBG_NPH
  float* scr = (float*)(w + off);
  dbg_zero<<<grid, NTHREADS, 0, stream>>>(scr);
  dbg_sums<<<grid, NTHREADS, 0, stream>>>(p, scr, DBG_NPH);
  dbg_out<<<grid, NTHREADS, 0, stream>>>(p, scr);
#endif
#endif
}
```

```cpp
#include <hip/hip_runtime.h>
#include <hip/hip_cooperative_groups.h>
#include <cstdio>
#include <cstdint>
namespace cg = cooperative_groups;

#ifndef MK_ONE_LAUNCH
#define MK_ONE_LAUNCH 1
#endif

typedef unsigned short bf16_t;
typedef short bf16x8 __attribute__((ext_vector_type(8)));
typedef short bf16x2v __attribute__((ext_vector_type(2)));
typedef float f32x4 __attribute__((ext_vector_type(4)));
typedef unsigned u32x4 __attribute__((ext_vector_type(4)));
typedef unsigned u32x2 __attribute__((ext_vector_type(2)));
typedef unsigned u32x6 __attribute__((ext_vector_type(6)));
typedef unsigned u32x16 __attribute__((ext_vector_type(16)));
typedef float f32x32 __attribute__((ext_vector_type(32)));
typedef __bf16 bf16x32n __attribute__((ext_vector_type(32)));

constexpr int D = 1024, BATCH = 32, SEQ = 2048, CTXL = 256;
constexpr int NCTX = BATCH * CTXL;
constexpr int NLAT = BATCH * SEQ;
constexpr int NTOK = NCTX + NLAT;
constexpr int MODW = 6 * D;
constexpr int NEXP = 16384;
constexpr float EPS = 1e-6f;
constexpr int NTHREADS = 512;
constexpr int LDS_BYTES = 140 * 1024;

struct Params {
  const float *x, *c, *ctx, *c_ctx, *ada_w, *ada_b, *mix_g, *ffn_g, *ev_w_in, *ev_w_out, *logit_f, *logit_b, *conv_w,
      *od_w_in, *od_w_out, *sinks, *peer_wq, *keys1, *keys2, *peer_u, *peer_v, *final_g;
  float* out;
  float* mod;
  float* ropec;
  float* ropes;
  bf16_t* winT0;
  bf16_t* woutT0;
  bf16_t* winT1;
  bf16_t* woutT1;
  bf16_t* wqT;
  unsigned char* u8;
  unsigned char* v8;
  float* uscale;
  float* vscale;
  float* hctx;
  bf16_t* act;
  bf16_t* proj;
  bf16_t* pq;
  u32x2* sel;
  float* kv;
  bf16_t* sprev;
  bf16_t* keysb;
  unsigned* bar;
};

typedef __bf16 bf16x2n __attribute__((ext_vector_type(2)));
typedef float f32x2 __attribute__((ext_vector_type(2)));
__device__ __forceinline__ unsigned cvt_pk_bf16(float lo, float hi) {
  f32x2 v = {lo, hi};
  return __builtin_bit_cast(unsigned, __builtin_convertvector(v, bf16x2n));
}
__device__ __forceinline__ float bf_lo(unsigned u) { return __uint_as_float(u << 16); }
__device__ __forceinline__ float bf_hi(unsigned u) { return __uint_as_float(u & 0xffff0000u); }
__device__ __forceinline__ float bf2f(bf16_t h) { return __uint_as_float(((unsigned)h) << 16); }
__device__ __forceinline__ bf16_t f2bf(float f) { return __builtin_bit_cast(unsigned short, (__bf16)f); }

template <int CTRL>
__device__ __forceinline__ float dppf(float x) {
  return __builtin_bit_cast(float, __builtin_amdgcn_mov_dpp(__builtin_bit_cast(int, x), CTRL, 0xf, 0xf, true));
}
template <int CTRL>
__device__ __forceinline__ unsigned dppu(unsigned x) { return (unsigned)__builtin_amdgcn_mov_dpp((int)x, CTRL, 0xf, 0xf, true); }
__device__ __forceinline__ float row16_sum(float x) {
  x += dppf<0xB1>(x); x += dppf<0x4E>(x); x += dppf<0x141>(x); x += dppf<0x128>(x);
  return x;
}
__device__ __forceinline__ float row16_max(float x) {
  x = fmaxf(x, dppf<0xB1>(x)); x = fmaxf(x, dppf<0x4E>(x)); x = fmaxf(x, dppf<0x141>(x)); x = fmaxf(x, dppf<0x128>(x));
  return x;
}
__device__ __forceinline__ float xrow16_sum(float x) {
  auto s = __builtin_amdgcn_permlane16_swap(__float_as_uint(x), __float_as_uint(x), false, false);
  x = __uint_as_float(s[0]) + __uint_as_float(s[1]);
  auto t = __builtin_amdgcn_permlane32_swap(__float_as_uint(x), __float_as_uint(x), false, false);
  return __uint_as_float(t[0]) + __uint_as_float(t[1]);
}
__device__ __forceinline__ float wave_sum(float x) { return xrow16_sum(row16_sum(x)); }
__device__ __forceinline__ float wave_max(float x) {
  x = row16_max(x);
  auto s = __builtin_amdgcn_permlane16_swap(__float_as_uint(x), __float_as_uint(x), false, false);
  x = fmaxf(__uint_as_float(s[0]), __uint_as_float(s[1]));
  auto t = __builtin_amdgcn_permlane32_swap(__float_as_uint(x), __float_as_uint(x), false, false);
  return fmaxf(__uint_as_float(t[0]), __uint_as_float(t[1]));
}

__device__ __forceinline__ int tidx() {
  int t = threadIdx.x;
  asm volatile("" : "+v"(t));
  __builtin_assume(t >= 0 && t < NTHREADS);
  return t;
}
__device__ __forceinline__ float siluf(float v) { return v / (1.f + __expf(-v)); }
__device__ __forceinline__ float log_sigmoidf(float v) { return -log1pf(expf(-v)); }

#define LAS __attribute__((address_space(3)))
constexpr int BM = 256, BK = 64, HALF = 128, HTB = HALF * BK * 2, NXCD = 8, WGM = 8;
constexpr int KDIM = 1024;

__device__ __forceinline__ int lds_byte(int r, int c) {
  const int st = (r >> 4) * 2 + (c >> 5), rr = r & 15, cc = c & 31, ob = rr * 64 + cc * 2;
  return st * 1024 + (ob ^ (((ob >> 9) & 1) << 5));
}
__device__ __forceinline__ void stage_rc(int b, int& R, int& C) {
  const int st = b / 1024, sb = b % 1024, swz = sb ^ (((sb >> 9) & 1) << 5);
  R = (st >> 1) * 16 + swz / 64;
  C = (st & 1) * 32 + (swz % 64) / 2;
}
__device__ __forceinline__ int perm32(int rho) { const int n = rho >> 4, i = rho & 15; return 8 * (i >> 2) + 4 * n + (i & 3); }
struct Sched {
  int pm0, pn0, nM, nN, G, c;
  __device__ __forceinline__ bool next(int i, int& pm, int& pn) const {
    const int nwg = nM * nN;
    const long L = (long)i * G + c;
    if (L >= nwg) return false;
    int wgid = (int)L;
    { const int q = nwg / NXCD, r = nwg % NXCD, xcd = wgid % NXCD, off = wgid / NXCD; wgid = (xcd < r ? xcd * (q + 1) : r * (q + 1) + (xcd - r) * q) + off; }
    const int nig = WGM * nN, gid = wgid / nig, fm = gid * WGM, gsz = (nM - fm) < WGM ? (nM - fm) : WGM;
    pm = pm0 + fm + ((wgid % nig) % gsz);
    pn = pn0 + (wgid % nig) / gsz;
    return true;
  }
};

template <class Epi>
__device__ __forceinline__ void gemm_phase(LAS unsigned char* lds, const bf16_t* __restrict__ Ag, const bf16_t* __restrict__ Btg, const Sched& S, const Epi& E) {
  const int tid = tidx(), wid = __builtin_amdgcn_readfirstlane(tid >> 6), lane = tid & 63, wr = wid >> 2, wc = wid & 3, fr = lane & 15, fq = lane >> 4;
  constexpr int K = KDIM, nt = K / BK;
  unsigned voffA[2], voffB[2];
#pragma unroll
  for (int i = 0; i < 2; ++i) { int R, C; stage_rc(tid * 16 + i * 8192, R, C); const int Rb = Epi::PERM ? ((R & ~31) + perm32(R & 31)) : R;
    voffA[i] = (unsigned)(R * K + C) * 2u; voffB[i] = (unsigned)(Rb * K + C) * 2u; }
  const size_t kstep = (size_t)(BK * 2);
  const size_t hstep = (size_t)HALF * K * 2;
  const size_t tstep = 2 * hstep;
  const unsigned ldsw = (unsigned)wid * 1024u;
  const int aoff = lds_byte(wr * 64 + fr, fq * 8), boff = lds_byte(wc * 32 + fr, fq * 8);
#define G_SA(b, h) (((b) * 2 + (h)) * HTB)
#define G_SB(b, h) ((4 + (b) * 2 + (h)) * HTB)
#define G_STAGEX(bufoff, gbase, VO) do { _Pragma("unroll") for (int _i = 0; _i < 2; ++_i) \
    __builtin_amdgcn_global_load_lds((const unsigned*)((const char*)(gbase) + VO[_i]), (LAS unsigned*)(lds + (bufoff) + ldsw + _i * 8192), 16, 0, 0); } while (0)
#define G_STAGE(bufoff, gbase) G_STAGEX(bufoff, gbase, voffA)
#define G_STAGEB(bufoff, gbase) G_STAGEX(bufoff, gbase, voffB)
#define G_LDA(dst, b, h) do { _Pragma("unroll") for (int m = 0; m < 4; ++m) _Pragma("unroll") for (int k = 0; k < 2; ++k) dst[m][k] = *(const LAS bf16x8*)(lds + G_SA(b, h) + aoff + m * 2048 + k * 1024); } while (0)
#define G_LDB(dst, b, h) do { _Pragma("unroll") for (int n = 0; n < 2; ++n) _Pragma("unroll") for (int k = 0; k < 2; ++k) dst[n][k] = *(const LAS bf16x8*)(lds + G_SB(b, h) + boff + n * 2048 + k * 1024); } while (0)
#define G_MMA(ai, bj, At, Bt) do { __builtin_amdgcn_s_setprio(1); _Pragma("unroll") for (int m = 0; m < 4; ++m) _Pragma("unroll") for (int n = 0; n < 2; ++n) _Pragma("unroll") for (int k = 0; k < 2; ++k) \
    acc[ai][bj][m][n] = __builtin_amdgcn_mfma_f32_16x16x32_bf16(Bt[n][k], At[m][k], acc[ai][bj][m][n], 0, 0, 0); __builtin_amdgcn_s_setprio(0); } while (0)
#define G_WAIT_V(n) asm volatile("s_waitcnt vmcnt(" #n ")" ::: "memory")
#define G_WAIT_L(n) asm volatile("s_waitcnt lgkmcnt(" #n ")" ::: "memory")
#define G_BAR __builtin_amdgcn_s_barrier()
#define G_SCHED __builtin_amdgcn_sched_barrier(0)
  int cpm, cpn, npm, npn, ui = 0;
  if (!S.next(0, cpm, cpn)) return;
  f32x4 acc[2][2][4][2];
#pragma unroll
  for (int a = 0; a < 2; ++a)
#pragma unroll
    for (int b = 0; b < 2; ++b)
#pragma unroll
      for (int m = 0; m < 4; ++m)
#pragma unroll
        for (int n = 0; n < 2; ++n) acc[a][b][m][n] = (f32x4){0.f, 0.f, 0.f, 0.f};
  bf16x8 At[4][2], B0[2][2], B1[2][2];
  const char* cA = (const char*)Ag + (size_t)cpm * tstep;
  const char* cB = (const char*)Btg + (size_t)cpn * tstep;
  G_STAGEB(G_SB(0, 0), cB); G_STAGE(G_SA(0, 0), cA); G_STAGEB(G_SB(0, 1), cB + hstep); G_STAGE(G_SA(0, 1), cA + hstep);
  if (wr == 1) G_BAR;
  G_WAIT_V(4); G_BAR;
  G_STAGEB(G_SB(1, 0), cB + kstep); G_STAGE(G_SA(1, 0), cA + kstep); G_STAGEB(G_SB(1, 1), cB + hstep + kstep);
  G_WAIT_V(6); G_BAR;
  for (;;) {
    const bool has_next = S.next(ui + 1, npm, npn);
    const char* nA = has_next ? (const char*)Ag + (size_t)npm * tstep : cA;
    const char* nB = has_next ? (const char*)Btg + (size_t)npn * tstep : cB;
    for (int t = 0; t < nt; t += 2) {
      const bool last = (t == nt - 2);
      const char* a1 = cA + (size_t)(t + 1) * kstep;
      const char* a2 = last ? nA : cA + (size_t)(t + 2) * kstep;
      const char* b2 = last ? nB : cB + (size_t)(t + 2) * kstep;
      const char* a3 = a2 + kstep;
      const char* b3 = b2 + kstep;
      G_LDB(B0, 0, 0); G_SCHED; G_LDA(At, 0, 0); G_STAGE(G_SA(1, 1), a1 + hstep);
      G_WAIT_L(8); G_BAR; G_WAIT_L(0); G_MMA(0, 0, At, B0); G_BAR; G_SCHED;
      G_LDB(B1, 0, 1); G_STAGEB(G_SB(0, 0), b2);
      G_BAR; G_WAIT_L(0); G_MMA(0, 1, At, B1); G_BAR;
      G_LDA(At, 0, 1); G_STAGE(G_SA(0, 0), a2);
      G_BAR; G_WAIT_L(0); G_MMA(1, 0, At, B0); G_BAR; G_SCHED;
      G_STAGEB(G_SB(0, 1), b2 + hstep);
      G_WAIT_V(6); G_BAR; G_MMA(1, 1, At, B1); G_BAR;
      G_LDB(B0, 1, 0); G_SCHED; G_LDA(At, 1, 0); G_STAGE(G_SA(0, 1), a2 + hstep);
      G_WAIT_L(8); G_BAR; G_WAIT_L(0); G_MMA(0, 0, At, B0); G_BAR; G_SCHED;
      G_LDB(B1, 1, 1); G_STAGEB(G_SB(1, 0), b3);
      G_BAR; G_WAIT_L(0); G_MMA(0, 1, At, B1); G_BAR;
      G_LDA(At, 1, 1); G_STAGE(G_SA(1, 0), a3);
      G_BAR; G_WAIT_L(0); G_MMA(1, 0, At, B0); G_BAR; G_SCHED;
      G_STAGEB(G_SB(1, 1), b3 + hstep);
      G_WAIT_V(6); G_BAR; G_MMA(1, 1, At, B1); G_BAR;
    }
    E(acc, cpm * BM, cpn * BM, wr, wc, fr, fq);
    if (!has_next) break;
#pragma unroll
    for (int a = 0; a < 2; ++a)
#pragma unroll
      for (int b = 0; b < 2; ++b)
#pragma unroll
        for (int m = 0; m < 4; ++m)
#pragma unroll
          for (int n = 0; n < 2; ++n) acc[a][b][m][n] = (f32x4){0.f, 0.f, 0.f, 0.f};
    cpm = npm; cpn = npn; cA = nA; cB = nB; ++ui;
  }
  G_WAIT_V(0);
  if (wr == 0) G_BAR;
  G_BAR;
#undef G_SA
#undef G_SB
#undef G_STAGE
#undef G_STAGEB
#undef G_STAGEX
#undef G_LDA
#undef G_LDB
#undef G_MMA
}

__device__ __forceinline__ f32x4 xlane32(const f32x4 v, const bool upper) {
  f32x4 r;
#pragma unroll
  for (int j = 0; j < 4; ++j) {
    const float x = v[j];
    auto t = __builtin_amdgcn_permlane32_swap(__float_as_uint(x), __float_as_uint(x), false, false);
    r[j] = __uint_as_float(upper ? t[0] : t[1]);
  }
  return r;
}
struct EpiInProj {
  static constexpr bool PERM = true;
  bf16_t* P; int ldc; int layer; const float* cosT; const float* sinT;
  __device__ __forceinline__ void operator()(const f32x4 (&acc)[2][2][4][2], int brow, int bcol, int wr, int wc, int fr, int fq) const {
#pragma unroll
    for (int bj = 0; bj < 2; ++bj) {
      const int colbase = bcol + bj * HALF + wc * 32;
      bool rope, scl;
      if (layer == 0) { rope = colbase < 512; scl = (colbase >= 256 && colbase < 512); }
      else { rope = colbase < 1280; scl = colbase < 1024; }
      const float sq = layer == 1 ? 0.125f * 1.44269504089f : 0.125f;
#pragma unroll
      for (int ai = 0; ai < 2; ++ai)
#pragma unroll
        for (int m = 0; m < 4; ++m) {
          const int row = brow + ai * HALF + wr * 64 + m * 16 + fr;
          f32x4 v0 = acc[ai][bj][m][0], v1 = acc[ai][bj][m][1];
          if (rope && brow >= NCTX) {
            const bool upper = fq >= 2;
            const f32x4 o0 = xlane32(v0, upper), o1 = xlane32(v1, upper);
            const int t = (row - NCTX) & (SEQ - 1);
            const int pos = (wc & 1) ? (t & 63) : (t >> 6);
            const float* ct = cosT + pos * 16 + (fq & 1) * 8;
            const float* st = sinT + pos * 16 + (fq & 1) * 8;
            const f32x4 c0 = *(const f32x4*)ct, c1 = *(const f32x4*)(ct + 4);
            f32x4 s0 = *(const f32x4*)st, s1 = *(const f32x4*)(st + 4);
            if (!upper) { s0 = -s0; s1 = -s1; }
            v0 = v0 * c0 + o0 * s0;
            v1 = v1 * c1 + o1 * s1;
          }
          if (scl) { v0 *= sq; v1 *= sq; }
          u32x4 w;
          w.x = cvt_pk_bf16(v0[0], v0[1]); w.y = cvt_pk_bf16(v0[2], v0[3]);
          w.z = cvt_pk_bf16(v1[0], v1[1]); w.w = cvt_pk_bf16(v1[2], v1[3]);
          *(u32x4*)(P + (size_t)row * ldc + colbase + fq * 8) = w;
        }
    }
  }
};
struct EpiBf16 {
  static constexpr bool PERM = true;
  bf16_t* P; int ldc;
  __device__ __forceinline__ void operator()(const f32x4 (&acc)[2][2][4][2], int brow, int bcol, int wr, int wc, int fr, int fq) const {
#pragma unroll
    for (int ai = 0; ai < 2; ++ai)
#pragma unroll
      for (int m = 0; m < 4; ++m) {
        const int row = brow + ai * HALF + wr * 64 + m * 16 + fr;
#pragma unroll
        for (int bj = 0; bj < 2; ++bj) {
          const f32x4 v0 = acc[ai][bj][m][0], v1 = acc[ai][bj][m][1];
          u32x4 w;
          w.x = cvt_pk_bf16(v0[0], v0[1]); w.y = cvt_pk_bf16(v0[2], v0[3]);
          w.z = cvt_pk_bf16(v1[0], v1[1]); w.w = cvt_pk_bf16(v1[2], v1[3]);
          *(u32x4*)(P + (size_t)row * ldc + bcol + bj * HALF + wc * 32 + fq * 8) = w;
        }
      }
  }
};
struct EpiGate {
  static constexpr bool PERM = true;
  bf16_t* M; const float* gate;
  __device__ __forceinline__ void operator()(const f32x4 (&acc)[2][2][4][2], int brow, int bcol, int wr, int wc, int fr, int fq) const {
    const int b = brow < NCTX ? 32 : ((brow - NCTX) >> 11);
    const float* g = gate + (size_t)b * MODW;
#pragma unroll
    for (int bj = 0; bj < 2; ++bj) {
      const int col = bcol + bj * HALF + wc * 32 + fq * 8;
      const f32x4 g0 = *(const f32x4*)(g + col), g1 = *(const f32x4*)(g + col + 4);
#pragma unroll
      for (int ai = 0; ai < 2; ++ai)
#pragma unroll
        for (int m = 0; m < 4; ++m) {
          const int row = brow + ai * HALF + wr * 64 + m * 16 + fr;
          const f32x4 v0 = acc[ai][bj][m][0] * g0, v1 = acc[ai][bj][m][1] * g1;
          u32x4 w;
          w.x = cvt_pk_bf16(v0[0], v0[1]); w.y = cvt_pk_bf16(v0[2], v0[3]);
          w.z = cvt_pk_bf16(v1[0], v1[1]); w.w = cvt_pk_bf16(v1[2], v1[3]);
          *(u32x4*)(M + (size_t)row * D + col) = w;
        }
    }
  }
};
struct EpiResid {
  static constexpr bool PERM = false;
  const float* hin_ctx; const float* hin_lat; float* hout_ctx; float* hout_lat; const float* gate;
  __device__ __forceinline__ void operator()(const f32x4 (&acc)[2][2][4][2], int brow, int bcol, int wr, int wc, int fr, int fq) const {
    const bool isctx = brow < NCTX;
    const int b = isctx ? 32 : ((brow - NCTX) >> 11);
    const float* hin = isctx ? hin_ctx + (size_t)brow * D : hin_lat + (size_t)(brow - NCTX) * D;
    float* hout = isctx ? hout_ctx + (size_t)brow * D : hout_lat + (size_t)(brow - NCTX) * D;
    const float* g = gate + (size_t)b * MODW;
#pragma unroll
    for (int bj = 0; bj < 2; ++bj)
#pragma unroll
      for (int n = 0; n < 2; ++n) {
        const int col = bcol + bj * HALF + wc * 32 + n * 16 + fq * 4;
        const f32x4 gv = *(const f32x4*)(g + col);
#pragma unroll
        for (int ai = 0; ai < 2; ++ai)
#pragma unroll
          for (int m = 0; m < 4; ++m) {
            const int r = ai * HALF + wr * 64 + m * 16 + fr;
            const f32x4 h = *(const f32x4*)(hin + (size_t)r * D + col);
            *(f32x4*)(hout + (size_t)r * D + col) = h + gv * acc[ai][bj][m][n];
          }
      }
  }
};

template <int MT, int NT>
__device__ __forceinline__ void mm_lds(const bf16_t* A, int lda, const bf16_t* B, int ldb, int K, f32x4 (&acc)[MT][NT], int fr, int fq) {
  for (int k0 = 0; k0 < K; k0 += 32) {
    bf16x8 af[MT], bf[NT];
#pragma unroll
    for (int m = 0; m < MT; ++m) af[m] = *(const bf16x8*)(A + (m * 16 + fr) * lda + k0 + fq * 8);
#pragma unroll
    for (int n = 0; n < NT; ++n) bf[n] = *(const bf16x8*)(B + (n * 16 + fr) * ldb + k0 + fq * 8);
#pragma unroll
    for (int m = 0; m < MT; ++m)
#pragma unroll
      for (int n = 0; n < NT; ++n) acc[m][n] = __builtin_amdgcn_mfma_f32_16x16x32_bf16(af[m], bf[n], acc[m][n], 0, 0, 0);
  }
}

__device__ void phase_prep(const Params& p, unsigned char* smem, int bid, int nb) {
  const int tid = tidx();
  for (int it = bid; it < 2 * 96; it += nb) {
    const int layer = it / 96, n0 = (it % 96) * 64;
    float* s = (float*)smem;
    for (int i = tid; i < 33 * 1024; i += NTHREADS) {
      const int b = i >> 10, k = i & 1023;
      const float v = (b < 32) ? p.c[b * 1024 + k] : p.c_ctx[k];
      s[k * 33 + b] = siluf(v);
    }
    __syncthreads();
    const int col = tid & 63, kg = tid >> 6;
    float acc[33];
#pragma unroll
    for (int b = 0; b < 33; ++b) acc[b] = 0.f;
    const float* W = p.ada_w + (size_t)layer * 1024 * MODW + n0 + col;
    for (int k = kg * 128; k < kg * 128 + 128; ++k) {
      const float w = W[(size_t)k * MODW];
      const float* sk = s + k * 33;
#pragma unroll
      for (int b = 0; b < 33; ++b) acc[b] += sk[b] * w;
    }
    __syncthreads();
    float* red = (float*)smem;
#pragma unroll
    for (int b = 0; b < 33; ++b) red[(kg * 33 + b) * 64 + col] = acc[b];
    __syncthreads();
    for (int i = tid; i < 33 * 64; i += NTHREADS) {
      const int b = i >> 6, cc = i & 63;
      float t = p.ada_b[layer * MODW + n0 + cc];
#pragma unroll
      for (int g = 0; g < 8; ++g) t += red[(g * 33 + b) * 64 + cc];
      p.mod[((size_t)layer * 33 + b) * MODW + n0 + cc] = t;
    }
    __syncthreads();
  }
  if (bid == nb - 1) {
    for (int i = tid; i < 1024; i += NTHREADS) {
      const int pos = i >> 4, f = i & 15;
      const float inv = powf(10000.f, -(float)f / 16.f);
      const float ang = (float)pos * inv;
      p.ropec[i] = cosf(ang);
      p.ropes[i] = sinf(ang);
    }
  }
  {
    float* tile = (float*)smem;
    const int ntile_total = 768 + 256 + 384 + 256 + 512;
    for (int it = bid; it < ntile_total; it += nb) {
      const float* src; bf16_t* dst; int N, ti;
      if (it < 768) { src = p.ev_w_in; dst = p.winT0; N = 3072; ti = it; }
      else if (it < 1024) { src = p.ev_w_out; dst = p.woutT0; N = 1024; ti = it - 768; }
      else if (it < 1408) { src = p.od_w_in; dst = p.winT1; N = 1536; ti = it - 1024; }
      else if (it < 1664) { src = p.od_w_out; dst = p.woutT1; N = 1024; ti = it - 1408; }
      else { const int l = (it - 1664) / 256; src = p.peer_wq + (size_t)l * 1024 * 1024; dst = p.wqT + (size_t)l * 1024 * 1024; N = 1024; ti = (it - 1664) % 256; }
      const int ntn = N / 64, tk = ti / ntn, tn = ti % ntn;
      __syncthreads();
      for (int i = tid; i < 64 * 64; i += NTHREADS) {
        const int r = i >> 6, cc = i & 63;
        tile[r * 65 + cc] = src[(size_t)(tk * 64 + r) * N + tn * 64 + cc];
      }
      __syncthreads();
      for (int i = tid; i < 64 * 32; i += NTHREADS) {
        const int nn = i >> 5, kk = (i & 31) * 2;
        const unsigned w = cvt_pk_bf16(tile[kk * 65 + nn], tile[(kk + 1) * 65 + nn]);
        *(unsigned*)(dst + (size_t)(tn * 64 + nn) * 1024 + tk * 64 + kk) = w;
      }
    }
    __syncthreads();
  }
  for (int idx = bid * NTHREADS + tid; idx < 2 * 8 * 2 * 128 * 64; idx += nb * NTHREADS) {
    const int d = idx & 63, k = (idx >> 6) & 127, s = (idx >> 13) & 1, hh = (idx >> 14) & 7, l = idx >> 17;
    const float v = (s ? p.keys2 : p.keys1)[((size_t)(l * 8 + hh) * 128 + k) * 64 + d];
    const bf16_t hi = f2bf(v);
    const bf16_t lo = f2bf(v - bf2f(hi));
    const size_t o = ((size_t)((l * 8 + hh) * 2 + s) * 2) * 8192 + (size_t)k * 64 + d;
    p.keysb[o] = hi;
    p.keysb[o + 8192] = lo;
  }
  {
    const int wid = tid >> 6, lane = tid & 63, hw = lane >> 5, L = lane & 31, bb = L >> 3, ii = L & 7;
    for (int r = (bid * 8 + wid) * 2 + hw; r < 4 * NEXP; r += nb * 16) {
      const bool isv = r >= 2 * NEXP;
      const int rr = isv ? r - 2 * NEXP : r;
      const float* src = (isv ? p.peer_v : p.peer_u) + (size_t)rr * D + bb * 256 + ii * 32;
      f32x4 a[8];
      float mx = 0.f;
#pragma unroll
      for (int q = 0; q < 8; ++q) {
        a[q] = *(const f32x4*)(src + q * 4);
        mx = fmaxf(mx, fmaxf(fmaxf(fabsf(a[q][0]), fabsf(a[q][1])), fmaxf(fabsf(a[q][2]), fabsf(a[q][3]))));
      }
      mx = row16_max(mx);
      { auto sw = __builtin_amdgcn_permlane16_swap(__float_as_uint(mx), __float_as_uint(mx), false, false); mx = fmaxf(__uint_as_float(sw[0]), __uint_as_float(sw[1])); }
      const float sc = mx > 0.f ? 7.0f / mx : 1.f;
      u32x16 pk;
#pragma unroll
      for (int q = 0; q < 8; ++q) { pk[2 * q] = cvt_pk_bf16(a[q][0] * sc, a[q][1] * sc); pk[2 * q + 1] = cvt_pk_bf16(a[q][2] * sc, a[q][3] * sc); }
      const u32x6 w = __builtin_amdgcn_cvt_scalef32_pk32_fp6_bf16(__builtin_bit_cast(bf16x32n, pk), 1.0f);
      unsigned char* dst = (isv ? p.v8 : p.u8) + (size_t)rr * 768 + ii * 16;
#pragma unroll
      for (int m = 0; m < 6; ++m) {
        const int sidx = 6 * bb + m;
        const unsigned wm = w[m];
        *(unsigned*)(dst + (sidx >> 2) * 128 + (sidx & 3) * 4) = wm;
      }
      if (L == 0) (isv ? p.vscale : p.uscale)[rr] = mx > 0.f ? mx / 7.0f : 1.f;
    }
  }
}

__device__ void phase_resid_norm(const Params& p, int bid, int nb, int row0, int row1, const float* hin_ctx, const float* hin_lat,
                                 const float* gain, const float* modl) {
  const int tid0 = tidx();
  const int wid = tid0 >> 6, lane = tid0 & 63;
  for (int rowa = row0 + (bid * 8 + wid) * 2; rowa < row1; rowa += nb * 16) {
    f32x4 v[2][4];
    float ss[2] = {0.f, 0.f};
#pragma unroll
    for (int r = 0; r < 2; ++r) {
      const int row = rowa + r;
      const bool isctx = row < NCTX;
      const float* h = isctx ? hin_ctx + (size_t)row * D : hin_lat + (size_t)(row - NCTX) * D;
      const bf16_t* mrow = p.pq + (size_t)row * D;
#pragma unroll
      for (int i = 0; i < 4; ++i) {
        const f32x4 hv = *(const f32x4*)(h + i * 256 + lane * 4);
        const u32x2 mv = *(const u32x2*)(mrow + i * 256 + lane * 4);
        v[r][i][0] = hv[0] + bf_lo(mv.x); v[r][i][1] = hv[1] + bf_hi(mv.x); v[r][i][2] = hv[2] + bf_lo(mv.y); v[r][i][3] = hv[3] + bf_hi(mv.y);
      }
    }
#pragma unroll
    for (int r = 0; r < 2; ++r) {
      const int row = rowa + r;
      const bool isctx = row < NCTX;
      float* ho = isctx ? p.hctx + (size_t)row * D : p.out + (size_t)(row - NCTX) * D;
      const int b = isctx ? 32 : ((row - NCTX) >> 11);
      const float* sh = modl + (size_t)b * MODW + 3 * D;
      const float* sc = modl + (size_t)b * MODW + 4 * D;
#pragma unroll
      for (int i = 0; i < 4; ++i) {
        *(f32x4*)(ho + i * 256 + lane * 4) = v[r][i];
        ss[r] += v[r][i][0] * v[r][i][0] + v[r][i][1] * v[r][i][1] + v[r][i][2] * v[r][i][2] + v[r][i][3] * v[r][i][3];
      }
      const float rstd = rsqrtf(wave_sum(ss[r]) * (1.f / D) + EPS);
#pragma unroll
      for (int i = 0; i < 4; ++i) {
        const int col = i * 256 + lane * 4;
        const f32x4 g = *(const f32x4*)(gain + col), s1 = *(const f32x4*)(sc + col), s0 = *(const f32x4*)(sh + col);
        f32x4 y = v[r][i] * rstd * g;
        y = y * (1.f + s1) + s0;
        u32x2 w; w.x = cvt_pk_bf16(y[0], y[1]); w.y = cvt_pk_bf16(y[2], y[3]);
        *(u32x2*)(p.act + (size_t)row * D + col) = w;
      }
    }
  }
}
__device__ void phase_norm(const Params& p, int bid, int nb, int row0, int row1, const float* hctx, const float* hlat,
                           const float* gain, const float* modl, int ish, int isc) {
  const int tid0 = tidx();
  const int wid = tid0 >> 6, lane = tid0 & 63;
  for (int rowa = row0 + (bid * 8 + wid) * 2; rowa < row1; rowa += nb * 16) {
    f32x4 v[2][4];
#pragma unroll
    for (int r = 0; r < 2; ++r) {
      const int row = rowa + r;
      const float* h = row < NCTX ? hctx + (size_t)row * D : hlat + (size_t)(row - NCTX) * D;
#pragma unroll
      for (int i = 0; i < 4; ++i) v[r][i] = *(const f32x4*)(h + i * 256 + lane * 4);
    }
#pragma unroll
    for (int r = 0; r < 2; ++r) {
      const int row = rowa + r;
      const int b = row < NCTX ? 32 : ((row - NCTX) >> 11);
      const float* sh = modl + (size_t)b * MODW + ish * D;
      const float* sc = modl + (size_t)b * MODW + isc * D;
      float ss = 0.f;
#pragma unroll
      for (int i = 0; i < 4; ++i) ss += v[r][i][0] * v[r][i][0] + v[r][i][1] * v[r][i][1] + v[r][i][2] * v[r][i][2] + v[r][i][3] * v[r][i][3];
      const float rstd = rsqrtf(wave_sum(ss) * (1.f / D) + EPS);
#pragma unroll
      for (int i = 0; i < 4; ++i) {
        const int col = i * 256 + lane * 4;
        const f32x4 g = *(const f32x4*)(gain + col), s1 = *(const f32x4*)(sc + col), s0 = *(const f32x4*)(sh + col);
        f32x4 y = v[r][i] * rstd * g;
        y = y * (1.f + s1) + s0;
        u32x2 w; w.x = cvt_pk_bf16(y[0], y[1]); w.y = cvt_pk_bf16(y[2], y[3]);
        *(u32x2*)(p.act + (size_t)row * D + col) = w;
      }
    }
  }
}

__device__ __forceinline__ void phase_gemm_inproj(const Params& p, unsigned char* smem, int bid, int nb, int layer) {
  LAS unsigned char* lds = (LAS unsigned char*)smem;
  if (layer == 0) {
    EpiInProj epi{p.proj, 3072, 0, p.ropec, p.ropes};
    Sched s{0, 0, NTOK / BM, 12, nb, bid};
    gemm_phase(lds, p.act, p.winT0, s, epi);
  } else {
    EpiInProj epi{p.proj, 1536, 1, p.ropec, p.ropes};
    Sched s{NCTX / BM, 0, NLAT / BM, 6, nb, bid};
    gemm_phase(lds, p.act, p.winT1, s, epi);
    Sched s2{0, 4, NCTX / BM, 2, nb, bid};
    gemm_phase(lds, p.act, p.winT1, s2, epi);
  }
}
__device__ __forceinline__ void phase_gemm_outproj(const Params& p, unsigned char* smem, int bid, int nb, int layer) {
  LAS unsigned char* lds = (LAS unsigned char*)smem;
  EpiGate epi{p.pq, p.mod + (size_t)layer * 33 * MODW + 2 * D};
  const int pm0 = layer == 0 ? 0 : NCTX / BM;
  Sched s{pm0, 0, NTOK / BM - pm0, 4, nb, bid};
  gemm_phase(lds, p.act, layer == 0 ? p.woutT0 : p.woutT1, s, epi);
}
__device__ __forceinline__ void phase_gemm_pq(const Params& p, unsigned char* smem, int bid, int nb, int layer) {
  LAS unsigned char* lds = (LAS unsigned char*)smem;
  EpiBf16 epi{p.pq, D};
  const int pm0 = layer == 0 ? 0 : NCTX / BM;
  Sched s{pm0, 0, NTOK / BM - pm0, 4, nb, bid};
  gemm_phase(lds, p.act, p.wqT + (size_t)layer * D * D, s, epi);
}

__device__ __forceinline__ int chunk_row0(int b, int cc) { return cc < 2 ? b * CTXL + cc * 128 : NCTX + b * SEQ + (cc - 2) * 128; }

constexpr int LDP = 136;
constexpr int LDK = 72;

typedef short s16x4 __attribute__((ext_vector_type(4)));
__device__ __forceinline__ bf16x8 tr_frag(const LAS bf16_t* base, int ld, int lane) {
  const int troff = ((lane & 15) >> 2) * ld + (lane & 3) * 4;
  const s16x4 v0 = __builtin_amdgcn_ds_read_tr16_b64_v4i16((LAS s16x4*)(base + troff));
  const s16x4 v1 = __builtin_amdgcn_ds_read_tr16_b64_v4i16((LAS s16x4*)(base + 16 * ld + troff));
  bf16x8 f;
  f[0] = v0[0]; f[1] = v0[1]; f[2] = v0[2]; f[3] = v0[3]; f[4] = v1[0]; f[5] = v1[1]; f[6] = v1[2]; f[7] = v1[3];
  return f;
}
__device__ void phase_ret_kv(const Params& p, unsigned char* smem, int bid, int nb) {
  const int tid = tidx(), wid = __builtin_amdgcn_readfirstlane(tid >> 6), lane = tid & 63, fr = lane & 15, fq = lane >> 4;
  LAS bf16_t* Kl = (LAS bf16_t*)smem;
  LAS bf16_t* Vl = Kl + 128 * LDK;
  for (int it = bid; it < BATCH * 4 * 18; it += nb) {
    const int cc = it % 18, h = (it / 18) & 3, b = it / 72;
    const int row0 = chunk_row0(b, cc);
    const float lf = log_sigmoidf(p.logit_f[h]), lb = log_sigmoidf(p.logit_b[h]);
    __syncthreads();
    for (int task = tid; task < 128 * 8; task += NTHREADS) {
      const int j = task >> 3, d0 = (task & 7) * 8;
      *(LAS u32x4*)(Kl + j * LDK + d0) = *(const u32x4*)(p.proj + (size_t)(row0 + j) * 3072 + 256 + h * 64 + d0);
    }
    for (int task = tid; task < 128 * 16; task += NTHREADS) {
      const int j = task >> 4, e0 = (task & 15) * 8;
      *(LAS u32x4*)(Vl + j * LDP + e0) = *(const u32x4*)(p.proj + (size_t)(row0 + j) * 3072 + 512 + h * 128 + e0);
    }
    __syncthreads();
    bf16x8 af[4], ab[4];
#pragma unroll
    for (int ks = 0; ks < 4; ++ks) {
      const bf16x8 vf = tr_frag(Vl + (ks * 32 + fq * 4) * LDP + wid * 16, LDP, lane);
      const u32x4 vu = __builtin_bit_cast(u32x4, vf);
      u32x4 wf, wb;
#pragma unroll
      for (int q = 0; q < 4; ++q) {
        const int j0 = ks * 32 + (q >> 1) * 16 + fq * 4 + (q & 1) * 2;
        const float lo = bf_lo(vu[q]), hi = bf_hi(vu[q]);
        wf[q] = cvt_pk_bf16(lo * __expf(lf * (float)(127 - j0)), hi * __expf(lf * (float)(126 - j0)));
        wb[q] = cvt_pk_bf16(lo * __expf(lb * (float)j0), hi * __expf(lb * (float)(j0 + 1)));
      }
      af[ks] = __builtin_bit_cast(bf16x8, wf);
      ab[ks] = __builtin_bit_cast(bf16x8, wb);
    }
    float* out = p.kv + (size_t)it * 16384;
#pragma unroll
    for (int n = 0; n < 4; ++n) {
      f32x4 accf = {0.f, 0.f, 0.f, 0.f}, accb = {0.f, 0.f, 0.f, 0.f};
#pragma unroll
      for (int ks = 0; ks < 4; ++ks) {
        const bf16x8 kf = tr_frag(Kl + (ks * 32 + fq * 4) * LDK + n * 16, LDK, lane);
        accf = __builtin_amdgcn_mfma_f32_16x16x32_bf16(af[ks], kf, accf, 0, 0, 0);
        accb = __builtin_amdgcn_mfma_f32_16x16x32_bf16(ab[ks], kf, accb, 0, 0, 0);
      }
#pragma unroll
      for (int j = 0; j < 4; ++j) {
        out[(wid * 16 + fq * 4 + j) * 128 + n * 16 + fr] = accf[j];
        out[(wid * 16 + fq * 4 + j) * 128 + 64 + n * 16 + fr] = accb[j];
      }
    }
  }
  for (size_t task = (size_t)bid * NTHREADS + tid; task < (size_t)NTOK * 64; task += (size_t)nb * NTHREADS) {
    const int row = (int)(task >> 6), c0 = (int)(task & 63) * 8;
    const int tin = row < NCTX ? (row & (CTXL - 1)) : ((row - NCTX) & (SEQ - 1));
    const int tlen = row < NCTX ? CTXL : SEQ;
    const bf16_t* pr = p.proj + (size_t)row * 3072;
    const u32x4 gb = *(const u32x4*)(pr + 1536 + c0);
    float accv[8];
#pragma unroll
    for (int q = 0; q < 8; ++q) accv[q] = 0.f;
#pragma unroll
    for (int dt = -1; dt <= 1; ++dt) {
      if (tin + dt < 0 || tin + dt >= tlen) continue;
      const bf16_t* pr2 = pr + (ptrdiff_t)dt * 3072;
      const u32x4 gc = *(const u32x4*)(pr2 + 2048 + c0), xt = *(const u32x4*)(pr2 + 2560 + c0);
      const float* w = p.conv_w + (dt + 1) * 512 + c0;
      const f32x4 wa = *(const f32x4*)w, wb = *(const f32x4*)(w + 4);
#pragma unroll
      for (int q = 0; q < 4; ++q) {
        const float u0 = bf_lo(gc[q]) * bf_lo(xt[q]), u1 = bf_hi(gc[q]) * bf_hi(xt[q]);
        const float w0 = (2 * q < 4) ? wa[2 * q] : wb[2 * q - 4], w1 = (2 * q + 1 < 4) ? wa[2 * q + 1] : wb[2 * q + 1 - 4];
        accv[2 * q] += w0 * u0;
        accv[2 * q + 1] += w1 * u1;
      }
    }
    u32x4 o;
#pragma unroll
    for (int q = 0; q < 4; ++q) o[q] = cvt_pk_bf16(bf_lo(gb[q]) * accv[2 * q], bf_hi(gb[q]) * accv[2 * q + 1]);
#ifdef ZERO_CONV
    o = (u32x4){0u, 0u, 0u, 0u};
#endif
    *(u32x4*)(p.act + (size_t)row * D + 512 + c0) = o;
  }
}

__device__ void phase_ret_scan(const Params& p, int bid, int nb) {
  const int tid = tidx();
  for (size_t idx = (size_t)bid * NTHREADS + tid; idx < (size_t)BATCH * 4 * 16384; idx += (size_t)nb * NTHREADS) {
    const int el = (int)(idx & 16383), bh = (int)(idx >> 14), h = bh & 3;
    const bool fwd = (el & 127) < 64;
    const float lg = log_sigmoidf(fwd ? p.logit_f[h] : p.logit_b[h]);
    const float dec = __expf(lg * 128.f);
    float st = 0.f;
    for (int s = 0; s < 18; ++s) {
      const int cc = fwd ? s : (s < 2 ? 1 - s : 19 - s);
      const size_t off = ((size_t)bh * 18 + cc) * 16384 + el;
      p.sprev[off] = f2bf(st);
      st = dec * st + p.kv[off];
    }
  }
}

__device__ void phase_ret_out(const Params& p, unsigned char* smem, int bid, int nb) {
  const int tid = tidx(), wid = __builtin_amdgcn_readfirstlane(tid >> 6), lane = tid & 63, fr = lane & 15, fq = lane >> 4;
  LAS bf16_t* Kl = (LAS bf16_t*)smem;
  LAS bf16_t* Vl = Kl + 128 * LDK;
  LAS bf16_t* Sl = Vl + 128 * LDP;
  const int NIT = BATCH * 4 * 18;
  u32x4 rk[2], rv[4], rs[4];
  bf16x8 qfn[2];
#define RO_LOAD(IT)                                                                                                      \
  do {                                                                                                                   \
    const int _cc = (IT) % 18, _h = ((IT) / 18) & 3, _b = (IT) / 72;                                                     \
    const int _row0 = chunk_row0(_b, _cc);                                                                               \
    _Pragma("unroll") for (int c = 0; c < 2; ++c) { const int task = tid + c * NTHREADS; const int j = task >> 3, d0 = (task & 7) * 8; \
      rk[c] = *(const u32x4*)(p.proj + (size_t)(_row0 + j) * 3072 + 256 + _h * 64 + d0); }                              \
    _Pragma("unroll") for (int c = 0; c < 4; ++c) { const int task = tid + c * NTHREADS; const int j = task >> 4, e0 = (task & 15) * 8; \
      rv[c] = *(const u32x4*)(p.proj + (size_t)(_row0 + j) * 3072 + 512 + _h * 128 + e0);                               \
      rs[c] = *(const u32x4*)(p.sprev + (size_t)(IT) * 16384 + j * 128 + e0); }                                          \
    _Pragma("unroll") for (int ks = 0; ks < 2; ++ks) qfn[ks] = *(const bf16x8*)(p.proj + (size_t)(_row0 + wid * 16 + fr) * 3072 + _h * 64 + ks * 32 + fq * 8); \
  } while (0)
#define RO_STORE()                                                                                                       \
  do {                                                                                                                   \
    _Pragma("unroll") for (int c = 0; c < 2; ++c) { const int task = tid + c * NTHREADS; const int j = task >> 3, d0 = (task & 7) * 8; \
      *(LAS u32x4*)(Kl + j * LDK + d0) = rk[c]; }                                                                        \
    _Pragma("unroll") for (int c = 0; c < 4; ++c) { const int task = tid + c * NTHREADS; const int j = task >> 4, e0 = (task & 15) * 8; \
      *(LAS u32x4*)(Vl + j * LDP + e0) = rv[c]; *(LAS u32x4*)(Sl + j * LDP + e0) = rs[c]; }                              \
  } while (0)
  if (bid < NIT) { RO_LOAD(bid); __syncthreads(); RO_STORE(); }
  __syncthreads();
  for (int it = bid; it < NIT; it += nb) {
    const int cc = it % 18, h = (it / 18) & 3, b = it / 72;
    const int row0 = chunk_row0(b, cc);
    const float lf = log_sigmoidf(p.logit_f[h]), lb = log_sigmoidf(p.logit_b[h]);
    const int irow = wid * 16 + fr;
    bf16x8 qf[2];
    qf[0] = qfn[0]; qf[1] = qfn[1];
    const bool more = it + nb < NIT;
    if (more) RO_LOAD(it + nb);
    const size_t row = (size_t)(row0 + irow);
    u32x2 gg[8];
#pragma unroll
    for (int dn = 0; dn < 8; ++dn) gg[dn] = *(const u32x2*)(p.proj + row * 3072 + 1024 + h * 128 + dn * 16 + fq * 4);
    bf16x8 pb[4];
    {
      f32x4 st[8];
#pragma unroll
      for (int n = 0; n < 8; ++n) st[n] = (f32x4){0.f, 0.f, 0.f, 0.f};
#pragma unroll
      for (int ks = 0; ks < 2; ++ks)
#pragma unroll
        for (int n = 0; n < 8; ++n) {
          const bf16x8 kf = *(const LAS bf16x8*)(Kl + (n * 16 + fr) * LDK + ks * 32 + fq * 8);
          st[n] = __builtin_amdgcn_mfma_f32_16x16x32_bf16(kf, qf[ks], st[n], 0, 0, 0);
        }
#pragma unroll
      for (int n = 0; n < 8; ++n)
#pragma unroll
        for (int r = 0; r < 4; ++r) {
          const int df = irow - (n * 16 + fq * 4 + r);
          const float lg = df > 0 ? lf : lb;
          const float ex = __expf(lg * fabsf((float)df));
          st[n][r] *= (df == 0) ? 2.f : ex;
        }
#pragma unroll
      for (int kk = 0; kk < 4; ++kk) {
        u32x4 w;
        w.x = cvt_pk_bf16(st[2 * kk][0], st[2 * kk][1]); w.y = cvt_pk_bf16(st[2 * kk][2], st[2 * kk][3]);
        w.z = cvt_pk_bf16(st[2 * kk + 1][0], st[2 * kk + 1][1]); w.w = cvt_pk_bf16(st[2 * kk + 1][2], st[2 * kk + 1][3]);
        pb[kk] = __builtin_bit_cast(bf16x8, w);
      }
    }
    bf16x8 qx[4];
    {
      const float xf = __expf(lf * (float)(irow + 1)), xb = __expf(lb * (float)(128 - irow));
#pragma unroll
      for (int ks = 0; ks < 4; ++ks) {
        const float sc = ks < 2 ? xf : xb;
        const u32x4 qu = __builtin_bit_cast(u32x4, qf[ks & 1]);
        u32x4 qo;
#pragma unroll
        for (int q = 0; q < 4; ++q) { const unsigned w = qu[q]; qo[q] = cvt_pk_bf16(bf_lo(w) * sc, bf_hi(w) * sc); }
        qx[ks] = __builtin_bit_cast(bf16x8, qo);
      }
    }
    f32x4 ot[8];
#pragma unroll
    for (int dn = 0; dn < 8; ++dn) {
      f32x4 o = {0.f, 0.f, 0.f, 0.f};
#pragma unroll
      for (int kk = 0; kk < 4; ++kk) {
        const bf16x8 vf = tr_frag(Vl + (kk * 32 + fq * 4) * LDP + dn * 16, LDP, lane);
        o = __builtin_amdgcn_mfma_f32_16x16x32_bf16(vf, pb[kk], o, 0, 0, 0);
      }
#pragma unroll
      for (int ks = 0; ks < 4; ++ks) {
        const bf16x8 sf = *(const LAS bf16x8*)(Sl + (dn * 16 + fr) * LDP + ks * 32 + fq * 8);
        o = __builtin_amdgcn_mfma_f32_16x16x32_bf16(sf, qx[ks], o, 0, 0, 0);
      }
      ot[dn] = o;
    }
    float ss = 0.f;
#pragma unroll
    for (int dn = 0; dn < 8; ++dn) ss += ot[dn][0] * ot[dn][0] + ot[dn][1] * ot[dn][1] + ot[dn][2] * ot[dn][2] + ot[dn][3] * ot[dn][3];
    ss = xrow16_sum(ss);
    const float rstd = rsqrtf(ss * (1.f / 128.f) + EPS);
#pragma unroll
    for (int dn = 0; dn < 8; ++dn) {
      const int e0 = dn * 16 + fq * 4;
      const u32x2 g = gg[dn];
      u32x2 w;
#ifdef ZERO_RET
      w.x = 0u; w.y = 0u;
#else
      w.x = cvt_pk_bf16(ot[dn][0] * rstd * siluf(bf_lo(g.x)), ot[dn][1] * rstd * siluf(bf_hi(g.x)));
      w.y = cvt_pk_bf16(ot[dn][2] * rstd * siluf(bf_lo(g.y)), ot[dn][3] * rstd * siluf(bf_hi(g.y)));
#endif
      *(u32x2*)(p.act + row * D + h * 128 + e0) = w;
    }
    __syncthreads();
    if (more) RO_STORE();
    __syncthreads();
  }
#undef RO_LOAD
#undef RO_STORE
}

__device__ __forceinline__ float xrow16_max(float x) {
  auto s = __builtin_amdgcn_permlane16_swap(__float_as_uint(x), __float_as_uint(x), false, false);
  x = fmaxf(__uint_as_float(s[0]), __uint_as_float(s[1]));
  auto t = __builtin_amdgcn_permlane32_swap(__float_as_uint(x), __float_as_uint(x), false, false);
  return fmaxf(__uint_as_float(t[0]), __uint_as_float(t[1]));
}
template <int VAR>
__device__ void phase_attn(const Params& p, unsigned char* smem, int bid, int nb, bf16_t* outp) {
  const int tid = tidx(), wid = __builtin_amdgcn_readfirstlane(tid >> 6), lane = tid & 63, fr = lane & 15, fq = lane >> 4;
  LAS bf16_t* Kl = (LAS bf16_t*)smem;
  LAS bf16_t* Vl = Kl + 2 * 64 * LDK;
  LAS bf16_t* Ql = Vl + 2 * 64 * LDK + wid * 64 * LDK;
  const int sj = tid >> 3, sc8 = (tid & 7) * 8;
  const int troff = ((lane & 15) >> 2) * LDK + (lane & 3) * 4;
  for (int it = bid; it < BATCH * 16 * 4; it += nb) {
    const int kvh = it & 3, qb = (it >> 2) & 15, b = it >> 6;
    const int hq = kvh * 4 + (wid >> 1);
    const int q0 = qb * 128 + (wid & 1) * 64;
    const size_t latrow0 = (size_t)NCTX + (size_t)b * SEQ;
    const int tlo = qb == 0 ? 2 : 0, nwin = (qb == 15 ? 4 : 6) - tlo, ntile = nwin + 4;
#pragma unroll
    for (int m = 0; m < 4; ++m)
#pragma unroll
      for (int ks = 0; ks < 2; ++ks)
        *(LAS bf16x8*)(Ql + (m * 16 + fr) * LDK + ks * 32 + fq * 8) = *(const bf16x8*)(p.proj + (latrow0 + q0 + m * 16 + fr) * 1536 + hq * 64 + ks * 32 + fq * 8);
    const float sink = p.sinks[hq] * 1.44269504089f;
    float mrow[4], lrow[4];
    f32x4 ot[4][4];
#pragma unroll
    for (int m = 0; m < 4; ++m) {
      mrow[m] = sink; lrow[m] = (fq == 0) ? 1.f : 0.f;
#pragma unroll
      for (int dn = 0; dn < 4; ++dn) ot[dn][m] = (f32x4){0.f, 0.f, 0.f, 0.f};
    }
#define AT_KROW(T) ((T) < nwin ? latrow0 + (qb * 128 - 128 + 64 * (tlo + (T))) : (size_t)b * CTXL + ((T) - nwin) * 64)
#define AT_LOAD(RK, RV, T) do { const size_t _kr = AT_KROW(T);                                                            \
      RK = *(const u32x4*)(p.proj + (_kr + sj) * 1536 + 1024 + kvh * 64 + sc8);                                          \
      RV = *(const u32x4*)(p.proj + (_kr + sj) * 1536 + 1280 + kvh * 64 + sc8); } while (0)
    u32x4 rk0, rv0, rk1, rv1;
    rk0 = rk1 = rv0 = rv1 = (u32x4){0u, 0u, 0u, 0u};
    {
      u32x4 kk, vv;
      AT_LOAD(kk, vv, 0);
      AT_LOAD(rk1, rv1, 1);
      *(LAS u32x4*)(Kl + sj * LDK + sc8) = kk;
      *(LAS u32x4*)(Vl + sj * LDK + sc8) = vv;
    }
    __syncthreads();
    auto tile = [&](const int s, u32x4& ldK, u32x4& ldV, const u32x4& wrK, const u32x4& wrV) __attribute__((always_inline)) {
      const int cur = s & 1;
      const int tt = s < nwin ? tlo + s : 6 + (s - nwin);
      const bool win = tt < 6;
      const int kpos0 = win ? qb * 128 - 128 + 64 * tt : (tt - 6) * 64;
      const bool more = s + 1 < ntile;
      if (!(VAR & 16)) { if (s + 2 < ntile) AT_LOAD(ldK, ldV, s + 2); }
      const LAS bf16_t* Kc = Kl + cur * 64 * LDK;
      const LAS bf16_t* Vc = Vl + cur * 64 * LDK;
      const int dq = q0 - kpos0;
      const bool skip = win && (dq >= 192 || dq <= -192);
      const bool edge = win && !(dq <= 65 && dq >= -65);
      if (!skip && !(VAR & 8)) {
      bf16x8 pb[4][2];
      {
        bf16x8 kfr[2][4];
#pragma unroll
        for (int ks = 0; ks < 2; ++ks)
#pragma unroll
          for (int n = 0; n < 4; ++n) kfr[ks][n] = *(const LAS bf16x8*)(Kc + (n * 16 + fr) * LDK + ks * 32 + fq * 8);
#pragma unroll
        for (int m = 0; m < 4; ++m) {
          f32x4 st[4];
#pragma unroll
          for (int n = 0; n < 4; ++n) st[n] = (f32x4){0.f, 0.f, 0.f, 0.f};
#pragma unroll
          for (int ks = 0; ks < 2; ++ks) {
            const bf16x8 qfm = *(const LAS bf16x8*)(Ql + (m * 16 + fr) * LDK + ks * 32 + fq * 8);
#pragma unroll
            for (int n = 0; n < 4; ++n) st[n] = __builtin_amdgcn_mfma_f32_16x16x32_bf16(kfr[ks][n], qfm, st[n], 0, 0, 0);
          }
          const int qpos = q0 + m * 16 + fr;
          float mx = -3.0e38f;
#pragma unroll
          for (int n = 0; n < 4; ++n)
#pragma unroll
            for (int j = 0; j < 4; ++j) {
              float sv = st[n][j];
              if (edge) { const int dd = qpos - (kpos0 + n * 16 + fq * 4 + j); if (dd > 128 || dd < -128) sv = -1e30f; }
              st[n][j] = sv;
              mx = fmaxf(mx, sv);
            }
          mx = xrow16_max(mx);
          const float mnew = fmaxf(mrow[m], mx);
          const float alpha = __builtin_amdgcn_exp2f(mrow[m] - mnew);
          mrow[m] = mnew;
          float ls = 0.f;
#pragma unroll
          for (int n = 0; n < 4; ++n)
#pragma unroll
            for (int j = 0; j < 4; ++j) { const float pv = (VAR & 2) ? (st[n][j] - mnew) : __builtin_amdgcn_exp2f(st[n][j] - mnew); st[n][j] = pv; ls += pv; }
          lrow[m] = lrow[m] * alpha + ls;
#pragma unroll
          for (int dn = 0; dn < 4; ++dn) ot[dn][m] *= alpha;
#pragma unroll
          for (int kk = 0; kk < 2; ++kk) {
            u32x4 w;
            w.x = cvt_pk_bf16(st[2 * kk][0], st[2 * kk][1]); w.y = cvt_pk_bf16(st[2 * kk][2], st[2 * kk][3]);
            w.z = cvt_pk_bf16(st[2 * kk + 1][0], st[2 * kk + 1][1]); w.w = cvt_pk_bf16(st[2 * kk + 1][2], st[2 * kk + 1][3]);
            pb[m][kk] = __builtin_bit_cast(bf16x8, w);
          }
          __builtin_amdgcn_sched_barrier(0);
        }
      }
#pragma unroll
      for (int kk = 0; kk < 2; ++kk) {
        bf16x8 vfr[4];
#pragma unroll
        for (int dn = 0; dn < 4; ++dn) {
          const s16x4 v0 = __builtin_amdgcn_ds_read_tr16_b64_v4i16((LAS s16x4*)(Vc + ((2 * kk) * 16 + fq * 4) * LDK + dn * 16 + troff));
          const s16x4 v1 = __builtin_amdgcn_ds_read_tr16_b64_v4i16((LAS s16x4*)(Vc + ((2 * kk + 1) * 16 + fq * 4) * LDK + dn * 16 + troff));
          bf16x8 vf;
          vf[0] = v0[0]; vf[1] = v0[1]; vf[2] = v0[2]; vf[3] = v0[3]; vf[4] = v1[0]; vf[5] = v1[1]; vf[6] = v1[2]; vf[7] = v1[3];
          vfr[dn] = vf;
        }
#pragma unroll
        for (int m = 0; m < 4; ++m)
#pragma unroll
          for (int dn = 0; dn < 4; ++dn) { if (VAR & 4) ot[dn][m][0] += __uint_as_float(__builtin_bit_cast(u32x4, vfr[dn]).x ^ __builtin_bit_cast(u32x4, pb[m][kk]).x); else ot[dn][m] = __builtin_amdgcn_mfma_f32_16x16x32_bf16(vfr[dn], pb[m][kk], ot[dn][m], 0, 0, 0); }
        __builtin_amdgcn_sched_barrier(0);
      }
      }
      if (!(VAR & 16)) {
        if (more) {
          *(LAS u32x4*)(Kl + ((cur ^ 1) * 64 + sj) * LDK + sc8) = wrK;
          *(LAS u32x4*)(Vl + ((cur ^ 1) * 64 + sj) * LDK + sc8) = wrV;
        }
        __syncthreads();
      }
    };
#pragma unroll 1
    for (int s = 0; s < ntile; s += 2) {
      tile(s, rk0, rv0, rk1, rv1);
      tile(s + 1, rk1, rv1, rk0, rv0);
    }
#undef AT_LOAD
#undef AT_KROW
    int fr2 = fr;
    asm volatile("" : "+v"(fr2));
#pragma unroll
    for (int m = 0; m < 4; ++m) {
      const float l = xrow16_sum(lrow[m]);
      const float inv = 1.f / l;
      bf16_t* orow = outp + (latrow0 + q0 + m * 16 + fr2) * D + hq * 64 + fq * 4;
#pragma unroll
      for (int dn = 0; dn < 4; ++dn) {
        u32x2 w;
#ifdef ZERO_ATTN
        w.x = 0u; w.y = 0u;
#else
        w.x = cvt_pk_bf16(ot[dn][m][0] * inv, ot[dn][m][1] * inv); w.y = cvt_pk_bf16(ot[dn][m][2] * inv, ot[dn][m][3] * inv);
#endif
        *(u32x2*)(orow + dn * 16) = w;
      }
    }
  }
}

#define CEX(a, b) do { const unsigned _h = max(a, b), _l = min(a, b); a = _h; b = _l; } while (0)
__device__ __forceinline__ void sort16_desc(unsigned (&v)[16]) { CEX(v[0], v[1]); CEX(v[2], v[3]); CEX(v[0], v[2]); CEX(v[1], v[3]); CEX(v[1], v[2]); CEX(v[4], v[5]); CEX(v[6], v[7]); CEX(v[4], v[6]); CEX(v[5], v[7]); CEX(v[5], v[6]); CEX(v[0], v[4]); CEX(v[2], v[6]); CEX(v[2], v[4]); CEX(v[1], v[5]); CEX(v[3], v[7]); CEX(v[3], v[5]); CEX(v[1], v[2]); CEX(v[3], v[4]); CEX(v[5], v[6]); CEX(v[8], v[9]); CEX(v[10], v[11]); CEX(v[8], v[10]); CEX(v[9], v[11]); CEX(v[9], v[10]); CEX(v[12], v[13]); CEX(v[14], v[15]); CEX(v[12], v[14]); CEX(v[13], v[15]); CEX(v[13], v[14]); CEX(v[8], v[12]); CEX(v[10], v[14]); CEX(v[10], v[12]); CEX(v[9], v[13]); CEX(v[11], v[15]); CEX(v[11], v[13]); CEX(v[9], v[10]); CEX(v[11], v[12]); CEX(v[13], v[14]); CEX(v[0], v[8]); CEX(v[4], v[12]); CEX(v[4], v[8]); CEX(v[2], v[10]); CEX(v[6], v[14]); CEX(v[6], v[10]); CEX(v[2], v[4]); CEX(v[6], v[8]); CEX(v[10], v[12]); CEX(v[1], v[9]); CEX(v[5], v[13]); CEX(v[5], v[9]); CEX(v[3], v[11]); CEX(v[7], v[15]); CEX(v[7], v[11]); CEX(v[3], v[5]); CEX(v[7], v[9]); CEX(v[11], v[13]); CEX(v[1], v[2]); CEX(v[3], v[4]); CEX(v[5], v[6]); CEX(v[7], v[8]); CEX(v[9], v[10]); CEX(v[11], v[12]); CEX(v[13], v[14]); }
__device__ __forceinline__ void merge16_desc(unsigned (&t)[16], const unsigned (&b)[16]) {
#pragma unroll
  for (int i = 0; i < 16; ++i) t[i] = max(t[i], b[15 - i]);
  CEX(t[0], t[8]); CEX(t[1], t[9]); CEX(t[2], t[10]); CEX(t[3], t[11]); CEX(t[4], t[12]); CEX(t[5], t[13]); CEX(t[6], t[14]); CEX(t[7], t[15]); CEX(t[0], t[4]); CEX(t[1], t[5]); CEX(t[2], t[6]); CEX(t[3], t[7]); CEX(t[8], t[12]); CEX(t[9], t[13]); CEX(t[10], t[14]); CEX(t[11], t[15]); CEX(t[0], t[2]); CEX(t[1], t[3]); CEX(t[4], t[6]); CEX(t[5], t[7]); CEX(t[8], t[10]); CEX(t[9], t[11]); CEX(t[12], t[14]); CEX(t[13], t[15]); CEX(t[0], t[1]); CEX(t[2], t[3]); CEX(t[4], t[5]); CEX(t[6], t[7]); CEX(t[8], t[9]); CEX(t[10], t[11]); CEX(t[12], t[13]); CEX(t[14], t[15]);
}

__device__ __forceinline__ unsigned f2ord(float f) { const unsigned u = __float_as_uint(f); return (u & 0x80000000u) ? ~u : (u | 0x80000000u); }
__device__ __forceinline__ float ord2f(unsigned k) { const unsigned u = (k & 0x80000000u) ? (k & 0x7fffffffu) : ~k; return __uint_as_float(u); }
__device__ __forceinline__ unsigned dpp_xor1(unsigned x) { return (unsigned)__builtin_amdgcn_mov_dpp((int)x, 0xB1, 0xf, 0xf, true); }

__device__ void phase_peer_topk(const Params& p, unsigned char* smem, int bid, int nb, int layer, int tok0, int ntok) {
  const int tid = tidx(), wid = __builtin_amdgcn_readfirstlane(tid >> 6), lane = tid & 63, fr = lane & 15, fq = lane >> 4;
  LAS unsigned* sc = (LAS unsigned*)smem + wid * (64 * 36 + 64 * 16);
  LAS unsigned* fl = sc + 64 * 36;
  const int ls = lane & 1;
  const int nitem = (ntok / 256) * 8;
  for (int it = bid; it < nitem; it += nb) {
    const int h = it & 7, tile = it >> 3;
    const int tokw0 = tok0 + tile * 256 + wid * 32;
    bf16x8 qa[2][2][2];
#pragma unroll
    for (int m = 0; m < 2; ++m)
#pragma unroll
      for (int s = 0; s < 2; ++s)
#pragma unroll
        for (int ks = 0; ks < 2; ++ks)
          qa[m][s][ks] = *(const bf16x8*)(p.pq + (size_t)(tokw0 + m * 16 + fr) * D + h * 128 + s * 64 + ks * 32 + fq * 8);
    unsigned top[16];
#pragma unroll
    for (int i = 0; i < 16; ++i) top[i] = 0u;
    const bf16_t* kb = p.keysb + (size_t)(layer * 8 + h) * (2 * 2 * 128 * 64);
    bf16x8 kfr[2][2][2];
#define TK_LOADKEYS(C)                                                                                                   \
    _Pragma("unroll") for (int s = 0; s < 2; ++s) _Pragma("unroll") for (int n = 0; n < 2; ++n) _Pragma("unroll") for (int ks = 0; ks < 2; ++ks) \
      kfr[s][n][ks] = *(const bf16x8*)(kb + (size_t)((s * 2) * 128 + (C) * 32 + n * 16 + fr) * 64 + ks * 32 + fq * 8)
    TK_LOADKEYS(0);
#pragma unroll 1
    for (int c = 0; c < 4; ++c) {
      f32x4 acc[2][2][2];
#pragma unroll
      for (int m = 0; m < 2; ++m)
#pragma unroll
        for (int s = 0; s < 2; ++s)
#pragma unroll
          for (int n = 0; n < 2; ++n) acc[m][s][n] = (f32x4){0.f, 0.f, 0.f, 0.f};
#pragma unroll
      for (int s = 0; s < 2; ++s)
#pragma unroll
        for (int n = 0; n < 2; ++n)
#pragma unroll
          for (int ks = 0; ks < 2; ++ks)
#pragma unroll
            for (int m = 0; m < 2; ++m) acc[m][s][n] = __builtin_amdgcn_mfma_f32_16x16x32_bf16(qa[m][s][ks], kfr[s][n][ks], acc[m][s][n], 0, 0, 0);
      { const int cn = c < 3 ? c + 1 : 3; TK_LOADKEYS(cn); }
#pragma unroll
      for (int m = 0; m < 2; ++m)
#pragma unroll
        for (int s = 0; s < 2; ++s)
#pragma unroll
          for (int n = 0; n < 2; ++n)
#pragma unroll
            for (int j = 0; j < 4; ++j)
              sc[((m * 16 + fq * 4 + j) * 2 + s) * 36 + n * 16 + fr] = (f2ord(acc[m][s][n][j]) & 0xffffff80u) | (unsigned)(127 - (c * 32 + n * 16 + fr));
      unsigned b0[16], b1[16];
#pragma unroll
      for (int q = 0; q < 4; ++q) {
        const u32x4 w0 = *(const LAS u32x4*)(sc + lane * 36 + q * 4), w1 = *(const LAS u32x4*)(sc + lane * 36 + 16 + q * 4);
        b0[4 * q] = w0.x; b0[4 * q + 1] = w0.y; b0[4 * q + 2] = w0.z; b0[4 * q + 3] = w0.w;
        b1[4 * q] = w1.x; b1[4 * q + 1] = w1.y; b1[4 * q + 2] = w1.z; b1[4 * q + 3] = w1.w;
      }
      sort16_desc(b0); merge16_desc(top, b0);
      sort16_desc(b1); merge16_desc(top, b1);
    }
#undef TK_LOADKEYS
#pragma unroll
    for (int q = 0; q < 4; ++q) { u32x4 w; w.x = top[4 * q]; w.y = top[4 * q + 1]; w.z = top[4 * q + 2]; w.w = top[4 * q + 3]; *(LAS u32x4*)(fl + lane * 16 + q * 4) = w; }
    float own[16], oth[16];
#pragma unroll
    for (int q = 0; q < 4; ++q) {
      const u32x4 w = *(const LAS u32x4*)(fl + (lane ^ 1) * 16 + q * 4);
      oth[4 * q] = ord2f(w.x & 0xffffff80u); oth[4 * q + 1] = ord2f(w.y & 0xffffff80u); oth[4 * q + 2] = ord2f(w.z & 0xffffff80u); oth[4 * q + 3] = ord2f(w.w & 0xffffff80u);
    }
#pragma unroll
    for (int i = 0; i < 16; ++i) own[i] = ord2f(top[i] & 0xffffff80u);
    unsigned ck[32];
    ck[0] = (f2ord(own[0] + oth[1]) & 0xffffff00u) | (255u - (ls ? 16u : 1u));
    ck[1] = (f2ord(own[0] + oth[2]) & 0xffffff00u) | (255u - (ls ? 32u : 2u));
    ck[2] = (f2ord(own[0] + oth[3]) & 0xffffff00u) | (255u - (ls ? 48u : 3u));
    ck[3] = (f2ord(own[0] + oth[4]) & 0xffffff00u) | (255u - (ls ? 64u : 4u));
    ck[4] = (f2ord(own[0] + oth[5]) & 0xffffff00u) | (255u - (ls ? 80u : 5u));
    ck[5] = (f2ord(own[0] + oth[6]) & 0xffffff00u) | (255u - (ls ? 96u : 6u));
    ck[6] = (f2ord(own[0] + oth[7]) & 0xffffff00u) | (255u - (ls ? 112u : 7u));
    ck[7] = (f2ord(own[0] + oth[8]) & 0xffffff00u) | (255u - (ls ? 128u : 8u));
    ck[8] = (f2ord(own[0] + oth[9]) & 0xffffff00u) | (255u - (ls ? 144u : 9u));
    ck[9] = (f2ord(own[0] + oth[10]) & 0xffffff00u) | (255u - (ls ? 160u : 10u));
    ck[10] = (f2ord(own[0] + oth[11]) & 0xffffff00u) | (255u - (ls ? 176u : 11u));
    ck[11] = (f2ord(own[0] + oth[12]) & 0xffffff00u) | (255u - (ls ? 192u : 12u));
    ck[12] = (f2ord(own[0] + oth[13]) & 0xffffff00u) | (255u - (ls ? 208u : 13u));
    ck[13] = (f2ord(own[0] + oth[14]) & 0xffffff00u) | (255u - (ls ? 224u : 14u));
    ck[14] = (f2ord(own[0] + oth[15]) & 0xffffff00u) | (255u - (ls ? 240u : 15u));
    ck[15] = (f2ord(own[1] + oth[2]) & 0xffffff00u) | (255u - (ls ? 33u : 18u));
    ck[16] = (f2ord(own[1] + oth[3]) & 0xffffff00u) | (255u - (ls ? 49u : 19u));
    ck[17] = (f2ord(own[1] + oth[4]) & 0xffffff00u) | (255u - (ls ? 65u : 20u));
    ck[18] = (f2ord(own[1] + oth[5]) & 0xffffff00u) | (255u - (ls ? 81u : 21u));
    ck[19] = (f2ord(own[1] + oth[6]) & 0xffffff00u) | (255u - (ls ? 97u : 22u));
    ck[20] = (f2ord(own[1] + oth[7]) & 0xffffff00u) | (255u - (ls ? 113u : 23u));
    ck[21] = (f2ord(own[2] + oth[3]) & 0xffffff00u) | (255u - (ls ? 50u : 35u));
    ck[22] = (f2ord(own[2] + oth[4]) & 0xffffff00u) | (255u - (ls ? 66u : 36u));
    ck[23] = ls ? 0u : ((f2ord(own[0] + oth[0]) & 0xffffff00u) | (255u - 0u));
    ck[24] = ls ? 0u : ((f2ord(own[1] + oth[1]) & 0xffffff00u) | (255u - 17u));
    ck[25] = ls ? 0u : ((f2ord(own[2] + oth[2]) & 0xffffff00u) | (255u - 34u));
    ck[26] = ls ? 0u : ((f2ord(own[3] + oth[3]) & 0xffffff00u) | (255u - 51u));
    ck[27] = 0u;
    ck[28] = 0u;
    ck[29] = 0u;
    ck[30] = 0u;
    ck[31] = 0u;
    unsigned c0[16], c1[16];
#pragma unroll
    for (int i = 0; i < 16; ++i) { c0[i] = ck[i]; c1[i] = ck[16 + i]; }
    sort16_desc(c0); sort16_desc(c1); merge16_desc(c0, c1);
    unsigned pt[16];
#pragma unroll
    for (int i = 0; i < 16; ++i) pt[i] = dpp_xor1(c0[i]);
    merge16_desc(c0, pt);
    float cs[16], den = 0.f;
    const float mx = ord2f(c0[0] & 0xffffff00u);
#pragma unroll
    for (int r = 0; r < 16; ++r) { cs[r] = __expf(ord2f(c0[r] & 0xffffff00u) - mx); den += cs[r]; }
    const float inv = 1.f / den;
    const int token = tokw0 + (lane >> 1);
    if (ls == 0) {
      u32x2* so = p.sel + (size_t)token * 128 + h * 16;
      const LAS unsigned* l1 = fl + lane * 16;
      const LAS unsigned* l2 = fl + (lane + 1) * 16;
#pragma unroll
      for (int rr = 0; rr < 16; rr += 2) {
        u32x4 w;
        {
          const unsigned ci = 255u - (c0[rr] & 0xffu);
          w.x = (127u - (l1[ci >> 4] & 0x7fu)) * 128u + (127u - (l2[ci & 15u] & 0x7fu)); w.y = __float_as_uint(cs[rr] * inv);
        }
        {
          const unsigned ci = 255u - (c0[rr + 1] & 0xffu);
          w.z = (127u - (l1[ci >> 4] & 0x7fu)) * 128u + (127u - (l2[ci & 15u] & 0x7fu)); w.w = __float_as_uint(cs[rr + 1] * inv);
        }
        *(u32x4*)(so + rr) = w;
      }
    }
  }
}

__device__ __forceinline__ float gelu_as(float v) {
  const float av = fabsf(v), t = __builtin_amdgcn_rcpf(av * 0.2316418882f + 1.0f);
  float q = t * 0.5307027145f + (-0.7265760135f);
  q = q * t + 0.7107068705f; q = q * t + (-0.142248368f); q = q * t + 0.127414796f; q = q * t;
  const float ee = __builtin_amdgcn_exp2f((v * v) * (-0.72134752044f));
  const float m = v * (q * ee);
  return v < 0.f ? m : v - m;
}
typedef __bf16 bf16x2t __attribute__((ext_vector_type(2)));
__device__ __forceinline__ unsigned rl2(unsigned lo, unsigned hi, int j) {
  const unsigned a = (unsigned)__builtin_amdgcn_readlane((int)lo, j & 63), b = (unsigned)__builtin_amdgcn_readlane((int)hi, j & 63);
  return j < 64 ? a : b;
}
__device__ __forceinline__ float group8_sum(float x) { x += dppf<0xB1>(x); x += dppf<0x4E>(x); x += dppf<0x141>(x); return x; }
__device__ __forceinline__ float dot2u(unsigned a, unsigned b, float c) {
  return __builtin_amdgcn_fdot2_f32_bf16(__builtin_bit_cast(bf16x2t, a), __builtin_bit_cast(bf16x2t, b), c, false);
}
__device__ __forceinline__ void peer_sort_token(const Params& p, int token, int lane_in, LAS unsigned* lst, int t, const float* us, const float* vs) {
  int lane = lane_in;
  asm volatile("" : "+v"(lane));
      const u32x2 se0 = p.sel[(size_t)token * 128 + lane], se1 = p.sel[(size_t)token * 128 + 64 + lane];
      unsigned ka = (se0.x << 7) | (unsigned)lane, kb = (se1.x << 7) | (unsigned)(lane + 64);
#define BSTEP(J, UPA, UPB)                                                                                               \
      do {                                                                                                               \
        unsigned oa, ob;                                                                                                 \
        if ((J) == 1) { oa = dppu<0xB1>(ka); ob = dppu<0xB1>(kb); }                                                      \
        else if ((J) == 2) { oa = dppu<0x4E>(ka); ob = dppu<0x4E>(kb); }                                                 \
        else if ((J) == 4) { const bool hi4 = (lane & 4) != 0;                                                           \
          const unsigned a0 = dppu<0x104>(ka), a1 = dppu<0x114>(ka), b0 = dppu<0x104>(kb), b1 = dppu<0x114>(kb);         \
          oa = hi4 ? a1 : a0; ob = hi4 ? b1 : b0; }                                                                      \
        else if ((J) == 8) { oa = dppu<0x128>(ka); ob = dppu<0x128>(kb); }                                               \
        else if ((J) == 16) { const bool odd = (lane & 16) != 0;                                                         \
          auto ta = __builtin_amdgcn_permlane16_swap(ka, ka, false, false); auto tb = __builtin_amdgcn_permlane16_swap(kb, kb, false, false); \
          oa = odd ? ta[0] : ta[1]; ob = odd ? tb[0] : tb[1]; }                                                          \
        else { const bool up32 = lane >= 32;                                                                             \
          auto ta = __builtin_amdgcn_permlane32_swap(ka, ka, false, false); auto tb = __builtin_amdgcn_permlane32_swap(kb, kb, false, false); \
          oa = up32 ? ta[0] : ta[1]; ob = up32 ? tb[0] : tb[1]; }                                                        \
        const bool lower = (lane & (J)) == 0;                                                                            \
        const unsigned mna = min(ka, oa), mxa = max(ka, oa), mnb = min(kb, ob), mxb = max(kb, ob);                       \
        ka = (lower == (UPA)) ? mna : mxa;                                                                               \
        kb = (lower == (UPB)) ? mnb : mxb;                                                                               \
      } while (0)
#define BLAYERS(K)                                                                                                       \
      do {                                                                                                               \
        const bool up = ((K) >= 64) ? true : ((lane & (K)) == 0);                                                        \
        const bool upa = up, upb = ((K) == 64) ? false : up;                                                             \
        if ((K) >= 64) BSTEP(32, upa, upb);                                                                              \
        if ((K) >= 32) BSTEP(16, upa, upb);                                                                              \
        if ((K) >= 16) BSTEP(8, upa, upb);                                                                               \
        if ((K) >= 8) BSTEP(4, upa, upb);                                                                                \
        if ((K) >= 4) BSTEP(2, upa, upb);                                                                                \
        BSTEP(1, upa, upb);                                                                                              \
      } while (0)
      BLAYERS(2); BLAYERS(4); BLAYERS(8); BLAYERS(16); BLAYERS(32); BLAYERS(64);
      { const unsigned mn = min(ka, kb), mx = max(ka, kb); ka = mn; kb = mx; }
      BLAYERS(128);
#undef BLAYERS
#undef BSTEP
      const unsigned sa = ka & 127u, sb = kb & 127u;
      const unsigned ga0 = (unsigned)__builtin_amdgcn_ds_bpermute((int)((sa & 63u) * 4u), (int)se0.y), ga1 = (unsigned)__builtin_amdgcn_ds_bpermute((int)((sa & 63u) * 4u), (int)se1.y);
      const unsigned gb0 = (unsigned)__builtin_amdgcn_ds_bpermute((int)((sb & 63u) * 4u), (int)se0.y), gb1 = (unsigned)__builtin_amdgcn_ds_bpermute((int)((sb & 63u) * 4u), (int)se1.y);
      const float gta = __uint_as_float((sa & 64u) ? ga1 : ga0), gtb = __uint_as_float((sb & 64u) ? gb1 : gb0);
      const unsigned ea = ka >> 7, eb = kb >> 7;
      lst[t * 128 + lane] = ka; lst[t * 128 + 64 + lane] = kb;
      lst[1024 + t * 128 + lane] = __float_as_uint(gta * vs[ea]); lst[1024 + t * 128 + 64 + lane] = __float_as_uint(gtb * vs[eb]);
      lst[2048 + t * 128 + lane] = __float_as_uint(us[ea]); lst[2048 + t * 128 + 64 + lane] = __float_as_uint(us[eb]);
}
__device__ void phase_peer_gather(const Params& p, unsigned char* smem, int bid, int nb, int layer, int tok0, int ntok) {
  const int tid0 = tidx();
  const int wid = __builtin_amdgcn_readfirstlane(tid0 >> 6), lane = tid0 & 63, g = lane >> 3, i = lane & 7;
  const __amdgpu_buffer_rsrc_t U = __builtin_amdgcn_make_buffer_rsrc((void*)(p.u8 + (size_t)layer * NEXP * 768), (short)0, NEXP * 768, 0x00020000);
  const __amdgpu_buffer_rsrc_t V = __builtin_amdgcn_make_buffer_rsrc((void*)(p.v8 + (size_t)layer * NEXP * 768), (short)0, NEXP * 768, 0x00020000);
  const float* us = p.uscale + (size_t)layer * NEXP;
  const float* vs = p.vscale + (size_t)layer * NEXP;
  const float* modl = p.mod + (size_t)layer * 33 * MODW;
  LAS unsigned* lst = (LAS unsigned*)smem + wid * 3072;
#define PIECE(R, VOFF, K) __builtin_bit_cast(u32x4, __builtin_amdgcn_raw_buffer_load_b128(R, (VOFF) + (K) * 128, 0, 0))
  const int n8 = (ntok / (nb * 64)) * (nb * 64);
  for (int grp = bid * 8 + wid; grp < n8 / 8; grp += nb * 8) {
    const int token0 = tok0 + grp * 8;
#pragma unroll 1
    for (int t = 0; t < 8; ++t) {
      const int token = token0 + t;
      peer_sort_token(p, token, lane, lst, t, us, vs);
    }
    const int token = token0 + g;
    {
      u32x4 x[4][4];
#pragma unroll
      for (int b = 0; b < 4; ++b) {
        const bf16_t* xr = p.act + (size_t)token * D + b * 256 + i * 32;
#pragma unroll
        for (int q = 0; q < 4; ++q) x[b][q] = *(const u32x4*)(xr + q * 8);
      }
      constexpr int NB1 = 4;
      u32x4 pk[NB1][6];
#pragma unroll
      for (int s = 0; s < NB1; ++s) {
        const int voff = (int)((lst[g * 128 + s] >> 7) * 768u) + i * 16;
#pragma unroll
        for (int k = 0; k < 6; ++k) pk[s][k] = PIECE(U, voff, k);
      }
#define P1_BLOCK(B, W0, W1, W2, W3, W4, W5)                                                                              \
      do {                                                                                                               \
        u32x6 w6; w6[0] = (W0); w6[1] = (W1); w6[2] = (W2); w6[3] = (W3); w6[4] = (W4); w6[5] = (W5);                    \
        const u32x16 bw = __builtin_bit_cast(u32x16, __builtin_amdgcn_cvt_scalef32_pk32_bf16_fp6(w6, 1.0f));             \
        _Pragma("unroll") for (int q = 0; q < 4; ++q) {                                                                  \
          const u32x4 xv = x[B][q];                                                                                      \
          const unsigned b0 = bw[4 * q], b1 = bw[4 * q + 1], b2 = bw[4 * q + 2], b3 = bw[4 * q + 3];                     \
          const unsigned x0 = xv[0], x1 = xv[1], x2 = xv[2], x3 = xv[3];                                                 \
          d0 = dot2u(b0, x0, d0); d1 = dot2u(b1, x1, d1); d2 = dot2u(b2, x2, d2); d3 = dot2u(b3, x3, d3);                \
        }                                                                                                                \
      } while (0)
#define P1_STEP(S, J)                                                                                                    \
      do {                                                                                                               \
        const int jn = (J) + NB1 < 128 ? (J) + NB1 : 127;                                                                \
        const int voffn = (int)((lst[g * 128 + jn] >> 7) * 768u) + i * 16;                                               \
        const float su = __uint_as_float(lst[2048 + g * 128 + (J)]), gsv = __uint_as_float(lst[1024 + g * 128 + (J)]);   \
        float d0 = 0.f, d1 = 0.f, d2 = 0.f, d3 = 0.f;                                                                    \
        P1_BLOCK(0, pk[S][0][0], pk[S][0][1], pk[S][0][2], pk[S][0][3], pk[S][1][0], pk[S][1][1]);                       \
        P1_BLOCK(1, pk[S][1][2], pk[S][1][3], pk[S][2][0], pk[S][2][1], pk[S][2][2], pk[S][2][3]);                       \
        pk[S][0] = PIECE(U, voffn, 0); pk[S][1] = PIECE(U, voffn, 1); pk[S][2] = PIECE(U, voffn, 2);                     \
        __builtin_amdgcn_sched_barrier(0);                                                                               \
        P1_BLOCK(2, pk[S][3][0], pk[S][3][1], pk[S][3][2], pk[S][3][3], pk[S][4][0], pk[S][4][1]);                       \
        P1_BLOCK(3, pk[S][4][2], pk[S][4][3], pk[S][5][0], pk[S][5][1], pk[S][5][2], pk[S][5][3]);                       \
        pk[S][3] = PIECE(U, voffn, 3); pk[S][4] = PIECE(U, voffn, 4); pk[S][5] = PIECE(U, voffn, 5);                     \
        __builtin_amdgcn_sched_barrier(0);                                                                               \
        const float d = group8_sum((d0 + d1) + (d2 + d3)) * su;                                                          \
        lst[1024 + g * 128 + (J)] = __float_as_uint(gsv * gelu_as(d));                                                   \
      } while (0)
#pragma unroll 1
      for (int j = 0; j < 128; j += 4) { P1_STEP(0, j); P1_STEP(1, j + 1); P1_STEP(2, j + 2); P1_STEP(3, j + 3); }
#undef P1_STEP
#undef P1_BLOCK
    }
    const bool isctx = token < NCTX;
    const int b = isctx ? 32 : ((token - NCTX) >> 11);
    const float* g2 = modl + (size_t)b * MODW + 5 * D + i * 32;
    float* hrow = (isctx ? p.hctx + (size_t)token * D : p.out + (size_t)(token - NCTX) * D) + i * 32;
    float ss = 0.f;
#pragma unroll 1
    for (int hf = 0; hf < 2; ++hf) {
      f32x32 y0, y1;
#pragma unroll
      for (int c = 0; c < 32; ++c) { y0[c] = 0.f; y1[c] = 0.f; }
      const int hoff = hf * 384 + i * 16;
      constexpr int NB2 = 8;
      u32x4 pk[NB2][3];
#pragma unroll
      for (int s = 0; s < NB2; ++s) {
        const int voff = (int)((lst[g * 128 + s] >> 7) * 768u) + hoff;
#pragma unroll
        for (int k = 0; k < 3; ++k) pk[s][k] = PIECE(V, voff, k);
      }
#define P2_STEP(S, J)                                                                                                    \
      do {                                                                                                               \
        const int jn = (J) + NB2 < 128 ? (J) + NB2 : 127;                                                                \
        const int voffn = (int)((lst[g * 128 + jn] >> 7) * 768u) + hoff;                                                 \
        const float a = __uint_as_float(lst[1024 + g * 128 + (J)]);                                                      \
        {                                                                                                                \
          u32x6 w6; w6[0] = pk[S][0][0]; w6[1] = pk[S][0][1]; w6[2] = pk[S][0][2]; w6[3] = pk[S][0][3]; w6[4] = pk[S][1][0]; w6[5] = pk[S][1][1]; \
          const f32x32 f = __builtin_amdgcn_cvt_scalef32_pk32_f32_fp6(w6, 1.0f);                                         \
          y0 += f * a;                                                                                                   \
        }                                                                                                                \
        __builtin_amdgcn_sched_barrier(0);                                                                               \
        {                                                                                                                \
          u32x6 w6; w6[0] = pk[S][1][2]; w6[1] = pk[S][1][3]; w6[2] = pk[S][2][0]; w6[3] = pk[S][2][1]; w6[4] = pk[S][2][2]; w6[5] = pk[S][2][3]; \
          const f32x32 f = __builtin_amdgcn_cvt_scalef32_pk32_f32_fp6(w6, 1.0f);                                         \
          y1 += f * a;                                                                                                   \
        }                                                                                                                \
        pk[S][0] = PIECE(V, voffn, 0); pk[S][1] = PIECE(V, voffn, 1); pk[S][2] = PIECE(V, voffn, 2);                     \
        __builtin_amdgcn_sched_barrier(0);                                                                               \
      } while (0)
#pragma unroll 1
      for (int j = 0; j < 128; j += 8) { P2_STEP(0, j); P2_STEP(1, j + 1); P2_STEP(2, j + 2); P2_STEP(3, j + 3); P2_STEP(4, j + 4); P2_STEP(5, j + 5); P2_STEP(6, j + 6); P2_STEP(7, j + 7); }
#undef P2_STEP
#ifdef ZERO_PEER
      if (layer == ZERO_PEER) {
#pragma unroll
        for (int c = 0; c < 32; ++c) { y0[c] = 0.f; y1[c] = 0.f; }
      }
#endif
#pragma unroll
      for (int bb = 0; bb < 2; ++bb)
#pragma unroll
        for (int q4 = 0; q4 < 8; ++q4) {
          const int co = (2 * hf + bb) * 256 + q4 * 4;
          const f32x4 hv = *(const f32x4*)(hrow + co), gv = *(const f32x4*)(g2 + co);
          f32x4 o;
#pragma unroll
          for (int e = 0; e < 4; ++e) { const float yv = bb ? y1[q4 * 4 + e] : y0[q4 * 4 + e]; const float v = hv[e] + gv[e] * yv; o[e] = v; ss += v * v; }
          *(f32x4*)(hrow + co) = o;
        }
    }
    {
      ss = group8_sum(ss);
      const float rstd = rsqrtf(ss * (1.f / D) + EPS);
      if (layer == 0) {
        const float* modn = p.mod + (size_t)33 * MODW + (size_t)b * MODW + i * 32;
        const float* gain = p.mix_g + D + i * 32;
#pragma unroll 2
        for (int k = 0; k < 16; ++k) {
          const int co = (k >> 2) * 256 + (k & 3) * 8;
          u32x4 w;
#pragma unroll
          for (int q4 = 0; q4 < 2; ++q4) {
            const f32x4 hv = *(const f32x4*)(hrow + co + q4 * 4);
            const f32x4 gg = *(const f32x4*)(gain + co + q4 * 4), s0 = *(const f32x4*)(modn + co + q4 * 4), s1 = *(const f32x4*)(modn + D + co + q4 * 4);
            f32x4 yv = hv * rstd * gg;
            yv = yv * (1.f + s1) + s0;
            w[q4 * 2] = cvt_pk_bf16(yv[0], yv[1]); w[q4 * 2 + 1] = cvt_pk_bf16(yv[2], yv[3]);
          }
          *(u32x4*)(p.act + (size_t)token * D + i * 32 + co) = w;
        }
      } else {
        const float* gain = p.final_g + i * 32;
#pragma unroll 2
        for (int k = 0; k < 32; ++k) {
          const int co = (k >> 3) * 256 + (k & 7) * 4;
          const f32x4 hv = *(const f32x4*)(hrow + co), gg = *(const f32x4*)(gain + co);
          *(f32x4*)(hrow + co) = hv * rstd * gg;
        }
      }
    }
    __syncthreads();
  }
  {
    const int g4 = lane >> 4, iv = lane & 7, hs = (lane >> 3) & 1;
    const int poff = hs * 384 + iv * 16;
    for (int grp = bid * 8 + wid; grp < (ntok - n8) / 4; grp += nb * 8) {
      const int token0 = tok0 + n8 + grp * 4;
#pragma unroll 1
      for (int t = 0; t < 4; ++t) peer_sort_token(p, token0 + t, lane, lst, t, us, vs);
      const int token = token0 + g4;
      {
        u32x4 x[2][4];
#pragma unroll
        for (int bb = 0; bb < 2; ++bb) {
          const bf16_t* xr = p.act + (size_t)token * D + (2 * hs + bb) * 256 + iv * 32;
#pragma unroll
          for (int q = 0; q < 4; ++q) x[bb][q] = *(const u32x4*)(xr + q * 8);
        }
        constexpr int NB1 = 8;
        u32x4 pk[NB1][3];
#pragma unroll
        for (int s = 0; s < NB1; ++s) {
          const int voff = (int)((lst[g4 * 128 + s] >> 7) * 768u) + poff;
#pragma unroll
          for (int k = 0; k < 3; ++k) pk[s][k] = PIECE(U, voff, k);
        }
#define T1_BLOCK(B, W0, W1, W2, W3, W4, W5)                                                                              \
        do {                                                                                                             \
          u32x6 w6; w6[0] = (W0); w6[1] = (W1); w6[2] = (W2); w6[3] = (W3); w6[4] = (W4); w6[5] = (W5);                  \
          const u32x16 bw = __builtin_bit_cast(u32x16, __builtin_amdgcn_cvt_scalef32_pk32_bf16_fp6(w6, 1.0f));           \
          _Pragma("unroll") for (int q = 0; q < 4; ++q) {                                                                \
            const u32x4 xv = x[B][q];                                                                                    \
            const unsigned b0 = bw[4 * q], b1 = bw[4 * q + 1], b2 = bw[4 * q + 2], b3 = bw[4 * q + 3];                   \
            const unsigned x0 = xv[0], x1 = xv[1], x2 = xv[2], x3 = xv[3];                                               \
            d0 = dot2u(b0, x0, d0); d1 = dot2u(b1, x1, d1); d2 = dot2u(b2, x2, d2); d3 = dot2u(b3, x3, d3);              \
          }                                                                                                              \
        } while (0)
#define T1_STEP(S, J)                                                                                                    \
        do {                                                                                                             \
          const int jn = (J) + NB1 < 128 ? (J) + NB1 : 127;                                                              \
          const int voffn = (int)((lst[g4 * 128 + jn] >> 7) * 768u) + poff;                                              \
          const float su = __uint_as_float(lst[2048 + g4 * 128 + (J)]), gsv = __uint_as_float(lst[1024 + g4 * 128 + (J)]); \
          float d0 = 0.f, d1 = 0.f, d2 = 0.f, d3 = 0.f;                                                                  \
          T1_BLOCK(0, pk[S][0][0], pk[S][0][1], pk[S][0][2], pk[S][0][3], pk[S][1][0], pk[S][1][1]);                     \
          T1_BLOCK(1, pk[S][1][2], pk[S][1][3], pk[S][2][0], pk[S][2][1], pk[S][2][2], pk[S][2][3]);                     \
          pk[S][0] = PIECE(U, voffn, 0); pk[S][1] = PIECE(U, voffn, 1); pk[S][2] = PIECE(U, voffn, 2);                   \
          __builtin_amdgcn_sched_barrier(0);                                                                             \
          float dd = group8_sum((d0 + d1) + (d2 + d3)); dd += dppf<0x128>(dd);             \
          lst[1024 + g4 * 128 + (J)] = __float_as_uint(gsv * gelu_as(dd * su));                                          \
        } while (0)
#pragma unroll 1
        for (int j = 0; j < 128; j += 8) { T1_STEP(0, j); T1_STEP(1, j + 1); T1_STEP(2, j + 2); T1_STEP(3, j + 3); T1_STEP(4, j + 4); T1_STEP(5, j + 5); T1_STEP(6, j + 6); T1_STEP(7, j + 7); }
#undef T1_STEP
#undef T1_BLOCK
      }
      const bool isctx = token < NCTX;
      const int b = isctx ? 32 : ((token - NCTX) >> 11);
      const float* g2 = modl + (size_t)b * MODW + 5 * D + iv * 32;
      float* hrow = (isctx ? p.hctx + (size_t)token * D : p.out + (size_t)(token - NCTX) * D) + iv * 32;
      float ss = 0.f;
      {
        f32x32 y0, y1;
#pragma unroll
        for (int c = 0; c < 32; ++c) { y0[c] = 0.f; y1[c] = 0.f; }
        constexpr int NB2 = 8;
        u32x4 pk[NB2][3];
#pragma unroll
        for (int s = 0; s < NB2; ++s) {
          const int voff = (int)((lst[g4 * 128 + s] >> 7) * 768u) + poff;
#pragma unroll
          for (int k = 0; k < 3; ++k) pk[s][k] = PIECE(V, voff, k);
        }
#define T2_STEP(S, J)                                                                                                    \
        do {                                                                                                             \
          const int jn = (J) + NB2 < 128 ? (J) + NB2 : 127;                                                              \
          const int voffn = (int)((lst[g4 * 128 + jn] >> 7) * 768u) + poff;                                              \
          const float a = __uint_as_float(lst[1024 + g4 * 128 + (J)]);                                                   \
          {                                                                                                              \
            u32x6 w6; w6[0] = pk[S][0][0]; w6[1] = pk[S][0][1]; w6[2] = pk[S][0][2]; w6[3] = pk[S][0][3]; w6[4] = pk[S][1][0]; w6[5] = pk[S][1][1]; \
            const f32x32 f = __builtin_amdgcn_cvt_scalef32_pk32_f32_fp6(w6, 1.0f);                                       \
            y0 += f * a;                                                                                                 \
          }                                                                                                              \
          __builtin_amdgcn_sched_barrier(0);                                                                             \
          {                                                                                                              \
            u32x6 w6; w6[0] = pk[S][1][2]; w6[1] = pk[S][1][3]; w6[2] = pk[S][2][0]; w6[3] = pk[S][2][1]; w6[4] = pk[S][2][2]; w6[5] = pk[S][2][3]; \
            const f32x32 f = __builtin_amdgcn_cvt_scalef32_pk32_f32_fp6(w6, 1.0f);                                       \
            y1 += f * a;                                                                                                 \
          }                                                                                                              \
          pk[S][0] = PIECE(V, voffn, 0); pk[S][1] = PIECE(V, voffn, 1); pk[S][2] = PIECE(V, voffn, 2);                   \
          __builtin_amdgcn_sched_barrier(0);                                                                             \
        } while (0)
#pragma unroll 1
        for (int j = 0; j < 128; j += 8) { T2_STEP(0, j); T2_STEP(1, j + 1); T2_STEP(2, j + 2); T2_STEP(3, j + 3); T2_STEP(4, j + 4); T2_STEP(5, j + 5); T2_STEP(6, j + 6); T2_STEP(7, j + 7); }
#undef T2_STEP
#ifdef ZERO_PEER
        if (layer == ZERO_PEER) {
#pragma unroll
          for (int c = 0; c < 32; ++c) { y0[c] = 0.f; y1[c] = 0.f; }
        }
#endif
#pragma unroll
        for (int bb = 0; bb < 2; ++bb)
#pragma unroll
          for (int q4 = 0; q4 < 8; ++q4) {
            const int co = (2 * hs + bb) * 256 + q4 * 4;
            const f32x4 hv = *(const f32x4*)(hrow + co), gv = *(const f32x4*)(g2 + co);
            f32x4 o;
#pragma unroll
            for (int e = 0; e < 4; ++e) { const float yv = bb ? y1[q4 * 4 + e] : y0[q4 * 4 + e]; const float v = hv[e] + gv[e] * yv; o[e] = v; ss += v * v; }
            *(f32x4*)(hrow + co) = o;
          }
      }
      {
        ss = group8_sum(ss); ss += dppf<0x128>(ss);
        const float rstd = rsqrtf(ss * (1.f / D) + EPS);
        if (layer == 0) {
          const float* modn = p.mod + (size_t)33 * MODW + (size_t)b * MODW + iv * 32;
          const float* gain = p.mix_g + D + iv * 32;
#pragma unroll 2
          for (int k = 0; k < 8; ++k) {
            const int co = (2 * hs + (k >> 2)) * 256 + (k & 3) * 8;
            u32x4 w;
#pragma unroll
            for (int q4 = 0; q4 < 2; ++q4) {
              const f32x4 hv = *(const f32x4*)(hrow + co + q4 * 4);
              const f32x4 gg = *(const f32x4*)(gain + co + q4 * 4), s0 = *(const f32x4*)(modn + co + q4 * 4), s1 = *(const f32x4*)(modn + D + co + q4 * 4);
              f32x4 yv = hv * rstd * gg;
              yv = yv * (1.f + s1) + s0;
              w[q4 * 2] = cvt_pk_bf16(yv[0], yv[1]); w[q4 * 2 + 1] = cvt_pk_bf16(yv[2], yv[3]);
            }
            *(u32x4*)(p.act + (size_t)token * D + iv * 32 + co) = w;
          }
        } else {
          const float* gain = p.final_g + iv * 32;
#pragma unroll 2
          for (int k = 0; k < 16; ++k) {
            const int co = (2 * hs + (k >> 3)) * 256 + (k & 7) * 4;
            const f32x4 hv = *(const f32x4*)(hrow + co), gg = *(const f32x4*)(gain + co);
            *(f32x4*)(hrow + co) = hv * rstd * gg;
          }
        }
      }
      __syncthreads();
    }
  }
#undef PIECE
}

constexpr int NPH = 18;
template <int PH>
__device__ __forceinline__ void run_phase(const Params& p, unsigned char* smem, int bid, int nb) {
  if constexpr (PH == 0) phase_prep(p, smem, bid, nb);
  else if constexpr (PH == 1) phase_norm(p, bid, nb, 0, NTOK, p.ctx, p.x, p.mix_g, p.mod, 0, 1);
  else if constexpr (PH == 2) phase_gemm_inproj(p, smem, bid, nb, 0);
  else if constexpr (PH == 3) phase_ret_kv(p, smem, bid, nb);
  else if constexpr (PH == 4) phase_ret_scan(p, bid, nb);
  else if constexpr (PH == 5) phase_ret_out(p, smem, bid, nb);
  else if constexpr (PH == 6) phase_gemm_outproj(p, smem, bid, nb, 0);
  else if constexpr (PH == 7) phase_resid_norm(p, bid, nb, 0, NTOK, p.ctx, p.x, p.ffn_g, p.mod);
  else if constexpr (PH == 8) phase_gemm_pq(p, smem, bid, nb, 0);
  else if constexpr (PH == 9) phase_peer_topk(p, smem, bid, nb, 0, 0, NTOK);
  else if constexpr (PH == 10) phase_peer_gather(p, smem, bid, nb, 0, 0, NTOK);
  else if constexpr (PH == 11) phase_gemm_inproj(p, smem, bid, nb, 1);
  else if constexpr (PH == 12) phase_attn<0>(p, smem, bid, nb, p.act);
  else if constexpr (PH == 13) phase_gemm_outproj(p, smem, bid, nb, 1);
  else if constexpr (PH == 14) phase_resid_norm(p, bid, nb, NCTX, NTOK, p.hctx, p.out, p.ffn_g + D, p.mod + (size_t)33 * MODW);
  else if constexpr (PH == 15) phase_gemm_pq(p, smem, bid, nb, 1);
  else if constexpr (PH == 16) phase_peer_topk(p, smem, bid, nb, 1, NCTX, NLAT);
  else if constexpr (PH == 17) phase_peer_gather(p, smem, bid, nb, 1, NCTX, NLAT);
}
template <int PH>
__global__ void __launch_bounds__(NTHREADS) phase_k(Params p) {
  extern __shared__ __attribute__((aligned(16))) unsigned char smem[];
  run_phase<PH>(p, smem, blockIdx.x, gridDim.x);
}
#define XB_TMO      128
#define XB_XCNT(j)  (256  + 64 * (j))
#define XB_XSUB(j)  (1280 + 64 * (j))
#define XB_XGEN(j)  (2304 + 64 * (j))
#define XB_TOP      3328
#define XB_TOPGEN   3392
#define XCD_BAR_WORDS 3456
#define XB_SPIN_CAP (1u << 22)
__device__ __forceinline__ unsigned xb_ld(unsigned* p)              { return __hip_atomic_load(p, __ATOMIC_RELAXED, __HIP_MEMORY_SCOPE_AGENT); }
__device__ __forceinline__ unsigned xb_add(unsigned* p, unsigned v) { return __hip_atomic_fetch_add(p, v, __ATOMIC_RELAXED, __HIP_MEMORY_SCOPE_AGENT); }
__device__ __forceinline__ unsigned xb_xcc_id() { return (unsigned)__builtin_amdgcn_s_getreg((3 << 11) | 20) & 0xFu; }
#define XB_SPIN(cond, bar) do { unsigned _sp = 0; while (cond) { __builtin_amdgcn_s_sleep(1); \
    if ((++_sp & 255u) == 0u) { if (xb_ld(&(bar)[XB_TMO])) break; if (_sp > XB_SPIN_CAP) { atomicAdd(&(bar)[XB_TMO], 1u); break; } } } } while (0)
struct XcdBarrier { unsigned* bar; unsigned x; volatile LAS unsigned* st; };
__device__ __forceinline__ XcdBarrier xcd_barrier_post(unsigned* bar, volatile LAS unsigned* st) {
  XcdBarrier b; b.bar = bar; b.x = xb_xcc_id(); b.st = st;
  if (threadIdx.x == 0) (void)xb_add(&bar[XB_XCNT(b.x)], 1u);
  return b;
}
__device__ __forceinline__ void xcd_barrier_complete(unsigned* bar, unsigned x, unsigned& nloc, unsigned& nx) {
  const unsigned G = gridDim.x * gridDim.y * gridDim.z;
  unsigned sum, cnt, mine, sp = 0u;
  for (;;) {
    sum = 0u; cnt = 0u; mine = 0u;
#pragma unroll
    for (unsigned j = 0; j < 16; ++j) { const unsigned c = xb_ld(&bar[XB_XCNT(j)]); sum += c; cnt += (c > 0u) ? 1u : 0u; mine = (j == x) ? c : mine; }
    if (sum == G) break;
    __builtin_amdgcn_s_sleep(1);
    if ((++sp & 255u) == 0u) { if (xb_ld(&bar[XB_TMO])) break; if (sp > XB_SPIN_CAP) { atomicAdd(&bar[XB_TMO], 1u); break; } }
  }
  nloc = mine > 0u ? mine : 1u; nx = cnt > 0u ? cnt : 1u;
}
__device__ __forceinline__ void xcd_barrier(const XcdBarrier& b) {
  asm volatile("s_waitcnt vmcnt(0)" ::: "memory");
  __syncthreads();
  if (threadIdx.x == 0) {
    unsigned* bar = b.bar;
    __builtin_amdgcn_s_waitcnt(0);
    unsigned nloc = b.st[0], nx = b.st[1];
    if (nloc == 0u) { xcd_barrier_complete(bar, b.x, nloc, nx); b.st[0] = nloc; b.st[1] = nx; }
    const unsigned old = xb_add(&bar[XB_XSUB(b.x)], 1u);
    const unsigned gen = old / nloc;
    if (old + 1u == (gen + 1u) * nloc) {
      __builtin_amdgcn_fence(__ATOMIC_RELEASE, "agent");
      asm volatile("s_waitcnt vmcnt(0)" ::: "memory");
      const unsigned og = xb_add(&bar[XB_TOP], 1u);
      const unsigned tg = og / nx;
      if (og + 1u == (tg + 1u) * nx) xb_add(&bar[XB_TOPGEN], 1u);
      else XB_SPIN(xb_ld(&bar[XB_TOPGEN]) == tg, bar);
      __builtin_amdgcn_fence(__ATOMIC_ACQUIRE, "agent");
      xb_add(&bar[XB_XGEN(b.x)], 1u);
      asm volatile("s_waitcnt vmcnt(0)" ::: "memory");
    } else {
      XB_SPIN(xb_ld(&bar[XB_XGEN(b.x)]) == gen, bar);
      __builtin_amdgcn_fence(__ATOMIC_ACQUIRE, "agent");
      asm volatile("s_waitcnt vmcnt(0)" ::: "memory");
    }
  }
  __syncthreads();
}

#if MK_ONE_LAUNCH
constexpr int PARAMS_OFF = LDS_BYTES - 512;
static_assert(sizeof(Params) <= 480, "params block");
template <class T>
__device__ __forceinline__ T* uni(T* q) {
  const unsigned long long v = (unsigned long long)q;
  const unsigned lo = __builtin_amdgcn_readfirstlane((unsigned)v), hi = __builtin_amdgcn_readfirstlane((unsigned)(v >> 32));
  return (T*)(((unsigned long long)hi << 32) | lo);
}
__device__ __forceinline__ Params load_params(const unsigned char* smem) {
  const Params* l = (const Params*)(smem + PARAMS_OFF);
  Params q;
  q.x = uni(l->x); q.c = uni(l->c); q.ctx = uni(l->ctx); q.c_ctx = uni(l->c_ctx); q.ada_w = uni(l->ada_w); q.ada_b = uni(l->ada_b);
  q.mix_g = uni(l->mix_g); q.ffn_g = uni(l->ffn_g); q.ev_w_in = uni(l->ev_w_in); q.ev_w_out = uni(l->ev_w_out);
  q.logit_f = uni(l->logit_f); q.logit_b = uni(l->logit_b); q.conv_w = uni(l->conv_w); q.od_w_in = uni(l->od_w_in);
  q.od_w_out = uni(l->od_w_out); q.sinks = uni(l->sinks); q.peer_wq = uni(l->peer_wq); q.keys1 = uni(l->keys1); q.keys2 = uni(l->keys2);
  q.peer_u = uni(l->peer_u); q.peer_v = uni(l->peer_v); q.final_g = uni(l->final_g); q.out = uni(l->out); q.mod = uni(l->mod);
  q.ropec = uni(l->ropec); q.ropes = uni(l->ropes); q.winT0 = uni(l->winT0); q.woutT0 = uni(l->woutT0); q.winT1 = uni(l->winT1);
  q.woutT1 = uni(l->woutT1); q.wqT = uni(l->wqT); q.u8 = uni(l->u8); q.v8 = uni(l->v8); q.uscale = uni(l->uscale); q.vscale = uni(l->vscale); q.hctx = uni(l->hctx); q.act = uni(l->act);
  q.proj = uni(l->proj); q.pq = uni(l->pq); q.sel = uni(l->sel); q.kv = uni(l->kv); q.sprev = uni(l->sprev); q.bar = uni(l->bar); q.keysb = uni(l->keysb);
  return q;
}
template <int PH>
__device__ __forceinline__ void run_from(unsigned char* smem, int bid, int nb, const XcdBarrier& xb) {
  {
    const Params q = load_params(smem);
    run_phase<PH>(q, smem, bid, nb);
  }
#ifdef DUP_PH
  if constexpr (PH == DUP_PH) {
    xcd_barrier(xb);
    const Params q = load_params(smem);
#ifdef DUP_ATTN_VAR
    phase_attn<DUP_ATTN_VAR>(q, smem, bid, nb, q.proj + (size_t)113246208);
#else
    run_phase<PH>(q, smem, bid, nb);
#endif
  }
#endif
  if constexpr (PH + 1 < NPH) {
    if constexpr (PH == 0) cg::this_grid().sync();
    else xcd_barrier(xb);
    run_from<PH + 1>(smem, bid, nb, xb);
  }
}
__global__ void __launch_bounds__(NTHREADS) mega(Params p) {
  extern __shared__ __attribute__((aligned(16))) unsigned char smem[];
  volatile LAS unsigned* st = (volatile LAS unsigned*)((LAS unsigned char*)smem + PARAMS_OFF + 480);
  if (threadIdx.x == 0) { *(Params*)(smem + PARAMS_OFF) = p; st[0] = 0u; st[1] = 0u; }
  __syncthreads();
  const XcdBarrier xb = xcd_barrier_post(p.bar, st);
  run_from<0>(smem, blockIdx.x, gridDim.x, xb);
}
#endif
#ifndef DBG_NPH
#define DBG_NPH 0
#endif
#if DBG_NPH
__global__ void __launch_bounds__(NTHREADS) dbg_sums(Params p, float* scr, int nph) {
  const int wid = threadIdx.x >> 6, lane = threadIdx.x & 63;
  const int gw = blockIdx.x * 8 + wid, nw = gridDim.x * 8;
  if (nph >= 2) for (int r = gw; r < NTOK; r += nw) { float s = 0.f; for (int c = lane; c < D; c += 64) s += bf2f(p.act[(size_t)r * D + c]) * (1 + (c & 7)); s = wave_sum(s); if (lane == 0) scr[r] = s; }
  if (nph >= 3 && nph <= 8) for (int r = gw; r < NTOK; r += nw) { float s = 0.f; for (int c = lane; c < 3072; c += 64) s += bf2f(p.proj[(size_t)r * 3072 + c]) * (1 + (c & 7)); s = wave_sum(s); if (lane == 0) scr[(1 << 20) + r] = s; }
  if (nph >= 12 && nph <= 15) for (int r = gw; r < NTOK; r += nw) { float s = 0.f; for (int c = lane + (r < NCTX ? 1024 : 0); c < 1536; c += 64) s += bf2f(p.proj[(size_t)r * 1536 + c]) * (1 + (c & 7)); s = wave_sum(s); if (lane == 0) scr[(1 << 20) + r] = s; }
  if (nph >= 4) for (int r = gw; r < 2304 * 128; r += nw) { float s = 0.f; for (int c = lane; c < 128; c += 64) s += p.kv[(size_t)r * 128 + c] * (1 + (c & 7)); s = wave_sum(s); if (lane == 0) scr[(2 << 20) + r] = s; }
  if (nph >= 5) for (int r = gw; r < 2304 * 128; r += nw) { float s = 0.f; for (int c = lane; c < 128; c += 64) s += bf2f(p.sprev[(size_t)r * 128 + c]) * (1 + (c & 7)); s = wave_sum(s); if (lane == 0) scr[(3 << 20) + r] = s; }
  if (nph >= 7) for (int r = gw; r < NCTX; r += nw) { float s = 0.f; for (int c = lane; c < D; c += 64) s += p.hctx[(size_t)r * D + c] * (1 + (c & 7)); s = wave_sum(s); if (lane == 0) scr[(4 << 20) + r] = s; }
  if (nph >= 1) for (int i = blockIdx.x * NTHREADS + threadIdx.x; i < 2 * 33 * MODW; i += gridDim.x * NTHREADS) scr[(5 << 20) + i] = p.mod[i];
  if (nph >= 7) for (int r = gw; r < NLAT; r += nw) { float s = 0.f; for (int c = lane; c < D; c += 64) s += p.out[(size_t)r * D + c] * (1 + (c & 7)); s = wave_sum(s); if (lane == 0) scr[(6 << 20) + r] = s; }
  if (nph >= 10 && nph <= 11) for (int r = gw; r < NTOK; r += nw) { float s = 0.f; for (int c = lane; c < 128; c += 64) { const u32x2 e = p.sel[(size_t)r * 128 + c]; s += __uint_as_float(e.y) * (float)(e.x & 1023); } s = wave_sum(s); if (lane == 0) scr[(7 << 20) + r] = s; }
}
__global__ void __launch_bounds__(NTHREADS) dbg_out(Params p, const float* scr) {
  for (size_t i = (size_t)blockIdx.x * NTHREADS + threadIdx.x; i < (size_t)NLAT * D; i += (size_t)gridDim.x * NTHREADS) p.out[i] = (i < (size_t)(8 << 20)) ? scr[i] : 0.f;
}
__global__ void __launch_bounds__(NTHREADS) dbg_zero(float* scr) {
  for (size_t i = (size_t)blockIdx.x * NTHREADS + threadIdx.x; i < (size_t)(8 << 20); i += (size_t)gridDim.x * NTHREADS) scr[i] = 0.f;
}
#endif
template <int PH>
static void launch_phases(const Params& p, int grid, hipStream_t stream) {
  static bool attr_set = false;
  if (!attr_set) { (void)hipFuncSetAttribute((const void*)phase_k<PH>, hipFuncAttributeMaxDynamicSharedMemorySize, LDS_BYTES); attr_set = true; }
  phase_k<PH><<<grid, NTHREADS, LDS_BYTES, stream>>>(p);
  if constexpr (PH + 1 < (DBG_NPH ? DBG_NPH : NPH)) launch_phases<PH + 1>(p, grid, stream);
}

extern "C" void kernel_launch(void* const* d_in, const int* in_sizes, int n_in, void* d_out, int out_size, void* d_ws,
                              size_t ws_size, hipStream_t stream) {
  Params p{};
  const float* const* in = (const float* const*)d_in;
  p.x = in[0]; p.c = in[1]; p.ctx = in[2]; p.c_ctx = in[3]; p.ada_w = in[4]; p.ada_b = in[5]; p.mix_g = in[6]; p.ffn_g = in[7];
  p.ev_w_in = in[8]; p.ev_w_out = in[9]; p.logit_f = in[10]; p.logit_b = in[11]; p.conv_w = in[12]; p.od_w_in = in[13];
  p.od_w_out = in[14]; p.sinks = in[15]; p.peer_wq = in[16]; p.keys1 = in[17]; p.keys2 = in[18]; p.peer_u = in[19];
  p.peer_v = in[20]; p.final_g = in[21];
  p.out = (float*)d_out;
  unsigned char* w = (unsigned char*)d_ws;
  size_t off = 0;
  auto take = [&](size_t bytes) { unsigned char* r = w + off; off += (bytes + 255) & ~(size_t)255; return r; };
  p.mod = (float*)take((size_t)2 * 33 * MODW * 4);
  p.ropec = (float*)take(1024 * 4);
  p.ropes = (float*)take(1024 * 4);
  p.winT0 = (bf16_t*)take((size_t)3072 * 1024 * 2);
  p.woutT0 = (bf16_t*)take((size_t)1024 * 1024 * 2);
  p.winT1 = (bf16_t*)take((size_t)1536 * 1024 * 2);
  p.woutT1 = (bf16_t*)take((size_t)1024 * 1024 * 2);
  p.wqT = (bf16_t*)take((size_t)2 * 1024 * 1024 * 2);
  p.u8 = (unsigned char*)take((size_t)2 * NEXP * 768);
  p.v8 = (unsigned char*)take((size_t)2 * NEXP * 768);
  p.uscale = (float*)take((size_t)2 * NEXP * 4);
  p.vscale = (float*)take((size_t)2 * NEXP * 4);
  p.hctx = (float*)take((size_t)NCTX * D * 4);
  p.act = (bf16_t*)take((size_t)NTOK * D * 2);
  p.kv = (float*)take((size_t)2304 * 16384 * 4);
  p.sprev = (bf16_t*)take((size_t)2304 * 16384 * 2);
  p.bar = (unsigned*)take((size_t)XCD_BAR_WORDS * 4);
  p.keysb = (bf16_t*)take((size_t)2 * 8 * 2 * 2 * 128 * 64 * 2);
  p.proj = (bf16_t*)take((size_t)NTOK * 3072 * 2);
  p.pq = p.proj;
  p.sel = (u32x2*)((unsigned char*)p.proj + (size_t)NTOK * D * 2);
  if (off > ws_size) { fprintf(stderr, "workspace too small: need %zu have %zu\n", off, ws_size); }

  int grid = 256;
#if MK_ONE_LAUNCH
  static int grid_blocks = 0;
  if (!grid_blocks) {
    (void)hipFuncSetAttribute((const void*)mega, hipFuncAttributeMaxDynamicSharedMemorySize, LDS_BYTES);
    int dev = 0, cus = 0, per_cu = 0;
    (void)hipGetDevice(&dev);
    (void)hipDeviceGetAttribute(&cus, hipDeviceAttributeMultiprocessorCount, dev);
    (void)hipOccupancyMaxActiveBlocksPerMultiprocessor(&per_cu, mega, NTHREADS, LDS_BYTES);
    if (per_cu > 1) per_cu = 1;
    grid_blocks = cus * per_cu;
    if (grid_blocks <= 0) grid_blocks = 256;
  }
  grid = grid_blocks;
  (void)hipMemsetAsync(p.bar, 0, (size_t)XCD_BAR_WORDS * 4, stream);
  void* args[] = {&p};
  hipError_t e = hipLaunchCooperativeKernel((const void*)mega, dim3(grid), dim3(NTHREADS), args, LDS_BYTES, stream);
  if (e != hipSuccess) fprintf(stderr, "cooperative launch failed: %s\n", hipGetErrorString(e));
#else
  launch_phases<0>(p, grid, stream);
#if DBG_NPH
  float* scr = (float*)(w + off);
  dbg_zero<<<grid, NTHREADS, 0, stream>>>(scr);
  dbg_sums<<<grid, NTHREADS, 0, stream>>>(p, scr, DBG_NPH);
  dbg_out<<<grid, NTHREADS, 0, stream>>>(p, scr);
#endif
#endif
}
```

```cpp
#include <hip/hip_runtime.h>
#include <hip/hip_cooperative_groups.h>
#include <cstdio>
#include <cstdint>
namespace cg = cooperative_groups;

#ifndef MK_ONE_LAUNCH
#define MK_ONE_LAUNCH 1
#endif

typedef unsigned short bf16_t;
typedef short bf16x8 __attribute__((ext_vector_type(8)));
typedef short bf16x2v __attribute__((ext_vector_type(2)));
typedef float f32x4 __attribute__((ext_vector_type(4)));
typedef unsigned u32x4 __attribute__((ext_vector_type(4)));
typedef unsigned u32x2 __attribute__((ext_vector_type(2)));
typedef unsigned u32x6 __attribute__((ext_vector_type(6)));
typedef unsigned u32x16 __attribute__((ext_vector_type(16)));
typedef float f32x32 __attribute__((ext_vector_type(32)));
typedef __bf16 bf16x32n __attribute__((ext_vector_type(32)));

constexpr int D = 1024, BATCH = 32, SEQ = 2048, CTXL = 256;
constexpr int NCTX = BATCH * CTXL;
constexpr int NLAT = BATCH * SEQ;
constexpr int NTOK = NCTX + NLAT;
constexpr int MODW = 6 * D;
constexpr int NEXP = 16384;
constexpr float EPS = 1e-6f;
constexpr int NTHREADS = 512;
constexpr int LDS_BYTES = 140 * 1024;

struct Params {
  const float *x, *c, *ctx, *c_ctx, *ada_w, *ada_b, *mix_g, *ffn_g, *ev_w_in, *ev_w_out, *logit_f, *logit_b, *conv_w,
      *od_w_in, *od_w_out, *sinks, *peer_wq, *keys1, *keys2, *peer_u, *peer_v, *final_g;
  float* out;
  float* mod;
  float* ropec;
  float* ropes;
  bf16_t* winT0;
  bf16_t* woutT0;
  bf16_t* winT1;
  bf16_t* woutT1;
  bf16_t* wqT;
  unsigned char* u8;
  unsigned char* v8;
  float* uscale;
  float* vscale;
  float* hctx;
  bf16_t* act;
  bf16_t* proj;
  bf16_t* pq;
  u32x2* sel;
  float* kv;
  bf16_t* sprev;
  bf16_t* keysb;
  unsigned* bar;
};

typedef __bf16 bf16x2n __attribute__((ext_vector_type(2)));
typedef float f32x2 __attribute__((ext_vector_type(2)));
__device__ __forceinline__ unsigned cvt_pk_bf16(float lo, float hi) {
  f32x2 v = {lo, hi};
  return __builtin_bit_cast(unsigned, __builtin_convertvector(v, bf16x2n));
}
__device__ __forceinline__ float bf_lo(unsigned u) { return __uint_as_float(u << 16); }
__device__ __forceinline__ float bf_hi(unsigned u) { return __uint_as_float(u & 0xffff0000u); }
__device__ __forceinline__ float bf2f(bf16_t h) { return __uint_as_float(((unsigned)h) << 16); }
__device__ __forceinline__ bf16_t f2bf(float f) { return __builtin_bit_cast(unsigned short, (__bf16)f); }

template <int CTRL>
__device__ __forceinline__ float dppf(float x) {
  return __builtin_bit_cast(float, __builtin_amdgcn_mov_dpp(__builtin_bit_cast(int, x), CTRL, 0xf, 0xf, true));
}
template <int CTRL>
__device__ __forceinline__ unsigned dppu(unsigned x) { return (unsigned)__builtin_amdgcn_mov_dpp((int)x, CTRL, 0xf, 0xf, true); }
__device__ __forceinline__ float row16_sum(float x) {
  x += dppf<0xB1>(x); x += dppf<0x4E>(x); x += dppf<0x141>(x); x += dppf<0x128>(x);
  return x;
}
__device__ __forceinline__ float row16_max(float x) {
  x = fmaxf(x, dppf<0xB1>(x)); x = fmaxf(x, dppf<0x4E>(x)); x = fmaxf(x, dppf<0x141>(x)); x = fmaxf(x, dppf<0x128>(x));
  return x;
}
__device__ __forceinline__ float xrow16_sum(float x) {
  auto s = __builtin_amdgcn_permlane16_swap(__float_as_uint(x), __float_as_uint(x), false, false);
  x = __uint_as_float(s[0]) + __uint_as_float(s[1]);
  auto t = __builtin_amdgcn_permlane32_swap(__float_as_uint(x), __float_as_uint(x), false, false);
  return __uint_as_float(t[0]) + __uint_as_float(t[1]);
}
__device__ __forceinline__ float wave_sum(float x) { return xrow16_sum(row16_sum(x)); }
__device__ __forceinline__ float wave_max(float x) {
  x = row16_max(x);
  auto s = __builtin_amdgcn_permlane16_swap(__float_as_uint(x), __float_as_uint(x), false, false);
  x = fmaxf(__uint_as_float(s[0]), __uint_as_float(s[1]));
  auto t = __builtin_amdgcn_permlane32_swap(__float_as_uint(x), __float_as_uint(x), false, false);
  return fmaxf(__uint_as_float(t[0]), __uint_as_float(t[1]));
}

__device__ __forceinline__ int tidx() {
  int t = threadIdx.x;
  asm volatile("" : "+v"(t));
  __builtin_assume(t >= 0 && t < NTHREADS);
  return t;
}
__device__ __forceinline__ float siluf(float v) { return v / (1.f + __expf(-v)); }
__device__ __forceinline__ float log_sigmoidf(float v) { return -log1pf(expf(-v)); }

#define LAS __attribute__((address_space(3)))
constexpr int BM = 256, BK = 64, HALF = 128, HTB = HALF * BK * 2, NXCD = 8, WGM = 8;
constexpr int KDIM = 1024;

__device__ __forceinline__ int lds_byte(int r, int c) {
  const int st = (r >> 4) * 2 + (c >> 5), rr = r & 15, cc = c & 31, ob = rr * 64 + cc * 2;
  return st * 1024 + (ob ^ (((ob >> 9) & 1) << 5));
}
__device__ __forceinline__ void stage_rc(int b, int& R, int& C) {
  const int st = b / 1024, sb = b % 1024, swz = sb ^ (((sb >> 9) & 1) << 5);
  R = (st >> 1) * 16 + swz / 64;
  C = (st & 1) * 32 + (swz % 64) / 2;
}
__device__ __forceinline__ int perm32(int rho) { const int n = rho >> 4, i = rho & 15; return 8 * (i >> 2) + 4 * n + (i & 3); }
struct Sched {
  int pm0, pn0, nM, nN, G, c;
  __device__ __forceinline__ bool next(int i, int& pm, int& pn) const {
    const int nwg = nM * nN;
    const long L = (long)i * G + c;
    if (L >= nwg) return false;
    int wgid = (int)L;
    { const int q = nwg / NXCD, r = nwg % NXCD, xcd = wgid % NXCD, off = wgid / NXCD; wgid = (xcd < r ? xcd * (q + 1) : r * (q + 1) + (xcd - r) * q) + off; }
    const int nig = WGM * nN, gid = wgid / nig, fm = gid * WGM, gsz = (nM - fm) < WGM ? (nM - fm) : WGM;
    pm = pm0 + fm + ((wgid % nig) % gsz);
    pn = pn0 + (wgid % nig) / gsz;
    return true;
  }
};

template <class Epi>
__device__ __forceinline__ void gemm_phase(LAS unsigned char* lds, const bf16_t* __restrict__ Ag, const bf16_t* __restrict__ Btg, const Sched& S, const Epi& E) {
  const int tid = tidx(), wid = __builtin_amdgcn_readfirstlane(tid >> 6), lane = tid & 63, wr = wid >> 2, wc = wid & 3, fr = lane & 15, fq = lane >> 4;
  constexpr int K = KDIM, nt = K / BK;
  unsigned voffA[2], voffB[2];
#pragma unroll
  for (int i = 0; i < 2; ++i) { int R, C; stage_rc(tid * 16 + i * 8192, R, C); const int Rb = Epi::PERM ? ((R & ~31) + perm32(R & 31)) : R;
    voffA[i] = (unsigned)(R * K + C) * 2u; voffB[i] = (unsigned)(Rb * K + C) * 2u; }
  const size_t kstep = (size_t)(BK * 2);
  const size_t hstep = (size_t)HALF * K * 2;
  const size_t tstep = 2 * hstep;
  const unsigned ldsw = (unsigned)wid * 1024u;
  const int aoff = lds_byte(wr * 64 + fr, fq * 8), boff = lds_byte(wc * 32 + fr, fq * 8);
#define G_SA(b, h) (((b) * 2 + (h)) * HTB)
#define G_SB(b, h) ((4 + (b) * 2 + (h)) * HTB)
#define G_STAGEX(bufoff, gbase, VO) do { _Pragma("unroll") for (int _i = 0; _i < 2; ++_i) \
    __builtin_amdgcn_global_load_lds((const unsigned*)((const char*)(gbase) + VO[_i]), (LAS unsigned*)(lds + (bufoff) + ldsw + _i * 8192), 16, 0, 0); } while (0)
#define G_STAGE(bufoff, gbase) G_STAGEX(bufoff, gbase, voffA)
#define G_STAGEB(bufoff, gbase) G_STAGEX(bufoff, gbase, voffB)
#define G_LDA(dst, b, h) do { _Pragma("unroll") for (int m = 0; m < 4; ++m) _Pragma("unroll") for (int k = 0; k < 2; ++k) dst[m][k] = *(const LAS bf16x8*)(lds + G_SA(b, h) + aoff + m * 2048 + k * 1024); } while (0)
#define G_LDB(dst, b, h) do { _Pragma("unroll") for (int n = 0; n < 2; ++n) _Pragma("unroll") for (int k = 0; k < 2; ++k) dst[n][k] = *(const LAS bf16x8*)(lds + G_SB(b, h) + boff + n * 2048 + k * 1024); } while (0)
#define G_MMA(ai, bj, At, Bt) do { __builtin_amdgcn_s_setprio(1); _Pragma("unroll") for (int m = 0; m < 4; ++m) _Pragma("unroll") for (int n = 0; n < 2; ++n) _Pragma("unroll") for (int k = 0; k < 2; ++k) \
    acc[ai][bj][m][n] = __builtin_amdgcn_mfma_f32_16x16x32_bf16(Bt[n][k], At[m][k], acc[ai][bj][m][n], 0, 0, 0); __builtin_amdgcn_s_setprio(0); } while (0)
#define G_WAIT_V(n) asm volatile("s_waitcnt vmcnt(" #n ")" ::: "memory")
#define G_WAIT_L(n) asm volatile("s_waitcnt lgkmcnt(" #n ")" ::: "memory")
#define G_BAR __builtin_amdgcn_s_barrier()
#define G_SCHED __builtin_amdgcn_sched_barrier(0)
  int cpm, cpn, npm, npn, ui = 0;
  if (!S.next(0, cpm, cpn)) return;
  f32x4 acc[2][2][4][2];
#pragma unroll
  for (int a = 0; a < 2; ++a)
#pragma unroll
    for (int b = 0; b < 2; ++b)
#pragma unroll
      for (int m = 0; m < 4; ++m)
#pragma unroll
        for (int n = 0; n < 2; ++n) acc[a][b][m][n] = (f32x4){0.f, 0.f, 0.f, 0.f};
  bf16x8 At[4][2], B0[2][2], B1[2][2];
  const char* cA = (const char*)Ag + (size_t)cpm * tstep;
  const char* cB = (const char*)Btg + (size_t)cpn * tstep;
  G_STAGEB(G_SB(0, 0), cB); G_STAGE(G_SA(0, 0), cA); G_STAGEB(G_SB(0, 1), cB + hstep); G_STAGE(G_SA(0, 1), cA + hstep);
  if (wr == 1) G_BAR;
  G_WAIT_V(4); G_BAR;
  G_STAGEB(G_SB(1, 0), cB + kstep); G_STAGE(G_SA(1, 0), cA + kstep); G_STAGEB(G_SB(1, 1), cB + hstep + kstep);
  G_WAIT_V(6); G_BAR;
  for (;;) {
    const bool has_next = S.next(ui + 1, npm, npn);
    const char* nA = has_next ? (const char*)Ag + (size_t)npm * tstep : cA;
    const char* nB = has_next ? (const char*)Btg + (size_t)npn * tstep : cB;
    for (int t = 0; t < nt; t += 2) {
      const bool last = (t == nt - 2);
      const char* a1 = cA + (size_t)(t + 1) * kstep;
      const char* a2 = last ? nA : cA + (size_t)(t + 2) * kstep;
      const char* b2 = last ? nB : cB + (size_t)(t + 2) * kstep;
      const char* a3 = a2 + kstep;
      const char* b3 = b2 + kstep;
      G_LDB(B0, 0, 0); G_SCHED; G_LDA(At, 0, 0); G_STAGE(G_SA(1, 1), a1 + hstep);
      G_WAIT_L(8); G_BAR; G_WAIT_L(0); G_MMA(0, 0, At, B0); G_BAR; G_SCHED;
      G_LDB(B1, 0, 1); G_STAGEB(G_SB(0, 0), b2);
      G_BAR; G_WAIT_L(0); G_MMA(0, 1, At, B1); G_BAR;
      G_LDA(At, 0, 1); G_STAGE(G_SA(0, 0), a2);
      G_BAR; G_WAIT_L(0); G_MMA(1, 0, At, B0); G_BAR; G_SCHED;
      G_STAGEB(G_SB(0, 1), b2 + hstep);
      G_WAIT_V(6); G_BAR; G_MMA(1, 1, At, B1); G_BAR;
      G_LDB(B0, 1, 0); G_SCHED; G_LDA(At, 1, 0); G_STAGE(G_SA(0, 1), a2 + hstep);
      G_WAIT_L(8); G_BAR; G_WAIT_L(0); G_MMA(0, 0, At, B0); G_BAR; G_SCHED;
      G_LDB(B1, 1, 1); G_STAGEB(G_SB(1, 0), b3);
      G_BAR; G_WAIT_L(0); G_MMA(0, 1, At, B1); G_BAR;
      G_LDA(At, 1, 1); G_STAGE(G_SA(1, 0), a3);
      G_BAR; G_WAIT_L(0); G_MMA(1, 0, At, B0); G_BAR; G_SCHED;
      G_STAGEB(G_SB(1, 1), b3 + hstep);
      G_WAIT_V(6); G_BAR; G_MMA(1, 1, At, B1); G_BAR;
    }
    E(acc, cpm * BM, cpn * BM, wr, wc, fr, fq);
    if (!has_next) break;
#pragma unroll
    for (int a = 0; a < 2; ++a)
#pragma unroll
      for (int b = 0; b < 2; ++b)
#pragma unroll
        for (int m = 0; m < 4; ++m)
#pragma unroll
          for (int n = 0; n < 2; ++n) acc[a][b][m][n] = (f32x4){0.f, 0.f, 0.f, 0.f};
    cpm = npm; cpn = npn; cA = nA; cB = nB; ++ui;
  }
  G_WAIT_V(0);
  if (wr == 0) G_BAR;
  G_BAR;
#undef G_SA
#undef G_SB
#undef G_STAGE
#undef G_STAGEB
#undef G_STAGEX
#undef G_LDA
#undef G_LDB
#undef G_MMA
}

__device__ __forceinline__ f32x4 xlane32(const f32x4 v, const bool upper) {
  f32x4 r;
#pragma unroll
  for (int j = 0; j < 4; ++j) {
    const float x = v[j];
    auto t = __builtin_amdgcn_permlane32_swap(__float_as_uint(x), __float_as_uint(x), false, false);
    r[j] = __uint_as_float(upper ? t[0] : t[1]);
  }
  return r;
}
struct EpiInProj {
  static constexpr bool PERM = true;
  bf16_t* P; int ldc; int layer; const float* cosT; const float* sinT;
  __device__ __forceinline__ void operator()(const f32x4 (&acc)[2][2][4][2], int brow, int bcol, int wr, int wc, int fr, int fq) const {
#pragma unroll
    for (int bj = 0; bj < 2; ++bj) {
      const int colbase = bcol + bj * HALF + wc * 32;
      bool rope, scl;
      if (layer == 0) { rope = colbase < 512; scl = (colbase >= 256 && colbase < 512); }
      else { rope = colbase < 1280; scl = colbase < 1024; }
      const float sq = layer == 1 ? 0.125f * 1.44269504089f : 0.125f;
#pragma unroll
      for (int ai = 0; ai < 2; ++ai)
#pragma unroll
        for (int m = 0; m < 4; ++m) {
          const int row = brow + ai * HALF + wr * 64 + m * 16 + fr;
          f32x4 v0 = acc[ai][bj][m][0], v1 = acc[ai][bj][m][1];
          if (rope && brow >= NCTX) {
            const bool upper = fq >= 2;
            const f32x4 o0 = xlane32(v0, upper), o1 = xlane32(v1, upper);
            const int t = (row - NCTX) & (SEQ - 1);
            const int pos = (wc & 1) ? (t & 63) : (t >> 6);
            const float* ct = cosT + pos * 16 + (fq & 1) * 8;
            const float* st = sinT + pos * 16 + (fq & 1) * 8;
            const f32x4 c0 = *(const f32x4*)ct, c1 = *(const f32x4*)(ct + 4);
            f32x4 s0 = *(const f32x4*)st, s1 = *(const f32x4*)(st + 4);
            if (!upper) { s0 = -s0; s1 = -s1; }
            v0 = v0 * c0 + o0 * s0;
            v1 = v1 * c1 + o1 * s1;
          }
          if (scl) { v0 *= sq; v1 *= sq; }
          u32x4 w;
          w.x = cvt_pk_bf16(v0[0], v0[1]); w.y = cvt_pk_bf16(v0[2], v0[3]);
          w.z = cvt_pk_bf16(v1[0], v1[1]); w.w = cvt_pk_bf16(v1[2], v1[3]);
          *(u32x4*)(P + (size_t)row * ldc + colbase + fq * 8) = w;
        }
    }
  }
};
struct EpiBf16 {
  static constexpr bool PERM = true;
  bf16_t* P; int ldc;
  __device__ __forceinline__ void operator()(const f32x4 (&acc)[2][2][4][2], int brow, int bcol, int wr, int wc, int fr, int fq) const {
#pragma unroll
    for (int ai = 0; ai < 2; ++ai)
#pragma unroll
      for (int m = 0; m < 4; ++m) {
        const int row = brow + ai * HALF + wr * 64 + m * 16 + fr;
#pragma unroll
        for (int bj = 0; bj < 2; ++bj) {
          const f32x4 v0 = acc[ai][bj][m][0], v1 = acc[ai][bj][m][1];
          u32x4 w;
          w.x = cvt_pk_bf16(v0[0], v0[1]); w.y = cvt_pk_bf16(v0[2], v0[3]);
          w.z = cvt_pk_bf16(v1[0], v1[1]); w.w = cvt_pk_bf16(v1[2], v1[3]);
          *(u32x4*)(P + (size_t)row * ldc + bcol + bj * HALF + wc * 32 + fq * 8) = w;
        }
      }
  }
};
struct EpiGate {
  static constexpr bool PERM = true;
  bf16_t* M; const float* gate;
  __device__ __forceinline__ void operator()(const f32x4 (&acc)[2][2][4][2], int brow, int bcol, int wr, int wc, int fr, int fq) const {
    const int b = brow < NCTX ? 32 : ((brow - NCTX) >> 11);
    const float* g = gate + (size_t)b * MODW;
#pragma unroll
    for (int bj = 0; bj < 2; ++bj) {
      const int col = bcol + bj * HALF + wc * 32 + fq * 8;
      const f32x4 g0 = *(const f32x4*)(g + col), g1 = *(const f32x4*)(g + col + 4);
#pragma unroll
      for (int ai = 0; ai < 2; ++ai)
#pragma unroll
        for (int m = 0; m < 4; ++m) {
          const int row = brow + ai * HALF + wr * 64 + m * 16 + fr;
          const f32x4 v0 = acc[ai][bj][m][0] * g0, v1 = acc[ai][bj][m][1] * g1;
          u32x4 w;
          w.x = cvt_pk_bf16(v0[0], v0[1]); w.y = cvt_pk_bf16(v0[2], v0[3]);
          w.z = cvt_pk_bf16(v1[0], v1[1]); w.w = cvt_pk_bf16(v1[2], v1[3]);
          *(u32x4*)(M + (size_t)row * D + col) = w;
        }
    }
  }
};
struct EpiResid {
  static constexpr bool PERM = false;
  const float* hin_ctx; const float* hin_lat; float* hout_ctx; float* hout_lat; const float* gate;
  __device__ __forceinline__ void operator()(const f32x4 (&acc)[2][2][4][2], int brow, int bcol, int wr, int wc, int fr, int fq) const {
    const bool isctx = brow < NCTX;
    const int b = isctx ? 32 : ((brow - NCTX) >> 11);
    const float* hin = isctx ? hin_ctx + (size_t)brow * D : hin_lat + (size_t)(brow - NCTX) * D;
    float* hout = isctx ? hout_ctx + (size_t)brow * D : hout_lat + (size_t)(brow - NCTX) * D;
    const float* g = gate + (size_t)b * MODW;
#pragma unroll
    for (int bj = 0; bj < 2; ++bj)
#pragma unroll
      for (int n = 0; n < 2; ++n) {
        const int col = bcol + bj * HALF + wc * 32 + n * 16 + fq * 4;
        const f32x4 gv = *(const f32x4*)(g + col);
#pragma unroll
        for (int ai = 0; ai < 2; ++ai)
#pragma unroll
          for (int m = 0; m < 4; ++m) {
            const int r = ai * HALF + wr * 64 + m * 16 + fr;
            const f32x4 h = *(const f32x4*)(hin + (size_t)r * D + col);
            *(f32x4*)(hout + (size_t)r * D + col) = h + gv * acc[ai][bj][m][n];
          }
      }
  }
};

template <int MT, int NT>
__device__ __forceinline__ void mm_lds(const bf16_t* A, int lda, const bf16_t* B, int ldb, int K, f32x4 (&acc)[MT][NT], int fr, int fq) {
  for (int k0 = 0; k0 < K; k0 += 32) {
    bf16x8 af[MT], bf[NT];
#pragma unroll
    for (int m = 0; m < MT; ++m) af[m] = *(const bf16x8*)(A + (m * 16 + fr) * lda + k0 + fq * 8);
#pragma unroll
    for (int n = 0; n < NT; ++n) bf[n] = *(const bf16x8*)(B + (n * 16 + fr) * ldb + k0 + fq * 8);
#pragma unroll
    for (int m = 0; m < MT; ++m)
#pragma unroll
      for (int n = 0; n < NT; ++n) acc[m][n] = __builtin_amdgcn_mfma_f32_16x16x32_bf16(af[m], bf[n], acc[m][n], 0, 0, 0);
  }
}

__device__ void phase_prep(const Params& p, unsigned char* smem, int bid, int nb) {
  const int tid = tidx();
  for (int it = bid; it < 2 * 96; it += nb) {
    const int layer = it / 96, n0 = (it % 96) * 64;
    float* s = (float*)smem;
    for (int i = tid; i < 33 * 1024; i += NTHREADS) {
      const int b = i >> 10, k = i & 1023;
      const float v = (b < 32) ? p.c[b * 1024 + k] : p.c_ctx[k];
      s[k * 33 + b] = siluf(v);
    }
    __syncthreads();
    const int col = tid & 63, kg = tid >> 6;
    float acc[33];
#pragma unroll
    for (int b = 0; b < 33; ++b) acc[b] = 0.f;
    const float* W = p.ada_w + (size_t)layer * 1024 * MODW + n0 + col;
    for (int k = kg * 128; k < kg * 128 + 128; ++k) {
      const float w = W[(size_t)k * MODW];
      const float* sk = s + k * 33;
#pragma unroll
      for (int b = 0; b < 33; ++b) acc[b] += sk[b] * w;
    }
    __syncthreads();
    float* red = (float*)smem;
#pragma unroll
    for (int b = 0; b < 33; ++b) red[(kg * 33 + b) * 64 + col] = acc[b];
    __syncthreads();
    for (int i = tid; i < 33 * 64; i += NTHREADS) {
      const int b = i >> 6, cc = i & 63;
      float t = p.ada_b[layer * MODW + n0 + cc];
#pragma unroll
      for (int g = 0; g < 8; ++g) t += red[(g * 33 + b) * 64 + cc];
      p.mod[((size_t)layer * 33 + b) * MODW + n0 + cc] = t;
    }
    __syncthreads();
  }
  if (bid == nb - 1) {
    for (int i = tid; i < 1024; i += NTHREADS) {
      const int pos = i >> 4, f = i & 15;
      const float inv = powf(10000.f, -(float)f / 16.f);
      const float ang = (float)pos * inv;
      p.ropec[i] = cosf(ang);
      p.ropes[i] = sinf(ang);
    }
  }
  {
    float* tile = (float*)smem;
    const int ntile_total = 768 + 256 + 384 + 256 + 512;
    for (int it = bid; it < ntile_total; it += nb) {
      const float* src; bf16_t* dst; int N, ti;
      if (it < 768) { src = p.ev_w_in; dst = p.winT0; N = 3072; ti = it; }
      else if (it < 1024) { src = p.ev_w_out; dst = p.woutT0; N = 1024; ti = it - 768; }
      else if (it < 1408) { src = p.od_w_in; dst = p.winT1; N = 1536; ti = it - 1024; }
      else if (it < 1664) { src = p.od_w_out; dst = p.woutT1; N = 1024; ti = it - 1408; }
      else { const int l = (it - 1664) / 256; src = p.peer_wq + (size_t)l * 1024 * 1024; dst = p.wqT + (size_t)l * 1024 * 1024; N = 1024; ti = (it - 1664) % 256; }
      const int ntn = N / 64, tk = ti / ntn, tn = ti % ntn;
      __syncthreads();
      for (int i = tid; i < 64 * 64; i += NTHREADS) {
        const int r = i >> 6, cc = i & 63;
        tile[r * 65 + cc] = src[(size_t)(tk * 64 + r) * N + tn * 64 + cc];
      }
      __syncthreads();
      for (int i = tid; i < 64 * 32; i += NTHREADS) {
        const int nn = i >> 5, kk = (i & 31) * 2;
        const unsigned w = cvt_pk_bf16(tile[kk * 65 + nn], tile[(kk + 1) * 65 + nn]);
        *(unsigned*)(dst + (size_t)(tn * 64 + nn) * 1024 + tk * 64 + kk) = w;
      }
    }
    __syncthreads();
  }
  for (int idx = bid * NTHREADS + tid; idx < 2 * 8 * 2 * 128 * 64; idx += nb * NTHREADS) {
    const int d = idx & 63, k = (idx >> 6) & 127, s = (idx >> 13) & 1, hh = (idx >> 14) & 7, l = idx >> 17;
    const float v = (s ? p.keys2 : p.keys1)[((size_t)(l * 8 + hh) * 128 + k) * 64 + d];
    const bf16_t hi = f2bf(v);
    const bf16_t lo = f2bf(v - bf2f(hi));
    const size_t o = ((size_t)((l * 8 + hh) * 2 + s) * 2) * 8192 + (size_t)k * 64 + d;
    p.keysb[o] = hi;
    p.keysb[o + 8192] = lo;
  }
  {
    const int wid = tid >> 6, lane = tid & 63, hw = lane >> 5, L = lane & 31, bb = L >> 3, ii = L & 7;
    for (int r = (bid * 8 + wid) * 2 + hw; r < 4 * NEXP; r += nb * 16) {
      const bool isv = r >= 2 * NEXP;
      const int rr = isv ? r - 2 * NEXP : r;
      const float* src = (isv ? p.peer_v : p.peer_u) + (size_t)rr * D + bb * 256 + ii * 32;
      f32x4 a[8];
      float mx = 0.f;
#pragma unroll
      for (int q = 0; q < 8; ++q) {
        a[q] = *(const f32x4*)(src + q * 4);
        mx = fmaxf(mx, fmaxf(fmaxf(fabsf(a[q][0]), fabsf(a[q][1])), fmaxf(fabsf(a[q][2]), fabsf(a[q][3]))));
      }
      mx = row16_max(mx);
      { auto sw = __builtin_amdgcn_permlane16_swap(__float_as_uint(mx), __float_as_uint(mx), false, false); mx = fmaxf(__uint_as_float(sw[0]), __uint_as_float(sw[1])); }
      const float sc = mx > 0.f ? 7.0f / mx : 1.f;
      u32x16 pk;
#pragma unroll
      for (int q = 0; q < 8; ++q) { pk[2 * q] = cvt_pk_bf16(a[q][0] * sc, a[q][1] * sc); pk[2 * q + 1] = cvt_pk_bf16(a[q][2] * sc, a[q][3] * sc); }
      const u32x6 w = __builtin_amdgcn_cvt_scalef32_pk32_fp6_bf16(__builtin_bit_cast(bf16x32n, pk), 1.0f);
      unsigned char* dst = (isv ? p.v8 : p.u8) + (size_t)rr * 768 + ii * 16;
#pragma unroll
      for (int m = 0; m < 6; ++m) {
        const int sidx = 6 * bb + m;
        const unsigned wm = w[m];
        *(unsigned*)(dst + (sidx >> 2) * 128 + (sidx & 3) * 4) = wm;
      }
      if (L == 0) (isv ? p.vscale : p.uscale)[rr] = mx > 0.f ? mx / 7.0f : 1.f;
    }
  }
}

__device__ void phase_resid_norm(const Params& p, int bid, int nb, int row0, int row1, const float* hin_ctx, const float* hin_lat,
                                 const float* gain, const float* modl) {
  const int tid0 = tidx();
  const int wid = tid0 >> 6, lane = tid0 & 63;
  for (int rowa = row0 + (bid * 8 + wid) * 2; rowa < row1; rowa += nb * 16) {
    f32x4 v[2][4];
    float ss[2] = {0.f, 0.f};
#pragma unroll
    for (int r = 0; r < 2; ++r) {
      const int row = rowa + r;
      const bool isctx = row < NCTX;
      const float* h = isctx ? hin_ctx + (size_t)row * D : hin_lat + (size_t)(row - NCTX) * D;
      const bf16_t* mrow = p.pq + (size_t)row * D;
#pragma unroll
      for (int i = 0; i < 4; ++i) {
        const f32x4 hv = *(const f32x4*)(h + i * 256 + lane * 4);
        const u32x2 mv = *(const u32x2*)(mrow + i * 256 + lane * 4);
        v[r][i][0] = hv[0] + bf_lo(mv.x); v[r][i][1] = hv[1] + bf_hi(mv.x); v[r][i][2] = hv[2] + bf_lo(mv.y); v[r][i][3] = hv[3] + bf_hi(mv.y);
      }
    }
#pragma unroll
    for (int r = 0; r < 2; ++r) {
      const int row = rowa + r;
      const bool isctx = row < NCTX;
      float* ho = isctx ? p.hctx + (size_t)row * D : p.out + (size_t)(row - NCTX) * D;
      const int b = isctx ? 32 : ((row - NCTX) >> 11);
      const float* sh = modl + (size_t)b * MODW + 3 * D;
      const float* sc = modl + (size_t)b * MODW + 4 * D;
#pragma unroll
      for (int i = 0; i < 4; ++i) {
        *(f32x4*)(ho + i * 256 + lane * 4) = v[r][i];
        ss[r] += v[r][i][0] * v[r][i][0] + v[r][i][1] * v[r][i][1] + v[r][i][2] * v[r][i][2] + v[r][i][3] * v[r][i][3];
      }
      const float rstd = rsqrtf(wave_sum(ss[r]) * (1.f / D) + EPS);
#pragma unroll
      for (int i = 0; i < 4; ++i) {
        const int col = i * 256 + lane * 4;
        const f32x4 g = *(const f32x4*)(gain + col), s1 = *(const f32x4*)(sc + col), s0 = *(const f32x4*)(sh + col);
        f32x4 y = v[r][i] * rstd * g;
        y = y * (1.f + s1) + s0;
        u32x2 w; w.x = cvt_pk_bf16(y[0], y[1]); w.y = cvt_pk_bf16(y[2], y[3]);
        *(u32x2*)(p.act + (size_t)row * D + col) = w;
      }
    }
  }
}
__device__ void phase_norm(const Params& p, int bid, int nb, int row0, int row1, const float* hctx, const float* hlat,
                           const float* gain, const float* modl, int ish, int isc) {
  const int tid0 = tidx();
  const int wid = tid0 >> 6, lane = tid0 & 63;
  for (int rowa = row0 + (bid * 8 + wid) * 2; rowa < row1; rowa += nb * 16) {
    f32x4 v[2][4];
#pragma unroll
    for (int r = 0; r < 2; ++r) {
      const int row = rowa + r;
      const float* h = row < NCTX ? hctx + (size_t)row * D : hlat + (size_t)(row - NCTX) * D;
#pragma unroll
      for (int i = 0; i < 4; ++i) v[r][i] = *(const f32x4*)(h + i * 256 + lane * 4);
    }
#pragma unroll
    for (int r = 0; r < 2; ++r) {
      const int row = rowa + r;
      const int b = row < NCTX ? 32 : ((row - NCTX) >> 11);
      const float* sh = modl + (size_t)b * MODW + ish * D;
      const float* sc = modl + (size_t)b * MODW + isc * D;
      float ss = 0.f;
#pragma unroll
      for (int i = 0; i < 4; ++i) ss += v[r][i][0] * v[r][i][0] + v[r][i][1] * v[r][i][1] + v[r][i][2] * v[r][i][2] + v[r][i][3] * v[r][i][3];
      const float rstd = rsqrtf(wave_sum(ss) * (1.f / D) + EPS);
#pragma unroll
      for (int i = 0; i < 4; ++i) {
        const int col = i * 256 + lane * 4;
        const f32x4 g = *(const f32x4*)(gain + col), s1 = *(const f32x4*)(sc + col), s0 = *(const f32x4*)(sh + col);
        f32x4 y = v[r][i] * rstd * g;
        y = y * (1.f + s1) + s0;
        u32x2 w; w.x = cvt_pk_bf16(y[0], y[1]); w.y = cvt_pk_bf16(y[2], y[3]);
        *(u32x2*)(p.act + (size_t)row * D + col) = w;
      }
    }
  }
}

__device__ __forceinline__ void phase_gemm_inproj(const Params& p, unsigned char* smem, int bid, int nb, int layer) {
  LAS unsigned char* lds = (LAS unsigned char*)smem;
  if (layer == 0) {
    EpiInProj epi{p.proj, 3072, 0, p.ropec, p.ropes};
    Sched s{0, 0, NTOK / BM, 12, nb, bid};
    gemm_phase(lds, p.act, p.winT0, s, epi);
  } else {
    EpiInProj epi{p.proj, 1536, 1, p.ropec, p.ropes};
    Sched s{NCTX / BM, 0, NLAT / BM, 6, nb, bid};
    gemm_phase(lds, p.act, p.winT1, s, epi);
    Sched s2{0, 4, NCTX / BM, 2, nb, bid};
    gemm_phase(lds, p.act, p.winT1, s2, epi);
  }
}
__device__ __forceinline__ void phase_gemm_outproj(const Params& p, unsigned char* smem, int bid, int nb, int layer) {
  LAS unsigned char* lds = (LAS unsigned char*)smem;
  EpiGate epi{p.pq, p.mod + (size_t)layer * 33 * MODW + 2 * D};
  const int pm0 = layer == 0 ? 0 : NCTX / BM;
  Sched s{pm0, 0, NTOK / BM - pm0, 4, nb, bid};
  gemm_phase(lds, p.act, layer == 0 ? p.woutT0 : p.woutT1, s, epi);
}
__device__ __forceinline__ void phase_gemm_pq(const Params& p, unsigned char* smem, int bid, int nb, int layer) {
  LAS unsigned char* lds = (LAS unsigned char*)smem;
  EpiBf16 epi{p.pq, D};
  const int pm0 = layer == 0 ? 0 : NCTX / BM;
  Sched s{pm0, 0, NTOK / BM - pm0, 4, nb, bid};
  gemm_phase(lds, p.act, p.wqT + (size_t)layer * D * D, s, epi);
}

__device__ __forceinline__ int chunk_row0(int b, int cc) { return cc < 2 ? b * CTXL + cc * 128 : NCTX + b * SEQ + (cc - 2) * 128; }

constexpr int LDP = 136;
constexpr int LDK = 72;

typedef short s16x4 __attribute__((ext_vector_type(4)));
__device__ __forceinline__ bf16x8 tr_frag(const LAS bf16_t* base, int ld, int lane) {
  const int troff = ((lane & 15) >> 2) * ld + (lane & 3) * 4;
  const s16x4 v0 = __builtin_amdgcn_ds_read_tr16_b64_v4i16((LAS s16x4*)(base + troff));
  const s16x4 v1 = __builtin_amdgcn_ds_read_tr16_b64_v4i16((LAS s16x4*)(base + 16 * ld + troff));
  bf16x8 f;
  f[0] = v0[0]; f[1] = v0[1]; f[2] = v0[2]; f[3] = v0[3]; f[4] = v1[0]; f[5] = v1[1]; f[6] = v1[2]; f[7] = v1[3];
  return f;
}
__device__ void phase_ret_kv(const Params& p, unsigned char* smem, int bid, int nb) {
  const int tid = tidx(), wid = __builtin_amdgcn_readfirstlane(tid >> 6), lane = tid & 63, fr = lane & 15, fq = lane >> 4;
  LAS bf16_t* Kl = (LAS bf16_t*)smem;
  LAS bf16_t* Vl = Kl + 128 * LDK;
  for (int it = bid; it < BATCH * 4 * 18; it += nb) {
    const int cc = it % 18, h = (it / 18) & 3, b = it / 72;
    const int row0 = chunk_row0(b, cc);
    const float lf = log_sigmoidf(p.logit_f[h]), lb = log_sigmoidf(p.logit_b[h]);
    __syncthreads();
    for (int task = tid; task < 128 * 8; task += NTHREADS) {
      const int j = task >> 3, d0 = (task & 7) * 8;
      *(LAS u32x4*)(Kl + j * LDK + d0) = *(const u32x4*)(p.proj + (size_t)(row0 + j) * 3072 + 256 + h * 64 + d0);
    }
    for (int task = tid; task < 128 * 16; task += NTHREADS) {
      const int j = task >> 4, e0 = (task & 15) * 8;
      *(LAS u32x4*)(Vl + j * LDP + e0) = *(const u32x4*)(p.proj + (size_t)(row0 + j) * 3072 + 512 + h * 128 + e0);
    }
    __syncthreads();
    bf16x8 af[4], ab[4];
#pragma unroll
    for (int ks = 0; ks < 4; ++ks) {
      const bf16x8 vf = tr_frag(Vl + (ks * 32 + fq * 4) * LDP + wid * 16, LDP, lane);
      const u32x4 vu = __builtin_bit_cast(u32x4, vf);
      u32x4 wf, wb;
#pragma unroll
      for (int q = 0; q < 4; ++q) {
        const int j0 = ks * 32 + (q >> 1) * 16 + fq * 4 + (q & 1) * 2;
        const float lo = bf_lo(vu[q]), hi = bf_hi(vu[q]);
        wf[q] = cvt_pk_bf16(lo * __expf(lf * (float)(127 - j0)), hi * __expf(lf * (float)(126 - j0)));
        wb[q] = cvt_pk_bf16(lo * __expf(lb * (float)j0), hi * __expf(lb * (float)(j0 + 1)));
      }
      af[ks] = __builtin_bit_cast(bf16x8, wf);
      ab[ks] = __builtin_bit_cast(bf16x8, wb);
    }
    float* out = p.kv + (size_t)it * 16384;
#pragma unroll
    for (int n = 0; n < 4; ++n) {
      f32x4 accf = {0.f, 0.f, 0.f, 0.f}, accb = {0.f, 0.f, 0.f, 0.f};
#pragma unroll
      for (int ks = 0; ks < 4; ++ks) {
        const bf16x8 kf = tr_frag(Kl + (ks * 32 + fq * 4) * LDK + n * 16, LDK, lane);
        accf = __builtin_amdgcn_mfma_f32_16x16x32_bf16(af[ks], kf, accf, 0, 0, 0);
        accb = __builtin_amdgcn_mfma_f32_16x16x32_bf16(ab[ks], kf, accb, 0, 0, 0);
      }
#pragma unroll
      for (int j = 0; j < 4; ++j) {
        out[(wid * 16 + fq * 4 + j) * 128 + n * 16 + fr] = accf[j];
        out[(wid * 16 + fq * 4 + j) * 128 + 64 + n * 16 + fr] = accb[j];
      }
    }
  }
  for (size_t task = (size_t)bid * NTHREADS + tid; task < (size_t)NTOK * 64; task += (size_t)nb * NTHREADS) {
    const int row = (int)(task >> 6), c0 = (int)(task & 63) * 8;
    const int tin = row < NCTX ? (row & (CTXL - 1)) : ((row - NCTX) & (SEQ - 1));
    const int tlen = row < NCTX ? CTXL : SEQ;
    const bf16_t* pr = p.proj + (size_t)row * 3072;
    const u32x4 gb = *(const u32x4*)(pr + 1536 + c0);
    float accv[8];
#pragma unroll
    for (int q = 0; q < 8; ++q) accv[q] = 0.f;
#pragma unroll
    for (int dt = -1; dt <= 1; ++dt) {
      if (tin + dt < 0 || tin + dt >= tlen) continue;
      const bf16_t* pr2 = pr + (ptrdiff_t)dt * 3072;
      const u32x4 gc = *(const u32x4*)(pr2 + 2048 + c0), xt = *(const u32x4*)(pr2 + 2560 + c0);
      const float* w = p.conv_w + (dt + 1) * 512 + c0;
      const f32x4 wa = *(const f32x4*)w, wb = *(const f32x4*)(w + 4);
#pragma unroll
      for (int q = 0; q < 4; ++q) {
        const float u0 = bf_lo(gc[q]) * bf_lo(xt[q]), u1 = bf_hi(gc[q]) * bf_hi(xt[q]);
        const float w0 = (2 * q < 4) ? wa[2 * q] : wb[2 * q - 4], w1 = (2 * q + 1 < 4) ? wa[2 * q + 1] : wb[2 * q + 1 - 4];
        accv[2 * q] += w0 * u0;
        accv[2 * q + 1] += w1 * u1;
      }
    }
    u32x4 o;
#pragma unroll
    for (int q = 0; q < 4; ++q) o[q] = cvt_pk_bf16(bf_lo(gb[q]) * accv[2 * q], bf_hi(gb[q]) * accv[2 * q + 1]);
#ifdef ZERO_CONV
    o = (u32x4){0u, 0u, 0u, 0u};
#endif
    *(u32x4*)(p.act + (size_t)row * D + 512 + c0) = o;
  }
}

__device__ void phase_ret_scan(const Params& p, int bid, int nb) {
  const int tid = tidx();
  for (size_t idx = (size_t)bid * NTHREADS + tid; idx < (size_t)BATCH * 4 * 16384; idx += (size_t)nb * NTHREADS) {
    const int el = (int)(idx & 16383), bh = (int)(idx >> 14), h = bh & 3;
    const bool fwd = (el & 127) < 64;
    const float lg = log_sigmoidf(fwd ? p.logit_f[h] : p.logit_b[h]);
    const float dec = __expf(lg * 128.f);
    float st = 0.f;
    for (int s = 0; s < 18; ++s) {
      const int cc = fwd ? s : (s < 2 ? 1 - s : 19 - s);
      const size_t off = ((size_t)bh * 18 + cc) * 16384 + el;
      p.sprev[off] = f2bf(st);
      st = dec * st + p.kv[off];
    }
  }
}

__device__ void phase_ret_out(const Params& p, unsigned char* smem, int bid, int nb) {
  const int tid = tidx(), wid = __builtin_amdgcn_readfirstlane(tid >> 6), lane = tid & 63, fr = lane & 15, fq = lane >> 4;
  LAS bf16_t* Kl = (LAS bf16_t*)smem;
  LAS bf16_t* Vl = Kl + 128 * LDK;
  LAS bf16_t* Sl = Vl + 128 * LDP;
  const int NIT = BATCH * 4 * 18;
  u32x4 rk[2], rv[4], rs[4];
  bf16x8 qfn[2];
#define RO_LOAD(IT)                                                                                                      \
  do {                                                                                                                   \
    const int _cc = (IT) % 18, _h = ((IT) / 18) & 3, _b = (IT) / 72;                                                     \
    const int _row0 = chunk_row0(_b, _cc);                                                                               \
    _Pragma("unroll") for (int c = 0; c < 2; ++c) { const int task = tid + c * NTHREADS; const int j = task >> 3, d0 = (task & 7) * 8; \
      rk[c] = *(const u32x4*)(p.proj + (size_t)(_row0 + j) * 3072 + 256 + _h * 64 + d0); }                              \
    _Pragma("unroll") for (int c = 0; c < 4; ++c) { const int task = tid + c * NTHREADS; const int j = task >> 4, e0 = (task & 15) * 8; \
      rv[c] = *(const u32x4*)(p.proj + (size_t)(_row0 + j) * 3072 + 512 + _h * 128 + e0);                               \
      rs[c] = *(const u32x4*)(p.sprev + (size_t)(IT) * 16384 + j * 128 + e0); }                                          \
    _Pragma("unroll") for (int ks = 0; ks < 2; ++ks) qfn[ks] = *(const bf16x8*)(p.proj + (size_t)(_row0 + wid * 16 + fr) * 3072 + _h * 64 + ks * 32 + fq * 8); \
  } while (0)
#define RO_STORE()                                                                                                       \
  do {                                                                                                                   \
    _Pragma("unroll") for (int c = 0; c < 2; ++c) { const int task = tid + c * NTHREADS; const int j = task >> 3, d0 = (task & 7) * 8; \
      *(LAS u32x4*)(Kl + j * LDK + d0) = rk[c]; }                                                                        \
    _Pragma("unroll") for (int c = 0; c < 4; ++c) { const int task = tid + c * NTHREADS; const int j = task >> 4, e0 = (task & 15) * 8; \
      *(LAS u32x4*)(Vl + j * LDP + e0) = rv[c]; *(LAS u32x4*)(Sl + j * LDP + e0) = rs[c]; }                              \
  } while (0)
  if (bid < NIT) { RO_LOAD(bid); __syncthreads(); RO_STORE(); }
  __syncthreads();
  for (int it = bid; it < NIT; it += nb) {
    const int cc = it % 18, h = (it / 18) & 3, b = it / 72;
    const int row0 = chunk_row0(b, cc);
    const float lf = log_sigmoidf(p.logit_f[h]), lb = log_sigmoidf(p.logit_b[h]);
    const int irow = wid * 16 + fr;
    bf16x8 qf[2];
    qf[0] = qfn[0]; qf[1] = qfn[1];
    const bool more = it + nb < NIT;
    if (more) RO_LOAD(it + nb);
    const size_t row = (size_t)(row0 + irow);
    u32x2 gg[8];
#pragma unroll
    for (int dn = 0; dn < 8; ++dn) gg[dn] = *(const u32x2*)(p.proj + row * 3072 + 1024 + h * 128 + dn * 16 + fq * 4);
    bf16x8 pb[4];
    {
      f32x4 st[8];
#pragma unroll
      for (int n = 0; n < 8; ++n) st[n] = (f32x4){0.f, 0.f, 0.f, 0.f};
#pragma unroll
      for (int ks = 0; ks < 2; ++ks)
#pragma unroll
        for (int n = 0; n < 8; ++n) {
          const bf16x8 kf = *(const LAS bf16x8*)(Kl + (n * 16 + fr) * LDK + ks * 32 + fq * 8);
          st[n] = __builtin_amdgcn_mfma_f32_16x16x32_bf16(kf, qf[ks], st[n], 0, 0, 0);
        }
#pragma unroll
      for (int n = 0; n < 8; ++n)
#pragma unroll
        for (int r = 0; r < 4; ++r) {
          const int df = irow - (n * 16 + fq * 4 + r);
          const float lg = df > 0 ? lf : lb;
          const float ex = __expf(lg * fabsf((float)df));
          st[n][r] *= (df == 0) ? 2.f : ex;
        }
#pragma unroll
      for (int kk = 0; kk < 4; ++kk) {
        u32x4 w;
        w.x = cvt_pk_bf16(st[2 * kk][0], st[2 * kk][1]); w.y = cvt_pk_bf16(st[2 * kk][2], st[2 * kk][3]);
        w.z = cvt_pk_bf16(st[2 * kk + 1][0], st[2 * kk + 1][1]); w.w = cvt_pk_bf16(st[2 * kk + 1][2], st[2 * kk + 1][3]);
        pb[kk] = __builtin_bit_cast(bf16x8, w);
      }
    }
    bf16x8 qx[4];
    {
      const float xf = __expf(lf * (float)(irow + 1)), xb = __expf(lb * (float)(128 - irow));
#pragma unroll
      for (int ks = 0; ks < 4; ++ks) {
        const float sc = ks < 2 ? xf : xb;
        const u32x4 qu = __builtin_bit_cast(u32x4, qf[ks & 1]);
        u32x4 qo;
#pragma unroll
        for (int q = 0; q < 4; ++q) { const unsigned w = qu[q]; qo[q] = cvt_pk_bf16(bf_lo(w) * sc, bf_hi(w) * sc); }
        qx[ks] = __builtin_bit_cast(bf16x8, qo);
      }
    }
    f32x4 ot[8];
#pragma unroll
    for (int dn = 0; dn < 8; ++dn) {
      f32x4 o = {0.f, 0.f, 0.f, 0.f};
#pragma unroll
      for (int kk = 0; kk < 4; ++kk) {
        const bf16x8 vf = tr_frag(Vl + (kk * 32 + fq * 4) * LDP + dn * 16, LDP, lane);
        o = __builtin_amdgcn_mfma_f32_16x16x32_bf16(vf, pb[kk], o, 0, 0, 0);
      }
#pragma unroll
      for (int ks = 0; ks < 4; ++ks) {
        const bf16x8 sf = *(const LAS bf16x8*)(Sl + (dn * 16 + fr) * LDP + ks * 32 + fq * 8);
        o = __builtin_amdgcn_mfma_f32_16x16x32_bf16(sf, qx[ks], o, 0, 0, 0);
      }
      ot[dn] = o;
    }
    float ss = 0.f;
#pragma unroll
    for (int dn = 0; dn < 8; ++dn) ss += ot[dn][0] * ot[dn][0] + ot[dn][1] * ot[dn][1] + ot[dn][2] * ot[dn][2] + ot[dn][3] * ot[dn][3];
    ss = xrow16_sum(ss);
    const float rstd = rsqrtf(ss * (1.f / 128.f) + EPS);
#pragma unroll
    for (int dn = 0; dn < 8; ++dn) {
      const int e0 = dn * 16 + fq * 4;
      const u32x2 g = gg[dn];
      u32x2 w;
#ifdef ZERO_RET
      w.x = 0u; w.y = 0u;
#else
      w.x = cvt_pk_bf16(ot[dn][0] * rstd * siluf(bf_lo(g.x)), ot[dn][1] * rstd * siluf(bf_hi(g.x)));
      w.y = cvt_pk_bf16(ot[dn][2] * rstd * siluf(bf_lo(g.y)), ot[dn][3] * rstd * siluf(bf_hi(g.y)));
#endif
      *(u32x2*)(p.act + row * D + h * 128 + e0) = w;
    }
    __syncthreads();
    if (more) RO_STORE();
    __syncthreads();
  }
#undef RO_LOAD
#undef RO_STORE
}

__device__ __forceinline__ float xrow16_max(float x) {
  auto s = __builtin_amdgcn_permlane16_swap(__float_as_uint(x), __float_as_uint(x), false, false);
  x = fmaxf(__uint_as_float(s[0]), __uint_as_float(s[1]));
  auto t = __builtin_amdgcn_permlane32_swap(__float_as_uint(x), __float_as_uint(x), false, false);
  return fmaxf(__uint_as_float(t[0]), __uint_as_float(t[1]));
}
template <int VAR>
__device__ void phase_attn(const Params& p, unsigned char* smem, int bid, int nb, bf16_t* outp) {
  const int tid = tidx(), wid = __builtin_amdgcn_readfirstlane(tid >> 6), lane = tid & 63, fr = lane & 15, fq = lane >> 4;
  LAS bf16_t* Kl = (LAS bf16_t*)smem;
  LAS bf16_t* Vl = Kl + 2 * 64 * LDK;
  LAS bf16_t* Ql = Vl + 2 * 64 * LDK + wid * 64 * LDK;
  const int sj = tid >> 3, sc8 = (tid & 7) * 8;
  const int troff = ((lane & 15) >> 2) * LDK + (lane & 3) * 4;
  for (int it = bid; it < BATCH * 16 * 4; it += nb) {
    const int kvh = it & 3, qb = (it >> 2) & 15, b = it >> 6;
    const int hq = kvh * 4 + (wid >> 1);
    const int q0 = qb * 128 + (wid & 1) * 64;
    const size_t latrow0 = (size_t)NCTX + (size_t)b * SEQ;
    const int tlo = qb == 0 ? 2 : 0, nwin = (qb == 15 ? 4 : 6) - tlo, ntile = nwin + 4;
#pragma unroll
    for (int m = 0; m < 4; ++m)
#pragma unroll
      for (int ks = 0; ks < 2; ++ks)
        *(LAS bf16x8*)(Ql + (m * 16 + fr) * LDK + ks * 32 + fq * 8) = *(const bf16x8*)(p.proj + (latrow0 + q0 + m * 16 + fr) * 1536 + hq * 64 + ks * 32 + fq * 8);
    const float sink = p.sinks[hq] * 1.44269504089f;
    float mrow[4], lrow[4];
    f32x4 ot[4][4];
#pragma unroll
    for (int m = 0; m < 4; ++m) {
      mrow[m] = sink; lrow[m] = (fq == 0) ? 1.f : 0.f;
#pragma unroll
      for (int dn = 0; dn < 4; ++dn) ot[dn][m] = (f32x4){0.f, 0.f, 0.f, 0.f};
    }
#define AT_KROW(T) ((T) < nwin ? latrow0 + (qb * 128 - 128 + 64 * (tlo + (T))) : (size_t)b * CTXL + ((T) - nwin) * 64)
#define AT_LOAD(RK, RV, T) do { const size_t _kr = AT_KROW(T);                                                            \
      RK = *(const u32x4*)(p.proj + (_kr + sj) * 1536 + 1024 + kvh * 64 + sc8);                                          \
      RV = *(const u32x4*)(p.proj + (_kr + sj) * 1536 + 1280 + kvh * 64 + sc8); } while (0)
    u32x4 rk0, rv0, rk1, rv1;
    rk0 = rk1 = rv0 = rv1 = (u32x4){0u, 0u, 0u, 0u};
    {
      u32x4 kk, vv;
      AT_LOAD(kk, vv, 0);
      AT_LOAD(rk1, rv1, 1);
      *(LAS u32x4*)(Kl + sj * LDK + sc8) = kk;
      *(LAS u32x4*)(Vl + sj * LDK + sc8) = vv;
    }
    __syncthreads();
    auto tile = [&](const int s, u32x4& ldK, u32x4& ldV, const u32x4& wrK, const u32x4& wrV) __attribute__((always_inline)) {
      const int cur = s & 1;
      const int tt = s < nwin ? tlo + s : 6 + (s - nwin);
      const bool win = tt < 6;
      const int kpos0 = win ? qb * 128 - 128 + 64 * tt : (tt - 6) * 64;
      const bool more = s + 1 < ntile;
      if (!(VAR & 16)) { if (s + 2 < ntile) AT_LOAD(ldK, ldV, s + 2); }
      const LAS bf16_t* Kc = Kl + cur * 64 * LDK;
      const LAS bf16_t* Vc = Vl + cur * 64 * LDK;
      const int dq = q0 - kpos0;
      const bool skip = win && (dq >= 192 || dq <= -192);
      const bool edge = win && !(dq <= 65 && dq >= -65);
      if (!skip && !(VAR & 8)) {
      bf16x8 pb[4][2];
      {
        bf16x8 kfr[2][4];
#pragma unroll
        for (int ks = 0; ks < 2; ++ks)
#pragma unroll
          for (int n = 0; n < 4; ++n) kfr[ks][n] = *(const LAS bf16x8*)(Kc + (n * 16 + fr) * LDK + ks * 32 + fq * 8);
#pragma unroll
        for (int m = 0; m < 4; ++m) {
          f32x4 st[4];
#pragma unroll
          for (int n = 0; n < 4; ++n) st[n] = (f32x4){0.f, 0.f, 0.f, 0.f};
#pragma unroll
          for (int ks = 0; ks < 2; ++ks) {
            const bf16x8 qfm = *(const LAS bf16x8*)(Ql + (m * 16 + fr) * LDK + ks * 32 + fq * 8);
#pragma unroll
            for (int n = 0; n < 4; ++n) st[n] = __builtin_amdgcn_mfma_f32_16x16x32_bf16(kfr[ks][n], qfm, st[n], 0, 0, 0);
          }
          const int qpos = q0 + m * 16 + fr;
          float mx = -3.0e38f;
#pragma unroll
          for (int n = 0; n < 4; ++n)
#pragma unroll
            for (int j = 0; j < 4; ++j) {
              float sv = st[n][j];
              if (edge) { const int dd = qpos - (kpos0 + n * 16 + fq * 4 + j); if (dd > 128 || dd < -128) sv = -1e30f; }
              st[n][j] = sv;
              mx = fmaxf(mx, sv);
            }
          mx = xrow16_max(mx);
          const float mnew = fmaxf(mrow[m], mx);
          const float alpha = __builtin_amdgcn_exp2f(mrow[m] - mnew);
          mrow[m] = mnew;
          float ls = 0.f;
#pragma unroll
          for (int n = 0; n < 4; ++n)
#pragma unroll
            for (int j = 0; j < 4; ++j) { const float pv = (VAR & 2) ? (st[n][j] - mnew) : __builtin_amdgcn_exp2f(st[n][j] - mnew); st[n][j] = pv; ls += pv; }
          lrow[m] = lrow[m] * alpha + ls;
#pragma unroll
          for (int dn = 0; dn < 4; ++dn) ot[dn][m] *= alpha;
#pragma unroll
          for (int kk = 0; kk < 2; ++kk) {
            u32x4 w;
            w.x = cvt_pk_bf16(st[2 * kk][0], st[2 * kk][1]); w.y = cvt_pk_bf16(st[2 * kk][2], st[2 * kk][3]);
            w.z = cvt_pk_bf16(st[2 * kk + 1][0], st[2 * kk + 1][1]); w.w = cvt_pk_bf16(st[2 * kk + 1][2], st[2 * kk + 1][3]);
            pb[m][kk] = __builtin_bit_cast(bf16x8, w);
          }
          __builtin_amdgcn_sched_barrier(0);
        }
      }
#pragma unroll
      for (int kk = 0; kk < 2; ++kk) {
        bf16x8 vfr[4];
#pragma unroll
        for (int dn = 0; dn < 4; ++dn) {
          const s16x4 v0 = __builtin_amdgcn_ds_read_tr16_b64_v4i16((LAS s16x4*)(Vc + ((2 * kk) * 16 + fq * 4) * LDK + dn * 16 + troff));
          const s16x4 v1 = __builtin_amdgcn_ds_read_tr16_b64_v4i16((LAS s16x4*)(Vc + ((2 * kk + 1) * 16 + fq * 4) * LDK + dn * 16 + troff));
          bf16x8 vf;
          vf[0] = v0[0]; vf[1] = v0[1]; vf[2] = v0[2]; vf[3] = v0[3]; vf[4] = v1[0]; vf[5] = v1[1]; vf[6] = v1[2]; vf[7] = v1[3];
          vfr[dn] = vf;
        }
#pragma unroll
        for (int m = 0; m < 4; ++m)
#pragma unroll
          for (int dn = 0; dn < 4; ++dn) { if (VAR & 4) ot[dn][m][0] += __uint_as_float(__builtin_bit_cast(u32x4, vfr[dn]).x ^ __builtin_bit_cast(u32x4, pb[m][kk]).x); else ot[dn][m] = __builtin_amdgcn_mfma_f32_16x16x32_bf16(vfr[dn], pb[m][kk], ot[dn][m], 0, 0, 0); }
        __builtin_amdgcn_sched_barrier(0);
      }
      }
      if (!(VAR & 16)) {
        if (more) {
          *(LAS u32x4*)(Kl + ((cur ^ 1) * 64 + sj) * LDK + sc8) = wrK;
          *(LAS u32x4*)(Vl + ((cur ^ 1) * 64 + sj) * LDK + sc8) = wrV;
        }
        __syncthreads();
      }
    };
#pragma unroll 1
    for (int s = 0; s < ntile; s += 2) {
      tile(s, rk0, rv0, rk1, rv1);
      tile(s + 1, rk1, rv1, rk0, rv0);
    }
#undef AT_LOAD
#undef AT_KROW
    int fr2 = fr;
    asm volatile("" : "+v"(fr2));
#pragma unroll
    for (int m = 0; m < 4; ++m) {
      const float l = xrow16_sum(lrow[m]);
      const float inv = 1.f / l;
      bf16_t* orow = outp + (latrow0 + q0 + m * 16 + fr2) * D + hq * 64 + fq * 4;
#pragma unroll
      for (int dn = 0; dn < 4; ++dn) {
        u32x2 w;
#ifdef ZERO_ATTN
        w.x = 0u; w.y = 0u;
#else
        w.x = cvt_pk_bf16(ot[dn][m][0] * inv, ot[dn][m][1] * inv); w.y = cvt_pk_bf16(ot[dn][m][2] * inv, ot[dn][m][3] * inv);
#endif
        *(u32x2*)(orow + dn * 16) = w;
      }
    }
  }
}

#define CEX(a, b) do { const unsigned _h = max(a, b), _l = min(a, b); a = _h; b = _l; } while (0)
__device__ __forceinline__ void sort16_desc(unsigned (&v)[16]) { CEX(v[0], v[1]); CEX(v[2], v[3]); CEX(v[0], v[2]); CEX(v[1], v[3]); CEX(v[1], v[2]); CEX(v[4], v[5]); CEX(v[6], v[7]); CEX(v[4], v[6]); CEX(v[5], v[7]); CEX(v[5], v[6]); CEX(v[0], v[4]); CEX(v[2], v[6]); CEX(v[2], v[4]); CEX(v[1], v[5]); CEX(v[3], v[7]); CEX(v[3], v[5]); CEX(v[1], v[2]); CEX(v[3], v[4]); CEX(v[5], v[6]); CEX(v[8], v[9]); CEX(v[10], v[11]); CEX(v[8], v[10]); CEX(v[9], v[11]); CEX(v[9], v[10]); CEX(v[12], v[13]); CEX(v[14], v[15]); CEX(v[12], v[14]); CEX(v[13], v[15]); CEX(v[13], v[14]); CEX(v[8], v[12]); CEX(v[10], v[14]); CEX(v[10], v[12]); CEX(v[9], v[13]); CEX(v[11], v[15]); CEX(v[11], v[13]); CEX(v[9], v[10]); CEX(v[11], v[12]); CEX(v[13], v[14]); CEX(v[0], v[8]); CEX(v[4], v[12]); CEX(v[4], v[8]); CEX(v[2], v[10]); CEX(v[6], v[14]); CEX(v[6], v[10]); CEX(v[2], v[4]); CEX(v[6], v[8]); CEX(v[10], v[12]); CEX(v[1], v[9]); CEX(v[5], v[13]); CEX(v[5], v[9]); CEX(v[3], v[11]); CEX(v[7], v[15]); CEX(v[7], v[11]); CEX(v[3], v[5]); CEX(v[7], v[9]); CEX(v[11], v[13]); CEX(v[1], v[2]); CEX(v[3], v[4]); CEX(v[5], v[6]); CEX(v[7], v[8]); CEX(v[9], v[10]); CEX(v[11], v[12]); CEX(v[13], v[14]); }
__device__ __forceinline__ void merge16_desc(unsigned (&t)[16], const unsigned (&b)[16]) {
#pragma unroll
  for (int i = 0; i < 16; ++i) t[i] = max(t[i], b[15 - i]);
  CEX(t[0], t[8]); CEX(t[1], t[9]); CEX(t[2], t[10]); CEX(t[3], t[11]); CEX(t[4], t[12]); CEX(t[5], t[13]); CEX(t[6], t[14]); CEX(t[7], t[15]); CEX(t[0], t[4]); CEX(t[1], t[5]); CEX(t[2], t[6]); CEX(t[3], t[7]); CEX(t[8], t[12]); CEX(t[9], t[13]); CEX(t[10], t[14]); CEX(t[11], t[15]); CEX(t[0], t[2]); CEX(t[1], t[3]); CEX(t[4], t[6]); CEX(t[5], t[7]); CEX(t[8], t[10]); CEX(t[9], t[11]); CEX(t[12], t[14]); CEX(t[13], t[15]); CEX(t[0], t[1]); CEX(t[2], t[3]); CEX(t[4], t[5]); CEX(t[6], t[7]); CEX(t[8], t[9]); CEX(t[10], t[11]); CEX(t[12], t[13]); CEX(t[14], t[15]);
}

__device__ __forceinline__ unsigned f2ord(float f) { const unsigned u = __float_as_uint(f); return (u & 0x80000000u) ? ~u : (u | 0x80000000u); }
__device__ __forceinline__ float ord2f(unsigned k) { const unsigned u = (k & 0x80000000u) ? (k & 0x7fffffffu) : ~k; return __uint_as_float(u); }
__device__ __forceinline__ unsigned dpp_xor1(unsigned x) { return (unsigned)__builtin_amdgcn_mov_dpp((int)x, 0xB1, 0xf, 0xf, true); }

__device__ void phase_peer_topk(const Params& p, unsigned char* smem, int bid, int nb, int layer, int tok0, int ntok) {
  const int tid = tidx(), wid = __builtin_amdgcn_readfirstlane(tid >> 6), lane = tid & 63, fr = lane & 15, fq = lane >> 4;
  LAS unsigned* sc = (LAS unsigned*)smem + wid * (64 * 36 + 64 * 16);
  LAS unsigned* fl = sc + 64 * 36;
  const int ls = lane & 1;
  const int nitem = (ntok / 256) * 8;
  for (int it = bid; it < nitem; it += nb) {
    const int h = it & 7, tile = it >> 3;
    const int tokw0 = tok0 + tile * 256 + wid * 32;
    bf16x8 qa[2][2][2];
#pragma unroll
    for (int m = 0; m < 2; ++m)
#pragma unroll
      for (int s = 0; s < 2; ++s)
#pragma unroll
        for (int ks = 0; ks < 2; ++ks)
          qa[m][s][ks] = *(const bf16x8*)(p.pq + (size_t)(tokw0 + m * 16 + fr) * D + h * 128 + s * 64 + ks * 32 + fq * 8);
    unsigned top[16];
#pragma unroll
    for (int i = 0; i < 16; ++i) top[i] = 0u;
    const bf16_t* kb = p.keysb + (size_t)(layer * 8 + h) * (2 * 2 * 128 * 64);
    bf16x8 kfr[2][2][2];
#define TK_LOADKEYS(C)                                                                                                   \
    _Pragma("unroll") for (int s = 0; s < 2; ++s) _Pragma("unroll") for (int n = 0; n < 2; ++n) _Pragma("unroll") for (int ks = 0; ks < 2; ++ks) \
      kfr[s][n][ks] = *(const bf16x8*)(kb + (size_t)((s * 2) * 128 + (C) * 32 + n * 16 + fr) * 64 + ks * 32 + fq * 8)
    TK_LOADKEYS(0);
#pragma unroll 1
    for (int c = 0; c < 4; ++c) {
      f32x4 acc[2][2][2];
#pragma unroll
      for (int m = 0; m < 2; ++m)
#pragma unroll
        for (int s = 0; s < 2; ++s)
#pragma unroll
          for (int n = 0; n < 2; ++n) acc[m][s][n] = (f32x4){0.f, 0.f, 0.f, 0.f};
#pragma unroll
      for (int s = 0; s < 2; ++s)
#pragma unroll
        for (int n = 0; n < 2; ++n)
#pragma unroll
          for (int ks = 0; ks < 2; ++ks)
#pragma unroll
            for (int m = 0; m < 2; ++m) acc[m][s][n] = __builtin_amdgcn_mfma_f32_16x16x32_bf16(qa[m][s][ks], kfr[s][n][ks], acc[m][s][n], 0, 0, 0);
      { const int cn = c < 3 ? c + 1 : 3; TK_LOADKEYS(cn); }
#pragma unroll
      for (int m = 0; m < 2; ++m)
#pragma unroll
        for (int s = 0; s < 2; ++s)
#pragma unroll
          for (int n = 0; n < 2; ++n)
#pragma unroll
            for (int j = 0; j < 4; ++j)
              sc[((m * 16 + fq * 4 + j) * 2 + s) * 36 + n * 16 + fr] = (f2ord(acc[m][s][n][j]) & 0xffffff80u) | (unsigned)(127 - (c * 32 + n * 16 + fr));
      unsigned b0[16], b1[16];
#pragma unroll
      for (int q = 0; q < 4; ++q) {
        const u32x4 w0 = *(const LAS u32x4*)(sc + lane * 36 + q * 4), w1 = *(const LAS u32x4*)(sc + lane * 36 + 16 + q * 4);
        b0[4 * q] = w0.x; b0[4 * q + 1] = w0.y; b0[4 * q + 2] = w0.z; b0[4 * q + 3] = w0.w;
        b1[4 * q] = w1.x; b1[4 * q + 1] = w1.y; b1[4 * q + 2] = w1.z; b1[4 * q + 3] = w1.w;
      }
      sort16_desc(b0); merge16_desc(top, b0);
      sort16_desc(b1); merge16_desc(top, b1);
    }
#undef TK_LOADKEYS
#pragma unroll
    for (int q = 0; q < 4; ++q) { u32x4 w; w.x = top[4 * q]; w.y = top[4 * q + 1]; w.z = top[4 * q + 2]; w.w = top[4 * q + 3]; *(LAS u32x4*)(fl + lane * 16 + q * 4) = w; }
    float own[16], oth[16];
#pragma unroll
    for (int q = 0; q < 4; ++q) {
      const u32x4 w = *(const LAS u32x4*)(fl + (lane ^ 1) * 16 + q * 4);
      oth[4 * q] = ord2f(w.x & 0xffffff80u); oth[4 * q + 1] = ord2f(w.y & 0xffffff80u); oth[4 * q + 2] = ord2f(w.z & 0xffffff80u); oth[4 * q + 3] = ord2f(w.w & 0xffffff80u);
    }
#pragma unroll
    for (int i = 0; i < 16; ++i) own[i] = ord2f(top[i] & 0xffffff80u);
    unsigned ck[32];
    ck[0] = (f2ord(own[0] + oth[1]) & 0xffffff00u) | (255u - (ls ? 16u : 1u));
    ck[1] = (f2ord(own[0] + oth[2]) & 0xffffff00u) | (255u - (ls ? 32u : 2u));
    ck[2] = (f2ord(own[0] + oth[3]) & 0xffffff00u) | (255u - (ls ? 48u : 3u));
    ck[3] = (f2ord(own[0] + oth[4]) & 0xffffff00u) | (255u - (ls ? 64u : 4u));
    ck[4] = (f2ord(own[0] + oth[5]) & 0xffffff00u) | (255u - (ls ? 80u : 5u));
    ck[5] = (f2ord(own[0] + oth[6]) & 0xffffff00u) | (255u - (ls ? 96u : 6u));
    ck[6] = (f2ord(own[0] + oth[7]) & 0xffffff00u) | (255u - (ls ? 112u : 7u));
    ck[7] = (f2ord(own[0] + oth[8]) & 0xffffff00u) | (255u - (ls ? 128u : 8u));
    ck[8] = (f2ord(own[0] + oth[9]) & 0xffffff00u) | (255u - (ls ? 144u : 9u));
    ck[9] = (f2ord(own[0] + oth[10]) & 0xffffff00u) | (255u - (ls ? 160u : 10u));
    ck[10] = (f2ord(own[0] + oth[11]) & 0xffffff00u) | (255u - (ls ? 176u : 11u));
    ck[11] = (f2ord(own[0] + oth[12]) & 0xffffff00u) | (255u - (ls ? 192u : 12u));
    ck[12] = (f2ord(own[0] + oth[13]) & 0xffffff00u) | (255u - (ls ? 208u : 13u));
    ck[13] = (f2ord(own[0] + oth[14]) & 0xffffff00u) | (255u - (ls ? 224u : 14u));
    ck[14] = (f2ord(own[0] + oth[15]) & 0xffffff00u) | (255u - (ls ? 240u : 15u));
    ck[15] = (f2ord(own[1] + oth[2]) & 0xffffff00u) | (255u - (ls ? 33u : 18u));
    ck[16] = (f2ord(own[1] + oth[3]) & 0xffffff00u) | (255u - (ls ? 49u : 19u));
    ck[17] = (f2ord(own[1] + oth[4]) & 0xffffff00u) | (255u - (ls ? 65u : 20u));
    ck[18] = (f2ord(own[1] + oth[5]) & 0xffffff00u) | (255u - (ls ? 81u : 21u));
    ck[19] = (f2ord(own[1] + oth[6]) & 0xffffff00u) | (255u - (ls ? 97u : 22u));
    ck[20] = (f2ord(own[1] + oth[7]) & 0xffffff00u) | (255u - (ls ? 113u : 23u));
    ck[21] = (f2ord(own[2] + oth[3]) & 0xffffff00u) | (255u - (ls ? 50u : 35u));
    ck[22] = (f2ord(own[2] + oth[4]) & 0xffffff00u) | (255u - (ls ? 66u : 36u));
    ck[23] = ls ? 0u : ((f2ord(own[0] + oth[0]) & 0xffffff00u) | (255u - 0u));
    ck[24] = ls ? 0u : ((f2ord(own[1] + oth[1]) & 0xffffff00u) | (255u - 17u));
    ck[25] = ls ? 0u : ((f2ord(own[2] + oth[2]) & 0xffffff00u) | (255u - 34u));
    ck[26] = ls ? 0u : ((f2ord(own[3] + oth[3]) & 0xffffff00u) | (255u - 51u));
    ck[27] = 0u;
    ck[28] = 0u;
    ck[29] = 0u;
    ck[30] = 0u;
    ck[31] = 0u;
    unsigned c0[16], c1[16];
#pragma unroll
    for (int i = 0; i < 16; ++i) { c0[i] = ck[i]; c1[i] = ck[16 + i]; }
    sort16_desc(c0); sort16_desc(c1); merge16_desc(c0, c1);
    unsigned pt[16];
#pragma unroll
    for (int i = 0; i < 16; ++i) pt[i] = dpp_xor1(c0[i]);
    merge16_desc(c0, pt);
    float cs[16], den = 0.f;
    const float mx = ord2f(c0[0] & 0xffffff00u);
#pragma unroll
    for (int r = 0; r < 16; ++r) { cs[r] = __expf(ord2f(c0[r] & 0xffffff00u) - mx); den += cs[r]; }
    const float inv = 1.f / den;
    const int token = tokw0 + (lane >> 1);
    if (ls == 0) {
      u32x2* so = p.sel + (size_t)token * 128 + h * 16;
      const LAS unsigned* l1 = fl + lane * 16;
      const LAS unsigned* l2 = fl + (lane + 1) * 16;
#pragma unroll
      for (int rr = 0; rr < 16; rr += 2) {
        u32x4 w;
        {
          const unsigned ci = 255u - (c0[rr] & 0xffu);
          w.x = (127u - (l1[ci >> 4] & 0x7fu)) * 128u + (127u - (l2[ci & 15u] & 0x7fu)); w.y = __float_as_uint(cs[rr] * inv);
        }
        {
          const unsigned ci = 255u - (c0[rr + 1] & 0xffu);
          w.z = (127u - (l1[ci >> 4] & 0x7fu)) * 128u + (127u - (l2[ci & 15u] & 0x7fu)); w.w = __float_as_uint(cs[rr + 1] * inv);
        }
        *(u32x4*)(so + rr) = w;
      }
    }
  }
}

__device__ __forceinline__ float gelu_as(float v) {
  const float av = fabsf(v), t = __builtin_amdgcn_rcpf(av * 0.2316418882f + 1.0f);
  float q = t * 0.5307027145f + (-0.7265760135f);
  q = q * t + 0.7107068705f; q = q * t + (-0.142248368f); q = q * t + 0.127414796f; q = q * t;
  const float ee = __builtin_amdgcn_exp2f((v * v) * (-0.72134752044f));
  const float m = v * (q * ee);
  return v < 0.f ? m : v - m;
}
typedef __bf16 bf16x2t __attribute__((ext_vector_type(2)));
__device__ __forceinline__ unsigned rl2(unsigned lo, unsigned hi, int j) {
  const unsigned a = (unsigned)__builtin_amdgcn_readlane((int)lo, j & 63), b = (unsigned)__builtin_amdgcn_readlane((int)hi, j & 63);
  return j < 64 ? a : b;
}
__device__ __forceinline__ float group8_sum(float x) { x += dppf<0xB1>(x); x += dppf<0x4E>(x); x += dppf<0x141>(x); return x; }
__device__ __forceinline__ float dot2u(unsigned a, unsigned b, float c) {
  return __builtin_amdgcn_fdot2_f32_bf16(__builtin_bit_cast(bf16x2t, a), __builtin_bit_cast(bf16x2t, b), c, false);
}
__device__ __forceinline__ void peer_sort_token(const Params& p, int token, int lane_in, LAS unsigned* lst, int t, const float* us, const float* vs) {
  int lane = lane_in;
  asm volatile("" : "+v"(lane));
      const u32x2 se0 = p.sel[(size_t)token * 128 + lane], se1 = p.sel[(size_t)token * 128 + 64 + lane];
      unsigned ka = (se0.x << 7) | (unsigned)lane, kb = (se1.x << 7) | (unsigned)(lane + 64);
#define BSTEP(J, UPA, UPB)                                                                                               \
      do {                                                                                                               \
        unsigned oa, ob;                                                                                                 \
        if ((J) == 1) { oa = dppu<0xB1>(ka); ob = dppu<0xB1>(kb); }                                                      \
        else if ((J) == 2) { oa = dppu<0x4E>(ka); ob = dppu<0x4E>(kb); }                                                 \
        else if ((J) == 4) { const bool hi4 = (lane & 4) != 0;                                                           \
          const unsigned a0 = dppu<0x104>(ka), a1 = dppu<0x114>(ka), b0 = dppu<0x104>(kb), b1 = dppu<0x114>(kb);         \
          oa = hi4 ? a1 : a0; ob = hi4 ? b1 : b0; }                                                                      \
        else if ((J) == 8) { oa = dppu<0x128>(ka); ob = dppu<0x128>(kb); }                                               \
        else if ((J) == 16) { const bool odd = (lane & 16) != 0;                                                         \
          auto ta = __builtin_amdgcn_permlane16_swap(ka, ka, false, false); auto tb = __builtin_amdgcn_permlane16_swap(kb, kb, false, false); \
          oa = odd ? ta[0] : ta[1]; ob = odd ? tb[0] : tb[1]; }                                                          \
        else { const bool up32 = lane >= 32;                                                                             \
          auto ta = __builtin_amdgcn_permlane32_swap(ka, ka, false, false); auto tb = __builtin_amdgcn_permlane32_swap(kb, kb, false, false); \
          oa = up32 ? ta[0] : ta[1]; ob = up32 ? tb[0] : tb[1]; }                                                        \
        const bool lower = (lane & (J)) == 0;                                                                            \
        const unsigned mna = min(ka, oa), mxa = max(ka, oa), mnb = min(kb, ob), mxb = max(kb, ob);                       \
        ka = (lower == (UPA)) ? mna : mxa;                                                                               \
        kb = (lower == (UPB)) ? mnb : mxb;                                                                               \
      } while (0)
#define BLAYERS(K)                                                                                                       \
      do {                                                                                                               \
        const bool up = ((K) >= 64) ? true : ((lane & (K)) == 0);                                                        \
        const bool upa = up, upb = ((K) == 64) ? false : up;                                                             \
        if ((K) >= 64) BSTEP(32, upa, upb);                                                                              \
        if ((K) >= 32) BSTEP(16, upa, upb);                                                                              \
        if ((K) >= 16) BSTEP(8, upa, upb);                                                                               \
        if ((K) >= 8) BSTEP(4, upa, upb);                                                                                \
        if ((K) >= 4) BSTEP(2, upa, upb);                                                                                \
        BSTEP(1, upa, upb);                                                                                              \
      } while (0)
      BLAYERS(2); BLAYERS(4); BLAYERS(8); BLAYERS(16); BLAYERS(32); BLAYERS(64);
      { const unsigned mn = min(ka, kb), mx = max(ka, kb); ka = mn; kb = mx; }
      BLAYERS(128);
#undef BLAYERS
#undef BSTEP
      const unsigned sa = ka & 127u, sb = kb & 127u;
      const unsigned ga0 = (unsigned)__builtin_amdgcn_ds_bpermute((int)((sa & 63u) * 4u), (int)se0.y), ga1 = (unsigned)__builtin_amdgcn_ds_bpermute((int)((sa & 63u) * 4u), (int)se1.y);
      const unsigned gb0 = (unsigned)__builtin_amdgcn_ds_bpermute((int)((sb & 63u) * 4u), (int)se0.y), gb1 = (unsigned)__builtin_amdgcn_ds_bpermute((int)((sb & 63u) * 4u), (int)se1.y);
      const float gta = __uint_as_float((sa & 64u) ? ga1 : ga0), gtb = __uint_as_float((sb & 64u) ? gb1 : gb0);
      const unsigned ea = ka >> 7, eb = kb >> 7;
      lst[t * 128 + lane] = ka; lst[t * 128 + 64 + lane] = kb;
      lst[1024 + t * 128 + lane] = __float_as_uint(gta * vs[ea]); lst[1024 + t * 128 + 64 + lane] = __float_as_uint(gtb * vs[eb]);
      lst[2048 + t * 128 + lane] = __float_as_uint(us[ea]); lst[2048 + t * 128 + 64 + lane] = __float_as_uint(us[eb]);
}
template <int VAR>
__device__ void phase_peer_gather(const Params& p, unsigned char* smem, int bid, int nb, int layer, int tok0, int ntok) {
  const int tid0 = tidx();
  const int wid = __builtin_amdgcn_readfirstlane(tid0 >> 6), lane = tid0 & 63, g = lane >> 3, i = lane & 7;
  const __amdgpu_buffer_rsrc_t U = __builtin_amdgcn_make_buffer_rsrc((void*)(p.u8 + (size_t)layer * NEXP * 768), (short)0, NEXP * 768, 0x00020000);
  const __amdgpu_buffer_rsrc_t V = __builtin_amdgcn_make_buffer_rsrc((void*)(p.v8 + (size_t)layer * NEXP * 768), (short)0, NEXP * 768, 0x00020000);
  const float* us = p.uscale + (size_t)layer * NEXP;
  const float* vs = p.vscale + (size_t)layer * NEXP;
  const float* modl = p.mod + (size_t)layer * 33 * MODW;
  LAS unsigned* lst = (LAS unsigned*)smem + wid * 3072;
#define PIECE(R, VOFF, K) __builtin_bit_cast(u32x4, __builtin_amdgcn_raw_buffer_load_b128(R, ((VAR & 2) ? (i * 16) : (VOFF)) + (K) * 128, 0, 0))
  const int n8 = (ntok / (nb * 64)) * (nb * 64);
  for (int grp = bid * 8 + wid; grp < n8 / 8; grp += nb * 8) {
    const int token0 = tok0 + grp * 8;
#pragma unroll 1
    for (int t = 0; t < 8; ++t) {
      const int token = token0 + t;
      peer_sort_token(p, token, lane, lst, t, us, vs);
    }
    const int token = token0 + g;
    {
      u32x4 x[4][4];
#pragma unroll
      for (int b = 0; b < 4; ++b) {
        const bf16_t* xr = p.act + (size_t)token * D + b * 256 + i * 32;
#pragma unroll
        for (int q = 0; q < 4; ++q) x[b][q] = *(const u32x4*)(xr + q * 8);
      }
      constexpr int NB1 = 4;
      u32x4 pk[NB1][6];
#pragma unroll
      for (int s = 0; s < NB1; ++s) {
        const int voff = (int)((lst[g * 128 + s] >> 7) * 768u) + i * 16;
#pragma unroll
        for (int k = 0; k < 6; ++k) pk[s][k] = PIECE(U, voff, k);
      }
#define P1_BLOCK(B, W0, W1, W2, W3, W4, W5)                                                                              \
      do {                                                                                                               \
        u32x6 w6; w6[0] = (W0); w6[1] = (W1); w6[2] = (W2); w6[3] = (W3); w6[4] = (W4); w6[5] = (W5);                    \
        const u32x16 bw = __builtin_bit_cast(u32x16, __builtin_amdgcn_cvt_scalef32_pk32_bf16_fp6(w6, 1.0f));             \
        _Pragma("unroll") for (int q = 0; q < 4; ++q) {                                                                  \
          const u32x4 xv = x[B][q];                                                                                      \
          const unsigned b0 = bw[4 * q], b1 = bw[4 * q + 1], b2 = bw[4 * q + 2], b3 = bw[4 * q + 3];                     \
          const unsigned x0 = xv[0], x1 = xv[1], x2 = xv[2], x3 = xv[3];                                                 \
          d0 = dot2u(b0, x0, d0); d1 = dot2u(b1, x1, d1); d2 = dot2u(b2, x2, d2); d3 = dot2u(b3, x3, d3);                \
        }                                                                                                                \
      } while (0)
      unsigned keyn = lst[g * 128 + NB1];
      float sun = __uint_as_float(lst[2048 + g * 128]), gsvn = __uint_as_float(lst[1024 + g * 128]);
#define P1_STEP(S, J)                                                                                                    \
      do {                                                                                                               \
        const int voffn = (int)((keyn >> 7) * 768u) + i * 16;                                                            \
        const float su = sun, gsv = gsvn;                                                                                \
        { const int jk = (J) + 1 + NB1 < 128 ? (J) + 1 + NB1 : 127; const int jq = (J) + 1 < 128 ? (J) + 1 : 127;        \
          keyn = lst[g * 128 + jk]; sun = __uint_as_float(lst[2048 + g * 128 + jq]); gsvn = __uint_as_float(lst[1024 + g * 128 + jq]); } \
        float d0 = 0.f, d1 = 0.f, d2 = 0.f, d3 = 0.f;                                                                    \
        if (VAR & 4) { d0 += __uint_as_float(pk[S][0][0] ^ pk[S][1][1] ^ pk[S][2][2]); } else {                          \
        P1_BLOCK(0, pk[S][0][0], pk[S][0][1], pk[S][0][2], pk[S][0][3], pk[S][1][0], pk[S][1][1]);                       \
        P1_BLOCK(1, pk[S][1][2], pk[S][1][3], pk[S][2][0], pk[S][2][1], pk[S][2][2], pk[S][2][3]); }                     \
        pk[S][0] = PIECE(U, voffn, 0); pk[S][1] = PIECE(U, voffn, 1); pk[S][2] = PIECE(U, voffn, 2);                     \
        if (VAR & 4) { d1 += __uint_as_float(pk[S][3][0] ^ pk[S][4][1] ^ pk[S][5][2]); } else {                          \
        P1_BLOCK(2, pk[S][3][0], pk[S][3][1], pk[S][3][2], pk[S][3][3], pk[S][4][0], pk[S][4][1]);                       \
        P1_BLOCK(3, pk[S][4][2], pk[S][4][3], pk[S][5][0], pk[S][5][1], pk[S][5][2], pk[S][5][3]); }                     \
        pk[S][3] = PIECE(U, voffn, 3); pk[S][4] = PIECE(U, voffn, 4); pk[S][5] = PIECE(U, voffn, 5);                     \
        const float d = group8_sum((d0 + d1) + (d2 + d3)) * su;                                                          \
        lst[1024 + g * 128 + (J)] = __float_as_uint(gsv * gelu_as(d));                                                   \
      } while (0)
#pragma unroll 1
      for (int j = 0; j < 128; j += 4) { P1_STEP(0, j); P1_STEP(1, j + 1); P1_STEP(2, j + 2); P1_STEP(3, j + 3); }
#undef P1_STEP
#undef P1_BLOCK
    }
    const bool isctx = token < NCTX;
    const int b = isctx ? 32 : ((token - NCTX) >> 11);
    const float* g2 = modl + (size_t)b * MODW + 5 * D + i * 32;
    float* hrow = ((VAR & 1) ? (float*)(p.proj + (size_t)113246208) + (size_t)(token - tok0) * D
                             : (isctx ? p.hctx + (size_t)token * D : p.out + (size_t)(token - NCTX) * D)) + i * 32;
    float ss = 0.f;
#pragma unroll 1
    for (int hf = 0; hf < 2; ++hf) {
      f32x32 y0, y1;
#pragma unroll
      for (int c = 0; c < 32; ++c) { y0[c] = 0.f; y1[c] = 0.f; }
      const int hoff = hf * 384 + i * 16;
      constexpr int NB2 = 8;
      u32x4 pk[NB2][3];
#pragma unroll
      for (int s = 0; s < NB2; ++s) {
        const int voff = (int)((lst[g * 128 + s] >> 7) * 768u) + hoff;
#pragma unroll
        for (int k = 0; k < 3; ++k) pk[s][k] = PIECE(V, voff, k);
      }
      unsigned keyn = lst[g * 128 + NB2];
      float an = __uint_as_float(lst[1024 + g * 128]);
#define P2_STEP(S, J)                                                                                                    \
      do {                                                                                                               \
        const int voffn = (int)((keyn >> 7) * 768u) + hoff;                                                              \
        const float a = an;                                                                                              \
        { const int jk = (J) + 1 + NB2 < 128 ? (J) + 1 + NB2 : 127; const int jq = (J) + 1 < 128 ? (J) + 1 : 127;        \
          keyn = lst[g * 128 + jk]; an = __uint_as_float(lst[1024 + g * 128 + jq]); }                                    \
        {                                                                                                                \
          u32x6 w6; w6[0] = pk[S][0][0]; w6[1] = pk[S][0][1]; w6[2] = pk[S][0][2]; w6[3] = pk[S][0][3]; w6[4] = pk[S][1][0]; w6[5] = pk[S][1][1]; \
          if (VAR & 4) { y0[0] += __uint_as_float(w6[0] ^ w6[5]) * a; } else {                                           \
          const f32x32 f = __builtin_amdgcn_cvt_scalef32_pk32_f32_fp6(w6, 1.0f);                                         \
          y0 += f * a; }                                                                                                 \
        }                                                                                                                \
        {                                                                                                                \
          u32x6 w6; w6[0] = pk[S][1][2]; w6[1] = pk[S][1][3]; w6[2] = pk[S][2][0]; w6[3] = pk[S][2][1]; w6[4] = pk[S][2][2]; w6[5] = pk[S][2][3]; \
          if (VAR & 4) { y1[0] += __uint_as_float(w6[0] ^ w6[5]) * a; } else {                                           \
          const f32x32 f = __builtin_amdgcn_cvt_scalef32_pk32_f32_fp6(w6, 1.0f);                                         \
          y1 += f * a; }                                                                                                 \
        }                                                                                                                \
        pk[S][0] = PIECE(V, voffn, 0); pk[S][1] = PIECE(V, voffn, 1); pk[S][2] = PIECE(V, voffn, 2);                     \
      } while (0)
#pragma unroll 1
      for (int j = 0; j < 128; j += 8) { P2_STEP(0, j); P2_STEP(1, j + 1); P2_STEP(2, j + 2); P2_STEP(3, j + 3); P2_STEP(4, j + 4); P2_STEP(5, j + 5); P2_STEP(6, j + 6); P2_STEP(7, j + 7); }
#undef P2_STEP
#ifdef ZERO_PEER
      if (layer == ZERO_PEER) {
#pragma unroll
        for (int c = 0; c < 32; ++c) { y0[c] = 0.f; y1[c] = 0.f; }
      }
#endif
#pragma unroll
      for (int bb = 0; bb < 2; ++bb)
#pragma unroll
        for (int q4 = 0; q4 < 8; ++q4) {
          const int co = (2 * hf + bb) * 256 + q4 * 4;
          const f32x4 hv = *(const f32x4*)(hrow + co), gv = *(const f32x4*)(g2 + co);
          f32x4 o;
#pragma unroll
          for (int e = 0; e < 4; ++e) { const float yv = bb ? y1[q4 * 4 + e] : y0[q4 * 4 + e]; const float v = hv[e] + gv[e] * yv; o[e] = v; ss += v * v; }
          *(f32x4*)(hrow + co) = o;
        }
    }
    {
      ss = group8_sum(ss);
      const float rstd = rsqrtf(ss * (1.f / D) + EPS);
      if (layer == 0) {
        const float* modn = p.mod + (size_t)33 * MODW + (size_t)b * MODW + i * 32;
        const float* gain = p.mix_g + D + i * 32;
#pragma unroll 2
        for (int k = 0; k < 16; ++k) {
          const int co = (k >> 2) * 256 + (k & 3) * 8;
          u32x4 w;
#pragma unroll
          for (int q4 = 0; q4 < 2; ++q4) {
            const f32x4 hv = *(const f32x4*)(hrow + co + q4 * 4);
            const f32x4 gg = *(const f32x4*)(gain + co + q4 * 4), s0 = *(const f32x4*)(modn + co + q4 * 4), s1 = *(const f32x4*)(modn + D + co + q4 * 4);
            f32x4 yv = hv * rstd * gg;
            yv = yv * (1.f + s1) + s0;
            w[q4 * 2] = cvt_pk_bf16(yv[0], yv[1]); w[q4 * 2 + 1] = cvt_pk_bf16(yv[2], yv[3]);
          }
          *(u32x4*)(p.act + (size_t)token * D + i * 32 + co) = w;
        }
      } else {
        const float* gain = p.final_g + i * 32;
#pragma unroll 2
        for (int k = 0; k < 32; ++k) {
          const int co = (k >> 3) * 256 + (k & 7) * 4;
          const f32x4 hv = *(const f32x4*)(hrow + co), gg = *(const f32x4*)(gain + co);
          *(f32x4*)(hrow + co) = hv * rstd * gg;
        }
      }
    }
    __syncthreads();
  }
  {
    const int g4 = lane >> 4, iv = lane & 7, hs = (lane >> 3) & 1;
    const int poff = hs * 384 + iv * 16;
    for (int grp = bid * 8 + wid; grp < (ntok - n8) / 4; grp += nb * 8) {
      const int token0 = tok0 + n8 + grp * 4;
#pragma unroll 1
      for (int t = 0; t < 4; ++t) peer_sort_token(p, token0 + t, lane, lst, t, us, vs);
      const int token = token0 + g4;
      {
        u32x4 x[2][4];
#pragma unroll
        for (int bb = 0; bb < 2; ++bb) {
          const bf16_t* xr = p.act + (size_t)token * D + (2 * hs + bb) * 256 + iv * 32;
#pragma unroll
          for (int q = 0; q < 4; ++q) x[bb][q] = *(const u32x4*)(xr + q * 8);
        }
        constexpr int NB1 = 8;
        u32x4 pk[NB1][3];
#pragma unroll
        for (int s = 0; s < NB1; ++s) {
          const int voff = (int)((lst[g4 * 128 + s] >> 7) * 768u) + poff;
#pragma unroll
          for (int k = 0; k < 3; ++k) pk[s][k] = PIECE(U, voff, k);
        }
#define T1_BLOCK(B, W0, W1, W2, W3, W4, W5)                                                                              \
        do {                                                                                                             \
          u32x6 w6; w6[0] = (W0); w6[1] = (W1); w6[2] = (W2); w6[3] = (W3); w6[4] = (W4); w6[5] = (W5);                  \
          const u32x16 bw = __builtin_bit_cast(u32x16, __builtin_amdgcn_cvt_scalef32_pk32_bf16_fp6(w6, 1.0f));           \
          _Pragma("unroll") for (int q = 0; q < 4; ++q) {                                                                \
            const u32x4 xv = x[B][q];                                                                                    \
            const unsigned b0 = bw[4 * q], b1 = bw[4 * q + 1], b2 = bw[4 * q + 2], b3 = bw[4 * q + 3];                   \
            const unsigned x0 = xv[0], x1 = xv[1], x2 = xv[2], x3 = xv[3];                                               \
            d0 = dot2u(b0, x0, d0); d1 = dot2u(b1, x1, d1); d2 = dot2u(b2, x2, d2); d3 = dot2u(b3, x3, d3);              \
          }                                                                                                              \
        } while (0)
#define T1_STEP(S, J)                                                                                                    \
        do {                                                                                                             \
          const int jn = (J) + NB1 < 128 ? (J) + NB1 : 127;                                                              \
          const int voffn = (int)((lst[g4 * 128 + jn] >> 7) * 768u) + poff;                                              \
          const float su = __uint_as_float(lst[2048 + g4 * 128 + (J)]), gsv = __uint_as_float(lst[1024 + g4 * 128 + (J)]); \
          float d0 = 0.f, d1 = 0.f, d2 = 0.f, d3 = 0.f;                                                                  \
          T1_BLOCK(0, pk[S][0][0], pk[S][0][1], pk[S][0][2], pk[S][0][3], pk[S][1][0], pk[S][1][1]);                     \
          T1_BLOCK(1, pk[S][1][2], pk[S][1][3], pk[S][2][0], pk[S][2][1], pk[S][2][2], pk[S][2][3]);                     \
          pk[S][0] = PIECE(U, voffn, 0); pk[S][1] = PIECE(U, voffn, 1); pk[S][2] = PIECE(U, voffn, 2);                   \
          __builtin_amdgcn_sched_barrier(0);                                                                             \
          float dd = group8_sum((d0 + d1) + (d2 + d3)); dd += dppf<0x128>(dd);             \
          lst[1024 + g4 * 128 + (J)] = __float_as_uint(gsv * gelu_as(dd * su));                                          \
        } while (0)
#pragma unroll 1
        for (int j = 0; j < 128; j += 8) { T1_STEP(0, j); T1_STEP(1, j + 1); T1_STEP(2, j + 2); T1_STEP(3, j + 3); T1_STEP(4, j + 4); T1_STEP(5, j + 5); T1_STEP(6, j + 6); T1_STEP(7, j + 7); }
#undef T1_STEP
#undef T1_BLOCK
      }
      const bool isctx = token < NCTX;
      const int b = isctx ? 32 : ((token - NCTX) >> 11);
      const float* g2 = modl + (size_t)b * MODW + 5 * D + iv * 32;
      float* hrow = (isctx ? p.hctx + (size_t)token * D : p.out + (size_t)(token - NCTX) * D) + iv * 32;
      float ss = 0.f;
      {
        f32x32 y0, y1;
#pragma unroll
        for (int c = 0; c < 32; ++c) { y0[c] = 0.f; y1[c] = 0.f; }
        constexpr int NB2 = 8;
        u32x4 pk[NB2][3];
#pragma unroll
        for (int s = 0; s < NB2; ++s) {
          const int voff = (int)((lst[g4 * 128 + s] >> 7) * 768u) + poff;
#pragma unroll
          for (int k = 0; k < 3; ++k) pk[s][k] = PIECE(V, voff, k);
        }
#define T2_STEP(S, J)                                                                                                    \
        do {                                                                                                             \
          const int jn = (J) + NB2 < 128 ? (J) + NB2 : 127;                                                              \
          const int voffn = (int)((lst[g4 * 128 + jn] >> 7) * 768u) + poff;                                              \
          const float a = __uint_as_float(lst[1024 + g4 * 128 + (J)]);                                                   \
          {                                                                                                              \
            u32x6 w6; w6[0] = pk[S][0][0]; w6[1] = pk[S][0][1]; w6[2] = pk[S][0][2]; w6[3] = pk[S][0][3]; w6[4] = pk[S][1][0]; w6[5] = pk[S][1][1]; \
            const f32x32 f = __builtin_amdgcn_cvt_scalef32_pk32_f32_fp6(w6, 1.0f);                                       \
            y0 += f * a;                                                                                                 \
          }                                                                                                              \
          __builtin_amdgcn_sched_barrier(0);                                                                             \
          {                                                                                                              \
            u32x6 w6; w6[0] = pk[S][1][2]; w6[1] = pk[S][1][3]; w6[2] = pk[S][2][0]; w6[3] = pk[S][2][1]; w6[4] = pk[S][2][2]; w6[5] = pk[S][2][3]; \
            const f32x32 f = __builtin_amdgcn_cvt_scalef32_pk32_f32_fp6(w6, 1.0f);                                       \
            y1 += f * a;                                                                                                 \
          }                                                                                                              \
          pk[S][0] = PIECE(V, voffn, 0); pk[S][1] = PIECE(V, voffn, 1); pk[S][2] = PIECE(V, voffn, 2);                   \
          __builtin_amdgcn_sched_barrier(0);                                                                             \
        } while (0)
#pragma unroll 1
        for (int j = 0; j < 128; j += 8) { T2_STEP(0, j); T2_STEP(1, j + 1); T2_STEP(2, j + 2); T2_STEP(3, j + 3); T2_STEP(4, j + 4); T2_STEP(5, j + 5); T2_STEP(6, j + 6); T2_STEP(7, j + 7); }
#undef T2_STEP
#ifdef ZERO_PEER
        if (layer == ZERO_PEER) {
#pragma unroll
          for (int c = 0; c < 32; ++c) { y0[c] = 0.f; y1[c] = 0.f; }
        }
#endif
#pragma unroll
        for (int bb = 0; bb < 2; ++bb)
#pragma unroll
          for (int q4 = 0; q4 < 8; ++q4) {
            const int co = (2 * hs + bb) * 256 + q4 * 4;
            const f32x4 hv = *(const f32x4*)(hrow + co), gv = *(const f32x4*)(g2 + co);
            f32x4 o;
#pragma unroll
            for (int e = 0; e < 4; ++e) { const float yv = bb ? y1[q4 * 4 + e] : y0[q4 * 4 + e]; const float v = hv[e] + gv[e] * yv; o[e] = v; ss += v * v; }
            *(f32x4*)(hrow + co) = o;
          }
      }
      {
        ss = group8_sum(ss); ss += dppf<0x128>(ss);
        const float rstd = rsqrtf(ss * (1.f / D) + EPS);
        if (layer == 0) {
          const float* modn = p.mod + (size_t)33 * MODW + (size_t)b * MODW + iv * 32;
          const float* gain = p.mix_g + D + iv * 32;
#pragma unroll 2
          for (int k = 0; k < 8; ++k) {
            const int co = (2 * hs + (k >> 2)) * 256 + (k & 3) * 8;
            u32x4 w;
#pragma unroll
            for (int q4 = 0; q4 < 2; ++q4) {
              const f32x4 hv = *(const f32x4*)(hrow + co + q4 * 4);
              const f32x4 gg = *(const f32x4*)(gain + co + q4 * 4), s0 = *(const f32x4*)(modn + co + q4 * 4), s1 = *(const f32x4*)(modn + D + co + q4 * 4);
              f32x4 yv = hv * rstd * gg;
              yv = yv * (1.f + s1) + s0;
              w[q4 * 2] = cvt_pk_bf16(yv[0], yv[1]); w[q4 * 2 + 1] = cvt_pk_bf16(yv[2], yv[3]);
            }
            *(u32x4*)(p.act + (size_t)token * D + iv * 32 + co) = w;
          }
        } else {
          const float* gain = p.final_g + iv * 32;
#pragma unroll 2
          for (int k = 0; k < 16; ++k) {
            const int co = (2 * hs + (k >> 3)) * 256 + (k & 7) * 4;
            const f32x4 hv = *(const f32x4*)(hrow + co), gg = *(const f32x4*)(gain + co);
            *(f32x4*)(hrow + co) = hv * rstd * gg;
          }
        }
      }
      __syncthreads();
    }
  }
#undef PIECE
}

constexpr int NPH = 18;
template <int PH>
__device__ __forceinline__ void run_phase(const Params& p, unsigned char* smem, int bid, int nb) {
  if constexpr (PH == 0) phase_prep(p, smem, bid, nb);
  else if constexpr (PH == 1) phase_norm(p, bid, nb, 0, NTOK, p.ctx, p.x, p.mix_g, p.mod, 0, 1);
  else if constexpr (PH == 2) phase_gemm_inproj(p, smem, bid, nb, 0);
  else if constexpr (PH == 3) phase_ret_kv(p, smem, bid, nb);
  else if constexpr (PH == 4) phase_ret_scan(p, bid, nb);
  else if constexpr (PH == 5) phase_ret_out(p, smem, bid, nb);
  else if constexpr (PH == 6) phase_gemm_outproj(p, smem, bid, nb, 0);
  else if constexpr (PH == 7) phase_resid_norm(p, bid, nb, 0, NTOK, p.ctx, p.x, p.ffn_g, p.mod);
  else if constexpr (PH == 8) phase_gemm_pq(p, smem, bid, nb, 0);
  else if constexpr (PH == 9) phase_peer_topk(p, smem, bid, nb, 0, 0, NTOK);
  else if constexpr (PH == 10) phase_peer_gather<0>(p, smem, bid, nb, 0, 0, NTOK);
  else if constexpr (PH == 11) phase_gemm_inproj(p, smem, bid, nb, 1);
  else if constexpr (PH == 12) phase_attn<0>(p, smem, bid, nb, p.act);
  else if constexpr (PH == 13) phase_gemm_outproj(p, smem, bid, nb, 1);
  else if constexpr (PH == 14) phase_resid_norm(p, bid, nb, NCTX, NTOK, p.hctx, p.out, p.ffn_g + D, p.mod + (size_t)33 * MODW);
  else if constexpr (PH == 15) phase_gemm_pq(p, smem, bid, nb, 1);
  else if constexpr (PH == 16) phase_peer_topk(p, smem, bid, nb, 1, NCTX, NLAT);
  else if constexpr (PH == 17) phase_peer_gather<0>(p, smem, bid, nb, 1, NCTX, NLAT);
}
template <int PH>
__global__ void __launch_bounds__(NTHREADS) phase_k(Params p) {
  extern __shared__ __attribute__((aligned(16))) unsigned char smem[];
  run_phase<PH>(p, smem, blockIdx.x, gridDim.x);
}
#define XB_TMO      128
#define XB_XCNT(j)  (256  + 64 * (j))
#define XB_XSUB(j)  (1280 + 64 * (j))
#define XB_XGEN(j)  (2304 + 64 * (j))
#define XB_TOP      3328
#define XB_TOPGEN   3392
#define XCD_BAR_WORDS 3456
#define XB_SPIN_CAP (1u << 22)
__device__ __forceinline__ unsigned xb_ld(unsigned* p)              { return __hip_atomic_load(p, __ATOMIC_RELAXED, __HIP_MEMORY_SCOPE_AGENT); }
__device__ __forceinline__ unsigned xb_add(unsigned* p, unsigned v) { return __hip_atomic_fetch_add(p, v, __ATOMIC_RELAXED, __HIP_MEMORY_SCOPE_AGENT); }
__device__ __forceinline__ unsigned xb_xcc_id() { return (unsigned)__builtin_amdgcn_s_getreg((3 << 11) | 20) & 0xFu; }
#define XB_SPIN(cond, bar) do { unsigned _sp = 0; while (cond) { __builtin_amdgcn_s_sleep(1); \
    if ((++_sp & 255u) == 0u) { if (xb_ld(&(bar)[XB_TMO])) break; if (_sp > XB_SPIN_CAP) { atomicAdd(&(bar)[XB_TMO], 1u); break; } } } } while (0)
struct XcdBarrier { unsigned* bar; unsigned x; volatile LAS unsigned* st; };
__device__ __forceinline__ XcdBarrier xcd_barrier_post(unsigned* bar, volatile LAS unsigned* st) {
  XcdBarrier b; b.bar = bar; b.x = xb_xcc_id(); b.st = st;
  if (threadIdx.x == 0) (void)xb_add(&bar[XB_XCNT(b.x)], 1u);
  return b;
}
__device__ __forceinline__ void xcd_barrier_complete(unsigned* bar, unsigned x, unsigned& nloc, unsigned& nx) {
  const unsigned G = gridDim.x * gridDim.y * gridDim.z;
  unsigned sum, cnt, mine, sp = 0u;
  for (;;) {
    sum = 0u; cnt = 0u; mine = 0u;
#pragma unroll
    for (unsigned j = 0; j < 16; ++j) { const unsigned c = xb_ld(&bar[XB_XCNT(j)]); sum += c; cnt += (c > 0u) ? 1u : 0u; mine = (j == x) ? c : mine; }
    if (sum == G) break;
    __builtin_amdgcn_s_sleep(1);
    if ((++sp & 255u) == 0u) { if (xb_ld(&bar[XB_TMO])) break; if (sp > XB_SPIN_CAP) { atomicAdd(&bar[XB_TMO], 1u); break; } }
  }
  nloc = mine > 0u ? mine : 1u; nx = cnt > 0u ? cnt : 1u;
}
__device__ __forceinline__ void xcd_barrier(const XcdBarrier& b) {
  asm volatile("s_waitcnt vmcnt(0)" ::: "memory");
  __syncthreads();
  if (threadIdx.x == 0) {
    unsigned* bar = b.bar;
    __builtin_amdgcn_s_waitcnt(0);
    unsigned nloc = b.st[0], nx = b.st[1];
    if (nloc == 0u) { xcd_barrier_complete(bar, b.x, nloc, nx); b.st[0] = nloc; b.st[1] = nx; }
    const unsigned old = xb_add(&bar[XB_XSUB(b.x)], 1u);
    const unsigned gen = old / nloc;
    if (old + 1u == (gen + 1u) * nloc) {
      __builtin_amdgcn_fence(__ATOMIC_RELEASE, "agent");
      asm volatile("s_waitcnt vmcnt(0)" ::: "memory");
      const unsigned og = xb_add(&bar[XB_TOP], 1u);
      const unsigned tg = og / nx;
      if (og + 1u == (tg + 1u) * nx) xb_add(&bar[XB_TOPGEN], 1u);
      else XB_SPIN(xb_ld(&bar[XB_TOPGEN]) == tg, bar);
      __builtin_amdgcn_fence(__ATOMIC_ACQUIRE, "agent");
      xb_add(&bar[XB_XGEN(b.x)], 1u);
      asm volatile("s_waitcnt vmcnt(0)" ::: "memory");
    } else {
      XB_SPIN(xb_ld(&bar[XB_XGEN(b.x)]) == gen, bar);
      __builtin_amdgcn_fence(__ATOMIC_ACQUIRE, "agent");
      asm volatile("s_waitcnt vmcnt(0)" ::: "memory");
    }
  }
  __syncthreads();
}

#if MK_ONE_LAUNCH
constexpr int PARAMS_OFF = LDS_BYTES - 512;
static_assert(sizeof(Params) <= 480, "params block");
template <class T>
__device__ __forceinline__ T* uni(T* q) {
  const unsigned long long v = (unsigned long long)q;
  const unsigned lo = __builtin_amdgcn_readfirstlane((unsigned)v), hi = __builtin_amdgcn_readfirstlane((unsigned)(v >> 32));
  return (T*)(((unsigned long long)hi << 32) | lo);
}
__device__ __forceinline__ Params load_params(const unsigned char* smem) {
  const Params* l = (const Params*)(smem + PARAMS_OFF);
  Params q;
  q.x = uni(l->x); q.c = uni(l->c); q.ctx = uni(l->ctx); q.c_ctx = uni(l->c_ctx); q.ada_w = uni(l->ada_w); q.ada_b = uni(l->ada_b);
  q.mix_g = uni(l->mix_g); q.ffn_g = uni(l->ffn_g); q.ev_w_in = uni(l->ev_w_in); q.ev_w_out = uni(l->ev_w_out);
  q.logit_f = uni(l->logit_f); q.logit_b = uni(l->logit_b); q.conv_w = uni(l->conv_w); q.od_w_in = uni(l->od_w_in);
  q.od_w_out = uni(l->od_w_out); q.sinks = uni(l->sinks); q.peer_wq = uni(l->peer_wq); q.keys1 = uni(l->keys1); q.keys2 = uni(l->keys2);
  q.peer_u = uni(l->peer_u); q.peer_v = uni(l->peer_v); q.final_g = uni(l->final_g); q.out = uni(l->out); q.mod = uni(l->mod);
  q.ropec = uni(l->ropec); q.ropes = uni(l->ropes); q.winT0 = uni(l->winT0); q.woutT0 = uni(l->woutT0); q.winT1 = uni(l->winT1);
  q.woutT1 = uni(l->woutT1); q.wqT = uni(l->wqT); q.u8 = uni(l->u8); q.v8 = uni(l->v8); q.uscale = uni(l->uscale); q.vscale = uni(l->vscale); q.hctx = uni(l->hctx); q.act = uni(l->act);
  q.proj = uni(l->proj); q.pq = uni(l->pq); q.sel = uni(l->sel); q.kv = uni(l->kv); q.sprev = uni(l->sprev); q.bar = uni(l->bar); q.keysb = uni(l->keysb);
  return q;
}
template <int PH>
__device__ __forceinline__ void run_from(unsigned char* smem, int bid, int nb, const XcdBarrier& xb) {
  {
    const Params q = load_params(smem);
    run_phase<PH>(q, smem, bid, nb);
  }
#ifdef DUP_PH
  if constexpr (PH == DUP_PH) {
    xcd_barrier(xb);
    const Params q = load_params(smem);
#ifdef DUP_ATTN_VAR
    phase_attn<DUP_ATTN_VAR>(q, smem, bid, nb, q.proj + (size_t)113246208);
#elif defined(DUP_GATHER_VAR)
    phase_peer_gather<DUP_GATHER_VAR>(q, smem, bid, nb, 1, NCTX, NLAT);
#else
    run_phase<PH>(q, smem, bid, nb);
#endif
  }
#endif
  if constexpr (PH + 1 < NPH) {
    if constexpr (PH == 0) cg::this_grid().sync();
    else xcd_barrier(xb);
    run_from<PH + 1>(smem, bid, nb, xb);
  }
}
__global__ void __launch_bounds__(NTHREADS) mega(Params p) {
  extern __shared__ __attribute__((aligned(16))) unsigned char smem[];
  volatile LAS unsigned* st = (volatile LAS unsigned*)((LAS unsigned char*)smem + PARAMS_OFF + 480);
  if (threadIdx.x == 0) { *(Params*)(smem + PARAMS_OFF) = p; st[0] = 0u; st[1] = 0u; }
  __syncthreads();
  const XcdBarrier xb = xcd_barrier_post(p.bar, st);
  run_from<0>(smem, blockIdx.x, gridDim.x, xb);
}
#endif
#ifndef DBG_NPH
#define DBG_NPH 0
#endif
#if DBG_NPH
__global__ void __launch_bounds__(NTHREADS) dbg_sums(Params p, float* scr, int nph) {
  const int wid = threadIdx.x >> 6, lane = threadIdx.x & 63;
  const int gw = blockIdx.x * 8 + wid, nw = gridDim.x * 8;
  if (nph >= 2) for (int r = gw; r < NTOK; r += nw) { float s = 0.f; for (int c = lane; c < D; c += 64) s += bf2f(p.act[(size_t)r * D + c]) * (1 + (c & 7)); s = wave_sum(s); if (lane == 0) scr[r] = s; }
  if (nph >= 3 && nph <= 8) for (int r = gw; r < NTOK; r += nw) { float s = 0.f; for (int c = lane; c < 3072; c += 64) s += bf2f(p.proj[(size_t)r * 3072 + c]) * (1 + (c & 7)); s = wave_sum(s); if (lane == 0) scr[(1 << 20) + r] = s; }
  if (nph >= 12 && nph <= 15) for (int r = gw; r < NTOK; r += nw) { float s = 0.f; for (int c = lane + (r < NCTX ? 1024 : 0); c < 1536; c += 64) s += bf2f(p.proj[(size_t)r * 1536 + c]) * (1 + (c & 7)); s = wave_sum(s); if (lane == 0) scr[(1 << 20) + r] = s; }
  if (nph >= 4) for (int r = gw; r < 2304 * 128; r += nw) { float s = 0.f; for (int c = lane; c < 128; c += 64) s += p.kv[(size_t)r * 128 + c] * (1 + (c & 7)); s = wave_sum(s); if (lane == 0) scr[(2 << 20) + r] = s; }
  if (nph >= 5) for (int r = gw; r < 2304 * 128; r += nw) { float s = 0.f; for (int c = lane; c < 128; c += 64) s += bf2f(p.sprev[(size_t)r * 128 + c]) * (1 + (c & 7)); s = wave_sum(s); if (lane == 0) scr[(3 << 20) + r] = s; }
  if (nph >= 7) for (int r = gw; r < NCTX; r += nw) { float s = 0.f; for (int c = lane; c < D; c += 64) s += p.hctx[(size_t)r * D + c] * (1 + (c & 7)); s = wave_sum(s); if (lane == 0) scr[(4 << 20) + r] = s; }
  if (nph >= 1) for (int i = blockIdx.x * NTHREADS + threadIdx.x; i < 2 * 33 * MODW; i += gridDim.x * NTHREADS) scr[(5 << 20) + i] = p.mod[i];
  if (nph >= 7) for (int r = gw; r < NLAT; r += nw) { float s = 0.f; for (int c = lane; c < D; c += 64) s += p.out[(size_t)r * D + c] * (1 + (c & 7)); s = wave_sum(s); if (lane == 0) scr[(6 << 20) + r] = s; }
  if (nph >= 10 && nph <= 11) for (int r = gw; r < NTOK; r += nw) { float s = 0.f; for (int c = lane; c < 128; c += 64) { const u32x2 e = p.sel[(size_t)r * 128 + c]; s += __uint_as_float(e.y) * (float)(e.x & 1023); } s = wave_sum(s); if (lane == 0) scr[(7 << 20) + r] = s; }
}
__global__ void __launch_bounds__(NTHREADS) dbg_out(Params p, const float* scr) {
  for (size_t i = (size_t)blockIdx.x * NTHREADS + threadIdx.x; i < (size_t)NLAT * D; i += (size_t)gridDim.x * NTHREADS) p.out[i] = (i < (size_t)(8 << 20)) ? scr[i] : 0.f;
}
__global__ void __launch_bounds__(NTHREADS) dbg_zero(float* scr) {
  for (size_t i = (size_t)blockIdx.x * NTHREADS + threadIdx.x; i < (size_t)(8 << 20); i += (size_t)gridDim.x * NTHREADS) scr[i] = 0.f;
}
#endif
template <int PH>
static void launch_phases(const Params& p, int grid, hipStream_t stream) {
  static bool attr_set = false;
  if (!attr_set) { (void)hipFuncSetAttribute((const void*)phase_k<PH>, hipFuncAttributeMaxDynamicSharedMemorySize, LDS_BYTES); attr_set = true; }
  phase_k<PH><<<grid, NTHREADS, LDS_BYTES, stream>>>(p);
  if constexpr (PH + 1 < (DBG_NPH ? DBG_NPH : NPH)) launch_phases<PH + 1>(p, grid, stream);
}

extern "C" void kernel_launch(void* const* d_in, const int* in_sizes, int n_in, void* d_out, int out_size, void* d_ws,
                              size_t ws_size, hipStream_t stream) {
  Params p{};
  const float* const* in = (const float* const*)d_in;
  p.x = in[0]; p.c = in[1]; p.ctx = in[2]; p.c_ctx = in[3]; p.ada_w = in[4]; p.ada_b = in[5]; p.mix_g = in[6]; p.ffn_g = in[7];
  p.ev_w_in = in[8]; p.ev_w_out = in[9]; p.logit_f = in[10]; p.logit_b = in[11]; p.conv_w = in[12]; p.od_w_in = in[13];
  p.od_w_out = in[14]; p.sinks = in[15]; p.peer_wq = in[16]; p.keys1 = in[17]; p.keys2 = in[18]; p.peer_u = in[19];
  p.peer_v = in[20]; p.final_g = in[21];
  p.out = (float*)d_out;
  unsigned char* w = (unsigned char*)d_ws;
  size_t off = 0;
  auto take = [&](size_t bytes) { unsigned char* r = w + off; off += (bytes + 255) & ~(size_t)255; return r; };
  p.mod = (float*)take((size_t)2 * 33 * MODW * 4);
  p.ropec = (float*)take(1024 * 4);
  p.ropes = (float*)take(1024 * 4);
  p.winT0 = (bf16_t*)take((size_t)3072 * 1024 * 2);
  p.woutT0 = (bf16_t*)take((size_t)1024 * 1024 * 2);
  p.winT1 = (bf16_t*)take((size_t)1536 * 1024 * 2);
  p.woutT1 = (bf16_t*)take((size_t)1024 * 1024 * 2);
  p.wqT = (bf16_t*)take((size_t)2 * 1024 * 1024 * 2);
  p.u8 = (unsigned char*)take((size_t)2 * NEXP * 768);
  p.v8 = (unsigned char*)take((size_t)2 * NEXP * 768);
  p.uscale = (float*)take((size_t)2 * NEXP * 4);
  p.vscale = (float*)take((size_t)2 * NEXP * 4);
  p.hctx = (float*)take((size_t)NCTX * D * 4);
  p.act = (bf16_t*)take((size_t)NTOK * D * 2);
  p.kv = (float*)take((size_t)2304 * 16384 * 4);
  p.sprev = (bf16_t*)take((size_t)2304 * 16384 * 2);
  p.bar = (unsigned*)take((size_t)XCD_BAR_WORDS * 4);
  p.keysb = (bf16_t*)take((size_t)2 * 8 * 2 * 2 * 128 * 64 * 2);
  p.proj = (bf16_t*)take((size_t)NTOK * 3072 * 2);
  p.pq = p.proj;
  p.sel = (u32x2*)((unsigned char*)p.proj + (size_t)NTOK * D * 2);
  if (off > ws_size) { fprintf(stderr, "workspace too small: need %zu have %zu\n", off, ws_size); }

  int grid = 256;
#if MK_ONE_LAUNCH
  static int grid_blocks = 0;
  if (!grid_blocks) {
    (void)hipFuncSetAttribute((const void*)mega, hipFuncAttributeMaxDynamicSharedMemorySize, LDS_BYTES);
    int dev = 0, cus = 0, per_cu = 0;
    (void)hipGetDevice(&dev);
    (void)hipDeviceGetAttribute(&cus, hipDeviceAttributeMultiprocessorCount, dev);
    (void)hipOccupancyMaxActiveBlocksPerMultiprocessor(&per_cu, mega, NTHREADS, LDS_BYTES);
    if (per_cu > 1) per_cu = 1;
    grid_blocks = cus * per_cu;
    if (grid_blocks <= 0) grid_blocks = 256;
  }
  grid = grid_blocks;
  (void)hipMemsetAsync(p.bar, 0, (size_t)XCD_BAR_WORDS * 4, stream);
  void* args[] = {&p};
  hipError_t e = hipLaunchCooperativeKernel((const void*)mega, dim3(grid), dim3(NTHREADS), args, LDS_BYTES, stream);
  if (e != hipSuccess) fprintf(stderr, "cooperative launch failed: %s\n", hipGetErrorString(e));
#else
  launch_phases<0>(p, grid, stream);
#if DBG_NPH
  float* scr = (float*)(w + off);
  dbg_zero<<<grid, NTHREADS, 0, stream>>>(scr);
  dbg_sums<<<grid, NTHREADS, 0, stream>>>(p, scr, DBG_NPH);
  dbg_out<<<grid, NTHREADS, 0, stream>>>(p, scr);
#endif
#endif
}
```

```cpp
#include <hip/hip_runtime.h>
#include <hip/hip_cooperative_groups.h>
#include <cstdio>
#include <cstdint>
namespace cg = cooperative_groups;

#ifndef MK_ONE_LAUNCH
#define MK_ONE_LAUNCH 1
#endif

typedef unsigned short bf16_t;
typedef short bf16x8 __attribute__((ext_vector_type(8)));
typedef short bf16x2v __attribute__((ext_vector_type(2)));
typedef float f32x4 __attribute__((ext_vector_type(4)));
typedef unsigned u32x4 __attribute__((ext_vector_type(4)));
typedef unsigned u32x2 __attribute__((ext_vector_type(2)));
typedef unsigned u32x6 __attribute__((ext_vector_type(6)));
typedef unsigned u32x16 __attribute__((ext_vector_type(16)));
typedef float f32x32 __attribute__((ext_vector_type(32)));
typedef __bf16 bf16x32n __attribute__((ext_vector_type(32)));

constexpr int D = 1024, BATCH = 32, SEQ = 2048, CTXL = 256;
constexpr int NCTX = BATCH * CTXL;
constexpr int NLAT = BATCH * SEQ;
constexpr int NTOK = NCTX + NLAT;
constexpr int MODW = 6 * D;
constexpr int NEXP = 16384;
constexpr float EPS = 1e-6f;
constexpr int NTHREADS = 512;
constexpr int LDS_BYTES = 140 * 1024;

struct Params {
  const float *x, *c, *ctx, *c_ctx, *ada_w, *ada_b, *mix_g, *ffn_g, *ev_w_in, *ev_w_out, *logit_f, *logit_b, *conv_w,
      *od_w_in, *od_w_out, *sinks, *peer_wq, *keys1, *keys2, *peer_u, *peer_v, *final_g;
  float* out;
  float* mod;
  float* ropec;
  float* ropes;
  bf16_t* winT0;
  bf16_t* woutT0;
  bf16_t* winT1;
  bf16_t* woutT1;
  bf16_t* wqT;
  unsigned char* u8;
  unsigned char* v8;
  float* uscale;
  float* vscale;
  float* hctx;
  bf16_t* act;
  bf16_t* proj;
  bf16_t* pq;
  u32x2* sel;
  float* kv;
  bf16_t* sprev;
  bf16_t* keysb;
  unsigned* bar;
};

typedef __bf16 bf16x2n __attribute__((ext_vector_type(2)));
typedef float f32x2 __attribute__((ext_vector_type(2)));
__device__ __forceinline__ unsigned cvt_pk_bf16(float lo, float hi) {
  f32x2 v = {lo, hi};
  return __builtin_bit_cast(unsigned, __builtin_convertvector(v, bf16x2n));
}
__device__ __forceinline__ float bf_lo(unsigned u) { return __uint_as_float(u << 16); }
__device__ __forceinline__ float bf_hi(unsigned u) { return __uint_as_float(u & 0xffff0000u); }
__device__ __forceinline__ float bf2f(bf16_t h) { return __uint_as_float(((unsigned)h) << 16); }
__device__ __forceinline__ bf16_t f2bf(float f) { return __builtin_bit_cast(unsigned short, (__bf16)f); }

template <int CTRL>
__device__ __forceinline__ float dppf(float x) {
  return __builtin_bit_cast(float, __builtin_amdgcn_mov_dpp(__builtin_bit_cast(int, x), CTRL, 0xf, 0xf, true));
}
template <int CTRL>
__device__ __forceinline__ unsigned dppu(unsigned x) { return (unsigned)__builtin_amdgcn_mov_dpp((int)x, CTRL, 0xf, 0xf, true); }
__device__ __forceinline__ float row16_sum(float x) {
  x += dppf<0xB1>(x); x += dppf<0x4E>(x); x += dppf<0x141>(x); x += dppf<0x128>(x);
  return x;
}
__device__ __forceinline__ float row16_max(float x) {
  x = fmaxf(x, dppf<0xB1>(x)); x = fmaxf(x, dppf<0x4E>(x)); x = fmaxf(x, dppf<0x141>(x)); x = fmaxf(x, dppf<0x128>(x));
  return x;
}
__device__ __forceinline__ float xrow16_sum(float x) {
  auto s = __builtin_amdgcn_permlane16_swap(__float_as_uint(x), __float_as_uint(x), false, false);
  x = __uint_as_float(s[0]) + __uint_as_float(s[1]);
  auto t = __builtin_amdgcn_permlane32_swap(__float_as_uint(x), __float_as_uint(x), false, false);
  return __uint_as_float(t[0]) + __uint_as_float(t[1]);
}
__device__ __forceinline__ float wave_sum(float x) { return xrow16_sum(row16_sum(x)); }
__device__ __forceinline__ float wave_max(float x) {
  x = row16_max(x);
  auto s = __builtin_amdgcn_permlane16_swap(__float_as_uint(x), __float_as_uint(x), false, false);
  x = fmaxf(__uint_as_float(s[0]), __uint_as_float(s[1]));
  auto t = __builtin_amdgcn_permlane32_swap(__float_as_uint(x), __float_as_uint(x), false, false);
  return fmaxf(__uint_as_float(t[0]), __uint_as_float(t[1]));
}

__device__ __forceinline__ int tidx() {
  int t = threadIdx.x;
  asm volatile("" : "+v"(t));
  __builtin_assume(t >= 0 && t < NTHREADS);
  return t;
}
__device__ __forceinline__ float siluf(float v) { return v / (1.f + __expf(-v)); }
__device__ __forceinline__ float log_sigmoidf(float v) { return -log1pf(expf(-v)); }

#define LAS __attribute__((address_space(3)))
constexpr int BM = 256, BK = 64, HALF = 128, HTB = HALF * BK * 2, NXCD = 8, WGM = 8;
constexpr int KDIM = 1024;

__device__ __forceinline__ int lds_byte(int r, int c) {
  const int st = (r >> 4) * 2 + (c >> 5), rr = r & 15, cc = c & 31, ob = rr * 64 + cc * 2;
  return st * 1024 + (ob ^ (((ob >> 9) & 1) << 5));
}
__device__ __forceinline__ void stage_rc(int b, int& R, int& C) {
  const int st = b / 1024, sb = b % 1024, swz = sb ^ (((sb >> 9) & 1) << 5);
  R = (st >> 1) * 16 + swz / 64;
  C = (st & 1) * 32 + (swz % 64) / 2;
}
__device__ __forceinline__ int perm32(int rho) { const int n = rho >> 4, i = rho & 15; return 8 * (i >> 2) + 4 * n + (i & 3); }
struct Sched {
  int pm0, pn0, nM, nN, G, c;
  __device__ __forceinline__ bool next(int i, int& pm, int& pn) const {
    const int nwg = nM * nN;
    const long L = (long)i * G + c;
    if (L >= nwg) return false;
    int wgid = (int)L;
    { const int q = nwg / NXCD, r = nwg % NXCD, xcd = wgid % NXCD, off = wgid / NXCD; wgid = (xcd < r ? xcd * (q + 1) : r * (q + 1) + (xcd - r) * q) + off; }
    const int nig = WGM * nN, gid = wgid / nig, fm = gid * WGM, gsz = (nM - fm) < WGM ? (nM - fm) : WGM;
    pm = pm0 + fm + ((wgid % nig) % gsz);
    pn = pn0 + (wgid % nig) / gsz;
    return true;
  }
};

template <class Epi>
__device__ __forceinline__ void gemm_phase(LAS unsigned char* lds, const bf16_t* __restrict__ Ag, const bf16_t* __restrict__ Btg, const Sched& S, const Epi& E) {
  const int tid = tidx(), wid = __builtin_amdgcn_readfirstlane(tid >> 6), lane = tid & 63, wr = wid >> 2, wc = wid & 3, fr = lane & 15, fq = lane >> 4;
  constexpr int K = KDIM, nt = K / BK;
  unsigned voffA[2], voffB[2];
#pragma unroll
  for (int i = 0; i < 2; ++i) { int R, C; stage_rc(tid * 16 + i * 8192, R, C); const int Rb = Epi::PERM ? ((R & ~31) + perm32(R & 31)) : R;
    voffA[i] = (unsigned)(R * K + C) * 2u; voffB[i] = (unsigned)(Rb * K + C) * 2u; }
  const size_t kstep = (size_t)(BK * 2);
  const size_t hstep = (size_t)HALF * K * 2;
  const size_t tstep = 2 * hstep;
  const unsigned ldsw = (unsigned)wid * 1024u;
  const int aoff = lds_byte(wr * 64 + fr, fq * 8), boff = lds_byte(wc * 32 + fr, fq * 8);
#define G_SA(b, h) (((b) * 2 + (h)) * HTB)
#define G_SB(b, h) ((4 + (b) * 2 + (h)) * HTB)
#define G_STAGEX(bufoff, gbase, VO) do { _Pragma("unroll") for (int _i = 0; _i < 2; ++_i) \
    __builtin_amdgcn_global_load_lds((const unsigned*)((const char*)(gbase) + VO[_i]), (LAS unsigned*)(lds + (bufoff) + ldsw + _i * 8192), 16, 0, 0); } while (0)
#define G_STAGE(bufoff, gbase) G_STAGEX(bufoff, gbase, voffA)
#define G_STAGEB(bufoff, gbase) G_STAGEX(bufoff, gbase, voffB)
#define G_LDA(dst, b, h) do { _Pragma("unroll") for (int m = 0; m < 4; ++m) _Pragma("unroll") for (int k = 0; k < 2; ++k) dst[m][k] = *(const LAS bf16x8*)(lds + G_SA(b, h) + aoff + m * 2048 + k * 1024); } while (0)
#define G_LDB(dst, b, h) do { _Pragma("unroll") for (int n = 0; n < 2; ++n) _Pragma("unroll") for (int k = 0; k < 2; ++k) dst[n][k] = *(const LAS bf16x8*)(lds + G_SB(b, h) + boff + n * 2048 + k * 1024); } while (0)
#define G_MMA(ai, bj, At, Bt) do { __builtin_amdgcn_s_setprio(1); _Pragma("unroll") for (int m = 0; m < 4; ++m) _Pragma("unroll") for (int n = 0; n < 2; ++n) _Pragma("unroll") for (int k = 0; k < 2; ++k) \
    acc[ai][bj][m][n] = __builtin_amdgcn_mfma_f32_16x16x32_bf16(Bt[n][k], At[m][k], acc[ai][bj][m][n], 0, 0, 0); __builtin_amdgcn_s_setprio(0); } while (0)
#define G_WAIT_V(n) asm volatile("s_waitcnt vmcnt(" #n ")" ::: "memory")
#define G_WAIT_L(n) asm volatile("s_waitcnt lgkmcnt(" #n ")" ::: "memory")
#define G_BAR __builtin_amdgcn_s_barrier()
#define G_SCHED __builtin_amdgcn_sched_barrier(0)
  int cpm, cpn, npm, npn, ui = 0;
  if (!S.next(0, cpm, cpn)) return;
  f32x4 acc[2][2][4][2];
#pragma unroll
  for (int a = 0; a < 2; ++a)
#pragma unroll
    for (int b = 0; b < 2; ++b)
#pragma unroll
      for (int m = 0; m < 4; ++m)
#pragma unroll
        for (int n = 0; n < 2; ++n) acc[a][b][m][n] = (f32x4){0.f, 0.f, 0.f, 0.f};
  bf16x8 At[4][2], B0[2][2], B1[2][2];
  const char* cA = (const char*)Ag + (size_t)cpm * tstep;
  const char* cB = (const char*)Btg + (size_t)cpn * tstep;
  G_STAGEB(G_SB(0, 0), cB); G_STAGE(G_SA(0, 0), cA); G_STAGEB(G_SB(0, 1), cB + hstep); G_STAGE(G_SA(0, 1), cA + hstep);
  if (wr == 1) G_BAR;
  G_WAIT_V(4); G_BAR;
  G_STAGEB(G_SB(1, 0), cB + kstep); G_STAGE(G_SA(1, 0), cA + kstep); G_STAGEB(G_SB(1, 1), cB + hstep + kstep);
  G_WAIT_V(6); G_BAR;
  for (;;) {
    const bool has_next = S.next(ui + 1, npm, npn);
    const char* nA = has_next ? (const char*)Ag + (size_t)npm * tstep : cA;
    const char* nB = has_next ? (const char*)Btg + (size_t)npn * tstep : cB;
    for (int t = 0; t < nt; t += 2) {
      const bool last = (t == nt - 2);
      const char* a1 = cA + (size_t)(t + 1) * kstep;
      const char* a2 = last ? nA : cA + (size_t)(t + 2) * kstep;
      const char* b2 = last ? nB : cB + (size_t)(t + 2) * kstep;
      const char* a3 = a2 + kstep;
      const char* b3 = b2 + kstep;
      G_LDB(B0, 0, 0); G_SCHED; G_LDA(At, 0, 0); G_STAGE(G_SA(1, 1), a1 + hstep);
      G_WAIT_L(8); G_BAR; G_WAIT_L(0); G_MMA(0, 0, At, B0); G_BAR; G_SCHED;
      G_LDB(B1, 0, 1); G_STAGEB(G_SB(0, 0), b2);
      G_BAR; G_WAIT_L(0); G_MMA(0, 1, At, B1); G_BAR;
      G_LDA(At, 0, 1); G_STAGE(G_SA(0, 0), a2);
      G_BAR; G_WAIT_L(0); G_MMA(1, 0, At, B0); G_BAR; G_SCHED;
      G_STAGEB(G_SB(0, 1), b2 + hstep);
      G_WAIT_V(6); G_BAR; G_MMA(1, 1, At, B1); G_BAR;
      G_LDB(B0, 1, 0); G_SCHED; G_LDA(At, 1, 0); G_STAGE(G_SA(0, 1), a2 + hstep);
      G_WAIT_L(8); G_BAR; G_WAIT_L(0); G_MMA(0, 0, At, B0); G_BAR; G_SCHED;
      G_LDB(B1, 1, 1); G_STAGEB(G_SB(1, 0), b3);
      G_BAR; G_WAIT_L(0); G_MMA(0, 1, At, B1); G_BAR;
      G_LDA(At, 1, 1); G_STAGE(G_SA(1, 0), a3);
      G_BAR; G_WAIT_L(0); G_MMA(1, 0, At, B0); G_BAR; G_SCHED;
      G_STAGEB(G_SB(1, 1), b3 + hstep);
      G_WAIT_V(6); G_BAR; G_MMA(1, 1, At, B1); G_BAR;
    }
    E(acc, cpm * BM, cpn * BM, wr, wc, fr, fq);
    if (!has_next) break;
#pragma unroll
    for (int a = 0; a < 2; ++a)
#pragma unroll
      for (int b = 0; b < 2; ++b)
#pragma unroll
        for (int m = 0; m < 4; ++m)
#pragma unroll
          for (int n = 0; n < 2; ++n) acc[a][b][m][n] = (f32x4){0.f, 0.f, 0.f, 0.f};
    cpm = npm; cpn = npn; cA = nA; cB = nB; ++ui;
  }
  G_WAIT_V(0);
  if (wr == 0) G_BAR;
  G_BAR;
#undef G_SA
#undef G_SB
#undef G_STAGE
#undef G_STAGEB
#undef G_STAGEX
#undef G_LDA
#undef G_LDB
#undef G_MMA
}

__device__ __forceinline__ f32x4 xlane32(const f32x4 v, const bool upper) {
  f32x4 r;
#pragma unroll
  for (int j = 0; j < 4; ++j) {
    const float x = v[j];
    auto t = __builtin_amdgcn_permlane32_swap(__float_as_uint(x), __float_as_uint(x), false, false);
    r[j] = __uint_as_float(upper ? t[0] : t[1]);
  }
  return r;
}
struct EpiInProj {
  static constexpr bool PERM = true;
  bf16_t* P; int ldc; int layer; const float* cosT; const float* sinT;
  __device__ __forceinline__ void operator()(const f32x4 (&acc)[2][2][4][2], int brow, int bcol, int wr, int wc, int fr, int fq) const {
#pragma unroll
    for (int bj = 0; bj < 2; ++bj) {
      const int colbase = bcol + bj * HALF + wc * 32;
      bool rope, scl;
      if (layer == 0) { rope = colbase < 512; scl = (colbase >= 256 && colbase < 512); }
      else { rope = colbase < 1280; scl = colbase < 1024; }
      const float sq = layer == 1 ? 0.125f * 1.44269504089f : 0.125f;
#pragma unroll
      for (int ai = 0; ai < 2; ++ai)
#pragma unroll
        for (int m = 0; m < 4; ++m) {
          const int row = brow + ai * HALF + wr * 64 + m * 16 + fr;
          f32x4 v0 = acc[ai][bj][m][0], v1 = acc[ai][bj][m][1];
          if (rope && brow >= NCTX) {
            const bool upper = fq >= 2;
            const f32x4 o0 = xlane32(v0, upper), o1 = xlane32(v1, upper);
            const int t = (row - NCTX) & (SEQ - 1);
            const int pos = (wc & 1) ? (t & 63) : (t >> 6);
            const float* ct = cosT + pos * 16 + (fq & 1) * 8;
            const float* st = sinT + pos * 16 + (fq & 1) * 8;
            const f32x4 c0 = *(const f32x4*)ct, c1 = *(const f32x4*)(ct + 4);
            f32x4 s0 = *(const f32x4*)st, s1 = *(const f32x4*)(st + 4);
            if (!upper) { s0 = -s0; s1 = -s1; }
            v0 = v0 * c0 + o0 * s0;
            v1 = v1 * c1 + o1 * s1;
          }
          if (scl) { v0 *= sq; v1 *= sq; }
          u32x4 w;
          w.x = cvt_pk_bf16(v0[0], v0[1]); w.y = cvt_pk_bf16(v0[2], v0[3]);
          w.z = cvt_pk_bf16(v1[0], v1[1]); w.w = cvt_pk_bf16(v1[2], v1[3]);
          *(u32x4*)(P + (size_t)row * ldc + colbase + fq * 8) = w;
        }
    }
  }
};
struct EpiBf16 {
  static constexpr bool PERM = true;
  bf16_t* P; int ldc;
  __device__ __forceinline__ void operator()(const f32x4 (&acc)[2][2][4][2], int brow, int bcol, int wr, int wc, int fr, int fq) const {
#pragma unroll
    for (int ai = 0; ai < 2; ++ai)
#pragma unroll
      for (int m = 0; m < 4; ++m) {
        const int row = brow + ai * HALF + wr * 64 + m * 16 + fr;
#pragma unroll
        for (int bj = 0; bj < 2; ++bj) {
          const f32x4 v0 = acc[ai][bj][m][0], v1 = acc[ai][bj][m][1];
          u32x4 w;
          w.x = cvt_pk_bf16(v0[0], v0[1]); w.y = cvt_pk_bf16(v0[2], v0[3]);
          w.z = cvt_pk_bf16(v1[0], v1[1]); w.w = cvt_pk_bf16(v1[2], v1[3]);
          *(u32x4*)(P + (size_t)row * ldc + bcol + bj * HALF + wc * 32 + fq * 8) = w;
        }
      }
  }
};
struct EpiGate {
  static constexpr bool PERM = true;
  bf16_t* M; const float* gate;
  __device__ __forceinline__ void operator()(const f32x4 (&acc)[2][2][4][2], int brow, int bcol, int wr, int wc, int fr, int fq) const {
    const int b = brow < NCTX ? 32 : ((brow - NCTX) >> 11);
    const float* g = gate + (size_t)b * MODW;
#pragma unroll
    for (int bj = 0; bj < 2; ++bj) {
      const int col = bcol + bj * HALF + wc * 32 + fq * 8;
      const f32x4 g0 = *(const f32x4*)(g + col), g1 = *(const f32x4*)(g + col + 4);
#pragma unroll
      for (int ai = 0; ai < 2; ++ai)
#pragma unroll
        for (int m = 0; m < 4; ++m) {
          const int row = brow + ai * HALF + wr * 64 + m * 16 + fr;
          const f32x4 v0 = acc[ai][bj][m][0] * g0, v1 = acc[ai][bj][m][1] * g1;
          u32x4 w;
          w.x = cvt_pk_bf16(v0[0], v0[1]); w.y = cvt_pk_bf16(v0[2], v0[3]);
          w.z = cvt_pk_bf16(v1[0], v1[1]); w.w = cvt_pk_bf16(v1[2], v1[3]);
          *(u32x4*)(M + (size_t)row * D + col) = w;
        }
    }
  }
};
struct EpiResid {
  static constexpr bool PERM = false;
  const float* hin_ctx; const float* hin_lat; float* hout_ctx; float* hout_lat; const float* gate;
  __device__ __forceinline__ void operator()(const f32x4 (&acc)[2][2][4][2], int brow, int bcol, int wr, int wc, int fr, int fq) const {
    const bool isctx = brow < NCTX;
    const int b = isctx ? 32 : ((brow - NCTX) >> 11);
    const float* hin = isctx ? hin_ctx + (size_t)brow * D : hin_lat + (size_t)(brow - NCTX) * D;
    float* hout = isctx ? hout_ctx + (size_t)brow * D : hout_lat + (size_t)(brow - NCTX) * D;
    const float* g = gate + (size_t)b * MODW;
#pragma unroll
    for (int bj = 0; bj < 2; ++bj)
#pragma unroll
      for (int n = 0; n < 2; ++n) {
        const int col = bcol + bj * HALF + wc * 32 + n * 16 + fq * 4;
        const f32x4 gv = *(const f32x4*)(g + col);
#pragma unroll
        for (int ai = 0; ai < 2; ++ai)
#pragma unroll
          for (int m = 0; m < 4; ++m) {
            const int r = ai * HALF + wr * 64 + m * 16 + fr;
            const f32x4 h = *(const f32x4*)(hin + (size_t)r * D + col);
            *(f32x4*)(hout + (size_t)r * D + col) = h + gv * acc[ai][bj][m][n];
          }
      }
  }
};

template <int MT, int NT>
__device__ __forceinline__ void mm_lds(const bf16_t* A, int lda, const bf16_t* B, int ldb, int K, f32x4 (&acc)[MT][NT], int fr, int fq) {
  for (int k0 = 0; k0 < K; k0 += 32) {
    bf16x8 af[MT], bf[NT];
#pragma unroll
    for (int m = 0; m < MT; ++m) af[m] = *(const bf16x8*)(A + (m * 16 + fr) * lda + k0 + fq * 8);
#pragma unroll
    for (int n = 0; n < NT; ++n) bf[n] = *(const bf16x8*)(B + (n * 16 + fr) * ldb + k0 + fq * 8);
#pragma unroll
    for (int m = 0; m < MT; ++m)
#pragma unroll
      for (int n = 0; n < NT; ++n) acc[m][n] = __builtin_amdgcn_mfma_f32_16x16x32_bf16(af[m], bf[n], acc[m][n], 0, 0, 0);
  }
}

__device__ void phase_prep(const Params& p, unsigned char* smem, int bid, int nb) {
  const int tid = tidx();
  for (int it = bid; it < 2 * 96; it += nb) {
    const int layer = it / 96, n0 = (it % 96) * 64;
    float* s = (float*)smem;
    for (int i = tid; i < 33 * 1024; i += NTHREADS) {
      const int b = i >> 10, k = i & 1023;
      const float v = (b < 32) ? p.c[b * 1024 + k] : p.c_ctx[k];
      s[k * 33 + b] = siluf(v);
    }
    __syncthreads();
    const int col = tid & 63, kg = tid >> 6;
    float acc[33];
#pragma unroll
    for (int b = 0; b < 33; ++b) acc[b] = 0.f;
    const float* W = p.ada_w + (size_t)layer * 1024 * MODW + n0 + col;
    for (int k = kg * 128; k < kg * 128 + 128; ++k) {
      const float w = W[(size_t)k * MODW];
      const float* sk = s + k * 33;
#pragma unroll
      for (int b = 0; b < 33; ++b) acc[b] += sk[b] * w;
    }
    __syncthreads();
    float* red = (float*)smem;
#pragma unroll
    for (int b = 0; b < 33; ++b) red[(kg * 33 + b) * 64 + col] = acc[b];
    __syncthreads();
    for (int i = tid; i < 33 * 64; i += NTHREADS) {
      const int b = i >> 6, cc = i & 63;
      float t = p.ada_b[layer * MODW + n0 + cc];
#pragma unroll
      for (int g = 0; g < 8; ++g) t += red[(g * 33 + b) * 64 + cc];
      p.mod[((size_t)layer * 33 + b) * MODW + n0 + cc] = t;
    }
    __syncthreads();
  }
  if (bid == nb - 1) {
    for (int i = tid; i < 1024; i += NTHREADS) {
      const int pos = i >> 4, f = i & 15;
      const float inv = powf(10000.f, -(float)f / 16.f);
      const float ang = (float)pos * inv;
      p.ropec[i] = cosf(ang);
      p.ropes[i] = sinf(ang);
    }
  }
  {
    float* tile = (float*)smem;
    const int ntile_total = 768 + 256 + 384 + 256 + 512;
    for (int it = bid; it < ntile_total; it += nb) {
      const float* src; bf16_t* dst; int N, ti;
      if (it < 768) { src = p.ev_w_in; dst = p.winT0; N = 3072; ti = it; }
      else if (it < 1024) { src = p.ev_w_out; dst = p.woutT0; N = 1024; ti = it - 768; }
      else if (it < 1408) { src = p.od_w_in; dst = p.winT1; N = 1536; ti = it - 1024; }
      else if (it < 1664) { src = p.od_w_out; dst = p.woutT1; N = 1024; ti = it - 1408; }
      else { const int l = (it - 1664) / 256; src = p.peer_wq + (size_t)l * 1024 * 1024; dst = p.wqT + (size_t)l * 1024 * 1024; N = 1024; ti = (it - 1664) % 256; }
      const int ntn = N / 64, tk = ti / ntn, tn = ti % ntn;
      __syncthreads();
      for (int i = tid; i < 64 * 64; i += NTHREADS) {
        const int r = i >> 6, cc = i & 63;
        tile[r * 65 + cc] = src[(size_t)(tk * 64 + r) * N + tn * 64 + cc];
      }
      __syncthreads();
      for (int i = tid; i < 64 * 32; i += NTHREADS) {
        const int nn = i >> 5, kk = (i & 31) * 2;
        const unsigned w = cvt_pk_bf16(tile[kk * 65 + nn], tile[(kk + 1) * 65 + nn]);
        *(unsigned*)(dst + (size_t)(tn * 64 + nn) * 1024 + tk * 64 + kk) = w;
      }
    }
    __syncthreads();
  }
  for (int idx = bid * NTHREADS + tid; idx < 2 * 8 * 2 * 128 * 64; idx += nb * NTHREADS) {
    const int d = idx & 63, k = (idx >> 6) & 127, s = (idx >> 13) & 1, hh = (idx >> 14) & 7, l = idx >> 17;
    const float v = (s ? p.keys2 : p.keys1)[((size_t)(l * 8 + hh) * 128 + k) * 64 + d];
    const bf16_t hi = f2bf(v);
    const bf16_t lo = f2bf(v - bf2f(hi));
    const size_t o = ((size_t)((l * 8 + hh) * 2 + s) * 2) * 8192 + (size_t)k * 64 + d;
    p.keysb[o] = hi;
    p.keysb[o + 8192] = lo;
  }
  {
    const int wid = tid >> 6, lane = tid & 63, hw = lane >> 5, L = lane & 31, bb = L >> 3, ii = L & 7;
    for (int r = (bid * 8 + wid) * 2 + hw; r < 4 * NEXP; r += nb * 16) {
      const bool isv = r >= 2 * NEXP;
      const int rr = isv ? r - 2 * NEXP : r;
      const float* src = (isv ? p.peer_v : p.peer_u) + (size_t)rr * D + bb * 256 + ii * 32;
      f32x4 a[8];
      float mx = 0.f;
#pragma unroll
      for (int q = 0; q < 8; ++q) {
        a[q] = *(const f32x4*)(src + q * 4);
        mx = fmaxf(mx, fmaxf(fmaxf(fabsf(a[q][0]), fabsf(a[q][1])), fmaxf(fabsf(a[q][2]), fabsf(a[q][3]))));
      }
      mx = row16_max(mx);
      { auto sw = __builtin_amdgcn_permlane16_swap(__float_as_uint(mx), __float_as_uint(mx), false, false); mx = fmaxf(__uint_as_float(sw[0]), __uint_as_float(sw[1])); }
      const float sc = mx > 0.f ? 7.0f / mx : 1.f;
      u32x16 pk;
#pragma unroll
      for (int q = 0; q < 8; ++q) { pk[2 * q] = cvt_pk_bf16(a[q][0] * sc, a[q][1] * sc); pk[2 * q + 1] = cvt_pk_bf16(a[q][2] * sc, a[q][3] * sc); }
      const u32x6 w = __builtin_amdgcn_cvt_scalef32_pk32_fp6_bf16(__builtin_bit_cast(bf16x32n, pk), 1.0f);
      unsigned char* dst = (isv ? p.v8 : p.u8) + (size_t)rr * 768 + ii * 16;
#pragma unroll
      for (int m = 0; m < 6; ++m) {
        const int sidx = 6 * bb + m;
        const unsigned wm = w[m];
        *(unsigned*)(dst + (sidx >> 2) * 128 + (sidx & 3) * 4) = wm;
      }
      if (L == 0) (isv ? p.vscale : p.uscale)[rr] = mx > 0.f ? mx / 7.0f : 1.f;
    }
  }
}

__device__ void phase_resid_norm(const Params& p, int bid, int nb, int row0, int row1, const float* hin_ctx, const float* hin_lat,
                                 const float* gain, const float* modl) {
  const int tid0 = tidx();
  const int wid = tid0 >> 6, lane = tid0 & 63;
  for (int rowa = row0 + (bid * 8 + wid) * 2; rowa < row1; rowa += nb * 16) {
    f32x4 v[2][4];
    float ss[2] = {0.f, 0.f};
#pragma unroll
    for (int r = 0; r < 2; ++r) {
      const int row = rowa + r;
      const bool isctx = row < NCTX;
      const float* h = isctx ? hin_ctx + (size_t)row * D : hin_lat + (size_t)(row - NCTX) * D;
      const bf16_t* mrow = p.pq + (size_t)row * D;
#pragma unroll
      for (int i = 0; i < 4; ++i) {
        const f32x4 hv = *(const f32x4*)(h + i * 256 + lane * 4);
        const u32x2 mv = *(const u32x2*)(mrow + i * 256 + lane * 4);
        v[r][i][0] = hv[0] + bf_lo(mv.x); v[r][i][1] = hv[1] + bf_hi(mv.x); v[r][i][2] = hv[2] + bf_lo(mv.y); v[r][i][3] = hv[3] + bf_hi(mv.y);
      }
    }
#pragma unroll
    for (int r = 0; r < 2; ++r) {
      const int row = rowa + r;
      const bool isctx = row < NCTX;
      float* ho = isctx ? p.hctx + (size_t)row * D : p.out + (size_t)(row - NCTX) * D;
      const int b = isctx ? 32 : ((row - NCTX) >> 11);
      const float* sh = modl + (size_t)b * MODW + 3 * D;
      const float* sc = modl + (size_t)b * MODW + 4 * D;
#pragma unroll
      for (int i = 0; i < 4; ++i) {
        *(f32x4*)(ho + i * 256 + lane * 4) = v[r][i];
        ss[r] += v[r][i][0] * v[r][i][0] + v[r][i][1] * v[r][i][1] + v[r][i][2] * v[r][i][2] + v[r][i][3] * v[r][i][3];
      }
      const float rstd = rsqrtf(wave_sum(ss[r]) * (1.f / D) + EPS);
#pragma unroll
      for (int i = 0; i < 4; ++i) {
        const int col = i * 256 + lane * 4;
        const f32x4 g = *(const f32x4*)(gain + col), s1 = *(const f32x4*)(sc + col), s0 = *(const f32x4*)(sh + col);
        f32x4 y = v[r][i] * rstd * g;
        y = y * (1.f + s1) + s0;
        u32x2 w; w.x = cvt_pk_bf16(y[0], y[1]); w.y = cvt_pk_bf16(y[2], y[3]);
        *(u32x2*)(p.act + (size_t)row * D + col) = w;
      }
    }
  }
}
__device__ void phase_norm(const Params& p, int bid, int nb, int row0, int row1, const float* hctx, const float* hlat,
                           const float* gain, const float* modl, int ish, int isc) {
  const int tid0 = tidx();
  const int wid = tid0 >> 6, lane = tid0 & 63;
  for (int rowa = row0 + (bid * 8 + wid) * 2; rowa < row1; rowa += nb * 16) {
    f32x4 v[2][4];
#pragma unroll
    for (int r = 0; r < 2; ++r) {
      const int row = rowa + r;
      const float* h = row < NCTX ? hctx + (size_t)row * D : hlat + (size_t)(row - NCTX) * D;
#pragma unroll
      for (int i = 0; i < 4; ++i) v[r][i] = *(const f32x4*)(h + i * 256 + lane * 4);
    }
#pragma unroll
    for (int r = 0; r < 2; ++r) {
      const int row = rowa + r;
      const int b = row < NCTX ? 32 : ((row - NCTX) >> 11);
      const float* sh = modl + (size_t)b * MODW + ish * D;
      const float* sc = modl + (size_t)b * MODW + isc * D;
      float ss = 0.f;
#pragma unroll
      for (int i = 0; i < 4; ++i) ss += v[r][i][0] * v[r][i][0] + v[r][i][1] * v[r][i][1] + v[r][i][2] * v[r][i][2] + v[r][i][3] * v[r][i][3];
      const float rstd = rsqrtf(wave_sum(ss) * (1.f / D) + EPS);
#pragma unroll
      for (int i = 0; i < 4; ++i) {
        const int col = i * 256 + lane * 4;
        const f32x4 g = *(const f32x4*)(gain + col), s1 = *(const f32x4*)(sc + col), s0 = *(const f32x4*)(sh + col);
        f32x4 y = v[r][i] * rstd * g;
        y = y * (1.f + s1) + s0;
        u32x2 w; w.x = cvt_pk_bf16(y[0], y[1]); w.y = cvt_pk_bf16(y[2], y[3]);
        *(u32x2*)(p.act + (size_t)row * D + col) = w;
      }
    }
  }
}

__device__ __forceinline__ void phase_gemm_inproj(const Params& p, unsigned char* smem, int bid, int nb, int layer) {
  LAS unsigned char* lds = (LAS unsigned char*)smem;
  if (layer == 0) {
    EpiInProj epi{p.proj, 3072, 0, p.ropec, p.ropes};
    Sched s{0, 0, NTOK / BM, 12, nb, bid};
    gemm_phase(lds, p.act, p.winT0, s, epi);
  } else {
    EpiInProj epi{p.proj, 1536, 1, p.ropec, p.ropes};
    Sched s{NCTX / BM, 0, NLAT / BM, 6, nb, bid};
    gemm_phase(lds, p.act, p.winT1, s, epi);
    Sched s2{0, 4, NCTX / BM, 2, nb, bid};
    gemm_phase(lds, p.act, p.winT1, s2, epi);
  }
}
__device__ __forceinline__ void phase_gemm_outproj(const Params& p, unsigned char* smem, int bid, int nb, int layer) {
  LAS unsigned char* lds = (LAS unsigned char*)smem;
  EpiGate epi{p.pq, p.mod + (size_t)layer * 33 * MODW + 2 * D};
  const int pm0 = layer == 0 ? 0 : NCTX / BM;
  Sched s{pm0, 0, NTOK / BM - pm0, 4, nb, bid};
  gemm_phase(lds, p.act, layer == 0 ? p.woutT0 : p.woutT1, s, epi);
}
__device__ __forceinline__ void phase_gemm_pq(const Params& p, unsigned char* smem, int bid, int nb, int layer) {
  LAS unsigned char* lds = (LAS unsigned char*)smem;
  EpiBf16 epi{p.pq, D};
  const int pm0 = layer == 0 ? 0 : NCTX / BM;
  Sched s{pm0, 0, NTOK / BM - pm0, 4, nb, bid};
  gemm_phase(lds, p.act, p.wqT + (size_t)layer * D * D, s, epi);
}

__device__ __forceinline__ int chunk_row0(int b, int cc) { return cc < 2 ? b * CTXL + cc * 128 : NCTX + b * SEQ + (cc - 2) * 128; }

constexpr int LDP = 136;
constexpr int LDK = 72;

typedef short s16x4 __attribute__((ext_vector_type(4)));
__device__ __forceinline__ bf16x8 tr_frag(const LAS bf16_t* base, int ld, int lane) {
  const int troff = ((lane & 15) >> 2) * ld + (lane & 3) * 4;
  const s16x4 v0 = __builtin_amdgcn_ds_read_tr16_b64_v4i16((LAS s16x4*)(base + troff));
  const s16x4 v1 = __builtin_amdgcn_ds_read_tr16_b64_v4i16((LAS s16x4*)(base + 16 * ld + troff));
  bf16x8 f;
  f[0] = v0[0]; f[1] = v0[1]; f[2] = v0[2]; f[3] = v0[3]; f[4] = v1[0]; f[5] = v1[1]; f[6] = v1[2]; f[7] = v1[3];
  return f;
}
__device__ void phase_ret_kv(const Params& p, unsigned char* smem, int bid, int nb) {
  const int tid = tidx(), wid = __builtin_amdgcn_readfirstlane(tid >> 6), lane = tid & 63, fr = lane & 15, fq = lane >> 4;
  LAS bf16_t* Kl = (LAS bf16_t*)smem;
  LAS bf16_t* Vl = Kl + 128 * LDK;
  const int NIT = BATCH * 4 * 18;
  u32x4 rk[2], rv[4];
#define RK_LOAD(IT)                                                                                                      \
  do {                                                                                                                   \
    const int _cc = (IT) % 18, _h = ((IT) / 18) & 3, _b = (IT) / 72;                                                     \
    const int _row0 = chunk_row0(_b, _cc);                                                                               \
    _Pragma("unroll") for (int c = 0; c < 2; ++c) { const int task = tid + c * NTHREADS; const int j = task >> 3, d0 = (task & 7) * 8; \
      rk[c] = *(const u32x4*)(p.proj + (size_t)(_row0 + j) * 3072 + 256 + _h * 64 + d0); }                              \
    _Pragma("unroll") for (int c = 0; c < 4; ++c) { const int task = tid + c * NTHREADS; const int j = task >> 4, e0 = (task & 15) * 8; \
      rv[c] = *(const u32x4*)(p.proj + (size_t)(_row0 + j) * 3072 + 512 + _h * 128 + e0); }                              \
  } while (0)
#define RK_STORE()                                                                                                       \
  do {                                                                                                                   \
    _Pragma("unroll") for (int c = 0; c < 2; ++c) { const int task = tid + c * NTHREADS; const int j = task >> 3, d0 = (task & 7) * 8; \
      *(LAS u32x4*)(Kl + j * LDK + d0) = rk[c]; }                                                                        \
    _Pragma("unroll") for (int c = 0; c < 4; ++c) { const int task = tid + c * NTHREADS; const int j = task >> 4, e0 = (task & 15) * 8; \
      *(LAS u32x4*)(Vl + j * LDP + e0) = rv[c]; }                                                                        \
  } while (0)
  RK_LOAD(bid);
  RK_STORE();
  __syncthreads();
  for (int it = bid; it < NIT; it += nb) {
    const int h = (it / 18) & 3;
    const float lf = log_sigmoidf(p.logit_f[h]), lb = log_sigmoidf(p.logit_b[h]);
    const bool more = it + nb < NIT;
    if (more) RK_LOAD(it + nb);
    bf16x8 af[4], ab[4];
#pragma unroll
    for (int ks = 0; ks < 4; ++ks) {
      const bf16x8 vf = tr_frag(Vl + (ks * 32 + fq * 4) * LDP + wid * 16, LDP, lane);
      const u32x4 vu = __builtin_bit_cast(u32x4, vf);
      u32x4 wf, wb;
#pragma unroll
      for (int q = 0; q < 4; ++q) {
        const int j0 = ks * 32 + (q >> 1) * 16 + fq * 4 + (q & 1) * 2;
        const float lo = bf_lo(vu[q]), hi = bf_hi(vu[q]);
        wf[q] = cvt_pk_bf16(lo * __expf(lf * (float)(127 - j0)), hi * __expf(lf * (float)(126 - j0)));
        wb[q] = cvt_pk_bf16(lo * __expf(lb * (float)j0), hi * __expf(lb * (float)(j0 + 1)));
      }
      af[ks] = __builtin_bit_cast(bf16x8, wf);
      ab[ks] = __builtin_bit_cast(bf16x8, wb);
    }
    float* out = p.kv + (size_t)it * 16384;
#pragma unroll
    for (int n = 0; n < 4; ++n) {
      f32x4 accf = {0.f, 0.f, 0.f, 0.f}, accb = {0.f, 0.f, 0.f, 0.f};
#pragma unroll
      for (int ks = 0; ks < 4; ++ks) {
        const bf16x8 kf = tr_frag(Kl + (ks * 32 + fq * 4) * LDK + n * 16, LDK, lane);
        accf = __builtin_amdgcn_mfma_f32_16x16x32_bf16(af[ks], kf, accf, 0, 0, 0);
        accb = __builtin_amdgcn_mfma_f32_16x16x32_bf16(ab[ks], kf, accb, 0, 0, 0);
      }
#pragma unroll
      for (int j = 0; j < 4; ++j) {
        out[(wid * 16 + fq * 4 + j) * 128 + n * 16 + fr] = accf[j];
        out[(wid * 16 + fq * 4 + j) * 128 + 64 + n * 16 + fr] = accb[j];
      }
    }
    __syncthreads();
    if (more) RK_STORE();
    __syncthreads();
  }
#undef RK_LOAD
#undef RK_STORE
  for (size_t task = (size_t)bid * NTHREADS + tid; task < (size_t)NTOK * 64; task += (size_t)nb * NTHREADS) {
    const int row = (int)(task >> 6), c0 = (int)(task & 63) * 8;
    const int tin = row < NCTX ? (row & (CTXL - 1)) : ((row - NCTX) & (SEQ - 1));
    const int tlen = row < NCTX ? CTXL : SEQ;
    const bf16_t* pr = p.proj + (size_t)row * 3072;
    const u32x4 gb = *(const u32x4*)(pr + 1536 + c0);
    float accv[8];
#pragma unroll
    for (int q = 0; q < 8; ++q) accv[q] = 0.f;
#pragma unroll
    for (int dt = -1; dt <= 1; ++dt) {
      if (tin + dt < 0 || tin + dt >= tlen) continue;
      const bf16_t* pr2 = pr + (ptrdiff_t)dt * 3072;
      const u32x4 gc = *(const u32x4*)(pr2 + 2048 + c0), xt = *(const u32x4*)(pr2 + 2560 + c0);
      const float* w = p.conv_w + (dt + 1) * 512 + c0;
      const f32x4 wa = *(const f32x4*)w, wb = *(const f32x4*)(w + 4);
#pragma unroll
      for (int q = 0; q < 4; ++q) {
        const float u0 = bf_lo(gc[q]) * bf_lo(xt[q]), u1 = bf_hi(gc[q]) * bf_hi(xt[q]);
        const float w0 = (2 * q < 4) ? wa[2 * q] : wb[2 * q - 4], w1 = (2 * q + 1 < 4) ? wa[2 * q + 1] : wb[2 * q + 1 - 4];
        accv[2 * q] += w0 * u0;
        accv[2 * q + 1] += w1 * u1;
      }
    }
    u32x4 o;
#pragma unroll
    for (int q = 0; q < 4; ++q) o[q] = cvt_pk_bf16(bf_lo(gb[q]) * accv[2 * q], bf_hi(gb[q]) * accv[2 * q + 1]);
#ifdef ZERO_CONV
    o = (u32x4){0u, 0u, 0u, 0u};
#endif
    *(u32x4*)(p.act + (size_t)row * D + 512 + c0) = o;
  }
}

__device__ void phase_ret_scan(const Params& p, int bid, int nb) {
  const int tid = tidx();
  for (size_t idx = (size_t)bid * NTHREADS + tid; idx < (size_t)BATCH * 4 * 16384; idx += (size_t)nb * NTHREADS) {
    const int el = (int)(idx & 16383), bh = (int)(idx >> 14), h = bh & 3;
    const bool fwd = (el & 127) < 64;
    const float lg = log_sigmoidf(fwd ? p.logit_f[h] : p.logit_b[h]);
    const float dec = __expf(lg * 128.f);
    float st = 0.f;
    for (int s = 0; s < 18; ++s) {
      const int cc = fwd ? s : (s < 2 ? 1 - s : 19 - s);
      const size_t off = ((size_t)bh * 18 + cc) * 16384 + el;
      p.sprev[off] = f2bf(st);
      st = dec * st + p.kv[off];
    }
  }
}

__device__ void phase_ret_out(const Params& p, unsigned char* smem, int bid, int nb) {
  const int tid = tidx(), wid = __builtin_amdgcn_readfirstlane(tid >> 6), lane = tid & 63, fr = lane & 15, fq = lane >> 4;
  LAS bf16_t* Kl = (LAS bf16_t*)smem;
  LAS bf16_t* Vl = Kl + 128 * LDK;
  LAS bf16_t* Sl = Vl + 128 * LDP;
  const int NIT = BATCH * 4 * 18;
  u32x4 rk[2], rv[4], rs[4];
  bf16x8 qfn[2];
#define RO_LOAD(IT)                                                                                                      \
  do {                                                                                                                   \
    const int _cc = (IT) % 18, _h = ((IT) / 18) & 3, _b = (IT) / 72;                                                     \
    const int _row0 = chunk_row0(_b, _cc);                                                                               \
    _Pragma("unroll") for (int c = 0; c < 2; ++c) { const int task = tid + c * NTHREADS; const int j = task >> 3, d0 = (task & 7) * 8; \
      rk[c] = *(const u32x4*)(p.proj + (size_t)(_row0 + j) * 3072 + 256 + _h * 64 + d0); }                              \
    _Pragma("unroll") for (int c = 0; c < 4; ++c) { const int task = tid + c * NTHREADS; const int j = task >> 4, e0 = (task & 15) * 8; \
      rv[c] = *(const u32x4*)(p.proj + (size_t)(_row0 + j) * 3072 + 512 + _h * 128 + e0);                               \
      rs[c] = *(const u32x4*)(p.sprev + (size_t)(IT) * 16384 + j * 128 + e0); }                                          \
    _Pragma("unroll") for (int ks = 0; ks < 2; ++ks) qfn[ks] = *(const bf16x8*)(p.proj + (size_t)(_row0 + wid * 16 + fr) * 3072 + _h * 64 + ks * 32 + fq * 8); \
  } while (0)
#define RO_STORE()                                                                                                       \
  do {                                                                                                                   \
    _Pragma("unroll") for (int c = 0; c < 2; ++c) { const int task = tid + c * NTHREADS; const int j = task >> 3, d0 = (task & 7) * 8; \
      *(LAS u32x4*)(Kl + j * LDK + d0) = rk[c]; }                                                                        \
    _Pragma("unroll") for (int c = 0; c < 4; ++c) { const int task = tid + c * NTHREADS; const int j = task >> 4, e0 = (task & 15) * 8; \
      *(LAS u32x4*)(Vl + j * LDP + e0) = rv[c]; *(LAS u32x4*)(Sl + j * LDP + e0) = rs[c]; }                              \
  } while (0)
  if (bid < NIT) { RO_LOAD(bid); __syncthreads(); RO_STORE(); }
  __syncthreads();
  for (int it = bid; it < NIT; it += nb) {
    const int cc = it % 18, h = (it / 18) & 3, b = it / 72;
    const int row0 = chunk_row0(b, cc);
    const float lf = log_sigmoidf(p.logit_f[h]), lb = log_sigmoidf(p.logit_b[h]);
    const int irow = wid * 16 + fr;
    bf16x8 qf[2];
    qf[0] = qfn[0]; qf[1] = qfn[1];
    const bool more = it + nb < NIT;
    if (more) RO_LOAD(it + nb);
    const size_t row = (size_t)(row0 + irow);
    u32x2 gg[8];
#pragma unroll
    for (int dn = 0; dn < 8; ++dn) gg[dn] = *(const u32x2*)(p.proj + row * 3072 + 1024 + h * 128 + dn * 16 + fq * 4);
    bf16x8 pb[4];
    {
      f32x4 st[8];
#pragma unroll
      for (int n = 0; n < 8; ++n) st[n] = (f32x4){0.f, 0.f, 0.f, 0.f};
#pragma unroll
      for (int ks = 0; ks < 2; ++ks)
#pragma unroll
        for (int n = 0; n < 8; ++n) {
          const bf16x8 kf = *(const LAS bf16x8*)(Kl + (n * 16 + fr) * LDK + ks * 32 + fq * 8);
          st[n] = __builtin_amdgcn_mfma_f32_16x16x32_bf16(kf, qf[ks], st[n], 0, 0, 0);
        }
#pragma unroll
      for (int n = 0; n < 8; ++n)
#pragma unroll
        for (int r = 0; r < 4; ++r) {
          const int df = irow - (n * 16 + fq * 4 + r);
          const float lg = df > 0 ? lf : lb;
          const float ex = __expf(lg * fabsf((float)df));
          st[n][r] *= (df == 0) ? 2.f : ex;
        }
#pragma unroll
      for (int kk = 0; kk < 4; ++kk) {
        u32x4 w;
        w.x = cvt_pk_bf16(st[2 * kk][0], st[2 * kk][1]); w.y = cvt_pk_bf16(st[2 * kk][2], st[2 * kk][3]);
        w.z = cvt_pk_bf16(st[2 * kk + 1][0], st[2 * kk + 1][1]); w.w = cvt_pk_bf16(st[2 * kk + 1][2], st[2 * kk + 1][3]);
        pb[kk] = __builtin_bit_cast(bf16x8, w);
      }
    }
    bf16x8 qx[4];
    {
      const float xf = __expf(lf * (float)(irow + 1)), xb = __expf(lb * (float)(128 - irow));
#pragma unroll
      for (int ks = 0; ks < 4; ++ks) {
        const float sc = ks < 2 ? xf : xb;
        const u32x4 qu = __builtin_bit_cast(u32x4, qf[ks & 1]);
        u32x4 qo;
#pragma unroll
        for (int q = 0; q < 4; ++q) { const unsigned w = qu[q]; qo[q] = cvt_pk_bf16(bf_lo(w) * sc, bf_hi(w) * sc); }
        qx[ks] = __builtin_bit_cast(bf16x8, qo);
      }
    }
    f32x4 ot[8];
#pragma unroll
    for (int dn = 0; dn < 8; ++dn) {
      f32x4 o = {0.f, 0.f, 0.f, 0.f};
#pragma unroll
      for (int kk = 0; kk < 4; ++kk) {
        const bf16x8 vf = tr_frag(Vl + (kk * 32 + fq * 4) * LDP + dn * 16, LDP, lane);
        o = __builtin_amdgcn_mfma_f32_16x16x32_bf16(vf, pb[kk], o, 0, 0, 0);
      }
#pragma unroll
      for (int ks = 0; ks < 4; ++ks) {
        const bf16x8 sf = *(const LAS bf16x8*)(Sl + (dn * 16 + fr) * LDP + ks * 32 + fq * 8);
        o = __builtin_amdgcn_mfma_f32_16x16x32_bf16(sf, qx[ks], o, 0, 0, 0);
      }
      ot[dn] = o;
    }
    float ss = 0.f;
#pragma unroll
    for (int dn = 0; dn < 8; ++dn) ss += ot[dn][0] * ot[dn][0] + ot[dn][1] * ot[dn][1] + ot[dn][2] * ot[dn][2] + ot[dn][3] * ot[dn][3];
    ss = xrow16_sum(ss);
    const float rstd = rsqrtf(ss * (1.f / 128.f) + EPS);
#pragma unroll
    for (int dn = 0; dn < 8; ++dn) {
      const int e0 = dn * 16 + fq * 4;
      const u32x2 g = gg[dn];
      u32x2 w;
#ifdef ZERO_RET
      w.x = 0u; w.y = 0u;
#else
      w.x = cvt_pk_bf16(ot[dn][0] * rstd * siluf(bf_lo(g.x)), ot[dn][1] * rstd * siluf(bf_hi(g.x)));
      w.y = cvt_pk_bf16(ot[dn][2] * rstd * siluf(bf_lo(g.y)), ot[dn][3] * rstd * siluf(bf_hi(g.y)));
#endif
      *(u32x2*)(p.act + row * D + h * 128 + e0) = w;
    }
    __syncthreads();
    if (more) RO_STORE();
    __syncthreads();
  }
#undef RO_LOAD
#undef RO_STORE
}

__device__ __forceinline__ float xrow16_max(float x) {
  auto s = __builtin_amdgcn_permlane16_swap(__float_as_uint(x), __float_as_uint(x), false, false);
  x = fmaxf(__uint_as_float(s[0]), __uint_as_float(s[1]));
  auto t = __builtin_amdgcn_permlane32_swap(__float_as_uint(x), __float_as_uint(x), false, false);
  return fmaxf(__uint_as_float(t[0]), __uint_as_float(t[1]));
}
template <int VAR>
__device__ void phase_attn(const Params& p, unsigned char* smem, int bid, int nb, bf16_t* outp) {
  const int tid = tidx(), wid = __builtin_amdgcn_readfirstlane(tid >> 6), lane = tid & 63, fr = lane & 15, fq = lane >> 4;
  LAS bf16_t* Kl = (LAS bf16_t*)smem;
  LAS bf16_t* Vl = Kl + 2 * 64 * LDK;
  LAS bf16_t* Ql = Vl + 2 * 64 * LDK + wid * 64 * LDK;
  const int sj = tid >> 3, sc8 = (tid & 7) * 8;
  const int troff = ((lane & 15) >> 2) * LDK + (lane & 3) * 4;
  for (int it = bid; it < BATCH * 16 * 4; it += nb) {
    const int kvh = it & 3, qb = (it >> 2) & 15, b = it >> 6;
    const int hq = kvh * 4 + (wid >> 1);
    const int q0 = qb * 128 + (wid & 1) * 64;
    const size_t latrow0 = (size_t)NCTX + (size_t)b * SEQ;
    const int tlo = qb == 0 ? 2 : 0, nwin = (qb == 15 ? 4 : 6) - tlo, ntile = nwin + 4;
#pragma unroll
    for (int m = 0; m < 4; ++m)
#pragma unroll
      for (int ks = 0; ks < 2; ++ks)
        *(LAS bf16x8*)(Ql + (m * 16 + fr) * LDK + ks * 32 + fq * 8) = *(const bf16x8*)(p.proj + (latrow0 + q0 + m * 16 + fr) * 1536 + hq * 64 + ks * 32 + fq * 8);
    const float sink = p.sinks[hq] * 1.44269504089f;
    float mrow[4], lrow[4];
    f32x4 ot[4][4];
#pragma unroll
    for (int m = 0; m < 4; ++m) {
      mrow[m] = sink; lrow[m] = (fq == 0) ? 1.f : 0.f;
#pragma unroll
      for (int dn = 0; dn < 4; ++dn) ot[dn][m] = (f32x4){0.f, 0.f, 0.f, 0.f};
    }
#define AT_KROW(T) ((T) < nwin ? latrow0 + (qb * 128 - 128 + 64 * (tlo + (T))) : (size_t)b * CTXL + ((T) - nwin) * 64)
#define AT_LOAD(RK, RV, T) do { const size_t _kr = AT_KROW(T);                                                            \
      RK = *(const u32x4*)(p.proj + (_kr + sj) * 1536 + 1024 + kvh * 64 + sc8);                                          \
      RV = *(const u32x4*)(p.proj + (_kr + sj) * 1536 + 1280 + kvh * 64 + sc8); } while (0)
    u32x4 rk0, rv0, rk1, rv1;
    rk0 = rk1 = rv0 = rv1 = (u32x4){0u, 0u, 0u, 0u};
    {
      u32x4 kk, vv;
      AT_LOAD(kk, vv, 0);
      AT_LOAD(rk1, rv1, 1);
      *(LAS u32x4*)(Kl + sj * LDK + sc8) = kk;
      *(LAS u32x4*)(Vl + sj * LDK + sc8) = vv;
    }
    __syncthreads();
    auto tile = [&](const int s, u32x4& ldK, u32x4& ldV, const u32x4& wrK, const u32x4& wrV) __attribute__((always_inline)) {
      const int cur = s & 1;
      const int tt = s < nwin ? tlo + s : 6 + (s - nwin);
      const bool win = tt < 6;
      const int kpos0 = win ? qb * 128 - 128 + 64 * tt : (tt - 6) * 64;
      const bool more = s + 1 < ntile;
      if (!(VAR & 16)) { if (s + 2 < ntile) AT_LOAD(ldK, ldV, s + 2); }
      const LAS bf16_t* Kc = Kl + cur * 64 * LDK;
      const LAS bf16_t* Vc = Vl + cur * 64 * LDK;
      const int dq = q0 - kpos0;
      const bool skip = win && (dq >= 192 || dq <= -192);
      const bool edge = win && !(dq <= 65 && dq >= -65);
      if (!skip && !(VAR & 8)) {
      bf16x8 pb[4][2];
      {
        bf16x8 kfr[2][4];
#pragma unroll
        for (int ks = 0; ks < 2; ++ks)
#pragma unroll
          for (int n = 0; n < 4; ++n) kfr[ks][n] = *(const LAS bf16x8*)(Kc + (n * 16 + fr) * LDK + ks * 32 + fq * 8);
#pragma unroll
        for (int m = 0; m < 4; ++m) {
          f32x4 st[4];
#pragma unroll
          for (int n = 0; n < 4; ++n) st[n] = (f32x4){0.f, 0.f, 0.f, 0.f};
#pragma unroll
          for (int ks = 0; ks < 2; ++ks) {
            const bf16x8 qfm = *(const LAS bf16x8*)(Ql + (m * 16 + fr) * LDK + ks * 32 + fq * 8);
#pragma unroll
            for (int n = 0; n < 4; ++n) st[n] = __builtin_amdgcn_mfma_f32_16x16x32_bf16(kfr[ks][n], qfm, st[n], 0, 0, 0);
          }
          const int qpos = q0 + m * 16 + fr;
          float mx = -3.0e38f;
#pragma unroll
          for (int n = 0; n < 4; ++n)
#pragma unroll
            for (int j = 0; j < 4; ++j) {
              float sv = st[n][j];
              if (edge) { const int dd = qpos - (kpos0 + n * 16 + fq * 4 + j); if (dd > 128 || dd < -128) sv = -1e30f; }
              st[n][j] = sv;
              mx = fmaxf(mx, sv);
            }
          mx = xrow16_max(mx);
          const float mnew = fmaxf(mrow[m], mx);
          const float alpha = __builtin_amdgcn_exp2f(mrow[m] - mnew);
          mrow[m] = mnew;
          float ls = 0.f;
#pragma unroll
          for (int n = 0; n < 4; ++n)
#pragma unroll
            for (int j = 0; j < 4; ++j) { const float pv = (VAR & 2) ? (st[n][j] - mnew) : __builtin_amdgcn_exp2f(st[n][j] - mnew); st[n][j] = pv; ls += pv; }
          lrow[m] = lrow[m] * alpha + ls;
#pragma unroll
          for (int dn = 0; dn < 4; ++dn) ot[dn][m] *= alpha;
#pragma unroll
          for (int kk = 0; kk < 2; ++kk) {
            u32x4 w;
            w.x = cvt_pk_bf16(st[2 * kk][0], st[2 * kk][1]); w.y = cvt_pk_bf16(st[2 * kk][2], st[2 * kk][3]);
            w.z = cvt_pk_bf16(st[2 * kk + 1][0], st[2 * kk + 1][1]); w.w = cvt_pk_bf16(st[2 * kk + 1][2], st[2 * kk + 1][3]);
            pb[m][kk] = __builtin_bit_cast(bf16x8, w);
          }
          __builtin_amdgcn_sched_barrier(0);
        }
      }
#pragma unroll
      for (int kk = 0; kk < 2; ++kk) {
        bf16x8 vfr[4];
#pragma unroll
        for (int dn = 0; dn < 4; ++dn) {
          const s16x4 v0 = __builtin_amdgcn_ds_read_tr16_b64_v4i16((LAS s16x4*)(Vc + ((2 * kk) * 16 + fq * 4) * LDK + dn * 16 + troff));
          const s16x4 v1 = __builtin_amdgcn_ds_read_tr16_b64_v4i16((LAS s16x4*)(Vc + ((2 * kk + 1) * 16 + fq * 4) * LDK + dn * 16 + troff));
          bf16x8 vf;
          vf[0] = v0[0]; vf[1] = v0[1]; vf[2] = v0[2]; vf[3] = v0[3]; vf[4] = v1[0]; vf[5] = v1[1]; vf[6] = v1[2]; vf[7] = v1[3];
          vfr[dn] = vf;
        }
#pragma unroll
        for (int m = 0; m < 4; ++m)
#pragma unroll
          for (int dn = 0; dn < 4; ++dn) { if (VAR & 4) ot[dn][m][0] += __uint_as_float(__builtin_bit_cast(u32x4, vfr[dn]).x ^ __builtin_bit_cast(u32x4, pb[m][kk]).x); else ot[dn][m] = __builtin_amdgcn_mfma_f32_16x16x32_bf16(vfr[dn], pb[m][kk], ot[dn][m], 0, 0, 0); }
        __builtin_amdgcn_sched_barrier(0);
      }
      }
      if (!(VAR & 16)) {
        if (more) {
          *(LAS u32x4*)(Kl + ((cur ^ 1) * 64 + sj) * LDK + sc8) = wrK;
          *(LAS u32x4*)(Vl + ((cur ^ 1) * 64 + sj) * LDK + sc8) = wrV;
        }
        __syncthreads();
      }
    };
#pragma unroll 1
    for (int s = 0; s < ntile; s += 2) {
      tile(s, rk0, rv0, rk1, rv1);
      tile(s + 1, rk1, rv1, rk0, rv0);
    }
#undef AT_LOAD
#undef AT_KROW
    int fr2 = fr;
    asm volatile("" : "+v"(fr2));
#pragma unroll
    for (int m = 0; m < 4; ++m) {
      const float l = xrow16_sum(lrow[m]);
      const float inv = 1.f / l;
      bf16_t* orow = outp + (latrow0 + q0 + m * 16 + fr2) * D + hq * 64 + fq * 4;
#pragma unroll
      for (int dn = 0; dn < 4; ++dn) {
        u32x2 w;
#ifdef ZERO_ATTN
        w.x = 0u; w.y = 0u;
#else
        w.x = cvt_pk_bf16(ot[dn][m][0] * inv, ot[dn][m][1] * inv); w.y = cvt_pk_bf16(ot[dn][m][2] * inv, ot[dn][m][3] * inv);
#endif
        *(u32x2*)(orow + dn * 16) = w;
      }
    }
  }
}

#define CEX(a, b) do { const unsigned _h = max(a, b), _l = min(a, b); a = _h; b = _l; } while (0)
__device__ __forceinline__ void sort16_desc(unsigned (&v)[16]) { CEX(v[0], v[1]); CEX(v[2], v[3]); CEX(v[0], v[2]); CEX(v[1], v[3]); CEX(v[1], v[2]); CEX(v[4], v[5]); CEX(v[6], v[7]); CEX(v[4], v[6]); CEX(v[5], v[7]); CEX(v[5], v[6]); CEX(v[0], v[4]); CEX(v[2], v[6]); CEX(v[2], v[4]); CEX(v[1], v[5]); CEX(v[3], v[7]); CEX(v[3], v[5]); CEX(v[1], v[2]); CEX(v[3], v[4]); CEX(v[5], v[6]); CEX(v[8], v[9]); CEX(v[10], v[11]); CEX(v[8], v[10]); CEX(v[9], v[11]); CEX(v[9], v[10]); CEX(v[12], v[13]); CEX(v[14], v[15]); CEX(v[12], v[14]); CEX(v[13], v[15]); CEX(v[13], v[14]); CEX(v[8], v[12]); CEX(v[10], v[14]); CEX(v[10], v[12]); CEX(v[9], v[13]); CEX(v[11], v[15]); CEX(v[11], v[13]); CEX(v[9], v[10]); CEX(v[11], v[12]); CEX(v[13], v[14]); CEX(v[0], v[8]); CEX(v[4], v[12]); CEX(v[4], v[8]); CEX(v[2], v[10]); CEX(v[6], v[14]); CEX(v[6], v[10]); CEX(v[2], v[4]); CEX(v[6], v[8]); CEX(v[10], v[12]); CEX(v[1], v[9]); CEX(v[5], v[13]); CEX(v[5], v[9]); CEX(v[3], v[11]); CEX(v[7], v[15]); CEX(v[7], v[11]); CEX(v[3], v[5]); CEX(v[7], v[9]); CEX(v[11], v[13]); CEX(v[1], v[2]); CEX(v[3], v[4]); CEX(v[5], v[6]); CEX(v[7], v[8]); CEX(v[9], v[10]); CEX(v[11], v[12]); CEX(v[13], v[14]); }
__device__ __forceinline__ void merge16_desc(unsigned (&t)[16], const unsigned (&b)[16]) {
#pragma unroll
  for (int i = 0; i < 16; ++i) t[i] = max(t[i], b[15 - i]);
  CEX(t[0], t[8]); CEX(t[1], t[9]); CEX(t[2], t[10]); CEX(t[3], t[11]); CEX(t[4], t[12]); CEX(t[5], t[13]); CEX(t[6], t[14]); CEX(t[7], t[15]); CEX(t[0], t[4]); CEX(t[1], t[5]); CEX(t[2], t[6]); CEX(t[3], t[7]); CEX(t[8], t[12]); CEX(t[9], t[13]); CEX(t[10], t[14]); CEX(t[11], t[15]); CEX(t[0], t[2]); CEX(t[1], t[3]); CEX(t[4], t[6]); CEX(t[5], t[7]); CEX(t[8], t[10]); CEX(t[9], t[11]); CEX(t[12], t[14]); CEX(t[13], t[15]); CEX(t[0], t[1]); CEX(t[2], t[3]); CEX(t[4], t[5]); CEX(t[6], t[7]); CEX(t[8], t[9]); CEX(t[10], t[11]); CEX(t[12], t[13]); CEX(t[14], t[15]);
}

__device__ __forceinline__ unsigned f2ord(float f) { const unsigned u = __float_as_uint(f); return (u & 0x80000000u) ? ~u : (u | 0x80000000u); }
__device__ __forceinline__ float ord2f(unsigned k) { const unsigned u = (k & 0x80000000u) ? (k & 0x7fffffffu) : ~k; return __uint_as_float(u); }
__device__ __forceinline__ unsigned dpp_xor1(unsigned x) { return (unsigned)__builtin_amdgcn_mov_dpp((int)x, 0xB1, 0xf, 0xf, true); }

__device__ void phase_peer_topk(const Params& p, unsigned char* smem, int bid, int nb, int layer, int tok0, int ntok) {
  const int tid = tidx(), wid = __builtin_amdgcn_readfirstlane(tid >> 6), lane = tid & 63, fr = lane & 15, fq = lane >> 4;
  LAS unsigned* sc = (LAS unsigned*)smem + wid * (64 * 36 + 64 * 16);
  LAS unsigned* fl = sc + 64 * 36;
  const int ls = lane & 1;
  const int nitem = (ntok / 256) * 8;
  for (int it = bid; it < nitem; it += nb) {
    const int h = it & 7, tile = it >> 3;
    const int tokw0 = tok0 + tile * 256 + wid * 32;
    bf16x8 qa[2][2][2];
#pragma unroll
    for (int m = 0; m < 2; ++m)
#pragma unroll
      for (int s = 0; s < 2; ++s)
#pragma unroll
        for (int ks = 0; ks < 2; ++ks)
          qa[m][s][ks] = *(const bf16x8*)(p.pq + (size_t)(tokw0 + m * 16 + fr) * D + h * 128 + s * 64 + ks * 32 + fq * 8);
    unsigned top[16];
#pragma unroll
    for (int i = 0; i < 16; ++i) top[i] = 0u;
    const bf16_t* kb = p.keysb + (size_t)(layer * 8 + h) * (2 * 2 * 128 * 64);
    bf16x8 kfr[2][2][2];
#define TK_LOADKEYS(C)                                                                                                   \
    _Pragma("unroll") for (int s = 0; s < 2; ++s) _Pragma("unroll") for (int n = 0; n < 2; ++n) _Pragma("unroll") for (int ks = 0; ks < 2; ++ks) \
      kfr[s][n][ks] = *(const bf16x8*)(kb + (size_t)((s * 2) * 128 + (C) * 32 + n * 16 + fr) * 64 + ks * 32 + fq * 8)
    TK_LOADKEYS(0);
#pragma unroll 1
    for (int c = 0; c < 4; ++c) {
      f32x4 acc[2][2][2];
#pragma unroll
      for (int m = 0; m < 2; ++m)
#pragma unroll
        for (int s = 0; s < 2; ++s)
#pragma unroll
          for (int n = 0; n < 2; ++n) acc[m][s][n] = (f32x4){0.f, 0.f, 0.f, 0.f};
#pragma unroll
      for (int s = 0; s < 2; ++s)
#pragma unroll
        for (int n = 0; n < 2; ++n)
#pragma unroll
          for (int ks = 0; ks < 2; ++ks)
#pragma unroll
            for (int m = 0; m < 2; ++m) acc[m][s][n] = __builtin_amdgcn_mfma_f32_16x16x32_bf16(qa[m][s][ks], kfr[s][n][ks], acc[m][s][n], 0, 0, 0);
      { const int cn = c < 3 ? c + 1 : 3; TK_LOADKEYS(cn); }
#pragma unroll
      for (int m = 0; m < 2; ++m)
#pragma unroll
        for (int s = 0; s < 2; ++s)
#pragma unroll
          for (int n = 0; n < 2; ++n)
#pragma unroll
            for (int j = 0; j < 4; ++j)
              sc[((m * 16 + fq * 4 + j) * 2 + s) * 36 + n * 16 + fr] = (f2ord(acc[m][s][n][j]) & 0xffffff80u) | (unsigned)(127 - (c * 32 + n * 16 + fr));
      unsigned b0[16], b1[16];
#pragma unroll
      for (int q = 0; q < 4; ++q) {
        const u32x4 w0 = *(const LAS u32x4*)(sc + lane * 36 + q * 4), w1 = *(const LAS u32x4*)(sc + lane * 36 + 16 + q * 4);
        b0[4 * q] = w0.x; b0[4 * q + 1] = w0.y; b0[4 * q + 2] = w0.z; b0[4 * q + 3] = w0.w;
        b1[4 * q] = w1.x; b1[4 * q + 1] = w1.y; b1[4 * q + 2] = w1.z; b1[4 * q + 3] = w1.w;
      }
      sort16_desc(b0); merge16_desc(top, b0);
      sort16_desc(b1); merge16_desc(top, b1);
    }
#undef TK_LOADKEYS
#pragma unroll
    for (int q = 0; q < 4; ++q) { u32x4 w; w.x = top[4 * q]; w.y = top[4 * q + 1]; w.z = top[4 * q + 2]; w.w = top[4 * q + 3]; *(LAS u32x4*)(fl + lane * 16 + q * 4) = w; }
    float own[16], oth[16];
#pragma unroll
    for (int q = 0; q < 4; ++q) {
      const u32x4 w = *(const LAS u32x4*)(fl + (lane ^ 1) * 16 + q * 4);
      oth[4 * q] = ord2f(w.x & 0xffffff80u); oth[4 * q + 1] = ord2f(w.y & 0xffffff80u); oth[4 * q + 2] = ord2f(w.z & 0xffffff80u); oth[4 * q + 3] = ord2f(w.w & 0xffffff80u);
    }
#pragma unroll
    for (int i = 0; i < 16; ++i) own[i] = ord2f(top[i] & 0xffffff80u);
    unsigned ck[32];
    ck[0] = (f2ord(own[0] + oth[1]) & 0xffffff00u) | (255u - (ls ? 16u : 1u));
    ck[1] = (f2ord(own[0] + oth[2]) & 0xffffff00u) | (255u - (ls ? 32u : 2u));
    ck[2] = (f2ord(own[0] + oth[3]) & 0xffffff00u) | (255u - (ls ? 48u : 3u));
    ck[3] = (f2ord(own[0] + oth[4]) & 0xffffff00u) | (255u - (ls ? 64u : 4u));
    ck[4] = (f2ord(own[0] + oth[5]) & 0xffffff00u) | (255u - (ls ? 80u : 5u));
    ck[5] = (f2ord(own[0] + oth[6]) & 0xffffff00u) | (255u - (ls ? 96u : 6u));
    ck[6] = (f2ord(own[0] + oth[7]) & 0xffffff00u) | (255u - (ls ? 112u : 7u));
    ck[7] = (f2ord(own[0] + oth[8]) & 0xffffff00u) | (255u - (ls ? 128u : 8u));
    ck[8] = (f2ord(own[0] + oth[9]) & 0xffffff00u) | (255u - (ls ? 144u : 9u));
    ck[9] = (f2ord(own[0] + oth[10]) & 0xffffff00u) | (255u - (ls ? 160u : 10u));
    ck[10] = (f2ord(own[0] + oth[11]) & 0xffffff00u) | (255u - (ls ? 176u : 11u));
    ck[11] = (f2ord(own[0] + oth[12]) & 0xffffff00u) | (255u - (ls ? 192u : 12u));
    ck[12] = (f2ord(own[0] + oth[13]) & 0xffffff00u) | (255u - (ls ? 208u : 13u));
    ck[13] = (f2ord(own[0] + oth[14]) & 0xffffff00u) | (255u - (ls ? 224u : 14u));
    ck[14] = (f2ord(own[0] + oth[15]) & 0xffffff00u) | (255u - (ls ? 240u : 15u));
    ck[15] = (f2ord(own[1] + oth[2]) & 0xffffff00u) | (255u - (ls ? 33u : 18u));
    ck[16] = (f2ord(own[1] + oth[3]) & 0xffffff00u) | (255u - (ls ? 49u : 19u));
    ck[17] = (f2ord(own[1] + oth[4]) & 0xffffff00u) | (255u - (ls ? 65u : 20u));
    ck[18] = (f2ord(own[1] + oth[5]) & 0xffffff00u) | (255u - (ls ? 81u : 21u));
    ck[19] = (f2ord(own[1] + oth[6]) & 0xffffff00u) | (255u - (ls ? 97u : 22u));
    ck[20] = (f2ord(own[1] + oth[7]) & 0xffffff00u) | (255u - (ls ? 113u : 23u));
    ck[21] = (f2ord(own[2] + oth[3]) & 0xffffff00u) | (255u - (ls ? 50u : 35u));
    ck[22] = (f2ord(own[2] + oth[4]) & 0xffffff00u) | (255u - (ls ? 66u : 36u));
    ck[23] = ls ? 0u : ((f2ord(own[0] + oth[0]) & 0xffffff00u) | (255u - 0u));
    ck[24] = ls ? 0u : ((f2ord(own[1] + oth[1]) & 0xffffff00u) | (255u - 17u));
    ck[25] = ls ? 0u : ((f2ord(own[2] + oth[2]) & 0xffffff00u) | (255u - 34u));
    ck[26] = ls ? 0u : ((f2ord(own[3] + oth[3]) & 0xffffff00u) | (255u - 51u));
    ck[27] = 0u;
    ck[28] = 0u;
    ck[29] = 0u;
    ck[30] = 0u;
    ck[31] = 0u;
    unsigned c0[16], c1[16];
#pragma unroll
    for (int i = 0; i < 16; ++i) { c0[i] = ck[i]; c1[i] = ck[16 + i]; }
    sort16_desc(c0); sort16_desc(c1); merge16_desc(c0, c1);
    unsigned pt[16];
#pragma unroll
    for (int i = 0; i < 16; ++i) pt[i] = dpp_xor1(c0[i]);
    merge16_desc(c0, pt);
    float cs[16], den = 0.f;
    const float mx = ord2f(c0[0] & 0xffffff00u);
#pragma unroll
    for (int r = 0; r < 16; ++r) { cs[r] = __expf(ord2f(c0[r] & 0xffffff00u) - mx); den += cs[r]; }
    const float inv = 1.f / den;
    const int token = tokw0 + (lane >> 1);
    if (ls == 0) {
      u32x2* so = p.sel + (size_t)token * 128 + h * 16;
      const LAS unsigned* l1 = fl + lane * 16;
      const LAS unsigned* l2 = fl + (lane + 1) * 16;
#pragma unroll
      for (int rr = 0; rr < 16; rr += 2) {
        u32x4 w;
        {
          const unsigned ci = 255u - (c0[rr] & 0xffu);
          w.x = (127u - (l1[ci >> 4] & 0x7fu)) * 128u + (127u - (l2[ci & 15u] & 0x7fu)); w.y = __float_as_uint(cs[rr] * inv);
        }
        {
          const unsigned ci = 255u - (c0[rr + 1] & 0xffu);
          w.z = (127u - (l1[ci >> 4] & 0x7fu)) * 128u + (127u - (l2[ci & 15u] & 0x7fu)); w.w = __float_as_uint(cs[rr + 1] * inv);
        }
        *(u32x4*)(so + rr) = w;
      }
    }
  }
}

__device__ __forceinline__ float gelu_as(float v) {
  const float av = fabsf(v), t = __builtin_amdgcn_rcpf(av * 0.2316418882f + 1.0f);
  float q = t * 0.5307027145f + (-0.7265760135f);
  q = q * t + 0.7107068705f; q = q * t + (-0.142248368f); q = q * t + 0.127414796f; q = q * t;
  const float ee = __builtin_amdgcn_exp2f((v * v) * (-0.72134752044f));
  const float m = v * (q * ee);
  return v < 0.f ? m : v - m;
}
typedef __bf16 bf16x2t __attribute__((ext_vector_type(2)));
__device__ __forceinline__ unsigned rl2(unsigned lo, unsigned hi, int j) {
  const unsigned a = (unsigned)__builtin_amdgcn_readlane((int)lo, j & 63), b = (unsigned)__builtin_amdgcn_readlane((int)hi, j & 63);
  return j < 64 ? a : b;
}
__device__ __forceinline__ float group8_sum(float x) { x += dppf<0xB1>(x); x += dppf<0x4E>(x); x += dppf<0x141>(x); return x; }
__device__ __forceinline__ float dot2u(unsigned a, unsigned b, float c) {
  return __builtin_amdgcn_fdot2_f32_bf16(__builtin_bit_cast(bf16x2t, a), __builtin_bit_cast(bf16x2t, b), c, false);
}
__device__ __forceinline__ void peer_sort_token(const Params& p, int token, int lane_in, LAS unsigned* lst, int t, const float* us, const float* vs) {
  int lane = lane_in;
  asm volatile("" : "+v"(lane));
      const u32x2 se0 = p.sel[(size_t)token * 128 + lane], se1 = p.sel[(size_t)token * 128 + 64 + lane];
      unsigned ka = (se0.x << 7) | (unsigned)lane, kb = (se1.x << 7) | (unsigned)(lane + 64);
#define BSTEP(J, UPA, UPB)                                                                                               \
      do {                                                                                                               \
        unsigned oa, ob;                                                                                                 \
        if ((J) == 1) { oa = dppu<0xB1>(ka); ob = dppu<0xB1>(kb); }                                                      \
        else if ((J) == 2) { oa = dppu<0x4E>(ka); ob = dppu<0x4E>(kb); }                                                 \
        else if ((J) == 4) { const bool hi4 = (lane & 4) != 0;                                                           \
          const unsigned a0 = dppu<0x104>(ka), a1 = dppu<0x114>(ka), b0 = dppu<0x104>(kb), b1 = dppu<0x114>(kb);         \
          oa = hi4 ? a1 : a0; ob = hi4 ? b1 : b0; }                                                                      \
        else if ((J) == 8) { oa = dppu<0x128>(ka); ob = dppu<0x128>(kb); }                                               \
        else if ((J) == 16) { const bool odd = (lane & 16) != 0;                                                         \
          auto ta = __builtin_amdgcn_permlane16_swap(ka, ka, false, false); auto tb = __builtin_amdgcn_permlane16_swap(kb, kb, false, false); \
          oa = odd ? ta[0] : ta[1]; ob = odd ? tb[0] : tb[1]; }                                                          \
        else { const bool up32 = lane >= 32;                                                                             \
          auto ta = __builtin_amdgcn_permlane32_swap(ka, ka, false, false); auto tb = __builtin_amdgcn_permlane32_swap(kb, kb, false, false); \
          oa = up32 ? ta[0] : ta[1]; ob = up32 ? tb[0] : tb[1]; }                                                        \
        const bool lower = (lane & (J)) == 0;                                                                            \
        const unsigned mna = min(ka, oa), mxa = max(ka, oa), mnb = min(kb, ob), mxb = max(kb, ob);                       \
        ka = (lower == (UPA)) ? mna : mxa;                                                                               \
        kb = (lower == (UPB)) ? mnb : mxb;                                                                               \
      } while (0)
#define BLAYERS(K)                                                                                                       \
      do {                                                                                                               \
        const bool up = ((K) >= 64) ? true : ((lane & (K)) == 0);                                                        \
        const bool upa = up, upb = ((K) == 64) ? false : up;                                                             \
        if ((K) >= 64) BSTEP(32, upa, upb);                                                                              \
        if ((K) >= 32) BSTEP(16, upa, upb);                                                                              \
        if ((K) >= 16) BSTEP(8, upa, upb);                                                                               \
        if ((K) >= 8) BSTEP(4, upa, upb);                                                                                \
        if ((K) >= 4) BSTEP(2, upa, upb);                                                                                \
        BSTEP(1, upa, upb);                                                                                              \
      } while (0)
      BLAYERS(2); BLAYERS(4); BLAYERS(8); BLAYERS(16); BLAYERS(32); BLAYERS(64);
      { const unsigned mn = min(ka, kb), mx = max(ka, kb); ka = mn; kb = mx; }
      BLAYERS(128);
#undef BLAYERS
#undef BSTEP
      const unsigned sa = ka & 127u, sb = kb & 127u;
      const unsigned ga0 = (unsigned)__builtin_amdgcn_ds_bpermute((int)((sa & 63u) * 4u), (int)se0.y), ga1 = (unsigned)__builtin_amdgcn_ds_bpermute((int)((sa & 63u) * 4u), (int)se1.y);
      const unsigned gb0 = (unsigned)__builtin_amdgcn_ds_bpermute((int)((sb & 63u) * 4u), (int)se0.y), gb1 = (unsigned)__builtin_amdgcn_ds_bpermute((int)((sb & 63u) * 4u), (int)se1.y);
      const float gta = __uint_as_float((sa & 64u) ? ga1 : ga0), gtb = __uint_as_float((sb & 64u) ? gb1 : gb0);
      const unsigned ea = ka >> 7, eb = kb >> 7;
      lst[t * 128 + lane] = ka; lst[t * 128 + 64 + lane] = kb;
      lst[1024 + t * 128 + lane] = __float_as_uint(gta * vs[ea]); lst[1024 + t * 128 + 64 + lane] = __float_as_uint(gtb * vs[eb]);
      lst[2048 + t * 128 + lane] = __float_as_uint(us[ea]); lst[2048 + t * 128 + 64 + lane] = __float_as_uint(us[eb]);
}
template <int VAR>
__device__ void phase_peer_gather(const Params& p, unsigned char* smem, int bid, int nb, int layer, int tok0, int ntok) {
  const int tid0 = tidx();
  const int wid = __builtin_amdgcn_readfirstlane(tid0 >> 6), lane = tid0 & 63, g = lane >> 3, i = lane & 7;
  const __amdgpu_buffer_rsrc_t U = __builtin_amdgcn_make_buffer_rsrc((void*)(p.u8 + (size_t)layer * NEXP * 768), (short)0, NEXP * 768, 0x00020000);
  const __amdgpu_buffer_rsrc_t V = __builtin_amdgcn_make_buffer_rsrc((void*)(p.v8 + (size_t)layer * NEXP * 768), (short)0, NEXP * 768, 0x00020000);
  const float* us = p.uscale + (size_t)layer * NEXP;
  const float* vs = p.vscale + (size_t)layer * NEXP;
  const float* modl = p.mod + (size_t)layer * 33 * MODW;
  LAS unsigned* lst = (LAS unsigned*)smem + wid * 3072;
#define PIECE(R, VOFF, K) __builtin_bit_cast(u32x4, __builtin_amdgcn_raw_buffer_load_b128(R, ((VAR & 2) ? (i * 16) : (VOFF)) + (K) * 128, 0, 0))
  const int n8 = (ntok / (nb * 64)) * (nb * 64);
  for (int grp = bid * 8 + wid; grp < n8 / 8; grp += nb * 8) {
    const int token0 = tok0 + grp * 8;
#pragma unroll 1
    for (int t = 0; t < 8; ++t) {
      const int token = token0 + t;
      peer_sort_token(p, token, lane, lst, t, us, vs);
    }
    const int token = token0 + g;
    {
      u32x4 x[4][4];
#pragma unroll
      for (int b = 0; b < 4; ++b) {
        const bf16_t* xr = p.act + (size_t)token * D + b * 256 + i * 32;
#pragma unroll
        for (int q = 0; q < 4; ++q) x[b][q] = *(const u32x4*)(xr + q * 8);
      }
      constexpr int NB1 = 4;
      u32x4 pk[NB1][6];
#pragma unroll
      for (int s = 0; s < NB1; ++s) {
        const int voff = (int)((lst[g * 128 + s] >> 7) * 768u) + i * 16;
#pragma unroll
        for (int k = 0; k < 6; ++k) pk[s][k] = PIECE(U, voff, k);
      }
#define P1_BLOCK(B, W0, W1, W2, W3, W4, W5)                                                                              \
      do {                                                                                                               \
        u32x6 w6; w6[0] = (W0); w6[1] = (W1); w6[2] = (W2); w6[3] = (W3); w6[4] = (W4); w6[5] = (W5);                    \
        const u32x16 bw = __builtin_bit_cast(u32x16, __builtin_amdgcn_cvt_scalef32_pk32_bf16_fp6(w6, 1.0f));             \
        _Pragma("unroll") for (int q = 0; q < 4; ++q) {                                                                  \
          const u32x4 xv = x[B][q];                                                                                      \
          const unsigned b0 = bw[4 * q], b1 = bw[4 * q + 1], b2 = bw[4 * q + 2], b3 = bw[4 * q + 3];                     \
          const unsigned x0 = xv[0], x1 = xv[1], x2 = xv[2], x3 = xv[3];                                                 \
          d0 = dot2u(b0, x0, d0); d1 = dot2u(b1, x1, d1); d2 = dot2u(b2, x2, d2); d3 = dot2u(b3, x3, d3);                \
        }                                                                                                                \
      } while (0)
      unsigned keyn = lst[g * 128 + NB1];
      float sun = __uint_as_float(lst[2048 + g * 128]), gsvn = __uint_as_float(lst[1024 + g * 128]);
#define P1_STEP(S, J)                                                                                                    \
      do {                                                                                                               \
        const int voffn = (int)((keyn >> 7) * 768u) + i * 16;                                                            \
        const float su = sun, gsv = gsvn;                                                                                \
        { const int jk = (J) + 1 + NB1 < 128 ? (J) + 1 + NB1 : 127; const int jq = (J) + 1 < 128 ? (J) + 1 : 127;        \
          keyn = lst[g * 128 + jk]; sun = __uint_as_float(lst[2048 + g * 128 + jq]); gsvn = __uint_as_float(lst[1024 + g * 128 + jq]); } \
        float d0 = 0.f, d1 = 0.f, d2 = 0.f, d3 = 0.f;                                                                    \
        if (VAR & 4) { d0 += __uint_as_float(pk[S][0][0] ^ pk[S][1][1] ^ pk[S][2][2]); } else {                          \
        P1_BLOCK(0, pk[S][0][0], pk[S][0][1], pk[S][0][2], pk[S][0][3], pk[S][1][0], pk[S][1][1]);                       \
        P1_BLOCK(1, pk[S][1][2], pk[S][1][3], pk[S][2][0], pk[S][2][1], pk[S][2][2], pk[S][2][3]); }                     \
        pk[S][0] = PIECE(U, voffn, 0); pk[S][1] = PIECE(U, voffn, 1); pk[S][2] = PIECE(U, voffn, 2);                     \
        if (VAR & 4) { d1 += __uint_as_float(pk[S][3][0] ^ pk[S][4][1] ^ pk[S][5][2]); } else {                          \
        P1_BLOCK(2, pk[S][3][0], pk[S][3][1], pk[S][3][2], pk[S][3][3], pk[S][4][0], pk[S][4][1]);                       \
        P1_BLOCK(3, pk[S][4][2], pk[S][4][3], pk[S][5][0], pk[S][5][1], pk[S][5][2], pk[S][5][3]); }                     \
        pk[S][3] = PIECE(U, voffn, 3); pk[S][4] = PIECE(U, voffn, 4); pk[S][5] = PIECE(U, voffn, 5);                     \
        const float d = group8_sum((d0 + d1) + (d2 + d3)) * su;                                                          \
        lst[1024 + g * 128 + (J)] = __float_as_uint(gsv * gelu_as(d));                                                   \
      } while (0)
#pragma unroll 1
      for (int j = 0; j < 128; j += 4) { P1_STEP(0, j); P1_STEP(1, j + 1); P1_STEP(2, j + 2); P1_STEP(3, j + 3); }
#undef P1_STEP
#undef P1_BLOCK
    }
    const bool isctx = token < NCTX;
    const int b = isctx ? 32 : ((token - NCTX) >> 11);
    const float* g2 = modl + (size_t)b * MODW + 5 * D + i * 32;
    float* hrow = ((VAR & 1) ? (float*)(p.proj + (size_t)113246208) + (size_t)(token - tok0) * D
                             : (isctx ? p.hctx + (size_t)token * D : p.out + (size_t)(token - NCTX) * D)) + i * 32;
    float ss = 0.f;
#pragma unroll 1
    for (int hf = 0; hf < 2; ++hf) {
      f32x32 y0, y1;
#pragma unroll
      for (int c = 0; c < 32; ++c) { y0[c] = 0.f; y1[c] = 0.f; }
      const int hoff = hf * 384 + i * 16;
      constexpr int NB2 = 8;
      u32x4 pk[NB2][3];
#pragma unroll
      for (int s = 0; s < NB2; ++s) {
        const int voff = (int)((lst[g * 128 + s] >> 7) * 768u) + hoff;
#pragma unroll
        for (int k = 0; k < 3; ++k) pk[s][k] = PIECE(V, voff, k);
      }
      unsigned keyn = lst[g * 128 + NB2];
      float an = __uint_as_float(lst[1024 + g * 128]);
#define P2_STEP(S, J)                                                                                                    \
      do {                                                                                                               \
        const int voffn = (int)((keyn >> 7) * 768u) + hoff;                                                              \
        const float a = an;                                                                                              \
        { const int jk = (J) + 1 + NB2 < 128 ? (J) + 1 + NB2 : 127; const int jq = (J) + 1 < 128 ? (J) + 1 : 127;        \
          keyn = lst[g * 128 + jk]; an = __uint_as_float(lst[1024 + g * 128 + jq]); }                                    \
        {                                                                                                                \
          u32x6 w6; w6[0] = pk[S][0][0]; w6[1] = pk[S][0][1]; w6[2] = pk[S][0][2]; w6[3] = pk[S][0][3]; w6[4] = pk[S][1][0]; w6[5] = pk[S][1][1]; \
          if (VAR & 4) { y0[0] += __uint_as_float(w6[0] ^ w6[5]) * a; } else {                                           \
          const f32x32 f = __builtin_amdgcn_cvt_scalef32_pk32_f32_fp6(w6, 1.0f);                                         \
          y0 += f * a; }                                                                                                 \
        }                                                                                                                \
        {                                                                                                                \
          u32x6 w6; w6[0] = pk[S][1][2]; w6[1] = pk[S][1][3]; w6[2] = pk[S][2][0]; w6[3] = pk[S][2][1]; w6[4] = pk[S][2][2]; w6[5] = pk[S][2][3]; \
          if (VAR & 4) { y1[0] += __uint_as_float(w6[0] ^ w6[5]) * a; } else {                                           \
          const f32x32 f = __builtin_amdgcn_cvt_scalef32_pk32_f32_fp6(w6, 1.0f);                                         \
          y1 += f * a; }                                                                                                 \
        }                                                                                                                \
        pk[S][0] = PIECE(V, voffn, 0); pk[S][1] = PIECE(V, voffn, 1); pk[S][2] = PIECE(V, voffn, 2);                     \
      } while (0)
#pragma unroll 1
      for (int j = 0; j < 128; j += 8) { P2_STEP(0, j); P2_STEP(1, j + 1); P2_STEP(2, j + 2); P2_STEP(3, j + 3); P2_STEP(4, j + 4); P2_STEP(5, j + 5); P2_STEP(6, j + 6); P2_STEP(7, j + 7); }
#undef P2_STEP
#ifdef ZERO_PEER
      if (layer == ZERO_PEER) {
#pragma unroll
        for (int c = 0; c < 32; ++c) { y0[c] = 0.f; y1[c] = 0.f; }
      }
#endif
#pragma unroll
      for (int bb = 0; bb < 2; ++bb)
#pragma unroll
        for (int q4 = 0; q4 < 8; ++q4) {
          const int co = (2 * hf + bb) * 256 + q4 * 4;
          const f32x4 hv = *(const f32x4*)(hrow + co), gv = *(const f32x4*)(g2 + co);
          f32x4 o;
#pragma unroll
          for (int e = 0; e < 4; ++e) { const float yv = bb ? y1[q4 * 4 + e] : y0[q4 * 4 + e]; const float v = hv[e] + gv[e] * yv; o[e] = v; ss += v * v; }
          *(f32x4*)(hrow + co) = o;
        }
    }
    {
      ss = group8_sum(ss);
      const float rstd = rsqrtf(ss * (1.f / D) + EPS);
      if (layer == 0) {
        const float* modn = p.mod + (size_t)33 * MODW + (size_t)b * MODW + i * 32;
        const float* gain = p.mix_g + D + i * 32;
#pragma unroll 2
        for (int k = 0; k < 16; ++k) {
          const int co = (k >> 2) * 256 + (k & 3) * 8;
          u32x4 w;
#pragma unroll
          for (int q4 = 0; q4 < 2; ++q4) {
            const f32x4 hv = *(const f32x4*)(hrow + co + q4 * 4);
            const f32x4 gg = *(const f32x4*)(gain + co + q4 * 4), s0 = *(const f32x4*)(modn + co + q4 * 4), s1 = *(const f32x4*)(modn + D + co + q4 * 4);
            f32x4 yv = hv * rstd * gg;
            yv = yv * (1.f + s1) + s0;
            w[q4 * 2] = cvt_pk_bf16(yv[0], yv[1]); w[q4 * 2 + 1] = cvt_pk_bf16(yv[2], yv[3]);
          }
          *(u32x4*)(p.act + (size_t)token * D + i * 32 + co) = w;
        }
      } else {
        const float* gain = p.final_g + i * 32;
#pragma unroll 2
        for (int k = 0; k < 32; ++k) {
          const int co = (k >> 3) * 256 + (k & 7) * 4;
          const f32x4 hv = *(const f32x4*)(hrow + co), gg = *(const f32x4*)(gain + co);
          *(f32x4*)(hrow + co) = hv * rstd * gg;
        }
      }
    }
    __syncthreads();
  }
  {
    const int g4 = lane >> 4, iv = lane & 7, hs = (lane >> 3) & 1;
    const int poff = hs * 384 + iv * 16;
    for (int grp = bid * 8 + wid; grp < (ntok - n8) / 4; grp += nb * 8) {
      const int token0 = tok0 + n8 + grp * 4;
#pragma unroll 1
      for (int t = 0; t < 4; ++t) peer_sort_token(p, token0 + t, lane, lst, t, us, vs);
      const int token = token0 + g4;
      {
        u32x4 x[2][4];
#pragma unroll
        for (int bb = 0; bb < 2; ++bb) {
          const bf16_t* xr = p.act + (size_t)token * D + (2 * hs + bb) * 256 + iv * 32;
#pragma unroll
          for (int q = 0; q < 4; ++q) x[bb][q] = *(const u32x4*)(xr + q * 8);
        }
        constexpr int NB1 = 8;
        u32x4 pk[NB1][3];
#pragma unroll
        for (int s = 0; s < NB1; ++s) {
          const int voff = (int)((lst[g4 * 128 + s] >> 7) * 768u) + poff;
#pragma unroll
          for (int k = 0; k < 3; ++k) pk[s][k] = PIECE(U, voff, k);
        }
#define T1_BLOCK(B, W0, W1, W2, W3, W4, W5)                                                                              \
        do {                                                                                                             \
          u32x6 w6; w6[0] = (W0); w6[1] = (W1); w6[2] = (W2); w6[3] = (W3); w6[4] = (W4); w6[5] = (W5);                  \
          const u32x16 bw = __builtin_bit_cast(u32x16, __builtin_amdgcn_cvt_scalef32_pk32_bf16_fp6(w6, 1.0f));           \
          _Pragma("unroll") for (int q = 0; q < 4; ++q) {                                                                \
            const u32x4 xv = x[B][q];                                                                                    \
            const unsigned b0 = bw[4 * q], b1 = bw[4 * q + 1], b2 = bw[4 * q + 2], b3 = bw[4 * q + 3];                   \
            const unsigned x0 = xv[0], x1 = xv[1], x2 = xv[2], x3 = xv[3];                                               \
            d0 = dot2u(b0, x0, d0); d1 = dot2u(b1, x1, d1); d2 = dot2u(b2, x2, d2); d3 = dot2u(b3, x3, d3);              \
          }                                                                                                              \
        } while (0)
#define T1_STEP(S, J)                                                                                                    \
        do {                                                                                                             \
          const int jn = (J) + NB1 < 128 ? (J) + NB1 : 127;                                                              \
          const int voffn = (int)((lst[g4 * 128 + jn] >> 7) * 768u) + poff;                                              \
          const float su = __uint_as_float(lst[2048 + g4 * 128 + (J)]), gsv = __uint_as_float(lst[1024 + g4 * 128 + (J)]); \
          float d0 = 0.f, d1 = 0.f, d2 = 0.f, d3 = 0.f;                                                                  \
          T1_BLOCK(0, pk[S][0][0], pk[S][0][1], pk[S][0][2], pk[S][0][3], pk[S][1][0], pk[S][1][1]);                     \
          T1_BLOCK(1, pk[S][1][2], pk[S][1][3], pk[S][2][0], pk[S][2][1], pk[S][2][2], pk[S][2][3]);                     \
          pk[S][0] = PIECE(U, voffn, 0); pk[S][1] = PIECE(U, voffn, 1); pk[S][2] = PIECE(U, voffn, 2);                   \
          __builtin_amdgcn_sched_barrier(0);                                                                             \
          float dd = group8_sum((d0 + d1) + (d2 + d3)); dd += dppf<0x128>(dd);             \
          lst[1024 + g4 * 128 + (J)] = __float_as_uint(gsv * gelu_as(dd * su));                                          \
        } while (0)
#pragma unroll 1
        for (int j = 0; j < 128; j += 8) { T1_STEP(0, j); T1_STEP(1, j + 1); T1_STEP(2, j + 2); T1_STEP(3, j + 3); T1_STEP(4, j + 4); T1_STEP(5, j + 5); T1_STEP(6, j + 6); T1_STEP(7, j + 7); }
#undef T1_STEP
#undef T1_BLOCK
      }
      const bool isctx = token < NCTX;
      const int b = isctx ? 32 : ((token - NCTX) >> 11);
      const float* g2 = modl + (size_t)b * MODW + 5 * D + iv * 32;
      float* hrow = (isctx ? p.hctx + (size_t)token * D : p.out + (size_t)(token - NCTX) * D) + iv * 32;
      float ss = 0.f;
      {
        f32x32 y0, y1;
#pragma unroll
        for (int c = 0; c < 32; ++c) { y0[c] = 0.f; y1[c] = 0.f; }
        constexpr int NB2 = 8;
        u32x4 pk[NB2][3];
#pragma unroll
        for (int s = 0; s < NB2; ++s) {
          const int voff = (int)((lst[g4 * 128 + s] >> 7) * 768u) + poff;
#pragma unroll
          for (int k = 0; k < 3; ++k) pk[s][k] = PIECE(V, voff, k);
        }
#define T2_STEP(S, J)                                                                                                    \
        do {                                                                                                             \
          const int jn = (J) + NB2 < 128 ? (J) + NB2 : 127;                                                              \
          const int voffn = (int)((lst[g4 * 128 + jn] >> 7) * 768u) + poff;                                              \
          const float a = __uint_as_float(lst[1024 + g4 * 128 + (J)]);                                                   \
          {                                                                                                              \
            u32x6 w6; w6[0] = pk[S][0][0]; w6[1] = pk[S][0][1]; w6[2] = pk[S][0][2]; w6[3] = pk[S][0][3]; w6[4] = pk[S][1][0]; w6[5] = pk[S][1][1]; \
            const f32x32 f = __builtin_amdgcn_cvt_scalef32_pk32_f32_fp6(w6, 1.0f);                                       \
            y0 += f * a;                                                                                                 \
          }                                                                                                              \
          __builtin_amdgcn_sched_barrier(0);                                                                             \
          {                                                                                                              \
            u32x6 w6; w6[0] = pk[S][1][2]; w6[1] = pk[S][1][3]; w6[2] = pk[S][2][0]; w6[3] = pk[S][2][1]; w6[4] = pk[S][2][2]; w6[5] = pk[S][2][3]; \
            const f32x32 f = __builtin_amdgcn_cvt_scalef32_pk32_f32_fp6(w6, 1.0f);                                       \
            y1 += f * a;                                                                                                 \
          }                                                                                                              \
          pk[S][0] = PIECE(V, voffn, 0); pk[S][1] = PIECE(V, voffn, 1); pk[S][2] = PIECE(V, voffn, 2);                   \
          __builtin_amdgcn_sched_barrier(0);                                                                             \
        } while (0)
#pragma unroll 1
        for (int j = 0; j < 128; j += 8) { T2_STEP(0, j); T2_STEP(1, j + 1); T2_STEP(2, j + 2); T2_STEP(3, j + 3); T2_STEP(4, j + 4); T2_STEP(5, j + 5); T2_STEP(6, j + 6); T2_STEP(7, j + 7); }
#undef T2_STEP
#ifdef ZERO_PEER
        if (layer == ZERO_PEER) {
#pragma unroll
          for (int c = 0; c < 32; ++c) { y0[c] = 0.f; y1[c] = 0.f; }
        }
#endif
#pragma unroll
        for (int bb = 0; bb < 2; ++bb)
#pragma unroll
          for (int q4 = 0; q4 < 8; ++q4) {
            const int co = (2 * hs + bb) * 256 + q4 * 4;
            const f32x4 hv = *(const f32x4*)(hrow + co), gv = *(const f32x4*)(g2 + co);
            f32x4 o;
#pragma unroll
            for (int e = 0; e < 4; ++e) { const float yv = bb ? y1[q4 * 4 + e] : y0[q4 * 4 + e]; const float v = hv[e] + gv[e] * yv; o[e] = v; ss += v * v; }
            *(f32x4*)(hrow + co) = o;
          }
      }
      {
        ss = group8_sum(ss); ss += dppf<0x128>(ss);
        const float rstd = rsqrtf(ss * (1.f / D) + EPS);
        if (layer == 0) {
          const float* modn = p.mod + (size_t)33 * MODW + (size_t)b * MODW + iv * 32;
          const float* gain = p.mix_g + D + iv * 32;
#pragma unroll 2
          for (int k = 0; k < 8; ++k) {
            const int co = (2 * hs + (k >> 2)) * 256 + (k & 3) * 8;
            u32x4 w;
#pragma unroll
            for (int q4 = 0; q4 < 2; ++q4) {
              const f32x4 hv = *(const f32x4*)(hrow + co + q4 * 4);
              const f32x4 gg = *(const f32x4*)(gain + co + q4 * 4), s0 = *(const f32x4*)(modn + co + q4 * 4), s1 = *(const f32x4*)(modn + D + co + q4 * 4);
              f32x4 yv = hv * rstd * gg;
              yv = yv * (1.f + s1) + s0;
              w[q4 * 2] = cvt_pk_bf16(yv[0], yv[1]); w[q4 * 2 + 1] = cvt_pk_bf16(yv[2], yv[3]);
            }
            *(u32x4*)(p.act + (size_t)token * D + iv * 32 + co) = w;
          }
        } else {
          const float* gain = p.final_g + iv * 32;
#pragma unroll 2
          for (int k = 0; k < 16; ++k) {
            const int co = (2 * hs + (k >> 3)) * 256 + (k & 7) * 4;
            const f32x4 hv = *(const f32x4*)(hrow + co), gg = *(const f32x4*)(gain + co);
            *(f32x4*)(hrow + co) = hv * rstd * gg;
          }
        }
      }
      __syncthreads();
    }
  }
#undef PIECE
}

constexpr int NPH = 18;
template <int PH>
__device__ __forceinline__ void run_phase(const Params& p, unsigned char* smem, int bid, int nb) {
  if constexpr (PH == 0) phase_prep(p, smem, bid, nb);
  else if constexpr (PH == 1) phase_norm(p, bid, nb, 0, NTOK, p.ctx, p.x, p.mix_g, p.mod, 0, 1);
  else if constexpr (PH == 2) phase_gemm_inproj(p, smem, bid, nb, 0);
  else if constexpr (PH == 3) phase_ret_kv(p, smem, bid, nb);
  else if constexpr (PH == 4) phase_ret_scan(p, bid, nb);
  else if constexpr (PH == 5) phase_ret_out(p, smem, bid, nb);
  else if constexpr (PH == 6) phase_gemm_outproj(p, smem, bid, nb, 0);
  else if constexpr (PH == 7) phase_resid_norm(p, bid, nb, 0, NTOK, p.ctx, p.x, p.ffn_g, p.mod);
  else if constexpr (PH == 8) phase_gemm_pq(p, smem, bid, nb, 0);
  else if constexpr (PH == 9) phase_peer_topk(p, smem, bid, nb, 0, 0, NTOK);
  else if constexpr (PH == 10) phase_peer_gather<0>(p, smem, bid, nb, 0, 0, NTOK);
  else if constexpr (PH == 11) phase_gemm_inproj(p, smem, bid, nb, 1);
  else if constexpr (PH == 12) phase_attn<0>(p, smem, bid, nb, p.act);
  else if constexpr (PH == 13) phase_gemm_outproj(p, smem, bid, nb, 1);
  else if constexpr (PH == 14) phase_resid_norm(p, bid, nb, NCTX, NTOK, p.hctx, p.out, p.ffn_g + D, p.mod + (size_t)33 * MODW);
  else if constexpr (PH == 15) phase_gemm_pq(p, smem, bid, nb, 1);
  else if constexpr (PH == 16) phase_peer_topk(p, smem, bid, nb, 1, NCTX, NLAT);
  else if constexpr (PH == 17) phase_peer_gather<0>(p, smem, bid, nb, 1, NCTX, NLAT);
}
template <int PH>
__global__ void __launch_bounds__(NTHREADS) phase_k(Params p) {
  extern __shared__ __attribute__((aligned(16))) unsigned char smem[];
  run_phase<PH>(p, smem, blockIdx.x, gridDim.x);
}
#define XB_TMO      128
#define XB_XCNT(j)  (256  + 64 * (j))
#define XB_XSUB(j)  (1280 + 64 * (j))
#define XB_XGEN(j)  (2304 + 64 * (j))
#define XB_TOP      3328
#define XB_TOPGEN   3392
#define XCD_BAR_WORDS 3456
#define XB_SPIN_CAP (1u << 22)
__device__ __forceinline__ unsigned xb_ld(unsigned* p)              { return __hip_atomic_load(p, __ATOMIC_RELAXED, __HIP_MEMORY_SCOPE_AGENT); }
__device__ __forceinline__ unsigned xb_add(unsigned* p, unsigned v) { return __hip_atomic_fetch_add(p, v, __ATOMIC_RELAXED, __HIP_MEMORY_SCOPE_AGENT); }
__device__ __forceinline__ unsigned xb_xcc_id() { return (unsigned)__builtin_amdgcn_s_getreg((3 << 11) | 20) & 0xFu; }
#define XB_SPIN(cond, bar) do { unsigned _sp = 0; while (cond) { __builtin_amdgcn_s_sleep(1); \
    if ((++_sp & 255u) == 0u) { if (xb_ld(&(bar)[XB_TMO])) break; if (_sp > XB_SPIN_CAP) { atomicAdd(&(bar)[XB_TMO], 1u); break; } } } } while (0)
struct XcdBarrier { unsigned* bar; unsigned x; volatile LAS unsigned* st; };
__device__ __forceinline__ XcdBarrier xcd_barrier_post(unsigned* bar, volatile LAS unsigned* st) {
  XcdBarrier b; b.bar = bar; b.x = xb_xcc_id(); b.st = st;
  if (threadIdx.x == 0) (void)xb_add(&bar[XB_XCNT(b.x)], 1u);
  return b;
}
__device__ __forceinline__ void xcd_barrier_complete(unsigned* bar, unsigned x, unsigned& nloc, unsigned& nx) {
  const unsigned G = gridDim.x * gridDim.y * gridDim.z;
  unsigned sum, cnt, mine, sp = 0u;
  for (;;) {
    sum = 0u; cnt = 0u; mine = 0u;
#pragma unroll
    for (unsigned j = 0; j < 16; ++j) { const unsigned c = xb_ld(&bar[XB_XCNT(j)]); sum += c; cnt += (c > 0u) ? 1u : 0u; mine = (j == x) ? c : mine; }
    if (sum == G) break;
    __builtin_amdgcn_s_sleep(1);
    if ((++sp & 255u) == 0u) { if (xb_ld(&bar[XB_TMO])) break; if (sp > XB_SPIN_CAP) { atomicAdd(&bar[XB_TMO], 1u); break; } }
  }
  nloc = mine > 0u ? mine : 1u; nx = cnt > 0u ? cnt : 1u;
}
__device__ __forceinline__ void xcd_barrier(const XcdBarrier& b) {
  asm volatile("s_waitcnt vmcnt(0)" ::: "memory");
  __syncthreads();
  if (threadIdx.x == 0) {
    unsigned* bar = b.bar;
    __builtin_amdgcn_s_waitcnt(0);
    unsigned nloc = b.st[0], nx = b.st[1];
    if (nloc == 0u) { xcd_barrier_complete(bar, b.x, nloc, nx); b.st[0] = nloc; b.st[1] = nx; }
    const unsigned old = xb_add(&bar[XB_XSUB(b.x)], 1u);
    const unsigned gen = old / nloc;
    if (old + 1u == (gen + 1u) * nloc) {
      __builtin_amdgcn_fence(__ATOMIC_RELEASE, "agent");
      asm volatile("s_waitcnt vmcnt(0)" ::: "memory");
      const unsigned og = xb_add(&bar[XB_TOP], 1u);
      const unsigned tg = og / nx;
      if (og + 1u == (tg + 1u) * nx) xb_add(&bar[XB_TOPGEN], 1u);
      else XB_SPIN(xb_ld(&bar[XB_TOPGEN]) == tg, bar);
      __builtin_amdgcn_fence(__ATOMIC_ACQUIRE, "agent");
      xb_add(&bar[XB_XGEN(b.x)], 1u);
      asm volatile("s_waitcnt vmcnt(0)" ::: "memory");
    } else {
      XB_SPIN(xb_ld(&bar[XB_XGEN(b.x)]) == gen, bar);
      __builtin_amdgcn_fence(__ATOMIC_ACQUIRE, "agent");
      asm volatile("s_waitcnt vmcnt(0)" ::: "memory");
    }
  }
  __syncthreads();
}

#if MK_ONE_LAUNCH
constexpr int PARAMS_OFF = LDS_BYTES - 512;
static_assert(sizeof(Params) <= 480, "params block");
template <class T>
__device__ __forceinline__ T* uni(T* q) {
  const unsigned long long v = (unsigned long long)q;
  const unsigned lo = __builtin_amdgcn_readfirstlane((unsigned)v), hi = __builtin_amdgcn_readfirstlane((unsigned)(v >> 32));
  return (T*)(((unsigned long long)hi << 32) | lo);
}
__device__ __forceinline__ Params load_params(const unsigned char* smem) {
  const Params* l = (const Params*)(smem + PARAMS_OFF);
  Params q;
  q.x = uni(l->x); q.c = uni(l->c); q.ctx = uni(l->ctx); q.c_ctx = uni(l->c_ctx); q.ada_w = uni(l->ada_w); q.ada_b = uni(l->ada_b);
  q.mix_g = uni(l->mix_g); q.ffn_g = uni(l->ffn_g); q.ev_w_in = uni(l->ev_w_in); q.ev_w_out = uni(l->ev_w_out);
  q.logit_f = uni(l->logit_f); q.logit_b = uni(l->logit_b); q.conv_w = uni(l->conv_w); q.od_w_in = uni(l->od_w_in);
  q.od_w_out = uni(l->od_w_out); q.sinks = uni(l->sinks); q.peer_wq = uni(l->peer_wq); q.keys1 = uni(l->keys1); q.keys2 = uni(l->keys2);
  q.peer_u = uni(l->peer_u); q.peer_v = uni(l->peer_v); q.final_g = uni(l->final_g); q.out = uni(l->out); q.mod = uni(l->mod);
  q.ropec = uni(l->ropec); q.ropes = uni(l->ropes); q.winT0 = uni(l->winT0); q.woutT0 = uni(l->woutT0); q.winT1 = uni(l->winT1);
  q.woutT1 = uni(l->woutT1); q.wqT = uni(l->wqT); q.u8 = uni(l->u8); q.v8 = uni(l->v8); q.uscale = uni(l->uscale); q.vscale = uni(l->vscale); q.hctx = uni(l->hctx); q.act = uni(l->act);
  q.proj = uni(l->proj); q.pq = uni(l->pq); q.sel = uni(l->sel); q.kv = uni(l->kv); q.sprev = uni(l->sprev); q.bar = uni(l->bar); q.keysb = uni(l->keysb);
  return q;
}
template <int PH>
__device__ __forceinline__ void run_from(unsigned char* smem, int bid, int nb, const XcdBarrier& xb) {
  {
    const Params q = load_params(smem);
    run_phase<PH>(q, smem, bid, nb);
  }
#ifdef DUP_PH
  if constexpr (PH == DUP_PH) {
    xcd_barrier(xb);
    const Params q = load_params(smem);
#ifdef DUP_ATTN_VAR
    phase_attn<DUP_ATTN_VAR>(q, smem, bid, nb, q.proj + (size_t)113246208);
#elif defined(DUP_GATHER_VAR)
    phase_peer_gather<DUP_GATHER_VAR>(q, smem, bid, nb, 1, NCTX, NLAT);
#else
    run_phase<PH>(q, smem, bid, nb);
#endif
  }
#endif
  if constexpr (PH + 1 < NPH) {
    if constexpr (PH == 0) cg::this_grid().sync();
    else xcd_barrier(xb);
    run_from<PH + 1>(smem, bid, nb, xb);
  }
}
__global__ void __launch_bounds__(NTHREADS) mega(Params p) {
  extern __shared__ __attribute__((aligned(16))) unsigned char smem[];
  volatile LAS unsigned* st = (volatile LAS unsigned*)((LAS unsigned char*)smem + PARAMS_OFF + 480);
  if (threadIdx.x == 0) { *(Params*)(smem + PARAMS_OFF) = p; st[0] = 0u; st[1] = 0u; }
  __syncthreads();
  const XcdBarrier xb = xcd_barrier_post(p.bar, st);
  run_from<0>(smem, blockIdx.x, gridDim.x, xb);
}
#endif
#ifndef DBG_NPH
#define DBG_NPH 0
#endif
#if DBG_NPH
__global__ void __launch_bounds__(NTHREADS) dbg_sums(Params p, float* scr, int nph) {
  const int wid = threadIdx.x >> 6, lane = threadIdx.x & 63;
  const int gw = blockIdx.x * 8 + wid, nw = gridDim.x * 8;
  if (nph >= 2) for (int r = gw; r < NTOK; r += nw) { float s = 0.f; for (int c = lane; c < D; c += 64) s += bf2f(p.act[(size_t)r * D + c]) * (1 + (c & 7)); s = wave_sum(s); if (lane == 0) scr[r] = s; }
  if (nph >= 3 && nph <= 8) for (int r = gw; r < NTOK; r += nw) { float s = 0.f; for (int c = lane; c < 3072; c += 64) s += bf2f(p.proj[(size_t)r * 3072 + c]) * (1 + (c & 7)); s = wave_sum(s); if (lane == 0) scr[(1 << 20) + r] = s; }
  if (nph >= 12 && nph <= 15) for (int r = gw; r < NTOK; r += nw) { float s = 0.f; for (int c = lane + (r < NCTX ? 1024 : 0); c < 1536; c += 64) s += bf2f(p.proj[(size_t)r * 1536 + c]) * (1 + (c & 7)); s = wave_sum(s); if (lane == 0) scr[(1 << 20) + r] = s; }
  if (nph >= 4) for (int r = gw; r < 2304 * 128; r += nw) { float s = 0.f; for (int c = lane; c < 128; c += 64) s += p.kv[(size_t)r * 128 + c] * (1 + (c & 7)); s = wave_sum(s); if (lane == 0) scr[(2 << 20) + r] = s; }
  if (nph >= 5) for (int r = gw; r < 2304 * 128; r += nw) { float s = 0.f; for (int c = lane; c < 128; c += 64) s += bf2f(p.sprev[(size_t)r * 128 + c]) * (1 + (c & 7)); s = wave_sum(s); if (lane == 0) scr[(3 << 20) + r] = s; }
  if (nph >= 7) for (int r = gw; r < NCTX; r += nw) { float s = 0.f; for (int c = lane; c < D; c += 64) s += p.hctx[(size_t)r * D + c] * (1 + (c & 7)); s = wave_sum(s); if (lane == 0) scr[(4 << 20) + r] = s; }
  if (nph >= 1) for (int i = blockIdx.x * NTHREADS + threadIdx.x; i < 2 * 33 * MODW; i += gridDim.x * NTHREADS) scr[(5 << 20) + i] = p.mod[i];
  if (nph >= 7) for (int r = gw; r < NLAT; r += nw) { float s = 0.f; for (int c = lane; c < D; c += 64) s += p.out[(size_t)r * D + c] * (1 + (c & 7)); s = wave_sum(s); if (lane == 0) scr[(6 << 20) + r] = s; }
  if (nph >= 10 && nph <= 11) for (int r = gw; r < NTOK; r += nw) { float s = 0.f; for (int c = lane; c < 128; c += 64) { const u32x2 e = p.sel[(size_t)r * 128 + c]; s += __uint_as_float(e.y) * (float)(e.x & 1023); } s = wave_sum(s); if (lane == 0) scr[(7 << 20) + r] = s; }
}
__global__ void __launch_bounds__(NTHREADS) dbg_out(Params p, const float* scr) {
  for (size_t i = (size_t)blockIdx.x * NTHREADS + threadIdx.x; i < (size_t)NLAT * D; i += (size_t)gridDim.x * NTHREADS) p.out[i] = (i < (size_t)(8 << 20)) ? scr[i] : 0.f;
}
__global__ void __launch_bounds__(NTHREADS) dbg_zero(float* scr) {
  for (size_t i = (size_t)blockIdx.x * NTHREADS + threadIdx.x; i < (size_t)(8 << 20); i += (size_t)gridDim.x * NTHREADS) scr[i] = 0.f;
}
#endif
template <int PH>
static void launch_phases(const Params& p, int grid, hipStream_t stream) {
  static bool attr_set = false;
  if (!attr_set) { (void)hipFuncSetAttribute((const void*)phase_k<PH>, hipFuncAttributeMaxDynamicSharedMemorySize, LDS_BYTES); attr_set = true; }
  phase_k<PH><<<grid, NTHREADS, LDS_BYTES, stream>>>(p);
  if constexpr (PH + 1 < (DBG_NPH ? DBG_NPH : NPH)) launch_phases<PH + 1>(p, grid, stream);
}

extern "C" void kernel_launch(void* const* d_in, const int* in_sizes, int n_in, void* d_out, int out_size, void* d_ws,
                              size_t ws_size, hipStream_t stream) {
  Params p{};
  const float* const* in = (const float* const*)d_in;
  p.x = in[0]; p.c = in[1]; p.ctx = in[2]; p.c_ctx = in[3]; p.ada_w = in[4]; p.ada_b = in[5]; p.mix_g = in[6]; p.ffn_g = in[7];
  p.ev_w_in = in[8]; p.ev_w_out = in[9]; p.logit_f = in[10]; p.logit_b = in[11]; p.conv_w = in[12]; p.od_w_in = in[13];
  p.od_w_out = in[14]; p.sinks = in[15]; p.peer_wq = in[16]; p.keys1 = in[17]; p.keys2 = in[18]; p.peer_u = in[19];
  p.peer_v = in[20]; p.final_g = in[21];
  p.out = (float*)d_out;
  unsigned char* w = (unsigned char*)d_ws;
  size_t off = 0;
  auto take = [&](size_t bytes) { unsigned char* r = w + off; off += (bytes + 255) & ~(size_t)255; return r; };
  p.mod = (float*)take((size_t)2 * 33 * MODW * 4);
  p.ropec = (float*)take(1024 * 4);
  p.ropes = (float*)take(1024 * 4);
  p.winT0 = (bf16_t*)take((size_t)3072 * 1024 * 2);
  p.woutT0 = (bf16_t*)take((size_t)1024 * 1024 * 2);
  p.winT1 = (bf16_t*)take((size_t)1536 * 1024 * 2);
  p.woutT1 = (bf16_t*)take((size_t)1024 * 1024 * 2);
  p.wqT = (bf16_t*)take((size_t)2 * 1024 * 1024 * 2);
  p.u8 = (unsigned char*)take((size_t)2 * NEXP * 768);
  p.v8 = (unsigned char*)take((size_t)2 * NEXP * 768);
  p.uscale = (float*)take((size_t)2 * NEXP * 4);
  p.vscale = (float*)take((size_t)2 * NEXP * 4);
  p.hctx = (float*)take((size_t)NCTX * D * 4);
  p.act = (bf16_t*)take((size_t)NTOK * D * 2);
  p.kv = (float*)take((size_t)2304 * 16384 * 4);
  p.sprev = (bf16_t*)take((size_t)2304 * 16384 * 2);
  p.bar = (unsigned*)take((size_t)XCD_BAR_WORDS * 4);
  p.keysb = (bf16_t*)take((size_t)2 * 8 * 2 * 2 * 128 * 64 * 2);
  p.proj = (bf16_t*)take((size_t)NTOK * 3072 * 2);
  p.pq = p.proj;
  p.sel = (u32x2*)((unsigned char*)p.proj + (size_t)NTOK * D * 2);
  if (off > ws_size) { fprintf(stderr, "workspace too small: need %zu have %zu\n", off, ws_size); }

  int grid = 256;
#if MK_ONE_LAUNCH
  static int grid_blocks = 0;
  if (!grid_blocks) {
    (void)hipFuncSetAttribute((const void*)mega, hipFuncAttributeMaxDynamicSharedMemorySize, LDS_BYTES);
    int dev = 0, cus = 0, per_cu = 0;
    (void)hipGetDevice(&dev);
    (void)hipDeviceGetAttribute(&cus, hipDeviceAttributeMultiprocessorCount, dev);
    (void)hipOccupancyMaxActiveBlocksPerMultiprocessor(&per_cu, mega, NTHREADS, LDS_BYTES);
    if (per_cu > 1) per_cu = 1;
    grid_blocks = cus * per_cu;
    if (grid_blocks <= 0) grid_blocks = 256;
  }
  grid = grid_blocks;
  (void)hipMemsetAsync(p.bar, 0, (size_t)XCD_BAR_WORDS * 4, stream);
  void* args[] = {&p};
  hipError_t e = hipLaunchCooperativeKernel((const void*)mega, dim3(grid), dim3(NTHREADS), args, LDS_BYTES, stream);
  if (e != hipSuccess) fprintf(stderr, "cooperative launch failed: %s\n", hipGetErrorString(e));
#else
  launch_phases<0>(p, grid, stream);
#if DBG_NPH
  float* scr = (float*)(w + off);
  dbg_zero<<<grid, NTHREADS, 0, stream>>>(scr);
  dbg_sums<<<grid, NTHREADS, 0, stream>>>(p, scr, DBG_NPH);
  dbg_out<<<grid, NTHREADS, 0, stream>>>(p, scr);
#endif
#endif
}
```
